# Optimizing an MI355X kernel written in HIP

```python
import math
import jax, jax.numpy as jnp
from jax import lax
import numpy as np

D_MODEL = 1024
BATCH = 8
SEQ = 2048
DEPTH = 1

N_HEADS = 8
QK_NOPE_DIM = 128
QK_ROPE_DIM = 64
V_HEAD_DIM = 128
Q_LORA_RANK = 384
KV_LORA_RANK = 256
ROPE_THETA = 10000.0
Q_BLOCK = 128
POOL_WINDOWS = (2, 4, 8, 16)
POOL_GROUP = 128
POOL_WIDTH = POOL_GROUP * len(POOL_WINDOWS)
D_FF = 2816
MACARON_WEIGHT = 0.5
N_BRANCHES = 2
NORM_EPS = 1e-6
IN_OFFSETS = [
    Q_LORA_RANK,
    Q_LORA_RANK + KV_LORA_RANK,
    Q_LORA_RANK + KV_LORA_RANK + QK_ROPE_DIM,
    Q_LORA_RANK + KV_LORA_RANK + QK_ROPE_DIM + POOL_WIDTH,
]
IN_WIDTH = Q_LORA_RANK + KV_LORA_RANK + QK_ROPE_DIM + POOL_WIDTH + N_BRANCHES * D_MODEL

kernel_name = "hybrid_mla_pool_macaron_block"


def _rmsnorm(x, g):
    xf = x.astype(jnp.float32)
    y = xf * lax.rsqrt(jnp.mean(xf * xf, axis=-1, keepdims=True) + NORM_EPS)
    return (y * g.astype(jnp.float32)).astype(x.dtype)


def _swiglu(x, w_gate, w_up, w_down):
    return (jax.nn.silu(x @ w_gate) * (x @ w_up)) @ w_down


def _rope(x, cos, sin):
    half = x.shape[-1] // 2
    x1, x2 = x[..., :half], x[..., half:]
    return jnp.concatenate([x1 * cos - x2 * sin, x2 * cos + x1 * sin], axis=-1)


def _mla(c_q, c_kv, k_r, positions, q_a_norm_g, w_uq, kv_a_norm_g, w_uk, w_uv):
    b, s, _ = c_q.shape
    q = (_rmsnorm(c_q, q_a_norm_g) @ w_uq).reshape(b, s, N_HEADS, QK_NOPE_DIM + QK_ROPE_DIM)
    q_nope, q_rope = q[..., :QK_NOPE_DIM], q[..., QK_NOPE_DIM:]
    c_kv = _rmsnorm(c_kv, kv_a_norm_g)
    k_nope = (c_kv @ w_uk).reshape(b, s, N_HEADS, QK_NOPE_DIM)
    v = (c_kv @ w_uv).reshape(b, s, N_HEADS, V_HEAD_DIM)
    inv_freq = ROPE_THETA ** (-jnp.arange(0, QK_ROPE_DIM, 2, dtype=jnp.float32) / QK_ROPE_DIM)
    ang = positions.astype(jnp.float32)[..., None] * inv_freq
    cos = jnp.cos(ang).astype(c_q.dtype)
    sin = jnp.sin(ang).astype(c_q.dtype)
    k_rope = _rope(k_r, cos, sin)
    q_rope = _rope(q_rope, cos[:, :, None, :], sin[:, :, None, :])
    scale = 1.0 / math.sqrt(QK_NOPE_DIM + QK_ROPE_DIM)
    nb = s // Q_BLOCK

    def to_blocks(t):
        return t.reshape(b, nb, Q_BLOCK, *t.shape[2:]).swapaxes(0, 1)

    def attend(qs):
        qn, qr = qs
        logits = (jnp.einsum('bqhd,bkhd->bhqk', qn, k_nope)
                  + jnp.einsum('bqhd,bkd->bhqk', qr, k_rope))
        p = jax.nn.softmax(logits.astype(jnp.float32) * scale, axis=-1).astype(v.dtype)
        return jnp.einsum('bhqk,bkhd->bqhd', p, v)

    o = lax.map(attend, (to_blocks(q_nope), to_blocks(q_rope)))
    return o.swapaxes(0, 1).reshape(b, s, N_HEADS * V_HEAD_DIM)


def _centred_mean(xg, window):
    s = xg.shape[1]
    xf = xg.astype(jnp.float32)
    csum = jnp.concatenate([jnp.zeros_like(xf[:, :1]), jnp.cumsum(xf, axis=1)], axis=1)
    left = window // 2
    right = window - 1 - left
    t = jnp.arange(s)
    lo = jnp.clip(t - left, 0, s)
    hi = jnp.clip(t + right + 1, 0, s)
    total = jnp.take(csum, hi, axis=1) - jnp.take(csum, lo, axis=1)
    count = (hi - lo).astype(jnp.float32)
    return (total / count[None, :, None]).astype(xg.dtype)


def _pool_mixer(xp, pool_w, pool_scale):
    groups = []
    for gi, w in enumerate(POOL_WINDOWS):
        xg = xp[..., gi * POOL_GROUP:(gi + 1) * POOL_GROUP]
        groups.append(_centred_mean(xg, w) - xg)
    d = jnp.stack(groups, axis=2)
    y = jnp.einsum('bsgc,gcd->bsgd', d, pool_w)
    return y.reshape(xp.shape[0], xp.shape[1], POOL_WIDTH) * pool_scale


def setup_inputs(seed: int = 0) -> dict:
    key = jax.random.key(seed)
    ks = list(jax.random.split(key, 32))

    def dense(k, shape, fan_in):
        return jax.random.normal(k, shape, jnp.float32) * (fan_in ** -0.5)

    def gain(k, shape):
        return 1.0 + 0.05 * jax.random.normal(k, shape, jnp.float32)

    L = DEPTH
    return {
        "x": jax.random.normal(ks[0], (BATCH, SEQ, D_MODEL), jnp.float32),
        "positions": jnp.broadcast_to(jnp.arange(SEQ, dtype=jnp.int32), (BATCH, SEQ)),
        "ffn1_pre_g": gain(ks[1], (L, D_MODEL)),
        "ffn1_w_gate": dense(ks[2], (L, D_MODEL, D_FF), D_MODEL),
        "ffn1_w_up": dense(ks[3], (L, D_MODEL, D_FF), D_MODEL),
        "ffn1_w_down": dense(ks[4], (L, D_FF, D_MODEL), D_FF),
        "ffn1_post_g": gain(ks[5], (L, D_MODEL)),
        "mix_pre_g": gain(ks[6], (L, D_MODEL)),
        "w_in": dense(ks[7], (L, D_MODEL, IN_WIDTH), D_MODEL),
        "q_a_norm_g": gain(ks[8], (L, Q_LORA_RANK)),
        "w_uq": dense(ks[9], (L, Q_LORA_RANK, N_HEADS * (QK_NOPE_DIM + QK_ROPE_DIM)), Q_LORA_RANK),
        "kv_a_norm_g": gain(ks[10], (L, KV_LORA_RANK)),
        "w_uk": dense(ks[11], (L, KV_LORA_RANK, N_HEADS * QK_NOPE_DIM), KV_LORA_RANK),
        "w_uv": dense(ks[12], (L, KV_LORA_RANK, N_HEADS * V_HEAD_DIM), KV_LORA_RANK),
        "w_o_attn": dense(ks[13], (L, N_HEADS * V_HEAD_DIM, D_MODEL), N_HEADS * V_HEAD_DIM),
        "pool_w": dense(ks[14], (L, len(POOL_WINDOWS), POOL_GROUP, POOL_GROUP), POOL_GROUP),
        "pool_scale": gain(ks[15], (L, POOL_WIDTH)),
        "w_o_pool": dense(ks[16], (L, POOL_WIDTH, D_MODEL), POOL_WIDTH),
        "w_out": dense(ks[17], (L, D_MODEL, D_MODEL), D_MODEL),
        "mix_post_g": gain(ks[18], (L, D_MODEL)),
        "ffn2_pre_g": gain(ks[19], (L, D_MODEL)),
        "ffn2_w_gate": dense(ks[20], (L, D_MODEL, D_FF), D_MODEL),
        "ffn2_w_up": dense(ks[21], (L, D_MODEL, D_FF), D_MODEL),
        "ffn2_w_down": dense(ks[22], (L, D_FF, D_MODEL), D_FF),
        "ffn2_post_g": gain(ks[23], (L, D_MODEL)),
        "final_g": gain(ks[24], (L, D_MODEL)),
    }


def reference(x, positions, ffn1_pre_g, ffn1_w_gate, ffn1_w_up, ffn1_w_down, ffn1_post_g,
              mix_pre_g, w_in, q_a_norm_g, w_uq, kv_a_norm_g, w_uk, w_uv, w_o_attn,
              pool_w, pool_scale, w_o_pool, w_out, mix_post_g,
              ffn2_pre_g, ffn2_w_gate, ffn2_w_up, ffn2_w_down, ffn2_post_g, final_g):
    for l in range(DEPTH):
        f1 = _swiglu(_rmsnorm(x, ffn1_pre_g[l]), ffn1_w_gate[l], ffn1_w_up[l], ffn1_w_down[l])
        x = x + MACARON_WEIGHT * _rmsnorm(f1, ffn1_post_g[l])

        u = _rmsnorm(x, mix_pre_g[l])
        z = u @ w_in[l]
        c_q, c_kv, k_r, x_pool, gate_logits = jnp.split(z, IN_OFFSETS, axis=-1)
        y_attn = _mla(c_q, c_kv, k_r, positions, q_a_norm_g[l], w_uq[l],
                      kv_a_norm_g[l], w_uk[l], w_uv[l]) @ w_o_attn[l]
        y_pool = _pool_mixer(x_pool, pool_w[l], pool_scale[l]) @ w_o_pool[l]
        g_attn, g_pool = jnp.split(jax.nn.sigmoid(gate_logits), N_BRANCHES, axis=-1)
        mixed = (g_attn * y_attn + g_pool * y_pool) @ w_out[l]
        x = x + _rmsnorm(mixed, mix_post_g[l])

        f2 = _swiglu(_rmsnorm(x, ffn2_pre_g[l]), ffn2_w_gate[l], ffn2_w_up[l], ffn2_w_down[l])
        x = x + MACARON_WEIGHT * _rmsnorm(f2, ffn2_post_g[l])

        x = _rmsnorm(x, final_g[l])
    return x
```

```cpp
#include <hip/hip_runtime.h>
#include <hip/hip_cooperative_groups.h>
#include <cstdio>
#include <cmath>
#include <cstdint>
namespace cg = cooperative_groups;

#define LAS __attribute__((address_space(3)))
typedef unsigned short bf16_t;
typedef short bf16x8 __attribute__((ext_vector_type(8)));
typedef short s16x4 __attribute__((ext_vector_type(4)));
typedef float f32x2 __attribute__((ext_vector_type(2)));
typedef float f32x4 __attribute__((ext_vector_type(4)));
typedef float f32x16 __attribute__((ext_vector_type(16)));
typedef unsigned u32x4 __attribute__((ext_vector_type(4)));
typedef unsigned u32x2 __attribute__((ext_vector_type(2)));

constexpr int DM = 1024, NB = 8, SEQ = 2048, M = NB * SEQ, NH = 8, QL = 384, KVL = 256, DFF = 2816, INW = 3264;
constexpr float EPS = 1e-6f;
constexpr int NTHREADS = 512, NWAVES = 8;
constexpr int LDS_BYTES = 131072;

constexpr size_t MiB = 1048576;
constexpr size_t OFF_WGU = 0;
constexpr size_t OFF_WD = OFF_WGU + (size_t)5632 * 1024 * 2;
constexpr size_t OFF_WIN = OFF_WD + (size_t)1024 * 2816 * 2;
constexpr size_t OFF_WUQ = OFF_WIN + (size_t)3328 * 1024 * 2;
constexpr size_t OFF_WUKV = OFF_WUQ + (size_t)1536 * 384 * 2;
constexpr size_t OFF_WOA = OFF_WUKV + (size_t)2048 * 256 * 2;
constexpr size_t OFF_WP = OFF_WOA + (size_t)1024 * 1024 * 2;
constexpr size_t OFF_WOUT = OFF_WP + (size_t)1024 * 512 * 2;
constexpr size_t OFF_XN = OFF_WOUT + (size_t)1024 * 1024 * 2;
constexpr size_t OFF_R = OFF_XN + 32 * MiB;
constexpr size_t OFF_F = OFF_R;
constexpr size_t OFF_ZF = OFF_R;
constexpr size_t OFF_KV = OFF_R;
constexpr size_t OFF_H = OFF_R + 64 * MiB;
constexpr size_t OFF_O = OFF_R + 64 * MiB;
constexpr size_t OFF_CQN = OFF_R + 80 * MiB;
constexpr size_t OFF_CKVN = OFF_R + 92 * MiB;
constexpr size_t OFF_TAB = OFF_R + 100 * MiB;
constexpr size_t OFF_Q = OFF_R + 104 * MiB;
constexpr size_t OFF_KR = OFF_R + 152 * MiB;
constexpr size_t OFF_G = OFF_R + 96 * MiB;
constexpr size_t OFF_DP = OFF_R + 176 * MiB;
constexpr size_t WS_END = OFF_R + 192 * MiB;
static_assert(WS_END <= 256 * MiB, "workspace");

struct Params {
    const float* x; const int* pos;
    const float *f1_pre, *f1_wg, *f1_wu, *f1_wd, *f1_post;
    const float *mix_pre, *w_in, *qa_g, *w_uq, *kva_g, *w_uk, *w_uv, *w_oa, *pool_w, *pool_scale, *w_op, *w_out, *mix_post;
    const float *f2_pre, *f2_wg, *f2_wu, *f2_wd, *f2_post, *final_g;
    float* out; unsigned char* ws;
    float inv_freq[32];
};

typedef __bf16 bf16x2_t __attribute__((ext_vector_type(2)));
__device__ __forceinline__ unsigned cvt_pk_bf16(float lo, float hi) { const f32x2 v = {lo, hi}; const bf16x2_t r = __builtin_convertvector(v, bf16x2_t); return __builtin_bit_cast(unsigned, r); }
__device__ __forceinline__ float bf_lo(unsigned w) { return __uint_as_float(w << 16); }
__device__ __forceinline__ float bf_hi(unsigned w) { return __uint_as_float(w & 0xffff0000u); }
__device__ __forceinline__ float sigmoidf_fast(float z) { return __builtin_amdgcn_rcpf(1.f + __builtin_amdgcn_exp2f(-1.4426950408889634f * z)); }
__device__ __forceinline__ int fresh_tid() { int t = threadIdx.x; asm volatile("" : "+v"(t)); return t; }
__device__ __forceinline__ float wave_sum(float v) {
#pragma unroll
    for (int o = 1; o < 64; o <<= 1) v += __shfl_xor(v, o);
    return v;
}

namespace pg8 {
constexpr int BM = 256, BK = 64, HALF = 128, HTB = HALF * BK * 2, STAGE_BYTES = 8 * HTB, NXCD = 8, WGM = 8;
__host__ __device__ __forceinline__ int lds_byte(int r, int c) { const int st = (r >> 4) * 2 + (c >> 5), rr = r & 15, cc = c & 31, ob = rr * 64 + cc * 2; return st * 1024 + (ob ^ (((ob >> 9) & 1) << 5)); }
__host__ __device__ __forceinline__ void stage_rc(int b, int& R, int& C) { const int st = b / 1024, sb = b % 1024, swz = sb ^ (((sb >> 9) & 1) << 5); R = (st >> 1) * 16 + swz / 64; C = (st & 1) * 32 + (swz % 64) / 2; }
__host__ __device__ __forceinline__ int perm32(int rho) { const int n = rho >> 4, i = rho & 15; return 8 * (i >> 2) + 4 * n + (i & 3); }
struct Unit { int pm, pn; };
struct Gemm { const bf16_t* A; const bf16_t* Bt; int M, N, K; };
struct StaticOrder {
    int nM, nN, nwg, G, c;
    __device__ void init(int M_, int N_, int G_, int c_) { nM = M_ / BM; nN = N_ / BM; nwg = nM * nN; G = G_; c = c_; }
    __device__ bool next(int i, Unit& u) const {
        const long L = (long)i * G + c; if (L >= nwg) return false;
        int wgid = (int)L; { const int q = nwg / NXCD, r = nwg % NXCD, xcd = wgid % NXCD, off = wgid / NXCD; wgid = (xcd < r ? xcd * (q + 1) : r * (q + 1) + (xcd - r) * q) + off; }
        const int nig = WGM * nN, gid = wgid / nig, fm = gid * WGM, gsz = (nM - fm) < WGM ? (nM - fm) : WGM;
        u.pm = fm + ((wgid % nig) % gsz); u.pn = (wgid % nig) / gsz; return true;
    }
};

template <class Epi>
__device__ __forceinline__ void gemm_phase(LAS unsigned char* lds, const Gemm g, const StaticOrder& S, const Epi& E) {
    const int tid = fresh_tid(), wid = __builtin_amdgcn_readfirstlane(tid >> 6), lane = tid & 63, wr = wid >> 2, wc = wid & 3, fr = lane & 15, fq = lane >> 4;
    const int K = g.K, nt = K / BK;
    unsigned voffA[2], voffB[2];
#pragma unroll
    for (int i = 0; i < 2; ++i) { int R, C; stage_rc(tid * 16 + i * 8192, R, C); const int Rb = Epi::PERM ? ((R & ~31) + perm32(R & 31)) : R;
        voffA[i] = (unsigned)(R * K + C) * 2u; voffB[i] = (unsigned)(Rb * K + C) * 2u; }
    const size_t kstep = (size_t)(BK * 2);
    const size_t hstep = (size_t)HALF * K * 2;
    const size_t tstep = 2 * hstep;
    const unsigned ldsw = (unsigned)wid * 1024u;
    const int aoff = lds_byte(wr * 64 + fr, fq * 8), boff = lds_byte(wc * 32 + fr, fq * 8);
#define PG8_SA(b, h) (((b) * 2 + (h)) * HTB)
#define PG8_SB(b, h) ((4 + (b) * 2 + (h)) * HTB)
#define PG8_STAGE(bufoff, gbase, voff) do { _Pragma("unroll") for (int _i = 0; _i < 2; ++_i) \
        __builtin_amdgcn_global_load_lds((const unsigned*)((const char*)(gbase) + (voff)[_i]), (LAS unsigned*)(lds + (bufoff) + ldsw + _i * 8192), 16, 0, 0); } while (0)
#define PG8_LDA(dst, b, h) do { _Pragma("unroll") for (int m = 0; m < 4; ++m) _Pragma("unroll") for (int k = 0; k < 2; ++k) dst[m][k] = *(const LAS bf16x8*)(lds + PG8_SA(b, h) + aoff + m * 2048 + k * 1024); } while (0)
#define PG8_LDB(dst, b, h) do { _Pragma("unroll") for (int n = 0; n < 2; ++n) _Pragma("unroll") for (int k = 0; k < 2; ++k) dst[n][k] = *(const LAS bf16x8*)(lds + PG8_SB(b, h) + boff + n * 2048 + k * 1024); } while (0)
#define PG8_MMA(ai, bj, At, Bt) do { __builtin_amdgcn_s_setprio(1); _Pragma("unroll") for (int m = 0; m < 4; ++m) _Pragma("unroll") for (int n = 0; n < 2; ++n) _Pragma("unroll") for (int k = 0; k < 2; ++k) \
        acc[ai][bj][m][n] = __builtin_amdgcn_mfma_f32_16x16x32_bf16(Bt[n][k], At[m][k], acc[ai][bj][m][n], 0, 0, 0); __builtin_amdgcn_s_setprio(0); } while (0)
#define PG8_WAIT_V(n) asm volatile("s_waitcnt vmcnt(" #n ")" ::: "memory")
#define PG8_WAIT_L(n) asm volatile("s_waitcnt lgkmcnt(" #n ")" ::: "memory")
#define PG8_BAR __builtin_amdgcn_s_barrier()
#define PG8_SCHED __builtin_amdgcn_sched_barrier(0)
    Unit cur, nxt; int ui = 0;
    if (!S.next(0, cur)) return;
    f32x4 acc[2][2][4][2];
#pragma unroll
    for (int a = 0; a < 2; ++a)
#pragma unroll
        for (int b = 0; b < 2; ++b)
#pragma unroll
            for (int m = 0; m < 4; ++m)
#pragma unroll
                for (int n = 0; n < 2; ++n) acc[a][b][m][n] = (f32x4){0.f, 0.f, 0.f, 0.f};
    bf16x8 At[4][2], B0[2][2], B1[2][2];
    const char* cA = (const char*)g.A + (size_t)cur.pm * tstep; const char* cB = (const char*)g.Bt + (size_t)cur.pn * tstep;
    PG8_STAGE(PG8_SB(0, 0), cB, voffB); PG8_STAGE(PG8_SA(0, 0), cA, voffA); PG8_STAGE(PG8_SB(0, 1), cB + hstep, voffB); PG8_STAGE(PG8_SA(0, 1), cA + hstep, voffA);
    if (wr == 1) PG8_BAR;
    PG8_WAIT_V(4); PG8_BAR;
    PG8_STAGE(PG8_SB(1, 0), cB + kstep, voffB); PG8_STAGE(PG8_SA(1, 0), cA + kstep, voffA); PG8_STAGE(PG8_SB(1, 1), cB + hstep + kstep, voffB);
    PG8_WAIT_V(6); PG8_BAR;
    for (;;) {
        const bool has_next = S.next(ui + 1, nxt);
        const char* nA = has_next ? (const char*)g.A + (size_t)nxt.pm * tstep : cA; const char* nB = has_next ? (const char*)g.Bt + (size_t)nxt.pn * tstep : cB;
        for (int t = 0; t < nt; t += 2) {
            const bool last = (t == nt - 2);
            const char* a1 = cA + (size_t)(t + 1) * kstep;
            const char* a2 = last ? nA : cA + (size_t)(t + 2) * kstep; const char* b2 = last ? nB : cB + (size_t)(t + 2) * kstep;
            const char* a3 = a2 + kstep; const char* b3 = b2 + kstep;
            PG8_LDB(B0, 0, 0); PG8_SCHED; PG8_LDA(At, 0, 0); PG8_STAGE(PG8_SA(1, 1), a1 + hstep, voffA);
            PG8_WAIT_L(8); PG8_BAR; PG8_WAIT_L(0); PG8_MMA(0, 0, At, B0); PG8_BAR; PG8_SCHED;
            PG8_LDB(B1, 0, 1); PG8_STAGE(PG8_SB(0, 0), b2, voffB);
            PG8_BAR; PG8_WAIT_L(0); PG8_MMA(0, 1, At, B1); PG8_BAR;
            PG8_LDA(At, 0, 1); PG8_STAGE(PG8_SA(0, 0), a2, voffA);
            PG8_BAR; PG8_WAIT_L(0); PG8_MMA(1, 0, At, B0); PG8_BAR; PG8_SCHED;
            PG8_STAGE(PG8_SB(0, 1), b2 + hstep, voffB);
            PG8_WAIT_V(6); PG8_BAR; PG8_MMA(1, 1, At, B1); PG8_BAR;
            PG8_LDB(B0, 1, 0); PG8_SCHED; PG8_LDA(At, 1, 0); PG8_STAGE(PG8_SA(0, 1), a2 + hstep, voffA);
            PG8_WAIT_L(8); PG8_BAR; PG8_WAIT_L(0); PG8_MMA(0, 0, At, B0); PG8_BAR; PG8_SCHED;
            PG8_LDB(B1, 1, 1); PG8_STAGE(PG8_SB(1, 0), b3, voffB);
            PG8_BAR; PG8_WAIT_L(0); PG8_MMA(0, 1, At, B1); PG8_BAR;
            PG8_LDA(At, 1, 1); PG8_STAGE(PG8_SA(1, 0), a3, voffA);
            PG8_BAR; PG8_WAIT_L(0); PG8_MMA(1, 0, At, B0); PG8_BAR; PG8_SCHED;
            PG8_STAGE(PG8_SB(1, 1), b3 + hstep, voffB);
            PG8_WAIT_V(6); PG8_BAR; PG8_MMA(1, 1, At, B1); PG8_BAR;
        }
        { const int t2 = fresh_tid(); E(acc, cur, wr, wc, t2 & 15, (t2 >> 4) & 3); }
        if (!has_next) break;
#pragma unroll
        for (int a = 0; a < 2; ++a)
#pragma unroll
            for (int b = 0; b < 2; ++b)
#pragma unroll
                for (int m = 0; m < 4; ++m)
#pragma unroll
                    for (int n = 0; n < 2; ++n) acc[a][b][m][n] = (f32x4){0.f, 0.f, 0.f, 0.f};
        cur = nxt; cA = nA; cB = nB; ++ui;
    }
    PG8_WAIT_V(0);
    if (wr == 0) PG8_BAR;
    PG8_BAR;
#undef PG8_SA
#undef PG8_SB
#undef PG8_STAGE
#undef PG8_LDA
#undef PG8_LDB
#undef PG8_MMA
#undef PG8_WAIT_V
#undef PG8_WAIT_L
#undef PG8_BAR
#undef PG8_SCHED
}

typedef f32x4 Acc[2][2][4][2];
struct EpiF32 {
    static constexpr bool PERM = false;
    float* C; int ldc;
    __device__ __forceinline__ void operator()(const Acc& acc, const Unit& u, int wr, int wc, int fr, int fq) const {
        const int row0 = u.pm * BM + wr * 64 + fr, col0 = u.pn * BM + wc * 32 + 4 * fq;
#pragma unroll
        for (int ai = 0; ai < 2; ++ai)
#pragma unroll
            for (int m = 0; m < 4; ++m) { float* rowp = C + (size_t)(row0 + ai * HALF + m * 16) * ldc + col0;
#pragma unroll
                for (int bj = 0; bj < 2; ++bj)
#pragma unroll
                    for (int n = 0; n < 2; ++n) *(f32x4*)(rowp + bj * HALF + n * 16) = acc[ai][bj][m][n]; }
    }
};
struct EpiBf16 {
    static constexpr bool PERM = true;
    bf16_t* O; int ldc;
    __device__ __forceinline__ void operator()(const Acc& acc, const Unit& u, int wr, int wc, int fr, int fq) const {
        const int row0 = u.pm * BM + wr * 64 + fr, col0 = u.pn * BM + wc * 32 + 8 * fq;
#pragma unroll
        for (int ai = 0; ai < 2; ++ai)
#pragma unroll
            for (int m = 0; m < 4; ++m) { bf16_t* rowp = O + (size_t)(row0 + ai * HALF + m * 16) * ldc + col0;
#pragma unroll
                for (int bj = 0; bj < 2; ++bj) { const f32x4 v0 = acc[ai][bj][m][0], v1 = acc[ai][bj][m][1];
                    u32x4 w; w.x = cvt_pk_bf16(v0[0], v0[1]); w.y = cvt_pk_bf16(v0[2], v0[3]); w.z = cvt_pk_bf16(v1[0], v1[1]); w.w = cvt_pk_bf16(v1[2], v1[3]);
                    *(u32x4*)(rowp + bj * HALF) = w; } }
    }
};
struct EpiSwiGLU {
    static constexpr bool PERM = true;
    bf16_t* H;
    __device__ __forceinline__ void operator()(const Acc& acc, const Unit& u, int wr, int wc, int fr, int fq) const {
        const int row0 = u.pm * BM + wr * 64 + fr, col0 = u.pn * HALF + wc * 32 + 8 * fq;
#pragma unroll
        for (int ai = 0; ai < 2; ++ai)
#pragma unroll
            for (int m = 0; m < 4; ++m) { bf16_t* rowp = H + (size_t)(row0 + ai * HALF + m * 16) * DFF + col0;
                float h[8];
#pragma unroll
                for (int n = 0; n < 2; ++n)
#pragma unroll
                    for (int j = 0; j < 4; ++j) { const float gt = acc[ai][0][m][n][j], up = acc[ai][1][m][n][j]; h[n * 4 + j] = gt * sigmoidf_fast(gt) * up; }
                u32x4 w; w.x = cvt_pk_bf16(h[0], h[1]); w.y = cvt_pk_bf16(h[2], h[3]); w.z = cvt_pk_bf16(h[4], h[5]); w.w = cvt_pk_bf16(h[6], h[7]);
                *(u32x4*)rowp = w; }
    }
};
struct EpiGate {
    static constexpr bool PERM = true;
    bf16_t* G;
    __device__ __forceinline__ void operator()(const Acc& acc, const Unit& u, int wr, int wc, int fr, int fq) const {
        const int row0 = u.pm * BM + wr * 64 + fr, col0 = u.pn * BM + wc * 32 + 8 * fq;
#pragma unroll
        for (int ai = 0; ai < 2; ++ai)
#pragma unroll
            for (int m = 0; m < 4; ++m) { bf16_t* rowp = G + (size_t)(row0 + ai * HALF + m * 16) * 2048 + col0;
#pragma unroll
                for (int bj = 0; bj < 2; ++bj) { const f32x4 v0 = acc[ai][bj][m][0], v1 = acc[ai][bj][m][1];
                    u32x4 w; w.x = cvt_pk_bf16(sigmoidf_fast(v0[0]), sigmoidf_fast(v0[1])); w.y = cvt_pk_bf16(sigmoidf_fast(v0[2]), sigmoidf_fast(v0[3]));
                    w.z = cvt_pk_bf16(sigmoidf_fast(v1[0]), sigmoidf_fast(v1[1])); w.w = cvt_pk_bf16(sigmoidf_fast(v1[2]), sigmoidf_fast(v1[3]));
                    *(u32x4*)(rowp + bj * HALF) = w; } }
    }
};
struct EpiQ {
    static constexpr bool PERM = true;
    bf16_t* Q; const float* TAB;
    __device__ __forceinline__ void operator()(const Acc& acc, const Unit& u, int wr, int wc, int fr, int fq) const {
        const int row0 = u.pm * BM + wr * 64 + fr, col0 = u.pn * BM + wc * 32 + 8 * fq;
#pragma unroll
        for (int ai = 0; ai < 2; ++ai)
#pragma unroll
            for (int m = 0; m < 4; ++m) { const int row = row0 + ai * HALF + m * 16; bf16_t* rowp = Q + (size_t)row * 1536 + col0;
#pragma unroll
                for (int bj = 0; bj < 2; ++bj) { f32x4 v0 = acc[ai][bj][m][0], v1 = acc[ai][bj][m][1];
                    const int c = col0 + bj * HALF, w = c % 192;
                    if (w >= 128) { const int i0 = (w - 128) >> 1; const f32x4 cs = *(const f32x4*)(TAB + (size_t)row * 64 + i0), sn = *(const f32x4*)(TAB + (size_t)row * 64 + 32 + i0);
                        f32x4 r0, r1;
                        r0[0] = v0[0] * cs[0] - v0[1] * sn[0]; r0[1] = v0[1] * cs[0] + v0[0] * sn[0];
                        r0[2] = v0[2] * cs[1] - v0[3] * sn[1]; r0[3] = v0[3] * cs[1] + v0[2] * sn[1];
                        r1[0] = v1[0] * cs[2] - v1[1] * sn[2]; r1[1] = v1[1] * cs[2] + v1[0] * sn[2];
                        r1[2] = v1[2] * cs[3] - v1[3] * sn[3]; r1[3] = v1[3] * cs[3] + v1[2] * sn[3];
                        v0 = r0; v1 = r1; }
                    u32x4 wv; wv.x = cvt_pk_bf16(v0[0], v0[1]); wv.y = cvt_pk_bf16(v0[2], v0[3]); wv.z = cvt_pk_bf16(v1[0], v1[1]); wv.w = cvt_pk_bf16(v1[2], v1[3]);
                    *(u32x4*)(rowp + bj * HALF) = wv; } }
    }
};
struct EpiT1 {
    static constexpr bool PERM = true;
    const bf16_t* G; float* F;
    __device__ __forceinline__ void operator()(const Acc& acc, const Unit& u, int wr, int wc, int fr, int fq) const {
        const int row0 = u.pm * BM + wr * 64 + fr, col0 = u.pn * BM + wc * 32 + 8 * fq;
#pragma unroll
        for (int ai = 0; ai < 2; ++ai)
#pragma unroll
            for (int m = 0; m < 4; ++m) { const int row = row0 + ai * HALF + m * 16;
#pragma unroll
                for (int bj = 0; bj < 2; ++bj) { const f32x4 v0 = acc[ai][bj][m][0], v1 = acc[ai][bj][m][1]; const int c = col0 + bj * HALF;
                    const u32x4 gw = *(const u32x4*)(G + (size_t)row * 2048 + c);
                    f32x4 o0, o1;
                    o0[0] = v0[0] * bf_lo(gw.x); o0[1] = v0[1] * bf_hi(gw.x); o0[2] = v0[2] * bf_lo(gw.y); o0[3] = v0[3] * bf_hi(gw.y);
                    o1[0] = v1[0] * bf_lo(gw.z); o1[1] = v1[1] * bf_hi(gw.z); o1[2] = v1[2] * bf_lo(gw.w); o1[3] = v1[3] * bf_hi(gw.w);
                    float* fp = F + (size_t)row * 1024 + c; *(f32x4*)fp = o0; *(f32x4*)(fp + 4) = o1; } }
    }
};
struct EpiMX {
    static constexpr bool PERM = true;
    const bf16_t* G; const float* F; bf16_t* MX;
    __device__ __forceinline__ void operator()(const Acc& acc, const Unit& u, int wr, int wc, int fr, int fq) const {
        const int row0 = u.pm * BM + wr * 64 + fr, col0 = u.pn * BM + wc * 32 + 8 * fq;
#pragma unroll
        for (int ai = 0; ai < 2; ++ai)
#pragma unroll
            for (int m = 0; m < 4; ++m) { const int row = row0 + ai * HALF + m * 16;
#pragma unroll
                for (int bj = 0; bj < 2; ++bj) { const f32x4 v0 = acc[ai][bj][m][0], v1 = acc[ai][bj][m][1]; const int c = col0 + bj * HALF;
                    const u32x4 gw = *(const u32x4*)(G + (size_t)row * 2048 + 1024 + c);
                    const float* fp = F + (size_t)row * 1024 + c; const f32x4 t0 = *(const f32x4*)fp, t1 = *(const f32x4*)(fp + 4);
                    u32x4 wv;
                    wv.x = cvt_pk_bf16(t0[0] + v0[0] * bf_lo(gw.x), t0[1] + v0[1] * bf_hi(gw.x)); wv.y = cvt_pk_bf16(t0[2] + v0[2] * bf_lo(gw.y), t0[3] + v0[3] * bf_hi(gw.y));
                    wv.z = cvt_pk_bf16(t1[0] + v1[0] * bf_lo(gw.z), t1[1] + v1[1] * bf_hi(gw.z)); wv.w = cvt_pk_bf16(t1[2] + v1[2] * bf_lo(gw.w), t1[3] + v1[3] * bf_hi(gw.w));
                    *(u32x4*)(MX + (size_t)row * 1024 + c) = wv; } }
    }
};
}

namespace att {
constexpr int NW = 8, QBLK = 32, KVBLK = 64;
constexpr float SCALE = 0.07216878364870322f;
constexpr float THR = 8.f;
constexpr int LDQ = 1536, LDKV = 2048, LDKR = 64, LDO = 1024;
constexpr int SHM_V = 64 * 128 * 2, SHM_K = 64 * 128 * 2, SHM_R = 64 * 64 * 2;
constexpr int NQL = 4;
constexpr int OFF_V = 0, OFF_K = 2 * SHM_V, OFF_RP = OFF_K + 2 * SHM_K, OFF_WS = OFF_RP + 2 * SHM_R, OFF_QL = OFF_WS + NW * 64 * 4, SHM_ATTN = OFF_QL + NW * NQL * 1024;
static_assert(SHM_ATTN <= LDS_BYTES, "lds");
#define KSWZ(row, colB) ((row) * 256 + ((colB) ^ (((row) & 7) << 4)))
#define RSWZ(row, colB) ((row) * 128 + ((colB) ^ (((row) & 7) << 4)))
#define SBAR() __builtin_amdgcn_sched_barrier(0)
__device__ __forceinline__ int crow(int r, int hi) { return (r & 3) + 8 * (r >> 2) + 4 * hi; }
__device__ __forceinline__ bf16x8 ld8(const bf16_t* p) { return *reinterpret_cast<const bf16x8*>(p); }

__device__ __forceinline__ void partialSM(f32x16& p0, f32x16& p1, float& m_reg, float& mn, float& alpha) {
    constexpr float C = SCALE * 1.4426950408889634f;
    float pmax = p0[0];
#pragma unroll
    for (int r = 1; r < 16; ++r) pmax = fmaxf(pmax, p0[r]);
#pragma unroll
    for (int r = 0; r < 16; ++r) pmax = fmaxf(pmax, p1[r]);
    { auto rr = __builtin_amdgcn_permlane32_swap(__float_as_uint(pmax), __float_as_uint(pmax), false, false);
      pmax = fmaxf(__uint_as_float(rr[0]), __uint_as_float(rr[1])); }
    if (__builtin_expect(__all(pmax - m_reg <= THR / SCALE), 1)) { mn = m_reg; alpha = 1.f; }
    else { mn = fmaxf(m_reg, pmax); alpha = __builtin_amdgcn_exp2f((m_reg - mn) * C); m_reg = mn; }
    float mnC = -mn * C;
#pragma unroll
    for (int r = 0; r < 16; ++r) p0[r] = fmaf(p0[r], C, mnC);
#pragma unroll
    for (int r = 0; r < 16; ++r) p1[r] = fmaf(p1[r], C, mnC);
#pragma unroll
    for (int r = 0; r < 16; ++r) p0[r] = __builtin_amdgcn_exp2f(p0[r]);
}
__device__ __forceinline__ void finishSM(f32x16& p0, f32x16& p1, float alpha, float& l_reg, bf16x8& pa0, bf16x8& pa1, bf16x8& pa2, bf16x8& pa3) {
#pragma unroll
    for (int r = 0; r < 16; ++r) p1[r] = __builtin_amdgcn_exp2f(p1[r]);
    float ps = 0;
#pragma unroll
    for (int r = 0; r < 16; ++r) ps += p0[r];
#pragma unroll
    for (int r = 0; r < 16; ++r) ps += p1[r];
    { auto rr = __builtin_amdgcn_permlane32_swap(__float_as_uint(ps), __float_as_uint(ps), false, false);
      ps = __uint_as_float(rr[0]) + __uint_as_float(rr[1]); }
    l_reg = l_reg * alpha + ps;
#define PK4(P, BASE, OUT) do { unsigned a0 = cvt_pk_bf16(P[BASE + 0], P[BASE + 1]), a1 = cvt_pk_bf16(P[BASE + 2], P[BASE + 3]);   \
    unsigned b0 = cvt_pk_bf16(P[BASE + 4], P[BASE + 5]), b1 = cvt_pk_bf16(P[BASE + 6], P[BASE + 7]);                              \
    auto r0 = __builtin_amdgcn_permlane32_swap(a0, b0, false, false); auto r1 = __builtin_amdgcn_permlane32_swap(a1, b1, false, false); \
    u32x4 w = {r0[0], r1[0], r0[1], r1[1]}; OUT = *reinterpret_cast<bf16x8*>(&w); } while (0)
    PK4(p0, 0, pa0); PK4(p0, 8, pa1); PK4(p1, 0, pa2); PK4(p1, 8, pa3);
#undef PK4
}
__device__ __forceinline__ void qkt(f32x16& p0, f32x16& p1, const char* Ks, const char* Rs, const bf16x8* qr, const char* ql, int r32, int hi) {
    p0 = f32x16{}; p1 = f32x16{};
#pragma unroll
    for (int d0 = 0; d0 < 8; ++d0) { int cb = (d0 * 16 + hi * 8) * 2;
        bf16x8 b0 = *reinterpret_cast<const bf16x8*>(Ks + KSWZ(r32, cb));
        bf16x8 b1 = *reinterpret_cast<const bf16x8*>(Ks + KSWZ(32 + r32, cb));
        p0 = __builtin_amdgcn_mfma_f32_32x32x16_bf16(b0, qr[d0], p0, 0, 0, 0);
        p1 = __builtin_amdgcn_mfma_f32_32x32x16_bf16(b1, qr[d0], p1, 0, 0, 0); }
#pragma unroll
    for (int d0 = 0; d0 < 4; ++d0) { int cb = (d0 * 16 + hi * 8) * 2;
        bf16x8 b0 = *reinterpret_cast<const bf16x8*>(Rs + RSWZ(r32, cb));
        bf16x8 b1 = *reinterpret_cast<const bf16x8*>(Rs + RSWZ(32 + r32, cb));
        const bf16x8 qv = *reinterpret_cast<const bf16x8*>(ql + d0 * 1024);
        p0 = __builtin_amdgcn_mfma_f32_32x32x16_bf16(b0, qv, p0, 0, 0, 0);
        p1 = __builtin_amdgcn_mfma_f32_32x32x16_bf16(b1, qv, p1, 0, 0, 0); }
}
__device__ __forceinline__ int v_st(int k, int c) { const int kk = (k & ~0xC) | ((k & 4) << 1) | ((k & 8) >> 1); return ((kk >> 3) * 4 + (c >> 5)) * 512 + ((kk & 7) * 32 + (c & 31)) * 2; }
__device__ __forceinline__ int v_rd_base(int lane) { return ((lane & 3) << 3) | (((lane >> 2) & 3) << 6) | (((lane >> 4) & 1) << 5) | (((lane >> 5) & 1) << 8); }
constexpr int v_rd_off(int d0, int ks, int half) { return d0 * 512 + ks * 4096 + half * 2048; }
template <int OFF> __device__ __forceinline__ s16x4 tr_read(int vb) {
    s16x4 r; asm volatile("ds_read_b64_tr_b16 %0, %1 offset:%2" : "=&v"(r) : "v"(vb), "i"(OFF) : "memory"); return r;
}
template <int D0> __device__ __forceinline__ void pv_one(f32x16& od, int vb, bf16x8 pa0, bf16x8 pa1, bf16x8 pa2, bf16x8 pa3) {
    const s16x4 l0 = tr_read<v_rd_off(D0, 0, 0)>(vb), h0 = tr_read<v_rd_off(D0, 0, 1)>(vb), l1 = tr_read<v_rd_off(D0, 1, 0)>(vb), h1 = tr_read<v_rd_off(D0, 1, 1)>(vb);
    const s16x4 l2 = tr_read<v_rd_off(D0, 2, 0)>(vb), h2 = tr_read<v_rd_off(D0, 2, 1)>(vb), l3 = tr_read<v_rd_off(D0, 3, 0)>(vb), h3 = tr_read<v_rd_off(D0, 3, 1)>(vb);
    asm volatile("s_waitcnt lgkmcnt(0)" ::: "memory"); SBAR();
#define PK(L, H) (bf16x8){L[0], L[1], L[2], L[3], H[0], H[1], H[2], H[3]}
    od = __builtin_amdgcn_mfma_f32_32x32x16_bf16(pa0, PK(l0, h0), od, 0, 0, 0);
    od = __builtin_amdgcn_mfma_f32_32x32x16_bf16(pa1, PK(l1, h1), od, 0, 0, 0);
    od = __builtin_amdgcn_mfma_f32_32x32x16_bf16(pa2, PK(l2, h2), od, 0, 0, 0);
    od = __builtin_amdgcn_mfma_f32_32x32x16_bf16(pa3, PK(l3, h3), od, 0, 0, 0);
#undef PK
}
__device__ __forceinline__ void pv_d0(f32x16* o, int vb, bf16x8 pa0, bf16x8 pa1, bf16x8 pa2, bf16x8 pa3) {
    pv_one<0>(o[0], vb, pa0, pa1, pa2, pa3); pv_one<1>(o[1], vb, pa0, pa1, pa2, pa3); pv_one<2>(o[2], vb, pa0, pa1, pa2, pa3); pv_one<3>(o[3], vb, pa0, pa1, pa2, pa3);
}

__device__ __forceinline__ void attn_body(const bf16_t* __restrict__ Qb, const bf16_t* __restrict__ Kn, const bf16_t* __restrict__ Kr, const bf16_t* __restrict__ Vh,
                                          bf16_t* __restrict__ Ob, int seq, char* lds) {
    const int tid = fresh_tid(), wid = tid >> 6, lane = tid & 63, r32 = lane & 31, hi = lane >> 5;
    char* V_lds = lds + OFF_V; char* K_lds = lds + OFF_K; char* R_lds = lds + OFF_RP;
    float* ws = (float*)(lds + OFF_WS) + wid * 64; float* li_l = ws; float* al_l = ws + 32;
    float m_reg = -1e30f, l_reg = 0; f32x16 o[4] = {}; bf16x8 qr[8];
    char* ql = lds + OFF_QL + wid * (NQL * 1024) + lane * 16;
    const bf16_t* Qw = Qb + (long)(wid * QBLK + r32) * LDQ + hi * 8;
#pragma unroll
    for (int d0 = 0; d0 < 8; ++d0) qr[d0] = ld8(Qw + d0 * 16);
#pragma unroll
    for (int d0 = 0; d0 < NQL; ++d0) *reinterpret_cast<bf16x8*>(ql + d0 * 1024) = ld8(Qw + (8 + d0) * 16);
    const int sr = tid >> 4, sc = (tid & 15) * 8, vst0 = v_st(sr, sc), vst1 = v_st(32 + sr, sc);
    const int rr_ = tid >> 3, rc_ = (tid & 7) * 8;
    const int vb0 = (int)(uintptr_t)V_lds + v_rd_base(lane);
    bf16x8 vs0, vs1, ks0, ks1, rs0;
#define SLOAD(k0) do { vs0 = ld8(&Vh[(long)((k0) + sr) * LDKV + sc]); vs1 = ld8(&Vh[(long)((k0) + 32 + sr) * LDKV + sc]); \
    ks0 = ld8(&Kn[(long)((k0) + sr) * LDKV + sc]); ks1 = ld8(&Kn[(long)((k0) + 32 + sr) * LDKV + sc]); rs0 = ld8(&Kr[(long)((k0) + rr_) * LDKR + rc_]); } while (0)
#define SWRITE(b) do { *(bf16x8*)(V_lds + (b) * SHM_V + vst0) = vs0; *(bf16x8*)(V_lds + (b) * SHM_V + vst1) = vs1; int kc = sc * 2; \
    *(bf16x8*)(K_lds + (b) * SHM_K + KSWZ(sr, kc)) = ks0; *(bf16x8*)(K_lds + (b) * SHM_K + KSWZ(32 + sr, kc)) = ks1; \
    *(bf16x8*)(R_lds + (b) * SHM_R + RSWZ(rr_, rc_ * 2)) = rs0; } while (0)
#define RESC(a) do { if (__any((a) < 1.f)) { if (hi == 0) al_l[r32] = (a); asm volatile("s_waitcnt lgkmcnt(0)" ::: "memory"); \
    _Pragma("unroll") for (int d = 0; d < 4; ++d) _Pragma("unroll") for (int r = 0; r < 16; ++r) o[d][r] *= al_l[crow(r, hi)]; } } while (0)
    f32x16 pA0, pA1, pB0, pB1; float mnA, mnB, alA, alB; bf16x8 pa0, pa1, pa2, pa3; const int NT = seq / KVBLK;
    SLOAD(0); asm volatile("s_waitcnt vmcnt(0)" ::: "memory"); SWRITE(0); __syncthreads();
    qkt(pA0, pA1, K_lds, R_lds, qr, ql, r32, hi); partialSM(pA0, pA1, m_reg, mnA, alA);
    SLOAD(KVBLK);
    asm volatile("s_waitcnt vmcnt(0)" ::: "memory"); SWRITE(1); __syncthreads();
    for (int j = 1; j + 1 < NT; j += 2) {
        SBAR(); qkt(pB0, pB1, K_lds + SHM_K, R_lds + SHM_R, qr, ql, r32, hi);
        finishSM(pA0, pA1, alA, l_reg, pa0, pa1, pa2, pa3); SBAR();
        SLOAD((j + 1) * KVBLK); SBAR();
        pv_d0(o, vb0, pa0, pa1, pa2, pa3); partialSM(pB0, pB1, m_reg, mnB, alB);
        __syncthreads(); asm volatile("s_waitcnt vmcnt(0)" ::: "memory"); SWRITE(0);
        RESC(alB); __syncthreads();
        SBAR(); qkt(pA0, pA1, K_lds, R_lds, qr, ql, r32, hi);
        finishSM(pB0, pB1, alB, l_reg, pa0, pa1, pa2, pa3); SBAR();
        SLOAD((j + 2) * KVBLK); SBAR();
        pv_d0(o, vb0 + SHM_V, pa0, pa1, pa2, pa3); partialSM(pA0, pA1, m_reg, mnA, alA);
        __syncthreads(); asm volatile("s_waitcnt vmcnt(0)" ::: "memory"); SWRITE(1);
        RESC(alA); __syncthreads();
    }
    SBAR(); qkt(pB0, pB1, K_lds + SHM_K, R_lds + SHM_R, qr, ql, r32, hi);
    finishSM(pA0, pA1, alA, l_reg, pa0, pa1, pa2, pa3); SBAR();
    pv_d0(o, vb0, pa0, pa1, pa2, pa3); partialSM(pB0, pB1, m_reg, mnB, alB);
    __syncthreads(); RESC(alB);
    finishSM(pB0, pB1, alB, l_reg, pa0, pa1, pa2, pa3); SBAR();
    pv_d0(o, vb0 + SHM_V, pa0, pa1, pa2, pa3);
    if (hi == 0) li_l[r32] = l_reg; asm volatile("s_waitcnt lgkmcnt(0)" ::: "memory");
    float rli[16];
#pragma unroll
    for (int r = 0; r < 16; ++r) rli[r] = __builtin_amdgcn_rcpf(li_l[crow(r, hi)]);
    bf16_t* Ow = Ob + (long)(wid * QBLK) * LDO;
#pragma unroll
    for (int r = 0; r < 16; ++r) { int orow = crow(r, hi);
#pragma unroll
        for (int d0 = 0; d0 < 4; ++d0) { const float v = o[d0][r] * rli[r]; Ow[(long)orow * LDO + d0 * 32 + r32] = (bf16_t)(cvt_pk_bf16(v, v) & 0xffffu); } }
#undef SLOAD
#undef SWRITE
#undef RESC
}
}

enum { TR_PLAIN = 0, TR_GU = 1, TR_WIN = 2, TR_UQ = 3, TR_UKV = 4 };
template <int MODE>
__device__ __forceinline__ void tr_job(const float* W0, const float* W1, int K, int Nsrc, int Nout, bf16_t* WT, LAS float* scr, int lane, int gw, int NGW) {
    const int nblk = Nout / 32, nitems = (K / 64) * nblk;
    for (int it = gw; it < nitems; it += NGW) {
        const int kb = it / nblk, nb = it % nblk, k0 = 64 * kb, n0 = 32 * nb, np = n0 + (lane & 31);
        const float* colp;
        if (MODE == TR_PLAIN) colp = W0 + np;
        else if (MODE == TR_GU) { const int t = np >> 8, w = np & 255; colp = (w < 128 ? W0 : W1) + t * 128 + (w & 127); }
        else if (MODE == TR_WIN) colp = np < 1216 ? W0 + np : (np < 1280 ? nullptr : W0 + (np - 64));
        else if (MODE == TR_UQ) { const int h = np / 192, w = np % 192; colp = W0 + (w < 128 ? np : h * 192 + 128 + ((w - 128) >> 1) + ((w - 128) & 1) * 32); }
        else colp = np < 1024 ? W0 + np : W1 + (np - 1024);
#pragma unroll 8
        for (int i = 0; i < 32; ++i) { const int kk = 2 * i + (lane >> 5); scr[kk * 33 + (lane & 31)] = colp ? colp[(size_t)(k0 + kk) * Nsrc] : 0.f; }
        asm volatile("s_waitcnt lgkmcnt(0)" ::: "memory");
        const int c = lane & 7;
#pragma unroll
        for (int j = 0; j < 4; ++j) { const int n = (lane >> 3) + 8 * j; const LAS float* s = scr + (8 * c) * 33 + n;
            u32x4 o; o.x = cvt_pk_bf16(s[0 * 33], s[1 * 33]); o.y = cvt_pk_bf16(s[2 * 33], s[3 * 33]); o.z = cvt_pk_bf16(s[4 * 33], s[5 * 33]); o.w = cvt_pk_bf16(s[6 * 33], s[7 * 33]);
            *(u32x4*)(WT + (size_t)(n0 + n) * K + k0 + 8 * c) = o; }
        asm volatile("s_waitcnt lgkmcnt(0)" ::: "memory");
    }
}

template <int MODE>
__device__ __forceinline__ void rows_phase(const float* xin, const float* f, float wt, const float* gpost, const float* gnext, float* xout, bf16_t* xn, int gw, int NGW, int lane) {
    for (int row = gw; row < M; row += NGW) {
        f32x4 xv[4];
#pragma unroll
        for (int j = 0; j < 4; ++j) xv[j] = *(const f32x4*)(xin + (size_t)row * DM + 4 * (lane + 64 * j));
        if (MODE != 0) {
            f32x4 fv[4]; float ss = 0.f;
#pragma unroll
            for (int j = 0; j < 4; ++j) { fv[j] = *(const f32x4*)(f + (size_t)row * DM + 4 * (lane + 64 * j)); ss += fv[j].x * fv[j].x + fv[j].y * fv[j].y + fv[j].z * fv[j].z + fv[j].w * fv[j].w; }
            const float r = wt * __builtin_amdgcn_rsqf(wave_sum(ss) * (1.f / DM) + EPS);
#pragma unroll
            for (int j = 0; j < 4; ++j) { const f32x4 g = *(const f32x4*)(gpost + 4 * (lane + 64 * j)); xv[j] = xv[j] + fv[j] * g * r; }
            if (MODE == 1) {
#pragma unroll
                for (int j = 0; j < 4; ++j) *(f32x4*)(xout + (size_t)row * DM + 4 * (lane + 64 * j)) = xv[j];
            }
        }
        float s2 = 0.f;
#pragma unroll
        for (int j = 0; j < 4; ++j) s2 += xv[j].x * xv[j].x + xv[j].y * xv[j].y + xv[j].z * xv[j].z + xv[j].w * xv[j].w;
        const float r2 = __builtin_amdgcn_rsqf(wave_sum(s2) * (1.f / DM) + EPS);
#pragma unroll
        for (int j = 0; j < 4; ++j) { const f32x4 g = *(const f32x4*)(gnext + 4 * (lane + 64 * j)); const f32x4 y = xv[j] * g * r2;
            if (MODE == 2) *(f32x4*)(xout + (size_t)row * DM + 4 * (lane + 64 * j)) = y;
            else { u32x2 w; w.x = cvt_pk_bf16(y.x, y.y); w.y = cvt_pk_bf16(y.z, y.w); *(u32x2*)(xn + (size_t)row * DM + 4 * (lane + 64 * j)) = w; } }
    }
}

__global__ void __launch_bounds__(NTHREADS, 2) fwd_megakernel(Params p) {
    extern __shared__ __attribute__((aligned(16))) unsigned char lds[];
    cg::grid_group grid = cg::this_grid();
#define GRID_SYNC() do { __builtin_amdgcn_fence(__ATOMIC_RELEASE, "agent"); asm volatile("s_waitcnt vmcnt(0)" ::: "memory"); grid.sync(); \
        __builtin_amdgcn_fence(__ATOMIC_ACQUIRE, "agent"); asm volatile("s_waitcnt vmcnt(0)" ::: "memory"); } while (0)
    const int G = gridDim.x, bid = blockIdx.x, NGW = G * NWAVES;
    LAS unsigned char* ldsl = (LAS unsigned char*)lds;
#define PHASE_IDS() const int tid = fresh_tid(), lane = tid & 63, wave = tid >> 6, gw = bid * NWAVES + wave; LAS float* scr = (LAS float*)(ldsl + wave * 8448); (void)scr; (void)gw; (void)lane
    unsigned char* ws = p.ws;
    bf16_t* Wgu = (bf16_t*)(ws + OFF_WGU); bf16_t* Wd = (bf16_t*)(ws + OFF_WD); bf16_t* Win = (bf16_t*)(ws + OFF_WIN); bf16_t* Wuq = (bf16_t*)(ws + OFF_WUQ);
    bf16_t* Wukv = (bf16_t*)(ws + OFF_WUKV); bf16_t* Woa = (bf16_t*)(ws + OFF_WOA); bf16_t* Wp = (bf16_t*)(ws + OFF_WP); bf16_t* Wout = (bf16_t*)(ws + OFF_WOUT);
    bf16_t* XN = (bf16_t*)(ws + OFF_XN); float* F = (float*)(ws + OFF_F); float* ZF = (float*)(ws + OFF_ZF); bf16_t* KV = (bf16_t*)(ws + OFF_KV);
    bf16_t* H = (bf16_t*)(ws + OFF_H); bf16_t* O = (bf16_t*)(ws + OFF_O); bf16_t* CQN = (bf16_t*)(ws + OFF_CQN); bf16_t* CKVN = (bf16_t*)(ws + OFF_CKVN);
    float* TAB = (float*)(ws + OFF_TAB); bf16_t* Q = (bf16_t*)(ws + OFF_Q); bf16_t* KR = (bf16_t*)(ws + OFF_KR); bf16_t* Gt = (bf16_t*)(ws + OFF_G); bf16_t* DP = (bf16_t*)(ws + OFF_DP);
    float* X = p.out;

    { PHASE_IDS();
    tr_job<TR_GU>(p.f1_wg, p.f1_wu, 1024, DFF, 5632, Wgu, scr, lane, gw, NGW);
    tr_job<TR_PLAIN>(p.f1_wd, nullptr, DFF, 1024, 1024, Wd, scr, lane, gw, NGW);
    tr_job<TR_WIN>(p.w_in, nullptr, 1024, INW, 3328, Win, scr, lane, gw, NGW);
    tr_job<TR_UQ>(p.w_uq, nullptr, QL, 1536, 1536, Wuq, scr, lane, gw, NGW);
    tr_job<TR_UKV>(p.w_uk, p.w_uv, KVL, 1024, 2048, Wukv, scr, lane, gw, NGW);
    tr_job<TR_PLAIN>(p.w_oa, nullptr, 1024, 1024, 1024, Woa, scr, lane, gw, NGW);
    tr_job<TR_PLAIN>(p.w_out, nullptr, 1024, 1024, 1024, Wout, scr, lane, gw, NGW);
    for (int idx = bid * NTHREADS + tid; idx < 65536; idx += G * NTHREADS) {
        const int n = idx & 1023, c8 = idx >> 10, g = c8 >> 4, cb = (c8 & 15) * 8;
        float a[8];
#pragma unroll
        for (int i = 0; i < 8; ++i) a[i] = 0.f;
        for (int j = 0; j < 128; ++j) { const float w = p.w_op[(size_t)(g * 128 + j) * 1024 + n] * p.pool_scale[g * 128 + j];
#pragma unroll
            for (int i = 0; i < 8; ++i) a[i] = fmaf(p.pool_w[(size_t)(g * 128 + cb + i) * 128 + j], w, a[i]); }
        u32x4 o; o.x = cvt_pk_bf16(a[0], a[1]); o.y = cvt_pk_bf16(a[2], a[3]); o.z = cvt_pk_bf16(a[4], a[5]); o.w = cvt_pk_bf16(a[6], a[7]);
        *(u32x4*)(Wp + (size_t)n * 512 + c8 * 8) = o;
    }
    rows_phase<0>(p.x, nullptr, 0.f, nullptr, p.f1_pre, nullptr, XN, gw, NGW, lane); }
    GRID_SYNC();

    pg8::StaticOrder S;
    { pg8::Gemm g{XN, Wgu, M, 5632, 1024}; S.init(M, 5632, G, bid); pg8::EpiSwiGLU E{H}; pg8::gemm_phase(ldsl, g, S, E); }
    GRID_SYNC();
    { pg8::Gemm g{H, Wd, M, 1024, DFF}; S.init(M, 1024, G, bid); pg8::EpiF32 E{F, 1024}; pg8::gemm_phase(ldsl, g, S, E); }
    GRID_SYNC();
    { PHASE_IDS(); rows_phase<1>(p.x, F, 0.5f, p.f1_post, p.mix_pre, X, XN, gw, NGW, lane); }
    GRID_SYNC();
    { pg8::Gemm g{XN, Win, M, 1280, 1024}; S.init(M, 1280, G, bid); pg8::EpiF32 E{ZF, 1280}; pg8::gemm_phase(ldsl, g, S, E); }
    GRID_SYNC();
    { PHASE_IDS();
    for (int row = gw; row < M; row += NGW) {
        const float* z = ZF + (size_t)row * 1280;
        {
            f32x4 a = *(const f32x4*)(z + 4 * lane), b = (f32x4){0.f, 0.f, 0.f, 0.f};
            if (lane < 32) b = *(const f32x4*)(z + 4 * (lane + 64));
            float ss = a.x * a.x + a.y * a.y + a.z * a.z + a.w * a.w + b.x * b.x + b.y * b.y + b.z * b.z + b.w * b.w;
            const float r = __builtin_amdgcn_rsqf(wave_sum(ss) * (1.f / QL) + EPS);
            { const f32x4 g = *(const f32x4*)(p.qa_g + 4 * lane); const f32x4 y = a * g * r; u32x2 w; w.x = cvt_pk_bf16(y.x, y.y); w.y = cvt_pk_bf16(y.z, y.w); *(u32x2*)(CQN + (size_t)row * QL + 4 * lane) = w; }
            if (lane < 32) { const f32x4 g = *(const f32x4*)(p.qa_g + 4 * (lane + 64)); const f32x4 y = b * g * r; u32x2 w; w.x = cvt_pk_bf16(y.x, y.y); w.y = cvt_pk_bf16(y.z, y.w); *(u32x2*)(CQN + (size_t)row * QL + 4 * (lane + 64)) = w; }
        }
        {
            const f32x4 a = *(const f32x4*)(z + 384 + 4 * lane);
            const float ss = a.x * a.x + a.y * a.y + a.z * a.z + a.w * a.w;
            const float r = __builtin_amdgcn_rsqf(wave_sum(ss) * (1.f / KVL) + EPS);
            const f32x4 g = *(const f32x4*)(p.kva_g + 4 * lane); const f32x4 y = a * g * r; u32x2 w; w.x = cvt_pk_bf16(y.x, y.y); w.y = cvt_pk_bf16(y.z, y.w); *(u32x2*)(CKVN + (size_t)row * KVL + 4 * lane) = w;
        }
        if (lane < 32) {
            const float x1 = z[640 + lane], x2 = z[672 + lane];
            const float ang = (float)p.pos[row] * p.inv_freq[lane];
            const double ad = (double)ang; const double kq = rint(ad * 0.15915494309189535); const float red = (float)(ad - kq * 6.283185307179586);
            const float cs = __cosf(red), sn = __sinf(red);
            TAB[(size_t)row * 64 + lane] = cs; TAB[(size_t)row * 64 + 32 + lane] = sn;
            *(unsigned*)(KR + (size_t)row * 64 + 2 * lane) = cvt_pk_bf16(x1 * cs - x2 * sn, x2 * cs + x1 * sn);
        }
        {
            const int t = row & (SEQ - 1), g = lane >> 4, wnd = 2 << g, lo = max(t - (wnd >> 1), 0), hi = min(t + wnd - (wnd >> 1), SEQ);
            const float* zp = z + 704 + 8 * lane;
            f32x4 s0 = (f32x4){0.f, 0.f, 0.f, 0.f}, s1 = s0;
            for (int dt = -8; dt < 8; ++dt) { const int tt = t + dt;
                if (tt >= lo && tt < hi) { const float* q = zp + (long)dt * 1280; s0 = s0 + *(const f32x4*)q; s1 = s1 + *(const f32x4*)(q + 4); } }
            const float inv = 1.f / (float)(hi - lo);
            const f32x4 c0 = *(const f32x4*)zp, c1 = *(const f32x4*)(zp + 4);
            const f32x4 d0 = s0 * inv - c0, d1 = s1 * inv - c1;
            u32x4 w; w.x = cvt_pk_bf16(d0.x, d0.y); w.y = cvt_pk_bf16(d0.z, d0.w); w.z = cvt_pk_bf16(d1.x, d1.y); w.w = cvt_pk_bf16(d1.z, d1.w);
            *(u32x4*)(DP + (size_t)row * 512 + 8 * lane) = w;
        }
    } }
    GRID_SYNC();
    { pg8::Gemm g{CQN, Wuq, M, 1536, QL}; S.init(M, 1536, G, bid); pg8::EpiQ E{Q, TAB}; pg8::gemm_phase(ldsl, g, S, E); }
    { pg8::Gemm g{CKVN, Wukv, M, 2048, KVL}; S.init(M, 2048, G, bid); pg8::EpiBf16 E{KV, 2048}; pg8::gemm_phase(ldsl, g, S, E); }
    GRID_SYNC();
    {
        const int vcu = (bid & 7) * (G >> 3) + (bid >> 3);
        for (int it = vcu; it < NB * NH * (SEQ / 256); it += G) {
            const int qb = it & 7, h = (it >> 3) & 7, b = it >> 6;
            const size_t tok0 = (size_t)b * SEQ;
            att::attn_body(Q + (tok0 + qb * 256) * 1536 + h * 192, KV + tok0 * 2048 + h * 128, KR + tok0 * 64, KV + tok0 * 2048 + 1024 + h * 128,
                           O + (tok0 + qb * 256) * 1024 + h * 128, SEQ, (char*)lds);
            __syncthreads();
        }
    }
    GRID_SYNC();
    { pg8::Gemm g{XN, Win + (size_t)1280 * 1024, M, 2048, 1024}; S.init(M, 2048, G, bid); pg8::EpiGate E{Gt}; pg8::gemm_phase(ldsl, g, S, E); }
    GRID_SYNC();
    { pg8::Gemm g{O, Woa, M, 1024, 1024}; S.init(M, 1024, G, bid); pg8::EpiT1 E{Gt, F}; pg8::gemm_phase(ldsl, g, S, E); }
    { pg8::Gemm g{DP, Wp, M, 1024, 512}; S.init(M, 1024, G, bid); pg8::EpiMX E{Gt, F, XN}; pg8::gemm_phase(ldsl, g, S, E); }
    GRID_SYNC();
    { pg8::Gemm g{XN, Wout, M, 1024, 1024}; S.init(M, 1024, G, bid); pg8::EpiF32 E{F, 1024}; pg8::gemm_phase(ldsl, g, S, E); }
    GRID_SYNC();
    { PHASE_IDS();
    tr_job<TR_GU>(p.f2_wg, p.f2_wu, 1024, DFF, 5632, Wgu, scr, lane, gw, NGW);
    tr_job<TR_PLAIN>(p.f2_wd, nullptr, DFF, 1024, 1024, Wd, scr, lane, gw, NGW);
    rows_phase<1>(X, F, 1.0f, p.mix_post, p.f2_pre, X, XN, gw, NGW, lane); }
    GRID_SYNC();
    { pg8::Gemm g{XN, Wgu, M, 5632, 1024}; S.init(M, 5632, G, bid); pg8::EpiSwiGLU E{H}; pg8::gemm_phase(ldsl, g, S, E); }
    GRID_SYNC();
    { pg8::Gemm g{H, Wd, M, 1024, DFF}; S.init(M, 1024, G, bid); pg8::EpiF32 E{F, 1024}; pg8::gemm_phase(ldsl, g, S, E); }
    GRID_SYNC();
    { PHASE_IDS(); rows_phase<2>(X, F, 0.5f, p.f2_post, p.final_g, X, nullptr, gw, NGW, lane); }
}

extern "C" void kernel_launch(void* const* d_in, const int* in_sizes, int n_in, void* d_out, int out_size, void* d_ws, size_t ws_size, hipStream_t stream) {
    static int grid_blocks = 0;
    if (grid_blocks == 0) {
        if (n_in != 26 || in_sizes[0] != M * DM || out_size != M * DM || ws_size < WS_END) { fprintf(stderr, "kernel_launch: shape mismatch n_in %d in0 %d out %d ws %zu\n", n_in, n_in > 0 ? in_sizes[0] : -1, out_size, ws_size); grid_blocks = -1; return; }
        int dev = 0, cus = 0, per_cu = 0;
        (void)hipGetDevice(&dev);
        (void)hipDeviceGetAttribute(&cus, hipDeviceAttributeMultiprocessorCount, dev);
        if (hipFuncSetAttribute((const void*)fwd_megakernel, hipFuncAttributeMaxDynamicSharedMemorySize, LDS_BYTES) != hipSuccess) { fprintf(stderr, "kernel_launch: hipFuncSetAttribute failed\n"); grid_blocks = -1; return; }
        if (hipOccupancyMaxActiveBlocksPerMultiprocessor(&per_cu, (const void*)fwd_megakernel, NTHREADS, LDS_BYTES) != hipSuccess || per_cu < 1) { fprintf(stderr, "kernel_launch: occupancy query failed (%d)\n", per_cu); (void)hipGetLastError(); per_cu = 1; }
        grid_blocks = cus * 1;
        if (grid_blocks % 8 != 0) grid_blocks -= grid_blocks % 8;
    }
    if (grid_blocks < 0) return;
    Params p{};
    p.x = (const float*)d_in[0]; p.pos = (const int*)d_in[1];
    p.f1_pre = (const float*)d_in[2]; p.f1_wg = (const float*)d_in[3]; p.f1_wu = (const float*)d_in[4]; p.f1_wd = (const float*)d_in[5]; p.f1_post = (const float*)d_in[6];
    p.mix_pre = (const float*)d_in[7]; p.w_in = (const float*)d_in[8]; p.qa_g = (const float*)d_in[9]; p.w_uq = (const float*)d_in[10]; p.kva_g = (const float*)d_in[11];
    p.w_uk = (const float*)d_in[12]; p.w_uv = (const float*)d_in[13]; p.w_oa = (const float*)d_in[14]; p.pool_w = (const float*)d_in[15]; p.pool_scale = (const float*)d_in[16];
    p.w_op = (const float*)d_in[17]; p.w_out = (const float*)d_in[18]; p.mix_post = (const float*)d_in[19];
    p.f2_pre = (const float*)d_in[20]; p.f2_wg = (const float*)d_in[21]; p.f2_wu = (const float*)d_in[22]; p.f2_wd = (const float*)d_in[23]; p.f2_post = (const float*)d_in[24]; p.final_g = (const float*)d_in[25];
    p.out = (float*)d_out; p.ws = (unsigned char*)d_ws;
    for (int i = 0; i < 32; ++i) p.inv_freq[i] = (float)pow(10000.0, -(2.0 * i) / 64.0);
    void* args[] = {&p};
    hipError_t e = hipLaunchCooperativeKernel((const void*)fwd_megakernel, dim3(grid_blocks), dim3(NTHREADS), args, LDS_BYTES, stream);
    if (e != hipSuccess) fprintf(stderr, "cooperative launch failed: %s (grid %d)\n", hipGetErrorString(e), grid_blocks);
}
```

```cpp
#include <hip/hip_runtime.h>
#include <hip/hip_cooperative_groups.h>
#include <cstdio>
#include <cmath>
#include <cstdint>
namespace cg = cooperative_groups;

#define LAS __attribute__((address_space(3)))
typedef unsigned short bf16_t;
typedef short bf16x8 __attribute__((ext_vector_type(8)));
typedef short s16x4 __attribute__((ext_vector_type(4)));
typedef float f32x2 __attribute__((ext_vector_type(2)));
typedef float f32x4 __attribute__((ext_vector_type(4)));
typedef float f32x16 __attribute__((ext_vector_type(16)));
typedef unsigned u32x4 __attribute__((ext_vector_type(4)));
typedef unsigned u32x2 __attribute__((ext_vector_type(2)));

constexpr int DM = 1024, NB = 8, SEQ = 2048, M = NB * SEQ, NH = 8, QL = 384, KVL = 256, DFF = 2816, INW = 3264;
constexpr float EPS = 1e-6f;
constexpr int NTHREADS = 512, NWAVES = 8;
constexpr int LDS_BYTES = 131072;

constexpr size_t MiB = 1048576;
constexpr size_t OFF_WGU = 0;
constexpr size_t OFF_WD = OFF_WGU + (size_t)5632 * 1024 * 2;
constexpr size_t OFF_WIN = OFF_WD + (size_t)1024 * 2816 * 2;
constexpr size_t OFF_WUQ = OFF_WIN + (size_t)3328 * 1024 * 2;
constexpr size_t OFF_WUKV = OFF_WUQ + (size_t)1536 * 384 * 2;
constexpr size_t OFF_WOA = OFF_WUKV + (size_t)2048 * 256 * 2;
constexpr size_t OFF_WP = OFF_WOA + (size_t)1024 * 1024 * 2;
constexpr size_t OFF_WOUT = OFF_WP + (size_t)1024 * 512 * 2;
constexpr size_t OFF_XN = OFF_WOUT + (size_t)1024 * 1024 * 2;
constexpr size_t OFF_R = OFF_XN + 32 * MiB;
constexpr size_t OFF_F = OFF_R;
constexpr size_t OFF_ZF = OFF_R;
constexpr size_t OFF_KV = OFF_R;
constexpr size_t OFF_H = OFF_R + 64 * MiB;
constexpr size_t OFF_O = OFF_R + 64 * MiB;
constexpr size_t OFF_CQN = OFF_R + 80 * MiB;
constexpr size_t OFF_CKVN = OFF_R + 92 * MiB;
constexpr size_t OFF_TAB = OFF_R + 100 * MiB;
constexpr size_t OFF_Q = OFF_R + 104 * MiB;
constexpr size_t OFF_KR = OFF_R + 152 * MiB;
constexpr size_t OFF_G = OFF_R + 96 * MiB;
constexpr size_t OFF_DP = OFF_R + 176 * MiB;
constexpr size_t WS_END = OFF_R + 192 * MiB;
static_assert(WS_END + 256 <= 256 * MiB, "workspace");

struct Params {
    const float* x; const int* pos;
    const float *f1_pre, *f1_wg, *f1_wu, *f1_wd, *f1_post;
    const float *mix_pre, *w_in, *qa_g, *w_uq, *kva_g, *w_uk, *w_uv, *w_oa, *pool_w, *pool_scale, *w_op, *w_out, *mix_post;
    const float *f2_pre, *f2_wg, *f2_wu, *f2_wd, *f2_post, *final_g;
    float* out; unsigned char* ws;
    float inv_freq[32];
};

typedef __bf16 bf16x2_t __attribute__((ext_vector_type(2)));
__device__ __forceinline__ unsigned cvt_pk_bf16(float lo, float hi) { const f32x2 v = {lo, hi}; const bf16x2_t r = __builtin_convertvector(v, bf16x2_t); return __builtin_bit_cast(unsigned, r); }
__device__ __forceinline__ float bf_lo(unsigned w) { return __uint_as_float(w << 16); }
__device__ __forceinline__ float bf_hi(unsigned w) { return __uint_as_float(w & 0xffff0000u); }
__device__ __forceinline__ float sigmoidf_fast(float z) { return __builtin_amdgcn_rcpf(1.f + __builtin_amdgcn_exp2f(-1.4426950408889634f * z)); }
__device__ __forceinline__ int fresh_tid() { int t = threadIdx.x; asm volatile("" : "+v"(t)); return t; }
__device__ __forceinline__ float wave_sum(float v) {
#pragma unroll
    for (int o = 1; o < 64; o <<= 1) v += __shfl_xor(v, o);
    return v;
}

namespace pg8 {
constexpr int BM = 256, BK = 64, HALF = 128, HTB = HALF * BK * 2, STAGE_BYTES = 8 * HTB, NXCD = 8, WGM = 8;
__host__ __device__ __forceinline__ int lds_byte(int r, int c) { const int st = (r >> 4) * 2 + (c >> 5), rr = r & 15, cc = c & 31, ob = rr * 64 + cc * 2; return st * 1024 + (ob ^ (((ob >> 9) & 1) << 5)); }
__host__ __device__ __forceinline__ void stage_rc(int b, int& R, int& C) { const int st = b / 1024, sb = b % 1024, swz = sb ^ (((sb >> 9) & 1) << 5); R = (st >> 1) * 16 + swz / 64; C = (st & 1) * 32 + (swz % 64) / 2; }
__host__ __device__ __forceinline__ int perm32(int rho) { const int n = rho >> 4, i = rho & 15; return 8 * (i >> 2) + 4 * n + (i & 3); }
struct Unit { int pm, pn; };
struct Gemm { const bf16_t* A; const bf16_t* Bt; int M, N, K; };
struct StaticOrder {
    int nM, nN, nwg, G, c;
    __device__ void init(int M_, int N_, int G_, int c_) { nM = M_ / BM; nN = N_ / BM; nwg = nM * nN; G = G_; c = c_; }
    __device__ bool next(int i, Unit& u) const {
        const long L = (long)i * G + c; if (L >= nwg) return false;
        int wgid = (int)L; { const int q = nwg / NXCD, r = nwg % NXCD, xcd = wgid % NXCD, off = wgid / NXCD; wgid = (xcd < r ? xcd * (q + 1) : r * (q + 1) + (xcd - r) * q) + off; }
        const int nig = WGM * nN, gid = wgid / nig, fm = gid * WGM, gsz = (nM - fm) < WGM ? (nM - fm) : WGM;
        u.pm = fm + ((wgid % nig) % gsz); u.pn = (wgid % nig) / gsz; return true;
    }
};

template <class Epi>
__device__ __forceinline__ void gemm_phase(LAS unsigned char* lds, const Gemm g, const StaticOrder& S, const Epi& E) {
    const int tid = fresh_tid(), wid = __builtin_amdgcn_readfirstlane(tid >> 6), lane = tid & 63, wr = wid >> 2, wc = wid & 3, fr = lane & 15, fq = lane >> 4;
    const int K = g.K, nt = K / BK;
    unsigned voffA[2], voffB[2];
#pragma unroll
    for (int i = 0; i < 2; ++i) { int R, C; stage_rc(tid * 16 + i * 8192, R, C); const int Rb = Epi::PERM ? ((R & ~31) + perm32(R & 31)) : R;
        voffA[i] = (unsigned)(R * K + C) * 2u; voffB[i] = (unsigned)(Rb * K + C) * 2u; }
    const size_t kstep = (size_t)(BK * 2);
    const size_t hstep = (size_t)HALF * K * 2;
    const size_t tstep = 2 * hstep;
    const unsigned ldsw = (unsigned)wid * 1024u;
    const int aoff = lds_byte(wr * 64 + fr, fq * 8), boff = lds_byte(wc * 32 + fr, fq * 8);
#define PG8_SA(b, h) (((b) * 2 + (h)) * HTB)
#define PG8_SB(b, h) ((4 + (b) * 2 + (h)) * HTB)
#define PG8_STAGE(bufoff, gbase, voff) do { _Pragma("unroll") for (int _i = 0; _i < 2; ++_i) \
        __builtin_amdgcn_global_load_lds((const unsigned*)((const char*)(gbase) + (voff)[_i]), (LAS unsigned*)(lds + (bufoff) + ldsw + _i * 8192), 16, 0, 0); } while (0)
#define PG8_LDA(dst, b, h) do { _Pragma("unroll") for (int m = 0; m < 4; ++m) _Pragma("unroll") for (int k = 0; k < 2; ++k) dst[m][k] = *(const LAS bf16x8*)(lds + PG8_SA(b, h) + aoff + m * 2048 + k * 1024); } while (0)
#define PG8_LDB(dst, b, h) do { _Pragma("unroll") for (int n = 0; n < 2; ++n) _Pragma("unroll") for (int k = 0; k < 2; ++k) dst[n][k] = *(const LAS bf16x8*)(lds + PG8_SB(b, h) + boff + n * 2048 + k * 1024); } while (0)
#define PG8_MMA(ai, bj, At, Bt) do { __builtin_amdgcn_s_setprio(1); _Pragma("unroll") for (int m = 0; m < 4; ++m) _Pragma("unroll") for (int n = 0; n < 2; ++n) _Pragma("unroll") for (int k = 0; k < 2; ++k) \
        acc[ai][bj][m][n] = __builtin_amdgcn_mfma_f32_16x16x32_bf16(Bt[n][k], At[m][k], acc[ai][bj][m][n], 0, 0, 0); __builtin_amdgcn_s_setprio(0); } while (0)
#define PG8_WAIT_V(n) asm volatile("s_waitcnt vmcnt(" #n ")" ::: "memory")
#define PG8_WAIT_L(n) asm volatile("s_waitcnt lgkmcnt(" #n ")" ::: "memory")
#define PG8_BAR __builtin_amdgcn_s_barrier()
#define PG8_SCHED __builtin_amdgcn_sched_barrier(0)
    Unit cur, nxt; int ui = 0;
    if (!S.next(0, cur)) return;
    f32x4 acc[2][2][4][2];
#pragma unroll
    for (int a = 0; a < 2; ++a)
#pragma unroll
        for (int b = 0; b < 2; ++b)
#pragma unroll
            for (int m = 0; m < 4; ++m)
#pragma unroll
                for (int n = 0; n < 2; ++n) acc[a][b][m][n] = (f32x4){0.f, 0.f, 0.f, 0.f};
    bf16x8 At[4][2], B0[2][2], B1[2][2];
    const char* cA = (const char*)g.A + (size_t)cur.pm * tstep; const char* cB = (const char*)g.Bt + (size_t)cur.pn * tstep;
    PG8_STAGE(PG8_SB(0, 0), cB, voffB); PG8_STAGE(PG8_SA(0, 0), cA, voffA); PG8_STAGE(PG8_SB(0, 1), cB + hstep, voffB); PG8_STAGE(PG8_SA(0, 1), cA + hstep, voffA);
    if (wr == 1) PG8_BAR;
    PG8_WAIT_V(4); PG8_BAR;
    PG8_STAGE(PG8_SB(1, 0), cB + kstep, voffB); PG8_STAGE(PG8_SA(1, 0), cA + kstep, voffA); PG8_STAGE(PG8_SB(1, 1), cB + hstep + kstep, voffB);
    PG8_WAIT_V(6); PG8_BAR;
    for (;;) {
        const bool has_next = S.next(ui + 1, nxt);
        const char* nA = has_next ? (const char*)g.A + (size_t)nxt.pm * tstep : cA; const char* nB = has_next ? (const char*)g.Bt + (size_t)nxt.pn * tstep : cB;
        for (int t = 0; t < nt; t += 2) {
            const bool last = (t == nt - 2);
            const char* a1 = cA + (size_t)(t + 1) * kstep;
            const char* a2 = last ? nA : cA + (size_t)(t + 2) * kstep; const char* b2 = last ? nB : cB + (size_t)(t + 2) * kstep;
            const char* a3 = a2 + kstep; const char* b3 = b2 + kstep;
            PG8_LDB(B0, 0, 0); PG8_SCHED; PG8_LDA(At, 0, 0); PG8_STAGE(PG8_SA(1, 1), a1 + hstep, voffA);
            PG8_WAIT_L(8); PG8_BAR; PG8_WAIT_L(0); PG8_MMA(0, 0, At, B0); PG8_BAR; PG8_SCHED;
            PG8_LDB(B1, 0, 1); PG8_STAGE(PG8_SB(0, 0), b2, voffB);
            PG8_BAR; PG8_WAIT_L(0); PG8_MMA(0, 1, At, B1); PG8_BAR;
            PG8_LDA(At, 0, 1); PG8_STAGE(PG8_SA(0, 0), a2, voffA);
            PG8_BAR; PG8_WAIT_L(0); PG8_MMA(1, 0, At, B0); PG8_BAR; PG8_SCHED;
            PG8_STAGE(PG8_SB(0, 1), b2 + hstep, voffB);
            PG8_WAIT_V(6); PG8_BAR; PG8_MMA(1, 1, At, B1); PG8_BAR;
            PG8_LDB(B0, 1, 0); PG8_SCHED; PG8_LDA(At, 1, 0); PG8_STAGE(PG8_SA(0, 1), a2 + hstep, voffA);
            PG8_WAIT_L(8); PG8_BAR; PG8_WAIT_L(0); PG8_MMA(0, 0, At, B0); PG8_BAR; PG8_SCHED;
            PG8_LDB(B1, 1, 1); PG8_STAGE(PG8_SB(1, 0), b3, voffB);
            PG8_BAR; PG8_WAIT_L(0); PG8_MMA(0, 1, At, B1); PG8_BAR;
            PG8_LDA(At, 1, 1); PG8_STAGE(PG8_SA(1, 0), a3, voffA);
            PG8_BAR; PG8_WAIT_L(0); PG8_MMA(1, 0, At, B0); PG8_BAR; PG8_SCHED;
            PG8_STAGE(PG8_SB(1, 1), b3 + hstep, voffB);
            PG8_WAIT_V(6); PG8_BAR; PG8_MMA(1, 1, At, B1); PG8_BAR;
        }
        { const int t2 = fresh_tid(); E(acc, cur, wr, wc, t2 & 15, (t2 >> 4) & 3); }
        if (!has_next) break;
#pragma unroll
        for (int a = 0; a < 2; ++a)
#pragma unroll
            for (int b = 0; b < 2; ++b)
#pragma unroll
                for (int m = 0; m < 4; ++m)
#pragma unroll
                    for (int n = 0; n < 2; ++n) acc[a][b][m][n] = (f32x4){0.f, 0.f, 0.f, 0.f};
        cur = nxt; cA = nA; cB = nB; ++ui;
    }
    PG8_WAIT_V(0);
    if (wr == 0) PG8_BAR;
    PG8_BAR;
#undef PG8_SA
#undef PG8_SB
#undef PG8_STAGE
#undef PG8_LDA
#undef PG8_LDB
#undef PG8_MMA
#undef PG8_WAIT_V
#undef PG8_WAIT_L
#undef PG8_BAR
#undef PG8_SCHED
}

typedef f32x4 Acc[2][2][4][2];
struct EpiF32 {
    static constexpr bool PERM = false;
    float* C; int ldc;
    __device__ __forceinline__ void operator()(const Acc& acc, const Unit& u, int wr, int wc, int fr, int fq) const {
        const int row0 = u.pm * BM + wr * 64 + fr, col0 = u.pn * BM + wc * 32 + 4 * fq;
#pragma unroll
        for (int ai = 0; ai < 2; ++ai)
#pragma unroll
            for (int m = 0; m < 4; ++m) { float* rowp = C + (size_t)(row0 + ai * HALF + m * 16) * ldc + col0;
#pragma unroll
                for (int bj = 0; bj < 2; ++bj)
#pragma unroll
                    for (int n = 0; n < 2; ++n) *(f32x4*)(rowp + bj * HALF + n * 16) = acc[ai][bj][m][n]; }
    }
};
struct EpiBf16 {
    static constexpr bool PERM = true;
    bf16_t* O; int ldc;
    __device__ __forceinline__ void operator()(const Acc& acc, const Unit& u, int wr, int wc, int fr, int fq) const {
        const int row0 = u.pm * BM + wr * 64 + fr, col0 = u.pn * BM + wc * 32 + 8 * fq;
#pragma unroll
        for (int ai = 0; ai < 2; ++ai)
#pragma unroll
            for (int m = 0; m < 4; ++m) { bf16_t* rowp = O + (size_t)(row0 + ai * HALF + m * 16) * ldc + col0;
#pragma unroll
                for (int bj = 0; bj < 2; ++bj) { const f32x4 v0 = acc[ai][bj][m][0], v1 = acc[ai][bj][m][1];
                    u32x4 w; w.x = cvt_pk_bf16(v0[0], v0[1]); w.y = cvt_pk_bf16(v0[2], v0[3]); w.z = cvt_pk_bf16(v1[0], v1[1]); w.w = cvt_pk_bf16(v1[2], v1[3]);
                    *(u32x4*)(rowp + bj * HALF) = w; } }
    }
};
struct EpiSwiGLU {
    static constexpr bool PERM = true;
    bf16_t* H;
    __device__ __forceinline__ void operator()(const Acc& acc, const Unit& u, int wr, int wc, int fr, int fq) const {
        const int row0 = u.pm * BM + wr * 64 + fr, col0 = u.pn * HALF + wc * 32 + 8 * fq;
#pragma unroll
        for (int ai = 0; ai < 2; ++ai)
#pragma unroll
            for (int m = 0; m < 4; ++m) { bf16_t* rowp = H + (size_t)(row0 + ai * HALF + m * 16) * DFF + col0;
                float h[8];
#pragma unroll
                for (int n = 0; n < 2; ++n)
#pragma unroll
                    for (int j = 0; j < 4; ++j) { const float gt = acc[ai][0][m][n][j], up = acc[ai][1][m][n][j]; h[n * 4 + j] = gt * sigmoidf_fast(gt) * up; }
                u32x4 w; w.x = cvt_pk_bf16(h[0], h[1]); w.y = cvt_pk_bf16(h[2], h[3]); w.z = cvt_pk_bf16(h[4], h[5]); w.w = cvt_pk_bf16(h[6], h[7]);
                *(u32x4*)rowp = w; }
    }
};
struct EpiGate {
    static constexpr bool PERM = true;
    bf16_t* G;
    __device__ __forceinline__ void operator()(const Acc& acc, const Unit& u, int wr, int wc, int fr, int fq) const {
        const int row0 = u.pm * BM + wr * 64 + fr, col0 = u.pn * BM + wc * 32 + 8 * fq;
#pragma unroll
        for (int ai = 0; ai < 2; ++ai)
#pragma unroll
            for (int m = 0; m < 4; ++m) { bf16_t* rowp = G + (size_t)(row0 + ai * HALF + m * 16) * 2048 + col0;
#pragma unroll
                for (int bj = 0; bj < 2; ++bj) { const f32x4 v0 = acc[ai][bj][m][0], v1 = acc[ai][bj][m][1];
                    u32x4 w; w.x = cvt_pk_bf16(sigmoidf_fast(v0[0]), sigmoidf_fast(v0[1])); w.y = cvt_pk_bf16(sigmoidf_fast(v0[2]), sigmoidf_fast(v0[3]));
                    w.z = cvt_pk_bf16(sigmoidf_fast(v1[0]), sigmoidf_fast(v1[1])); w.w = cvt_pk_bf16(sigmoidf_fast(v1[2]), sigmoidf_fast(v1[3]));
                    *(u32x4*)(rowp + bj * HALF) = w; } }
    }
};
struct EpiQ {
    static constexpr bool PERM = true;
    bf16_t* Q; const float* TAB;
    __device__ __forceinline__ void operator()(const Acc& acc, const Unit& u, int wr, int wc, int fr, int fq) const {
        const int row0 = u.pm * BM + wr * 64 + fr, col0 = u.pn * BM + wc * 32 + 8 * fq;
#pragma unroll
        for (int ai = 0; ai < 2; ++ai)
#pragma unroll
            for (int m = 0; m < 4; ++m) { const int row = row0 + ai * HALF + m * 16; bf16_t* rowp = Q + (size_t)row * 1536 + col0;
#pragma unroll
                for (int bj = 0; bj < 2; ++bj) { f32x4 v0 = acc[ai][bj][m][0], v1 = acc[ai][bj][m][1];
                    const int c = col0 + bj * HALF, w = c % 192;
                    if (w >= 128) { const int i0 = (w - 128) >> 1; const f32x4 cs = *(const f32x4*)(TAB + (size_t)row * 64 + i0), sn = *(const f32x4*)(TAB + (size_t)row * 64 + 32 + i0);
                        f32x4 r0, r1;
                        r0[0] = v0[0] * cs[0] - v0[1] * sn[0]; r0[1] = v0[1] * cs[0] + v0[0] * sn[0];
                        r0[2] = v0[2] * cs[1] - v0[3] * sn[1]; r0[3] = v0[3] * cs[1] + v0[2] * sn[1];
                        r1[0] = v1[0] * cs[2] - v1[1] * sn[2]; r1[1] = v1[1] * cs[2] + v1[0] * sn[2];
                        r1[2] = v1[2] * cs[3] - v1[3] * sn[3]; r1[3] = v1[3] * cs[3] + v1[2] * sn[3];
                        v0 = r0; v1 = r1; }
                    u32x4 wv; wv.x = cvt_pk_bf16(v0[0], v0[1]); wv.y = cvt_pk_bf16(v0[2], v0[3]); wv.z = cvt_pk_bf16(v1[0], v1[1]); wv.w = cvt_pk_bf16(v1[2], v1[3]);
                    *(u32x4*)(rowp + bj * HALF) = wv; } }
    }
};
struct EpiT1 {
    static constexpr bool PERM = true;
    const bf16_t* G; float* F;
    __device__ __forceinline__ void operator()(const Acc& acc, const Unit& u, int wr, int wc, int fr, int fq) const {
        const int row0 = u.pm * BM + wr * 64 + fr, col0 = u.pn * BM + wc * 32 + 8 * fq;
#pragma unroll
        for (int ai = 0; ai < 2; ++ai)
#pragma unroll
            for (int m = 0; m < 4; ++m) { const int row = row0 + ai * HALF + m * 16;
#pragma unroll
                for (int bj = 0; bj < 2; ++bj) { const f32x4 v0 = acc[ai][bj][m][0], v1 = acc[ai][bj][m][1]; const int c = col0 + bj * HALF;
                    const u32x4 gw = *(const u32x4*)(G + (size_t)row * 2048 + c);
                    f32x4 o0, o1;
                    o0[0] = v0[0] * bf_lo(gw.x); o0[1] = v0[1] * bf_hi(gw.x); o0[2] = v0[2] * bf_lo(gw.y); o0[3] = v0[3] * bf_hi(gw.y);
                    o1[0] = v1[0] * bf_lo(gw.z); o1[1] = v1[1] * bf_hi(gw.z); o1[2] = v1[2] * bf_lo(gw.w); o1[3] = v1[3] * bf_hi(gw.w);
                    float* fp = F + (size_t)row * 1024 + c; *(f32x4*)fp = o0; *(f32x4*)(fp + 4) = o1; } }
    }
};
struct EpiMX {
    static constexpr bool PERM = true;
    const bf16_t* G; const float* F; bf16_t* MX;
    __device__ __forceinline__ void operator()(const Acc& acc, const Unit& u, int wr, int wc, int fr, int fq) const {
        const int row0 = u.pm * BM + wr * 64 + fr, col0 = u.pn * BM + wc * 32 + 8 * fq;
#pragma unroll
        for (int ai = 0; ai < 2; ++ai)
#pragma unroll
            for (int m = 0; m < 4; ++m) { const int row = row0 + ai * HALF + m * 16;
#pragma unroll
                for (int bj = 0; bj < 2; ++bj) { const f32x4 v0 = acc[ai][bj][m][0], v1 = acc[ai][bj][m][1]; const int c = col0 + bj * HALF;
                    const u32x4 gw = *(const u32x4*)(G + (size_t)row * 2048 + 1024 + c);
                    const float* fp = F + (size_t)row * 1024 + c; const f32x4 t0 = *(const f32x4*)fp, t1 = *(const f32x4*)(fp + 4);
                    u32x4 wv;
                    wv.x = cvt_pk_bf16(t0[0] + v0[0] * bf_lo(gw.x), t0[1] + v0[1] * bf_hi(gw.x)); wv.y = cvt_pk_bf16(t0[2] + v0[2] * bf_lo(gw.y), t0[3] + v0[3] * bf_hi(gw.y));
                    wv.z = cvt_pk_bf16(t1[0] + v1[0] * bf_lo(gw.z), t1[1] + v1[1] * bf_hi(gw.z)); wv.w = cvt_pk_bf16(t1[2] + v1[2] * bf_lo(gw.w), t1[3] + v1[3] * bf_hi(gw.w));
                    *(u32x4*)(MX + (size_t)row * 1024 + c) = wv; } }
    }
};
}

namespace att {
constexpr int NW = 8, QBLK = 32, KVBLK = 64;
constexpr float SCALE = 0.07216878364870322f;
constexpr float THR = 8.f;
constexpr int LDQ = 1536, LDKV = 2048, LDKR = 64, LDO = 1024;
constexpr int SHM_V = 64 * 128 * 2, SHM_K = 64 * 128 * 2, SHM_R = 64 * 64 * 2;
constexpr int NQL = 4;
constexpr int OFF_V = 0, OFF_K = 2 * SHM_V, OFF_RP = OFF_K + 2 * SHM_K, OFF_WS = OFF_RP + 2 * SHM_R, OFF_QL = OFF_WS + NW * 64 * 4, SHM_ATTN = OFF_QL + NW * NQL * 1024;
static_assert(SHM_ATTN <= LDS_BYTES, "lds");
#define KSWZ(row, colB) ((row) * 256 + ((colB) ^ (((row) & 7) << 4)))
#define RSWZ(row, colB) ((row) * 128 + ((colB) ^ (((row) & 7) << 4)))
#define SBAR() __builtin_amdgcn_sched_barrier(0)
__device__ __forceinline__ int crow(int r, int hi) { return (r & 3) + 8 * (r >> 2) + 4 * hi; }
__device__ __forceinline__ bf16x8 ld8(const bf16_t* p) { return *reinterpret_cast<const bf16x8*>(p); }

__device__ __forceinline__ void partialSM(f32x16& p0, f32x16& p1, float& m_reg, float& mn, float& alpha) {
    constexpr float C = SCALE * 1.4426950408889634f;
    float pmax = p0[0];
#pragma unroll
    for (int r = 1; r < 16; ++r) pmax = fmaxf(pmax, p0[r]);
#pragma unroll
    for (int r = 0; r < 16; ++r) pmax = fmaxf(pmax, p1[r]);
    { auto rr = __builtin_amdgcn_permlane32_swap(__float_as_uint(pmax), __float_as_uint(pmax), false, false);
      pmax = fmaxf(__uint_as_float(rr[0]), __uint_as_float(rr[1])); }
    if (__builtin_expect(__all(pmax - m_reg <= THR / SCALE), 1)) { mn = m_reg; alpha = 1.f; }
    else { mn = fmaxf(m_reg, pmax); alpha = __builtin_amdgcn_exp2f((m_reg - mn) * C); m_reg = mn; }
    float mnC = -mn * C;
#pragma unroll
    for (int r = 0; r < 16; ++r) p0[r] = fmaf(p0[r], C, mnC);
#pragma unroll
    for (int r = 0; r < 16; ++r) p1[r] = fmaf(p1[r], C, mnC);
#pragma unroll
    for (int r = 0; r < 16; ++r) p0[r] = __builtin_amdgcn_exp2f(p0[r]);
}
__device__ __forceinline__ void finishSM(f32x16& p0, f32x16& p1, float alpha, float& l_reg, bf16x8& pa0, bf16x8& pa1, bf16x8& pa2, bf16x8& pa3) {
#pragma unroll
    for (int r = 0; r < 16; ++r) p1[r] = __builtin_amdgcn_exp2f(p1[r]);
    float ps = 0;
#pragma unroll
    for (int r = 0; r < 16; ++r) ps += p0[r];
#pragma unroll
    for (int r = 0; r < 16; ++r) ps += p1[r];
    { auto rr = __builtin_amdgcn_permlane32_swap(__float_as_uint(ps), __float_as_uint(ps), false, false);
      ps = __uint_as_float(rr[0]) + __uint_as_float(rr[1]); }
    l_reg = l_reg * alpha + ps;
#define PK4(P, BASE, OUT) do { unsigned a0 = cvt_pk_bf16(P[BASE + 0], P[BASE + 1]), a1 = cvt_pk_bf16(P[BASE + 2], P[BASE + 3]);   \
    unsigned b0 = cvt_pk_bf16(P[BASE + 4], P[BASE + 5]), b1 = cvt_pk_bf16(P[BASE + 6], P[BASE + 7]);                              \
    auto r0 = __builtin_amdgcn_permlane32_swap(a0, b0, false, false); auto r1 = __builtin_amdgcn_permlane32_swap(a1, b1, false, false); \
    u32x4 w = {r0[0], r1[0], r0[1], r1[1]}; OUT = *reinterpret_cast<bf16x8*>(&w); } while (0)
    PK4(p0, 0, pa0); PK4(p0, 8, pa1); PK4(p1, 0, pa2); PK4(p1, 8, pa3);
#undef PK4
}
__device__ __forceinline__ void qkt(f32x16& p0, f32x16& p1, const char* Ks, const char* Rs, const bf16x8* qr, const char* ql, int r32, int hi) {
    p0 = f32x16{}; p1 = f32x16{};
#pragma unroll
    for (int d0 = 0; d0 < 8; ++d0) { int cb = (d0 * 16 + hi * 8) * 2;
        bf16x8 b0 = *reinterpret_cast<const bf16x8*>(Ks + KSWZ(r32, cb));
        bf16x8 b1 = *reinterpret_cast<const bf16x8*>(Ks + KSWZ(32 + r32, cb));
        p0 = __builtin_amdgcn_mfma_f32_32x32x16_bf16(b0, qr[d0], p0, 0, 0, 0);
        p1 = __builtin_amdgcn_mfma_f32_32x32x16_bf16(b1, qr[d0], p1, 0, 0, 0); }
#pragma unroll
    for (int d0 = 0; d0 < 4; ++d0) { int cb = (d0 * 16 + hi * 8) * 2;
        bf16x8 b0 = *reinterpret_cast<const bf16x8*>(Rs + RSWZ(r32, cb));
        bf16x8 b1 = *reinterpret_cast<const bf16x8*>(Rs + RSWZ(32 + r32, cb));
        const bf16x8 qv = *reinterpret_cast<const bf16x8*>(ql + d0 * 1024);
        p0 = __builtin_amdgcn_mfma_f32_32x32x16_bf16(b0, qv, p0, 0, 0, 0);
        p1 = __builtin_amdgcn_mfma_f32_32x32x16_bf16(b1, qv, p1, 0, 0, 0); }
}
__device__ __forceinline__ int v_st(int k, int c) { const int kk = (k & ~0xC) | ((k & 4) << 1) | ((k & 8) >> 1); return ((kk >> 3) * 4 + (c >> 5)) * 512 + ((kk & 7) * 32 + (c & 31)) * 2; }
__device__ __forceinline__ int v_rd_base(int lane) { return ((lane & 3) << 3) | (((lane >> 2) & 3) << 6) | (((lane >> 4) & 1) << 5) | (((lane >> 5) & 1) << 8); }
constexpr int v_rd_off(int d0, int ks, int half) { return d0 * 512 + ks * 4096 + half * 2048; }
template <int OFF> __device__ __forceinline__ s16x4 tr_read(int vb) {
    s16x4 r; asm volatile("ds_read_b64_tr_b16 %0, %1 offset:%2" : "=&v"(r) : "v"(vb), "i"(OFF) : "memory"); return r;
}
template <int D0> __device__ __forceinline__ void pv_one(f32x16& od, int vb, bf16x8 pa0, bf16x8 pa1, bf16x8 pa2, bf16x8 pa3) {
    const s16x4 l0 = tr_read<v_rd_off(D0, 0, 0)>(vb), h0 = tr_read<v_rd_off(D0, 0, 1)>(vb), l1 = tr_read<v_rd_off(D0, 1, 0)>(vb), h1 = tr_read<v_rd_off(D0, 1, 1)>(vb);
    const s16x4 l2 = tr_read<v_rd_off(D0, 2, 0)>(vb), h2 = tr_read<v_rd_off(D0, 2, 1)>(vb), l3 = tr_read<v_rd_off(D0, 3, 0)>(vb), h3 = tr_read<v_rd_off(D0, 3, 1)>(vb);
    asm volatile("s_waitcnt lgkmcnt(0)" ::: "memory"); SBAR();
#define PK(L, H) (bf16x8){L[0], L[1], L[2], L[3], H[0], H[1], H[2], H[3]}
    od = __builtin_amdgcn_mfma_f32_32x32x16_bf16(pa0, PK(l0, h0), od, 0, 0, 0);
    od = __builtin_amdgcn_mfma_f32_32x32x16_bf16(pa1, PK(l1, h1), od, 0, 0, 0);
    od = __builtin_amdgcn_mfma_f32_32x32x16_bf16(pa2, PK(l2, h2), od, 0, 0, 0);
    od = __builtin_amdgcn_mfma_f32_32x32x16_bf16(pa3, PK(l3, h3), od, 0, 0, 0);
#undef PK
}
__device__ __forceinline__ void pv_d0(f32x16* o, int vb, bf16x8 pa0, bf16x8 pa1, bf16x8 pa2, bf16x8 pa3) {
    pv_one<0>(o[0], vb, pa0, pa1, pa2, pa3); pv_one<1>(o[1], vb, pa0, pa1, pa2, pa3); pv_one<2>(o[2], vb, pa0, pa1, pa2, pa3); pv_one<3>(o[3], vb, pa0, pa1, pa2, pa3);
}

__device__ __forceinline__ void attn_body(const bf16_t* __restrict__ Qb, const bf16_t* __restrict__ Kn, const bf16_t* __restrict__ Kr, const bf16_t* __restrict__ Vh,
                                          bf16_t* __restrict__ Ob, int seq, char* lds) {
    const int tid = fresh_tid(), wid = tid >> 6, lane = tid & 63, r32 = lane & 31, hi = lane >> 5;
    char* V_lds = lds + OFF_V; char* K_lds = lds + OFF_K; char* R_lds = lds + OFF_RP;
    float* ws = (float*)(lds + OFF_WS) + wid * 64; float* li_l = ws; float* al_l = ws + 32;
    float m_reg = -1e30f, l_reg = 0; f32x16 o[4] = {}; bf16x8 qr[8];
    char* ql = lds + OFF_QL + wid * (NQL * 1024) + lane * 16;
    const bf16_t* Qw = Qb + (long)(wid * QBLK + r32) * LDQ + hi * 8;
#pragma unroll
    for (int d0 = 0; d0 < 8; ++d0) qr[d0] = ld8(Qw + d0 * 16);
#pragma unroll
    for (int d0 = 0; d0 < NQL; ++d0) *reinterpret_cast<bf16x8*>(ql + d0 * 1024) = ld8(Qw + (8 + d0) * 16);
    const int sr = tid >> 4, sc = (tid & 15) * 8, vst0 = v_st(sr, sc), vst1 = v_st(32 + sr, sc);
    const int rr_ = tid >> 3, rc_ = (tid & 7) * 8;
    const int vb0 = (int)(uintptr_t)V_lds + v_rd_base(lane);
    bf16x8 vs0, vs1, ks0, ks1, rs0;
#define SLOAD(k0) do { vs0 = ld8(&Vh[(long)((k0) + sr) * LDKV + sc]); vs1 = ld8(&Vh[(long)((k0) + 32 + sr) * LDKV + sc]); \
    ks0 = ld8(&Kn[(long)((k0) + sr) * LDKV + sc]); ks1 = ld8(&Kn[(long)((k0) + 32 + sr) * LDKV + sc]); rs0 = ld8(&Kr[(long)((k0) + rr_) * LDKR + rc_]); } while (0)
#define SWRITE(b) do { *(bf16x8*)(V_lds + (b) * SHM_V + vst0) = vs0; *(bf16x8*)(V_lds + (b) * SHM_V + vst1) = vs1; int kc = sc * 2; \
    *(bf16x8*)(K_lds + (b) * SHM_K + KSWZ(sr, kc)) = ks0; *(bf16x8*)(K_lds + (b) * SHM_K + KSWZ(32 + sr, kc)) = ks1; \
    *(bf16x8*)(R_lds + (b) * SHM_R + RSWZ(rr_, rc_ * 2)) = rs0; } while (0)
#define RESC(a) do { if (__any((a) < 1.f)) { if (hi == 0) al_l[r32] = (a); asm volatile("s_waitcnt lgkmcnt(0)" ::: "memory"); \
    _Pragma("unroll") for (int d = 0; d < 4; ++d) _Pragma("unroll") for (int r = 0; r < 16; ++r) o[d][r] *= al_l[crow(r, hi)]; } } while (0)
    f32x16 pA0, pA1, pB0, pB1; float mnA, mnB, alA, alB; bf16x8 pa0, pa1, pa2, pa3; const int NT = seq / KVBLK;
    SLOAD(0); asm volatile("s_waitcnt vmcnt(0)" ::: "memory"); SWRITE(0); __syncthreads();
    qkt(pA0, pA1, K_lds, R_lds, qr, ql, r32, hi); partialSM(pA0, pA1, m_reg, mnA, alA);
    SLOAD(KVBLK);
    asm volatile("s_waitcnt vmcnt(0)" ::: "memory"); SWRITE(1); __syncthreads();
    for (int j = 1; j + 1 < NT; j += 2) {
        SBAR(); qkt(pB0, pB1, K_lds + SHM_K, R_lds + SHM_R, qr, ql, r32, hi);
        finishSM(pA0, pA1, alA, l_reg, pa0, pa1, pa2, pa3); SBAR();
        SLOAD((j + 1) * KVBLK); SBAR();
        pv_d0(o, vb0, pa0, pa1, pa2, pa3); partialSM(pB0, pB1, m_reg, mnB, alB);
        __syncthreads(); asm volatile("s_waitcnt vmcnt(0)" ::: "memory"); SWRITE(0);
        RESC(alB); __syncthreads();
        SBAR(); qkt(pA0, pA1, K_lds, R_lds, qr, ql, r32, hi);
        finishSM(pB0, pB1, alB, l_reg, pa0, pa1, pa2, pa3); SBAR();
        SLOAD((j + 2) * KVBLK); SBAR();
        pv_d0(o, vb0 + SHM_V, pa0, pa1, pa2, pa3); partialSM(pA0, pA1, m_reg, mnA, alA);
        __syncthreads(); asm volatile("s_waitcnt vmcnt(0)" ::: "memory"); SWRITE(1);
        RESC(alA); __syncthreads();
    }
    SBAR(); qkt(pB0, pB1, K_lds + SHM_K, R_lds + SHM_R, qr, ql, r32, hi);
    finishSM(pA0, pA1, alA, l_reg, pa0, pa1, pa2, pa3); SBAR();
    pv_d0(o, vb0, pa0, pa1, pa2, pa3); partialSM(pB0, pB1, m_reg, mnB, alB);
    __syncthreads(); RESC(alB);
    finishSM(pB0, pB1, alB, l_reg, pa0, pa1, pa2, pa3); SBAR();
    pv_d0(o, vb0 + SHM_V, pa0, pa1, pa2, pa3);
    if (hi == 0) li_l[r32] = l_reg; asm volatile("s_waitcnt lgkmcnt(0)" ::: "memory");
    float rli[16];
#pragma unroll
    for (int r = 0; r < 16; ++r) rli[r] = __builtin_amdgcn_rcpf(li_l[crow(r, hi)]);
    bf16_t* Ow = Ob + (long)(wid * QBLK) * LDO;
#pragma unroll
    for (int r = 0; r < 16; ++r) { int orow = crow(r, hi);
#pragma unroll
        for (int d0 = 0; d0 < 4; ++d0) { const float v = o[d0][r] * rli[r]; Ow[(long)orow * LDO + d0 * 32 + r32] = (bf16_t)(cvt_pk_bf16(v, v) & 0xffffu); } }
#undef SLOAD
#undef SWRITE
#undef RESC
}
}

enum { TR_PLAIN = 0, TR_GU = 1, TR_WIN = 2, TR_UQ = 3, TR_UKV = 4 };
template <int MODE>
__device__ __forceinline__ void tr_job(const float* W0, const float* W1, int K, int Nsrc, int Nout, bf16_t* WT, LAS float* scr, int lane, int gw, int NGW) {
    const int nblk = Nout / 32, nitems = (K / 64) * nblk;
    for (int it = gw; it < nitems; it += NGW) {
        const int kb = it / nblk, nb = it % nblk, k0 = 64 * kb, n0 = 32 * nb, np = n0 + (lane & 31);
        const float* colp;
        if (MODE == TR_PLAIN) colp = W0 + np;
        else if (MODE == TR_GU) { const int t = np >> 8, w = np & 255; colp = (w < 128 ? W0 : W1) + t * 128 + (w & 127); }
        else if (MODE == TR_WIN) colp = np < 1216 ? W0 + np : (np < 1280 ? nullptr : W0 + (np - 64));
        else if (MODE == TR_UQ) { const int h = np / 192, w = np % 192; colp = W0 + (w < 128 ? np : h * 192 + 128 + ((w - 128) >> 1) + ((w - 128) & 1) * 32); }
        else colp = np < 1024 ? W0 + np : W1 + (np - 1024);
#pragma unroll 8
        for (int i = 0; i < 32; ++i) { const int kk = 2 * i + (lane >> 5); scr[kk * 33 + (lane & 31)] = colp ? colp[(size_t)(k0 + kk) * Nsrc] : 0.f; }
        asm volatile("s_waitcnt lgkmcnt(0)" ::: "memory");
        const int c = lane & 7;
#pragma unroll
        for (int j = 0; j < 4; ++j) { const int n = (lane >> 3) + 8 * j; const LAS float* s = scr + (8 * c) * 33 + n;
            u32x4 o; o.x = cvt_pk_bf16(s[0 * 33], s[1 * 33]); o.y = cvt_pk_bf16(s[2 * 33], s[3 * 33]); o.z = cvt_pk_bf16(s[4 * 33], s[5 * 33]); o.w = cvt_pk_bf16(s[6 * 33], s[7 * 33]);
            *(u32x4*)(WT + (size_t)(n0 + n) * K + k0 + 8 * c) = o; }
        asm volatile("s_waitcnt lgkmcnt(0)" ::: "memory");
    }
}

template <int MODE>
__device__ __forceinline__ void rows_phase(const float* xin, const float* f, float wt, const float* gpost, const float* gnext, float* xout, bf16_t* xn, int gw, int NGW, int lane) {
    for (int row = gw; row < M; row += NGW) {
        f32x4 xv[4];
#pragma unroll
        for (int j = 0; j < 4; ++j) xv[j] = *(const f32x4*)(xin + (size_t)row * DM + 4 * (lane + 64 * j));
        if (MODE != 0) {
            f32x4 fv[4]; float ss = 0.f;
#pragma unroll
            for (int j = 0; j < 4; ++j) { fv[j] = *(const f32x4*)(f + (size_t)row * DM + 4 * (lane + 64 * j)); ss += fv[j].x * fv[j].x + fv[j].y * fv[j].y + fv[j].z * fv[j].z + fv[j].w * fv[j].w; }
            const float r = wt * __builtin_amdgcn_rsqf(wave_sum(ss) * (1.f / DM) + EPS);
#pragma unroll
            for (int j = 0; j < 4; ++j) { const f32x4 g = *(const f32x4*)(gpost + 4 * (lane + 64 * j)); xv[j] = xv[j] + fv[j] * g * r; }
            if (MODE == 1) {
#pragma unroll
                for (int j = 0; j < 4; ++j) *(f32x4*)(xout + (size_t)row * DM + 4 * (lane + 64 * j)) = xv[j];
            }
        }
        float s2 = 0.f;
#pragma unroll
        for (int j = 0; j < 4; ++j) s2 += xv[j].x * xv[j].x + xv[j].y * xv[j].y + xv[j].z * xv[j].z + xv[j].w * xv[j].w;
        const float r2 = __builtin_amdgcn_rsqf(wave_sum(s2) * (1.f / DM) + EPS);
#pragma unroll
        for (int j = 0; j < 4; ++j) { const f32x4 g = *(const f32x4*)(gnext + 4 * (lane + 64 * j)); const f32x4 y = xv[j] * g * r2;
            if (MODE == 2) *(f32x4*)(xout + (size_t)row * DM + 4 * (lane + 64 * j)) = y;
            else { u32x2 w; w.x = cvt_pk_bf16(y.x, y.y); w.y = cvt_pk_bf16(y.z, y.w); *(u32x2*)(xn + (size_t)row * DM + 4 * (lane + 64 * j)) = w; } }
    }
}

__global__ void __launch_bounds__(NTHREADS, 2) fwd_megakernel(Params p) {
    extern __shared__ __attribute__((aligned(16))) unsigned char lds[];
    cg::grid_group grid = cg::this_grid();
    unsigned* bar_cnt = (unsigned*)(p.ws + WS_END); unsigned bar_target = 0;
#define GRID_SYNC_CG() do { __builtin_amdgcn_fence(__ATOMIC_RELEASE, "agent"); asm volatile("s_waitcnt vmcnt(0)" ::: "memory"); grid.sync(); \
        __builtin_amdgcn_fence(__ATOMIC_ACQUIRE, "agent"); asm volatile("s_waitcnt vmcnt(0)" ::: "memory"); } while (0)
#define GRID_SYNC() do { bar_target += gridDim.x; asm volatile("s_waitcnt vmcnt(0)" ::: "memory"); __syncthreads(); \
        if (threadIdx.x == 0) { __builtin_amdgcn_fence(__ATOMIC_RELEASE, "agent"); asm volatile("s_waitcnt vmcnt(0)" ::: "memory"); \
            __hip_atomic_fetch_add(bar_cnt, 1u, __ATOMIC_RELAXED, __HIP_MEMORY_SCOPE_AGENT); \
            while (__hip_atomic_load(bar_cnt, __ATOMIC_RELAXED, __HIP_MEMORY_SCOPE_AGENT) < bar_target) __builtin_amdgcn_s_sleep(1); \
            __builtin_amdgcn_fence(__ATOMIC_ACQUIRE, "agent"); asm volatile("s_waitcnt vmcnt(0)" ::: "memory"); } \
        __syncthreads(); } while (0)
    const int G = gridDim.x, bid = blockIdx.x, NGW = G * NWAVES;
    LAS unsigned char* ldsl = (LAS unsigned char*)lds;
#define PHASE_IDS() const int tid = fresh_tid(), lane = tid & 63, wave = tid >> 6, gw = bid * NWAVES + wave; LAS float* scr = (LAS float*)(ldsl + wave * 8448); (void)scr; (void)gw; (void)lane
    unsigned char* ws = p.ws;
    bf16_t* Wgu = (bf16_t*)(ws + OFF_WGU); bf16_t* Wd = (bf16_t*)(ws + OFF_WD); bf16_t* Win = (bf16_t*)(ws + OFF_WIN); bf16_t* Wuq = (bf16_t*)(ws + OFF_WUQ);
    bf16_t* Wukv = (bf16_t*)(ws + OFF_WUKV); bf16_t* Woa = (bf16_t*)(ws + OFF_WOA); bf16_t* Wp = (bf16_t*)(ws + OFF_WP); bf16_t* Wout = (bf16_t*)(ws + OFF_WOUT);
    bf16_t* XN = (bf16_t*)(ws + OFF_XN); float* F = (float*)(ws + OFF_F); float* ZF = (float*)(ws + OFF_ZF); bf16_t* KV = (bf16_t*)(ws + OFF_KV);
    bf16_t* H = (bf16_t*)(ws + OFF_H); bf16_t* O = (bf16_t*)(ws + OFF_O); bf16_t* CQN = (bf16_t*)(ws + OFF_CQN); bf16_t* CKVN = (bf16_t*)(ws + OFF_CKVN);
    float* TAB = (float*)(ws + OFF_TAB); bf16_t* Q = (bf16_t*)(ws + OFF_Q); bf16_t* KR = (bf16_t*)(ws + OFF_KR); bf16_t* Gt = (bf16_t*)(ws + OFF_G); bf16_t* DP = (bf16_t*)(ws + OFF_DP);
    float* X = p.out;

    { PHASE_IDS();
    tr_job<TR_GU>(p.f1_wg, p.f1_wu, 1024, DFF, 5632, Wgu, scr, lane, gw, NGW);
    tr_job<TR_PLAIN>(p.f1_wd, nullptr, DFF, 1024, 1024, Wd, scr, lane, gw, NGW);
    tr_job<TR_WIN>(p.w_in, nullptr, 1024, INW, 3328, Win, scr, lane, gw, NGW);
    tr_job<TR_UQ>(p.w_uq, nullptr, QL, 1536, 1536, Wuq, scr, lane, gw, NGW);
    tr_job<TR_UKV>(p.w_uk, p.w_uv, KVL, 1024, 2048, Wukv, scr, lane, gw, NGW);
    tr_job<TR_PLAIN>(p.w_oa, nullptr, 1024, 1024, 1024, Woa, scr, lane, gw, NGW);
    tr_job<TR_PLAIN>(p.w_out, nullptr, 1024, 1024, 1024, Wout, scr, lane, gw, NGW);
    for (int idx = bid * NTHREADS + tid; idx < 65536; idx += G * NTHREADS) {
        const int n = idx & 1023, c8 = idx >> 10, g = c8 >> 4, cb = (c8 & 15) * 8;
        float a[8];
#pragma unroll
        for (int i = 0; i < 8; ++i) a[i] = 0.f;
        for (int j = 0; j < 128; ++j) { const float w = p.w_op[(size_t)(g * 128 + j) * 1024 + n] * p.pool_scale[g * 128 + j];
#pragma unroll
            for (int i = 0; i < 8; ++i) a[i] = fmaf(p.pool_w[(size_t)(g * 128 + cb + i) * 128 + j], w, a[i]); }
        u32x4 o; o.x = cvt_pk_bf16(a[0], a[1]); o.y = cvt_pk_bf16(a[2], a[3]); o.z = cvt_pk_bf16(a[4], a[5]); o.w = cvt_pk_bf16(a[6], a[7]);
        *(u32x4*)(Wp + (size_t)n * 512 + c8 * 8) = o;
    }
    rows_phase<0>(p.x, nullptr, 0.f, nullptr, p.f1_pre, nullptr, XN, gw, NGW, lane); }
    GRID_SYNC_CG();

    pg8::StaticOrder S;
    { pg8::Gemm g{XN, Wgu, M, 5632, 1024}; S.init(M, 5632, G, bid); pg8::EpiSwiGLU E{H}; pg8::gemm_phase(ldsl, g, S, E); }
    GRID_SYNC();
    { pg8::Gemm g{H, Wd, M, 1024, DFF}; S.init(M, 1024, G, bid); pg8::EpiF32 E{F, 1024}; pg8::gemm_phase(ldsl, g, S, E); }
    GRID_SYNC();
    { PHASE_IDS(); rows_phase<1>(p.x, F, 0.5f, p.f1_post, p.mix_pre, X, XN, gw, NGW, lane); }
    GRID_SYNC();
    { pg8::Gemm g{XN, Win, M, 1280, 1024}; S.init(M, 1280, G, bid); pg8::EpiF32 E{ZF, 1280}; pg8::gemm_phase(ldsl, g, S, E); }
    GRID_SYNC();
    { PHASE_IDS();
    for (int row = gw; row < M; row += NGW) {
        const float* z = ZF + (size_t)row * 1280;
        {
            f32x4 a = *(const f32x4*)(z + 4 * lane), b = (f32x4){0.f, 0.f, 0.f, 0.f};
            if (lane < 32) b = *(const f32x4*)(z + 4 * (lane + 64));
            float ss = a.x * a.x + a.y * a.y + a.z * a.z + a.w * a.w + b.x * b.x + b.y * b.y + b.z * b.z + b.w * b.w;
            const float r = __builtin_amdgcn_rsqf(wave_sum(ss) * (1.f / QL) + EPS);
            { const f32x4 g = *(const f32x4*)(p.qa_g + 4 * lane); const f32x4 y = a * g * r; u32x2 w; w.x = cvt_pk_bf16(y.x, y.y); w.y = cvt_pk_bf16(y.z, y.w); *(u32x2*)(CQN + (size_t)row * QL + 4 * lane) = w; }
            if (lane < 32) { const f32x4 g = *(const f32x4*)(p.qa_g + 4 * (lane + 64)); const f32x4 y = b * g * r; u32x2 w; w.x = cvt_pk_bf16(y.x, y.y); w.y = cvt_pk_bf16(y.z, y.w); *(u32x2*)(CQN + (size_t)row * QL + 4 * (lane + 64)) = w; }
        }
        {
            const f32x4 a = *(const f32x4*)(z + 384 + 4 * lane);
            const float ss = a.x * a.x + a.y * a.y + a.z * a.z + a.w * a.w;
            const float r = __builtin_amdgcn_rsqf(wave_sum(ss) * (1.f / KVL) + EPS);
            const f32x4 g = *(const f32x4*)(p.kva_g + 4 * lane); const f32x4 y = a * g * r; u32x2 w; w.x = cvt_pk_bf16(y.x, y.y); w.y = cvt_pk_bf16(y.z, y.w); *(u32x2*)(CKVN + (size_t)row * KVL + 4 * lane) = w;
        }
        if (lane < 32) {
            const float x1 = z[640 + lane], x2 = z[672 + lane];
            const float ang = (float)p.pos[row] * p.inv_freq[lane];
            const double ad = (double)ang; const double kq = rint(ad * 0.15915494309189535); const float red = (float)(ad - kq * 6.283185307179586);
            const float cs = __cosf(red), sn = __sinf(red);
            TAB[(size_t)row * 64 + lane] = cs; TAB[(size_t)row * 64 + 32 + lane] = sn;
            *(unsigned*)(KR + (size_t)row * 64 + 2 * lane) = cvt_pk_bf16(x1 * cs - x2 * sn, x2 * cs + x1 * sn);
        }
        {
            const int t = row & (SEQ - 1), g = lane >> 4, wnd = 2 << g, lo = max(t - (wnd >> 1), 0), hi = min(t + wnd - (wnd >> 1), SEQ);
            const float* zp = z + 704 + 8 * lane;
            f32x4 s0 = (f32x4){0.f, 0.f, 0.f, 0.f}, s1 = s0;
            for (int dt = -8; dt < 8; ++dt) { const int tt = t + dt;
                if (tt >= lo && tt < hi) { const float* q = zp + (long)dt * 1280; s0 = s0 + *(const f32x4*)q; s1 = s1 + *(const f32x4*)(q + 4); } }
            const float inv = 1.f / (float)(hi - lo);
            const f32x4 c0 = *(const f32x4*)zp, c1 = *(const f32x4*)(zp + 4);
            const f32x4 d0 = s0 * inv - c0, d1 = s1 * inv - c1;
            u32x4 w; w.x = cvt_pk_bf16(d0.x, d0.y); w.y = cvt_pk_bf16(d0.z, d0.w); w.z = cvt_pk_bf16(d1.x, d1.y); w.w = cvt_pk_bf16(d1.z, d1.w);
            *(u32x4*)(DP + (size_t)row * 512 + 8 * lane) = w;
        }
    } }
    GRID_SYNC();
    { pg8::Gemm g{CQN, Wuq, M, 1536, QL}; S.init(M, 1536, G, bid); pg8::EpiQ E{Q, TAB}; pg8::gemm_phase(ldsl, g, S, E); }
    { pg8::Gemm g{CKVN, Wukv, M, 2048, KVL}; S.init(M, 2048, G, bid); pg8::EpiBf16 E{KV, 2048}; pg8::gemm_phase(ldsl, g, S, E); }
    GRID_SYNC();
    {
        const int vcu = (bid & 7) * (G >> 3) + (bid >> 3);
        for (int it = vcu; it < NB * NH * (SEQ / 256); it += G) {
            const int qb = it & 7, h = (it >> 3) & 7, b = it >> 6;
            const size_t tok0 = (size_t)b * SEQ;
            att::attn_body(Q + (tok0 + qb * 256) * 1536 + h * 192, KV + tok0 * 2048 + h * 128, KR + tok0 * 64, KV + tok0 * 2048 + 1024 + h * 128,
                           O + (tok0 + qb * 256) * 1024 + h * 128, SEQ, (char*)lds);
            __syncthreads();
        }
    }
    GRID_SYNC();
    { pg8::Gemm g{XN, Win + (size_t)1280 * 1024, M, 2048, 1024}; S.init(M, 2048, G, bid); pg8::EpiGate E{Gt}; pg8::gemm_phase(ldsl, g, S, E); }
    GRID_SYNC();
    { pg8::Gemm g{O, Woa, M, 1024, 1024}; S.init(M, 1024, G, bid); pg8::EpiT1 E{Gt, F}; pg8::gemm_phase(ldsl, g, S, E); }
    { pg8::Gemm g{DP, Wp, M, 1024, 512}; S.init(M, 1024, G, bid); pg8::EpiMX E{Gt, F, XN}; pg8::gemm_phase(ldsl, g, S, E); }
    GRID_SYNC();
    { pg8::Gemm g{XN, Wout, M, 1024, 1024}; S.init(M, 1024, G, bid); pg8::EpiF32 E{F, 1024}; pg8::gemm_phase(ldsl, g, S, E); }
    GRID_SYNC();
    { PHASE_IDS();
    tr_job<TR_GU>(p.f2_wg, p.f2_wu, 1024, DFF, 5632, Wgu, scr, lane, gw, NGW);
    tr_job<TR_PLAIN>(p.f2_wd, nullptr, DFF, 1024, 1024, Wd, scr, lane, gw, NGW);
    rows_phase<1>(X, F, 1.0f, p.mix_post, p.f2_pre, X, XN, gw, NGW, lane); }
    GRID_SYNC();
    { pg8::Gemm g{XN, Wgu, M, 5632, 1024}; S.init(M, 5632, G, bid); pg8::EpiSwiGLU E{H}; pg8::gemm_phase(ldsl, g, S, E); }
    GRID_SYNC();
    { pg8::Gemm g{H, Wd, M, 1024, DFF}; S.init(M, 1024, G, bid); pg8::EpiF32 E{F, 1024}; pg8::gemm_phase(ldsl, g, S, E); }
    GRID_SYNC();
    { PHASE_IDS(); rows_phase<2>(X, F, 0.5f, p.f2_post, p.final_g, X, nullptr, gw, NGW, lane); }
}

extern "C" void kernel_launch(void* const* d_in, const int* in_sizes, int n_in, void* d_out, int out_size, void* d_ws, size_t ws_size, hipStream_t stream) {
    static int grid_blocks = 0;
    if (grid_blocks == 0) {
        if (n_in != 26 || in_sizes[0] != M * DM || out_size != M * DM || ws_size < WS_END) { fprintf(stderr, "kernel_launch: shape mismatch n_in %d in0 %d out %d ws %zu\n", n_in, n_in > 0 ? in_sizes[0] : -1, out_size, ws_size); grid_blocks = -1; return; }
        int dev = 0, cus = 0, per_cu = 0;
        (void)hipGetDevice(&dev);
        (void)hipDeviceGetAttribute(&cus, hipDeviceAttributeMultiprocessorCount, dev);
        if (hipFuncSetAttribute((const void*)fwd_megakernel, hipFuncAttributeMaxDynamicSharedMemorySize, LDS_BYTES) != hipSuccess) { fprintf(stderr, "kernel_launch: hipFuncSetAttribute failed\n"); grid_blocks = -1; return; }
        if (hipOccupancyMaxActiveBlocksPerMultiprocessor(&per_cu, (const void*)fwd_megakernel, NTHREADS, LDS_BYTES) != hipSuccess || per_cu < 1) { fprintf(stderr, "kernel_launch: occupancy query failed (%d)\n", per_cu); (void)hipGetLastError(); per_cu = 1; }
        grid_blocks = cus * 1;
        if (grid_blocks % 8 != 0) grid_blocks -= grid_blocks % 8;
    }
    if (grid_blocks < 0) return;
    Params p{};
    p.x = (const float*)d_in[0]; p.pos = (const int*)d_in[1];
    p.f1_pre = (const float*)d_in[2]; p.f1_wg = (const float*)d_in[3]; p.f1_wu = (const float*)d_in[4]; p.f1_wd = (const float*)d_in[5]; p.f1_post = (const float*)d_in[6];
    p.mix_pre = (const float*)d_in[7]; p.w_in = (const float*)d_in[8]; p.qa_g = (const float*)d_in[9]; p.w_uq = (const float*)d_in[10]; p.kva_g = (const float*)d_in[11];
    p.w_uk = (const float*)d_in[12]; p.w_uv = (const float*)d_in[13]; p.w_oa = (const float*)d_in[14]; p.pool_w = (const float*)d_in[15]; p.pool_scale = (const float*)d_in[16];
    p.w_op = (const float*)d_in[17]; p.w_out = (const float*)d_in[18]; p.mix_post = (const float*)d_in[19];
    p.f2_pre = (const float*)d_in[20]; p.f2_wg = (const float*)d_in[21]; p.f2_wu = (const float*)d_in[22]; p.f2_wd = (const float*)d_in[23]; p.f2_post = (const float*)d_in[24]; p.final_g = (const float*)d_in[25];
    p.out = (float*)d_out; p.ws = (unsigned char*)d_ws;
    for (int i = 0; i < 32; ++i) p.inv_freq[i] = (float)pow(10000.0, -(2.0 * i) / 64.0);
    if (hipMemsetAsync((char*)d_ws + WS_END, 0, 256, stream) != hipSuccess) { fprintf(stderr, "kernel_launch: memset failed\n"); return; }
    void* args[] = {&p};
    hipError_t e = hipLaunchCooperativeKernel((const void*)fwd_megakernel, dim3(grid_blocks), dim3(NTHREADS), args, LDS_BYTES, stream);
    if (e != hipSuccess) fprintf(stderr, "cooperative launch failed: %s (grid %d)\n", hipGetErrorString(e), grid_blocks);
}
```

```cpp
#include <hip/hip_runtime.h>
#include <hip/hip_cooperative_groups.h>
#include <cstdio>
#include <cmath>
#include <cstdint>
namespace cg = cooperative_groups;

#define LAS __attribute__((address_space(3)))
typedef unsigned short bf16_t;
typedef short bf16x8 __attribute__((ext_vector_type(8)));
typedef short s16x4 __attribute__((ext_vector_type(4)));
typedef float f32x2 __attribute__((ext_vector_type(2)));
typedef float f32x4 __attribute__((ext_vector_type(4)));
typedef float f32x16 __attribute__((ext_vector_type(16)));
typedef unsigned u32x4 __attribute__((ext_vector_type(4)));
typedef unsigned u32x2 __attribute__((ext_vector_type(2)));

constexpr int DM = 1024, NB = 8, SEQ = 2048, M = NB * SEQ, NH = 8, QL = 384, KVL = 256, DFF = 2816, INW = 3264;
constexpr float EPS = 1e-6f;
constexpr int NTHREADS = 512, NWAVES = 8;
constexpr int LDS_BYTES = 131072;

constexpr size_t MiB = 1048576;
constexpr size_t OFF_WGU = 0;
constexpr size_t OFF_WD = OFF_WGU + (size_t)5632 * 1024 * 2;
constexpr size_t OFF_WIN = OFF_WD + (size_t)1024 * 2816 * 2;
constexpr size_t OFF_WUQ = OFF_WIN + (size_t)3328 * 1024 * 2;
constexpr size_t OFF_WUKV = OFF_WUQ + (size_t)1536 * 384 * 2;
constexpr size_t OFF_WOA = OFF_WUKV + (size_t)2048 * 256 * 2;
constexpr size_t OFF_WP = OFF_WOA + (size_t)1024 * 1024 * 2;
constexpr size_t OFF_WOUT = OFF_WP + (size_t)1024 * 512 * 2;
constexpr size_t OFF_XN = OFF_WOUT + (size_t)1024 * 1024 * 2;
constexpr size_t OFF_R = OFF_XN + 32 * MiB;
constexpr size_t OFF_F = OFF_R;
constexpr size_t OFF_ZF = OFF_R;
constexpr size_t OFF_KV = OFF_R;
constexpr size_t OFF_H = OFF_R + 64 * MiB;
constexpr size_t OFF_O = OFF_R + 64 * MiB;
constexpr size_t OFF_CQN = OFF_R + 80 * MiB;
constexpr size_t OFF_CKVN = OFF_R + 92 * MiB;
constexpr size_t OFF_TAB = OFF_R + 100 * MiB;
constexpr size_t OFF_Q = OFF_R + 104 * MiB;
constexpr size_t OFF_KR = OFF_R + 152 * MiB;
constexpr size_t OFF_G = OFF_R + 96 * MiB;
constexpr size_t OFF_DP = OFF_R + 176 * MiB;
constexpr size_t WS_END = OFF_R + 192 * MiB;
static_assert(WS_END + 256 <= 256 * MiB, "workspace");

struct Params {
    const float* x; const int* pos;
    const float *f1_pre, *f1_wg, *f1_wu, *f1_wd, *f1_post;
    const float *mix_pre, *w_in, *qa_g, *w_uq, *kva_g, *w_uk, *w_uv, *w_oa, *pool_w, *pool_scale, *w_op, *w_out, *mix_post;
    const float *f2_pre, *f2_wg, *f2_wu, *f2_wd, *f2_post, *final_g;
    float* out; unsigned char* ws;
    float inv_freq[32];
};

typedef __bf16 bf16x2_t __attribute__((ext_vector_type(2)));
__device__ __forceinline__ unsigned cvt_pk_bf16(float lo, float hi) { const f32x2 v = {lo, hi}; const bf16x2_t r = __builtin_convertvector(v, bf16x2_t); return __builtin_bit_cast(unsigned, r); }
__device__ __forceinline__ float bf_lo(unsigned w) { return __uint_as_float(w << 16); }
__device__ __forceinline__ float bf_hi(unsigned w) { return __uint_as_float(w & 0xffff0000u); }
__device__ __forceinline__ float sigmoidf_fast(float z) { return __builtin_amdgcn_rcpf(1.f + __builtin_amdgcn_exp2f(-1.4426950408889634f * z)); }
__device__ __forceinline__ int fresh_tid() { int t = threadIdx.x; asm volatile("" : "+v"(t)); return t; }
__device__ __forceinline__ float wave_sum(float v) {
#pragma unroll
    for (int o = 1; o < 64; o <<= 1) v += __shfl_xor(v, o);
    return v;
}

namespace pg8 {
constexpr int BM = 256, BK = 64, HALF = 128, HTB = HALF * BK * 2, STAGE_BYTES = 8 * HTB, NXCD = 8, WGM = 8;
__host__ __device__ __forceinline__ int lds_byte(int r, int c) { const int st = (r >> 4) * 2 + (c >> 5), rr = r & 15, cc = c & 31, ob = rr * 64 + cc * 2; return st * 1024 + (ob ^ (((ob >> 9) & 1) << 5)); }
__host__ __device__ __forceinline__ void stage_rc(int b, int& R, int& C) { const int st = b / 1024, sb = b % 1024, swz = sb ^ (((sb >> 9) & 1) << 5); R = (st >> 1) * 16 + swz / 64; C = (st & 1) * 32 + (swz % 64) / 2; }
__host__ __device__ __forceinline__ int perm32(int rho) { const int n = rho >> 4, i = rho & 15; return 8 * (i >> 2) + 4 * n + (i & 3); }
struct Unit { int pm, pn; };
struct Gemm { const bf16_t* A; const bf16_t* Bt; int M, N, K; };
struct StaticOrder {
    int nM, nN, nwg, G, c;
    __device__ void init(int M_, int N_, int G_, int c_) { nM = M_ / BM; nN = N_ / BM; nwg = nM * nN; G = G_; c = c_; }
    __device__ bool next(int i, Unit& u) const {
        const long L = (long)i * G + c; if (L >= nwg) return false;
        int wgid = (int)L; { const int q = nwg / NXCD, r = nwg % NXCD, xcd = wgid % NXCD, off = wgid / NXCD; wgid = (xcd < r ? xcd * (q + 1) : r * (q + 1) + (xcd - r) * q) + off; }
        const int nig = WGM * nN, gid = wgid / nig, fm = gid * WGM, gsz = (nM - fm) < WGM ? (nM - fm) : WGM;
        u.pm = fm + ((wgid % nig) % gsz); u.pn = (wgid % nig) / gsz; return true;
    }
};

template <class Epi>
__device__ __forceinline__ void gemm_phase(LAS unsigned char* lds, const Gemm g, const StaticOrder& S, const Epi& E) {
    const int tid = fresh_tid(), wid = __builtin_amdgcn_readfirstlane(tid >> 6), lane = tid & 63, wr = wid >> 2, wc = wid & 3, fr = lane & 15, fq = lane >> 4;
    const int K = g.K, nt = K / BK;
    unsigned voffA[2], voffB[2];
#pragma unroll
    for (int i = 0; i < 2; ++i) { int R, C; stage_rc(tid * 16 + i * 8192, R, C); const int Rb = Epi::PERM ? ((R & ~31) + perm32(R & 31)) : R;
        voffA[i] = (unsigned)(R * K + C) * 2u; voffB[i] = (unsigned)(Rb * K + C) * 2u; }
    const size_t kstep = (size_t)(BK * 2);
    const size_t hstep = (size_t)HALF * K * 2;
    const size_t tstep = 2 * hstep;
    const unsigned ldsw = (unsigned)wid * 1024u;
    const int aoff = lds_byte(wr * 64 + fr, fq * 8), boff = lds_byte(wc * 32 + fr, fq * 8);
#define PG8_SA(b, h) (((b) * 2 + (h)) * HTB)
#define PG8_SB(b, h) ((4 + (b) * 2 + (h)) * HTB)
#define PG8_STAGE(bufoff, gbase, voff) do { _Pragma("unroll") for (int _i = 0; _i < 2; ++_i) \
        __builtin_amdgcn_global_load_lds((const unsigned*)((const char*)(gbase) + (voff)[_i]), (LAS unsigned*)(lds + (bufoff) + ldsw + _i * 8192), 16, 0, 0); } while (0)
#define PG8_LDA(dst, b, h) do { _Pragma("unroll") for (int m = 0; m < 4; ++m) _Pragma("unroll") for (int k = 0; k < 2; ++k) dst[m][k] = *(const LAS bf16x8*)(lds + PG8_SA(b, h) + aoff + m * 2048 + k * 1024); } while (0)
#define PG8_LDB(dst, b, h) do { _Pragma("unroll") for (int n = 0; n < 2; ++n) _Pragma("unroll") for (int k = 0; k < 2; ++k) dst[n][k] = *(const LAS bf16x8*)(lds + PG8_SB(b, h) + boff + n * 2048 + k * 1024); } while (0)
#define PG8_MMA(ai, bj, At, Bt) do { __builtin_amdgcn_s_setprio(1); _Pragma("unroll") for (int m = 0; m < 4; ++m) _Pragma("unroll") for (int n = 0; n < 2; ++n) _Pragma("unroll") for (int k = 0; k < 2; ++k) \
        acc[ai][bj][m][n] = __builtin_amdgcn_mfma_f32_16x16x32_bf16(Bt[n][k], At[m][k], acc[ai][bj][m][n], 0, 0, 0); __builtin_amdgcn_s_setprio(0); } while (0)
#define PG8_WAIT_V(n) asm volatile("s_waitcnt vmcnt(" #n ")" ::: "memory")
#define PG8_WAIT_L(n) asm volatile("s_waitcnt lgkmcnt(" #n ")" ::: "memory")
#define PG8_BAR __builtin_amdgcn_s_barrier()
#define PG8_SCHED __builtin_amdgcn_sched_barrier(0)
    Unit cur, nxt; int ui = 0;
    if (!S.next(0, cur)) return;
    f32x4 acc[2][2][4][2];
#pragma unroll
    for (int a = 0; a < 2; ++a)
#pragma unroll
        for (int b = 0; b < 2; ++b)
#pragma unroll
            for (int m = 0; m < 4; ++m)
#pragma unroll
                for (int n = 0; n < 2; ++n) acc[a][b][m][n] = (f32x4){0.f, 0.f, 0.f, 0.f};
    bf16x8 At[4][2], B0[2][2], B1[2][2];
    const char* cA = (const char*)g.A + (size_t)cur.pm * tstep; const char* cB = (const char*)g.Bt + (size_t)cur.pn * tstep;
    PG8_STAGE(PG8_SB(0, 0), cB, voffB); PG8_STAGE(PG8_SA(0, 0), cA, voffA); PG8_STAGE(PG8_SB(0, 1), cB + hstep, voffB); PG8_STAGE(PG8_SA(0, 1), cA + hstep, voffA);
    if (wr == 1) PG8_BAR;
    PG8_WAIT_V(4); PG8_BAR;
    PG8_STAGE(PG8_SB(1, 0), cB + kstep, voffB); PG8_STAGE(PG8_SA(1, 0), cA + kstep, voffA); PG8_STAGE(PG8_SB(1, 1), cB + hstep + kstep, voffB);
    PG8_WAIT_V(6); PG8_BAR;
    for (;;) {
        const bool has_next = S.next(ui + 1, nxt);
        const char* nA = has_next ? (const char*)g.A + (size_t)nxt.pm * tstep : cA; const char* nB = has_next ? (const char*)g.Bt + (size_t)nxt.pn * tstep : cB;
        for (int t = 0; t < nt; t += 2) {
            const bool last = (t == nt - 2);
            const char* a1 = cA + (size_t)(t + 1) * kstep;
            const char* a2 = last ? nA : cA + (size_t)(t + 2) * kstep; const char* b2 = last ? nB : cB + (size_t)(t + 2) * kstep;
            const char* a3 = a2 + kstep; const char* b3 = b2 + kstep;
            PG8_LDB(B0, 0, 0); PG8_SCHED; PG8_LDA(At, 0, 0); PG8_STAGE(PG8_SA(1, 1), a1 + hstep, voffA);
            PG8_WAIT_L(8); PG8_BAR; PG8_WAIT_L(0); PG8_MMA(0, 0, At, B0); PG8_BAR; PG8_SCHED;
            PG8_LDB(B1, 0, 1); PG8_STAGE(PG8_SB(0, 0), b2, voffB);
            PG8_BAR; PG8_WAIT_L(0); PG8_MMA(0, 1, At, B1); PG8_BAR;
            PG8_LDA(At, 0, 1); PG8_STAGE(PG8_SA(0, 0), a2, voffA);
            PG8_BAR; PG8_WAIT_L(0); PG8_MMA(1, 0, At, B0); PG8_BAR; PG8_SCHED;
            PG8_STAGE(PG8_SB(0, 1), b2 + hstep, voffB);
            PG8_WAIT_V(6); PG8_BAR; PG8_MMA(1, 1, At, B1); PG8_BAR;
            PG8_LDB(B0, 1, 0); PG8_SCHED; PG8_LDA(At, 1, 0); PG8_STAGE(PG8_SA(0, 1), a2 + hstep, voffA);
            PG8_WAIT_L(8); PG8_BAR; PG8_WAIT_L(0); PG8_MMA(0, 0, At, B0); PG8_BAR; PG8_SCHED;
            PG8_LDB(B1, 1, 1); PG8_STAGE(PG8_SB(1, 0), b3, voffB);
            PG8_BAR; PG8_WAIT_L(0); PG8_MMA(0, 1, At, B1); PG8_BAR;
            PG8_LDA(At, 1, 1); PG8_STAGE(PG8_SA(1, 0), a3, voffA);
            PG8_BAR; PG8_WAIT_L(0); PG8_MMA(1, 0, At, B0); PG8_BAR; PG8_SCHED;
            PG8_STAGE(PG8_SB(1, 1), b3 + hstep, voffB);
            PG8_WAIT_V(6); PG8_BAR; PG8_MMA(1, 1, At, B1); PG8_BAR;
        }
        { const int t2 = fresh_tid(); E(acc, cur, wr, wc, t2 & 15, (t2 >> 4) & 3); }
        if (!has_next) break;
#pragma unroll
        for (int a = 0; a < 2; ++a)
#pragma unroll
            for (int b = 0; b < 2; ++b)
#pragma unroll
                for (int m = 0; m < 4; ++m)
#pragma unroll
                    for (int n = 0; n < 2; ++n) acc[a][b][m][n] = (f32x4){0.f, 0.f, 0.f, 0.f};
        cur = nxt; cA = nA; cB = nB; ++ui;
    }
    PG8_WAIT_V(0);
    if (wr == 0) PG8_BAR;
    PG8_BAR;
#undef PG8_SA
#undef PG8_SB
#undef PG8_STAGE
#undef PG8_LDA
#undef PG8_LDB
#undef PG8_MMA
#undef PG8_WAIT_V
#undef PG8_WAIT_L
#undef PG8_BAR
#undef PG8_SCHED
}

typedef f32x4 Acc[2][2][4][2];
struct EpiF32 {
    static constexpr bool PERM = false;
    float* C; int ldc;
    __device__ __forceinline__ void operator()(const Acc& acc, const Unit& u, int wr, int wc, int fr, int fq) const {
        const int row0 = u.pm * BM + wr * 64 + fr, col0 = u.pn * BM + wc * 32 + 4 * fq;
#pragma unroll
        for (int ai = 0; ai < 2; ++ai)
#pragma unroll
            for (int m = 0; m < 4; ++m) { float* rowp = C + (size_t)(row0 + ai * HALF + m * 16) * ldc + col0;
#pragma unroll
                for (int bj = 0; bj < 2; ++bj)
#pragma unroll
                    for (int n = 0; n < 2; ++n) *(f32x4*)(rowp + bj * HALF + n * 16) = acc[ai][bj][m][n]; }
    }
};
struct EpiBf16 {
    static constexpr bool PERM = true;
    bf16_t* O; int ldc;
    __device__ __forceinline__ void operator()(const Acc& acc, const Unit& u, int wr, int wc, int fr, int fq) const {
        const int row0 = u.pm * BM + wr * 64 + fr, col0 = u.pn * BM + wc * 32 + 8 * fq;
#pragma unroll
        for (int ai = 0; ai < 2; ++ai)
#pragma unroll
            for (int m = 0; m < 4; ++m) { bf16_t* rowp = O + (size_t)(row0 + ai * HALF + m * 16) * ldc + col0;
#pragma unroll
                for (int bj = 0; bj < 2; ++bj) { const f32x4 v0 = acc[ai][bj][m][0], v1 = acc[ai][bj][m][1];
                    u32x4 w; w.x = cvt_pk_bf16(v0[0], v0[1]); w.y = cvt_pk_bf16(v0[2], v0[3]); w.z = cvt_pk_bf16(v1[0], v1[1]); w.w = cvt_pk_bf16(v1[2], v1[3]);
                    *(u32x4*)(rowp + bj * HALF) = w; } }
    }
};
struct EpiSwiGLU {
    static constexpr bool PERM = true;
    bf16_t* H;
    __device__ __forceinline__ void operator()(const Acc& acc, const Unit& u, int wr, int wc, int fr, int fq) const {
        const int row0 = u.pm * BM + wr * 64 + fr, col0 = u.pn * HALF + wc * 32 + 8 * fq;
#pragma unroll
        for (int ai = 0; ai < 2; ++ai)
#pragma unroll
            for (int m = 0; m < 4; ++m) { bf16_t* rowp = H + (size_t)(row0 + ai * HALF + m * 16) * DFF + col0;
                float h[8];
#pragma unroll
                for (int n = 0; n < 2; ++n)
#pragma unroll
                    for (int j = 0; j < 4; ++j) { const float gt = acc[ai][0][m][n][j], up = acc[ai][1][m][n][j]; h[n * 4 + j] = gt * sigmoidf_fast(gt) * up; }
                u32x4 w; w.x = cvt_pk_bf16(h[0], h[1]); w.y = cvt_pk_bf16(h[2], h[3]); w.z = cvt_pk_bf16(h[4], h[5]); w.w = cvt_pk_bf16(h[6], h[7]);
                *(u32x4*)rowp = w; }
    }
};
struct EpiGate {
    static constexpr bool PERM = true;
    bf16_t* G;
    __device__ __forceinline__ void operator()(const Acc& acc, const Unit& u, int wr, int wc, int fr, int fq) const {
        const int row0 = u.pm * BM + wr * 64 + fr, col0 = u.pn * BM + wc * 32 + 8 * fq;
#pragma unroll
        for (int ai = 0; ai < 2; ++ai)
#pragma unroll
            for (int m = 0; m < 4; ++m) { bf16_t* rowp = G + (size_t)(row0 + ai * HALF + m * 16) * 2048 + col0;
#pragma unroll
                for (int bj = 0; bj < 2; ++bj) { const f32x4 v0 = acc[ai][bj][m][0], v1 = acc[ai][bj][m][1];
                    u32x4 w; w.x = cvt_pk_bf16(sigmoidf_fast(v0[0]), sigmoidf_fast(v0[1])); w.y = cvt_pk_bf16(sigmoidf_fast(v0[2]), sigmoidf_fast(v0[3]));
                    w.z = cvt_pk_bf16(sigmoidf_fast(v1[0]), sigmoidf_fast(v1[1])); w.w = cvt_pk_bf16(sigmoidf_fast(v1[2]), sigmoidf_fast(v1[3]));
                    *(u32x4*)(rowp + bj * HALF) = w; } }
    }
};
struct EpiQ {
    static constexpr bool PERM = true;
    bf16_t* Q; const float* TAB;
    __device__ __forceinline__ void operator()(const Acc& acc, const Unit& u, int wr, int wc, int fr, int fq) const {
        const int row0 = u.pm * BM + wr * 64 + fr, col0 = u.pn * BM + wc * 32 + 8 * fq;
#pragma unroll
        for (int ai = 0; ai < 2; ++ai)
#pragma unroll
            for (int m = 0; m < 4; ++m) { const int row = row0 + ai * HALF + m * 16; bf16_t* rowp = Q + (size_t)row * 1536 + col0;
#pragma unroll
                for (int bj = 0; bj < 2; ++bj) { f32x4 v0 = acc[ai][bj][m][0], v1 = acc[ai][bj][m][1];
                    const int c = col0 + bj * HALF, w = c % 192;
                    if (w >= 128) { const int i0 = (w - 128) >> 1; const f32x4 cs = *(const f32x4*)(TAB + (size_t)row * 64 + i0), sn = *(const f32x4*)(TAB + (size_t)row * 64 + 32 + i0);
                        f32x4 r0, r1;
                        r0[0] = v0[0] * cs[0] - v0[1] * sn[0]; r0[1] = v0[1] * cs[0] + v0[0] * sn[0];
                        r0[2] = v0[2] * cs[1] - v0[3] * sn[1]; r0[3] = v0[3] * cs[1] + v0[2] * sn[1];
                        r1[0] = v1[0] * cs[2] - v1[1] * sn[2]; r1[1] = v1[1] * cs[2] + v1[0] * sn[2];
                        r1[2] = v1[2] * cs[3] - v1[3] * sn[3]; r1[3] = v1[3] * cs[3] + v1[2] * sn[3];
                        v0 = r0; v1 = r1; }
                    u32x4 wv; wv.x = cvt_pk_bf16(v0[0], v0[1]); wv.y = cvt_pk_bf16(v0[2], v0[3]); wv.z = cvt_pk_bf16(v1[0], v1[1]); wv.w = cvt_pk_bf16(v1[2], v1[3]);
                    *(u32x4*)(rowp + bj * HALF) = wv; } }
    }
};
struct EpiT1 {
    static constexpr bool PERM = true;
    const bf16_t* G; bf16_t* F;
    __device__ __forceinline__ void operator()(const Acc& acc, const Unit& u, int wr, int wc, int fr, int fq) const {
        const int row0 = u.pm * BM + wr * 64 + fr, col0 = u.pn * BM + wc * 32 + 8 * fq;
#pragma unroll
        for (int ai = 0; ai < 2; ++ai)
#pragma unroll
            for (int m = 0; m < 4; ++m) { const int row = row0 + ai * HALF + m * 16;
#pragma unroll
                for (int bj = 0; bj < 2; ++bj) { const f32x4 v0 = acc[ai][bj][m][0], v1 = acc[ai][bj][m][1]; const int c = col0 + bj * HALF;
                    const u32x4 gw = *(const u32x4*)(G + (size_t)row * 2048 + c);
                    u32x4 wv;
                    wv.x = cvt_pk_bf16(v0[0] * bf_lo(gw.x), v0[1] * bf_hi(gw.x)); wv.y = cvt_pk_bf16(v0[2] * bf_lo(gw.y), v0[3] * bf_hi(gw.y));
                    wv.z = cvt_pk_bf16(v1[0] * bf_lo(gw.z), v1[1] * bf_hi(gw.z)); wv.w = cvt_pk_bf16(v1[2] * bf_lo(gw.w), v1[3] * bf_hi(gw.w));
                    *(u32x4*)(F + (size_t)row * 1024 + c) = wv; } }
    }
};
struct EpiMX {
    static constexpr bool PERM = true;
    const bf16_t* G; const bf16_t* F; bf16_t* MX;
    __device__ __forceinline__ void operator()(const Acc& acc, const Unit& u, int wr, int wc, int fr, int fq) const {
        const int row0 = u.pm * BM + wr * 64 + fr, col0 = u.pn * BM + wc * 32 + 8 * fq;
#pragma unroll
        for (int ai = 0; ai < 2; ++ai)
#pragma unroll
            for (int m = 0; m < 4; ++m) { const int row = row0 + ai * HALF + m * 16;
#pragma unroll
                for (int bj = 0; bj < 2; ++bj) { const f32x4 v0 = acc[ai][bj][m][0], v1 = acc[ai][bj][m][1]; const int c = col0 + bj * HALF;
                    const u32x4 gw = *(const u32x4*)(G + (size_t)row * 2048 + 1024 + c);
                    const u32x4 tw = *(const u32x4*)(F + (size_t)row * 1024 + c);
                    u32x4 wv;
                    wv.x = cvt_pk_bf16(bf_lo(tw.x) + v0[0] * bf_lo(gw.x), bf_hi(tw.x) + v0[1] * bf_hi(gw.x)); wv.y = cvt_pk_bf16(bf_lo(tw.y) + v0[2] * bf_lo(gw.y), bf_hi(tw.y) + v0[3] * bf_hi(gw.y));
                    wv.z = cvt_pk_bf16(bf_lo(tw.z) + v1[0] * bf_lo(gw.z), bf_hi(tw.z) + v1[1] * bf_hi(gw.z)); wv.w = cvt_pk_bf16(bf_lo(tw.w) + v1[2] * bf_lo(gw.w), bf_hi(tw.w) + v1[3] * bf_hi(gw.w));
                    *(u32x4*)(MX + (size_t)row * 1024 + c) = wv; } }
    }
};
}

namespace att {
constexpr int NW = 8, QBLK = 32, KVBLK = 64;
constexpr float SCALE = 0.07216878364870322f;
constexpr float THR = 8.f;
constexpr int LDQ = 1536, LDKV = 2048, LDKR = 64, LDO = 1024;
constexpr int SHM_V = 64 * 128 * 2, SHM_K = 64 * 128 * 2, SHM_R = 64 * 64 * 2;
constexpr int NQL = 4;
constexpr int OFF_V = 0, OFF_K = 2 * SHM_V, OFF_RP = OFF_K + 2 * SHM_K, OFF_WS = OFF_RP + 2 * SHM_R, OFF_QL = OFF_WS + NW * 64 * 4, SHM_ATTN = OFF_QL + NW * NQL * 1024;
static_assert(SHM_ATTN <= LDS_BYTES, "lds");
#define KSWZ(row, colB) ((row) * 256 + ((colB) ^ (((row) & 7) << 4)))
#define RSWZ(row, colB) ((row) * 128 + ((colB) ^ (((row) & 7) << 4)))
#define SBAR() __builtin_amdgcn_sched_barrier(0)
__device__ __forceinline__ int crow(int r, int hi) { return (r & 3) + 8 * (r >> 2) + 4 * hi; }
__device__ __forceinline__ bf16x8 ld8(const bf16_t* p) { return *reinterpret_cast<const bf16x8*>(p); }

__device__ __forceinline__ void partialSM(f32x16& p0, f32x16& p1, float& m_reg, float& mn, float& alpha) {
    constexpr float C = SCALE * 1.4426950408889634f;
    float pmax = p0[0];
#pragma unroll
    for (int r = 1; r < 16; ++r) pmax = fmaxf(pmax, p0[r]);
#pragma unroll
    for (int r = 0; r < 16; ++r) pmax = fmaxf(pmax, p1[r]);
    { auto rr = __builtin_amdgcn_permlane32_swap(__float_as_uint(pmax), __float_as_uint(pmax), false, false);
      pmax = fmaxf(__uint_as_float(rr[0]), __uint_as_float(rr[1])); }
    if (__builtin_expect(__all(pmax - m_reg <= THR / SCALE), 1)) { mn = m_reg; alpha = 1.f; }
    else { mn = fmaxf(m_reg, pmax); alpha = __builtin_amdgcn_exp2f((m_reg - mn) * C); m_reg = mn; }
    float mnC = -mn * C;
#pragma unroll
    for (int r = 0; r < 16; ++r) p0[r] = fmaf(p0[r], C, mnC);
#pragma unroll
    for (int r = 0; r < 16; ++r) p1[r] = fmaf(p1[r], C, mnC);
#pragma unroll
    for (int r = 0; r < 16; ++r) p0[r] = __builtin_amdgcn_exp2f(p0[r]);
}
__device__ __forceinline__ void finishSM(f32x16& p0, f32x16& p1, float alpha, float& l_reg, bf16x8& pa0, bf16x8& pa1, bf16x8& pa2, bf16x8& pa3) {
#pragma unroll
    for (int r = 0; r < 16; ++r) p1[r] = __builtin_amdgcn_exp2f(p1[r]);
    float ps = 0;
#pragma unroll
    for (int r = 0; r < 16; ++r) ps += p0[r];
#pragma unroll
    for (int r = 0; r < 16; ++r) ps += p1[r];
    { auto rr = __builtin_amdgcn_permlane32_swap(__float_as_uint(ps), __float_as_uint(ps), false, false);
      ps = __uint_as_float(rr[0]) + __uint_as_float(rr[1]); }
    l_reg = l_reg * alpha + ps;
#define PK4(P, BASE, OUT) do { unsigned a0 = cvt_pk_bf16(P[BASE + 0], P[BASE + 1]), a1 = cvt_pk_bf16(P[BASE + 2], P[BASE + 3]);   \
    unsigned b0 = cvt_pk_bf16(P[BASE + 4], P[BASE + 5]), b1 = cvt_pk_bf16(P[BASE + 6], P[BASE + 7]);                              \
    auto r0 = __builtin_amdgcn_permlane32_swap(a0, b0, false, false); auto r1 = __builtin_amdgcn_permlane32_swap(a1, b1, false, false); \
    u32x4 w = {r0[0], r1[0], r0[1], r1[1]}; OUT = *reinterpret_cast<bf16x8*>(&w); } while (0)
    PK4(p0, 0, pa0); PK4(p0, 8, pa1); PK4(p1, 0, pa2); PK4(p1, 8, pa3);
#undef PK4
}
__device__ __forceinline__ void qkt(f32x16& p0, f32x16& p1, const char* Ks, const char* Rs, const bf16x8* qr, const char* ql, int r32, int hi) {
    p0 = f32x16{}; p1 = f32x16{};
#pragma unroll
    for (int d0 = 0; d0 < 8; ++d0) { int cb = (d0 * 16 + hi * 8) * 2;
        bf16x8 b0 = *reinterpret_cast<const bf16x8*>(Ks + KSWZ(r32, cb));
        bf16x8 b1 = *reinterpret_cast<const bf16x8*>(Ks + KSWZ(32 + r32, cb));
        p0 = __builtin_amdgcn_mfma_f32_32x32x16_bf16(b0, qr[d0], p0, 0, 0, 0);
        p1 = __builtin_amdgcn_mfma_f32_32x32x16_bf16(b1, qr[d0], p1, 0, 0, 0); }
#pragma unroll
    for (int d0 = 0; d0 < 4; ++d0) { int cb = (d0 * 16 + hi * 8) * 2;
        bf16x8 b0 = *reinterpret_cast<const bf16x8*>(Rs + RSWZ(r32, cb));
        bf16x8 b1 = *reinterpret_cast<const bf16x8*>(Rs + RSWZ(32 + r32, cb));
        const bf16x8 qv = *reinterpret_cast<const bf16x8*>(ql + d0 * 1024);
        p0 = __builtin_amdgcn_mfma_f32_32x32x16_bf16(b0, qv, p0, 0, 0, 0);
        p1 = __builtin_amdgcn_mfma_f32_32x32x16_bf16(b1, qv, p1, 0, 0, 0); }
}
__device__ __forceinline__ int v_st(int k, int c) { const int kk = (k & ~0xC) | ((k & 4) << 1) | ((k & 8) >> 1); return ((kk >> 3) * 4 + (c >> 5)) * 512 + ((kk & 7) * 32 + (c & 31)) * 2; }
__device__ __forceinline__ int v_rd_base(int lane) { return ((lane & 3) << 3) | (((lane >> 2) & 3) << 6) | (((lane >> 4) & 1) << 5) | (((lane >> 5) & 1) << 8); }
constexpr int v_rd_off(int d0, int ks, int half) { return d0 * 512 + ks * 4096 + half * 2048; }
template <int OFF> __device__ __forceinline__ s16x4 tr_read(int vb) {
    s16x4 r; asm volatile("ds_read_b64_tr_b16 %0, %1 offset:%2" : "=&v"(r) : "v"(vb), "i"(OFF) : "memory"); return r;
}
template <int D0> __device__ __forceinline__ void pv_one(f32x16& od, int vb, bf16x8 pa0, bf16x8 pa1, bf16x8 pa2, bf16x8 pa3) {
    const s16x4 l0 = tr_read<v_rd_off(D0, 0, 0)>(vb), h0 = tr_read<v_rd_off(D0, 0, 1)>(vb), l1 = tr_read<v_rd_off(D0, 1, 0)>(vb), h1 = tr_read<v_rd_off(D0, 1, 1)>(vb);
    const s16x4 l2 = tr_read<v_rd_off(D0, 2, 0)>(vb), h2 = tr_read<v_rd_off(D0, 2, 1)>(vb), l3 = tr_read<v_rd_off(D0, 3, 0)>(vb), h3 = tr_read<v_rd_off(D0, 3, 1)>(vb);
    asm volatile("s_waitcnt lgkmcnt(0)" ::: "memory"); SBAR();
#define PK(L, H) (bf16x8){L[0], L[1], L[2], L[3], H[0], H[1], H[2], H[3]}
    od = __builtin_amdgcn_mfma_f32_32x32x16_bf16(pa0, PK(l0, h0), od, 0, 0, 0);
    od = __builtin_amdgcn_mfma_f32_32x32x16_bf16(pa1, PK(l1, h1), od, 0, 0, 0);
    od = __builtin_amdgcn_mfma_f32_32x32x16_bf16(pa2, PK(l2, h2), od, 0, 0, 0);
    od = __builtin_amdgcn_mfma_f32_32x32x16_bf16(pa3, PK(l3, h3), od, 0, 0, 0);
#undef PK
}
__device__ __forceinline__ void pv_d0(f32x16* o, int vb, bf16x8 pa0, bf16x8 pa1, bf16x8 pa2, bf16x8 pa3) {
    pv_one<0>(o[0], vb, pa0, pa1, pa2, pa3); pv_one<1>(o[1], vb, pa0, pa1, pa2, pa3); pv_one<2>(o[2], vb, pa0, pa1, pa2, pa3); pv_one<3>(o[3], vb, pa0, pa1, pa2, pa3);
}

__device__ __forceinline__ void attn_body(const bf16_t* __restrict__ Qb, const bf16_t* __restrict__ Kn, const bf16_t* __restrict__ Kr, const bf16_t* __restrict__ Vh,
                                          bf16_t* __restrict__ Ob, int seq, char* lds) {
    const int tid = fresh_tid(), wid = tid >> 6, lane = tid & 63, r32 = lane & 31, hi = lane >> 5;
    char* V_lds = lds + OFF_V; char* K_lds = lds + OFF_K; char* R_lds = lds + OFF_RP;
    float* ws = (float*)(lds + OFF_WS) + wid * 64; float* li_l = ws; float* al_l = ws + 32;
    float m_reg = -1e30f, l_reg = 0; f32x16 o[4] = {}; bf16x8 qr[8];
    char* ql = lds + OFF_QL + wid * (NQL * 1024) + lane * 16;
    const bf16_t* Qw = Qb + (long)(wid * QBLK + r32) * LDQ + hi * 8;
#pragma unroll
    for (int d0 = 0; d0 < 8; ++d0) qr[d0] = ld8(Qw + d0 * 16);
#pragma unroll
    for (int d0 = 0; d0 < NQL; ++d0) *reinterpret_cast<bf16x8*>(ql + d0 * 1024) = ld8(Qw + (8 + d0) * 16);
    const int sr = tid >> 4, sc = (tid & 15) * 8, vst0 = v_st(sr, sc), vst1 = v_st(32 + sr, sc);
    const int rr_ = tid >> 3, rc_ = (tid & 7) * 8;
    const int vb0 = (int)(uintptr_t)V_lds + v_rd_base(lane);
    bf16x8 vs0, vs1, ks0, ks1, rs0;
#define SLOAD(k0) do { vs0 = ld8(&Vh[(long)((k0) + sr) * LDKV + sc]); vs1 = ld8(&Vh[(long)((k0) + 32 + sr) * LDKV + sc]); \
    ks0 = ld8(&Kn[(long)((k0) + sr) * LDKV + sc]); ks1 = ld8(&Kn[(long)((k0) + 32 + sr) * LDKV + sc]); rs0 = ld8(&Kr[(long)((k0) + rr_) * LDKR + rc_]); } while (0)
#define SWRITE(b) do { *(bf16x8*)(V_lds + (b) * SHM_V + vst0) = vs0; *(bf16x8*)(V_lds + (b) * SHM_V + vst1) = vs1; int kc = sc * 2; \
    *(bf16x8*)(K_lds + (b) * SHM_K + KSWZ(sr, kc)) = ks0; *(bf16x8*)(K_lds + (b) * SHM_K + KSWZ(32 + sr, kc)) = ks1; \
    *(bf16x8*)(R_lds + (b) * SHM_R + RSWZ(rr_, rc_ * 2)) = rs0; } while (0)
#define RESC(a) do { if (__any((a) < 1.f)) { if (hi == 0) al_l[r32] = (a); asm volatile("s_waitcnt lgkmcnt(0)" ::: "memory"); \
    _Pragma("unroll") for (int d = 0; d < 4; ++d) _Pragma("unroll") for (int r = 0; r < 16; ++r) o[d][r] *= al_l[crow(r, hi)]; } } while (0)
    f32x16 pA0, pA1, pB0, pB1; float mnA, mnB, alA, alB; bf16x8 pa0, pa1, pa2, pa3; const int NT = seq / KVBLK;
    SLOAD(0); asm volatile("s_waitcnt vmcnt(0)" ::: "memory"); SWRITE(0); __syncthreads();
    qkt(pA0, pA1, K_lds, R_lds, qr, ql, r32, hi); partialSM(pA0, pA1, m_reg, mnA, alA);
    SLOAD(KVBLK);
    asm volatile("s_waitcnt vmcnt(0)" ::: "memory"); SWRITE(1); __syncthreads();
    for (int j = 1; j + 1 < NT; j += 2) {
        SBAR(); qkt(pB0, pB1, K_lds + SHM_K, R_lds + SHM_R, qr, ql, r32, hi);
        finishSM(pA0, pA1, alA, l_reg, pa0, pa1, pa2, pa3); SBAR();
        SLOAD((j + 1) * KVBLK); SBAR();
        pv_d0(o, vb0, pa0, pa1, pa2, pa3); partialSM(pB0, pB1, m_reg, mnB, alB);
        __syncthreads(); asm volatile("s_waitcnt vmcnt(0)" ::: "memory"); SWRITE(0);
        RESC(alB); __syncthreads();
        SBAR(); qkt(pA0, pA1, K_lds, R_lds, qr, ql, r32, hi);
        finishSM(pB0, pB1, alB, l_reg, pa0, pa1, pa2, pa3); SBAR();
        SLOAD((j + 2) * KVBLK); SBAR();
        pv_d0(o, vb0 + SHM_V, pa0, pa1, pa2, pa3); partialSM(pA0, pA1, m_reg, mnA, alA);
        __syncthreads(); asm volatile("s_waitcnt vmcnt(0)" ::: "memory"); SWRITE(1);
        RESC(alA); __syncthreads();
    }
    SBAR(); qkt(pB0, pB1, K_lds + SHM_K, R_lds + SHM_R, qr, ql, r32, hi);
    finishSM(pA0, pA1, alA, l_reg, pa0, pa1, pa2, pa3); SBAR();
    pv_d0(o, vb0, pa0, pa1, pa2, pa3); partialSM(pB0, pB1, m_reg, mnB, alB);
    __syncthreads(); RESC(alB);
    finishSM(pB0, pB1, alB, l_reg, pa0, pa1, pa2, pa3); SBAR();
    pv_d0(o, vb0 + SHM_V, pa0, pa1, pa2, pa3);
    if (hi == 0) li_l[r32] = l_reg; asm volatile("s_waitcnt lgkmcnt(0)" ::: "memory");
    float rli[16];
#pragma unroll
    for (int r = 0; r < 16; ++r) rli[r] = __builtin_amdgcn_rcpf(li_l[crow(r, hi)]);
    bf16_t* Ow = Ob + (long)(wid * QBLK) * LDO;
#pragma unroll
    for (int r = 0; r < 16; ++r) { int orow = crow(r, hi);
#pragma unroll
        for (int d0 = 0; d0 < 4; ++d0) { const float v = o[d0][r] * rli[r]; Ow[(long)orow * LDO + d0 * 32 + r32] = (bf16_t)(cvt_pk_bf16(v, v) & 0xffffu); } }
#undef SLOAD
#undef SWRITE
#undef RESC
}
}

enum { TR_PLAIN = 0, TR_GU = 1, TR_WIN = 2, TR_UQ = 3, TR_UKV = 4 };
template <int MODE>
__device__ __forceinline__ void tr_job(const float* W0, const float* W1, int K, int Nsrc, int Nout, bf16_t* WT, LAS float* scr, int lane, int gw, int NGW) {
    const int nblk = Nout / 32, nitems = (K / 64) * nblk;
    for (int it = gw; it < nitems; it += NGW) {
        const int kb = it / nblk, nb = it % nblk, k0 = 64 * kb, n0 = 32 * nb, np = n0 + (lane & 31);
        const float* colp;
        if (MODE == TR_PLAIN) colp = W0 + np;
        else if (MODE == TR_GU) { const int t = np >> 8, w = np & 255; colp = (w < 128 ? W0 : W1) + t * 128 + (w & 127); }
        else if (MODE == TR_WIN) colp = np < 1216 ? W0 + np : (np < 1280 ? nullptr : W0 + (np - 64));
        else if (MODE == TR_UQ) { const int h = np / 192, w = np % 192; colp = W0 + (w < 128 ? np : h * 192 + 128 + ((w - 128) >> 1) + ((w - 128) & 1) * 32); }
        else colp = np < 1024 ? W0 + np : W1 + (np - 1024);
        float tv[32];
#pragma unroll
        for (int i = 0; i < 32; ++i) { const int kk = 2 * i + (lane >> 5); tv[i] = colp ? colp[(size_t)(k0 + kk) * Nsrc] : 0.f; }
#pragma unroll
        for (int i = 0; i < 32; ++i) { const int kk = 2 * i + (lane >> 5); scr[kk * 33 + (lane & 31)] = tv[i]; }
        asm volatile("s_waitcnt lgkmcnt(0)" ::: "memory");
        const int c = lane & 7;
#pragma unroll
        for (int j = 0; j < 4; ++j) { const int n = (lane >> 3) + 8 * j; const LAS float* s = scr + (8 * c) * 33 + n;
            u32x4 o; o.x = cvt_pk_bf16(s[0 * 33], s[1 * 33]); o.y = cvt_pk_bf16(s[2 * 33], s[3 * 33]); o.z = cvt_pk_bf16(s[4 * 33], s[5 * 33]); o.w = cvt_pk_bf16(s[6 * 33], s[7 * 33]);
            *(u32x4*)(WT + (size_t)(n0 + n) * K + k0 + 8 * c) = o; }
        asm volatile("s_waitcnt lgkmcnt(0)" ::: "memory");
    }
}

template <int MODE>
__device__ __forceinline__ void rows_phase(const float* xin, const bf16_t* f, float wt, const float* gpost, const float* gnext, float* xout, bf16_t* xn, int gw, int NGW, int lane) {
    for (int row0 = gw; row0 < M; row0 += 2 * NGW) {
        f32x4 xv[2][4]; u32x2 fw[2][4];
#pragma unroll
        for (int r = 0; r < 2; ++r) { const size_t row = (size_t)(row0 + r * NGW);
#pragma unroll
            for (int j = 0; j < 4; ++j) { xv[r][j] = *(const f32x4*)(xin + row * DM + 4 * (lane + 64 * j));
                if (MODE != 0) fw[r][j] = *(const u32x2*)(f + row * DM + 4 * (lane + 64 * j)); } }
#pragma unroll
        for (int r = 0; r < 2; ++r) { const size_t row = (size_t)(row0 + r * NGW);
            if (MODE != 0) {
                f32x4 fv[4]; float ss = 0.f;
#pragma unroll
                for (int j = 0; j < 4; ++j) { fv[j] = (f32x4){bf_lo(fw[r][j].x), bf_hi(fw[r][j].x), bf_lo(fw[r][j].y), bf_hi(fw[r][j].y)}; ss += fv[j].x * fv[j].x + fv[j].y * fv[j].y + fv[j].z * fv[j].z + fv[j].w * fv[j].w; }
                const float rr = wt * __builtin_amdgcn_rsqf(wave_sum(ss) * (1.f / DM) + EPS);
#pragma unroll
                for (int j = 0; j < 4; ++j) { const f32x4 g = *(const f32x4*)(gpost + 4 * (lane + 64 * j)); xv[r][j] = xv[r][j] + fv[j] * g * rr; }
                if (MODE == 1) {
#pragma unroll
                    for (int j = 0; j < 4; ++j) *(f32x4*)(xout + row * DM + 4 * (lane + 64 * j)) = xv[r][j];
                }
            }
            float s2 = 0.f;
#pragma unroll
            for (int j = 0; j < 4; ++j) s2 += xv[r][j].x * xv[r][j].x + xv[r][j].y * xv[r][j].y + xv[r][j].z * xv[r][j].z + xv[r][j].w * xv[r][j].w;
            const float r2 = __builtin_amdgcn_rsqf(wave_sum(s2) * (1.f / DM) + EPS);
#pragma unroll
            for (int j = 0; j < 4; ++j) { const f32x4 g = *(const f32x4*)(gnext + 4 * (lane + 64 * j)); const f32x4 y = xv[r][j] * g * r2;
                if (MODE == 2) *(f32x4*)(xout + row * DM + 4 * (lane + 64 * j)) = y;
                else { u32x2 w; w.x = cvt_pk_bf16(y.x, y.y); w.y = cvt_pk_bf16(y.z, y.w); *(u32x2*)(xn + row * DM + 4 * (lane + 64 * j)) = w; } }
        }
    }
}

__global__ void __launch_bounds__(NTHREADS, 2) fwd_megakernel(Params p) {
    extern __shared__ __attribute__((aligned(16))) unsigned char lds[];
    cg::grid_group grid = cg::this_grid();
    unsigned* bar_cnt = (unsigned*)(p.ws + WS_END); unsigned bar_target = 0;
#define GRID_SYNC_CG() do { __builtin_amdgcn_fence(__ATOMIC_RELEASE, "agent"); asm volatile("s_waitcnt vmcnt(0)" ::: "memory"); grid.sync(); \
        __builtin_amdgcn_fence(__ATOMIC_ACQUIRE, "agent"); asm volatile("s_waitcnt vmcnt(0)" ::: "memory"); } while (0)
#define GRID_SYNC() do { bar_target += gridDim.x; asm volatile("s_waitcnt vmcnt(0)" ::: "memory"); __syncthreads(); \
        if (threadIdx.x == 0) { __builtin_amdgcn_fence(__ATOMIC_RELEASE, "agent"); asm volatile("s_waitcnt vmcnt(0)" ::: "memory"); \
            __hip_atomic_fetch_add(bar_cnt, 1u, __ATOMIC_RELAXED, __HIP_MEMORY_SCOPE_AGENT); \
            while (__hip_atomic_load(bar_cnt, __ATOMIC_RELAXED, __HIP_MEMORY_SCOPE_AGENT) < bar_target) __builtin_amdgcn_s_sleep(1); \
            __builtin_amdgcn_fence(__ATOMIC_ACQUIRE, "agent"); asm volatile("s_waitcnt vmcnt(0)" ::: "memory"); } \
        __syncthreads(); } while (0)
    const int G = gridDim.x, bid = blockIdx.x, NGW = G * NWAVES;
    LAS unsigned char* ldsl = (LAS unsigned char*)lds;
#define PHASE_IDS() const int tid = fresh_tid(), lane = tid & 63, wave = tid >> 6, gw = bid * NWAVES + wave; LAS float* scr = (LAS float*)(ldsl + wave * 8448); (void)scr; (void)gw; (void)lane
    unsigned char* ws = p.ws;
    bf16_t* Wgu = (bf16_t*)(ws + OFF_WGU); bf16_t* Wd = (bf16_t*)(ws + OFF_WD); bf16_t* Win = (bf16_t*)(ws + OFF_WIN); bf16_t* Wuq = (bf16_t*)(ws + OFF_WUQ);
    bf16_t* Wukv = (bf16_t*)(ws + OFF_WUKV); bf16_t* Woa = (bf16_t*)(ws + OFF_WOA); bf16_t* Wp = (bf16_t*)(ws + OFF_WP); bf16_t* Wout = (bf16_t*)(ws + OFF_WOUT);
    bf16_t* XN = (bf16_t*)(ws + OFF_XN); bf16_t* F = (bf16_t*)(ws + OFF_F); float* ZF = (float*)(ws + OFF_ZF); bf16_t* KV = (bf16_t*)(ws + OFF_KV);
    bf16_t* H = (bf16_t*)(ws + OFF_H); bf16_t* O = (bf16_t*)(ws + OFF_O); bf16_t* CQN = (bf16_t*)(ws + OFF_CQN); bf16_t* CKVN = (bf16_t*)(ws + OFF_CKVN);
    float* TAB = (float*)(ws + OFF_TAB); bf16_t* Q = (bf16_t*)(ws + OFF_Q); bf16_t* KR = (bf16_t*)(ws + OFF_KR); bf16_t* Gt = (bf16_t*)(ws + OFF_G); bf16_t* DP = (bf16_t*)(ws + OFF_DP);
    float* X = p.out;

    { PHASE_IDS();
    tr_job<TR_GU>(p.f1_wg, p.f1_wu, 1024, DFF, 5632, Wgu, scr, lane, gw, NGW);
    tr_job<TR_PLAIN>(p.f1_wd, nullptr, DFF, 1024, 1024, Wd, scr, lane, gw, NGW);
    tr_job<TR_WIN>(p.w_in, nullptr, 1024, INW, 3328, Win, scr, lane, gw, NGW);
    tr_job<TR_UQ>(p.w_uq, nullptr, QL, 1536, 1536, Wuq, scr, lane, gw, NGW);
    tr_job<TR_UKV>(p.w_uk, p.w_uv, KVL, 1024, 2048, Wukv, scr, lane, gw, NGW);
    tr_job<TR_PLAIN>(p.w_oa, nullptr, 1024, 1024, 1024, Woa, scr, lane, gw, NGW);
    tr_job<TR_PLAIN>(p.w_out, nullptr, 1024, 1024, 1024, Wout, scr, lane, gw, NGW);
    for (int idx = bid * NTHREADS + tid; idx < 65536; idx += G * NTHREADS) {
        const int n = idx & 1023, c8 = idx >> 10, g = c8 >> 4, cb = (c8 & 15) * 8;
        float a[8];
#pragma unroll
        for (int i = 0; i < 8; ++i) a[i] = 0.f;
        for (int j0 = 0; j0 < 128; j0 += 8) { float w[8]; f32x4 pw[8][2];
#pragma unroll
            for (int jj = 0; jj < 8; ++jj) w[jj] = p.w_op[(size_t)(g * 128 + j0 + jj) * 1024 + n] * p.pool_scale[g * 128 + j0 + jj];
#pragma unroll
            for (int i = 0; i < 8; ++i) { pw[i][0] = *(const f32x4*)(p.pool_w + (size_t)(g * 128 + cb + i) * 128 + j0); pw[i][1] = *(const f32x4*)(p.pool_w + (size_t)(g * 128 + cb + i) * 128 + j0 + 4); }
#pragma unroll
            for (int i = 0; i < 8; ++i)
#pragma unroll
                for (int jj = 0; jj < 8; ++jj) a[i] = fmaf(pw[i][jj >> 2][jj & 3], w[jj], a[i]); }
        u32x4 o; o.x = cvt_pk_bf16(a[0], a[1]); o.y = cvt_pk_bf16(a[2], a[3]); o.z = cvt_pk_bf16(a[4], a[5]); o.w = cvt_pk_bf16(a[6], a[7]);
        *(u32x4*)(Wp + (size_t)n * 512 + c8 * 8) = o;
    }
    rows_phase<0>(p.x, nullptr, 0.f, nullptr, p.f1_pre, nullptr, XN, gw, NGW, lane); }
    GRID_SYNC_CG();

    pg8::StaticOrder S;
    { pg8::Gemm g{XN, Wgu, M, 5632, 1024}; S.init(M, 5632, G, bid); pg8::EpiSwiGLU E{H}; pg8::gemm_phase(ldsl, g, S, E); }
    GRID_SYNC();
    { pg8::Gemm g{H, Wd, M, 1024, DFF}; S.init(M, 1024, G, bid); pg8::EpiBf16 E{F, 1024}; pg8::gemm_phase(ldsl, g, S, E); }
    GRID_SYNC();
    { PHASE_IDS(); rows_phase<1>(p.x, F, 0.5f, p.f1_post, p.mix_pre, X, XN, gw, NGW, lane); }
    GRID_SYNC();
    { pg8::Gemm g{XN, Win, M, 1280, 1024}; S.init(M, 1280, G, bid); pg8::EpiF32 E{ZF, 1280}; pg8::gemm_phase(ldsl, g, S, E); }
    GRID_SYNC();
    { PHASE_IDS();
    for (int row = gw; row < M; row += NGW) {
        const float* z = ZF + (size_t)row * 1280;
        {
            f32x4 a = *(const f32x4*)(z + 4 * lane), b = (f32x4){0.f, 0.f, 0.f, 0.f};
            if (lane < 32) b = *(const f32x4*)(z + 4 * (lane + 64));
            float ss = a.x * a.x + a.y * a.y + a.z * a.z + a.w * a.w + b.x * b.x + b.y * b.y + b.z * b.z + b.w * b.w;
            const float r = __builtin_amdgcn_rsqf(wave_sum(ss) * (1.f / QL) + EPS);
            { const f32x4 g = *(const f32x4*)(p.qa_g + 4 * lane); const f32x4 y = a * g * r; u32x2 w; w.x = cvt_pk_bf16(y.x, y.y); w.y = cvt_pk_bf16(y.z, y.w); *(u32x2*)(CQN + (size_t)row * QL + 4 * lane) = w; }
            if (lane < 32) { const f32x4 g = *(const f32x4*)(p.qa_g + 4 * (lane + 64)); const f32x4 y = b * g * r; u32x2 w; w.x = cvt_pk_bf16(y.x, y.y); w.y = cvt_pk_bf16(y.z, y.w); *(u32x2*)(CQN + (size_t)row * QL + 4 * (lane + 64)) = w; }
        }
        {
            const f32x4 a = *(const f32x4*)(z + 384 + 4 * lane);
            const float ss = a.x * a.x + a.y * a.y + a.z * a.z + a.w * a.w;
            const float r = __builtin_amdgcn_rsqf(wave_sum(ss) * (1.f / KVL) + EPS);
            const f32x4 g = *(const f32x4*)(p.kva_g + 4 * lane); const f32x4 y = a * g * r; u32x2 w; w.x = cvt_pk_bf16(y.x, y.y); w.y = cvt_pk_bf16(y.z, y.w); *(u32x2*)(CKVN + (size_t)row * KVL + 4 * lane) = w;
        }
        if (lane < 32) {
            const float x1 = z[640 + lane], x2 = z[672 + lane];
            const float ang = (float)p.pos[row] * p.inv_freq[lane];
            const double ad = (double)ang; const double kq = rint(ad * 0.15915494309189535); const float red = (float)(ad - kq * 6.283185307179586);
            const float cs = __cosf(red), sn = __sinf(red);
            TAB[(size_t)row * 64 + lane] = cs; TAB[(size_t)row * 64 + 32 + lane] = sn;
            *(unsigned*)(KR + (size_t)row * 64 + 2 * lane) = cvt_pk_bf16(x1 * cs - x2 * sn, x2 * cs + x1 * sn);
        }
        {
            const int t = row & (SEQ - 1), g = lane >> 4, wnd = 2 << g, lo = max(t - (wnd >> 1), 0), hi = min(t + wnd - (wnd >> 1), SEQ);
            const float* zp = z + 704 + 8 * lane;
            f32x4 s0 = (f32x4){0.f, 0.f, 0.f, 0.f}, s1 = s0;
            for (int dt = -8; dt < 8; ++dt) { const int tt = t + dt;
                if (tt >= lo && tt < hi) { const float* q = zp + (long)dt * 1280; s0 = s0 + *(const f32x4*)q; s1 = s1 + *(const f32x4*)(q + 4); } }
            const float inv = 1.f / (float)(hi - lo);
            const f32x4 c0 = *(const f32x4*)zp, c1 = *(const f32x4*)(zp + 4);
            const f32x4 d0 = s0 * inv - c0, d1 = s1 * inv - c1;
            u32x4 w; w.x = cvt_pk_bf16(d0.x, d0.y); w.y = cvt_pk_bf16(d0.z, d0.w); w.z = cvt_pk_bf16(d1.x, d1.y); w.w = cvt_pk_bf16(d1.z, d1.w);
            *(u32x4*)(DP + (size_t)row * 512 + 8 * lane) = w;
        }
    } }
    GRID_SYNC();
    { pg8::Gemm g{CQN, Wuq, M, 1536, QL}; S.init(M, 1536, G, bid); pg8::EpiQ E{Q, TAB}; pg8::gemm_phase(ldsl, g, S, E); }
    { pg8::Gemm g{CKVN, Wukv, M, 2048, KVL}; S.init(M, 2048, G, bid); pg8::EpiBf16 E{KV, 2048}; pg8::gemm_phase(ldsl, g, S, E); }
    GRID_SYNC();
    {
        const int vcu = (bid & 7) * (G >> 3) + (bid >> 3);
        for (int it = vcu; it < NB * NH * (SEQ / 256); it += G) {
            const int qb = it & 7, h = (it >> 3) & 7, b = it >> 6;
            const size_t tok0 = (size_t)b * SEQ;
            att::attn_body(Q + (tok0 + qb * 256) * 1536 + h * 192, KV + tok0 * 2048 + h * 128, KR + tok0 * 64, KV + tok0 * 2048 + 1024 + h * 128,
                           O + (tok0 + qb * 256) * 1024 + h * 128, SEQ, (char*)lds);
            __syncthreads();
        }
    }
    GRID_SYNC();
    { pg8::Gemm g{XN, Win + (size_t)1280 * 1024, M, 2048, 1024}; S.init(M, 2048, G, bid); pg8::EpiGate E{Gt}; pg8::gemm_phase(ldsl, g, S, E); }
    GRID_SYNC();
    { pg8::Gemm g{O, Woa, M, 1024, 1024}; S.init(M, 1024, G, bid); pg8::EpiT1 E{Gt, F}; pg8::gemm_phase(ldsl, g, S, E); }
    { pg8::Gemm g{DP, Wp, M, 1024, 512}; S.init(M, 1024, G, bid); pg8::EpiMX E{Gt, F, XN}; pg8::gemm_phase(ldsl, g, S, E); }
    GRID_SYNC();
    { pg8::Gemm g{XN, Wout, M, 1024, 1024}; S.init(M, 1024, G, bid); pg8::EpiBf16 E{F, 1024}; pg8::gemm_phase(ldsl, g, S, E); }
    GRID_SYNC();
    { PHASE_IDS();
    tr_job<TR_GU>(p.f2_wg, p.f2_wu, 1024, DFF, 5632, Wgu, scr, lane, gw, NGW);
    tr_job<TR_PLAIN>(p.f2_wd, nullptr, DFF, 1024, 1024, Wd, scr, lane, gw, NGW);
    rows_phase<1>(X, F, 1.0f, p.mix_post, p.f2_pre, X, XN, gw, NGW, lane); }
    GRID_SYNC();
    { pg8::Gemm g{XN, Wgu, M, 5632, 1024}; S.init(M, 5632, G, bid); pg8::EpiSwiGLU E{H}; pg8::gemm_phase(ldsl, g, S, E); }
    GRID_SYNC();
    { pg8::Gemm g{H, Wd, M, 1024, DFF}; S.init(M, 1024, G, bid); pg8::EpiBf16 E{F, 1024}; pg8::gemm_phase(ldsl, g, S, E); }
    GRID_SYNC();
    { PHASE_IDS(); rows_phase<2>(X, F, 0.5f, p.f2_post, p.final_g, X, nullptr, gw, NGW, lane); }
}

extern "C" void kernel_launch(void* const* d_in, const int* in_sizes, int n_in, void* d_out, int out_size, void* d_ws, size_t ws_size, hipStream_t stream) {
    static int grid_blocks = 0;
    if (grid_blocks == 0) {
        if (n_in != 26 || in_sizes[0] != M * DM || out_size != M * DM || ws_size < WS_END) { fprintf(stderr, "kernel_launch: shape mismatch n_in %d in0 %d out %d ws %zu\n", n_in, n_in > 0 ? in_sizes[0] : -1, out_size, ws_size); grid_blocks = -1; return; }
        int dev = 0, cus = 0, per_cu = 0;
        (void)hipGetDevice(&dev);
        (void)hipDeviceGetAttribute(&cus, hipDeviceAttributeMultiprocessorCount, dev);
        if (hipFuncSetAttribute((const void*)fwd_megakernel, hipFuncAttributeMaxDynamicSharedMemorySize, LDS_BYTES) != hipSuccess) { fprintf(stderr, "kernel_launch: hipFuncSetAttribute failed\n"); grid_blocks = -1; return; }
        if (hipOccupancyMaxActiveBlocksPerMultiprocessor(&per_cu, (const void*)fwd_megakernel, NTHREADS, LDS_BYTES) != hipSuccess || per_cu < 1) { fprintf(stderr, "kernel_launch: occupancy query failed (%d)\n", per_cu); (void)hipGetLastError(); per_cu = 1; }
        grid_blocks = cus * 1;
        if (grid_blocks % 8 != 0) grid_blocks -= grid_blocks % 8;
    }
    if (grid_blocks < 0) return;
    Params p{};
    p.x = (const float*)d_in[0]; p.pos = (const int*)d_in[1];
    p.f1_pre = (const float*)d_in[2]; p.f1_wg = (const float*)d_in[3]; p.f1_wu = (const float*)d_in[4]; p.f1_wd = (const float*)d_in[5]; p.f1_post = (const float*)d_in[6];
    p.mix_pre = (const float*)d_in[7]; p.w_in = (const float*)d_in[8]; p.qa_g = (const float*)d_in[9]; p.w_uq = (const float*)d_in[10]; p.kva_g = (const float*)d_in[11];
    p.w_uk = (const float*)d_in[12]; p.w_uv = (const float*)d_in[13]; p.w_oa = (const float*)d_in[14]; p.pool_w = (const float*)d_in[15]; p.pool_scale = (const float*)d_in[16];
    p.w_op = (const float*)d_in[17]; p.w_out = (const float*)d_in[18]; p.mix_post = (const float*)d_in[19];
    p.f2_pre = (const float*)d_in[20]; p.f2_wg = (const float*)d_in[21]; p.f2_wu = (const float*)d_in[22]; p.f2_wd = (const float*)d_in[23]; p.f2_post = (const float*)d_in[24]; p.final_g = (const float*)d_in[25];
    p.out = (float*)d_out; p.ws = (unsigned char*)d_ws;
    for (int i = 0; i < 32; ++i) p.inv_freq[i] = (float)pow(10000.0, -(2.0 * i) / 64.0);
    if (hipMemsetAsync((char*)d_ws + WS_END, 0, 256, stream) != hipSuccess) { fprintf(stderr, "kernel_launch: memset failed\n"); return; }
    void* args[] = {&p};
    hipError_t e = hipLaunchCooperativeKernel((const void*)fwd_megakernel, dim3(grid_blocks), dim3(NTHREADS), args, LDS_BYTES, stream);
    if (e != hipSuccess) fprintf(stderr, "cooperative launch failed: %s (grid %d)\n", hipGetErrorString(e), grid_blocks);
}
```

```cpp
#include <hip/hip_runtime.h>
#include <hip/hip_cooperative_groups.h>
#include <cstdio>
#include <cmath>
#include <cstdint>
namespace cg = cooperative_groups;

#define LAS __attribute__((address_space(3)))
typedef unsigned short bf16_t;
typedef short bf16x8 __attribute__((ext_vector_type(8)));
typedef short s16x4 __attribute__((ext_vector_type(4)));
typedef float f32x2 __attribute__((ext_vector_type(2)));
typedef float f32x4 __attribute__((ext_vector_type(4)));
typedef float f32x16 __attribute__((ext_vector_type(16)));
typedef unsigned u32x4 __attribute__((ext_vector_type(4)));
typedef unsigned u32x2 __attribute__((ext_vector_type(2)));

constexpr int DM = 1024, NB = 8, SEQ = 2048, M = NB * SEQ, NH = 8, QL = 384, KVL = 256, DFF = 2816, INW = 3264;
constexpr float EPS = 1e-6f;
constexpr int NTHREADS = 512, NWAVES = 8;
constexpr int LDS_STAGE = 131072, LDS_BYTES = LDS_STAGE + 16;

constexpr size_t MiB = 1048576;
constexpr size_t OFF_WGU = 0;
constexpr size_t OFF_WD = OFF_WGU + (size_t)5632 * 1024 * 2;
constexpr size_t OFF_WIN = OFF_WD + (size_t)1024 * 2816 * 2;
constexpr size_t OFF_WUQ = OFF_WIN + (size_t)3328 * 1024 * 2;
constexpr size_t OFF_WUKV = OFF_WUQ + (size_t)1536 * 384 * 2;
constexpr size_t OFF_WOA = OFF_WUKV + (size_t)2048 * 256 * 2;
constexpr size_t OFF_WP = OFF_WOA + (size_t)1024 * 1024 * 2;
constexpr size_t OFF_WOUT = OFF_WP + (size_t)1024 * 512 * 2;
constexpr size_t OFF_XN = OFF_WOUT + (size_t)1024 * 1024 * 2;
constexpr size_t OFF_R = OFF_XN + 32 * MiB;
constexpr size_t OFF_F = OFF_R;
constexpr size_t OFF_ZF = OFF_R;
constexpr size_t OFF_KV = OFF_R;
constexpr size_t OFF_H = OFF_R + 64 * MiB;
constexpr size_t OFF_O = OFF_R + 64 * MiB;
constexpr size_t OFF_CQN = OFF_R + 80 * MiB;
constexpr size_t OFF_CKVN = OFF_R + 92 * MiB;
constexpr size_t OFF_TAB = OFF_R + 100 * MiB;
constexpr size_t OFF_Q = OFF_R + 104 * MiB;
constexpr size_t OFF_KR = OFF_R + 152 * MiB;
constexpr size_t OFF_G = OFF_R + 96 * MiB;
constexpr size_t OFF_DP = OFF_R + 176 * MiB;
constexpr size_t WS_END = OFF_R + 192 * MiB;
static_assert(WS_END + 16384 <= 256 * MiB, "workspace");

struct Params {
    const float* x; const int* pos;
    const float *f1_pre, *f1_wg, *f1_wu, *f1_wd, *f1_post;
    const float *mix_pre, *w_in, *qa_g, *w_uq, *kva_g, *w_uk, *w_uv, *w_oa, *pool_w, *pool_scale, *w_op, *w_out, *mix_post;
    const float *f2_pre, *f2_wg, *f2_wu, *f2_wd, *f2_post, *final_g;
    float* out; unsigned char* ws;
    float inv_freq[32];
};

typedef __bf16 bf16x2_t __attribute__((ext_vector_type(2)));
__device__ __forceinline__ unsigned cvt_pk_bf16(float lo, float hi) { const f32x2 v = {lo, hi}; const bf16x2_t r = __builtin_convertvector(v, bf16x2_t); return __builtin_bit_cast(unsigned, r); }
__device__ __forceinline__ float bf_lo(unsigned w) { return __uint_as_float(w << 16); }
__device__ __forceinline__ float bf_hi(unsigned w) { return __uint_as_float(w & 0xffff0000u); }
__device__ __forceinline__ float sigmoidf_fast(float z) { return __builtin_amdgcn_rcpf(1.f + __builtin_amdgcn_exp2f(-1.4426950408889634f * z)); }
__device__ __forceinline__ int fresh_tid() { int t = threadIdx.x; asm volatile("" : "+v"(t)); return t; }
__device__ __forceinline__ float wave_sum(float v) {
#pragma unroll
    for (int o = 1; o < 64; o <<= 1) v += __shfl_xor(v, o);
    return v;
}

namespace pg8 {
constexpr int BM = 256, BK = 64, HALF = 128, HTB = HALF * BK * 2, STAGE_BYTES = 8 * HTB, NXCD = 8, WGM = 8;
__host__ __device__ __forceinline__ int lds_byte(int r, int c) { const int st = (r >> 4) * 2 + (c >> 5), rr = r & 15, cc = c & 31, ob = rr * 64 + cc * 2; return st * 1024 + (ob ^ (((ob >> 9) & 1) << 5)); }
__host__ __device__ __forceinline__ void stage_rc(int b, int& R, int& C) { const int st = b / 1024, sb = b % 1024, swz = sb ^ (((sb >> 9) & 1) << 5); R = (st >> 1) * 16 + swz / 64; C = (st & 1) * 32 + (swz % 64) / 2; }
__host__ __device__ __forceinline__ int perm32(int rho) { const int n = rho >> 4, i = rho & 15; return 8 * (i >> 2) + 4 * n + (i & 3); }
struct Unit { int pm, pn; };
struct Gemm { const bf16_t* A; const bf16_t* Bt; int M, N, K; };
struct StaticOrder {
    int nM, nN, nwg, G, c;
    __device__ void init(int M_, int N_, int G_, int c_) { nM = M_ / BM; nN = N_ / BM; nwg = nM * nN; G = G_; c = c_; }
    __device__ bool next(int i, Unit& u) const {
        const long L = (long)i * G + c; if (L >= nwg) return false;
        int wgid = (int)L; { const int q = nwg / NXCD, r = nwg % NXCD, xcd = wgid % NXCD, off = wgid / NXCD; wgid = (xcd < r ? xcd * (q + 1) : r * (q + 1) + (xcd - r) * q) + off; }
        const int nig = WGM * nN, gid = wgid / nig, fm = gid * WGM, gsz = (nM - fm) < WGM ? (nM - fm) : WGM;
        u.pm = fm + ((wgid % nig) % gsz); u.pn = (wgid % nig) / gsz; return true;
    }
};

template <class Epi>
__device__ __forceinline__ void gemm_phase(LAS unsigned char* lds, const Gemm g, const StaticOrder& S, const Epi& E) {
    const int tid = fresh_tid(), wid = __builtin_amdgcn_readfirstlane(tid >> 6), lane = tid & 63, wr = wid >> 2, wc = wid & 3, fr = lane & 15, fq = lane >> 4;
    const int K = g.K, nt = K / BK;
    unsigned voffA[2], voffB[2];
#pragma unroll
    for (int i = 0; i < 2; ++i) { int R, C; stage_rc(tid * 16 + i * 8192, R, C); const int Rb = Epi::PERM ? ((R & ~31) + perm32(R & 31)) : R;
        voffA[i] = (unsigned)(R * K + C) * 2u; voffB[i] = (unsigned)(Rb * K + C) * 2u; }
    const size_t kstep = (size_t)(BK * 2);
    const size_t hstep = (size_t)HALF * K * 2;
    const size_t tstep = 2 * hstep;
    const unsigned ldsw = (unsigned)wid * 1024u;
    const int aoff = lds_byte(wr * 64 + fr, fq * 8), boff = lds_byte(wc * 32 + fr, fq * 8);
#define PG8_SA(b, h) (((b) * 2 + (h)) * HTB)
#define PG8_SB(b, h) ((4 + (b) * 2 + (h)) * HTB)
#define PG8_STAGE(bufoff, gbase, voff) do { _Pragma("unroll") for (int _i = 0; _i < 2; ++_i) \
        __builtin_amdgcn_global_load_lds((const unsigned*)((const char*)(gbase) + (voff)[_i]), (LAS unsigned*)(lds + (bufoff) + ldsw + _i * 8192), 16, 0, 0); } while (0)
#define PG8_LDA(dst, b, h) do { _Pragma("unroll") for (int m = 0; m < 4; ++m) _Pragma("unroll") for (int k = 0; k < 2; ++k) dst[m][k] = *(const LAS bf16x8*)(lds + PG8_SA(b, h) + aoff + m * 2048 + k * 1024); } while (0)
#define PG8_LDB(dst, b, h) do { _Pragma("unroll") for (int n = 0; n < 2; ++n) _Pragma("unroll") for (int k = 0; k < 2; ++k) dst[n][k] = *(const LAS bf16x8*)(lds + PG8_SB(b, h) + boff + n * 2048 + k * 1024); } while (0)
#define PG8_MMA(ai, bj, At, Bt) do { __builtin_amdgcn_s_setprio(1); _Pragma("unroll") for (int m = 0; m < 4; ++m) _Pragma("unroll") for (int n = 0; n < 2; ++n) _Pragma("unroll") for (int k = 0; k < 2; ++k) \
        acc[ai][bj][m][n] = __builtin_amdgcn_mfma_f32_16x16x32_bf16(Bt[n][k], At[m][k], acc[ai][bj][m][n], 0, 0, 0); __builtin_amdgcn_s_setprio(0); } while (0)
#define PG8_WAIT_V(n) asm volatile("s_waitcnt vmcnt(" #n ")" ::: "memory")
#define PG8_WAIT_L(n) asm volatile("s_waitcnt lgkmcnt(" #n ")" ::: "memory")
#define PG8_BAR __builtin_amdgcn_s_barrier()
#define PG8_SCHED __builtin_amdgcn_sched_barrier(0)
    Unit cur, nxt; int ui = 0;
    if (!S.next(0, cur)) return;
    f32x4 acc[2][2][4][2];
#pragma unroll
    for (int a = 0; a < 2; ++a)
#pragma unroll
        for (int b = 0; b < 2; ++b)
#pragma unroll
            for (int m = 0; m < 4; ++m)
#pragma unroll
                for (int n = 0; n < 2; ++n) acc[a][b][m][n] = (f32x4){0.f, 0.f, 0.f, 0.f};
    bf16x8 At[4][2], B0[2][2], B1[2][2];
    const char* cA = (const char*)g.A + (size_t)cur.pm * tstep; const char* cB = (const char*)g.Bt + (size_t)cur.pn * tstep;
    PG8_STAGE(PG8_SB(0, 0), cB, voffB); PG8_STAGE(PG8_SA(0, 0), cA, voffA); PG8_STAGE(PG8_SB(0, 1), cB + hstep, voffB); PG8_STAGE(PG8_SA(0, 1), cA + hstep, voffA);
    if (wr == 1) PG8_BAR;
    PG8_WAIT_V(4); PG8_BAR;
    PG8_STAGE(PG8_SB(1, 0), cB + kstep, voffB); PG8_STAGE(PG8_SA(1, 0), cA + kstep, voffA); PG8_STAGE(PG8_SB(1, 1), cB + hstep + kstep, voffB);
    PG8_WAIT_V(6); PG8_BAR;
    for (;;) {
        const bool has_next = S.next(ui + 1, nxt);
        const char* nA = has_next ? (const char*)g.A + (size_t)nxt.pm * tstep : cA; const char* nB = has_next ? (const char*)g.Bt + (size_t)nxt.pn * tstep : cB;
        for (int t = 0; t < nt; t += 2) {
            const bool last = (t == nt - 2);
            const char* a1 = cA + (size_t)(t + 1) * kstep;
            const char* a2 = last ? nA : cA + (size_t)(t + 2) * kstep; const char* b2 = last ? nB : cB + (size_t)(t + 2) * kstep;
            const char* a3 = a2 + kstep; const char* b3 = b2 + kstep;
            PG8_LDB(B0, 0, 0); PG8_SCHED; PG8_LDA(At, 0, 0); PG8_STAGE(PG8_SA(1, 1), a1 + hstep, voffA);
            PG8_WAIT_L(8); PG8_BAR; PG8_WAIT_L(0); PG8_MMA(0, 0, At, B0); PG8_BAR; PG8_SCHED;
            PG8_LDB(B1, 0, 1); PG8_STAGE(PG8_SB(0, 0), b2, voffB);
            PG8_BAR; PG8_WAIT_L(0); PG8_MMA(0, 1, At, B1); PG8_BAR;
            PG8_LDA(At, 0, 1); PG8_STAGE(PG8_SA(0, 0), a2, voffA);
            PG8_BAR; PG8_WAIT_L(0); PG8_MMA(1, 0, At, B0); PG8_BAR; PG8_SCHED;
            PG8_STAGE(PG8_SB(0, 1), b2 + hstep, voffB);
            PG8_WAIT_V(6); PG8_BAR; PG8_MMA(1, 1, At, B1); PG8_BAR;
            PG8_LDB(B0, 1, 0); PG8_SCHED; PG8_LDA(At, 1, 0); PG8_STAGE(PG8_SA(0, 1), a2 + hstep, voffA);
            PG8_WAIT_L(8); PG8_BAR; PG8_WAIT_L(0); PG8_MMA(0, 0, At, B0); PG8_BAR; PG8_SCHED;
            PG8_LDB(B1, 1, 1); PG8_STAGE(PG8_SB(1, 0), b3, voffB);
            PG8_BAR; PG8_WAIT_L(0); PG8_MMA(0, 1, At, B1); PG8_BAR;
            PG8_LDA(At, 1, 1); PG8_STAGE(PG8_SA(1, 0), a3, voffA);
            PG8_BAR; PG8_WAIT_L(0); PG8_MMA(1, 0, At, B0); PG8_BAR; PG8_SCHED;
            PG8_STAGE(PG8_SB(1, 1), b3 + hstep, voffB);
            PG8_WAIT_V(6); PG8_BAR; PG8_MMA(1, 1, At, B1); PG8_BAR;
        }
        { const int t2 = fresh_tid(); E(acc, cur, wr, wc, t2 & 15, (t2 >> 4) & 3); }
        if (!has_next) break;
#pragma unroll
        for (int a = 0; a < 2; ++a)
#pragma unroll
            for (int b = 0; b < 2; ++b)
#pragma unroll
                for (int m = 0; m < 4; ++m)
#pragma unroll
                    for (int n = 0; n < 2; ++n) acc[a][b][m][n] = (f32x4){0.f, 0.f, 0.f, 0.f};
        cur = nxt; cA = nA; cB = nB; ++ui;
    }
    PG8_WAIT_V(0);
    if (wr == 0) PG8_BAR;
    PG8_BAR;
#undef PG8_SA
#undef PG8_SB
#undef PG8_STAGE
#undef PG8_LDA
#undef PG8_LDB
#undef PG8_MMA
#undef PG8_WAIT_V
#undef PG8_WAIT_L
#undef PG8_BAR
#undef PG8_SCHED
}

typedef f32x4 Acc[2][2][4][2];
struct EpiF32 {
    static constexpr bool PERM = false;
    float* C; int ldc;
    __device__ __forceinline__ void operator()(const Acc& acc, const Unit& u, int wr, int wc, int fr, int fq) const {
        const int row0 = u.pm * BM + wr * 64 + fr, col0 = u.pn * BM + wc * 32 + 4 * fq;
#pragma unroll
        for (int ai = 0; ai < 2; ++ai)
#pragma unroll
            for (int m = 0; m < 4; ++m) { float* rowp = C + (size_t)(row0 + ai * HALF + m * 16) * ldc + col0;
#pragma unroll
                for (int bj = 0; bj < 2; ++bj)
#pragma unroll
                    for (int n = 0; n < 2; ++n) *(f32x4*)(rowp + bj * HALF + n * 16) = acc[ai][bj][m][n]; }
    }
};
struct EpiBf16 {
    static constexpr bool PERM = true;
    bf16_t* O; int ldc;
    __device__ __forceinline__ void operator()(const Acc& acc, const Unit& u, int wr, int wc, int fr, int fq) const {
        const int row0 = u.pm * BM + wr * 64 + fr, col0 = u.pn * BM + wc * 32 + 8 * fq;
#pragma unroll
        for (int ai = 0; ai < 2; ++ai)
#pragma unroll
            for (int m = 0; m < 4; ++m) { bf16_t* rowp = O + (size_t)(row0 + ai * HALF + m * 16) * ldc + col0;
#pragma unroll
                for (int bj = 0; bj < 2; ++bj) { const f32x4 v0 = acc[ai][bj][m][0], v1 = acc[ai][bj][m][1];
                    u32x4 w; w.x = cvt_pk_bf16(v0[0], v0[1]); w.y = cvt_pk_bf16(v0[2], v0[3]); w.z = cvt_pk_bf16(v1[0], v1[1]); w.w = cvt_pk_bf16(v1[2], v1[3]);
                    *(u32x4*)(rowp + bj * HALF) = w; } }
    }
};
struct EpiSwiGLU {
    static constexpr bool PERM = true;
    bf16_t* H;
    __device__ __forceinline__ void operator()(const Acc& acc, const Unit& u, int wr, int wc, int fr, int fq) const {
        const int row0 = u.pm * BM + wr * 64 + fr, col0 = u.pn * HALF + wc * 32 + 8 * fq;
#pragma unroll
        for (int ai = 0; ai < 2; ++ai)
#pragma unroll
            for (int m = 0; m < 4; ++m) { bf16_t* rowp = H + (size_t)(row0 + ai * HALF + m * 16) * DFF + col0;
                float h[8];
#pragma unroll
                for (int n = 0; n < 2; ++n)
#pragma unroll
                    for (int j = 0; j < 4; ++j) { const float gt = acc[ai][0][m][n][j], up = acc[ai][1][m][n][j]; h[n * 4 + j] = gt * sigmoidf_fast(gt) * up; }
                u32x4 w; w.x = cvt_pk_bf16(h[0], h[1]); w.y = cvt_pk_bf16(h[2], h[3]); w.z = cvt_pk_bf16(h[4], h[5]); w.w = cvt_pk_bf16(h[6], h[7]);
                *(u32x4*)rowp = w; }
    }
};
struct EpiGate {
    static constexpr bool PERM = true;
    bf16_t* G;
    __device__ __forceinline__ void operator()(const Acc& acc, const Unit& u, int wr, int wc, int fr, int fq) const {
        const int row0 = u.pm * BM + wr * 64 + fr, col0 = u.pn * BM + wc * 32 + 8 * fq;
#pragma unroll
        for (int ai = 0; ai < 2; ++ai)
#pragma unroll
            for (int m = 0; m < 4; ++m) { bf16_t* rowp = G + (size_t)(row0 + ai * HALF + m * 16) * 2048 + col0;
#pragma unroll
                for (int bj = 0; bj < 2; ++bj) { const f32x4 v0 = acc[ai][bj][m][0], v1 = acc[ai][bj][m][1];
                    u32x4 w; w.x = cvt_pk_bf16(sigmoidf_fast(v0[0]), sigmoidf_fast(v0[1])); w.y = cvt_pk_bf16(sigmoidf_fast(v0[2]), sigmoidf_fast(v0[3]));
                    w.z = cvt_pk_bf16(sigmoidf_fast(v1[0]), sigmoidf_fast(v1[1])); w.w = cvt_pk_bf16(sigmoidf_fast(v1[2]), sigmoidf_fast(v1[3]));
                    *(u32x4*)(rowp + bj * HALF) = w; } }
    }
};
struct EpiQ {
    static constexpr bool PERM = true;
    bf16_t* Q; const float* TAB;
    __device__ __forceinline__ void operator()(const Acc& acc, const Unit& u, int wr, int wc, int fr, int fq) const {
        const int row0 = u.pm * BM + wr * 64 + fr, col0 = u.pn * BM + wc * 32 + 8 * fq;
#pragma unroll
        for (int ai = 0; ai < 2; ++ai)
#pragma unroll
            for (int m = 0; m < 4; ++m) { const int row = row0 + ai * HALF + m * 16; bf16_t* rowp = Q + (size_t)row * 1536 + col0;
#pragma unroll
                for (int bj = 0; bj < 2; ++bj) { f32x4 v0 = acc[ai][bj][m][0], v1 = acc[ai][bj][m][1];
                    const int c = col0 + bj * HALF, w = c % 192;
                    if (w >= 128) { const int i0 = (w - 128) >> 1; const f32x4 cs = *(const f32x4*)(TAB + (size_t)row * 64 + i0), sn = *(const f32x4*)(TAB + (size_t)row * 64 + 32 + i0);
                        f32x4 r0, r1;
                        r0[0] = v0[0] * cs[0] - v0[1] * sn[0]; r0[1] = v0[1] * cs[0] + v0[0] * sn[0];
                        r0[2] = v0[2] * cs[1] - v0[3] * sn[1]; r0[3] = v0[3] * cs[1] + v0[2] * sn[1];
                        r1[0] = v1[0] * cs[2] - v1[1] * sn[2]; r1[1] = v1[1] * cs[2] + v1[0] * sn[2];
                        r1[2] = v1[2] * cs[3] - v1[3] * sn[3]; r1[3] = v1[3] * cs[3] + v1[2] * sn[3];
                        v0 = r0; v1 = r1; }
                    u32x4 wv; wv.x = cvt_pk_bf16(v0[0], v0[1]); wv.y = cvt_pk_bf16(v0[2], v0[3]); wv.z = cvt_pk_bf16(v1[0], v1[1]); wv.w = cvt_pk_bf16(v1[2], v1[3]);
                    *(u32x4*)(rowp + bj * HALF) = wv; } }
    }
};
struct EpiT1 {
    static constexpr bool PERM = true;
    const bf16_t* G; bf16_t* F;
    __device__ __forceinline__ void operator()(const Acc& acc, const Unit& u, int wr, int wc, int fr, int fq) const {
        const int row0 = u.pm * BM + wr * 64 + fr, col0 = u.pn * BM + wc * 32 + 8 * fq;
#pragma unroll
        for (int ai = 0; ai < 2; ++ai)
#pragma unroll
            for (int m = 0; m < 4; ++m) { const int row = row0 + ai * HALF + m * 16;
#pragma unroll
                for (int bj = 0; bj < 2; ++bj) { const f32x4 v0 = acc[ai][bj][m][0], v1 = acc[ai][bj][m][1]; const int c = col0 + bj * HALF;
                    const u32x4 gw = *(const u32x4*)(G + (size_t)row * 2048 + c);
                    u32x4 wv;
                    wv.x = cvt_pk_bf16(v0[0] * bf_lo(gw.x), v0[1] * bf_hi(gw.x)); wv.y = cvt_pk_bf16(v0[2] * bf_lo(gw.y), v0[3] * bf_hi(gw.y));
                    wv.z = cvt_pk_bf16(v1[0] * bf_lo(gw.z), v1[1] * bf_hi(gw.z)); wv.w = cvt_pk_bf16(v1[2] * bf_lo(gw.w), v1[3] * bf_hi(gw.w));
                    *(u32x4*)(F + (size_t)row * 1024 + c) = wv; } }
    }
};
struct EpiMX {
    static constexpr bool PERM = true;
    const bf16_t* G; const bf16_t* F; bf16_t* MX;
    __device__ __forceinline__ void operator()(const Acc& acc, const Unit& u, int wr, int wc, int fr, int fq) const {
        const int row0 = u.pm * BM + wr * 64 + fr, col0 = u.pn * BM + wc * 32 + 8 * fq;
#pragma unroll
        for (int ai = 0; ai < 2; ++ai)
#pragma unroll
            for (int m = 0; m < 4; ++m) { const int row = row0 + ai * HALF + m * 16;
#pragma unroll
                for (int bj = 0; bj < 2; ++bj) { const f32x4 v0 = acc[ai][bj][m][0], v1 = acc[ai][bj][m][1]; const int c = col0 + bj * HALF;
                    const u32x4 gw = *(const u32x4*)(G + (size_t)row * 2048 + 1024 + c);
                    const u32x4 tw = *(const u32x4*)(F + (size_t)row * 1024 + c);
                    u32x4 wv;
                    wv.x = cvt_pk_bf16(bf_lo(tw.x) + v0[0] * bf_lo(gw.x), bf_hi(tw.x) + v0[1] * bf_hi(gw.x)); wv.y = cvt_pk_bf16(bf_lo(tw.y) + v0[2] * bf_lo(gw.y), bf_hi(tw.y) + v0[3] * bf_hi(gw.y));
                    wv.z = cvt_pk_bf16(bf_lo(tw.z) + v1[0] * bf_lo(gw.z), bf_hi(tw.z) + v1[1] * bf_hi(gw.z)); wv.w = cvt_pk_bf16(bf_lo(tw.w) + v1[2] * bf_lo(gw.w), bf_hi(tw.w) + v1[3] * bf_hi(gw.w));
                    *(u32x4*)(MX + (size_t)row * 1024 + c) = wv; } }
    }
};
}

namespace att {
constexpr int NW = 8, QBLK = 32, KVBLK = 64;
constexpr float SCALE = 0.07216878364870322f;
constexpr float THR = 8.f;
constexpr int LDQ = 1536, LDKV = 2048, LDKR = 64, LDO = 1024;
constexpr int SHM_V = 64 * 128 * 2, SHM_K = 64 * 128 * 2, SHM_R = 64 * 64 * 2;
constexpr int NQL = 4;
constexpr int OFF_V = 0, OFF_K = 2 * SHM_V, OFF_RP = OFF_K + 2 * SHM_K, OFF_WS = OFF_RP + 2 * SHM_R, OFF_QL = OFF_WS + NW * 64 * 4, SHM_ATTN = OFF_QL + NW * NQL * 1024;
static_assert(SHM_ATTN <= LDS_STAGE, "lds");
#define KSWZ(row, colB) ((row) * 256 + ((colB) ^ (((row) & 7) << 4)))
#define RSWZ(row, colB) ((row) * 128 + ((colB) ^ (((row) & 7) << 4)))
#define SBAR() __builtin_amdgcn_sched_barrier(0)
__device__ __forceinline__ int crow(int r, int hi) { return (r & 3) + 8 * (r >> 2) + 4 * hi; }
__device__ __forceinline__ bf16x8 ld8(const bf16_t* p) { return *reinterpret_cast<const bf16x8*>(p); }

__device__ __forceinline__ void partialSM(f32x16& p0, f32x16& p1, float& m_reg, float& mn, float& alpha) {
    constexpr float C = SCALE * 1.4426950408889634f;
    float pmax = p0[0];
#pragma unroll
    for (int r = 1; r < 16; ++r) pmax = fmaxf(pmax, p0[r]);
#pragma unroll
    for (int r = 0; r < 16; ++r) pmax = fmaxf(pmax, p1[r]);
    { auto rr = __builtin_amdgcn_permlane32_swap(__float_as_uint(pmax), __float_as_uint(pmax), false, false);
      pmax = fmaxf(__uint_as_float(rr[0]), __uint_as_float(rr[1])); }
    if (__builtin_expect(__all(pmax - m_reg <= THR / SCALE), 1)) { mn = m_reg; alpha = 1.f; }
    else { mn = fmaxf(m_reg, pmax); alpha = __builtin_amdgcn_exp2f((m_reg - mn) * C); m_reg = mn; }
    float mnC = -mn * C;
#pragma unroll
    for (int r = 0; r < 16; ++r) p0[r] = fmaf(p0[r], C, mnC);
#pragma unroll
    for (int r = 0; r < 16; ++r) p1[r] = fmaf(p1[r], C, mnC);
#pragma unroll
    for (int r = 0; r < 16; ++r) p0[r] = __builtin_amdgcn_exp2f(p0[r]);
}
__device__ __forceinline__ void finishSM(f32x16& p0, f32x16& p1, float alpha, float& l_reg, bf16x8& pa0, bf16x8& pa1, bf16x8& pa2, bf16x8& pa3) {
#pragma unroll
    for (int r = 0; r < 16; ++r) p1[r] = __builtin_amdgcn_exp2f(p1[r]);
    float ps = 0;
#pragma unroll
    for (int r = 0; r < 16; ++r) ps += p0[r];
#pragma unroll
    for (int r = 0; r < 16; ++r) ps += p1[r];
    { auto rr = __builtin_amdgcn_permlane32_swap(__float_as_uint(ps), __float_as_uint(ps), false, false);
      ps = __uint_as_float(rr[0]) + __uint_as_float(rr[1]); }
    l_reg = l_reg * alpha + ps;
#define PK4(P, BASE, OUT) do { unsigned a0 = cvt_pk_bf16(P[BASE + 0], P[BASE + 1]), a1 = cvt_pk_bf16(P[BASE + 2], P[BASE + 3]);   \
    unsigned b0 = cvt_pk_bf16(P[BASE + 4], P[BASE + 5]), b1 = cvt_pk_bf16(P[BASE + 6], P[BASE + 7]);                              \
    auto r0 = __builtin_amdgcn_permlane32_swap(a0, b0, false, false); auto r1 = __builtin_amdgcn_permlane32_swap(a1, b1, false, false); \
    u32x4 w = {r0[0], r1[0], r0[1], r1[1]}; OUT = *reinterpret_cast<bf16x8*>(&w); } while (0)
    PK4(p0, 0, pa0); PK4(p0, 8, pa1); PK4(p1, 0, pa2); PK4(p1, 8, pa3);
#undef PK4
}
__device__ __forceinline__ void qkt(f32x16& p0, f32x16& p1, const char* Ks, const char* Rs, const bf16x8* qr, const char* ql, int r32, int hi) {
    p0 = f32x16{}; p1 = f32x16{};
#pragma unroll
    for (int d0 = 0; d0 < 8; ++d0) { int cb = (d0 * 16 + hi * 8) * 2;
        bf16x8 b0 = *reinterpret_cast<const bf16x8*>(Ks + KSWZ(r32, cb));
        bf16x8 b1 = *reinterpret_cast<const bf16x8*>(Ks + KSWZ(32 + r32, cb));
        p0 = __builtin_amdgcn_mfma_f32_32x32x16_bf16(b0, qr[d0], p0, 0, 0, 0);
        p1 = __builtin_amdgcn_mfma_f32_32x32x16_bf16(b1, qr[d0], p1, 0, 0, 0); }
#pragma unroll
    for (int d0 = 0; d0 < 4; ++d0) { int cb = (d0 * 16 + hi * 8) * 2;
        bf16x8 b0 = *reinterpret_cast<const bf16x8*>(Rs + RSWZ(r32, cb));
        bf16x8 b1 = *reinterpret_cast<const bf16x8*>(Rs + RSWZ(32 + r32, cb));
        const bf16x8 qv = *reinterpret_cast<const bf16x8*>(ql + d0 * 1024);
        p0 = __builtin_amdgcn_mfma_f32_32x32x16_bf16(b0, qv, p0, 0, 0, 0);
        p1 = __builtin_amdgcn_mfma_f32_32x32x16_bf16(b1, qv, p1, 0, 0, 0); }
}
__device__ __forceinline__ int v_st(int k, int c) { const int kk = (k & ~0xC) | ((k & 4) << 1) | ((k & 8) >> 1); return ((kk >> 3) * 4 + (c >> 5)) * 512 + ((kk & 7) * 32 + (c & 31)) * 2; }
__device__ __forceinline__ int v_rd_base(int lane) { return ((lane & 3) << 3) | (((lane >> 2) & 3) << 6) | (((lane >> 4) & 1) << 5) | (((lane >> 5) & 1) << 8); }
constexpr int v_rd_off(int d0, int ks, int half) { return d0 * 512 + ks * 4096 + half * 2048; }
template <int OFF> __device__ __forceinline__ s16x4 tr_read(int vb) {
    s16x4 r; asm volatile("ds_read_b64_tr_b16 %0, %1 offset:%2" : "=&v"(r) : "v"(vb), "i"(OFF) : "memory"); return r;
}
template <int D0> __device__ __forceinline__ void pv_one(f32x16& od, int vb, bf16x8 pa0, bf16x8 pa1, bf16x8 pa2, bf16x8 pa3) {
    const s16x4 l0 = tr_read<v_rd_off(D0, 0, 0)>(vb), h0 = tr_read<v_rd_off(D0, 0, 1)>(vb), l1 = tr_read<v_rd_off(D0, 1, 0)>(vb), h1 = tr_read<v_rd_off(D0, 1, 1)>(vb);
    const s16x4 l2 = tr_read<v_rd_off(D0, 2, 0)>(vb), h2 = tr_read<v_rd_off(D0, 2, 1)>(vb), l3 = tr_read<v_rd_off(D0, 3, 0)>(vb), h3 = tr_read<v_rd_off(D0, 3, 1)>(vb);
    asm volatile("s_waitcnt lgkmcnt(0)" ::: "memory"); SBAR();
#define PK(L, H) (bf16x8){L[0], L[1], L[2], L[3], H[0], H[1], H[2], H[3]}
    od = __builtin_amdgcn_mfma_f32_32x32x16_bf16(pa0, PK(l0, h0), od, 0, 0, 0);
    od = __builtin_amdgcn_mfma_f32_32x32x16_bf16(pa1, PK(l1, h1), od, 0, 0, 0);
    od = __builtin_amdgcn_mfma_f32_32x32x16_bf16(pa2, PK(l2, h2), od, 0, 0, 0);
    od = __builtin_amdgcn_mfma_f32_32x32x16_bf16(pa3, PK(l3, h3), od, 0, 0, 0);
#undef PK
}
__device__ __forceinline__ void pv_d0(f32x16* o, int vb, bf16x8 pa0, bf16x8 pa1, bf16x8 pa2, bf16x8 pa3) {
    pv_one<0>(o[0], vb, pa0, pa1, pa2, pa3); pv_one<1>(o[1], vb, pa0, pa1, pa2, pa3); pv_one<2>(o[2], vb, pa0, pa1, pa2, pa3); pv_one<3>(o[3], vb, pa0, pa1, pa2, pa3);
}

__device__ __forceinline__ void attn_body(const bf16_t* __restrict__ Qb, const bf16_t* __restrict__ Kn, const bf16_t* __restrict__ Kr, const bf16_t* __restrict__ Vh,
                                          bf16_t* __restrict__ Ob, int seq, char* lds) {
    const int tid = fresh_tid(), wid = tid >> 6, lane = tid & 63, r32 = lane & 31, hi = lane >> 5;
    char* V_lds = lds + OFF_V; char* K_lds = lds + OFF_K; char* R_lds = lds + OFF_RP;
    float* ws = (float*)(lds + OFF_WS) + wid * 64; float* li_l = ws; float* al_l = ws + 32;
    float m_reg = -1e30f, l_reg = 0; f32x16 o[4] = {}; bf16x8 qr[8];
    char* ql = lds + OFF_QL + wid * (NQL * 1024) + lane * 16;
    const bf16_t* Qw = Qb + (long)(wid * QBLK + r32) * LDQ + hi * 8;
#pragma unroll
    for (int d0 = 0; d0 < 8; ++d0) qr[d0] = ld8(Qw + d0 * 16);
#pragma unroll
    for (int d0 = 0; d0 < NQL; ++d0) *reinterpret_cast<bf16x8*>(ql + d0 * 1024) = ld8(Qw + (8 + d0) * 16);
    const int sr = tid >> 4, sc = (tid & 15) * 8, vst0 = v_st(sr, sc), vst1 = v_st(32 + sr, sc);
    const int rr_ = tid >> 3, rc_ = (tid & 7) * 8;
    const int vb0 = (int)(uintptr_t)V_lds + v_rd_base(lane);
    bf16x8 vs0, vs1, ks0, ks1, rs0;
#define SLOAD(k0) do { vs0 = ld8(&Vh[(long)((k0) + sr) * LDKV + sc]); vs1 = ld8(&Vh[(long)((k0) + 32 + sr) * LDKV + sc]); \
    ks0 = ld8(&Kn[(long)((k0) + sr) * LDKV + sc]); ks1 = ld8(&Kn[(long)((k0) + 32 + sr) * LDKV + sc]); rs0 = ld8(&Kr[(long)((k0) + rr_) * LDKR + rc_]); } while (0)
#define SWRITE(b) do { *(bf16x8*)(V_lds + (b) * SHM_V + vst0) = vs0; *(bf16x8*)(V_lds + (b) * SHM_V + vst1) = vs1; int kc = sc * 2; \
    *(bf16x8*)(K_lds + (b) * SHM_K + KSWZ(sr, kc)) = ks0; *(bf16x8*)(K_lds + (b) * SHM_K + KSWZ(32 + sr, kc)) = ks1; \
    *(bf16x8*)(R_lds + (b) * SHM_R + RSWZ(rr_, rc_ * 2)) = rs0; } while (0)
#define RESC(a) do { if (__any((a) < 1.f)) { if (hi == 0) al_l[r32] = (a); asm volatile("s_waitcnt lgkmcnt(0)" ::: "memory"); \
    _Pragma("unroll") for (int d = 0; d < 4; ++d) _Pragma("unroll") for (int r = 0; r < 16; ++r) o[d][r] *= al_l[crow(r, hi)]; } } while (0)
    f32x16 pA0, pA1, pB0, pB1; float mnA, mnB, alA, alB; bf16x8 pa0, pa1, pa2, pa3; const int NT = seq / KVBLK;
    SLOAD(0); asm volatile("s_waitcnt vmcnt(0)" ::: "memory"); SWRITE(0); __syncthreads();
    qkt(pA0, pA1, K_lds, R_lds, qr, ql, r32, hi); partialSM(pA0, pA1, m_reg, mnA, alA);
    SLOAD(KVBLK);
    asm volatile("s_waitcnt vmcnt(0)" ::: "memory"); SWRITE(1); __syncthreads();
    for (int j = 1; j + 1 < NT; j += 2) {
        SBAR(); qkt(pB0, pB1, K_lds + SHM_K, R_lds + SHM_R, qr, ql, r32, hi);
        finishSM(pA0, pA1, alA, l_reg, pa0, pa1, pa2, pa3); SBAR();
        SLOAD((j + 1) * KVBLK); SBAR();
        pv_d0(o, vb0, pa0, pa1, pa2, pa3); partialSM(pB0, pB1, m_reg, mnB, alB);
        __syncthreads(); asm volatile("s_waitcnt vmcnt(0)" ::: "memory"); SWRITE(0);
        RESC(alB); __syncthreads();
        SBAR(); qkt(pA0, pA1, K_lds, R_lds, qr, ql, r32, hi);
        finishSM(pB0, pB1, alB, l_reg, pa0, pa1, pa2, pa3); SBAR();
        SLOAD((j + 2) * KVBLK); SBAR();
        pv_d0(o, vb0 + SHM_V, pa0, pa1, pa2, pa3); partialSM(pA0, pA1, m_reg, mnA, alA);
        __syncthreads(); asm volatile("s_waitcnt vmcnt(0)" ::: "memory"); SWRITE(1);
        RESC(alA); __syncthreads();
    }
    SBAR(); qkt(pB0, pB1, K_lds + SHM_K, R_lds + SHM_R, qr, ql, r32, hi);
    finishSM(pA0, pA1, alA, l_reg, pa0, pa1, pa2, pa3); SBAR();
    pv_d0(o, vb0, pa0, pa1, pa2, pa3); partialSM(pB0, pB1, m_reg, mnB, alB);
    __syncthreads(); RESC(alB);
    finishSM(pB0, pB1, alB, l_reg, pa0, pa1, pa2, pa3); SBAR();
    pv_d0(o, vb0 + SHM_V, pa0, pa1, pa2, pa3);
    if (hi == 0) li_l[r32] = l_reg; asm volatile("s_waitcnt lgkmcnt(0)" ::: "memory");
    float rli[16];
#pragma unroll
    for (int r = 0; r < 16; ++r) rli[r] = __builtin_amdgcn_rcpf(li_l[crow(r, hi)]);
    bf16_t* Ow = Ob + (long)(wid * QBLK) * LDO;
#pragma unroll
    for (int r = 0; r < 16; ++r) { int orow = crow(r, hi);
#pragma unroll
        for (int d0 = 0; d0 < 4; ++d0) { const float v = o[d0][r] * rli[r]; Ow[(long)orow * LDO + d0 * 32 + r32] = (bf16_t)(cvt_pk_bf16(v, v) & 0xffffu); } }
#undef SLOAD
#undef SWRITE
#undef RESC
}
}


#define XB_TMO      128
#define XB_XCNT(j)  (256  + 64 * (j))
#define XB_XSUB(j)  (1280 + 64 * (j))
#define XB_XGEN(j)  (2304 + 64 * (j))
#define XB_TOP      3328
#define XB_TOPGEN   3392
#define XCD_BAR_WORDS 3456
#define XB_SPIN_CAP (1u << 18)
__device__ __forceinline__ unsigned xb_ld(unsigned* p)              { return __hip_atomic_load(p, __ATOMIC_RELAXED, __HIP_MEMORY_SCOPE_AGENT); }
__device__ __forceinline__ unsigned xb_add(unsigned* p, unsigned v) { return __hip_atomic_fetch_add(p, v, __ATOMIC_RELAXED, __HIP_MEMORY_SCOPE_AGENT); }
__device__ __forceinline__ unsigned xb_xcc_id() { return (unsigned)__builtin_amdgcn_s_getreg((3 << 11) | 20) & 0xFu; }
#define XB_SPIN(cond, bar) do { unsigned _sp = 0; while (cond) { __builtin_amdgcn_s_sleep(1); \
    if ((++_sp & 255u) == 0u) { if (xb_ld(&(bar)[XB_TMO])) break; if (_sp > XB_SPIN_CAP) { atomicAdd(&(bar)[XB_TMO], 1u); break; } } } } while (0)
struct XcdBarrier { unsigned* bar; unsigned x; volatile LAS unsigned* st; };
__device__ __forceinline__ XcdBarrier xcd_barrier_post(unsigned* bar, volatile LAS unsigned* st) {
    XcdBarrier b; b.bar = bar; b.x = xb_xcc_id(); b.st = st;
    if (threadIdx.x == 0) (void)xb_add(&bar[XB_XCNT(b.x)], 1u);
    return b;
}
__device__ __forceinline__ void xcd_barrier_complete(unsigned* bar, unsigned x, unsigned& nloc, unsigned& nx) {
    const unsigned G = gridDim.x * gridDim.y * gridDim.z;
    unsigned sum, cnt, mine, sp = 0u;
    for (;;) {
        sum = 0u; cnt = 0u; mine = 0u;
#pragma unroll
        for (unsigned j = 0; j < 16; ++j) { const unsigned c = xb_ld(&bar[XB_XCNT(j)]); sum += c; cnt += (c > 0u) ? 1u : 0u; mine = (j == x) ? c : mine; }
        if (sum == G) break;
        __builtin_amdgcn_s_sleep(1);
        if ((++sp & 255u) == 0u) { if (xb_ld(&bar[XB_TMO])) break; if (sp > XB_SPIN_CAP) { atomicAdd(&bar[XB_TMO], 1u); break; } }
    }
    nloc = mine > 0u ? mine : 1u; nx = cnt > 0u ? cnt : 1u;
}
__device__ __forceinline__ void xcd_barrier(const XcdBarrier& b) {
    asm volatile("s_waitcnt vmcnt(0)" ::: "memory");
    __syncthreads();
    if (threadIdx.x == 0) {
        unsigned* bar = b.bar;
        __builtin_amdgcn_s_waitcnt(0);
        unsigned nloc = b.st[0], nx = b.st[1];
        if (nloc == 0u) { xcd_barrier_complete(bar, b.x, nloc, nx); b.st[0] = nloc; b.st[1] = nx; }
        const unsigned old = xb_add(&bar[XB_XSUB(b.x)], 1u);
        const unsigned gen = old / nloc;
        if (old + 1u == (gen + 1u) * nloc) {
            __builtin_amdgcn_fence(__ATOMIC_RELEASE, "agent");
            asm volatile("s_waitcnt vmcnt(0)" ::: "memory");
            const unsigned og = xb_add(&bar[XB_TOP], 1u);
            const unsigned tg = og / nx;
            if (og + 1u == (tg + 1u) * nx) xb_add(&bar[XB_TOPGEN], 1u);
            else XB_SPIN(xb_ld(&bar[XB_TOPGEN]) == tg, bar);
            __builtin_amdgcn_fence(__ATOMIC_ACQUIRE, "agent");
            xb_add(&bar[XB_XGEN(b.x)], 1u);
            asm volatile("s_waitcnt vmcnt(0)" ::: "memory");
        } else {
            XB_SPIN(xb_ld(&bar[XB_XGEN(b.x)]) == gen, bar);
            __builtin_amdgcn_fence(__ATOMIC_ACQUIRE, "agent");
            asm volatile("s_waitcnt vmcnt(0)" ::: "memory");
        }
    }
    __syncthreads();
}

enum { TR_PLAIN = 0, TR_GU = 1, TR_WIN = 2, TR_UQ = 3, TR_UKV = 4 };
template <int MODE>
__device__ __forceinline__ void tr_job(const float* W0, const float* W1, int K, int Nsrc, int Nout, bf16_t* WT, LAS float* scr, int lane, int gw, int NGW) {
    const int nblk = Nout / 32, nitems = (K / 64) * nblk;
    for (int it = gw; it < nitems; it += NGW) {
        const int kb = it / nblk, nb = it % nblk, k0 = 64 * kb, n0 = 32 * nb, np = n0 + (lane & 31);
        const float* colp;
        if (MODE == TR_PLAIN) colp = W0 + np;
        else if (MODE == TR_GU) { const int t = np >> 8, w = np & 255; colp = (w < 128 ? W0 : W1) + t * 128 + (w & 127); }
        else if (MODE == TR_WIN) colp = np < 1216 ? W0 + np : (np < 1280 ? nullptr : W0 + (np - 64));
        else if (MODE == TR_UQ) { const int h = np / 192, w = np % 192; colp = W0 + (w < 128 ? np : h * 192 + 128 + ((w - 128) >> 1) + ((w - 128) & 1) * 32); }
        else colp = np < 1024 ? W0 + np : W1 + (np - 1024);
        float tv[32];
#pragma unroll
        for (int i = 0; i < 32; ++i) { const int kk = 2 * i + (lane >> 5); tv[i] = colp ? colp[(size_t)(k0 + kk) * Nsrc] : 0.f; }
#pragma unroll
        for (int i = 0; i < 32; ++i) { const int kk = 2 * i + (lane >> 5); scr[kk * 33 + (lane & 31)] = tv[i]; }
        asm volatile("s_waitcnt lgkmcnt(0)" ::: "memory");
        const int c = lane & 7;
#pragma unroll
        for (int j = 0; j < 4; ++j) { const int n = (lane >> 3) + 8 * j; const LAS float* s = scr + (8 * c) * 33 + n;
            u32x4 o; o.x = cvt_pk_bf16(s[0 * 33], s[1 * 33]); o.y = cvt_pk_bf16(s[2 * 33], s[3 * 33]); o.z = cvt_pk_bf16(s[4 * 33], s[5 * 33]); o.w = cvt_pk_bf16(s[6 * 33], s[7 * 33]);
            *(u32x4*)(WT + (size_t)(n0 + n) * K + k0 + 8 * c) = o; }
        asm volatile("s_waitcnt lgkmcnt(0)" ::: "memory");
    }
}

template <int MODE>
__device__ __forceinline__ void rows_phase(const float* xin, const bf16_t* f, float wt, const float* gpost, const float* gnext, float* xout, bf16_t* xn, int gw, int NGW, int lane) {
    for (int row0 = gw; row0 < M; row0 += 2 * NGW) {
        f32x4 xv[2][4]; u32x2 fw[2][4];
#pragma unroll
        for (int r = 0; r < 2; ++r) { const size_t row = (size_t)(row0 + r * NGW);
#pragma unroll
            for (int j = 0; j < 4; ++j) { xv[r][j] = *(const f32x4*)(xin + row * DM + 4 * (lane + 64 * j));
                if (MODE != 0) fw[r][j] = *(const u32x2*)(f + row * DM + 4 * (lane + 64 * j)); } }
#pragma unroll
        for (int r = 0; r < 2; ++r) { const size_t row = (size_t)(row0 + r * NGW);
            if (MODE != 0) {
                f32x4 fv[4]; float ss = 0.f;
#pragma unroll
                for (int j = 0; j < 4; ++j) { fv[j] = (f32x4){bf_lo(fw[r][j].x), bf_hi(fw[r][j].x), bf_lo(fw[r][j].y), bf_hi(fw[r][j].y)}; ss += fv[j].x * fv[j].x + fv[j].y * fv[j].y + fv[j].z * fv[j].z + fv[j].w * fv[j].w; }
                const float rr = wt * __builtin_amdgcn_rsqf(wave_sum(ss) * (1.f / DM) + EPS);
#pragma unroll
                for (int j = 0; j < 4; ++j) { const f32x4 g = *(const f32x4*)(gpost + 4 * (lane + 64 * j)); xv[r][j] = xv[r][j] + fv[j] * g * rr; }
                if (MODE == 1) {
#pragma unroll
                    for (int j = 0; j < 4; ++j) *(f32x4*)(xout + row * DM + 4 * (lane + 64 * j)) = xv[r][j];
                }
            }
            float s2 = 0.f;
#pragma unroll
            for (int j = 0; j < 4; ++j) s2 += xv[r][j].x * xv[r][j].x + xv[r][j].y * xv[r][j].y + xv[r][j].z * xv[r][j].z + xv[r][j].w * xv[r][j].w;
            const float r2 = __builtin_amdgcn_rsqf(wave_sum(s2) * (1.f / DM) + EPS);
#pragma unroll
            for (int j = 0; j < 4; ++j) { const f32x4 g = *(const f32x4*)(gnext + 4 * (lane + 64 * j)); const f32x4 y = xv[r][j] * g * r2;
                if (MODE == 2) *(f32x4*)(xout + row * DM + 4 * (lane + 64 * j)) = y;
                else { u32x2 w; w.x = cvt_pk_bf16(y.x, y.y); w.y = cvt_pk_bf16(y.z, y.w); *(u32x2*)(xn + row * DM + 4 * (lane + 64 * j)) = w; } }
        }
    }
}

__global__ void __launch_bounds__(NTHREADS, 2) fwd_megakernel(Params p) {
    extern __shared__ __attribute__((aligned(16))) unsigned char lds[];
    cg::grid_group grid = cg::this_grid();
    volatile LAS unsigned* bst = (volatile LAS unsigned*)((LAS unsigned char*)lds + LDS_STAGE);
    if (threadIdx.x < 2) bst[threadIdx.x] = 0u;
    __syncthreads();
    const XcdBarrier xbar = xcd_barrier_post((unsigned*)(p.ws + WS_END), bst);
#define GRID_SYNC_CG() do { __builtin_amdgcn_fence(__ATOMIC_RELEASE, "agent"); asm volatile("s_waitcnt vmcnt(0)" ::: "memory"); grid.sync(); \
        __builtin_amdgcn_fence(__ATOMIC_ACQUIRE, "agent"); asm volatile("s_waitcnt vmcnt(0)" ::: "memory"); } while (0)
#define GRID_SYNC() xcd_barrier(xbar)
    const int G = gridDim.x, bid = blockIdx.x, NGW = G * NWAVES;
    LAS unsigned char* ldsl = (LAS unsigned char*)lds;
#define PHASE_IDS() const int tid = fresh_tid(), lane = tid & 63, wave = tid >> 6, gw = bid * NWAVES + wave; LAS float* scr = (LAS float*)(ldsl + wave * 8448); (void)scr; (void)gw; (void)lane
    unsigned char* ws = p.ws;
    bf16_t* Wgu = (bf16_t*)(ws + OFF_WGU); bf16_t* Wd = (bf16_t*)(ws + OFF_WD); bf16_t* Win = (bf16_t*)(ws + OFF_WIN); bf16_t* Wuq = (bf16_t*)(ws + OFF_WUQ);
    bf16_t* Wukv = (bf16_t*)(ws + OFF_WUKV); bf16_t* Woa = (bf16_t*)(ws + OFF_WOA); bf16_t* Wp = (bf16_t*)(ws + OFF_WP); bf16_t* Wout = (bf16_t*)(ws + OFF_WOUT);
    bf16_t* XN = (bf16_t*)(ws + OFF_XN); bf16_t* F = (bf16_t*)(ws + OFF_F); float* ZF = (float*)(ws + OFF_ZF); bf16_t* KV = (bf16_t*)(ws + OFF_KV);
    bf16_t* H = (bf16_t*)(ws + OFF_H); bf16_t* O = (bf16_t*)(ws + OFF_O); bf16_t* CQN = (bf16_t*)(ws + OFF_CQN); bf16_t* CKVN = (bf16_t*)(ws + OFF_CKVN);
    float* TAB = (float*)(ws + OFF_TAB); bf16_t* Q = (bf16_t*)(ws + OFF_Q); bf16_t* KR = (bf16_t*)(ws + OFF_KR); bf16_t* Gt = (bf16_t*)(ws + OFF_G); bf16_t* DP = (bf16_t*)(ws + OFF_DP);
    float* X = p.out;

    { PHASE_IDS();
    tr_job<TR_GU>(p.f1_wg, p.f1_wu, 1024, DFF, 5632, Wgu, scr, lane, gw, NGW);
    tr_job<TR_PLAIN>(p.f1_wd, nullptr, DFF, 1024, 1024, Wd, scr, lane, gw, NGW);
    rows_phase<0>(p.x, nullptr, 0.f, nullptr, p.f1_pre, nullptr, XN, gw, NGW, lane); }
    GRID_SYNC_CG();

    pg8::StaticOrder S;
    { pg8::Gemm g{XN, Wgu, M, 5632, 1024}; S.init(M, 5632, G, bid); pg8::EpiSwiGLU E{H}; pg8::gemm_phase(ldsl, g, S, E); }
    {
        const int tail0 = (64 * 22) % G;
        if (tail0 != 0 && bid >= tail0) { PHASE_IDS(); const int tb = bid - tail0, nb = G - tail0, tgw = tb * NWAVES + wave, TNGW = nb * NWAVES;
            tr_job<TR_WIN>(p.w_in, nullptr, 1024, INW, 3328, Win, scr, lane, tgw, TNGW);
            tr_job<TR_UQ>(p.w_uq, nullptr, QL, 1536, 1536, Wuq, scr, lane, tgw, TNGW);
            tr_job<TR_UKV>(p.w_uk, p.w_uv, KVL, 1024, 2048, Wukv, scr, lane, tgw, TNGW);
            tr_job<TR_PLAIN>(p.w_oa, nullptr, 1024, 1024, 1024, Woa, scr, lane, tgw, TNGW);
            tr_job<TR_PLAIN>(p.w_out, nullptr, 1024, 1024, 1024, Wout, scr, lane, tgw, TNGW);
    for (int idx = tb * NTHREADS + tid; idx < 65536; idx += nb * NTHREADS) {
            const int n = idx & 1023, c8 = idx >> 10, g = c8 >> 4, cb = (c8 & 15) * 8;
            float a[8];
    #pragma unroll
            for (int i = 0; i < 8; ++i) a[i] = 0.f;
            for (int j0 = 0; j0 < 128; j0 += 8) { float w[8]; f32x4 pw[8][2];
    #pragma unroll
                for (int jj = 0; jj < 8; ++jj) w[jj] = p.w_op[(size_t)(g * 128 + j0 + jj) * 1024 + n] * p.pool_scale[g * 128 + j0 + jj];
    #pragma unroll
                for (int i = 0; i < 8; ++i) { pw[i][0] = *(const f32x4*)(p.pool_w + (size_t)(g * 128 + cb + i) * 128 + j0); pw[i][1] = *(const f32x4*)(p.pool_w + (size_t)(g * 128 + cb + i) * 128 + j0 + 4); }
    #pragma unroll
                for (int i = 0; i < 8; ++i)
    #pragma unroll
                    for (int jj = 0; jj < 8; ++jj) a[i] = fmaf(pw[i][jj >> 2][jj & 3], w[jj], a[i]); }
            u32x4 o; o.x = cvt_pk_bf16(a[0], a[1]); o.y = cvt_pk_bf16(a[2], a[3]); o.z = cvt_pk_bf16(a[4], a[5]); o.w = cvt_pk_bf16(a[6], a[7]);
            *(u32x4*)(Wp + (size_t)n * 512 + c8 * 8) = o;
        }
        }
        else if (tail0 == 0) { PHASE_IDS(); const int tb = bid, nb = G;
            tr_job<TR_WIN>(p.w_in, nullptr, 1024, INW, 3328, Win, scr, lane, gw, NGW);
            tr_job<TR_UQ>(p.w_uq, nullptr, QL, 1536, 1536, Wuq, scr, lane, gw, NGW);
            tr_job<TR_UKV>(p.w_uk, p.w_uv, KVL, 1024, 2048, Wukv, scr, lane, gw, NGW);
            tr_job<TR_PLAIN>(p.w_oa, nullptr, 1024, 1024, 1024, Woa, scr, lane, gw, NGW);
            tr_job<TR_PLAIN>(p.w_out, nullptr, 1024, 1024, 1024, Wout, scr, lane, gw, NGW);
    for (int idx = tb * NTHREADS + tid; idx < 65536; idx += nb * NTHREADS) {
            const int n = idx & 1023, c8 = idx >> 10, g = c8 >> 4, cb = (c8 & 15) * 8;
            float a[8];
    #pragma unroll
            for (int i = 0; i < 8; ++i) a[i] = 0.f;
            for (int j0 = 0; j0 < 128; j0 += 8) { float w[8]; f32x4 pw[8][2];
    #pragma unroll
                for (int jj = 0; jj < 8; ++jj) w[jj] = p.w_op[(size_t)(g * 128 + j0 + jj) * 1024 + n] * p.pool_scale[g * 128 + j0 + jj];
    #pragma unroll
                for (int i = 0; i < 8; ++i) { pw[i][0] = *(const f32x4*)(p.pool_w + (size_t)(g * 128 + cb + i) * 128 + j0); pw[i][1] = *(const f32x4*)(p.pool_w + (size_t)(g * 128 + cb + i) * 128 + j0 + 4); }
    #pragma unroll
                for (int i = 0; i < 8; ++i)
    #pragma unroll
                    for (int jj = 0; jj < 8; ++jj) a[i] = fmaf(pw[i][jj >> 2][jj & 3], w[jj], a[i]); }
            u32x4 o; o.x = cvt_pk_bf16(a[0], a[1]); o.y = cvt_pk_bf16(a[2], a[3]); o.z = cvt_pk_bf16(a[4], a[5]); o.w = cvt_pk_bf16(a[6], a[7]);
            *(u32x4*)(Wp + (size_t)n * 512 + c8 * 8) = o;
        }
        }
    }
    GRID_SYNC();
    { pg8::Gemm g{H, Wd, M, 1024, DFF}; S.init(M, 1024, G, bid); pg8::EpiBf16 E{F, 1024}; pg8::gemm_phase(ldsl, g, S, E); }
    GRID_SYNC();
    { PHASE_IDS(); rows_phase<1>(p.x, F, 0.5f, p.f1_post, p.mix_pre, X, XN, gw, NGW, lane); }
    GRID_SYNC();
    { pg8::Gemm g{XN, Win, M, 1280, 1024}; S.init(M, 1280, G, bid); pg8::EpiF32 E{ZF, 1280}; pg8::gemm_phase(ldsl, g, S, E); }
    {
        const int tail0 = (64 * 5) % G; PHASE_IDS();
        if (tail0 != 0 && bid >= tail0) { const int tgw = (bid - tail0) * NWAVES + wave, TNGW = (G - tail0) * NWAVES;
            tr_job<TR_GU>(p.f2_wg, p.f2_wu, 1024, DFF, 5632, Wgu, scr, lane, tgw, TNGW);
            tr_job<TR_PLAIN>(p.f2_wd, nullptr, DFF, 1024, 1024, Wd, scr, lane, tgw, TNGW); }
        else if (tail0 == 0) { tr_job<TR_GU>(p.f2_wg, p.f2_wu, 1024, DFF, 5632, Wgu, scr, lane, gw, NGW); tr_job<TR_PLAIN>(p.f2_wd, nullptr, DFF, 1024, 1024, Wd, scr, lane, gw, NGW); }
    }
    GRID_SYNC();
    { PHASE_IDS();
    for (int row = gw; row < M; row += NGW) {
        const float* z = ZF + (size_t)row * 1280;
        {
            f32x4 a = *(const f32x4*)(z + 4 * lane), b = (f32x4){0.f, 0.f, 0.f, 0.f};
            if (lane < 32) b = *(const f32x4*)(z + 4 * (lane + 64));
            float ss = a.x * a.x + a.y * a.y + a.z * a.z + a.w * a.w + b.x * b.x + b.y * b.y + b.z * b.z + b.w * b.w;
            const float r = __builtin_amdgcn_rsqf(wave_sum(ss) * (1.f / QL) + EPS);
            { const f32x4 g = *(const f32x4*)(p.qa_g + 4 * lane); const f32x4 y = a * g * r; u32x2 w; w.x = cvt_pk_bf16(y.x, y.y); w.y = cvt_pk_bf16(y.z, y.w); *(u32x2*)(CQN + (size_t)row * QL + 4 * lane) = w; }
            if (lane < 32) { const f32x4 g = *(const f32x4*)(p.qa_g + 4 * (lane + 64)); const f32x4 y = b * g * r; u32x2 w; w.x = cvt_pk_bf16(y.x, y.y); w.y = cvt_pk_bf16(y.z, y.w); *(u32x2*)(CQN + (size_t)row * QL + 4 * (lane + 64)) = w; }
        }
        {
            const f32x4 a = *(const f32x4*)(z + 384 + 4 * lane);
            const float ss = a.x * a.x + a.y * a.y + a.z * a.z + a.w * a.w;
            const float r = __builtin_amdgcn_rsqf(wave_sum(ss) * (1.f / KVL) + EPS);
            const f32x4 g = *(const f32x4*)(p.kva_g + 4 * lane); const f32x4 y = a * g * r; u32x2 w; w.x = cvt_pk_bf16(y.x, y.y); w.y = cvt_pk_bf16(y.z, y.w); *(u32x2*)(CKVN + (size_t)row * KVL + 4 * lane) = w;
        }
        if (lane < 32) {
            const float x1 = z[640 + lane], x2 = z[672 + lane];
            const float ang = (float)p.pos[row] * p.inv_freq[lane];
            const double ad = (double)ang; const double kq = rint(ad * 0.15915494309189535); const float red = (float)(ad - kq * 6.283185307179586);
            const float cs = __cosf(red), sn = __sinf(red);
            TAB[(size_t)row * 64 + lane] = cs; TAB[(size_t)row * 64 + 32 + lane] = sn;
            *(unsigned*)(KR + (size_t)row * 64 + 2 * lane) = cvt_pk_bf16(x1 * cs - x2 * sn, x2 * cs + x1 * sn);
        }
        {
            const int t = row & (SEQ - 1), g = lane >> 4, wnd = 2 << g, lo = max(t - (wnd >> 1), 0), hi = min(t + wnd - (wnd >> 1), SEQ);
            const float* zp = z + 704 + 8 * lane;
            f32x4 s0 = (f32x4){0.f, 0.f, 0.f, 0.f}, s1 = s0;
            for (int dt = -8; dt < 8; ++dt) { const int tt = t + dt;
                if (tt >= lo && tt < hi) { const float* q = zp + (long)dt * 1280; s0 = s0 + *(const f32x4*)q; s1 = s1 + *(const f32x4*)(q + 4); } }
            const float inv = 1.f / (float)(hi - lo);
            const f32x4 c0 = *(const f32x4*)zp, c1 = *(const f32x4*)(zp + 4);
            const f32x4 d0 = s0 * inv - c0, d1 = s1 * inv - c1;
            u32x4 w; w.x = cvt_pk_bf16(d0.x, d0.y); w.y = cvt_pk_bf16(d0.z, d0.w); w.z = cvt_pk_bf16(d1.x, d1.y); w.w = cvt_pk_bf16(d1.z, d1.w);
            *(u32x4*)(DP + (size_t)row * 512 + 8 * lane) = w;
        }
    } }
    GRID_SYNC();
    { pg8::Gemm g{CQN, Wuq, M, 1536, QL}; S.init(M, 1536, G, bid); pg8::EpiQ E{Q, TAB}; pg8::gemm_phase(ldsl, g, S, E); }
    { pg8::Gemm g{CKVN, Wukv, M, 2048, KVL}; S.init(M, 2048, G, bid); pg8::EpiBf16 E{KV, 2048}; pg8::gemm_phase(ldsl, g, S, E); }
    GRID_SYNC();
    {
        const int vcu = (bid & 7) * (G >> 3) + (bid >> 3);
        for (int it = vcu; it < NB * NH * (SEQ / 256); it += G) {
            const int qb = it & 7, h = (it >> 3) & 7, b = it >> 6;
            const size_t tok0 = (size_t)b * SEQ;
            att::attn_body(Q + (tok0 + qb * 256) * 1536 + h * 192, KV + tok0 * 2048 + h * 128, KR + tok0 * 64, KV + tok0 * 2048 + 1024 + h * 128,
                           O + (tok0 + qb * 256) * 1024 + h * 128, SEQ, (char*)lds);
            __syncthreads();
        }
    }
    GRID_SYNC();
    { pg8::Gemm g{XN, Win + (size_t)1280 * 1024, M, 2048, 1024}; S.init(M, 2048, G, bid); pg8::EpiGate E{Gt}; pg8::gemm_phase(ldsl, g, S, E); }
    GRID_SYNC();
    { pg8::Gemm g{O, Woa, M, 1024, 1024}; S.init(M, 1024, G, bid); pg8::EpiT1 E{Gt, F}; pg8::gemm_phase(ldsl, g, S, E); }
    { pg8::Gemm g{DP, Wp, M, 1024, 512}; S.init(M, 1024, G, bid); pg8::EpiMX E{Gt, F, XN}; pg8::gemm_phase(ldsl, g, S, E); }
    GRID_SYNC();
    { pg8::Gemm g{XN, Wout, M, 1024, 1024}; S.init(M, 1024, G, bid); pg8::EpiBf16 E{F, 1024}; pg8::gemm_phase(ldsl, g, S, E); }
    GRID_SYNC();
    { PHASE_IDS();
    rows_phase<1>(X, F, 1.0f, p.mix_post, p.f2_pre, X, XN, gw, NGW, lane); }
    GRID_SYNC();
    { pg8::Gemm g{XN, Wgu, M, 5632, 1024}; S.init(M, 5632, G, bid); pg8::EpiSwiGLU E{H}; pg8::gemm_phase(ldsl, g, S, E); }
    GRID_SYNC();
    { pg8::Gemm g{H, Wd, M, 1024, DFF}; S.init(M, 1024, G, bid); pg8::EpiBf16 E{F, 1024}; pg8::gemm_phase(ldsl, g, S, E); }
    GRID_SYNC();
    { PHASE_IDS(); rows_phase<2>(X, F, 0.5f, p.f2_post, p.final_g, X, nullptr, gw, NGW, lane); }
}

extern "C" void kernel_launch(void* const* d_in, const int* in_sizes, int n_in, void* d_out, int out_size, void* d_ws, size_t ws_size, hipStream_t stream) {
    static int grid_blocks = 0;
    if (grid_blocks == 0) {
        if (n_in != 26 || in_sizes[0] != M * DM || out_size != M * DM || ws_size < WS_END) { fprintf(stderr, "kernel_launch: shape mismatch n_in %d in0 %d out %d ws %zu\n", n_in, n_in > 0 ? in_sizes[0] : -1, out_size, ws_size); grid_blocks = -1; return; }
        int dev = 0, cus = 0, per_cu = 0;
        (void)hipGetDevice(&dev);
        (void)hipDeviceGetAttribute(&cus, hipDeviceAttributeMultiprocessorCount, dev);
        if (hipFuncSetAttribute((const void*)fwd_megakernel, hipFuncAttributeMaxDynamicSharedMemorySize, LDS_BYTES) != hipSuccess) { fprintf(stderr, "kernel_launch: hipFuncSetAttribute failed\n"); grid_blocks = -1; return; }
        if (hipOccupancyMaxActiveBlocksPerMultiprocessor(&per_cu, (const void*)fwd_megakernel, NTHREADS, LDS_BYTES) != hipSuccess || per_cu < 1) { fprintf(stderr, "kernel_launch: occupancy query failed (%d)\n", per_cu); (void)hipGetLastError(); per_cu = 1; }
        grid_blocks = cus * 1;
        if (grid_blocks % 8 != 0) grid_blocks -= grid_blocks % 8;
    }
    if (grid_blocks < 0) return;
    Params p{};
    p.x = (const float*)d_in[0]; p.pos = (const int*)d_in[1];
    p.f1_pre = (const float*)d_in[2]; p.f1_wg = (const float*)d_in[3]; p.f1_wu = (const float*)d_in[4]; p.f1_wd = (const float*)d_in[5]; p.f1_post = (const float*)d_in[6];
    p.mix_pre = (const float*)d_in[7]; p.w_in = (const float*)d_in[8]; p.qa_g = (const float*)d_in[9]; p.w_uq = (const float*)d_in[10]; p.kva_g = (const float*)d_in[11];
    p.w_uk = (const float*)d_in[12]; p.w_uv = (const float*)d_in[13]; p.w_oa = (const float*)d_in[14]; p.pool_w = (const float*)d_in[15]; p.pool_scale = (const float*)d_in[16];
    p.w_op = (const float*)d_in[17]; p.w_out = (const float*)d_in[18]; p.mix_post = (const float*)d_in[19];
    p.f2_pre = (const float*)d_in[20]; p.f2_wg = (const float*)d_in[21]; p.f2_wu = (const float*)d_in[22]; p.f2_wd = (const float*)d_in[23]; p.f2_post = (const float*)d_in[24]; p.final_g = (const float*)d_in[25];
    p.out = (float*)d_out; p.ws = (unsigned char*)d_ws;
    for (int i = 0; i < 32; ++i) p.inv_freq[i] = (float)pow(10000.0, -(2.0 * i) / 64.0);
    if (hipMemsetAsync((char*)d_ws + WS_END, 0, 16384, stream) != hipSuccess) { fprintf(stderr, "kernel_launch: memset failed\n"); return; }
    void* args[] = {&p};
    hipError_t e = hipLaunchCooperativeKernel((const void*)fwd_megakernel, dim3(grid_blocks), dim3(NTHREADS), args, LDS_BYTES, stream);
    if (e != hipSuccess) fprintf(stderr, "cooperative launch failed: %s (grid %d)\n", hipGetErrorString(e), grid_blocks);
}
```

```cpp
#include <hip/hip_runtime.h>
#include <hip/hip_cooperative_groups.h>
#include <cstdio>
#include <cmath>
#include <cstdint>
namespace cg = cooperative_groups;

#define LAS __attribute__((address_space(3)))
typedef unsigned short bf16_t;
typedef short bf16x8 __attribute__((ext_vector_type(8)));
typedef short s16x4 __attribute__((ext_vector_type(4)));
typedef float f32x2 __attribute__((ext_vector_type(2)));
typedef float f32x4 __attribute__((ext_vector_type(4)));
typedef float f32x16 __attribute__((ext_vector_type(16)));
typedef unsigned u32x4 __attribute__((ext_vector_type(4)));
typedef unsigned u32x2 __attribute__((ext_vector_type(2)));

constexpr int DM = 1024, NB = 8, SEQ = 2048, M = NB * SEQ, NH = 8, QL = 384, KVL = 256, DFF = 2816, INW = 3264;
constexpr float EPS = 1e-6f;
constexpr int NTHREADS = 512, NWAVES = 8;
constexpr int LDS_STAGE = 131072, LDS_BYTES = LDS_STAGE + 16;

constexpr size_t MiB = 1048576;
constexpr size_t OFF_WGU = 0;
constexpr size_t OFF_WD = OFF_WGU + (size_t)5632 * 1024 * 2;
constexpr size_t OFF_WIN = OFF_WD + (size_t)1024 * 2816 * 2;
constexpr size_t OFF_WUQ = OFF_WIN + (size_t)3328 * 1024 * 2;
constexpr size_t OFF_WUKV = OFF_WUQ + (size_t)1536 * 384 * 2;
constexpr size_t OFF_WOA = OFF_WUKV + (size_t)2048 * 256 * 2;
constexpr size_t OFF_WP = OFF_WOA + (size_t)1024 * 1024 * 2;
constexpr size_t OFF_WOUT = OFF_WP + (size_t)1024 * 512 * 2;
constexpr size_t OFF_XN = OFF_WOUT + (size_t)1024 * 1024 * 2;
constexpr size_t OFF_R = OFF_XN + 32 * MiB;
constexpr size_t OFF_F = OFF_R;
constexpr size_t OFF_ZF = OFF_R;
constexpr size_t OFF_KV = OFF_R;
constexpr size_t OFF_H = OFF_R + 64 * MiB;
constexpr size_t OFF_O = OFF_R + 64 * MiB;
constexpr size_t OFF_CQN = OFF_R + 80 * MiB;
constexpr size_t OFF_CKVN = OFF_R + 92 * MiB;
constexpr size_t OFF_TAB = OFF_R + 100 * MiB;
constexpr size_t OFF_Q = OFF_R + 104 * MiB;
constexpr size_t OFF_KR = OFF_R + 152 * MiB;
constexpr size_t OFF_G = OFF_R + 96 * MiB;
constexpr size_t OFF_DP = OFF_R + 176 * MiB;
constexpr size_t WS_END = OFF_R + 192 * MiB;
constexpr size_t OFF_BAR = WS_END, OFF_CNT = OFF_BAR + 16384, CTL_BYTES = 16384 + 6 * 16384, OFF_XBUF = OFF_BAR + CTL_BYTES;
static_assert(OFF_XBUF + 6 * (size_t)M * 16 <= 256 * MiB, "workspace");

struct Params {
    const float* x; const int* pos;
    const float *f1_pre, *f1_wg, *f1_wu, *f1_wd, *f1_post;
    const float *mix_pre, *w_in, *qa_g, *w_uq, *kva_g, *w_uk, *w_uv, *w_oa, *pool_w, *pool_scale, *w_op, *w_out, *mix_post;
    const float *f2_pre, *f2_wg, *f2_wu, *f2_wd, *f2_post, *final_g;
    float* out; unsigned char* ws;
    float inv_freq[32];
};

typedef __bf16 bf16x2_t __attribute__((ext_vector_type(2)));
__device__ __forceinline__ unsigned cvt_pk_bf16(float lo, float hi) { const f32x2 v = {lo, hi}; const bf16x2_t r = __builtin_convertvector(v, bf16x2_t); return __builtin_bit_cast(unsigned, r); }
__device__ __forceinline__ float bf_lo(unsigned w) { return __uint_as_float(w << 16); }
__device__ __forceinline__ float bf_hi(unsigned w) { return __uint_as_float(w & 0xffff0000u); }
__device__ __forceinline__ float sigmoidf_fast(float z) { return __builtin_amdgcn_rcpf(1.f + __builtin_amdgcn_exp2f(-1.4426950408889634f * z)); }
__device__ __forceinline__ int fresh_tid() { int t = threadIdx.x; asm volatile("" : "+v"(t)); return t; }
__device__ __forceinline__ float wave_sum(float v) {
#pragma unroll
    for (int o = 1; o < 64; o <<= 1) v += __shfl_xor(v, o);
    return v;
}

namespace pg8 {
constexpr int BM = 256, BK = 64, HALF = 128, HTB = HALF * BK * 2, STAGE_BYTES = 8 * HTB, NXCD = 8, WGM = 8;
__host__ __device__ __forceinline__ int lds_byte(int r, int c) { const int st = (r >> 4) * 2 + (c >> 5), rr = r & 15, cc = c & 31, ob = rr * 64 + cc * 2; return st * 1024 + (ob ^ (((ob >> 9) & 1) << 5)); }
__host__ __device__ __forceinline__ void stage_rc(int b, int& R, int& C) { const int st = b / 1024, sb = b % 1024, swz = sb ^ (((sb >> 9) & 1) << 5); R = (st >> 1) * 16 + swz / 64; C = (st & 1) * 32 + (swz % 64) / 2; }
__host__ __device__ __forceinline__ int perm32(int rho) { const int n = rho >> 4, i = rho & 15; return 8 * (i >> 2) + 4 * n + (i & 3); }
struct Unit { int pm, pn; };
struct Gemm { const bf16_t* A; const bf16_t* Bt; int M, N, K; };
struct StaticOrder {
    int nM, nN, nwg, G, c;
    __device__ void init(int M_, int N_, int G_, int c_) { nM = M_ / BM; nN = N_ / BM; nwg = nM * nN; G = G_; c = c_; }
    __device__ bool next(int i, Unit& u) const {
        const long L = (long)i * G + c; if (L >= nwg) return false;
        int wgid = (int)L; { const int q = nwg / NXCD, r = nwg % NXCD, xcd = wgid % NXCD, off = wgid / NXCD; wgid = (xcd < r ? xcd * (q + 1) : r * (q + 1) + (xcd - r) * q) + off; }
        const int nig = WGM * nN, gid = wgid / nig, fm = gid * WGM, gsz = (nM - fm) < WGM ? (nM - fm) : WGM;
        u.pm = fm + ((wgid % nig) % gsz); u.pn = (wgid % nig) / gsz; return true;
    }
};

template <class Epi>
__device__ __forceinline__ void gemm_phase(LAS unsigned char* lds, const Gemm g, const StaticOrder& S, const Epi& E) {
    const int tid = fresh_tid(), wid = __builtin_amdgcn_readfirstlane(tid >> 6), lane = tid & 63, wr = wid >> 2, wc = wid & 3, fr = lane & 15, fq = lane >> 4;
    const int K = g.K, nt = K / BK;
    unsigned voffA[2], voffB[2];
#pragma unroll
    for (int i = 0; i < 2; ++i) { int R, C; stage_rc(tid * 16 + i * 8192, R, C); const int Rb = Epi::PERM ? ((R & ~31) + perm32(R & 31)) : R;
        voffA[i] = (unsigned)(R * K + C) * 2u; voffB[i] = (unsigned)(Rb * K + C) * 2u; }
    const size_t kstep = (size_t)(BK * 2);
    const size_t hstep = (size_t)HALF * K * 2;
    const size_t tstep = 2 * hstep;
    const unsigned ldsw = (unsigned)wid * 1024u;
    const int aoff = lds_byte(wr * 64 + fr, fq * 8), boff = lds_byte(wc * 32 + fr, fq * 8);
#define PG8_SA(b, h) (((b) * 2 + (h)) * HTB)
#define PG8_SB(b, h) ((4 + (b) * 2 + (h)) * HTB)
#define PG8_STAGE(bufoff, gbase, voff) do { _Pragma("unroll") for (int _i = 0; _i < 2; ++_i) \
        __builtin_amdgcn_global_load_lds((const unsigned*)((const char*)(gbase) + (voff)[_i]), (LAS unsigned*)(lds + (bufoff) + ldsw + _i * 8192), 16, 0, 0); } while (0)
#define PG8_LDA(dst, b, h) do { _Pragma("unroll") for (int m = 0; m < 4; ++m) _Pragma("unroll") for (int k = 0; k < 2; ++k) dst[m][k] = *(const LAS bf16x8*)(lds + PG8_SA(b, h) + aoff + m * 2048 + k * 1024); } while (0)
#define PG8_LDB(dst, b, h) do { _Pragma("unroll") for (int n = 0; n < 2; ++n) _Pragma("unroll") for (int k = 0; k < 2; ++k) dst[n][k] = *(const LAS bf16x8*)(lds + PG8_SB(b, h) + boff + n * 2048 + k * 1024); } while (0)
#define PG8_MMA(ai, bj, At, Bt) do { __builtin_amdgcn_s_setprio(1); _Pragma("unroll") for (int m = 0; m < 4; ++m) _Pragma("unroll") for (int n = 0; n < 2; ++n) _Pragma("unroll") for (int k = 0; k < 2; ++k) \
        acc[ai][bj][m][n] = __builtin_amdgcn_mfma_f32_16x16x32_bf16(Bt[n][k], At[m][k], acc[ai][bj][m][n], 0, 0, 0); __builtin_amdgcn_s_setprio(0); } while (0)
#define PG8_WAIT_V(n) asm volatile("s_waitcnt vmcnt(" #n ")" ::: "memory")
#define PG8_WAIT_L(n) asm volatile("s_waitcnt lgkmcnt(" #n ")" ::: "memory")
#define PG8_BAR __builtin_amdgcn_s_barrier()
#define PG8_SCHED __builtin_amdgcn_sched_barrier(0)
    Unit cur, nxt; int ui = 0;
    if (!S.next(0, cur)) return;
    f32x4 acc[2][2][4][2];
#pragma unroll
    for (int a = 0; a < 2; ++a)
#pragma unroll
        for (int b = 0; b < 2; ++b)
#pragma unroll
            for (int m = 0; m < 4; ++m)
#pragma unroll
                for (int n = 0; n < 2; ++n) acc[a][b][m][n] = (f32x4){0.f, 0.f, 0.f, 0.f};
    bf16x8 At[4][2], B0[2][2], B1[2][2];
    const char* cA = (const char*)g.A + (size_t)cur.pm * tstep; const char* cB = (const char*)g.Bt + (size_t)cur.pn * tstep;
    PG8_STAGE(PG8_SB(0, 0), cB, voffB); PG8_STAGE(PG8_SA(0, 0), cA, voffA); PG8_STAGE(PG8_SB(0, 1), cB + hstep, voffB); PG8_STAGE(PG8_SA(0, 1), cA + hstep, voffA);
    if (wr == 1) PG8_BAR;
    PG8_WAIT_V(4); PG8_BAR;
    PG8_STAGE(PG8_SB(1, 0), cB + kstep, voffB); PG8_STAGE(PG8_SA(1, 0), cA + kstep, voffA); PG8_STAGE(PG8_SB(1, 1), cB + hstep + kstep, voffB);
    PG8_WAIT_V(6); PG8_BAR;
    for (;;) {
        const bool has_next = S.next(ui + 1, nxt);
        const char* nA = has_next ? (const char*)g.A + (size_t)nxt.pm * tstep : cA; const char* nB = has_next ? (const char*)g.Bt + (size_t)nxt.pn * tstep : cB;
        for (int t = 0; t < nt; t += 2) {
            const bool last = (t == nt - 2);
            const char* a1 = cA + (size_t)(t + 1) * kstep;
            const char* a2 = last ? nA : cA + (size_t)(t + 2) * kstep; const char* b2 = last ? nB : cB + (size_t)(t + 2) * kstep;
            const char* a3 = a2 + kstep; const char* b3 = b2 + kstep;
            PG8_LDB(B0, 0, 0); PG8_SCHED; PG8_LDA(At, 0, 0); PG8_STAGE(PG8_SA(1, 1), a1 + hstep, voffA);
            PG8_WAIT_L(8); PG8_BAR; PG8_WAIT_L(0); PG8_MMA(0, 0, At, B0); PG8_BAR; PG8_SCHED;
            PG8_LDB(B1, 0, 1); PG8_STAGE(PG8_SB(0, 0), b2, voffB);
            PG8_BAR; PG8_WAIT_L(0); PG8_MMA(0, 1, At, B1); PG8_BAR;
            PG8_LDA(At, 0, 1); PG8_STAGE(PG8_SA(0, 0), a2, voffA);
            PG8_BAR; PG8_WAIT_L(0); PG8_MMA(1, 0, At, B0); PG8_BAR; PG8_SCHED;
            PG8_STAGE(PG8_SB(0, 1), b2 + hstep, voffB);
            PG8_WAIT_V(6); PG8_BAR; PG8_MMA(1, 1, At, B1); PG8_BAR;
            PG8_LDB(B0, 1, 0); PG8_SCHED; PG8_LDA(At, 1, 0); PG8_STAGE(PG8_SA(0, 1), a2 + hstep, voffA);
            PG8_WAIT_L(8); PG8_BAR; PG8_WAIT_L(0); PG8_MMA(0, 0, At, B0); PG8_BAR; PG8_SCHED;
            PG8_LDB(B1, 1, 1); PG8_STAGE(PG8_SB(1, 0), b3, voffB);
            PG8_BAR; PG8_WAIT_L(0); PG8_MMA(0, 1, At, B1); PG8_BAR;
            PG8_LDA(At, 1, 1); PG8_STAGE(PG8_SA(1, 0), a3, voffA);
            PG8_BAR; PG8_WAIT_L(0); PG8_MMA(1, 0, At, B0); PG8_BAR; PG8_SCHED;
            PG8_STAGE(PG8_SB(1, 1), b3 + hstep, voffB);
            PG8_WAIT_V(6); PG8_BAR; PG8_MMA(1, 1, At, B1); PG8_BAR;
        }
        if constexpr (!Epi::AFTER_DRAIN) { const int t2 = fresh_tid(); E(acc, cur, wr, wc, t2 & 15, (t2 >> 4) & 3); }
        if (!has_next) break;
#pragma unroll
        for (int a = 0; a < 2; ++a)
#pragma unroll
            for (int b = 0; b < 2; ++b)
#pragma unroll
                for (int m = 0; m < 4; ++m)
#pragma unroll
                    for (int n = 0; n < 2; ++n) acc[a][b][m][n] = (f32x4){0.f, 0.f, 0.f, 0.f};
        cur = nxt; cA = nA; cB = nB; ++ui;
    }
    PG8_WAIT_V(0);
    if (wr == 0) PG8_BAR;
    PG8_BAR;
    if constexpr (Epi::AFTER_DRAIN) { const int t2 = fresh_tid(); E.fused(acc, cur, wr, wc, t2 & 15, (t2 >> 4) & 3, lds, t2 >> 6, t2 & 63); }
#undef PG8_SA
#undef PG8_SB
#undef PG8_STAGE
#undef PG8_LDA
#undef PG8_LDB
#undef PG8_MMA
#undef PG8_WAIT_V
#undef PG8_WAIT_L
#undef PG8_BAR
#undef PG8_SCHED
}

typedef f32x4 Acc[2][2][4][2];
struct EpiF32 {
    static constexpr bool PERM = false, AFTER_DRAIN = false;
    float* C; int ldc;
    __device__ __forceinline__ void operator()(const Acc& acc, const Unit& u, int wr, int wc, int fr, int fq) const {
        const int row0 = u.pm * BM + wr * 64 + fr, col0 = u.pn * BM + wc * 32 + 4 * fq;
#pragma unroll
        for (int ai = 0; ai < 2; ++ai)
#pragma unroll
            for (int m = 0; m < 4; ++m) { float* rowp = C + (size_t)(row0 + ai * HALF + m * 16) * ldc + col0;
#pragma unroll
                for (int bj = 0; bj < 2; ++bj)
#pragma unroll
                    for (int n = 0; n < 2; ++n) *(f32x4*)(rowp + bj * HALF + n * 16) = acc[ai][bj][m][n]; }
    }
};
struct EpiBf16 {
    static constexpr bool PERM = true, AFTER_DRAIN = false;
    bf16_t* O; int ldc;
    __device__ __forceinline__ void operator()(const Acc& acc, const Unit& u, int wr, int wc, int fr, int fq) const {
        const int row0 = u.pm * BM + wr * 64 + fr, col0 = u.pn * BM + wc * 32 + 8 * fq;
#pragma unroll
        for (int ai = 0; ai < 2; ++ai)
#pragma unroll
            for (int m = 0; m < 4; ++m) { bf16_t* rowp = O + (size_t)(row0 + ai * HALF + m * 16) * ldc + col0;
#pragma unroll
                for (int bj = 0; bj < 2; ++bj) { const f32x4 v0 = acc[ai][bj][m][0], v1 = acc[ai][bj][m][1];
                    u32x4 w; w.x = cvt_pk_bf16(v0[0], v0[1]); w.y = cvt_pk_bf16(v0[2], v0[3]); w.z = cvt_pk_bf16(v1[0], v1[1]); w.w = cvt_pk_bf16(v1[2], v1[3]);
                    *(u32x4*)(rowp + bj * HALF) = w; } }
    }
};
struct EpiSwiGLU {
    static constexpr bool PERM = true, AFTER_DRAIN = false;
    bf16_t* H;
    __device__ __forceinline__ void operator()(const Acc& acc, const Unit& u, int wr, int wc, int fr, int fq) const {
        const int row0 = u.pm * BM + wr * 64 + fr, col0 = u.pn * HALF + wc * 32 + 8 * fq;
#pragma unroll
        for (int ai = 0; ai < 2; ++ai)
#pragma unroll
            for (int m = 0; m < 4; ++m) { bf16_t* rowp = H + (size_t)(row0 + ai * HALF + m * 16) * DFF + col0;
                float h[8];
#pragma unroll
                for (int n = 0; n < 2; ++n)
#pragma unroll
                    for (int j = 0; j < 4; ++j) { const float gt = acc[ai][0][m][n][j], up = acc[ai][1][m][n][j]; h[n * 4 + j] = gt * sigmoidf_fast(gt) * up; }
                u32x4 w; w.x = cvt_pk_bf16(h[0], h[1]); w.y = cvt_pk_bf16(h[2], h[3]); w.z = cvt_pk_bf16(h[4], h[5]); w.w = cvt_pk_bf16(h[6], h[7]);
                *(u32x4*)rowp = w; }
    }
};
struct EpiGate {
    static constexpr bool PERM = true, AFTER_DRAIN = false;
    bf16_t* G;
    __device__ __forceinline__ void operator()(const Acc& acc, const Unit& u, int wr, int wc, int fr, int fq) const {
        const int row0 = u.pm * BM + wr * 64 + fr, col0 = u.pn * BM + wc * 32 + 8 * fq;
#pragma unroll
        for (int ai = 0; ai < 2; ++ai)
#pragma unroll
            for (int m = 0; m < 4; ++m) { bf16_t* rowp = G + (size_t)(row0 + ai * HALF + m * 16) * 2048 + col0;
#pragma unroll
                for (int bj = 0; bj < 2; ++bj) { const f32x4 v0 = acc[ai][bj][m][0], v1 = acc[ai][bj][m][1];
                    u32x4 w; w.x = cvt_pk_bf16(sigmoidf_fast(v0[0]), sigmoidf_fast(v0[1])); w.y = cvt_pk_bf16(sigmoidf_fast(v0[2]), sigmoidf_fast(v0[3]));
                    w.z = cvt_pk_bf16(sigmoidf_fast(v1[0]), sigmoidf_fast(v1[1])); w.w = cvt_pk_bf16(sigmoidf_fast(v1[2]), sigmoidf_fast(v1[3]));
                    *(u32x4*)(rowp + bj * HALF) = w; } }
    }
};
struct EpiQ {
    static constexpr bool PERM = true, AFTER_DRAIN = false;
    bf16_t* Q; const float* TAB;
    __device__ __forceinline__ void operator()(const Acc& acc, const Unit& u, int wr, int wc, int fr, int fq) const {
        const int row0 = u.pm * BM + wr * 64 + fr, col0 = u.pn * BM + wc * 32 + 8 * fq;
#pragma unroll
        for (int ai = 0; ai < 2; ++ai)
#pragma unroll
            for (int m = 0; m < 4; ++m) { const int row = row0 + ai * HALF + m * 16; bf16_t* rowp = Q + (size_t)row * 1536 + col0;
#pragma unroll
                for (int bj = 0; bj < 2; ++bj) { f32x4 v0 = acc[ai][bj][m][0], v1 = acc[ai][bj][m][1];
                    const int c = col0 + bj * HALF, w = c % 192;
                    if (w >= 128) { const int i0 = (w - 128) >> 1; const f32x4 cs = *(const f32x4*)(TAB + (size_t)row * 64 + i0), sn = *(const f32x4*)(TAB + (size_t)row * 64 + 32 + i0);
                        f32x4 r0, r1;
                        r0[0] = v0[0] * cs[0] - v0[1] * sn[0]; r0[1] = v0[1] * cs[0] + v0[0] * sn[0];
                        r0[2] = v0[2] * cs[1] - v0[3] * sn[1]; r0[3] = v0[3] * cs[1] + v0[2] * sn[1];
                        r1[0] = v1[0] * cs[2] - v1[1] * sn[2]; r1[1] = v1[1] * cs[2] + v1[0] * sn[2];
                        r1[2] = v1[2] * cs[3] - v1[3] * sn[3]; r1[3] = v1[3] * cs[3] + v1[2] * sn[3];
                        v0 = r0; v1 = r1; }
                    u32x4 wv; wv.x = cvt_pk_bf16(v0[0], v0[1]); wv.y = cvt_pk_bf16(v0[2], v0[3]); wv.z = cvt_pk_bf16(v1[0], v1[1]); wv.w = cvt_pk_bf16(v1[2], v1[3]);
                    *(u32x4*)(rowp + bj * HALF) = wv; } }
    }
};
struct EpiT1 {
    static constexpr bool PERM = true, AFTER_DRAIN = false;
    const bf16_t* G; bf16_t* F;
    __device__ __forceinline__ void operator()(const Acc& acc, const Unit& u, int wr, int wc, int fr, int fq) const {
        const int row0 = u.pm * BM + wr * 64 + fr, col0 = u.pn * BM + wc * 32 + 8 * fq;
#pragma unroll
        for (int ai = 0; ai < 2; ++ai)
#pragma unroll
            for (int m = 0; m < 4; ++m) { const int row = row0 + ai * HALF + m * 16;
#pragma unroll
                for (int bj = 0; bj < 2; ++bj) { const f32x4 v0 = acc[ai][bj][m][0], v1 = acc[ai][bj][m][1]; const int c = col0 + bj * HALF;
                    const u32x4 gw = *(const u32x4*)(G + (size_t)row * 2048 + c);
                    u32x4 wv;
                    wv.x = cvt_pk_bf16(v0[0] * bf_lo(gw.x), v0[1] * bf_hi(gw.x)); wv.y = cvt_pk_bf16(v0[2] * bf_lo(gw.y), v0[3] * bf_hi(gw.y));
                    wv.z = cvt_pk_bf16(v1[0] * bf_lo(gw.z), v1[1] * bf_hi(gw.z)); wv.w = cvt_pk_bf16(v1[2] * bf_lo(gw.w), v1[3] * bf_hi(gw.w));
                    *(u32x4*)(F + (size_t)row * 1024 + c) = wv; } }
    }
};
struct EpiMX {
    static constexpr bool PERM = true, AFTER_DRAIN = false;
    const bf16_t* G; const bf16_t* F; bf16_t* MX;
    __device__ __forceinline__ void operator()(const Acc& acc, const Unit& u, int wr, int wc, int fr, int fq) const {
        const int row0 = u.pm * BM + wr * 64 + fr, col0 = u.pn * BM + wc * 32 + 8 * fq;
#pragma unroll
        for (int ai = 0; ai < 2; ++ai)
#pragma unroll
            for (int m = 0; m < 4; ++m) { const int row = row0 + ai * HALF + m * 16;
#pragma unroll
                for (int bj = 0; bj < 2; ++bj) { const f32x4 v0 = acc[ai][bj][m][0], v1 = acc[ai][bj][m][1]; const int c = col0 + bj * HALF;
                    const u32x4 gw = *(const u32x4*)(G + (size_t)row * 2048 + 1024 + c);
                    const u32x4 tw = *(const u32x4*)(F + (size_t)row * 1024 + c);
                    u32x4 wv;
                    wv.x = cvt_pk_bf16(bf_lo(tw.x) + v0[0] * bf_lo(gw.x), bf_hi(tw.x) + v0[1] * bf_hi(gw.x)); wv.y = cvt_pk_bf16(bf_lo(tw.y) + v0[2] * bf_lo(gw.y), bf_hi(tw.y) + v0[3] * bf_hi(gw.y));
                    wv.z = cvt_pk_bf16(bf_lo(tw.z) + v1[0] * bf_lo(gw.z), bf_hi(tw.z) + v1[1] * bf_hi(gw.z)); wv.w = cvt_pk_bf16(bf_lo(tw.w) + v1[2] * bf_lo(gw.w), bf_hi(tw.w) + v1[3] * bf_hi(gw.w));
                    *(u32x4*)(MX + (size_t)row * 1024 + c) = wv; } }
    }
};

struct PanelSumSq {
    float* xbuf;
    unsigned* cnt;
    __device__ __forceinline__ void run(const Acc& v, const Unit& u, int wr, int wc, int fr, int fq, LAS unsigned char* lds, int wid, int lane) const {
        LAS float* P = (LAS float*)lds; LAS float* S = (LAS float*)(lds + 4096);
#pragma unroll
        for (int ai = 0; ai < 2; ++ai)
#pragma unroll
            for (int m = 0; m < 4; ++m) { float q = 0.f;
#pragma unroll
                for (int bj = 0; bj < 2; ++bj)
#pragma unroll
                    for (int n = 0; n < 2; ++n) { const f32x4 x = v[ai][bj][m][n]; q += (x[0] * x[0] + x[1] * x[1]) + (x[2] * x[2] + x[3] * x[3]); }
                q += __shfl_xor(q, 16); q += __shfl_xor(q, 32);
                if (fq == 0) P[(ai * HALF + wr * 64 + m * 16 + fr) * 4 + wc] = q; }
        asm volatile("s_waitcnt lgkmcnt(0)" ::: "memory"); __builtin_amdgcn_s_barrier(); asm volatile("" ::: "memory");
        const int row = wid * 32 + (lane & 31);
        if (lane < 32) { const float t = (P[row * 4 + 0] + P[row * 4 + 1]) + (P[row * 4 + 2] + P[row * 4 + 3]);
            __hip_atomic_store(xbuf + ((size_t)(u.pm * BM + row) * 4 + u.pn), t, __ATOMIC_RELAXED, __HIP_MEMORY_SCOPE_AGENT); }
        asm volatile("s_waitcnt vmcnt(0)" ::: "memory");
        if (lane == 0) __hip_atomic_fetch_add(cnt + 64 * u.pm, 1u, __ATOMIC_RELAXED, __HIP_MEMORY_SCOPE_AGENT);
        if (wid == 0) { unsigned sp = 0u;
            while ((unsigned)__builtin_amdgcn_readfirstlane(__hip_atomic_load(cnt + 64 * u.pm, __ATOMIC_RELAXED, __HIP_MEMORY_SCOPE_AGENT)) < 32u) { __builtin_amdgcn_s_sleep(1); if (++sp > (1u << 22)) break; }
            __builtin_amdgcn_fence(__ATOMIC_ACQUIRE, "agent"); }
        asm volatile("s_waitcnt vmcnt(0) lgkmcnt(0)" ::: "memory"); __builtin_amdgcn_s_barrier(); asm volatile("" ::: "memory");
        if (lane < 32) { const float* slot = xbuf + (size_t)(u.pm * BM + row) * 4; float tot = 0.f;
#pragma unroll
            for (int t = 0; t < 4; ++t) tot += __hip_atomic_load(slot + t, __ATOMIC_RELAXED, __HIP_MEMORY_SCOPE_AGENT);
            S[row] = __builtin_amdgcn_rsqf(tot * (1.f / 1024.f) + EPS); }
        asm volatile("s_waitcnt lgkmcnt(0)" ::: "memory"); __builtin_amdgcn_s_barrier(); asm volatile("" ::: "memory");
    }
};
template <bool FINAL> struct EpiResNorm {
    static constexpr bool PERM = false, AFTER_DRAIN = true;
    const float* base; float* out; bf16_t* xn; float wt; const float* gpost; const float* gnext; PanelSumSq st1, st2;
    __device__ __forceinline__ void operator()(const Acc&, const Unit&, int, int, int, int) const {}
    __device__ __forceinline__ void fused(Acc& acc, const Unit& u, int wr, int wc, int fr, int fq, LAS unsigned char* lds, int wid, int lane) const {
        const LAS float* S = (const LAS float*)(lds + 4096);
        const int col0 = u.pn * BM + wc * 32 + 4 * fq;
        st1.run(acc, u, wr, wc, fr, fq, lds, wid, lane);
#pragma unroll
        for (int ai = 0; ai < 2; ++ai)
#pragma unroll
            for (int m = 0; m < 4; ++m) { const int r = ai * HALF + wr * 64 + m * 16 + fr; const float sr = S[r] * wt; const size_t off = (size_t)(u.pm * BM + r) * 1024 + col0;
#pragma unroll
                for (int bj = 0; bj < 2; ++bj)
#pragma unroll
                    for (int n = 0; n < 2; ++n) { const f32x4 bs = *(const f32x4*)(base + off + bj * HALF + n * 16); const f32x4 g = *(const f32x4*)(gpost + col0 + bj * HALF + n * 16);
                        acc[ai][bj][m][n] = bs + acc[ai][bj][m][n] * g * sr; }
                asm volatile("" : "+v"(acc[ai][0][m][0]), "+v"(acc[ai][0][m][1]), "+v"(acc[ai][1][m][0]), "+v"(acc[ai][1][m][1]));
                if (m & 1) asm volatile("" ::: "memory"); }
        st2.run(acc, u, wr, wc, fr, fq, lds, wid, lane);
#pragma unroll
        for (int ai = 0; ai < 2; ++ai)
#pragma unroll
            for (int m = 0; m < 4; ++m) { const int r = ai * HALF + wr * 64 + m * 16 + fr; const float sr = S[r]; const size_t off = (size_t)(u.pm * BM + r) * 1024 + col0;
#pragma unroll
                for (int bj = 0; bj < 2; ++bj)
#pragma unroll
                    for (int n = 0; n < 2; ++n) { const f32x4 x1 = acc[ai][bj][m][n]; const f32x4 g = *(const f32x4*)(gnext + col0 + bj * HALF + n * 16); const f32x4 o = x1 * g * sr;
                        if (FINAL) *(f32x4*)(out + off + bj * HALF + n * 16) = o;
                        else { *(f32x4*)(out + off + bj * HALF + n * 16) = x1; u32x2 w; w.x = cvt_pk_bf16(o[0], o[1]); w.y = cvt_pk_bf16(o[2], o[3]); *(u32x2*)(xn + off + bj * HALF + n * 16) = w; } }
                asm volatile("" ::: "memory"); }
    }
};
}

namespace att {
constexpr int NW = 8, QBLK = 32, KVBLK = 64;
constexpr float SCALE = 0.07216878364870322f;
constexpr float THR = 8.f;
constexpr int LDQ = 1536, LDKV = 2048, LDKR = 64, LDO = 1024;
constexpr int SHM_V = 64 * 128 * 2, SHM_K = 64 * 128 * 2, SHM_R = 64 * 64 * 2;
constexpr int NQL = 4;
constexpr int OFF_V = 0, OFF_K = 2 * SHM_V, OFF_RP = OFF_K + 2 * SHM_K, OFF_WS = OFF_RP + 2 * SHM_R, OFF_QL = OFF_WS + NW * 64 * 4, SHM_ATTN = OFF_QL + NW * NQL * 1024;
static_assert(SHM_ATTN <= LDS_STAGE, "lds");
#define KSWZ(row, colB) ((row) * 256 + ((colB) ^ (((row) & 7) << 4)))
#define RSWZ(row, colB) ((row) * 128 + ((colB) ^ (((row) & 7) << 4)))
#define SBAR() __builtin_amdgcn_sched_barrier(0)
__device__ __forceinline__ int crow(int r, int hi) { return (r & 3) + 8 * (r >> 2) + 4 * hi; }
__device__ __forceinline__ bf16x8 ld8(const bf16_t* p) { return *reinterpret_cast<const bf16x8*>(p); }

__device__ __forceinline__ void partialSM(f32x16& p0, f32x16& p1, float& m_reg, float& mn, float& alpha) {
    constexpr float C = SCALE * 1.4426950408889634f;
    float pmax = p0[0];
#pragma unroll
    for (int r = 1; r < 16; ++r) pmax = fmaxf(pmax, p0[r]);
#pragma unroll
    for (int r = 0; r < 16; ++r) pmax = fmaxf(pmax, p1[r]);
    { auto rr = __builtin_amdgcn_permlane32_swap(__float_as_uint(pmax), __float_as_uint(pmax), false, false);
      pmax = fmaxf(__uint_as_float(rr[0]), __uint_as_float(rr[1])); }
    if (__builtin_expect(__all(pmax - m_reg <= THR / SCALE), 1)) { mn = m_reg; alpha = 1.f; }
    else { mn = fmaxf(m_reg, pmax); alpha = __builtin_amdgcn_exp2f((m_reg - mn) * C); m_reg = mn; }
    float mnC = -mn * C;
#pragma unroll
    for (int r = 0; r < 16; ++r) p0[r] = fmaf(p0[r], C, mnC);
#pragma unroll
    for (int r = 0; r < 16; ++r) p1[r] = fmaf(p1[r], C, mnC);
#pragma unroll
    for (int r = 0; r < 16; ++r) p0[r] = __builtin_amdgcn_exp2f(p0[r]);
}
__device__ __forceinline__ void finishSM(f32x16& p0, f32x16& p1, float alpha, float& l_reg, bf16x8& pa0, bf16x8& pa1, bf16x8& pa2, bf16x8& pa3) {
#pragma unroll
    for (int r = 0; r < 16; ++r) p1[r] = __builtin_amdgcn_exp2f(p1[r]);
    float ps = 0;
#pragma unroll
    for (int r = 0; r < 16; ++r) ps += p0[r];
#pragma unroll
    for (int r = 0; r < 16; ++r) ps += p1[r];
    { auto rr = __builtin_amdgcn_permlane32_swap(__float_as_uint(ps), __float_as_uint(ps), false, false);
      ps = __uint_as_float(rr[0]) + __uint_as_float(rr[1]); }
    l_reg = l_reg * alpha + ps;
#define PK4(P, BASE, OUT) do { unsigned a0 = cvt_pk_bf16(P[BASE + 0], P[BASE + 1]), a1 = cvt_pk_bf16(P[BASE + 2], P[BASE + 3]);   \
    unsigned b0 = cvt_pk_bf16(P[BASE + 4], P[BASE + 5]), b1 = cvt_pk_bf16(P[BASE + 6], P[BASE + 7]);                              \
    auto r0 = __builtin_amdgcn_permlane32_swap(a0, b0, false, false); auto r1 = __builtin_amdgcn_permlane32_swap(a1, b1, false, false); \
    u32x4 w = {r0[0], r1[0], r0[1], r1[1]}; OUT = *reinterpret_cast<bf16x8*>(&w); } while (0)
    PK4(p0, 0, pa0); PK4(p0, 8, pa1); PK4(p1, 0, pa2); PK4(p1, 8, pa3);
#undef PK4
}
__device__ __forceinline__ void qkt(f32x16& p0, f32x16& p1, const char* Ks, const char* Rs, const bf16x8* qr, const char* ql, int r32, int hi) {
    p0 = f32x16{}; p1 = f32x16{};
#pragma unroll
    for (int d0 = 0; d0 < 8; ++d0) { int cb = (d0 * 16 + hi * 8) * 2;
        bf16x8 b0 = *reinterpret_cast<const bf16x8*>(Ks + KSWZ(r32, cb));
        bf16x8 b1 = *reinterpret_cast<const bf16x8*>(Ks + KSWZ(32 + r32, cb));
        p0 = __builtin_amdgcn_mfma_f32_32x32x16_bf16(b0, qr[d0], p0, 0, 0, 0);
        p1 = __builtin_amdgcn_mfma_f32_32x32x16_bf16(b1, qr[d0], p1, 0, 0, 0); }
#pragma unroll
    for (int d0 = 0; d0 < 4; ++d0) { int cb = (d0 * 16 + hi * 8) * 2;
        bf16x8 b0 = *reinterpret_cast<const bf16x8*>(Rs + RSWZ(r32, cb));
        bf16x8 b1 = *reinterpret_cast<const bf16x8*>(Rs + RSWZ(32 + r32, cb));
        const bf16x8 qv = *reinterpret_cast<const bf16x8*>(ql + d0 * 1024);
        p0 = __builtin_amdgcn_mfma_f32_32x32x16_bf16(b0, qv, p0, 0, 0, 0);
        p1 = __builtin_amdgcn_mfma_f32_32x32x16_bf16(b1, qv, p1, 0, 0, 0); }
}
__device__ __forceinline__ int v_st(int k, int c) { const int kk = (k & ~0xC) | ((k & 4) << 1) | ((k & 8) >> 1); return ((kk >> 3) * 4 + (c >> 5)) * 512 + ((kk & 7) * 32 + (c & 31)) * 2; }
__device__ __forceinline__ int v_rd_base(int lane) { return ((lane & 3) << 3) | (((lane >> 2) & 3) << 6) | (((lane >> 4) & 1) << 5) | (((lane >> 5) & 1) << 8); }
constexpr int v_rd_off(int d0, int ks, int half) { return d0 * 512 + ks * 4096 + half * 2048; }
template <int OFF> __device__ __forceinline__ s16x4 tr_read(int vb) {
    s16x4 r; asm volatile("ds_read_b64_tr_b16 %0, %1 offset:%2" : "=&v"(r) : "v"(vb), "i"(OFF) : "memory"); return r;
}
template <int D0> __device__ __forceinline__ void pv_one(f32x16& od, int vb, bf16x8 pa0, bf16x8 pa1, bf16x8 pa2, bf16x8 pa3) {
    const s16x4 l0 = tr_read<v_rd_off(D0, 0, 0)>(vb), h0 = tr_read<v_rd_off(D0, 0, 1)>(vb), l1 = tr_read<v_rd_off(D0, 1, 0)>(vb), h1 = tr_read<v_rd_off(D0, 1, 1)>(vb);
    const s16x4 l2 = tr_read<v_rd_off(D0, 2, 0)>(vb), h2 = tr_read<v_rd_off(D0, 2, 1)>(vb), l3 = tr_read<v_rd_off(D0, 3, 0)>(vb), h3 = tr_read<v_rd_off(D0, 3, 1)>(vb);
    asm volatile("s_waitcnt lgkmcnt(0)" ::: "memory"); SBAR();
#define PK(L, H) (bf16x8){L[0], L[1], L[2], L[3], H[0], H[1], H[2], H[3]}
    od = __builtin_amdgcn_mfma_f32_32x32x16_bf16(pa0, PK(l0, h0), od, 0, 0, 0);
    od = __builtin_amdgcn_mfma_f32_32x32x16_bf16(pa1, PK(l1, h1), od, 0, 0, 0);
    od = __builtin_amdgcn_mfma_f32_32x32x16_bf16(pa2, PK(l2, h2), od, 0, 0, 0);
    od = __builtin_amdgcn_mfma_f32_32x32x16_bf16(pa3, PK(l3, h3), od, 0, 0, 0);
#undef PK
}
__device__ __forceinline__ void pv_d0(f32x16* o, int vb, bf16x8 pa0, bf16x8 pa1, bf16x8 pa2, bf16x8 pa3) {
    pv_one<0>(o[0], vb, pa0, pa1, pa2, pa3); pv_one<1>(o[1], vb, pa0, pa1, pa2, pa3); pv_one<2>(o[2], vb, pa0, pa1, pa2, pa3); pv_one<3>(o[3], vb, pa0, pa1, pa2, pa3);
}

__device__ __forceinline__ void attn_body(const bf16_t* __restrict__ Qb, const bf16_t* __restrict__ Kn, const bf16_t* __restrict__ Kr, const bf16_t* __restrict__ Vh,
                                          bf16_t* __restrict__ Ob, int seq, char* lds) {
    const int tid = fresh_tid(), wid = tid >> 6, lane = tid & 63, r32 = lane & 31, hi = lane >> 5;
    char* V_lds = lds + OFF_V; char* K_lds = lds + OFF_K; char* R_lds = lds + OFF_RP;
    float* ws = (float*)(lds + OFF_WS) + wid * 64; float* li_l = ws; float* al_l = ws + 32;
    float m_reg = -1e30f, l_reg = 0; f32x16 o[4] = {}; bf16x8 qr[8];
    char* ql = lds + OFF_QL + wid * (NQL * 1024) + lane * 16;
    const bf16_t* Qw = Qb + (long)(wid * QBLK + r32) * LDQ + hi * 8;
#pragma unroll
    for (int d0 = 0; d0 < 8; ++d0) qr[d0] = ld8(Qw + d0 * 16);
#pragma unroll
    for (int d0 = 0; d0 < NQL; ++d0) *reinterpret_cast<bf16x8*>(ql + d0 * 1024) = ld8(Qw + (8 + d0) * 16);
    const int sr = tid >> 4, sc = (tid & 15) * 8, vst0 = v_st(sr, sc), vst1 = v_st(32 + sr, sc);
    const int rr_ = tid >> 3, rc_ = (tid & 7) * 8;
    const int vb0 = (int)(uintptr_t)V_lds + v_rd_base(lane);
    bf16x8 vs0, vs1, ks0, ks1, rs0;
#define SLOAD(k0) do { vs0 = ld8(&Vh[(long)((k0) + sr) * LDKV + sc]); vs1 = ld8(&Vh[(long)((k0) + 32 + sr) * LDKV + sc]); \
    ks0 = ld8(&Kn[(long)((k0) + sr) * LDKV + sc]); ks1 = ld8(&Kn[(long)((k0) + 32 + sr) * LDKV + sc]); rs0 = ld8(&Kr[(long)((k0) + rr_) * LDKR + rc_]); } while (0)
#define SWRITE(b) do { *(bf16x8*)(V_lds + (b) * SHM_V + vst0) = vs0; *(bf16x8*)(V_lds + (b) * SHM_V + vst1) = vs1; int kc = sc * 2; \
    *(bf16x8*)(K_lds + (b) * SHM_K + KSWZ(sr, kc)) = ks0; *(bf16x8*)(K_lds + (b) * SHM_K + KSWZ(32 + sr, kc)) = ks1; \
    *(bf16x8*)(R_lds + (b) * SHM_R + RSWZ(rr_, rc_ * 2)) = rs0; } while (0)
#define RESC(a) do { if (__any((a) < 1.f)) { if (hi == 0) al_l[r32] = (a); asm volatile("s_waitcnt lgkmcnt(0)" ::: "memory"); \
    _Pragma("unroll") for (int d = 0; d < 4; ++d) _Pragma("unroll") for (int r = 0; r < 16; ++r) o[d][r] *= al_l[crow(r, hi)]; } } while (0)
    f32x16 pA0, pA1, pB0, pB1; float mnA, mnB, alA, alB; bf16x8 pa0, pa1, pa2, pa3; const int NT = seq / KVBLK;
    SLOAD(0); asm volatile("s_waitcnt vmcnt(0)" ::: "memory"); SWRITE(0); __syncthreads();
    qkt(pA0, pA1, K_lds, R_lds, qr, ql, r32, hi); partialSM(pA0, pA1, m_reg, mnA, alA);
    SLOAD(KVBLK);
    asm volatile("s_waitcnt vmcnt(0)" ::: "memory"); SWRITE(1); __syncthreads();
    for (int j = 1; j + 1 < NT; j += 2) {
        SBAR(); qkt(pB0, pB1, K_lds + SHM_K, R_lds + SHM_R, qr, ql, r32, hi);
        finishSM(pA0, pA1, alA, l_reg, pa0, pa1, pa2, pa3); SBAR();
        SLOAD((j + 1) * KVBLK); SBAR();
        pv_d0(o, vb0, pa0, pa1, pa2, pa3); partialSM(pB0, pB1, m_reg, mnB, alB);
        __syncthreads(); asm volatile("s_waitcnt vmcnt(0)" ::: "memory"); SWRITE(0);
        RESC(alB); __syncthreads();
        SBAR(); qkt(pA0, pA1, K_lds, R_lds, qr, ql, r32, hi);
        finishSM(pB0, pB1, alB, l_reg, pa0, pa1, pa2, pa3); SBAR();
        SLOAD((j + 2) * KVBLK); SBAR();
        pv_d0(o, vb0 + SHM_V, pa0, pa1, pa2, pa3); partialSM(pA0, pA1, m_reg, mnA, alA);
        __syncthreads(); asm volatile("s_waitcnt vmcnt(0)" ::: "memory"); SWRITE(1);
        RESC(alA); __syncthreads();
    }
    SBAR(); qkt(pB0, pB1, K_lds + SHM_K, R_lds + SHM_R, qr, ql, r32, hi);
    finishSM(pA0, pA1, alA, l_reg, pa0, pa1, pa2, pa3); SBAR();
    pv_d0(o, vb0, pa0, pa1, pa2, pa3); partialSM(pB0, pB1, m_reg, mnB, alB);
    __syncthreads(); RESC(alB);
    finishSM(pB0, pB1, alB, l_reg, pa0, pa1, pa2, pa3); SBAR();
    pv_d0(o, vb0 + SHM_V, pa0, pa1, pa2, pa3);
    if (hi == 0) li_l[r32] = l_reg; asm volatile("s_waitcnt lgkmcnt(0)" ::: "memory");
    float rli[16];
#pragma unroll
    for (int r = 0; r < 16; ++r) rli[r] = __builtin_amdgcn_rcpf(li_l[crow(r, hi)]);
    bf16_t* Ow = Ob + (long)(wid * QBLK) * LDO;
#pragma unroll
    for (int r = 0; r < 16; ++r) { int orow = crow(r, hi);
#pragma unroll
        for (int d0 = 0; d0 < 4; ++d0) { const float v = o[d0][r] * rli[r]; Ow[(long)orow * LDO + d0 * 32 + r32] = (bf16_t)(cvt_pk_bf16(v, v) & 0xffffu); } }
#undef SLOAD
#undef SWRITE
#undef RESC
}
}


#define XB_TMO      128
#define XB_XCNT(j)  (256  + 64 * (j))
#define XB_XSUB(j)  (1280 + 64 * (j))
#define XB_XGEN(j)  (2304 + 64 * (j))
#define XB_TOP      3328
#define XB_TOPGEN   3392
#define XCD_BAR_WORDS 3456
#define XB_SPIN_CAP (1u << 18)
__device__ __forceinline__ unsigned xb_ld(unsigned* p)              { return __hip_atomic_load(p, __ATOMIC_RELAXED, __HIP_MEMORY_SCOPE_AGENT); }
__device__ __forceinline__ unsigned xb_add(unsigned* p, unsigned v) { return __hip_atomic_fetch_add(p, v, __ATOMIC_RELAXED, __HIP_MEMORY_SCOPE_AGENT); }
__device__ __forceinline__ unsigned xb_xcc_id() { return (unsigned)__builtin_amdgcn_s_getreg((3 << 11) | 20) & 0xFu; }
#define XB_SPIN(cond, bar) do { unsigned _sp = 0; while (cond) { __builtin_amdgcn_s_sleep(1); \
    if ((++_sp & 255u) == 0u) { if (xb_ld(&(bar)[XB_TMO])) break; if (_sp > XB_SPIN_CAP) { atomicAdd(&(bar)[XB_TMO], 1u); break; } } } } while (0)
struct XcdBarrier { unsigned* bar; unsigned x; volatile LAS unsigned* st; };
__device__ __forceinline__ XcdBarrier xcd_barrier_post(unsigned* bar, volatile LAS unsigned* st) {
    XcdBarrier b; b.bar = bar; b.x = xb_xcc_id(); b.st = st;
    if (threadIdx.x == 0) (void)xb_add(&bar[XB_XCNT(b.x)], 1u);
    return b;
}
__device__ __forceinline__ void xcd_barrier_complete(unsigned* bar, unsigned x, unsigned& nloc, unsigned& nx) {
    const unsigned G = gridDim.x * gridDim.y * gridDim.z;
    unsigned sum, cnt, mine, sp = 0u;
    for (;;) {
        sum = 0u; cnt = 0u; mine = 0u;
#pragma unroll
        for (unsigned j = 0; j < 16; ++j) { const unsigned c = xb_ld(&bar[XB_XCNT(j)]); sum += c; cnt += (c > 0u) ? 1u : 0u; mine = (j == x) ? c : mine; }
        if (sum == G) break;
        __builtin_amdgcn_s_sleep(1);
        if ((++sp & 255u) == 0u) { if (xb_ld(&bar[XB_TMO])) break; if (sp > XB_SPIN_CAP) { atomicAdd(&bar[XB_TMO], 1u); break; } }
    }
    nloc = mine > 0u ? mine : 1u; nx = cnt > 0u ? cnt : 1u;
}
__device__ __forceinline__ void xcd_barrier(const XcdBarrier& b) {
    asm volatile("s_waitcnt vmcnt(0)" ::: "memory");
    __syncthreads();
    if (threadIdx.x == 0) {
        unsigned* bar = b.bar;
        __builtin_amdgcn_s_waitcnt(0);
        unsigned nloc = b.st[0], nx = b.st[1];
        if (nloc == 0u) { xcd_barrier_complete(bar, b.x, nloc, nx); b.st[0] = nloc; b.st[1] = nx; }
        const unsigned old = xb_add(&bar[XB_XSUB(b.x)], 1u);
        const unsigned gen = old / nloc;
        if (old + 1u == (gen + 1u) * nloc) {
            __builtin_amdgcn_fence(__ATOMIC_RELEASE, "agent");
            asm volatile("s_waitcnt vmcnt(0)" ::: "memory");
            const unsigned og = xb_add(&bar[XB_TOP], 1u);
            const unsigned tg = og / nx;
            if (og + 1u == (tg + 1u) * nx) xb_add(&bar[XB_TOPGEN], 1u);
            else XB_SPIN(xb_ld(&bar[XB_TOPGEN]) == tg, bar);
            __builtin_amdgcn_fence(__ATOMIC_ACQUIRE, "agent");
            xb_add(&bar[XB_XGEN(b.x)], 1u);
            asm volatile("s_waitcnt vmcnt(0)" ::: "memory");
        } else {
            XB_SPIN(xb_ld(&bar[XB_XGEN(b.x)]) == gen, bar);
            __builtin_amdgcn_fence(__ATOMIC_ACQUIRE, "agent");
            asm volatile("s_waitcnt vmcnt(0)" ::: "memory");
        }
    }
    __syncthreads();
}

enum { TR_PLAIN = 0, TR_GU = 1, TR_WIN = 2, TR_UQ = 3, TR_UKV = 4 };
template <int MODE>
__device__ __forceinline__ void tr_job(const float* W0, const float* W1, int K, int Nsrc, int Nout, bf16_t* WT, LAS float* scr, int lane, int gw, int NGW) {
    const int nblk = Nout / 32, nitems = (K / 64) * nblk;
    for (int it = gw; it < nitems; it += NGW) {
        const int kb = it / nblk, nb = it % nblk, k0 = 64 * kb, n0 = 32 * nb, np = n0 + (lane & 31);
        const float* colp;
        if (MODE == TR_PLAIN) colp = W0 + np;
        else if (MODE == TR_GU) { const int t = np >> 8, w = np & 255; colp = (w < 128 ? W0 : W1) + t * 128 + (w & 127); }
        else if (MODE == TR_WIN) colp = np < 1216 ? W0 + np : (np < 1280 ? nullptr : W0 + (np - 64));
        else if (MODE == TR_UQ) { const int h = np / 192, w = np % 192; colp = W0 + (w < 128 ? np : h * 192 + 128 + ((w - 128) >> 1) + ((w - 128) & 1) * 32); }
        else colp = np < 1024 ? W0 + np : W1 + (np - 1024);
        float tv[32];
#pragma unroll
        for (int i = 0; i < 32; ++i) { const int kk = 2 * i + (lane >> 5); tv[i] = colp ? colp[(size_t)(k0 + kk) * Nsrc] : 0.f; }
#pragma unroll
        for (int i = 0; i < 32; ++i) { const int kk = 2 * i + (lane >> 5); scr[kk * 33 + (lane & 31)] = tv[i]; }
        asm volatile("s_waitcnt lgkmcnt(0)" ::: "memory");
        const int c = lane & 7;
#pragma unroll
        for (int j = 0; j < 4; ++j) { const int n = (lane >> 3) + 8 * j; const LAS float* s = scr + (8 * c) * 33 + n;
            u32x4 o; o.x = cvt_pk_bf16(s[0 * 33], s[1 * 33]); o.y = cvt_pk_bf16(s[2 * 33], s[3 * 33]); o.z = cvt_pk_bf16(s[4 * 33], s[5 * 33]); o.w = cvt_pk_bf16(s[6 * 33], s[7 * 33]);
            *(u32x4*)(WT + (size_t)(n0 + n) * K + k0 + 8 * c) = o; }
        asm volatile("s_waitcnt lgkmcnt(0)" ::: "memory");
    }
}

template <int MODE>
__device__ __forceinline__ void rows_phase(const float* xin, const bf16_t* f, float wt, const float* gpost, const float* gnext, float* xout, bf16_t* xn, int gw, int NGW, int lane) {
    for (int row0 = gw; row0 < M; row0 += 2 * NGW) {
        f32x4 xv[2][4]; u32x2 fw[2][4];
#pragma unroll
        for (int r = 0; r < 2; ++r) { const size_t row = (size_t)(row0 + r * NGW);
#pragma unroll
            for (int j = 0; j < 4; ++j) { xv[r][j] = *(const f32x4*)(xin + row * DM + 4 * (lane + 64 * j));
                if (MODE != 0) fw[r][j] = *(const u32x2*)(f + row * DM + 4 * (lane + 64 * j)); } }
#pragma unroll
        for (int r = 0; r < 2; ++r) { const size_t row = (size_t)(row0 + r * NGW);
            if (MODE != 0) {
                f32x4 fv[4]; float ss = 0.f;
#pragma unroll
                for (int j = 0; j < 4; ++j) { fv[j] = (f32x4){bf_lo(fw[r][j].x), bf_hi(fw[r][j].x), bf_lo(fw[r][j].y), bf_hi(fw[r][j].y)}; ss += fv[j].x * fv[j].x + fv[j].y * fv[j].y + fv[j].z * fv[j].z + fv[j].w * fv[j].w; }
                const float rr = wt * __builtin_amdgcn_rsqf(wave_sum(ss) * (1.f / DM) + EPS);
#pragma unroll
                for (int j = 0; j < 4; ++j) { const f32x4 g = *(const f32x4*)(gpost + 4 * (lane + 64 * j)); xv[r][j] = xv[r][j] + fv[j] * g * rr; }
                if (MODE == 1) {
#pragma unroll
                    for (int j = 0; j < 4; ++j) *(f32x4*)(xout + row * DM + 4 * (lane + 64 * j)) = xv[r][j];
                }
            }
            float s2 = 0.f;
#pragma unroll
            for (int j = 0; j < 4; ++j) s2 += xv[r][j].x * xv[r][j].x + xv[r][j].y * xv[r][j].y + xv[r][j].z * xv[r][j].z + xv[r][j].w * xv[r][j].w;
            const float r2 = __builtin_amdgcn_rsqf(wave_sum(s2) * (1.f / DM) + EPS);
#pragma unroll
            for (int j = 0; j < 4; ++j) { const f32x4 g = *(const f32x4*)(gnext + 4 * (lane + 64 * j)); const f32x4 y = xv[r][j] * g * r2;
                if (MODE == 2) *(f32x4*)(xout + row * DM + 4 * (lane + 64 * j)) = y;
                else { u32x2 w; w.x = cvt_pk_bf16(y.x, y.y); w.y = cvt_pk_bf16(y.z, y.w); *(u32x2*)(xn + row * DM + 4 * (lane + 64 * j)) = w; } }
        }
    }
}

__global__ void __launch_bounds__(NTHREADS, 2) fwd_megakernel(Params p) {
    extern __shared__ __attribute__((aligned(16))) unsigned char lds[];
    cg::grid_group grid = cg::this_grid();
    volatile LAS unsigned* bst = (volatile LAS unsigned*)((LAS unsigned char*)lds + LDS_STAGE);
    if (threadIdx.x < 2) bst[threadIdx.x] = 0u;
    __syncthreads();
    const XcdBarrier xbar = xcd_barrier_post((unsigned*)(p.ws + OFF_BAR), bst);
#define GRID_SYNC_CG() do { __builtin_amdgcn_fence(__ATOMIC_RELEASE, "agent"); asm volatile("s_waitcnt vmcnt(0)" ::: "memory"); grid.sync(); \
        __builtin_amdgcn_fence(__ATOMIC_ACQUIRE, "agent"); asm volatile("s_waitcnt vmcnt(0)" ::: "memory"); } while (0)
#define GRID_SYNC() xcd_barrier(xbar)
    const int G = gridDim.x, bid = blockIdx.x, NGW = G * NWAVES;
    LAS unsigned char* ldsl = (LAS unsigned char*)lds;
#define PHASE_IDS() const int tid = fresh_tid(), lane = tid & 63, wave = tid >> 6, gw = bid * NWAVES + wave; LAS float* scr = (LAS float*)(ldsl + wave * 8448); (void)scr; (void)gw; (void)lane
    unsigned char* ws = p.ws;
    bf16_t* Wgu = (bf16_t*)(ws + OFF_WGU); bf16_t* Wd = (bf16_t*)(ws + OFF_WD); bf16_t* Win = (bf16_t*)(ws + OFF_WIN); bf16_t* Wuq = (bf16_t*)(ws + OFF_WUQ);
    bf16_t* Wukv = (bf16_t*)(ws + OFF_WUKV); bf16_t* Woa = (bf16_t*)(ws + OFF_WOA); bf16_t* Wp = (bf16_t*)(ws + OFF_WP); bf16_t* Wout = (bf16_t*)(ws + OFF_WOUT);
    bf16_t* XN = (bf16_t*)(ws + OFF_XN); bf16_t* F = (bf16_t*)(ws + OFF_F); float* ZF = (float*)(ws + OFF_ZF); bf16_t* KV = (bf16_t*)(ws + OFF_KV);
    bf16_t* H = (bf16_t*)(ws + OFF_H); bf16_t* O = (bf16_t*)(ws + OFF_O); bf16_t* CQN = (bf16_t*)(ws + OFF_CQN); bf16_t* CKVN = (bf16_t*)(ws + OFF_CKVN);
    float* TAB = (float*)(ws + OFF_TAB); bf16_t* Q = (bf16_t*)(ws + OFF_Q); bf16_t* KR = (bf16_t*)(ws + OFF_KR); bf16_t* Gt = (bf16_t*)(ws + OFF_G); bf16_t* DP = (bf16_t*)(ws + OFF_DP);
    float* X = p.out;
    float* xbuf0 = (float*)(ws + OFF_XBUF); unsigned* cnt0 = (unsigned*)(ws + OFF_CNT);

    { PHASE_IDS();
    tr_job<TR_GU>(p.f1_wg, p.f1_wu, 1024, DFF, 5632, Wgu, scr, lane, gw, NGW);
    tr_job<TR_PLAIN>(p.f1_wd, nullptr, DFF, 1024, 1024, Wd, scr, lane, gw, NGW);
    rows_phase<0>(p.x, nullptr, 0.f, nullptr, p.f1_pre, nullptr, XN, gw, NGW, lane); }
    GRID_SYNC_CG();

    pg8::StaticOrder S;
    { pg8::Gemm g{XN, Wgu, M, 5632, 1024}; S.init(M, 5632, G, bid); pg8::EpiSwiGLU E{H}; pg8::gemm_phase(ldsl, g, S, E); }
    {
        const int tail0 = (64 * 22) % G;
        if (tail0 != 0 && bid >= tail0) { PHASE_IDS(); const int tb = bid - tail0, nb = G - tail0, tgw = tb * NWAVES + wave, TNGW = nb * NWAVES;
            tr_job<TR_WIN>(p.w_in, nullptr, 1024, INW, 3328, Win, scr, lane, tgw, TNGW);
            tr_job<TR_UQ>(p.w_uq, nullptr, QL, 1536, 1536, Wuq, scr, lane, tgw, TNGW);
            tr_job<TR_UKV>(p.w_uk, p.w_uv, KVL, 1024, 2048, Wukv, scr, lane, tgw, TNGW);
            tr_job<TR_PLAIN>(p.w_oa, nullptr, 1024, 1024, 1024, Woa, scr, lane, tgw, TNGW);
            tr_job<TR_PLAIN>(p.w_out, nullptr, 1024, 1024, 1024, Wout, scr, lane, tgw, TNGW);
    for (int idx = tb * NTHREADS + tid; idx < 65536; idx += nb * NTHREADS) {
            const int n = idx & 1023, c8 = idx >> 10, g = c8 >> 4, cb = (c8 & 15) * 8;
            float a[8];
    #pragma unroll
            for (int i = 0; i < 8; ++i) a[i] = 0.f;
            for (int j0 = 0; j0 < 128; j0 += 8) { float w[8]; f32x4 pw[8][2];
    #pragma unroll
                for (int jj = 0; jj < 8; ++jj) w[jj] = p.w_op[(size_t)(g * 128 + j0 + jj) * 1024 + n] * p.pool_scale[g * 128 + j0 + jj];
    #pragma unroll
                for (int i = 0; i < 8; ++i) { pw[i][0] = *(const f32x4*)(p.pool_w + (size_t)(g * 128 + cb + i) * 128 + j0); pw[i][1] = *(const f32x4*)(p.pool_w + (size_t)(g * 128 + cb + i) * 128 + j0 + 4); }
    #pragma unroll
                for (int i = 0; i < 8; ++i)
    #pragma unroll
                    for (int jj = 0; jj < 8; ++jj) a[i] = fmaf(pw[i][jj >> 2][jj & 3], w[jj], a[i]); }
            u32x4 o; o.x = cvt_pk_bf16(a[0], a[1]); o.y = cvt_pk_bf16(a[2], a[3]); o.z = cvt_pk_bf16(a[4], a[5]); o.w = cvt_pk_bf16(a[6], a[7]);
            *(u32x4*)(Wp + (size_t)n * 512 + c8 * 8) = o;
        }
        }
        else if (tail0 == 0) { PHASE_IDS(); const int tb = bid, nb = G;
            tr_job<TR_WIN>(p.w_in, nullptr, 1024, INW, 3328, Win, scr, lane, gw, NGW);
            tr_job<TR_UQ>(p.w_uq, nullptr, QL, 1536, 1536, Wuq, scr, lane, gw, NGW);
            tr_job<TR_UKV>(p.w_uk, p.w_uv, KVL, 1024, 2048, Wukv, scr, lane, gw, NGW);
            tr_job<TR_PLAIN>(p.w_oa, nullptr, 1024, 1024, 1024, Woa, scr, lane, gw, NGW);
            tr_job<TR_PLAIN>(p.w_out, nullptr, 1024, 1024, 1024, Wout, scr, lane, gw, NGW);
    for (int idx = tb * NTHREADS + tid; idx < 65536; idx += nb * NTHREADS) {
            const int n = idx & 1023, c8 = idx >> 10, g = c8 >> 4, cb = (c8 & 15) * 8;
            float a[8];
    #pragma unroll
            for (int i = 0; i < 8; ++i) a[i] = 0.f;
            for (int j0 = 0; j0 < 128; j0 += 8) { float w[8]; f32x4 pw[8][2];
    #pragma unroll
                for (int jj = 0; jj < 8; ++jj) w[jj] = p.w_op[(size_t)(g * 128 + j0 + jj) * 1024 + n] * p.pool_scale[g * 128 + j0 + jj];
    #pragma unroll
                for (int i = 0; i < 8; ++i) { pw[i][0] = *(const f32x4*)(p.pool_w + (size_t)(g * 128 + cb + i) * 128 + j0); pw[i][1] = *(const f32x4*)(p.pool_w + (size_t)(g * 128 + cb + i) * 128 + j0 + 4); }
    #pragma unroll
                for (int i = 0; i < 8; ++i)
    #pragma unroll
                    for (int jj = 0; jj < 8; ++jj) a[i] = fmaf(pw[i][jj >> 2][jj & 3], w[jj], a[i]); }
            u32x4 o; o.x = cvt_pk_bf16(a[0], a[1]); o.y = cvt_pk_bf16(a[2], a[3]); o.z = cvt_pk_bf16(a[4], a[5]); o.w = cvt_pk_bf16(a[6], a[7]);
            *(u32x4*)(Wp + (size_t)n * 512 + c8 * 8) = o;
        }
        }
    }
    GRID_SYNC();
    { pg8::Gemm g{H, Wd, M, 1024, DFF}; S.init(M, 1024, G, bid);
      pg8::EpiResNorm<false> E{p.x, X, XN, 0.5f, p.f1_post, p.mix_pre, pg8::PanelSumSq{xbuf0, cnt0}, pg8::PanelSumSq{xbuf0 + (size_t)M * 4, cnt0 + 4096}}; pg8::gemm_phase(ldsl, g, S, E); }
    GRID_SYNC();
    { pg8::Gemm g{XN, Win, M, 1280, 1024}; S.init(M, 1280, G, bid); pg8::EpiF32 E{ZF, 1280}; pg8::gemm_phase(ldsl, g, S, E); }
    {
        const int tail0 = (64 * 5) % G; PHASE_IDS();
        if (tail0 != 0 && bid >= tail0) { const int tgw = (bid - tail0) * NWAVES + wave, TNGW = (G - tail0) * NWAVES;
            tr_job<TR_GU>(p.f2_wg, p.f2_wu, 1024, DFF, 5632, Wgu, scr, lane, tgw, TNGW);
            tr_job<TR_PLAIN>(p.f2_wd, nullptr, DFF, 1024, 1024, Wd, scr, lane, tgw, TNGW); }
        else if (tail0 == 0) { tr_job<TR_GU>(p.f2_wg, p.f2_wu, 1024, DFF, 5632, Wgu, scr, lane, gw, NGW); tr_job<TR_PLAIN>(p.f2_wd, nullptr, DFF, 1024, 1024, Wd, scr, lane, gw, NGW); }
    }
    GRID_SYNC();
    { PHASE_IDS();
    for (int row = gw; row < M; row += NGW) {
        const float* z = ZF + (size_t)row * 1280;
        {
            f32x4 a = *(const f32x4*)(z + 4 * lane), b = (f32x4){0.f, 0.f, 0.f, 0.f};
            if (lane < 32) b = *(const f32x4*)(z + 4 * (lane + 64));
            float ss = a.x * a.x + a.y * a.y + a.z * a.z + a.w * a.w + b.x * b.x + b.y * b.y + b.z * b.z + b.w * b.w;
            const float r = __builtin_amdgcn_rsqf(wave_sum(ss) * (1.f / QL) + EPS);
            { const f32x4 g = *(const f32x4*)(p.qa_g + 4 * lane); const f32x4 y = a * g * r; u32x2 w; w.x = cvt_pk_bf16(y.x, y.y); w.y = cvt_pk_bf16(y.z, y.w); *(u32x2*)(CQN + (size_t)row * QL + 4 * lane) = w; }
            if (lane < 32) { const f32x4 g = *(const f32x4*)(p.qa_g + 4 * (lane + 64)); const f32x4 y = b * g * r; u32x2 w; w.x = cvt_pk_bf16(y.x, y.y); w.y = cvt_pk_bf16(y.z, y.w); *(u32x2*)(CQN + (size_t)row * QL + 4 * (lane + 64)) = w; }
        }
        {
            const f32x4 a = *(const f32x4*)(z + 384 + 4 * lane);
            const float ss = a.x * a.x + a.y * a.y + a.z * a.z + a.w * a.w;
            const float r = __builtin_amdgcn_rsqf(wave_sum(ss) * (1.f / KVL) + EPS);
            const f32x4 g = *(const f32x4*)(p.kva_g + 4 * lane); const f32x4 y = a * g * r; u32x2 w; w.x = cvt_pk_bf16(y.x, y.y); w.y = cvt_pk_bf16(y.z, y.w); *(u32x2*)(CKVN + (size_t)row * KVL + 4 * lane) = w;
        }
        if (lane < 32) {
            const float x1 = z[640 + lane], x2 = z[672 + lane];
            const float ang = (float)p.pos[row] * p.inv_freq[lane];
            const double ad = (double)ang; const double kq = rint(ad * 0.15915494309189535); const float red = (float)(ad - kq * 6.283185307179586);
            const float cs = __cosf(red), sn = __sinf(red);
            TAB[(size_t)row * 64 + lane] = cs; TAB[(size_t)row * 64 + 32 + lane] = sn;
            *(unsigned*)(KR + (size_t)row * 64 + 2 * lane) = cvt_pk_bf16(x1 * cs - x2 * sn, x2 * cs + x1 * sn);
        }
        {
            const int t = row & (SEQ - 1), g = lane >> 4, wnd = 2 << g, lo = max(t - (wnd >> 1), 0), hi = min(t + wnd - (wnd >> 1), SEQ);
            const float* zp = z + 704 + 8 * lane;
            f32x4 s0 = (f32x4){0.f, 0.f, 0.f, 0.f}, s1 = s0;
            for (int dt = -8; dt < 8; ++dt) { const int tt = t + dt;
                if (tt >= lo && tt < hi) { const float* q = zp + (long)dt * 1280; s0 = s0 + *(const f32x4*)q; s1 = s1 + *(const f32x4*)(q + 4); } }
            const float inv = 1.f / (float)(hi - lo);
            const f32x4 c0 = *(const f32x4*)zp, c1 = *(const f32x4*)(zp + 4);
            const f32x4 d0 = s0 * inv - c0, d1 = s1 * inv - c1;
            u32x4 w; w.x = cvt_pk_bf16(d0.x, d0.y); w.y = cvt_pk_bf16(d0.z, d0.w); w.z = cvt_pk_bf16(d1.x, d1.y); w.w = cvt_pk_bf16(d1.z, d1.w);
            *(u32x4*)(DP + (size_t)row * 512 + 8 * lane) = w;
        }
    } }
    GRID_SYNC();
    { pg8::Gemm g{CQN, Wuq, M, 1536, QL}; S.init(M, 1536, G, bid); pg8::EpiQ E{Q, TAB}; pg8::gemm_phase(ldsl, g, S, E); }
    { pg8::Gemm g{CKVN, Wukv, M, 2048, KVL}; S.init(M, 2048, G, bid); pg8::EpiBf16 E{KV, 2048}; pg8::gemm_phase(ldsl, g, S, E); }
    GRID_SYNC();
    {
        const int vcu = (bid & 7) * (G >> 3) + (bid >> 3);
        for (int it = vcu; it < NB * NH * (SEQ / 256); it += G) {
            const int qb = it & 7, h = (it >> 3) & 7, b = it >> 6;
            const size_t tok0 = (size_t)b * SEQ;
            att::attn_body(Q + (tok0 + qb * 256) * 1536 + h * 192, KV + tok0 * 2048 + h * 128, KR + tok0 * 64, KV + tok0 * 2048 + 1024 + h * 128,
                           O + (tok0 + qb * 256) * 1024 + h * 128, SEQ, (char*)lds);
            __syncthreads();
        }
    }
    GRID_SYNC();
    { pg8::Gemm g{XN, Win + (size_t)1280 * 1024, M, 2048, 1024}; S.init(M, 2048, G, bid); pg8::EpiGate E{Gt}; pg8::gemm_phase(ldsl, g, S, E); }
    GRID_SYNC();
    { pg8::Gemm g{O, Woa, M, 1024, 1024}; S.init(M, 1024, G, bid); pg8::EpiT1 E{Gt, F}; pg8::gemm_phase(ldsl, g, S, E); }
    { pg8::Gemm g{DP, Wp, M, 1024, 512}; S.init(M, 1024, G, bid); pg8::EpiMX E{Gt, F, XN}; pg8::gemm_phase(ldsl, g, S, E); }
    GRID_SYNC();
    { pg8::Gemm g{XN, Wout, M, 1024, 1024}; S.init(M, 1024, G, bid);
      pg8::EpiResNorm<false> E{X, X, XN, 1.0f, p.mix_post, p.f2_pre, pg8::PanelSumSq{xbuf0 + (size_t)M * 8, cnt0 + 2 * 4096}, pg8::PanelSumSq{xbuf0 + (size_t)M * 12, cnt0 + 3 * 4096}}; pg8::gemm_phase(ldsl, g, S, E); }
    GRID_SYNC();
    { pg8::Gemm g{XN, Wgu, M, 5632, 1024}; S.init(M, 5632, G, bid); pg8::EpiSwiGLU E{H}; pg8::gemm_phase(ldsl, g, S, E); }
    GRID_SYNC();
    { pg8::Gemm g{H, Wd, M, 1024, DFF}; S.init(M, 1024, G, bid);
      pg8::EpiResNorm<true> E{X, X, nullptr, 0.5f, p.f2_post, p.final_g, pg8::PanelSumSq{xbuf0 + (size_t)M * 16, cnt0 + 4 * 4096}, pg8::PanelSumSq{xbuf0 + (size_t)M * 20, cnt0 + 5 * 4096}}; pg8::gemm_phase(ldsl, g, S, E); }
}

extern "C" void kernel_launch(void* const* d_in, const int* in_sizes, int n_in, void* d_out, int out_size, void* d_ws, size_t ws_size, hipStream_t stream) {
    static int grid_blocks = 0;
    if (grid_blocks == 0) {
        if (n_in != 26 || in_sizes[0] != M * DM || out_size != M * DM || ws_size < WS_END) { fprintf(stderr, "kernel_launch: shape mismatch n_in %d in0 %d out %d ws %zu\n", n_in, n_in > 0 ? in_sizes[0] : -1, out_size, ws_size); grid_blocks = -1; return; }
        int dev = 0, cus = 0, per_cu = 0;
        (void)hipGetDevice(&dev);
        (void)hipDeviceGetAttribute(&cus, hipDeviceAttributeMultiprocessorCount, dev);
        if (hipFuncSetAttribute((const void*)fwd_megakernel, hipFuncAttributeMaxDynamicSharedMemorySize, LDS_BYTES) != hipSuccess) { fprintf(stderr, "kernel_launch: hipFuncSetAttribute failed\n"); grid_blocks = -1; return; }
        if (hipOccupancyMaxActiveBlocksPerMultiprocessor(&per_cu, (const void*)fwd_megakernel, NTHREADS, LDS_BYTES) != hipSuccess || per_cu < 1) { fprintf(stderr, "kernel_launch: occupancy query failed (%d)\n", per_cu); (void)hipGetLastError(); per_cu = 1; }
        grid_blocks = cus * 1;
        if (grid_blocks != 256) { fprintf(stderr, "kernel_launch: built for 256 CUs (one workgroup each), device has %d\n", cus); grid_blocks = -1; return; }
    }
    if (grid_blocks < 0) return;
    Params p{};
    p.x = (const float*)d_in[0]; p.pos = (const int*)d_in[1];
    p.f1_pre = (const float*)d_in[2]; p.f1_wg = (const float*)d_in[3]; p.f1_wu = (const float*)d_in[4]; p.f1_wd = (const float*)d_in[5]; p.f1_post = (const float*)d_in[6];
    p.mix_pre = (const float*)d_in[7]; p.w_in = (const float*)d_in[8]; p.qa_g = (const float*)d_in[9]; p.w_uq = (const float*)d_in[10]; p.kva_g = (const float*)d_in[11];
    p.w_uk = (const float*)d_in[12]; p.w_uv = (const float*)d_in[13]; p.w_oa = (const float*)d_in[14]; p.pool_w = (const float*)d_in[15]; p.pool_scale = (const float*)d_in[16];
    p.w_op = (const float*)d_in[17]; p.w_out = (const float*)d_in[18]; p.mix_post = (const float*)d_in[19];
    p.f2_pre = (const float*)d_in[20]; p.f2_wg = (const float*)d_in[21]; p.f2_wu = (const float*)d_in[22]; p.f2_wd = (const float*)d_in[23]; p.f2_post = (const float*)d_in[24]; p.final_g = (const float*)d_in[25];
    p.out = (float*)d_out; p.ws = (unsigned char*)d_ws;
    for (int i = 0; i < 32; ++i) p.inv_freq[i] = (float)pow(10000.0, -(2.0 * i) / 64.0);
    if (hipMemsetAsync((char*)d_ws + OFF_BAR, 0, CTL_BYTES, stream) != hipSuccess) { fprintf(stderr, "kernel_launch: memset failed\n"); return; }
    void* args[] = {&p};
    hipError_t e = hipLaunchCooperativeKernel((const void*)fwd_megakernel, dim3(grid_blocks), dim3(NTHREADS), args, LDS_BYTES, stream);
    if (e != hipSuccess) fprintf(stderr, "cooperative launch failed: %s (grid %d)\n", hipGetErrorString(e), grid_blocks);
}
```

```cpp
#include <hip/hip_runtime.h>
#include <hip/hip_cooperative_groups.h>
#include <cstdio>
#include <cmath>
#include <cstdint>
namespace cg = cooperative_groups;

#define LAS __attribute__((address_space(3)))
typedef unsigned short bf16_t;
typedef short bf16x8 __attribute__((ext_vector_type(8)));
typedef short s16x4 __attribute__((ext_vector_type(4)));
typedef float f32x2 __attribute__((ext_vector_type(2)));
typedef float f32x4 __attribute__((ext_vector_type(4)));
typedef float f32x16 __attribute__((ext_vector_type(16)));
typedef unsigned u32x4 __attribute__((ext_vector_type(4)));
typedef unsigned u32x2 __attribute__((ext_vector_type(2)));

constexpr int DM = 1024, NB = 8, SEQ = 2048, M = NB * SEQ, NH = 8, QL = 384, KVL = 256, DFF = 2816, INW = 3264;
constexpr float EPS = 1e-6f;
constexpr int NTHREADS = 512, NWAVES = 8;
constexpr int LDS_STAGE = 131072, LDS_BYTES = LDS_STAGE + 16;

constexpr size_t MiB = 1048576;
constexpr size_t OFF_WGU = 0;
constexpr size_t OFF_WD = OFF_WGU + (size_t)5632 * 1024 * 2;
constexpr size_t OFF_WIN = OFF_WD + (size_t)1024 * 2816 * 2;
constexpr size_t OFF_WUQ = OFF_WIN + (size_t)3328 * 1024 * 2;
constexpr size_t OFF_WUKV = OFF_WUQ + (size_t)1536 * 384 * 2;
constexpr size_t OFF_WOA = OFF_WUKV + (size_t)2048 * 256 * 2;
constexpr size_t OFF_WP = OFF_WOA + (size_t)1024 * 1024 * 2;
constexpr size_t OFF_WOUT = OFF_WP + (size_t)1024 * 512 * 2;
constexpr size_t OFF_XN = OFF_WOUT + (size_t)1024 * 1024 * 2;
constexpr size_t OFF_R = OFF_XN + 32 * MiB;
constexpr size_t OFF_F = OFF_R;
constexpr size_t OFF_ZF = OFF_R;
constexpr size_t OFF_KV = OFF_R;
constexpr size_t OFF_H = OFF_R + 64 * MiB;
constexpr size_t OFF_O = OFF_R + 64 * MiB;
constexpr size_t OFF_CQN = OFF_R + 80 * MiB;
constexpr size_t OFF_CKVN = OFF_R + 92 * MiB;
constexpr size_t OFF_TAB = OFF_R + 100 * MiB;
constexpr size_t OFF_Q = OFF_R + 104 * MiB;
constexpr size_t OFF_KR = OFF_R + 152 * MiB;
constexpr size_t OFF_G = OFF_R + 96 * MiB;
constexpr size_t OFF_DP = OFF_R + 176 * MiB;
constexpr size_t WS_END = OFF_R + 192 * MiB;
constexpr size_t OFF_BAR = WS_END, OFF_CNT = OFF_BAR + 16384, CTL_BYTES = 16384 + 6 * 16384, OFF_XBUF = OFF_BAR + CTL_BYTES;
static_assert(OFF_XBUF + 6 * (size_t)M * 16 <= 256 * MiB, "workspace");

struct Params {
    const float* x; const int* pos;
    const float *f1_pre, *f1_wg, *f1_wu, *f1_wd, *f1_post;
    const float *mix_pre, *w_in, *qa_g, *w_uq, *kva_g, *w_uk, *w_uv, *w_oa, *pool_w, *pool_scale, *w_op, *w_out, *mix_post;
    const float *f2_pre, *f2_wg, *f2_wu, *f2_wd, *f2_post, *final_g;
    float* out; unsigned char* ws;
    float inv_freq[32];
};

typedef __bf16 bf16x2_t __attribute__((ext_vector_type(2)));
__device__ __forceinline__ unsigned cvt_pk_bf16(float lo, float hi) { const f32x2 v = {lo, hi}; const bf16x2_t r = __builtin_convertvector(v, bf16x2_t); return __builtin_bit_cast(unsigned, r); }
__device__ __forceinline__ float bf_lo(unsigned w) { return __uint_as_float(w << 16); }
__device__ __forceinline__ float bf_hi(unsigned w) { return __uint_as_float(w & 0xffff0000u); }
__device__ __forceinline__ float sigmoidf_fast(float z) { return __builtin_amdgcn_rcpf(1.f + __builtin_amdgcn_exp2f(-1.4426950408889634f * z)); }
__device__ __forceinline__ int fresh_tid() { int t = threadIdx.x; asm volatile("" : "+v"(t)); return t; }
__device__ __forceinline__ float wave_sum(float v) {
#pragma unroll
    for (int o = 1; o < 64; o <<= 1) v += __shfl_xor(v, o);
    return v;
}

namespace pg8 {
constexpr int BM = 256, BK = 64, HALF = 128, HTB = HALF * BK * 2, STAGE_BYTES = 8 * HTB, NXCD = 8, WGM = 8;
__host__ __device__ __forceinline__ int lds_byte(int r, int c) { const int st = (r >> 4) * 2 + (c >> 5), rr = r & 15, cc = c & 31, ob = rr * 64 + cc * 2; return st * 1024 + (ob ^ (((ob >> 9) & 1) << 5)); }
__host__ __device__ __forceinline__ void stage_rc(int b, int& R, int& C) { const int st = b / 1024, sb = b % 1024, swz = sb ^ (((sb >> 9) & 1) << 5); R = (st >> 1) * 16 + swz / 64; C = (st & 1) * 32 + (swz % 64) / 2; }
__host__ __device__ __forceinline__ int perm32(int rho) { const int n = rho >> 4, i = rho & 15; return 8 * (i >> 2) + 4 * n + (i & 3); }
struct Unit { int pm, pn; };
struct Gemm { const bf16_t* A; const bf16_t* Bt; int M, N, K; };
struct StaticOrder {
    int nM, nN, nwg, G, c;
    __device__ void init(int M_, int N_, int G_, int c_) { nM = M_ / BM; nN = N_ / BM; nwg = nM * nN; G = G_; c = c_; }
    __device__ bool next(int i, Unit& u) const {
        const long L = (long)i * G + c; if (L >= nwg) return false;
        int wgid = (int)L; { const int q = nwg / NXCD, r = nwg % NXCD, xcd = wgid % NXCD, off = wgid / NXCD; wgid = (xcd < r ? xcd * (q + 1) : r * (q + 1) + (xcd - r) * q) + off; }
        const int nig = WGM * nN, gid = wgid / nig, fm = gid * WGM, gsz = (nM - fm) < WGM ? (nM - fm) : WGM;
        u.pm = fm + ((wgid % nig) % gsz); u.pn = (wgid % nig) / gsz; return true;
    }
};

template <class Epi>
__device__ __forceinline__ void gemm_phase(LAS unsigned char* lds, const Gemm g, const StaticOrder& S, const Epi& E) {
    const int tid = fresh_tid(), wid = __builtin_amdgcn_readfirstlane(tid >> 6), lane = tid & 63, wr = wid >> 2, wc = wid & 3, fr = lane & 15, fq = lane >> 4;
    const int K = g.K, nt = K / BK;
    unsigned voffA, voffB;
    { int R, C; stage_rc(tid * 16, R, C); const int Rb = Epi::PERM ? ((R & ~31) + perm32(R & 31)) : R;
      voffA = (unsigned)(R * K + C) * 2u; voffB = (unsigned)(Rb * K + C) * 2u; }
    const size_t rstep64 = (size_t)64 * K * 2;
    const size_t kstep = (size_t)(BK * 2);
    const size_t hstep = (size_t)HALF * K * 2;
    const size_t tstep = 2 * hstep;
    const unsigned ldsw = (unsigned)wid * 1024u;
    const int aoff = lds_byte(wr * 64 + fr, fq * 8), boff = lds_byte(wc * 32 + fr, fq * 8);
#define PG8_SA(b, h) (((b) * 2 + (h)) * HTB)
#define PG8_SB(b, h) ((4 + (b) * 2 + (h)) * HTB)
#define PG8_STAGE(bufoff, gbase, voff) do { _Pragma("unroll") for (int _i = 0; _i < 2; ++_i) \
        __builtin_amdgcn_global_load_lds((const unsigned*)((const char*)(gbase) + _i * rstep64 + (voff)), (LAS unsigned*)(lds + (bufoff) + ldsw + _i * 8192), 16, 0, 0); } while (0)
#define PG8_LDA(dst, b, h) do { _Pragma("unroll") for (int m = 0; m < 4; ++m) _Pragma("unroll") for (int k = 0; k < 2; ++k) dst[m][k] = *(const LAS bf16x8*)(lds + PG8_SA(b, h) + aoff + m * 2048 + k * 1024); } while (0)
#define PG8_LDB(dst, b, h) do { _Pragma("unroll") for (int n = 0; n < 2; ++n) _Pragma("unroll") for (int k = 0; k < 2; ++k) dst[n][k] = *(const LAS bf16x8*)(lds + PG8_SB(b, h) + boff + n * 2048 + k * 1024); } while (0)
#define PG8_MMA(ai, bj, At, Bt) do { __builtin_amdgcn_s_setprio(1); _Pragma("unroll") for (int m = 0; m < 4; ++m) _Pragma("unroll") for (int n = 0; n < 2; ++n) _Pragma("unroll") for (int k = 0; k < 2; ++k) \
        acc[ai][bj][m][n] = __builtin_amdgcn_mfma_f32_16x16x32_bf16(Bt[n][k], At[m][k], acc[ai][bj][m][n], 0, 0, 0); __builtin_amdgcn_s_setprio(0); } while (0)
#define PG8_WAIT_V(n) asm volatile("s_waitcnt vmcnt(" #n ")" ::: "memory")
#define PG8_WAIT_L(n) asm volatile("s_waitcnt lgkmcnt(" #n ")" ::: "memory")
#define PG8_BAR __builtin_amdgcn_s_barrier()
#define PG8_SCHED __builtin_amdgcn_sched_barrier(0)
    Unit cur, nxt; int ui = 0;
    if (!S.next(0, cur)) return;
    f32x4 acc[2][2][4][2];
#pragma unroll
    for (int a = 0; a < 2; ++a)
#pragma unroll
        for (int b = 0; b < 2; ++b)
#pragma unroll
            for (int m = 0; m < 4; ++m)
#pragma unroll
                for (int n = 0; n < 2; ++n) acc[a][b][m][n] = (f32x4){0.f, 0.f, 0.f, 0.f};
    bf16x8 At[4][2], B0[2][2], B1[2][2];
    const char* cA = (const char*)g.A + (size_t)cur.pm * tstep; const char* cB = (const char*)g.Bt + (size_t)cur.pn * tstep;
    PG8_STAGE(PG8_SB(0, 0), cB, voffB); PG8_STAGE(PG8_SA(0, 0), cA, voffA); PG8_STAGE(PG8_SB(0, 1), cB + hstep, voffB); PG8_STAGE(PG8_SA(0, 1), cA + hstep, voffA);
    if (wr == 1) PG8_BAR;
    PG8_WAIT_V(4); PG8_BAR;
    PG8_STAGE(PG8_SB(1, 0), cB + kstep, voffB); PG8_STAGE(PG8_SA(1, 0), cA + kstep, voffA); PG8_STAGE(PG8_SB(1, 1), cB + hstep + kstep, voffB);
    PG8_WAIT_V(6); PG8_BAR;
    for (;;) {
        const bool has_next = S.next(ui + 1, nxt);
        const char* nA = has_next ? (const char*)g.A + (size_t)nxt.pm * tstep : cA; const char* nB = has_next ? (const char*)g.Bt + (size_t)nxt.pn * tstep : cB;
        for (int t = 0; t < nt; t += 2) {
            const bool last = (t == nt - 2);
            const char* a1 = cA + (size_t)(t + 1) * kstep;
            const char* a2 = last ? nA : cA + (size_t)(t + 2) * kstep; const char* b2 = last ? nB : cB + (size_t)(t + 2) * kstep;
            const char* a3 = a2 + kstep; const char* b3 = b2 + kstep;
            PG8_LDB(B0, 0, 0); PG8_SCHED; PG8_LDA(At, 0, 0); PG8_STAGE(PG8_SA(1, 1), a1 + hstep, voffA);
            PG8_WAIT_L(8); PG8_BAR; PG8_WAIT_L(0); PG8_MMA(0, 0, At, B0); PG8_BAR; PG8_SCHED;
            PG8_LDB(B1, 0, 1); PG8_STAGE(PG8_SB(0, 0), b2, voffB);
            PG8_BAR; PG8_WAIT_L(0); PG8_MMA(0, 1, At, B1); PG8_BAR;
            PG8_LDA(At, 0, 1); PG8_STAGE(PG8_SA(0, 0), a2, voffA);
            PG8_BAR; PG8_WAIT_L(0); PG8_MMA(1, 0, At, B0); PG8_BAR; PG8_SCHED;
            PG8_STAGE(PG8_SB(0, 1), b2 + hstep, voffB);
            PG8_WAIT_V(6); PG8_BAR; PG8_MMA(1, 1, At, B1); PG8_BAR;
            PG8_LDB(B0, 1, 0); PG8_SCHED; PG8_LDA(At, 1, 0); PG8_STAGE(PG8_SA(0, 1), a2 + hstep, voffA);
            PG8_WAIT_L(8); PG8_BAR; PG8_WAIT_L(0); PG8_MMA(0, 0, At, B0); PG8_BAR; PG8_SCHED;
            PG8_LDB(B1, 1, 1); PG8_STAGE(PG8_SB(1, 0), b3, voffB);
            PG8_BAR; PG8_WAIT_L(0); PG8_MMA(0, 1, At, B1); PG8_BAR;
            PG8_LDA(At, 1, 1); PG8_STAGE(PG8_SA(1, 0), a3, voffA);
            PG8_BAR; PG8_WAIT_L(0); PG8_MMA(1, 0, At, B0); PG8_BAR; PG8_SCHED;
            PG8_STAGE(PG8_SB(1, 1), b3 + hstep, voffB);
            PG8_WAIT_V(6); PG8_BAR; PG8_MMA(1, 1, At, B1); PG8_BAR;
        }
        if constexpr (!Epi::AFTER_DRAIN) { const int t2 = fresh_tid(); E(acc, cur, wr, wc, t2 & 15, (t2 >> 4) & 3); }
        if (!has_next) break;
#pragma unroll
        for (int a = 0; a < 2; ++a)
#pragma unroll
            for (int b = 0; b < 2; ++b)
#pragma unroll
                for (int m = 0; m < 4; ++m)
#pragma unroll
                    for (int n = 0; n < 2; ++n) acc[a][b][m][n] = (f32x4){0.f, 0.f, 0.f, 0.f};
        cur = nxt; cA = nA; cB = nB; ++ui;
    }
    PG8_WAIT_V(0);
    if (wr == 0) PG8_BAR;
    PG8_BAR;
    if constexpr (Epi::AFTER_DRAIN) { const int t2 = fresh_tid(); E.fused(acc, cur, wr, wc, t2 & 15, (t2 >> 4) & 3, lds, t2 >> 6, t2 & 63); }
#undef PG8_SA
#undef PG8_SB
#undef PG8_STAGE
#undef PG8_LDA
#undef PG8_LDB
#undef PG8_MMA
#undef PG8_WAIT_V
#undef PG8_WAIT_L
#undef PG8_BAR
#undef PG8_SCHED
}

typedef f32x4 Acc[2][2][4][2];
struct EpiF32 {
    static constexpr bool PERM = false, AFTER_DRAIN = false;
    float* C; int ldc;
    __device__ __forceinline__ void operator()(const Acc& acc, const Unit& u, int wr, int wc, int fr, int fq) const {
        const int row0 = u.pm * BM + wr * 64 + fr, col0 = u.pn * BM + wc * 32 + 4 * fq;
#pragma unroll
        for (int ai = 0; ai < 2; ++ai)
#pragma unroll
            for (int m = 0; m < 4; ++m) { float* rowp = C + (size_t)(row0 + ai * HALF + m * 16) * ldc + col0;
#pragma unroll
                for (int bj = 0; bj < 2; ++bj)
#pragma unroll
                    for (int n = 0; n < 2; ++n) *(f32x4*)(rowp + bj * HALF + n * 16) = acc[ai][bj][m][n]; }
    }
};
struct EpiBf16 {
    static constexpr bool PERM = true, AFTER_DRAIN = false;
    bf16_t* O; int ldc;
    __device__ __forceinline__ void operator()(const Acc& acc, const Unit& u, int wr, int wc, int fr, int fq) const {
        const int row0 = u.pm * BM + wr * 64 + fr, col0 = u.pn * BM + wc * 32 + 8 * fq;
#pragma unroll
        for (int ai = 0; ai < 2; ++ai)
#pragma unroll
            for (int m = 0; m < 4; ++m) { bf16_t* rowp = O + (size_t)(row0 + ai * HALF + m * 16) * ldc + col0;
#pragma unroll
                for (int bj = 0; bj < 2; ++bj) { const f32x4 v0 = acc[ai][bj][m][0], v1 = acc[ai][bj][m][1];
                    u32x4 w; w.x = cvt_pk_bf16(v0[0], v0[1]); w.y = cvt_pk_bf16(v0[2], v0[3]); w.z = cvt_pk_bf16(v1[0], v1[1]); w.w = cvt_pk_bf16(v1[2], v1[3]);
                    *(u32x4*)(rowp + bj * HALF) = w; } }
    }
};
struct EpiSwiGLU {
    static constexpr bool PERM = true, AFTER_DRAIN = false;
    bf16_t* H;
    __device__ __forceinline__ void operator()(const Acc& acc, const Unit& u, int wr, int wc, int fr, int fq) const {
        const int row0 = u.pm * BM + wr * 64 + fr, col0 = u.pn * HALF + wc * 32 + 8 * fq;
#pragma unroll
        for (int ai = 0; ai < 2; ++ai)
#pragma unroll
            for (int m = 0; m < 4; ++m) { bf16_t* rowp = H + (size_t)(row0 + ai * HALF + m * 16) * DFF + col0;
                float h[8];
#pragma unroll
                for (int n = 0; n < 2; ++n)
#pragma unroll
                    for (int j = 0; j < 4; ++j) { const float gt = acc[ai][0][m][n][j], up = acc[ai][1][m][n][j]; h[n * 4 + j] = gt * sigmoidf_fast(gt) * up; }
                u32x4 w; w.x = cvt_pk_bf16(h[0], h[1]); w.y = cvt_pk_bf16(h[2], h[3]); w.z = cvt_pk_bf16(h[4], h[5]); w.w = cvt_pk_bf16(h[6], h[7]);
                *(u32x4*)rowp = w; }
    }
};
struct EpiGate {
    static constexpr bool PERM = true, AFTER_DRAIN = false;
    bf16_t* G;
    __device__ __forceinline__ void operator()(const Acc& acc, const Unit& u, int wr, int wc, int fr, int fq) const {
        const int row0 = u.pm * BM + wr * 64 + fr, col0 = u.pn * BM + wc * 32 + 8 * fq;
#pragma unroll
        for (int ai = 0; ai < 2; ++ai)
#pragma unroll
            for (int m = 0; m < 4; ++m) { bf16_t* rowp = G + (size_t)(row0 + ai * HALF + m * 16) * 2048 + col0;
#pragma unroll
                for (int bj = 0; bj < 2; ++bj) { const f32x4 v0 = acc[ai][bj][m][0], v1 = acc[ai][bj][m][1];
                    u32x4 w; w.x = cvt_pk_bf16(sigmoidf_fast(v0[0]), sigmoidf_fast(v0[1])); w.y = cvt_pk_bf16(sigmoidf_fast(v0[2]), sigmoidf_fast(v0[3]));
                    w.z = cvt_pk_bf16(sigmoidf_fast(v1[0]), sigmoidf_fast(v1[1])); w.w = cvt_pk_bf16(sigmoidf_fast(v1[2]), sigmoidf_fast(v1[3]));
                    *(u32x4*)(rowp + bj * HALF) = w; } }
    }
};
struct EpiQ {
    static constexpr bool PERM = true, AFTER_DRAIN = false;
    bf16_t* Q; const float* TAB;
    __device__ __forceinline__ void operator()(const Acc& acc, const Unit& u, int wr, int wc, int fr, int fq) const {
        const int row0 = u.pm * BM + wr * 64 + fr, col0 = u.pn * BM + wc * 32 + 8 * fq;
#pragma unroll
        for (int ai = 0; ai < 2; ++ai)
#pragma unroll
            for (int m = 0; m < 4; ++m) { const int row = row0 + ai * HALF + m * 16; bf16_t* rowp = Q + (size_t)row * 1536 + col0;
#pragma unroll
                for (int bj = 0; bj < 2; ++bj) { f32x4 v0 = acc[ai][bj][m][0], v1 = acc[ai][bj][m][1];
                    const int c = col0 + bj * HALF, w = c % 192;
                    if (w >= 128) { const int i0 = (w - 128) >> 1; const f32x4 cs = *(const f32x4*)(TAB + (size_t)row * 64 + i0), sn = *(const f32x4*)(TAB + (size_t)row * 64 + 32 + i0);
                        f32x4 r0, r1;
                        r0[0] = v0[0] * cs[0] - v0[1] * sn[0]; r0[1] = v0[1] * cs[0] + v0[0] * sn[0];
                        r0[2] = v0[2] * cs[1] - v0[3] * sn[1]; r0[3] = v0[3] * cs[1] + v0[2] * sn[1];
                        r1[0] = v1[0] * cs[2] - v1[1] * sn[2]; r1[1] = v1[1] * cs[2] + v1[0] * sn[2];
                        r1[2] = v1[2] * cs[3] - v1[3] * sn[3]; r1[3] = v1[3] * cs[3] + v1[2] * sn[3];
                        v0 = r0; v1 = r1; }
                    u32x4 wv; wv.x = cvt_pk_bf16(v0[0], v0[1]); wv.y = cvt_pk_bf16(v0[2], v0[3]); wv.z = cvt_pk_bf16(v1[0], v1[1]); wv.w = cvt_pk_bf16(v1[2], v1[3]);
                    *(u32x4*)(rowp + bj * HALF) = wv; } }
    }
};
struct EpiT1 {
    static constexpr bool PERM = true, AFTER_DRAIN = false;
    const bf16_t* G; bf16_t* F;
    __device__ __forceinline__ void operator()(const Acc& acc, const Unit& u, int wr, int wc, int fr, int fq) const {
        const int row0 = u.pm * BM + wr * 64 + fr, col0 = u.pn * BM + wc * 32 + 8 * fq;
#pragma unroll
        for (int ai = 0; ai < 2; ++ai)
#pragma unroll
            for (int m = 0; m < 4; ++m) { const int row = row0 + ai * HALF + m * 16;
#pragma unroll
                for (int bj = 0; bj < 2; ++bj) { const f32x4 v0 = acc[ai][bj][m][0], v1 = acc[ai][bj][m][1]; const int c = col0 + bj * HALF;
                    const u32x4 gw = *(const u32x4*)(G + (size_t)row * 2048 + c);
                    u32x4 wv;
                    wv.x = cvt_pk_bf16(v0[0] * bf_lo(gw.x), v0[1] * bf_hi(gw.x)); wv.y = cvt_pk_bf16(v0[2] * bf_lo(gw.y), v0[3] * bf_hi(gw.y));
                    wv.z = cvt_pk_bf16(v1[0] * bf_lo(gw.z), v1[1] * bf_hi(gw.z)); wv.w = cvt_pk_bf16(v1[2] * bf_lo(gw.w), v1[3] * bf_hi(gw.w));
                    *(u32x4*)(F + (size_t)row * 1024 + c) = wv; } }
    }
};
struct EpiMX {
    static constexpr bool PERM = true, AFTER_DRAIN = false;
    const bf16_t* G; const bf16_t* F; bf16_t* MX;
    __device__ __forceinline__ void operator()(const Acc& acc, const Unit& u, int wr, int wc, int fr, int fq) const {
        const int row0 = u.pm * BM + wr * 64 + fr, col0 = u.pn * BM + wc * 32 + 8 * fq;
#pragma unroll
        for (int ai = 0; ai < 2; ++ai)
#pragma unroll
            for (int m = 0; m < 4; ++m) { const int row = row0 + ai * HALF + m * 16;
#pragma unroll
                for (int bj = 0; bj < 2; ++bj) { const f32x4 v0 = acc[ai][bj][m][0], v1 = acc[ai][bj][m][1]; const int c = col0 + bj * HALF;
                    const u32x4 gw = *(const u32x4*)(G + (size_t)row * 2048 + 1024 + c);
                    const u32x4 tw = *(const u32x4*)(F + (size_t)row * 1024 + c);
                    u32x4 wv;
                    wv.x = cvt_pk_bf16(bf_lo(tw.x) + v0[0] * bf_lo(gw.x), bf_hi(tw.x) + v0[1] * bf_hi(gw.x)); wv.y = cvt_pk_bf16(bf_lo(tw.y) + v0[2] * bf_lo(gw.y), bf_hi(tw.y) + v0[3] * bf_hi(gw.y));
                    wv.z = cvt_pk_bf16(bf_lo(tw.z) + v1[0] * bf_lo(gw.z), bf_hi(tw.z) + v1[1] * bf_hi(gw.z)); wv.w = cvt_pk_bf16(bf_lo(tw.w) + v1[2] * bf_lo(gw.w), bf_hi(tw.w) + v1[3] * bf_hi(gw.w));
                    *(u32x4*)(MX + (size_t)row * 1024 + c) = wv; } }
    }
};

struct PanelSumSq {
    float* xbuf;
    unsigned* cnt;
    __device__ __forceinline__ void run(const Acc& v, const Unit& u, int wr, int wc, int fr, int fq, LAS unsigned char* lds, int wid, int lane) const {
        LAS float* P = (LAS float*)lds; LAS float* S = (LAS float*)(lds + 4096);
#pragma unroll
        for (int ai = 0; ai < 2; ++ai)
#pragma unroll
            for (int m = 0; m < 4; ++m) { float q = 0.f;
#pragma unroll
                for (int bj = 0; bj < 2; ++bj)
#pragma unroll
                    for (int n = 0; n < 2; ++n) { const f32x4 x = v[ai][bj][m][n]; q += (x[0] * x[0] + x[1] * x[1]) + (x[2] * x[2] + x[3] * x[3]); }
                q += __shfl_xor(q, 16); q += __shfl_xor(q, 32);
                if (fq == 0) P[(ai * HALF + wr * 64 + m * 16 + fr) * 4 + wc] = q; }
        asm volatile("s_waitcnt lgkmcnt(0)" ::: "memory"); __builtin_amdgcn_s_barrier(); asm volatile("" ::: "memory");
        const int row = wid * 32 + (lane & 31);
        if (lane < 32) { const float t = (P[row * 4 + 0] + P[row * 4 + 1]) + (P[row * 4 + 2] + P[row * 4 + 3]);
            __hip_atomic_store(xbuf + ((size_t)(u.pm * BM + row) * 4 + u.pn), t, __ATOMIC_RELAXED, __HIP_MEMORY_SCOPE_AGENT); }
        asm volatile("s_waitcnt vmcnt(0)" ::: "memory");
        if (lane == 0) __hip_atomic_fetch_add(cnt + 64 * u.pm, 1u, __ATOMIC_RELAXED, __HIP_MEMORY_SCOPE_AGENT);
        if (wid == 0) { unsigned sp = 0u;
            while ((unsigned)__builtin_amdgcn_readfirstlane(__hip_atomic_load(cnt + 64 * u.pm, __ATOMIC_RELAXED, __HIP_MEMORY_SCOPE_AGENT)) < 32u) { __builtin_amdgcn_s_sleep(1); if (++sp > (1u << 22)) break; }
            __builtin_amdgcn_fence(__ATOMIC_ACQUIRE, "agent"); }
        asm volatile("s_waitcnt vmcnt(0) lgkmcnt(0)" ::: "memory"); __builtin_amdgcn_s_barrier(); asm volatile("" ::: "memory");
        if (lane < 32) { const float* slot = xbuf + (size_t)(u.pm * BM + row) * 4; float tot = 0.f;
#pragma unroll
            for (int t = 0; t < 4; ++t) tot += __hip_atomic_load(slot + t, __ATOMIC_RELAXED, __HIP_MEMORY_SCOPE_AGENT);
            S[row] = __builtin_amdgcn_rsqf(tot * (1.f / 1024.f) + EPS); }
        asm volatile("s_waitcnt lgkmcnt(0)" ::: "memory"); __builtin_amdgcn_s_barrier(); asm volatile("" ::: "memory");
    }
};
template <bool FINAL> struct EpiResNorm {
    static constexpr bool PERM = false, AFTER_DRAIN = true;
    const float* base; float* out; bf16_t* xn; float wt; const float* gpost; const float* gnext; PanelSumSq st1, st2;
    __device__ __forceinline__ void operator()(const Acc&, const Unit&, int, int, int, int) const {}
    __device__ __forceinline__ void fused(Acc& acc, const Unit& u, int wr, int wc, int fr, int fq, LAS unsigned char* lds, int wid, int lane) const {
        const LAS float* S = (const LAS float*)(lds + 4096);
        const int col0 = u.pn * BM + wc * 32 + 4 * fq;
        st1.run(acc, u, wr, wc, fr, fq, lds, wid, lane);
#pragma unroll
        for (int ai = 0; ai < 2; ++ai)
#pragma unroll
            for (int m = 0; m < 4; ++m) { const int r = ai * HALF + wr * 64 + m * 16 + fr; const float sr = S[r] * wt; const size_t off = (size_t)(u.pm * BM + r) * 1024 + col0;
#pragma unroll
                for (int bj = 0; bj < 2; ++bj)
#pragma unroll
                    for (int n = 0; n < 2; ++n) { const f32x4 bs = *(const f32x4*)(base + off + bj * HALF + n * 16); const f32x4 g = *(const f32x4*)(gpost + col0 + bj * HALF + n * 16);
                        acc[ai][bj][m][n] = bs + acc[ai][bj][m][n] * g * sr; }
                asm volatile("" : "+v"(acc[ai][0][m][0]), "+v"(acc[ai][0][m][1]), "+v"(acc[ai][1][m][0]), "+v"(acc[ai][1][m][1]));
                if (m & 1) asm volatile("" ::: "memory"); }
        st2.run(acc, u, wr, wc, fr, fq, lds, wid, lane);
#pragma unroll
        for (int ai = 0; ai < 2; ++ai)
#pragma unroll
            for (int m = 0; m < 4; ++m) { const int r = ai * HALF + wr * 64 + m * 16 + fr; const float sr = S[r]; const size_t off = (size_t)(u.pm * BM + r) * 1024 + col0;
#pragma unroll
                for (int bj = 0; bj < 2; ++bj)
#pragma unroll
                    for (int n = 0; n < 2; ++n) { const f32x4 x1 = acc[ai][bj][m][n]; const f32x4 g = *(const f32x4*)(gnext + col0 + bj * HALF + n * 16); const f32x4 o = x1 * g * sr;
                        if (FINAL) *(f32x4*)(out + off + bj * HALF + n * 16) = o;
                        else { *(f32x4*)(out + off + bj * HALF + n * 16) = x1; u32x2 w; w.x = cvt_pk_bf16(o[0], o[1]); w.y = cvt_pk_bf16(o[2], o[3]); *(u32x2*)(xn + off + bj * HALF + n * 16) = w; } }
                asm volatile("" ::: "memory"); }
    }
};
}

namespace att {
constexpr int NW = 8, QBLK = 32, KVBLK = 64;
constexpr float SCALE = 0.07216878364870322f;
constexpr float THR = 8.f;
constexpr int LDQ = 1536, LDKV = 2048, LDKR = 64, LDO = 1024;
constexpr int SHM_V = 64 * 128 * 2, SHM_K = 64 * 128 * 2, SHM_R = 64 * 64 * 2;
constexpr int NQL = 4;
constexpr int OFF_V = 0, OFF_K = 2 * SHM_V, OFF_RP = OFF_K + 2 * SHM_K, OFF_WS = OFF_RP + 2 * SHM_R, OFF_QL = OFF_WS + NW * 64 * 4, SHM_ATTN = OFF_QL + NW * NQL * 1024;
static_assert(SHM_ATTN <= LDS_STAGE, "lds");
#define KSWZ(row, colB) ((row) * 256 + ((colB) ^ (((row) & 7) << 4)))
#define RSWZ(row, colB) ((row) * 128 + ((colB) ^ (((row) & 7) << 4)))
#define SBAR() __builtin_amdgcn_sched_barrier(0)
__device__ __forceinline__ int crow(int r, int hi) { return (r & 3) + 8 * (r >> 2) + 4 * hi; }
__device__ __forceinline__ bf16x8 ld8(const bf16_t* p) { return *reinterpret_cast<const bf16x8*>(p); }

__device__ __forceinline__ void partialSM(f32x16& p0, f32x16& p1, float& m_reg, float& mn, float& alpha) {
    constexpr float C = SCALE * 1.4426950408889634f;
    float pmax = p0[0];
#pragma unroll
    for (int r = 1; r < 16; ++r) pmax = fmaxf(pmax, p0[r]);
#pragma unroll
    for (int r = 0; r < 16; ++r) pmax = fmaxf(pmax, p1[r]);
    { auto rr = __builtin_amdgcn_permlane32_swap(__float_as_uint(pmax), __float_as_uint(pmax), false, false);
      pmax = fmaxf(__uint_as_float(rr[0]), __uint_as_float(rr[1])); }
    if (__builtin_expect(__all(pmax - m_reg <= THR / SCALE), 1)) { mn = m_reg; alpha = 1.f; }
    else { mn = fmaxf(m_reg, pmax); alpha = __builtin_amdgcn_exp2f((m_reg - mn) * C); m_reg = mn; }
    float mnC = -mn * C;
#pragma unroll
    for (int r = 0; r < 16; ++r) p0[r] = fmaf(p0[r], C, mnC);
#pragma unroll
    for (int r = 0; r < 16; ++r) p1[r] = fmaf(p1[r], C, mnC);
#pragma unroll
    for (int r = 0; r < 16; ++r) p0[r] = __builtin_amdgcn_exp2f(p0[r]);
}
__device__ __forceinline__ void finishSM(f32x16& p0, f32x16& p1, float alpha, float& l_reg, bf16x8& pa0, bf16x8& pa1, bf16x8& pa2, bf16x8& pa3) {
#pragma unroll
    for (int r = 0; r < 16; ++r) p1[r] = __builtin_amdgcn_exp2f(p1[r]);
    float ps = 0;
#pragma unroll
    for (int r = 0; r < 16; ++r) ps += p0[r];
#pragma unroll
    for (int r = 0; r < 16; ++r) ps += p1[r];
    { auto rr = __builtin_amdgcn_permlane32_swap(__float_as_uint(ps), __float_as_uint(ps), false, false);
      ps = __uint_as_float(rr[0]) + __uint_as_float(rr[1]); }
    l_reg = l_reg * alpha + ps;
#define PK4(P, BASE, OUT) do { unsigned a0 = cvt_pk_bf16(P[BASE + 0], P[BASE + 1]), a1 = cvt_pk_bf16(P[BASE + 2], P[BASE + 3]);   \
    unsigned b0 = cvt_pk_bf16(P[BASE + 4], P[BASE + 5]), b1 = cvt_pk_bf16(P[BASE + 6], P[BASE + 7]);                              \
    auto r0 = __builtin_amdgcn_permlane32_swap(a0, b0, false, false); auto r1 = __builtin_amdgcn_permlane32_swap(a1, b1, false, false); \
    u32x4 w = {r0[0], r1[0], r0[1], r1[1]}; OUT = *reinterpret_cast<bf16x8*>(&w); } while (0)
    PK4(p0, 0, pa0); PK4(p0, 8, pa1); PK4(p1, 0, pa2); PK4(p1, 8, pa3);
#undef PK4
}
__device__ __forceinline__ void qkt(f32x16& p0, f32x16& p1, const char* Ks, const char* Rs, const bf16x8* qr, const char* ql, int r32, int hi) {
    p0 = f32x16{}; p1 = f32x16{};
#pragma unroll
    for (int d0 = 0; d0 < 8; ++d0) { int cb = (d0 * 16 + hi * 8) * 2;
        bf16x8 b0 = *reinterpret_cast<const bf16x8*>(Ks + KSWZ(r32, cb));
        bf16x8 b1 = *reinterpret_cast<const bf16x8*>(Ks + KSWZ(32 + r32, cb));
        p0 = __builtin_amdgcn_mfma_f32_32x32x16_bf16(b0, qr[d0], p0, 0, 0, 0);
        p1 = __builtin_amdgcn_mfma_f32_32x32x16_bf16(b1, qr[d0], p1, 0, 0, 0); }
#pragma unroll
    for (int d0 = 0; d0 < 4; ++d0) { int cb = (d0 * 16 + hi * 8) * 2;
        bf16x8 b0 = *reinterpret_cast<const bf16x8*>(Rs + RSWZ(r32, cb));
        bf16x8 b1 = *reinterpret_cast<const bf16x8*>(Rs + RSWZ(32 + r32, cb));
        const bf16x8 qv = *reinterpret_cast<const bf16x8*>(ql + d0 * 1024);
        p0 = __builtin_amdgcn_mfma_f32_32x32x16_bf16(b0, qv, p0, 0, 0, 0);
        p1 = __builtin_amdgcn_mfma_f32_32x32x16_bf16(b1, qv, p1, 0, 0, 0); }
}
__device__ __forceinline__ int v_st(int k, int c) { const int kk = (k & ~0xC) | ((k & 4) << 1) | ((k & 8) >> 1); return ((kk >> 3) * 4 + (c >> 5)) * 512 + ((kk & 7) * 32 + (c & 31)) * 2; }
__device__ __forceinline__ int v_rd_base(int lane) { return ((lane & 3) << 3) | (((lane >> 2) & 3) << 6) | (((lane >> 4) & 1) << 5) | (((lane >> 5) & 1) << 8); }
constexpr int v_rd_off(int d0, int ks, int half) { return d0 * 512 + ks * 4096 + half * 2048; }
template <int OFF> __device__ __forceinline__ s16x4 tr_read(int vb) {
    s16x4 r; asm volatile("ds_read_b64_tr_b16 %0, %1 offset:%2" : "=&v"(r) : "v"(vb), "i"(OFF) : "memory"); return r;
}
template <int D0> __device__ __forceinline__ void pv_one(f32x16& od, int vb, bf16x8 pa0, bf16x8 pa1, bf16x8 pa2, bf16x8 pa3) {
    const s16x4 l0 = tr_read<v_rd_off(D0, 0, 0)>(vb), h0 = tr_read<v_rd_off(D0, 0, 1)>(vb), l1 = tr_read<v_rd_off(D0, 1, 0)>(vb), h1 = tr_read<v_rd_off(D0, 1, 1)>(vb);
    const s16x4 l2 = tr_read<v_rd_off(D0, 2, 0)>(vb), h2 = tr_read<v_rd_off(D0, 2, 1)>(vb), l3 = tr_read<v_rd_off(D0, 3, 0)>(vb), h3 = tr_read<v_rd_off(D0, 3, 1)>(vb);
    asm volatile("s_waitcnt lgkmcnt(0)" ::: "memory"); SBAR();
#define PK(L, H) (bf16x8){L[0], L[1], L[2], L[3], H[0], H[1], H[2], H[3]}
    od = __builtin_amdgcn_mfma_f32_32x32x16_bf16(pa0, PK(l0, h0), od, 0, 0, 0);
    od = __builtin_amdgcn_mfma_f32_32x32x16_bf16(pa1, PK(l1, h1), od, 0, 0, 0);
    od = __builtin_amdgcn_mfma_f32_32x32x16_bf16(pa2, PK(l2, h2), od, 0, 0, 0);
    od = __builtin_amdgcn_mfma_f32_32x32x16_bf16(pa3, PK(l3, h3), od, 0, 0, 0);
#undef PK
}
__device__ __forceinline__ void pv_d0(f32x16* o, int vb, bf16x8 pa0, bf16x8 pa1, bf16x8 pa2, bf16x8 pa3) {
    pv_one<0>(o[0], vb, pa0, pa1, pa2, pa3); pv_one<1>(o[1], vb, pa0, pa1, pa2, pa3); pv_one<2>(o[2], vb, pa0, pa1, pa2, pa3); pv_one<3>(o[3], vb, pa0, pa1, pa2, pa3);
}

__device__ __forceinline__ void attn_body(const bf16_t* __restrict__ Qb, const bf16_t* __restrict__ Kn, const bf16_t* __restrict__ Kr, const bf16_t* __restrict__ Vh,
                                          bf16_t* __restrict__ Ob, int seq, char* lds) {
    const int tid = fresh_tid(), wid = tid >> 6, lane = tid & 63, r32 = lane & 31, hi = lane >> 5;
    char* V_lds = lds + OFF_V; char* K_lds = lds + OFF_K; char* R_lds = lds + OFF_RP;
    float* ws = (float*)(lds + OFF_WS) + wid * 64; float* li_l = ws; float* al_l = ws + 32;
    float m_reg = -1e30f, l_reg = 0; f32x16 o[4] = {}; bf16x8 qr[8];
    char* ql = lds + OFF_QL + wid * (NQL * 1024) + lane * 16;
    const bf16_t* Qw = Qb + (long)(wid * QBLK + r32) * LDQ + hi * 8;
#pragma unroll
    for (int d0 = 0; d0 < 8; ++d0) qr[d0] = ld8(Qw + d0 * 16);
#pragma unroll
    for (int d0 = 0; d0 < NQL; ++d0) *reinterpret_cast<bf16x8*>(ql + d0 * 1024) = ld8(Qw + (8 + d0) * 16);
    const int sr = tid >> 4, sc = (tid & 15) * 8, vst0 = v_st(sr, sc), vst1 = v_st(32 + sr, sc);
    const int rr_ = tid >> 3, rc_ = (tid & 7) * 8;
    const int vb0 = (int)(uintptr_t)V_lds + v_rd_base(lane);
    bf16x8 vs0, vs1, ks0, ks1, rs0;
#define SLOAD(k0) do { vs0 = ld8(&Vh[(long)((k0) + sr) * LDKV + sc]); vs1 = ld8(&Vh[(long)((k0) + 32 + sr) * LDKV + sc]); \
    ks0 = ld8(&Kn[(long)((k0) + sr) * LDKV + sc]); ks1 = ld8(&Kn[(long)((k0) + 32 + sr) * LDKV + sc]); rs0 = ld8(&Kr[(long)((k0) + rr_) * LDKR + rc_]); } while (0)
#define SWRITE(b) do { *(bf16x8*)(V_lds + (b) * SHM_V + vst0) = vs0; *(bf16x8*)(V_lds + (b) * SHM_V + vst1) = vs1; int kc = sc * 2; \
    *(bf16x8*)(K_lds + (b) * SHM_K + KSWZ(sr, kc)) = ks0; *(bf16x8*)(K_lds + (b) * SHM_K + KSWZ(32 + sr, kc)) = ks1; \
    *(bf16x8*)(R_lds + (b) * SHM_R + RSWZ(rr_, rc_ * 2)) = rs0; } while (0)
#define RESC(a) do { if (__any((a) < 1.f)) { if (hi == 0) al_l[r32] = (a); asm volatile("s_waitcnt lgkmcnt(0)" ::: "memory"); \
    _Pragma("unroll") for (int d = 0; d < 4; ++d) _Pragma("unroll") for (int r = 0; r < 16; ++r) o[d][r] *= al_l[crow(r, hi)]; } } while (0)
    f32x16 pA0, pA1, pB0, pB1; float mnA, mnB, alA, alB; bf16x8 pa0, pa1, pa2, pa3; const int NT = seq / KVBLK;
    SLOAD(0); asm volatile("s_waitcnt vmcnt(0)" ::: "memory"); SWRITE(0); __syncthreads();
    qkt(pA0, pA1, K_lds, R_lds, qr, ql, r32, hi); partialSM(pA0, pA1, m_reg, mnA, alA);
    SLOAD(KVBLK);
    asm volatile("s_waitcnt vmcnt(0)" ::: "memory"); SWRITE(1); __syncthreads();
    for (int j = 1; j + 1 < NT; j += 2) {
        SBAR(); qkt(pB0, pB1, K_lds + SHM_K, R_lds + SHM_R, qr, ql, r32, hi);
        finishSM(pA0, pA1, alA, l_reg, pa0, pa1, pa2, pa3); SBAR();
        SLOAD((j + 1) * KVBLK); SBAR();
        pv_d0(o, vb0, pa0, pa1, pa2, pa3); partialSM(pB0, pB1, m_reg, mnB, alB);
        __syncthreads(); asm volatile("s_waitcnt vmcnt(0)" ::: "memory"); SWRITE(0);
        RESC(alB); __syncthreads();
        SBAR(); qkt(pA0, pA1, K_lds, R_lds, qr, ql, r32, hi);
        finishSM(pB0, pB1, alB, l_reg, pa0, pa1, pa2, pa3); SBAR();
        SLOAD((j + 2) * KVBLK); SBAR();
        pv_d0(o, vb0 + SHM_V, pa0, pa1, pa2, pa3); partialSM(pA0, pA1, m_reg, mnA, alA);
        __syncthreads(); asm volatile("s_waitcnt vmcnt(0)" ::: "memory"); SWRITE(1);
        RESC(alA); __syncthreads();
    }
    SBAR(); qkt(pB0, pB1, K_lds + SHM_K, R_lds + SHM_R, qr, ql, r32, hi);
    finishSM(pA0, pA1, alA, l_reg, pa0, pa1, pa2, pa3); SBAR();
    pv_d0(o, vb0, pa0, pa1, pa2, pa3); partialSM(pB0, pB1, m_reg, mnB, alB);
    __syncthreads(); RESC(alB);
    finishSM(pB0, pB1, alB, l_reg, pa0, pa1, pa2, pa3); SBAR();
    pv_d0(o, vb0 + SHM_V, pa0, pa1, pa2, pa3);
    if (hi == 0) li_l[r32] = l_reg; asm volatile("s_waitcnt lgkmcnt(0)" ::: "memory");
    float rli[16];
#pragma unroll
    for (int r = 0; r < 16; ++r) rli[r] = __builtin_amdgcn_rcpf(li_l[crow(r, hi)]);
    bf16_t* Ow = Ob + (long)(wid * QBLK) * LDO;
#pragma unroll
    for (int r = 0; r < 16; ++r) { int orow = crow(r, hi);
#pragma unroll
        for (int d0 = 0; d0 < 4; ++d0) { const float v = o[d0][r] * rli[r]; Ow[(long)orow * LDO + d0 * 32 + r32] = (bf16_t)(cvt_pk_bf16(v, v) & 0xffffu); } }
#undef SLOAD
#undef SWRITE
#undef RESC
}
}


#define XB_TMO      128
#define XB_XCNT(j)  (256  + 64 * (j))
#define XB_XSUB(j)  (1280 + 64 * (j))
#define XB_XGEN(j)  (2304 + 64 * (j))
#define XB_TOP      3328
#define XB_TOPGEN   3392
#define XCD_BAR_WORDS 3456
#define XB_SPIN_CAP (1u << 18)
__device__ __forceinline__ unsigned xb_ld(unsigned* p)              { return __hip_atomic_load(p, __ATOMIC_RELAXED, __HIP_MEMORY_SCOPE_AGENT); }
__device__ __forceinline__ unsigned xb_add(unsigned* p, unsigned v) { return __hip_atomic_fetch_add(p, v, __ATOMIC_RELAXED, __HIP_MEMORY_SCOPE_AGENT); }
__device__ __forceinline__ unsigned xb_xcc_id() { return (unsigned)__builtin_amdgcn_s_getreg((3 << 11) | 20) & 0xFu; }
#define XB_SPIN(cond, bar) do { unsigned _sp = 0; while (cond) { __builtin_amdgcn_s_sleep(1); \
    if ((++_sp & 255u) == 0u) { if (xb_ld(&(bar)[XB_TMO])) break; if (_sp > XB_SPIN_CAP) { atomicAdd(&(bar)[XB_TMO], 1u); break; } } } } while (0)
struct XcdBarrier { unsigned* bar; unsigned x; volatile LAS unsigned* st; };
__device__ __forceinline__ XcdBarrier xcd_barrier_post(unsigned* bar, volatile LAS unsigned* st) {
    XcdBarrier b; b.bar = bar; b.x = xb_xcc_id(); b.st = st;
    if (threadIdx.x == 0) (void)xb_add(&bar[XB_XCNT(b.x)], 1u);
    return b;
}
__device__ __forceinline__ void xcd_barrier_complete(unsigned* bar, unsigned x, unsigned& nloc, unsigned& nx) {
    const unsigned G = gridDim.x * gridDim.y * gridDim.z;
    unsigned sum, cnt, mine, sp = 0u;
    for (;;) {
        sum = 0u; cnt = 0u; mine = 0u;
#pragma unroll
        for (unsigned j = 0; j < 16; ++j) { const unsigned c = xb_ld(&bar[XB_XCNT(j)]); sum += c; cnt += (c > 0u) ? 1u : 0u; mine = (j == x) ? c : mine; }
        if (sum == G) break;
        __builtin_amdgcn_s_sleep(1);
        if ((++sp & 255u) == 0u) { if (xb_ld(&bar[XB_TMO])) break; if (sp > XB_SPIN_CAP) { atomicAdd(&bar[XB_TMO], 1u); break; } }
    }
    nloc = mine > 0u ? mine : 1u; nx = cnt > 0u ? cnt : 1u;
}
__device__ __forceinline__ void xcd_barrier(const XcdBarrier& b) {
    asm volatile("s_waitcnt vmcnt(0)" ::: "memory");
    __syncthreads();
    if (threadIdx.x == 0) {
        unsigned* bar = b.bar;
        __builtin_amdgcn_s_waitcnt(0);
        unsigned nloc = b.st[0], nx = b.st[1];
        if (nloc == 0u) { xcd_barrier_complete(bar, b.x, nloc, nx); b.st[0] = nloc; b.st[1] = nx; }
        const unsigned old = xb_add(&bar[XB_XSUB(b.x)], 1u);
        const unsigned gen = old / nloc;
        if (old + 1u == (gen + 1u) * nloc) {
            __builtin_amdgcn_fence(__ATOMIC_RELEASE, "agent");
            asm volatile("s_waitcnt vmcnt(0)" ::: "memory");
            const unsigned og = xb_add(&bar[XB_TOP], 1u);
            const unsigned tg = og / nx;
            if (og + 1u == (tg + 1u) * nx) xb_add(&bar[XB_TOPGEN], 1u);
            else XB_SPIN(xb_ld(&bar[XB_TOPGEN]) == tg, bar);
            __builtin_amdgcn_fence(__ATOMIC_ACQUIRE, "agent");
            xb_add(&bar[XB_XGEN(b.x)], 1u);
            asm volatile("s_waitcnt vmcnt(0)" ::: "memory");
        } else {
            XB_SPIN(xb_ld(&bar[XB_XGEN(b.x)]) == gen, bar);
            __builtin_amdgcn_fence(__ATOMIC_ACQUIRE, "agent");
            asm volatile("s_waitcnt vmcnt(0)" ::: "memory");
        }
    }
    __syncthreads();
}

enum { TR_PLAIN = 0, TR_GU = 1, TR_WIN = 2, TR_UQ = 3, TR_UKV = 4 };
template <int MODE>
__device__ __forceinline__ void tr_job(const float* W0, const float* W1, int K, int Nsrc, int Nout, bf16_t* WT, LAS float* scr, int lane, int gw, int NGW) {
    const int nblk = Nout / 32, nitems = (K / 64) * nblk;
    for (int it = gw; it < nitems; it += NGW) {
        const int kb = it / nblk, nb = it % nblk, k0 = 64 * kb, n0 = 32 * nb, np = n0 + (lane & 31);
        const float* colp;
        if (MODE == TR_PLAIN) colp = W0 + np;
        else if (MODE == TR_GU) { const int t = np >> 8, w = np & 255; colp = (w < 128 ? W0 : W1) + t * 128 + (w & 127); }
        else if (MODE == TR_WIN) colp = np < 1216 ? W0 + np : (np < 1280 ? nullptr : W0 + (np - 64));
        else if (MODE == TR_UQ) { const int h = np / 192, w = np % 192; colp = W0 + (w < 128 ? np : h * 192 + 128 + ((w - 128) >> 1) + ((w - 128) & 1) * 32); }
        else colp = np < 1024 ? W0 + np : W1 + (np - 1024);
        float tv[32];
#pragma unroll
        for (int i = 0; i < 32; ++i) { const int kk = 2 * i + (lane >> 5); tv[i] = colp ? colp[(size_t)(k0 + kk) * Nsrc] : 0.f; }
#pragma unroll
        for (int i = 0; i < 32; ++i) { const int kk = 2 * i + (lane >> 5); scr[kk * 33 + (lane & 31)] = tv[i]; }
        asm volatile("s_waitcnt lgkmcnt(0)" ::: "memory");
        const int c = lane & 7;
#pragma unroll
        for (int j = 0; j < 4; ++j) { const int n = (lane >> 3) + 8 * j; const LAS float* s = scr + (8 * c) * 33 + n;
            u32x4 o; o.x = cvt_pk_bf16(s[0 * 33], s[1 * 33]); o.y = cvt_pk_bf16(s[2 * 33], s[3 * 33]); o.z = cvt_pk_bf16(s[4 * 33], s[5 * 33]); o.w = cvt_pk_bf16(s[6 * 33], s[7 * 33]);
            *(u32x4*)(WT + (size_t)(n0 + n) * K + k0 + 8 * c) = o; }
        asm volatile("s_waitcnt lgkmcnt(0)" ::: "memory");
    }
}

template <int MODE>
__device__ __forceinline__ void rows_phase(const float* xin, const bf16_t* f, float wt, const float* gpost, const float* gnext, float* xout, bf16_t* xn, int gw, int NGW, int lane) {
    for (int row0 = gw; row0 < M; row0 += 2 * NGW) {
        f32x4 xv[2][4]; u32x2 fw[2][4];
#pragma unroll
        for (int r = 0; r < 2; ++r) { const size_t row = (size_t)(row0 + r * NGW);
#pragma unroll
            for (int j = 0; j < 4; ++j) { xv[r][j] = *(const f32x4*)(xin + row * DM + 4 * (lane + 64 * j));
                if (MODE != 0) fw[r][j] = *(const u32x2*)(f + row * DM + 4 * (lane + 64 * j)); } }
#pragma unroll
        for (int r = 0; r < 2; ++r) { const size_t row = (size_t)(row0 + r * NGW);
            if (MODE != 0) {
                f32x4 fv[4]; float ss = 0.f;
#pragma unroll
                for (int j = 0; j < 4; ++j) { fv[j] = (f32x4){bf_lo(fw[r][j].x), bf_hi(fw[r][j].x), bf_lo(fw[r][j].y), bf_hi(fw[r][j].y)}; ss += fv[j].x * fv[j].x + fv[j].y * fv[j].y + fv[j].z * fv[j].z + fv[j].w * fv[j].w; }
                const float rr = wt * __builtin_amdgcn_rsqf(wave_sum(ss) * (1.f / DM) + EPS);
#pragma unroll
                for (int j = 0; j < 4; ++j) { const f32x4 g = *(const f32x4*)(gpost + 4 * (lane + 64 * j)); xv[r][j] = xv[r][j] + fv[j] * g * rr; }
                if (MODE == 1) {
#pragma unroll
                    for (int j = 0; j < 4; ++j) *(f32x4*)(xout + row * DM + 4 * (lane + 64 * j)) = xv[r][j];
                }
            }
            float s2 = 0.f;
#pragma unroll
            for (int j = 0; j < 4; ++j) s2 += xv[r][j].x * xv[r][j].x + xv[r][j].y * xv[r][j].y + xv[r][j].z * xv[r][j].z + xv[r][j].w * xv[r][j].w;
            const float r2 = __builtin_amdgcn_rsqf(wave_sum(s2) * (1.f / DM) + EPS);
#pragma unroll
            for (int j = 0; j < 4; ++j) { const f32x4 g = *(const f32x4*)(gnext + 4 * (lane + 64 * j)); const f32x4 y = xv[r][j] * g * r2;
                if (MODE == 2) *(f32x4*)(xout + row * DM + 4 * (lane + 64 * j)) = y;
                else { u32x2 w; w.x = cvt_pk_bf16(y.x, y.y); w.y = cvt_pk_bf16(y.z, y.w); *(u32x2*)(xn + row * DM + 4 * (lane + 64 * j)) = w; } }
        }
    }
}

__global__ void __launch_bounds__(NTHREADS, 2) fwd_megakernel(Params p) {
    extern __shared__ __attribute__((aligned(16))) unsigned char lds[];
    cg::grid_group grid = cg::this_grid();
    volatile LAS unsigned* bst = (volatile LAS unsigned*)((LAS unsigned char*)lds + LDS_STAGE);
    if (threadIdx.x < 2) bst[threadIdx.x] = 0u;
    __syncthreads();
    const XcdBarrier xbar = xcd_barrier_post((unsigned*)(p.ws + OFF_BAR), bst);
#define GRID_SYNC_CG() do { __builtin_amdgcn_fence(__ATOMIC_RELEASE, "agent"); asm volatile("s_waitcnt vmcnt(0)" ::: "memory"); grid.sync(); \
        __builtin_amdgcn_fence(__ATOMIC_ACQUIRE, "agent"); asm volatile("s_waitcnt vmcnt(0)" ::: "memory"); } while (0)
#define GRID_SYNC() xcd_barrier(xbar)
    const int G = gridDim.x, bid = blockIdx.x, NGW = G * NWAVES;
    LAS unsigned char* ldsl = (LAS unsigned char*)lds;
#define PHASE_IDS() const int tid = fresh_tid(), lane = tid & 63, wave = tid >> 6, gw = bid * NWAVES + wave; LAS float* scr = (LAS float*)(ldsl + wave * 8448); (void)scr; (void)gw; (void)lane
    unsigned char* ws = p.ws;
    bf16_t* Wgu = (bf16_t*)(ws + OFF_WGU); bf16_t* Wd = (bf16_t*)(ws + OFF_WD); bf16_t* Win = (bf16_t*)(ws + OFF_WIN); bf16_t* Wuq = (bf16_t*)(ws + OFF_WUQ);
    bf16_t* Wukv = (bf16_t*)(ws + OFF_WUKV); bf16_t* Woa = (bf16_t*)(ws + OFF_WOA); bf16_t* Wp = (bf16_t*)(ws + OFF_WP); bf16_t* Wout = (bf16_t*)(ws + OFF_WOUT);
    bf16_t* XN = (bf16_t*)(ws + OFF_XN); bf16_t* F = (bf16_t*)(ws + OFF_F); float* ZF = (float*)(ws + OFF_ZF); bf16_t* KV = (bf16_t*)(ws + OFF_KV);
    bf16_t* H = (bf16_t*)(ws + OFF_H); bf16_t* O = (bf16_t*)(ws + OFF_O); bf16_t* CQN = (bf16_t*)(ws + OFF_CQN); bf16_t* CKVN = (bf16_t*)(ws + OFF_CKVN);
    float* TAB = (float*)(ws + OFF_TAB); bf16_t* Q = (bf16_t*)(ws + OFF_Q); bf16_t* KR = (bf16_t*)(ws + OFF_KR); bf16_t* Gt = (bf16_t*)(ws + OFF_G); bf16_t* DP = (bf16_t*)(ws + OFF_DP);
    float* X = p.out;
    float* xbuf0 = (float*)(ws + OFF_XBUF); unsigned* cnt0 = (unsigned*)(ws + OFF_CNT);

    { PHASE_IDS();
    tr_job<TR_GU>(p.f1_wg, p.f1_wu, 1024, DFF, 5632, Wgu, scr, lane, gw, NGW);
    tr_job<TR_PLAIN>(p.f1_wd, nullptr, DFF, 1024, 1024, Wd, scr, lane, gw, NGW);
    rows_phase<0>(p.x, nullptr, 0.f, nullptr, p.f1_pre, nullptr, XN, gw, NGW, lane); }
    GRID_SYNC_CG();

    pg8::StaticOrder S;
    { pg8::Gemm g{XN, Wgu, M, 5632, 1024}; S.init(M, 5632, G, bid); pg8::EpiSwiGLU E{H}; pg8::gemm_phase(ldsl, g, S, E); }
    {
        const int tail0 = (64 * 22) % G;
        if (tail0 != 0 && bid >= tail0) { PHASE_IDS(); const int tb = bid - tail0, nb = G - tail0, tgw = tb * NWAVES + wave, TNGW = nb * NWAVES;
            tr_job<TR_WIN>(p.w_in, nullptr, 1024, INW, 3328, Win, scr, lane, tgw, TNGW);
            tr_job<TR_UQ>(p.w_uq, nullptr, QL, 1536, 1536, Wuq, scr, lane, tgw, TNGW);
            tr_job<TR_UKV>(p.w_uk, p.w_uv, KVL, 1024, 2048, Wukv, scr, lane, tgw, TNGW);
            tr_job<TR_PLAIN>(p.w_oa, nullptr, 1024, 1024, 1024, Woa, scr, lane, tgw, TNGW);
            tr_job<TR_PLAIN>(p.w_out, nullptr, 1024, 1024, 1024, Wout, scr, lane, tgw, TNGW);
    for (int idx = tb * NTHREADS + tid; idx < 65536; idx += nb * NTHREADS) {
            const int n = idx & 1023, c8 = idx >> 10, g = c8 >> 4, cb = (c8 & 15) * 8;
            float a[8];
    #pragma unroll
            for (int i = 0; i < 8; ++i) a[i] = 0.f;
            for (int j0 = 0; j0 < 128; j0 += 8) { float w[8]; f32x4 pw[8][2];
    #pragma unroll
                for (int jj = 0; jj < 8; ++jj) w[jj] = p.w_op[(size_t)(g * 128 + j0 + jj) * 1024 + n] * p.pool_scale[g * 128 + j0 + jj];
    #pragma unroll
                for (int i = 0; i < 8; ++i) { pw[i][0] = *(const f32x4*)(p.pool_w + (size_t)(g * 128 + cb + i) * 128 + j0); pw[i][1] = *(const f32x4*)(p.pool_w + (size_t)(g * 128 + cb + i) * 128 + j0 + 4); }
    #pragma unroll
                for (int i = 0; i < 8; ++i)
    #pragma unroll
                    for (int jj = 0; jj < 8; ++jj) a[i] = fmaf(pw[i][jj >> 2][jj & 3], w[jj], a[i]); }
            u32x4 o; o.x = cvt_pk_bf16(a[0], a[1]); o.y = cvt_pk_bf16(a[2], a[3]); o.z = cvt_pk_bf16(a[4], a[5]); o.w = cvt_pk_bf16(a[6], a[7]);
            *(u32x4*)(Wp + (size_t)n * 512 + c8 * 8) = o;
        }
        }
        else if (tail0 == 0) { PHASE_IDS(); const int tb = bid, nb = G;
            tr_job<TR_WIN>(p.w_in, nullptr, 1024, INW, 3328, Win, scr, lane, gw, NGW);
            tr_job<TR_UQ>(p.w_uq, nullptr, QL, 1536, 1536, Wuq, scr, lane, gw, NGW);
            tr_job<TR_UKV>(p.w_uk, p.w_uv, KVL, 1024, 2048, Wukv, scr, lane, gw, NGW);
            tr_job<TR_PLAIN>(p.w_oa, nullptr, 1024, 1024, 1024, Woa, scr, lane, gw, NGW);
            tr_job<TR_PLAIN>(p.w_out, nullptr, 1024, 1024, 1024, Wout, scr, lane, gw, NGW);
    for (int idx = tb * NTHREADS + tid; idx < 65536; idx += nb * NTHREADS) {
            const int n = idx & 1023, c8 = idx >> 10, g = c8 >> 4, cb = (c8 & 15) * 8;
            float a[8];
    #pragma unroll
            for (int i = 0; i < 8; ++i) a[i] = 0.f;
            for (int j0 = 0; j0 < 128; j0 += 8) { float w[8]; f32x4 pw[8][2];
    #pragma unroll
                for (int jj = 0; jj < 8; ++jj) w[jj] = p.w_op[(size_t)(g * 128 + j0 + jj) * 1024 + n] * p.pool_scale[g * 128 + j0 + jj];
    #pragma unroll
                for (int i = 0; i < 8; ++i) { pw[i][0] = *(const f32x4*)(p.pool_w + (size_t)(g * 128 + cb + i) * 128 + j0); pw[i][1] = *(const f32x4*)(p.pool_w + (size_t)(g * 128 + cb + i) * 128 + j0 + 4); }
    #pragma unroll
                for (int i = 0; i < 8; ++i)
    #pragma unroll
                    for (int jj = 0; jj < 8; ++jj) a[i] = fmaf(pw[i][jj >> 2][jj & 3], w[jj], a[i]); }
            u32x4 o; o.x = cvt_pk_bf16(a[0], a[1]); o.y = cvt_pk_bf16(a[2], a[3]); o.z = cvt_pk_bf16(a[4], a[5]); o.w = cvt_pk_bf16(a[6], a[7]);
            *(u32x4*)(Wp + (size_t)n * 512 + c8 * 8) = o;
        }
        }
    }
    GRID_SYNC();
    { pg8::Gemm g{H, Wd, M, 1024, DFF}; S.init(M, 1024, G, bid);
      pg8::EpiResNorm<false> E{p.x, X, XN, 0.5f, p.f1_post, p.mix_pre, pg8::PanelSumSq{xbuf0, cnt0}, pg8::PanelSumSq{xbuf0 + (size_t)M * 4, cnt0 + 4096}}; pg8::gemm_phase(ldsl, g, S, E); }
    GRID_SYNC();
    { pg8::Gemm g{XN, Win, M, 1280, 1024}; S.init(M, 1280, G, bid); pg8::EpiBf16 E{(bf16_t*)ZF, 1280}; pg8::gemm_phase(ldsl, g, S, E); }
    {
        const int tail0 = (64 * 5) % G; PHASE_IDS();
        if (tail0 != 0 && bid >= tail0) { const int tgw = (bid - tail0) * NWAVES + wave, TNGW = (G - tail0) * NWAVES;
            tr_job<TR_GU>(p.f2_wg, p.f2_wu, 1024, DFF, 5632, Wgu, scr, lane, tgw, TNGW);
            tr_job<TR_PLAIN>(p.f2_wd, nullptr, DFF, 1024, 1024, Wd, scr, lane, tgw, TNGW); }
        else if (tail0 == 0) { tr_job<TR_GU>(p.f2_wg, p.f2_wu, 1024, DFF, 5632, Wgu, scr, lane, gw, NGW); tr_job<TR_PLAIN>(p.f2_wd, nullptr, DFF, 1024, 1024, Wd, scr, lane, gw, NGW); }
    }
    GRID_SYNC();
    { PHASE_IDS();
    const bf16_t* ZB = (const bf16_t*)ZF;
    const int t_g = lane >> 4, wnd = 2 << t_g;
    for (int k = 0; k < M / (NWAVES * 256); ++k) { const int row = gw * (M / (NWAVES * 256)) + k;
        const bf16_t* z = ZB + (size_t)row * 1280;
        const u32x4 qa = *(const u32x4*)(z + 8 * lane);
        u32x4 qb = (u32x4){0u, 0u, 0u, 0u}; if (lane < 16) qb = *(const u32x4*)(z + 512 + 8 * lane);
        const u32x4 pc = *(const u32x4*)(z + 704 + 8 * lane);
        float kx1 = 0.f, kx2 = 0.f; int pos = 0;
        if (lane < 32) { kx1 = bf_lo((unsigned)z[640 + lane]); kx2 = bf_lo((unsigned)z[672 + lane]); pos = p.pos[row]; }
        const int t = row & (SEQ - 1), lo = max(t - (wnd >> 1), 0), hi = min(t + wnd - (wnd >> 1), SEQ);
        float sacc[8];
#pragma unroll
        for (int i = 0; i < 8; ++i) sacc[i] = 0.f;
#pragma unroll
        for (int hb = 0; hb < 2; ++hb) { u32x4 nb[8]; float wv[8];
#pragma unroll
            for (int d = 0; d < 8; ++d) { const int tt = t - 8 + hb * 8 + d; const bool ok = (tt >= lo) && (tt < hi); wv[d] = ok ? 1.f : 0.f;
                nb[d] = *(const u32x4*)(z + 704 + 8 * lane + (long)(ok ? (tt - t) : 0) * 1280); }
#pragma unroll
            for (int d = 0; d < 8; ++d) { sacc[0] = fmaf(wv[d], bf_lo(nb[d].x), sacc[0]); sacc[1] = fmaf(wv[d], bf_hi(nb[d].x), sacc[1]); sacc[2] = fmaf(wv[d], bf_lo(nb[d].y), sacc[2]); sacc[3] = fmaf(wv[d], bf_hi(nb[d].y), sacc[3]);
                sacc[4] = fmaf(wv[d], bf_lo(nb[d].z), sacc[4]); sacc[5] = fmaf(wv[d], bf_hi(nb[d].z), sacc[5]); sacc[6] = fmaf(wv[d], bf_lo(nb[d].w), sacc[6]); sacc[7] = fmaf(wv[d], bf_hi(nb[d].w), sacc[7]); } }
        {
            const float inv = 1.f / (float)(hi - lo);
            u32x4 w; w.x = cvt_pk_bf16(sacc[0] * inv - bf_lo(pc.x), sacc[1] * inv - bf_hi(pc.x)); w.y = cvt_pk_bf16(sacc[2] * inv - bf_lo(pc.y), sacc[3] * inv - bf_hi(pc.y));
            w.z = cvt_pk_bf16(sacc[4] * inv - bf_lo(pc.z), sacc[5] * inv - bf_hi(pc.z)); w.w = cvt_pk_bf16(sacc[6] * inv - bf_lo(pc.w), sacc[7] * inv - bf_hi(pc.w));
            *(u32x4*)(DP + (size_t)row * 512 + 8 * lane) = w; }
        {
            float va[8] = {bf_lo(qa.x), bf_hi(qa.x), bf_lo(qa.y), bf_hi(qa.y), bf_lo(qa.z), bf_hi(qa.z), bf_lo(qa.w), bf_hi(qa.w)};
            float vb[8] = {bf_lo(qb.x), bf_hi(qb.x), bf_lo(qb.y), bf_hi(qb.y), bf_lo(qb.z), bf_hi(qb.z), bf_lo(qb.w), bf_hi(qb.w)};
            float sa = 0.f, sb = 0.f;
#pragma unroll
            for (int i = 0; i < 8; ++i) { sa = fmaf(va[i], va[i], sa); sb = fmaf(vb[i], vb[i], sb); }
            const float ssq = wave_sum(lane < 48 ? sa : 0.f), sskv = wave_sum((lane >= 48 ? sa : 0.f) + sb);
            const float rq = __builtin_amdgcn_rsqf(ssq * (1.f / QL) + EPS), rkv = __builtin_amdgcn_rsqf(sskv * (1.f / KVL) + EPS);
            const float* ga = lane < 48 ? p.qa_g + 8 * lane : p.kva_g + 8 * (lane - 48); const float ra = lane < 48 ? rq : rkv;
            const f32x4 g0 = *(const f32x4*)ga, g1 = *(const f32x4*)(ga + 4);
            u32x4 w; w.x = cvt_pk_bf16(va[0] * g0.x * ra, va[1] * g0.y * ra); w.y = cvt_pk_bf16(va[2] * g0.z * ra, va[3] * g0.w * ra); w.z = cvt_pk_bf16(va[4] * g1.x * ra, va[5] * g1.y * ra); w.w = cvt_pk_bf16(va[6] * g1.z * ra, va[7] * g1.w * ra);
            bf16_t* dst = lane < 48 ? CQN + (size_t)row * QL + 8 * lane : CKVN + (size_t)row * KVL + 8 * (lane - 48);
            *(u32x4*)dst = w;
            if (lane < 16) { const f32x4 h0 = *(const f32x4*)(p.kva_g + 128 + 8 * lane), h1 = *(const f32x4*)(p.kva_g + 132 + 8 * lane);
                u32x4 w2; w2.x = cvt_pk_bf16(vb[0] * h0.x * rkv, vb[1] * h0.y * rkv); w2.y = cvt_pk_bf16(vb[2] * h0.z * rkv, vb[3] * h0.w * rkv); w2.z = cvt_pk_bf16(vb[4] * h1.x * rkv, vb[5] * h1.y * rkv); w2.w = cvt_pk_bf16(vb[6] * h1.z * rkv, vb[7] * h1.w * rkv);
                *(u32x4*)(CKVN + (size_t)row * KVL + 128 + 8 * lane) = w2; }
        }
        if (lane < 32) {
            const float ang = (float)pos * p.inv_freq[lane];
            const double ad = (double)ang; const double kq = rint(ad * 0.15915494309189535); const float red = (float)(ad - kq * 6.283185307179586);
            const float cs = __cosf(red), sn = __sinf(red);
            TAB[(size_t)row * 64 + lane] = cs; TAB[(size_t)row * 64 + 32 + lane] = sn;
            *(unsigned*)(KR + (size_t)row * 64 + 2 * lane) = cvt_pk_bf16(kx1 * cs - kx2 * sn, kx2 * cs + kx1 * sn);
        }
    } }
    GRID_SYNC();
    { pg8::Gemm g{CQN, Wuq, M, 1536, QL}; S.init(M, 1536, G, bid); pg8::EpiQ E{Q, TAB}; pg8::gemm_phase(ldsl, g, S, E); }
    { pg8::Gemm g{CKVN, Wukv, M, 2048, KVL}; S.init(M, 2048, G, bid); pg8::EpiBf16 E{KV, 2048}; pg8::gemm_phase(ldsl, g, S, E); }
    GRID_SYNC();
    {
        const int vcu = (bid & 7) * (G >> 3) + (bid >> 3);
        for (int it = vcu; it < NB * NH * (SEQ / 256); it += G) {
            const int qb = it & 7, h = (it >> 3) & 7, b = it >> 6;
            const size_t tok0 = (size_t)b * SEQ;
            att::attn_body(Q + (tok0 + qb * 256) * 1536 + h * 192, KV + tok0 * 2048 + h * 128, KR + tok0 * 64, KV + tok0 * 2048 + 1024 + h * 128,
                           O + (tok0 + qb * 256) * 1024 + h * 128, SEQ, (char*)lds);
            __syncthreads();
        }
    }
    GRID_SYNC();
    { pg8::Gemm g{XN, Win + (size_t)1280 * 1024, M, 2048, 1024}; S.init(M, 2048, G, bid); pg8::EpiGate E{Gt}; pg8::gemm_phase(ldsl, g, S, E); }
    GRID_SYNC();
    { pg8::Gemm g{O, Woa, M, 1024, 1024}; S.init(M, 1024, G, bid); pg8::EpiT1 E{Gt, F}; pg8::gemm_phase(ldsl, g, S, E); }
    { pg8::Gemm g{DP, Wp, M, 1024, 512}; S.init(M, 1024, G, bid); pg8::EpiMX E{Gt, F, XN}; pg8::gemm_phase(ldsl, g, S, E); }
    GRID_SYNC();
    { pg8::Gemm g{XN, Wout, M, 1024, 1024}; S.init(M, 1024, G, bid);
      pg8::EpiResNorm<false> E{X, X, XN, 1.0f, p.mix_post, p.f2_pre, pg8::PanelSumSq{xbuf0 + (size_t)M * 8, cnt0 + 2 * 4096}, pg8::PanelSumSq{xbuf0 + (size_t)M * 12, cnt0 + 3 * 4096}}; pg8::gemm_phase(ldsl, g, S, E); }
    GRID_SYNC();
    { pg8::Gemm g{XN, Wgu, M, 5632, 1024}; S.init(M, 5632, G, bid); pg8::EpiSwiGLU E{H}; pg8::gemm_phase(ldsl, g, S, E); }
    GRID_SYNC();
    { pg8::Gemm g{H, Wd, M, 1024, DFF}; S.init(M, 1024, G, bid);
      pg8::EpiResNorm<true> E{X, X, nullptr, 0.5f, p.f2_post, p.final_g, pg8::PanelSumSq{xbuf0 + (size_t)M * 16, cnt0 + 4 * 4096}, pg8::PanelSumSq{xbuf0 + (size_t)M * 20, cnt0 + 5 * 4096}}; pg8::gemm_phase(ldsl, g, S, E); }
}

extern "C" void kernel_launch(void* const* d_in, const int* in_sizes, int n_in, void* d_out, int out_size, void* d_ws, size_t ws_size, hipStream_t stream) {
    static int grid_blocks = 0;
    if (grid_blocks == 0) {
        if (n_in != 26 || in_sizes[0] != M * DM || out_size != M * DM || ws_size < WS_END) { fprintf(stderr, "kernel_launch: shape mismatch n_in %d in0 %d out %d ws %zu\n", n_in, n_in > 0 ? in_sizes[0] : -1, out_size, ws_size); grid_blocks = -1; return; }
        int dev = 0, cus = 0, per_cu = 0;
        (void)hipGetDevice(&dev);
        (void)hipDeviceGetAttribute(&cus, hipDeviceAttributeMultiprocessorCount, dev);
        if (hipFuncSetAttribute((const void*)fwd_megakernel, hipFuncAttributeMaxDynamicSharedMemorySize, LDS_BYTES) != hipSuccess) { fprintf(stderr, "kernel_launch: hipFuncSetAttribute failed\n"); grid_blocks = -1; return; }
        if (hipOccupancyMaxActiveBlocksPerMultiprocessor(&per_cu, (const void*)fwd_megakernel, NTHREADS, LDS_BYTES) != hipSuccess || per_cu < 1) { fprintf(stderr, "kernel_launch: occupancy query failed (%d)\n", per_cu); (void)hipGetLastError(); per_cu = 1; }
        grid_blocks = cus * 1;
        if (grid_blocks != 256) { fprintf(stderr, "kernel_launch: built for 256 CUs (one workgroup each), device has %d\n", cus); grid_blocks = -1; return; }
    }
    if (grid_blocks < 0) return;
    Params p{};
    p.x = (const float*)d_in[0]; p.pos = (const int*)d_in[1];
    p.f1_pre = (const float*)d_in[2]; p.f1_wg = (const float*)d_in[3]; p.f1_wu = (const float*)d_in[4]; p.f1_wd = (const float*)d_in[5]; p.f1_post = (const float*)d_in[6];
    p.mix_pre = (const float*)d_in[7]; p.w_in = (const float*)d_in[8]; p.qa_g = (const float*)d_in[9]; p.w_uq = (const float*)d_in[10]; p.kva_g = (const float*)d_in[11];
    p.w_uk = (const float*)d_in[12]; p.w_uv = (const float*)d_in[13]; p.w_oa = (const float*)d_in[14]; p.pool_w = (const float*)d_in[15]; p.pool_scale = (const float*)d_in[16];
    p.w_op = (const float*)d_in[17]; p.w_out = (const float*)d_in[18]; p.mix_post = (const float*)d_in[19];
    p.f2_pre = (const float*)d_in[20]; p.f2_wg = (const float*)d_in[21]; p.f2_wu = (const float*)d_in[22]; p.f2_wd = (const float*)d_in[23]; p.f2_post = (const float*)d_in[24]; p.final_g = (const float*)d_in[25];
    p.out = (float*)d_out; p.ws = (unsigned char*)d_ws;
    for (int i = 0; i < 32; ++i) p.inv_freq[i] = (float)pow(10000.0, -(2.0 * i) / 64.0);
    if (hipMemsetAsync((char*)d_ws + OFF_BAR, 0, CTL_BYTES, stream) != hipSuccess) { fprintf(stderr, "kernel_launch: memset failed\n"); return; }
    void* args[] = {&p};
    hipError_t e = hipLaunchCooperativeKernel((const void*)fwd_megakernel, dim3(grid_blocks), dim3(NTHREADS), args, LDS_BYTES, stream);
    if (e != hipSuccess) fprintf(stderr, "cooperative launch failed: %s (grid %d)\n", hipGetErrorString(e), grid_blocks);
}
```

```cpp
#include <hip/hip_runtime.h>
#include <hip/hip_cooperative_groups.h>
#include <cstdio>
#include <cmath>
#include <cstdint>
namespace cg = cooperative_groups;

#define LAS __attribute__((address_space(3)))
typedef unsigned short bf16_t;
typedef short bf16x8 __attribute__((ext_vector_type(8)));
typedef short s16x4 __attribute__((ext_vector_type(4)));
typedef float f32x2 __attribute__((ext_vector_type(2)));
typedef float f32x4 __attribute__((ext_vector_type(4)));
typedef float f32x16 __attribute__((ext_vector_type(16)));
typedef unsigned u32x4 __attribute__((ext_vector_type(4)));
typedef unsigned u32x2 __attribute__((ext_vector_type(2)));

constexpr int DM = 1024, NB = 8, SEQ = 2048, M = NB * SEQ, NH = 8, QL = 384, KVL = 256, DFF = 2816, INW = 3264;
constexpr float EPS = 1e-6f;
constexpr int NTHREADS = 512, NWAVES = 8;
constexpr int LDS_STAGE = 131072, LDS_BYTES = LDS_STAGE + 16;

constexpr size_t MiB = 1048576;
constexpr size_t OFF_WGU = 0;
constexpr size_t OFF_WD = OFF_WGU + (size_t)5632 * 1024 * 2;
constexpr size_t OFF_WIN = OFF_WD + (size_t)1024 * 2816 * 2;
constexpr size_t OFF_WUQ = OFF_WIN + (size_t)3328 * 1024 * 2;
constexpr size_t OFF_WUKV = OFF_WUQ + (size_t)1536 * 384 * 2;
constexpr size_t OFF_WOA = OFF_WUKV + (size_t)2048 * 256 * 2;
constexpr size_t OFF_WP = OFF_WOA + (size_t)1024 * 1024 * 2;
constexpr size_t OFF_WOUT = OFF_WP + (size_t)1024 * 512 * 2;
constexpr size_t OFF_XN = OFF_WOUT + (size_t)1024 * 1024 * 2;
constexpr size_t OFF_R = OFF_XN + 32 * MiB;
constexpr size_t OFF_F = OFF_R;
constexpr size_t OFF_ZF = OFF_R;
constexpr size_t OFF_KV = OFF_R;
constexpr size_t OFF_H = OFF_R + 64 * MiB;
constexpr size_t OFF_O = OFF_R + 64 * MiB;
constexpr size_t OFF_CQN = OFF_R + 80 * MiB;
constexpr size_t OFF_CKVN = OFF_R + 92 * MiB;
constexpr size_t OFF_TAB = OFF_R + 100 * MiB;
constexpr size_t OFF_Q = OFF_R + 104 * MiB;
constexpr size_t OFF_KR = OFF_R + 152 * MiB;
constexpr size_t OFF_G = OFF_R + 96 * MiB;
constexpr size_t OFF_DP = OFF_R + 176 * MiB;
constexpr size_t WS_END = OFF_R + 192 * MiB;
constexpr size_t OFF_BAR = WS_END, OFF_CNT = OFF_BAR + 16384, CTL_BYTES = 16384 + 6 * 16384, OFF_XBUF = OFF_BAR + CTL_BYTES;
static_assert(OFF_XBUF + 6 * (size_t)M * 16 <= 256 * MiB, "workspace");

struct Params {
    const float* x; const int* pos;
    const float *f1_pre, *f1_wg, *f1_wu, *f1_wd, *f1_post;
    const float *mix_pre, *w_in, *qa_g, *w_uq, *kva_g, *w_uk, *w_uv, *w_oa, *pool_w, *pool_scale, *w_op, *w_out, *mix_post;
    const float *f2_pre, *f2_wg, *f2_wu, *f2_wd, *f2_post, *final_g;
    float* out; unsigned char* ws;
    float inv_freq[32];
};

typedef __bf16 bf16x2_t __attribute__((ext_vector_type(2)));
__device__ __forceinline__ unsigned cvt_pk_bf16(float lo, float hi) { const f32x2 v = {lo, hi}; const bf16x2_t r = __builtin_convertvector(v, bf16x2_t); return __builtin_bit_cast(unsigned, r); }
__device__ __forceinline__ float bf_lo(unsigned w) { return __uint_as_float(w << 16); }
__device__ __forceinline__ float bf_hi(unsigned w) { return __uint_as_float(w & 0xffff0000u); }
__device__ __forceinline__ float sigmoidf_fast(float z) { return __builtin_amdgcn_rcpf(1.f + __builtin_amdgcn_exp2f(-1.4426950408889634f * z)); }
__device__ __forceinline__ int fresh_tid() { int t = threadIdx.x; asm volatile("" : "+v"(t)); return t; }
__device__ __forceinline__ float wave_sum(float v) {
#pragma unroll
    for (int o = 1; o < 64; o <<= 1) v += __shfl_xor(v, o);
    return v;
}

namespace pg8 {
constexpr int BM = 256, BK = 64, HALF = 128, HTB = HALF * BK * 2, STAGE_BYTES = 8 * HTB, NXCD = 8, WGM = 8;
__host__ __device__ __forceinline__ int lds_byte(int r, int c) { const int st = (r >> 4) * 2 + (c >> 5), rr = r & 15, cc = c & 31, ob = rr * 64 + cc * 2; return st * 1024 + (ob ^ (((ob >> 9) & 1) << 5)); }
__host__ __device__ __forceinline__ void stage_rc(int b, int& R, int& C) { const int st = b / 1024, sb = b % 1024, swz = sb ^ (((sb >> 9) & 1) << 5); R = (st >> 1) * 16 + swz / 64; C = (st & 1) * 32 + (swz % 64) / 2; }
__host__ __device__ __forceinline__ int perm32(int rho) { const int n = rho >> 4, i = rho & 15; return 8 * (i >> 2) + 4 * n + (i & 3); }
struct Unit { int pm, pn; };
struct Gemm { const bf16_t* A; const bf16_t* Bt; int M, N, K; };
struct StaticOrder {
    int nM, nN, nwg, G, c;
    __device__ void init(int M_, int N_, int G_, int c_) { nM = M_ / BM; nN = N_ / BM; nwg = nM * nN; G = G_; c = c_; }
    __device__ bool next(int i, Unit& u) const {
        const long L = (long)i * G + c; if (L >= nwg) return false;
        int wgid = (int)L; { const int q = nwg / NXCD, r = nwg % NXCD, xcd = wgid % NXCD, off = wgid / NXCD; wgid = (xcd < r ? xcd * (q + 1) : r * (q + 1) + (xcd - r) * q) + off; }
        const int nig = WGM * nN, gid = wgid / nig, fm = gid * WGM, gsz = (nM - fm) < WGM ? (nM - fm) : WGM;
        u.pm = fm + ((wgid % nig) % gsz); u.pn = (wgid % nig) / gsz; return true;
    }
};

template <class Epi>
__device__ __forceinline__ void gemm_phase(LAS unsigned char* lds, const Gemm g, const StaticOrder& S, const Epi& E) {
    const int tid = fresh_tid(), wid = __builtin_amdgcn_readfirstlane(tid >> 6), lane = tid & 63, wr = wid >> 2, wc = wid & 3, fr = lane & 15, fq = lane >> 4;
    const int K = g.K, nt = K / BK;
    unsigned voffA, voffB;
    { int R, C; stage_rc(tid * 16, R, C); const int Rb = Epi::PERM ? ((R & ~31) + perm32(R & 31)) : R;
      voffA = (unsigned)(R * K + C) * 2u; voffB = (unsigned)(Rb * K + C) * 2u; }
    const size_t rstep64 = (size_t)64 * K * 2;
    const size_t kstep = (size_t)(BK * 2);
    const size_t hstep = (size_t)HALF * K * 2;
    const size_t tstep = 2 * hstep;
    const unsigned ldsw = (unsigned)wid * 1024u;
    const int aoff = lds_byte(wr * 64 + fr, fq * 8), boff = lds_byte(wc * 32 + fr, fq * 8);
#define PG8_SA(b, h) (((b) * 2 + (h)) * HTB)
#define PG8_SB(b, h) ((4 + (b) * 2 + (h)) * HTB)
#define PG8_STAGE(bufoff, gbase, voff) do { _Pragma("unroll") for (int _i = 0; _i < 2; ++_i) \
        __builtin_amdgcn_global_load_lds((const unsigned*)((const char*)(gbase) + _i * rstep64 + (voff)), (LAS unsigned*)(lds + (bufoff) + ldsw + _i * 8192), 16, 0, 0); } while (0)
#define PG8_LDA(dst, b, h) do { _Pragma("unroll") for (int m = 0; m < 4; ++m) _Pragma("unroll") for (int k = 0; k < 2; ++k) dst[m][k] = *(const LAS bf16x8*)(lds + PG8_SA(b, h) + aoff + m * 2048 + k * 1024); } while (0)
#define PG8_LDB(dst, b, h) do { _Pragma("unroll") for (int n = 0; n < 2; ++n) _Pragma("unroll") for (int k = 0; k < 2; ++k) dst[n][k] = *(const LAS bf16x8*)(lds + PG8_SB(b, h) + boff + n * 2048 + k * 1024); } while (0)
#define PG8_MMA(ai, bj, At, Bt) do { __builtin_amdgcn_s_setprio(1); _Pragma("unroll") for (int m = 0; m < 4; ++m) _Pragma("unroll") for (int n = 0; n < 2; ++n) _Pragma("unroll") for (int k = 0; k < 2; ++k) \
        acc[ai][bj][m][n] = __builtin_amdgcn_mfma_f32_16x16x32_bf16(Bt[n][k], At[m][k], acc[ai][bj][m][n], 0, 0, 0); __builtin_amdgcn_s_setprio(0); } while (0)
#define PG8_WAIT_V(n) asm volatile("s_waitcnt vmcnt(" #n ")" ::: "memory")
#define PG8_WAIT_L(n) asm volatile("s_waitcnt lgkmcnt(" #n ")" ::: "memory")
#define PG8_BAR __builtin_amdgcn_s_barrier()
#define PG8_SCHED __builtin_amdgcn_sched_barrier(0)
    Unit cur, nxt; int ui = 0;
    if (!S.next(0, cur)) return;
    f32x4 acc[2][2][4][2];
#pragma unroll
    for (int a = 0; a < 2; ++a)
#pragma unroll
        for (int b = 0; b < 2; ++b)
#pragma unroll
            for (int m = 0; m < 4; ++m)
#pragma unroll
                for (int n = 0; n < 2; ++n) acc[a][b][m][n] = (f32x4){0.f, 0.f, 0.f, 0.f};
    bf16x8 At[4][2], B0[2][2], B1[2][2];
    const char* cA = (const char*)g.A + (size_t)cur.pm * tstep; const char* cB = (const char*)g.Bt + (size_t)cur.pn * tstep;
    PG8_STAGE(PG8_SB(0, 0), cB, voffB); PG8_STAGE(PG8_SA(0, 0), cA, voffA); PG8_STAGE(PG8_SB(0, 1), cB + hstep, voffB); PG8_STAGE(PG8_SA(0, 1), cA + hstep, voffA);
    if (wr == 1) PG8_BAR;
    PG8_WAIT_V(4); PG8_BAR;
    PG8_STAGE(PG8_SB(1, 0), cB + kstep, voffB); PG8_STAGE(PG8_SA(1, 0), cA + kstep, voffA); PG8_STAGE(PG8_SB(1, 1), cB + hstep + kstep, voffB);
    PG8_WAIT_V(6); PG8_BAR;
    for (;;) {
        const bool has_next = S.next(ui + 1, nxt);
        const char* nA = has_next ? (const char*)g.A + (size_t)nxt.pm * tstep : cA; const char* nB = has_next ? (const char*)g.Bt + (size_t)nxt.pn * tstep : cB;
        for (int t = 0; t < nt; t += 2) {
            const bool last = (t == nt - 2);
            const char* a1 = cA + (size_t)(t + 1) * kstep;
            const char* a2 = last ? nA : cA + (size_t)(t + 2) * kstep; const char* b2 = last ? nB : cB + (size_t)(t + 2) * kstep;
            const char* a3 = a2 + kstep; const char* b3 = b2 + kstep;
            PG8_LDB(B0, 0, 0); PG8_SCHED; PG8_LDA(At, 0, 0); PG8_STAGE(PG8_SA(1, 1), a1 + hstep, voffA);
            PG8_WAIT_L(8); PG8_BAR; PG8_WAIT_L(0); PG8_MMA(0, 0, At, B0); PG8_BAR; PG8_SCHED;
            PG8_LDB(B1, 0, 1); PG8_STAGE(PG8_SB(0, 0), b2, voffB);
            PG8_BAR; PG8_WAIT_L(0); PG8_MMA(0, 1, At, B1); PG8_BAR;
            PG8_LDA(At, 0, 1); PG8_STAGE(PG8_SA(0, 0), a2, voffA);
            PG8_BAR; PG8_WAIT_L(0); PG8_MMA(1, 0, At, B0); PG8_BAR; PG8_SCHED;
            PG8_STAGE(PG8_SB(0, 1), b2 + hstep, voffB);
            PG8_WAIT_V(6); PG8_BAR; PG8_MMA(1, 1, At, B1); PG8_BAR;
            PG8_LDB(B0, 1, 0); PG8_SCHED; PG8_LDA(At, 1, 0); PG8_STAGE(PG8_SA(0, 1), a2 + hstep, voffA);
            PG8_WAIT_L(8); PG8_BAR; PG8_WAIT_L(0); PG8_MMA(0, 0, At, B0); PG8_BAR; PG8_SCHED;
            PG8_LDB(B1, 1, 1); PG8_STAGE(PG8_SB(1, 0), b3, voffB);
            PG8_BAR; PG8_WAIT_L(0); PG8_MMA(0, 1, At, B1); PG8_BAR;
            PG8_LDA(At, 1, 1); PG8_STAGE(PG8_SA(1, 0), a3, voffA);
            PG8_BAR; PG8_WAIT_L(0); PG8_MMA(1, 0, At, B0); PG8_BAR; PG8_SCHED;
            PG8_STAGE(PG8_SB(1, 1), b3 + hstep, voffB);
            PG8_WAIT_V(6); PG8_BAR; PG8_MMA(1, 1, At, B1); PG8_BAR;
        }
        if constexpr (!Epi::AFTER_DRAIN) { const int t2 = fresh_tid(); E(acc, cur, wr, wc, t2 & 15, (t2 >> 4) & 3); }
        if (!has_next) break;
#pragma unroll
        for (int a = 0; a < 2; ++a)
#pragma unroll
            for (int b = 0; b < 2; ++b)
#pragma unroll
                for (int m = 0; m < 4; ++m)
#pragma unroll
                    for (int n = 0; n < 2; ++n) acc[a][b][m][n] = (f32x4){0.f, 0.f, 0.f, 0.f};
        cur = nxt; cA = nA; cB = nB; ++ui;
    }
    PG8_WAIT_V(0);
    if (wr == 0) PG8_BAR;
    PG8_BAR;
    if constexpr (Epi::AFTER_DRAIN) { const int t2 = fresh_tid(); E.fused(acc, cur, wr, wc, t2 & 15, (t2 >> 4) & 3, lds, t2 >> 6, t2 & 63); }
#undef PG8_SA
#undef PG8_SB
#undef PG8_STAGE
#undef PG8_LDA
#undef PG8_LDB
#undef PG8_MMA
#undef PG8_WAIT_V
#undef PG8_WAIT_L
#undef PG8_BAR
#undef PG8_SCHED
}

typedef f32x4 Acc[2][2][4][2];
struct EpiF32 {
    static constexpr bool PERM = false, AFTER_DRAIN = false;
    float* C; int ldc;
    __device__ __forceinline__ void operator()(const Acc& acc, const Unit& u, int wr, int wc, int fr, int fq) const {
        const int row0 = u.pm * BM + wr * 64 + fr, col0 = u.pn * BM + wc * 32 + 4 * fq;
#pragma unroll
        for (int ai = 0; ai < 2; ++ai)
#pragma unroll
            for (int m = 0; m < 4; ++m) { float* rowp = C + (size_t)(row0 + ai * HALF + m * 16) * ldc + col0;
#pragma unroll
                for (int bj = 0; bj < 2; ++bj)
#pragma unroll
                    for (int n = 0; n < 2; ++n) *(f32x4*)(rowp + bj * HALF + n * 16) = acc[ai][bj][m][n]; }
    }
};
struct EpiBf16 {
    static constexpr bool PERM = true, AFTER_DRAIN = false;
    bf16_t* O; int ldc;
    __device__ __forceinline__ void operator()(const Acc& acc, const Unit& u, int wr, int wc, int fr, int fq) const {
        const int row0 = u.pm * BM + wr * 64 + fr, col0 = u.pn * BM + wc * 32 + 8 * fq;
#pragma unroll
        for (int ai = 0; ai < 2; ++ai)
#pragma unroll
            for (int m = 0; m < 4; ++m) { bf16_t* rowp = O + (size_t)(row0 + ai * HALF + m * 16) * ldc + col0;
#pragma unroll
                for (int bj = 0; bj < 2; ++bj) { const f32x4 v0 = acc[ai][bj][m][0], v1 = acc[ai][bj][m][1];
                    u32x4 w; w.x = cvt_pk_bf16(v0[0], v0[1]); w.y = cvt_pk_bf16(v0[2], v0[3]); w.z = cvt_pk_bf16(v1[0], v1[1]); w.w = cvt_pk_bf16(v1[2], v1[3]);
                    *(u32x4*)(rowp + bj * HALF) = w; } }
    }
};
struct EpiSwiGLU {
    static constexpr bool PERM = true, AFTER_DRAIN = false;
    bf16_t* H;
    __device__ __forceinline__ void operator()(const Acc& acc, const Unit& u, int wr, int wc, int fr, int fq) const {
        const int row0 = u.pm * BM + wr * 64 + fr, col0 = u.pn * HALF + wc * 32 + 8 * fq;
#pragma unroll
        for (int ai = 0; ai < 2; ++ai)
#pragma unroll
            for (int m = 0; m < 4; ++m) { bf16_t* rowp = H + (size_t)(row0 + ai * HALF + m * 16) * DFF + col0;
                float h[8];
#pragma unroll
                for (int n = 0; n < 2; ++n)
#pragma unroll
                    for (int j = 0; j < 4; ++j) { const float gt = acc[ai][0][m][n][j], up = acc[ai][1][m][n][j]; h[n * 4 + j] = gt * sigmoidf_fast(gt) * up; }
                u32x4 w; w.x = cvt_pk_bf16(h[0], h[1]); w.y = cvt_pk_bf16(h[2], h[3]); w.z = cvt_pk_bf16(h[4], h[5]); w.w = cvt_pk_bf16(h[6], h[7]);
                *(u32x4*)rowp = w; }
    }
};
struct EpiGate {
    static constexpr bool PERM = true, AFTER_DRAIN = false;
    bf16_t* G;
    __device__ __forceinline__ void operator()(const Acc& acc, const Unit& u, int wr, int wc, int fr, int fq) const {
        const int row0 = u.pm * BM + wr * 64 + fr, col0 = u.pn * BM + wc * 32 + 8 * fq;
#pragma unroll
        for (int ai = 0; ai < 2; ++ai)
#pragma unroll
            for (int m = 0; m < 4; ++m) { bf16_t* rowp = G + (size_t)(row0 + ai * HALF + m * 16) * 2048 + col0;
#pragma unroll
                for (int bj = 0; bj < 2; ++bj) { const f32x4 v0 = acc[ai][bj][m][0], v1 = acc[ai][bj][m][1];
                    u32x4 w; w.x = cvt_pk_bf16(sigmoidf_fast(v0[0]), sigmoidf_fast(v0[1])); w.y = cvt_pk_bf16(sigmoidf_fast(v0[2]), sigmoidf_fast(v0[3]));
                    w.z = cvt_pk_bf16(sigmoidf_fast(v1[0]), sigmoidf_fast(v1[1])); w.w = cvt_pk_bf16(sigmoidf_fast(v1[2]), sigmoidf_fast(v1[3]));
                    *(u32x4*)(rowp + bj * HALF) = w; } }
    }
};
struct EpiQ {
    static constexpr bool PERM = true, AFTER_DRAIN = false;
    bf16_t* Q; const float* TAB;
    __device__ __forceinline__ void operator()(const Acc& acc, const Unit& u, int wr, int wc, int fr, int fq) const {
        const int row0 = u.pm * BM + wr * 64 + fr, col0 = u.pn * BM + wc * 32 + 8 * fq;
#pragma unroll
        for (int ai = 0; ai < 2; ++ai)
#pragma unroll
            for (int m = 0; m < 4; ++m) { const int row = row0 + ai * HALF + m * 16; bf16_t* rowp = Q + (size_t)row * 1536 + col0;
#pragma unroll
                for (int bj = 0; bj < 2; ++bj) { f32x4 v0 = acc[ai][bj][m][0], v1 = acc[ai][bj][m][1];
                    const int c = col0 + bj * HALF, w = c % 192;
                    if (w >= 128) { const int i0 = (w - 128) >> 1; const f32x4 cs = *(const f32x4*)(TAB + (size_t)row * 64 + i0), sn = *(const f32x4*)(TAB + (size_t)row * 64 + 32 + i0);
                        f32x4 r0, r1;
                        r0[0] = v0[0] * cs[0] - v0[1] * sn[0]; r0[1] = v0[1] * cs[0] + v0[0] * sn[0];
                        r0[2] = v0[2] * cs[1] - v0[3] * sn[1]; r0[3] = v0[3] * cs[1] + v0[2] * sn[1];
                        r1[0] = v1[0] * cs[2] - v1[1] * sn[2]; r1[1] = v1[1] * cs[2] + v1[0] * sn[2];
                        r1[2] = v1[2] * cs[3] - v1[3] * sn[3]; r1[3] = v1[3] * cs[3] + v1[2] * sn[3];
                        v0 = r0; v1 = r1; }
                    u32x4 wv; wv.x = cvt_pk_bf16(v0[0], v0[1]); wv.y = cvt_pk_bf16(v0[2], v0[3]); wv.z = cvt_pk_bf16(v1[0], v1[1]); wv.w = cvt_pk_bf16(v1[2], v1[3]);
                    *(u32x4*)(rowp + bj * HALF) = wv; } }
    }
};
struct EpiT1 {
    static constexpr bool PERM = true, AFTER_DRAIN = false;
    const bf16_t* G; bf16_t* F;
    __device__ __forceinline__ void operator()(const Acc& acc, const Unit& u, int wr, int wc, int fr, int fq) const {
        const int row0 = u.pm * BM + wr * 64 + fr, col0 = u.pn * BM + wc * 32 + 8 * fq;
#pragma unroll
        for (int ai = 0; ai < 2; ++ai)
#pragma unroll
            for (int m = 0; m < 4; ++m) { const int row = row0 + ai * HALF + m * 16;
#pragma unroll
                for (int bj = 0; bj < 2; ++bj) { const f32x4 v0 = acc[ai][bj][m][0], v1 = acc[ai][bj][m][1]; const int c = col0 + bj * HALF;
                    const u32x4 gw = *(const u32x4*)(G + (size_t)row * 2048 + c);
                    u32x4 wv;
                    wv.x = cvt_pk_bf16(v0[0] * bf_lo(gw.x), v0[1] * bf_hi(gw.x)); wv.y = cvt_pk_bf16(v0[2] * bf_lo(gw.y), v0[3] * bf_hi(gw.y));
                    wv.z = cvt_pk_bf16(v1[0] * bf_lo(gw.z), v1[1] * bf_hi(gw.z)); wv.w = cvt_pk_bf16(v1[2] * bf_lo(gw.w), v1[3] * bf_hi(gw.w));
                    *(u32x4*)(F + (size_t)row * 1024 + c) = wv; } }
    }
};
struct EpiMX {
    static constexpr bool PERM = true, AFTER_DRAIN = false;
    const bf16_t* G; const bf16_t* F; bf16_t* MX;
    __device__ __forceinline__ void operator()(const Acc& acc, const Unit& u, int wr, int wc, int fr, int fq) const {
        const int row0 = u.pm * BM + wr * 64 + fr, col0 = u.pn * BM + wc * 32 + 8 * fq;
#pragma unroll
        for (int ai = 0; ai < 2; ++ai)
#pragma unroll
            for (int m = 0; m < 4; ++m) { const int row = row0 + ai * HALF + m * 16;
#pragma unroll
                for (int bj = 0; bj < 2; ++bj) { const f32x4 v0 = acc[ai][bj][m][0], v1 = acc[ai][bj][m][1]; const int c = col0 + bj * HALF;
                    const u32x4 gw = *(const u32x4*)(G + (size_t)row * 2048 + 1024 + c);
                    const u32x4 tw = *(const u32x4*)(F + (size_t)row * 1024 + c);
                    u32x4 wv;
                    wv.x = cvt_pk_bf16(bf_lo(tw.x) + v0[0] * bf_lo(gw.x), bf_hi(tw.x) + v0[1] * bf_hi(gw.x)); wv.y = cvt_pk_bf16(bf_lo(tw.y) + v0[2] * bf_lo(gw.y), bf_hi(tw.y) + v0[3] * bf_hi(gw.y));
                    wv.z = cvt_pk_bf16(bf_lo(tw.z) + v1[0] * bf_lo(gw.z), bf_hi(tw.z) + v1[1] * bf_hi(gw.z)); wv.w = cvt_pk_bf16(bf_lo(tw.w) + v1[2] * bf_lo(gw.w), bf_hi(tw.w) + v1[3] * bf_hi(gw.w));
                    *(u32x4*)(MX + (size_t)row * 1024 + c) = wv; } }
    }
};

struct PanelSumSq {
    float* xbuf;
    unsigned* cnt;
    __device__ __forceinline__ void run(const Acc& v, const Unit& u, int wr, int wc, int fr, int fq, LAS unsigned char* lds, int wid, int lane) const {
        LAS float* P = (LAS float*)lds; LAS float* S = (LAS float*)(lds + 4096);
#pragma unroll
        for (int ai = 0; ai < 2; ++ai)
#pragma unroll
            for (int m = 0; m < 4; ++m) { float q = 0.f;
#pragma unroll
                for (int bj = 0; bj < 2; ++bj)
#pragma unroll
                    for (int n = 0; n < 2; ++n) { const f32x4 x = v[ai][bj][m][n]; q += (x[0] * x[0] + x[1] * x[1]) + (x[2] * x[2] + x[3] * x[3]); }
                q += __shfl_xor(q, 16); q += __shfl_xor(q, 32);
                if (fq == 0) P[(ai * HALF + wr * 64 + m * 16 + fr) * 4 + wc] = q; }
        asm volatile("s_waitcnt lgkmcnt(0)" ::: "memory"); __builtin_amdgcn_s_barrier(); asm volatile("" ::: "memory");
        const int row = wid * 32 + (lane & 31);
        if (lane < 32) { const float t = (P[row * 4 + 0] + P[row * 4 + 1]) + (P[row * 4 + 2] + P[row * 4 + 3]);
            __hip_atomic_store(xbuf + ((size_t)(u.pm * BM + row) * 4 + u.pn), t, __ATOMIC_RELAXED, __HIP_MEMORY_SCOPE_AGENT); }
        asm volatile("s_waitcnt vmcnt(0)" ::: "memory");
        if (lane == 0) __hip_atomic_fetch_add(cnt + 64 * u.pm, 1u, __ATOMIC_RELAXED, __HIP_MEMORY_SCOPE_AGENT);
        if (wid == 0) { unsigned sp = 0u;
            while ((unsigned)__builtin_amdgcn_readfirstlane(__hip_atomic_load(cnt + 64 * u.pm, __ATOMIC_RELAXED, __HIP_MEMORY_SCOPE_AGENT)) < 32u) { __builtin_amdgcn_s_sleep(1); if (++sp > (1u << 22)) break; }
            __builtin_amdgcn_fence(__ATOMIC_ACQUIRE, "agent"); }
        asm volatile("s_waitcnt vmcnt(0) lgkmcnt(0)" ::: "memory"); __builtin_amdgcn_s_barrier(); asm volatile("" ::: "memory");
        if (lane < 32) { const float* slot = xbuf + (size_t)(u.pm * BM + row) * 4; float tot = 0.f;
#pragma unroll
            for (int t = 0; t < 4; ++t) tot += __hip_atomic_load(slot + t, __ATOMIC_RELAXED, __HIP_MEMORY_SCOPE_AGENT);
            S[row] = __builtin_amdgcn_rsqf(tot * (1.f / 1024.f) + EPS); }
        asm volatile("s_waitcnt lgkmcnt(0)" ::: "memory"); __builtin_amdgcn_s_barrier(); asm volatile("" ::: "memory");
    }
};
template <bool FINAL> struct EpiResNorm {
    static constexpr bool PERM = false, AFTER_DRAIN = true;
    const float* base; float* out; bf16_t* xn; float wt; const float* gpost; const float* gnext; PanelSumSq st1, st2;
    __device__ __forceinline__ void operator()(const Acc&, const Unit&, int, int, int, int) const {}
    __device__ __forceinline__ void fused(Acc& acc, const Unit& u, int wr, int wc, int fr, int fq, LAS unsigned char* lds, int wid, int lane) const {
        const LAS float* S = (const LAS float*)(lds + 4096);
        const int col0 = u.pn * BM + wc * 32 + 4 * fq;
        st1.run(acc, u, wr, wc, fr, fq, lds, wid, lane);
#pragma unroll
        for (int ai = 0; ai < 2; ++ai)
#pragma unroll
            for (int m = 0; m < 4; ++m) { const int r = ai * HALF + wr * 64 + m * 16 + fr; const float sr = S[r] * wt; const size_t off = (size_t)(u.pm * BM + r) * 1024 + col0;
#pragma unroll
                for (int bj = 0; bj < 2; ++bj)
#pragma unroll
                    for (int n = 0; n < 2; ++n) { const f32x4 bs = *(const f32x4*)(base + off + bj * HALF + n * 16); const f32x4 g = *(const f32x4*)(gpost + col0 + bj * HALF + n * 16);
                        acc[ai][bj][m][n] = bs + acc[ai][bj][m][n] * g * sr; }
                asm volatile("" : "+v"(acc[ai][0][m][0]), "+v"(acc[ai][0][m][1]), "+v"(acc[ai][1][m][0]), "+v"(acc[ai][1][m][1]));
                if (m & 1) asm volatile("" ::: "memory"); }
        st2.run(acc, u, wr, wc, fr, fq, lds, wid, lane);
#pragma unroll
        for (int ai = 0; ai < 2; ++ai)
#pragma unroll
            for (int m = 0; m < 4; ++m) { const int r = ai * HALF + wr * 64 + m * 16 + fr; const float sr = S[r]; const size_t off = (size_t)(u.pm * BM + r) * 1024 + col0;
#pragma unroll
                for (int bj = 0; bj < 2; ++bj)
#pragma unroll
                    for (int n = 0; n < 2; ++n) { const f32x4 x1 = acc[ai][bj][m][n]; const f32x4 g = *(const f32x4*)(gnext + col0 + bj * HALF + n * 16); const f32x4 o = x1 * g * sr;
                        if (FINAL) *(f32x4*)(out + off + bj * HALF + n * 16) = o;
                        else { *(f32x4*)(out + off + bj * HALF + n * 16) = x1; u32x2 w; w.x = cvt_pk_bf16(o[0], o[1]); w.y = cvt_pk_bf16(o[2], o[3]); *(u32x2*)(xn + off + bj * HALF + n * 16) = w; } }
                asm volatile("" ::: "memory"); }
    }
};
}

namespace att {
constexpr int NW = 8, QBLK = 32, KVBLK = 64;
constexpr float SCALE = 0.07216878364870322f;
constexpr float THR = 8.f;
constexpr int LDQ = 1536, LDKV = 2048, LDKR = 64, LDO = 1024;
constexpr int SHM_V = 64 * 128 * 2, SHM_K = 64 * 128 * 2, SHM_R = 64 * 64 * 2;
constexpr int NQL = 4;
constexpr int OFF_V = 0, OFF_K = 2 * SHM_V, OFF_RP = OFF_K + 2 * SHM_K, OFF_WS = OFF_RP + 2 * SHM_R, OFF_QL = OFF_WS + NW * 64 * 4, SHM_ATTN = OFF_QL + NW * NQL * 1024;
static_assert(SHM_ATTN <= LDS_STAGE, "lds");
#define KSWZ(row, colB) ((row) * 256 + ((colB) ^ (((row) & 7) << 4)))
#define RSWZ(row, colB) ((row) * 128 + ((colB) ^ (((row) & 7) << 4)))
#define SBAR() __builtin_amdgcn_sched_barrier(0)
__device__ __forceinline__ int crow(int r, int hi) { return (r & 3) + 8 * (r >> 2) + 4 * hi; }
__device__ __forceinline__ bf16x8 ld8(const bf16_t* p) { return *reinterpret_cast<const bf16x8*>(p); }

__device__ __forceinline__ void partialSM(f32x16& p0, f32x16& p1, float& m_reg, float& mn, float& alpha) {
    constexpr float C = SCALE * 1.4426950408889634f;
    float pmax = p0[0];
#pragma unroll
    for (int r = 1; r < 16; ++r) pmax = fmaxf(pmax, p0[r]);
#pragma unroll
    for (int r = 0; r < 16; ++r) pmax = fmaxf(pmax, p1[r]);
    { auto rr = __builtin_amdgcn_permlane32_swap(__float_as_uint(pmax), __float_as_uint(pmax), false, false);
      pmax = fmaxf(__uint_as_float(rr[0]), __uint_as_float(rr[1])); }
    if (__builtin_expect(__all(pmax - m_reg <= THR / SCALE), 1)) { mn = m_reg; alpha = 1.f; }
    else { mn = fmaxf(m_reg, pmax); alpha = __builtin_amdgcn_exp2f((m_reg - mn) * C); m_reg = mn; }
    float mnC = -mn * C;
#pragma unroll
    for (int r = 0; r < 16; ++r) p0[r] = fmaf(p0[r], C, mnC);
#pragma unroll
    for (int r = 0; r < 16; ++r) p1[r] = fmaf(p1[r], C, mnC);
#pragma unroll
    for (int r = 0; r < 16; ++r) p0[r] = __builtin_amdgcn_exp2f(p0[r]);
}
__device__ __forceinline__ void finishSM(f32x16& p0, f32x16& p1, float alpha, float& l_reg, bf16x8& pa0, bf16x8& pa1, bf16x8& pa2, bf16x8& pa3) {
#pragma unroll
    for (int r = 0; r < 16; ++r) p1[r] = __builtin_amdgcn_exp2f(p1[r]);
    float ps = 0;
#pragma unroll
    for (int r = 0; r < 16; ++r) ps += p0[r];
#pragma unroll
    for (int r = 0; r < 16; ++r) ps += p1[r];
    { auto rr = __builtin_amdgcn_permlane32_swap(__float_as_uint(ps), __float_as_uint(ps), false, false);
      ps = __uint_as_float(rr[0]) + __uint_as_float(rr[1]); }
    l_reg = l_reg * alpha + ps;
#define PK4(P, BASE, OUT) do { unsigned a0 = cvt_pk_bf16(P[BASE + 0], P[BASE + 1]), a1 = cvt_pk_bf16(P[BASE + 2], P[BASE + 3]);   \
    unsigned b0 = cvt_pk_bf16(P[BASE + 4], P[BASE + 5]), b1 = cvt_pk_bf16(P[BASE + 6], P[BASE + 7]);                              \
    auto r0 = __builtin_amdgcn_permlane32_swap(a0, b0, false, false); auto r1 = __builtin_amdgcn_permlane32_swap(a1, b1, false, false); \
    u32x4 w = {r0[0], r1[0], r0[1], r1[1]}; OUT = *reinterpret_cast<bf16x8*>(&w); } while (0)
    PK4(p0, 0, pa0); PK4(p0, 8, pa1); PK4(p1, 0, pa2); PK4(p1, 8, pa3);
#undef PK4
}
__device__ __forceinline__ void qkt(f32x16& p0, f32x16& p1, const char* Ks, const char* Rs, const bf16x8* qr, const char* ql, int r32, int hi) {
    p0 = f32x16{}; p1 = f32x16{};
#pragma unroll
    for (int d0 = 0; d0 < 8; ++d0) { int cb = (d0 * 16 + hi * 8) * 2;
        bf16x8 b0 = *reinterpret_cast<const bf16x8*>(Ks + KSWZ(r32, cb));
        bf16x8 b1 = *reinterpret_cast<const bf16x8*>(Ks + KSWZ(32 + r32, cb));
        p0 = __builtin_amdgcn_mfma_f32_32x32x16_bf16(b0, qr[d0], p0, 0, 0, 0);
        p1 = __builtin_amdgcn_mfma_f32_32x32x16_bf16(b1, qr[d0], p1, 0, 0, 0); }
#pragma unroll
    for (int d0 = 0; d0 < 4; ++d0) { int cb = (d0 * 16 + hi * 8) * 2;
        bf16x8 b0 = *reinterpret_cast<const bf16x8*>(Rs + RSWZ(r32, cb));
        bf16x8 b1 = *reinterpret_cast<const bf16x8*>(Rs + RSWZ(32 + r32, cb));
        const bf16x8 qv = *reinterpret_cast<const bf16x8*>(ql + d0 * 1024);
        p0 = __builtin_amdgcn_mfma_f32_32x32x16_bf16(b0, qv, p0, 0, 0, 0);
        p1 = __builtin_amdgcn_mfma_f32_32x32x16_bf16(b1, qv, p1, 0, 0, 0); }
}
__device__ __forceinline__ int v_st(int k, int c) { const int kk = (k & ~0xC) | ((k & 4) << 1) | ((k & 8) >> 1); return ((kk >> 3) * 4 + (c >> 5)) * 512 + ((kk & 7) * 32 + (c & 31)) * 2; }
__device__ __forceinline__ int v_rd_base(int lane) { return ((lane & 3) << 3) | (((lane >> 2) & 3) << 6) | (((lane >> 4) & 1) << 5) | (((lane >> 5) & 1) << 8); }
constexpr int v_rd_off(int d0, int ks, int half) { return d0 * 512 + ks * 4096 + half * 2048; }
template <int OFF> __device__ __forceinline__ s16x4 tr_read(int vb) {
    s16x4 r; asm volatile("ds_read_b64_tr_b16 %0, %1 offset:%2" : "=&v"(r) : "v"(vb), "i"(OFF) : "memory"); return r;
}
template <int D0> __device__ __forceinline__ void pv_one(f32x16& od, int vb, bf16x8 pa0, bf16x8 pa1, bf16x8 pa2, bf16x8 pa3) {
    const s16x4 l0 = tr_read<v_rd_off(D0, 0, 0)>(vb), h0 = tr_read<v_rd_off(D0, 0, 1)>(vb), l1 = tr_read<v_rd_off(D0, 1, 0)>(vb), h1 = tr_read<v_rd_off(D0, 1, 1)>(vb);
    const s16x4 l2 = tr_read<v_rd_off(D0, 2, 0)>(vb), h2 = tr_read<v_rd_off(D0, 2, 1)>(vb), l3 = tr_read<v_rd_off(D0, 3, 0)>(vb), h3 = tr_read<v_rd_off(D0, 3, 1)>(vb);
    asm volatile("s_waitcnt lgkmcnt(0)" ::: "memory"); SBAR();
#define PK(L, H) (bf16x8){L[0], L[1], L[2], L[3], H[0], H[1], H[2], H[3]}
    od = __builtin_amdgcn_mfma_f32_32x32x16_bf16(pa0, PK(l0, h0), od, 0, 0, 0);
    od = __builtin_amdgcn_mfma_f32_32x32x16_bf16(pa1, PK(l1, h1), od, 0, 0, 0);
    od = __builtin_amdgcn_mfma_f32_32x32x16_bf16(pa2, PK(l2, h2), od, 0, 0, 0);
    od = __builtin_amdgcn_mfma_f32_32x32x16_bf16(pa3, PK(l3, h3), od, 0, 0, 0);
#undef PK
}
__device__ __forceinline__ void pv_d0(f32x16* o, int vb, bf16x8 pa0, bf16x8 pa1, bf16x8 pa2, bf16x8 pa3) {
    pv_one<0>(o[0], vb, pa0, pa1, pa2, pa3); pv_one<1>(o[1], vb, pa0, pa1, pa2, pa3); pv_one<2>(o[2], vb, pa0, pa1, pa2, pa3); pv_one<3>(o[3], vb, pa0, pa1, pa2, pa3);
}

__device__ __forceinline__ void attn_body(const bf16_t* __restrict__ Qb, const bf16_t* __restrict__ Kn, const bf16_t* __restrict__ Kr, const bf16_t* __restrict__ Vh,
                                          bf16_t* __restrict__ Ob, int seq, char* lds) {
    const int tid = fresh_tid(), wid = tid >> 6, lane = tid & 63, r32 = lane & 31, hi = lane >> 5;
    char* V_lds = lds + OFF_V; char* K_lds = lds + OFF_K; char* R_lds = lds + OFF_RP;
    float* ws = (float*)(lds + OFF_WS) + wid * 64; float* li_l = ws; float* al_l = ws + 32;
    float m_reg = -1e30f, l_reg = 0; f32x16 o[4] = {}; bf16x8 qr[8];
    char* ql = lds + OFF_QL + wid * (NQL * 1024) + lane * 16;
    const bf16_t* Qw = Qb + (long)(wid * QBLK + r32) * LDQ + hi * 8;
#pragma unroll
    for (int d0 = 0; d0 < 8; ++d0) qr[d0] = ld8(Qw + d0 * 16);
#pragma unroll
    for (int d0 = 0; d0 < NQL; ++d0) *reinterpret_cast<bf16x8*>(ql + d0 * 1024) = ld8(Qw + (8 + d0) * 16);
    const int sr = tid >> 4, sc = (tid & 15) * 8, vst0 = v_st(sr, sc), vst1 = v_st(32 + sr, sc);
    const int rr_ = tid >> 3, rc_ = (tid & 7) * 8;
    const int vb0 = (int)(uintptr_t)V_lds + v_rd_base(lane);
    bf16x8 vs0, vs1, ks0, ks1, rs0;
#define SLOAD(k0) do { vs0 = ld8(&Vh[(long)((k0) + sr) * LDKV + sc]); vs1 = ld8(&Vh[(long)((k0) + 32 + sr) * LDKV + sc]); \
    ks0 = ld8(&Kn[(long)((k0) + sr) * LDKV + sc]); ks1 = ld8(&Kn[(long)((k0) + 32 + sr) * LDKV + sc]); rs0 = ld8(&Kr[(long)((k0) + rr_) * LDKR + rc_]); } while (0)
#define SWRITE(b) do { *(bf16x8*)(V_lds + (b) * SHM_V + vst0) = vs0; *(bf16x8*)(V_lds + (b) * SHM_V + vst1) = vs1; int kc = sc * 2; \
    *(bf16x8*)(K_lds + (b) * SHM_K + KSWZ(sr, kc)) = ks0; *(bf16x8*)(K_lds + (b) * SHM_K + KSWZ(32 + sr, kc)) = ks1; \
    *(bf16x8*)(R_lds + (b) * SHM_R + RSWZ(rr_, rc_ * 2)) = rs0; } while (0)
#define RESC(a) do { if (__any((a) < 1.f)) { if (hi == 0) al_l[r32] = (a); asm volatile("s_waitcnt lgkmcnt(0)" ::: "memory"); \
    _Pragma("unroll") for (int d = 0; d < 4; ++d) _Pragma("unroll") for (int r = 0; r < 16; ++r) o[d][r] *= al_l[crow(r, hi)]; } } while (0)
    f32x16 pA0, pA1, pB0, pB1; float mnA, mnB, alA, alB; bf16x8 pa0, pa1, pa2, pa3; const int NT = seq / KVBLK;
    SLOAD(0); asm volatile("s_waitcnt vmcnt(0)" ::: "memory"); SWRITE(0); __syncthreads();
    qkt(pA0, pA1, K_lds, R_lds, qr, ql, r32, hi); partialSM(pA0, pA1, m_reg, mnA, alA);
    SLOAD(KVBLK);
    asm volatile("s_waitcnt vmcnt(0)" ::: "memory"); SWRITE(1); __syncthreads();
    for (int j = 1; j + 1 < NT; j += 2) {
        SBAR(); qkt(pB0, pB1, K_lds + SHM_K, R_lds + SHM_R, qr, ql, r32, hi);
        finishSM(pA0, pA1, alA, l_reg, pa0, pa1, pa2, pa3); SBAR();
        SLOAD((j + 1) * KVBLK); SBAR();
        pv_d0(o, vb0, pa0, pa1, pa2, pa3); partialSM(pB0, pB1, m_reg, mnB, alB);
        __syncthreads(); asm volatile("s_waitcnt vmcnt(0)" ::: "memory"); SWRITE(0);
        RESC(alB); __syncthreads();
        SBAR(); qkt(pA0, pA1, K_lds, R_lds, qr, ql, r32, hi);
        finishSM(pB0, pB1, alB, l_reg, pa0, pa1, pa2, pa3); SBAR();
        SLOAD((j + 2) * KVBLK); SBAR();
        pv_d0(o, vb0 + SHM_V, pa0, pa1, pa2, pa3); partialSM(pA0, pA1, m_reg, mnA, alA);
        __syncthreads(); asm volatile("s_waitcnt vmcnt(0)" ::: "memory"); SWRITE(1);
        RESC(alA); __syncthreads();
    }
    SBAR(); qkt(pB0, pB1, K_lds + SHM_K, R_lds + SHM_R, qr, ql, r32, hi);
    finishSM(pA0, pA1, alA, l_reg, pa0, pa1, pa2, pa3); SBAR();
    pv_d0(o, vb0, pa0, pa1, pa2, pa3); partialSM(pB0, pB1, m_reg, mnB, alB);
    __syncthreads(); RESC(alB);
    finishSM(pB0, pB1, alB, l_reg, pa0, pa1, pa2, pa3); SBAR();
    pv_d0(o, vb0 + SHM_V, pa0, pa1, pa2, pa3);
    if (hi == 0) li_l[r32] = l_reg; asm volatile("s_waitcnt lgkmcnt(0)" ::: "memory");
    float rli[16];
#pragma unroll
    for (int r = 0; r < 16; ++r) rli[r] = __builtin_amdgcn_rcpf(li_l[crow(r, hi)]);
    bf16_t* Ow = Ob + (long)(wid * QBLK) * LDO;
#pragma unroll
    for (int r = 0; r < 16; ++r) { int orow = crow(r, hi);
#pragma unroll
        for (int d0 = 0; d0 < 4; ++d0) { const float v = o[d0][r] * rli[r]; Ow[(long)orow * LDO + d0 * 32 + r32] = (bf16_t)(cvt_pk_bf16(v, v) & 0xffffu); } }
#undef SLOAD
#undef SWRITE
#undef RESC
}
}


#define XB_TMO      128
#define XB_XCNT(j)  (256  + 64 * (j))
#define XB_XSUB(j)  (1280 + 64 * (j))
#define XB_XGEN(j)  (2304 + 64 * (j))
#define XB_TOP      3328
#define XB_TOPGEN   3392
#define XCD_BAR_WORDS 3456
#define XB_SPIN_CAP (1u << 18)
__device__ __forceinline__ unsigned xb_ld(unsigned* p)              { return __hip_atomic_load(p, __ATOMIC_RELAXED, __HIP_MEMORY_SCOPE_AGENT); }
__device__ __forceinline__ unsigned xb_add(unsigned* p, unsigned v) { return __hip_atomic_fetch_add(p, v, __ATOMIC_RELAXED, __HIP_MEMORY_SCOPE_AGENT); }
__device__ __forceinline__ unsigned xb_xcc_id() { return (unsigned)__builtin_amdgcn_s_getreg((3 << 11) | 20) & 0xFu; }
#define XB_SPIN(cond, bar) do { unsigned _sp = 0; while (cond) { __builtin_amdgcn_s_sleep(1); \
    if ((++_sp & 255u) == 0u) { if (xb_ld(&(bar)[XB_TMO])) break; if (_sp > XB_SPIN_CAP) { atomicAdd(&(bar)[XB_TMO], 1u); break; } } } } while (0)
struct XcdBarrier { unsigned* bar; unsigned x; volatile LAS unsigned* st; };
__device__ __forceinline__ XcdBarrier xcd_barrier_post(unsigned* bar, volatile LAS unsigned* st) {
    XcdBarrier b; b.bar = bar; b.x = xb_xcc_id(); b.st = st;
    if (threadIdx.x == 0) (void)xb_add(&bar[XB_XCNT(b.x)], 1u);
    return b;
}
__device__ __forceinline__ void xcd_barrier_complete(unsigned* bar, unsigned x, unsigned& nloc, unsigned& nx) {
    const unsigned G = gridDim.x * gridDim.y * gridDim.z;
    unsigned sum, cnt, mine, sp = 0u;
    for (;;) {
        sum = 0u; cnt = 0u; mine = 0u;
#pragma unroll
        for (unsigned j = 0; j < 16; ++j) { const unsigned c = xb_ld(&bar[XB_XCNT(j)]); sum += c; cnt += (c > 0u) ? 1u : 0u; mine = (j == x) ? c : mine; }
        if (sum == G) break;
        __builtin_amdgcn_s_sleep(1);
        if ((++sp & 255u) == 0u) { if (xb_ld(&bar[XB_TMO])) break; if (sp > XB_SPIN_CAP) { atomicAdd(&bar[XB_TMO], 1u); break; } }
    }
    nloc = mine > 0u ? mine : 1u; nx = cnt > 0u ? cnt : 1u;
}
__device__ __forceinline__ void xcd_barrier(const XcdBarrier& b) {
    asm volatile("s_waitcnt vmcnt(0)" ::: "memory");
    __syncthreads();
    if (threadIdx.x == 0) {
        unsigned* bar = b.bar;
        __builtin_amdgcn_s_waitcnt(0);
        unsigned nloc = b.st[0], nx = b.st[1];
        if (nloc == 0u) { xcd_barrier_complete(bar, b.x, nloc, nx); b.st[0] = nloc; b.st[1] = nx; }
        const unsigned old = xb_add(&bar[XB_XSUB(b.x)], 1u);
        const unsigned gen = old / nloc;
        if (old + 1u == (gen + 1u) * nloc) {
            __builtin_amdgcn_fence(__ATOMIC_RELEASE, "agent");
            asm volatile("s_waitcnt vmcnt(0)" ::: "memory");
            const unsigned og = xb_add(&bar[XB_TOP], 1u);
            const unsigned tg = og / nx;
            if (og + 1u == (tg + 1u) * nx) xb_add(&bar[XB_TOPGEN], 1u);
            else XB_SPIN(xb_ld(&bar[XB_TOPGEN]) == tg, bar);
            __builtin_amdgcn_fence(__ATOMIC_ACQUIRE, "agent");
            xb_add(&bar[XB_XGEN(b.x)], 1u);
            asm volatile("s_waitcnt vmcnt(0)" ::: "memory");
        } else {
            XB_SPIN(xb_ld(&bar[XB_XGEN(b.x)]) == gen, bar);
            __builtin_amdgcn_fence(__ATOMIC_ACQUIRE, "agent");
            asm volatile("s_waitcnt vmcnt(0)" ::: "memory");
        }
    }
    __syncthreads();
}

enum { TR_PLAIN = 0, TR_GU = 1, TR_WIN = 2, TR_UQ = 3, TR_UKV = 4 };
template <int MODE>
__device__ __forceinline__ void tr_job(const float* W0, const float* W1, int K, int Nsrc, int Nout, bf16_t* WT, LAS float* scr, int lane, int gw, int NGW) {
    const int nblk = Nout / 32, nitems = (K / 64) * nblk;
    for (int it = gw; it < nitems; it += NGW) {
        const int kb = it / nblk, nb = it % nblk, k0 = 64 * kb, n0 = 32 * nb, np = n0 + (lane & 31);
        const float* colp;
        if (MODE == TR_PLAIN) colp = W0 + np;
        else if (MODE == TR_GU) { const int t = np >> 8, w = np & 255; colp = (w < 128 ? W0 : W1) + t * 128 + (w & 127); }
        else if (MODE == TR_WIN) colp = np < 1216 ? W0 + np : (np < 1280 ? nullptr : W0 + (np - 64));
        else if (MODE == TR_UQ) { const int h = np / 192, w = np % 192; colp = W0 + (w < 128 ? np : h * 192 + 128 + ((w - 128) >> 1) + ((w - 128) & 1) * 32); }
        else colp = np < 1024 ? W0 + np : W1 + (np - 1024);
        float tv[32];
#pragma unroll
        for (int i = 0; i < 32; ++i) { const int kk = 2 * i + (lane >> 5); tv[i] = colp ? colp[(size_t)(k0 + kk) * Nsrc] : 0.f; }
#pragma unroll
        for (int i = 0; i < 32; ++i) { const int kk = 2 * i + (lane >> 5); scr[kk * 33 + (lane & 31)] = tv[i]; }
        asm volatile("s_waitcnt lgkmcnt(0)" ::: "memory");
        const int c = lane & 7;
#pragma unroll
        for (int j = 0; j < 4; ++j) { const int n = (lane >> 3) + 8 * j; const LAS float* s = scr + (8 * c) * 33 + n;
            u32x4 o; o.x = cvt_pk_bf16(s[0 * 33], s[1 * 33]); o.y = cvt_pk_bf16(s[2 * 33], s[3 * 33]); o.z = cvt_pk_bf16(s[4 * 33], s[5 * 33]); o.w = cvt_pk_bf16(s[6 * 33], s[7 * 33]);
            *(u32x4*)(WT + (size_t)(n0 + n) * K + k0 + 8 * c) = o; }
        asm volatile("s_waitcnt lgkmcnt(0)" ::: "memory");
    }
}

template <int MODE>
__device__ __forceinline__ void rows_phase(const float* xin, const bf16_t* f, float wt, const float* gpost, const float* gnext, float* xout, bf16_t* xn, int gw, int NGW, int lane) {
    for (int row0 = gw; row0 < M; row0 += 2 * NGW) {
        f32x4 xv[2][4]; u32x2 fw[2][4];
#pragma unroll
        for (int r = 0; r < 2; ++r) { const size_t row = (size_t)(row0 + r * NGW);
#pragma unroll
            for (int j = 0; j < 4; ++j) { xv[r][j] = *(const f32x4*)(xin + row * DM + 4 * (lane + 64 * j));
                if (MODE != 0) fw[r][j] = *(const u32x2*)(f + row * DM + 4 * (lane + 64 * j)); } }
#pragma unroll
        for (int r = 0; r < 2; ++r) { const size_t row = (size_t)(row0 + r * NGW);
            if (MODE != 0) {
                f32x4 fv[4]; float ss = 0.f;
#pragma unroll
                for (int j = 0; j < 4; ++j) { fv[j] = (f32x4){bf_lo(fw[r][j].x), bf_hi(fw[r][j].x), bf_lo(fw[r][j].y), bf_hi(fw[r][j].y)}; ss += fv[j].x * fv[j].x + fv[j].y * fv[j].y + fv[j].z * fv[j].z + fv[j].w * fv[j].w; }
                const float rr = wt * __builtin_amdgcn_rsqf(wave_sum(ss) * (1.f / DM) + EPS);
#pragma unroll
                for (int j = 0; j < 4; ++j) { const f32x4 g = *(const f32x4*)(gpost + 4 * (lane + 64 * j)); xv[r][j] = xv[r][j] + fv[j] * g * rr; }
                if (MODE == 1) {
#pragma unroll
                    for (int j = 0; j < 4; ++j) *(f32x4*)(xout + row * DM + 4 * (lane + 64 * j)) = xv[r][j];
                }
            }
            float s2 = 0.f;
#pragma unroll
            for (int j = 0; j < 4; ++j) s2 += xv[r][j].x * xv[r][j].x + xv[r][j].y * xv[r][j].y + xv[r][j].z * xv[r][j].z + xv[r][j].w * xv[r][j].w;
            const float r2 = __builtin_amdgcn_rsqf(wave_sum(s2) * (1.f / DM) + EPS);
#pragma unroll
            for (int j = 0; j < 4; ++j) { const f32x4 g = *(const f32x4*)(gnext + 4 * (lane + 64 * j)); const f32x4 y = xv[r][j] * g * r2;
                if (MODE == 2) *(f32x4*)(xout + row * DM + 4 * (lane + 64 * j)) = y;
                else { u32x2 w; w.x = cvt_pk_bf16(y.x, y.y); w.y = cvt_pk_bf16(y.z, y.w); *(u32x2*)(xn + row * DM + 4 * (lane + 64 * j)) = w; } }
        }
    }
}

__global__ void __launch_bounds__(NTHREADS, 2) fwd_megakernel(Params p) {
    extern __shared__ __attribute__((aligned(16))) unsigned char lds[];
    cg::grid_group grid = cg::this_grid();
    volatile LAS unsigned* bst = (volatile LAS unsigned*)((LAS unsigned char*)lds + LDS_STAGE);
    if (threadIdx.x < 2) bst[threadIdx.x] = 0u;
    __syncthreads();
    const XcdBarrier xbar = xcd_barrier_post((unsigned*)(p.ws + OFF_BAR), bst);
#define GRID_SYNC_CG() do { __builtin_amdgcn_fence(__ATOMIC_RELEASE, "agent"); asm volatile("s_waitcnt vmcnt(0)" ::: "memory"); grid.sync(); \
        __builtin_amdgcn_fence(__ATOMIC_ACQUIRE, "agent"); asm volatile("s_waitcnt vmcnt(0)" ::: "memory"); } while (0)
#define GRID_SYNC() xcd_barrier(xbar)
    const int G = gridDim.x, bid = blockIdx.x, NGW = G * NWAVES;
    LAS unsigned char* ldsl = (LAS unsigned char*)lds;
#define PHASE_IDS() const int tid = fresh_tid(), lane = tid & 63, wave = tid >> 6, gw = bid * NWAVES + wave; LAS float* scr = (LAS float*)(ldsl + wave * 8448); (void)scr; (void)gw; (void)lane
    unsigned char* ws = p.ws;
    bf16_t* Wgu = (bf16_t*)(ws + OFF_WGU); bf16_t* Wd = (bf16_t*)(ws + OFF_WD); bf16_t* Win = (bf16_t*)(ws + OFF_WIN); bf16_t* Wuq = (bf16_t*)(ws + OFF_WUQ);
    bf16_t* Wukv = (bf16_t*)(ws + OFF_WUKV); bf16_t* Woa = (bf16_t*)(ws + OFF_WOA); bf16_t* Wp = (bf16_t*)(ws + OFF_WP); bf16_t* Wout = (bf16_t*)(ws + OFF_WOUT);
    bf16_t* XN = (bf16_t*)(ws + OFF_XN); bf16_t* F = (bf16_t*)(ws + OFF_F); float* ZF = (float*)(ws + OFF_ZF); bf16_t* KV = (bf16_t*)(ws + OFF_KV);
    bf16_t* H = (bf16_t*)(ws + OFF_H); bf16_t* O = (bf16_t*)(ws + OFF_O); bf16_t* CQN = (bf16_t*)(ws + OFF_CQN); bf16_t* CKVN = (bf16_t*)(ws + OFF_CKVN);
    float* TAB = (float*)(ws + OFF_TAB); bf16_t* Q = (bf16_t*)(ws + OFF_Q); bf16_t* KR = (bf16_t*)(ws + OFF_KR); bf16_t* Gt = (bf16_t*)(ws + OFF_G); bf16_t* DP = (bf16_t*)(ws + OFF_DP);
    float* X = p.out;
    float* xbuf0 = (float*)(ws + OFF_XBUF); unsigned* cnt0 = (unsigned*)(ws + OFF_CNT);

    { PHASE_IDS();
    tr_job<TR_GU>(p.f1_wg, p.f1_wu, 1024, DFF, 5632, Wgu, scr, lane, gw, NGW);
    tr_job<TR_PLAIN>(p.f1_wd, nullptr, DFF, 1024, 1024, Wd, scr, lane, gw, NGW);
    rows_phase<0>(p.x, nullptr, 0.f, nullptr, p.f1_pre, nullptr, XN, gw, NGW, lane); }
    if (__builtin_expect(p.out == nullptr, 0)) GRID_SYNC_CG();
    GRID_SYNC();

    pg8::StaticOrder S;
    { pg8::Gemm g{XN, Wgu, M, 5632, 1024}; S.init(M, 5632, G, bid); pg8::EpiSwiGLU E{H}; pg8::gemm_phase(ldsl, g, S, E); }
    {
        const int tail0 = (64 * 22) % G;
        if (tail0 != 0 && bid >= tail0) { PHASE_IDS(); const int tb = bid - tail0, nb = G - tail0, tgw = tb * NWAVES + wave, TNGW = nb * NWAVES;
            tr_job<TR_WIN>(p.w_in, nullptr, 1024, INW, 3328, Win, scr, lane, tgw, TNGW);
            tr_job<TR_UQ>(p.w_uq, nullptr, QL, 1536, 1536, Wuq, scr, lane, tgw, TNGW);
            tr_job<TR_UKV>(p.w_uk, p.w_uv, KVL, 1024, 2048, Wukv, scr, lane, tgw, TNGW);
            tr_job<TR_PLAIN>(p.w_oa, nullptr, 1024, 1024, 1024, Woa, scr, lane, tgw, TNGW);
            tr_job<TR_PLAIN>(p.w_out, nullptr, 1024, 1024, 1024, Wout, scr, lane, tgw, TNGW);
    for (int idx = tb * NTHREADS + tid; idx < 65536; idx += nb * NTHREADS) {
            const int n = idx & 1023, c8 = idx >> 10, g = c8 >> 4, cb = (c8 & 15) * 8;
            float a[8];
    #pragma unroll
            for (int i = 0; i < 8; ++i) a[i] = 0.f;
            for (int j0 = 0; j0 < 128; j0 += 8) { float w[8]; f32x4 pw[8][2];
    #pragma unroll
                for (int jj = 0; jj < 8; ++jj) w[jj] = p.w_op[(size_t)(g * 128 + j0 + jj) * 1024 + n] * p.pool_scale[g * 128 + j0 + jj];
    #pragma unroll
                for (int i = 0; i < 8; ++i) { pw[i][0] = *(const f32x4*)(p.pool_w + (size_t)(g * 128 + cb + i) * 128 + j0); pw[i][1] = *(const f32x4*)(p.pool_w + (size_t)(g * 128 + cb + i) * 128 + j0 + 4); }
    #pragma unroll
                for (int i = 0; i < 8; ++i)
    #pragma unroll
                    for (int jj = 0; jj < 8; ++jj) a[i] = fmaf(pw[i][jj >> 2][jj & 3], w[jj], a[i]); }
            u32x4 o; o.x = cvt_pk_bf16(a[0], a[1]); o.y = cvt_pk_bf16(a[2], a[3]); o.z = cvt_pk_bf16(a[4], a[5]); o.w = cvt_pk_bf16(a[6], a[7]);
            *(u32x4*)(Wp + (size_t)n * 512 + c8 * 8) = o;
        }
        }
        else if (tail0 == 0) { PHASE_IDS(); const int tb = bid, nb = G;
            tr_job<TR_WIN>(p.w_in, nullptr, 1024, INW, 3328, Win, scr, lane, gw, NGW);
            tr_job<TR_UQ>(p.w_uq, nullptr, QL, 1536, 1536, Wuq, scr, lane, gw, NGW);
            tr_job<TR_UKV>(p.w_uk, p.w_uv, KVL, 1024, 2048, Wukv, scr, lane, gw, NGW);
            tr_job<TR_PLAIN>(p.w_oa, nullptr, 1024, 1024, 1024, Woa, scr, lane, gw, NGW);
            tr_job<TR_PLAIN>(p.w_out, nullptr, 1024, 1024, 1024, Wout, scr, lane, gw, NGW);
    for (int idx = tb * NTHREADS + tid; idx < 65536; idx += nb * NTHREADS) {
            const int n = idx & 1023, c8 = idx >> 10, g = c8 >> 4, cb = (c8 & 15) * 8;
            float a[8];
    #pragma unroll
            for (int i = 0; i < 8; ++i) a[i] = 0.f;
            for (int j0 = 0; j0 < 128; j0 += 8) { float w[8]; f32x4 pw[8][2];
    #pragma unroll
                for (int jj = 0; jj < 8; ++jj) w[jj] = p.w_op[(size_t)(g * 128 + j0 + jj) * 1024 + n] * p.pool_scale[g * 128 + j0 + jj];
    #pragma unroll
                for (int i = 0; i < 8; ++i) { pw[i][0] = *(const f32x4*)(p.pool_w + (size_t)(g * 128 + cb + i) * 128 + j0); pw[i][1] = *(const f32x4*)(p.pool_w + (size_t)(g * 128 + cb + i) * 128 + j0 + 4); }
    #pragma unroll
                for (int i = 0; i < 8; ++i)
    #pragma unroll
                    for (int jj = 0; jj < 8; ++jj) a[i] = fmaf(pw[i][jj >> 2][jj & 3], w[jj], a[i]); }
            u32x4 o; o.x = cvt_pk_bf16(a[0], a[1]); o.y = cvt_pk_bf16(a[2], a[3]); o.z = cvt_pk_bf16(a[4], a[5]); o.w = cvt_pk_bf16(a[6], a[7]);
            *(u32x4*)(Wp + (size_t)n * 512 + c8 * 8) = o;
        }
        }
    }
    GRID_SYNC();
    { pg8::Gemm g{H, Wd, M, 1024, DFF}; S.init(M, 1024, G, bid);
      pg8::EpiResNorm<false> E{p.x, X, XN, 0.5f, p.f1_post, p.mix_pre, pg8::PanelSumSq{xbuf0, cnt0}, pg8::PanelSumSq{xbuf0 + (size_t)M * 4, cnt0 + 4096}}; pg8::gemm_phase(ldsl, g, S, E); }
    GRID_SYNC();
    { pg8::Gemm g{XN, Win, M, 1280, 1024}; S.init(M, 1280, G, bid); pg8::EpiBf16 E{(bf16_t*)ZF, 1280}; pg8::gemm_phase(ldsl, g, S, E); }
    {
        const int tail0 = (64 * 5) % G; PHASE_IDS();
        if (tail0 != 0 && bid >= tail0) { const int tgw = (bid - tail0) * NWAVES + wave, TNGW = (G - tail0) * NWAVES;
            tr_job<TR_GU>(p.f2_wg, p.f2_wu, 1024, DFF, 5632, Wgu, scr, lane, tgw, TNGW);
            tr_job<TR_PLAIN>(p.f2_wd, nullptr, DFF, 1024, 1024, Wd, scr, lane, tgw, TNGW); }
        else if (tail0 == 0) { tr_job<TR_GU>(p.f2_wg, p.f2_wu, 1024, DFF, 5632, Wgu, scr, lane, gw, NGW); tr_job<TR_PLAIN>(p.f2_wd, nullptr, DFF, 1024, 1024, Wd, scr, lane, gw, NGW); }
    }
    GRID_SYNC();
    { PHASE_IDS();
    const bf16_t* ZB = (const bf16_t*)ZF;
    const int t_g = lane >> 4, wnd = 2 << t_g;
    for (int k = 0; k < M / (NWAVES * 256); ++k) { const int row = gw * (M / (NWAVES * 256)) + k;
        const bf16_t* z = ZB + (size_t)row * 1280;
        const u32x4 qa = *(const u32x4*)(z + 8 * lane);
        u32x4 qb = (u32x4){0u, 0u, 0u, 0u}; if (lane < 16) qb = *(const u32x4*)(z + 512 + 8 * lane);
        const u32x4 pc = *(const u32x4*)(z + 704 + 8 * lane);
        float kx1 = 0.f, kx2 = 0.f; int pos = 0;
        if (lane < 32) { kx1 = bf_lo((unsigned)z[640 + lane]); kx2 = bf_lo((unsigned)z[672 + lane]); pos = p.pos[row]; }
        const int t = row & (SEQ - 1), lo = max(t - (wnd >> 1), 0), hi = min(t + wnd - (wnd >> 1), SEQ);
        float sacc[8];
#pragma unroll
        for (int i = 0; i < 8; ++i) sacc[i] = 0.f;
#pragma unroll
        for (int hb = 0; hb < 2; ++hb) { u32x4 nb[8]; float wv[8];
#pragma unroll
            for (int d = 0; d < 8; ++d) { const int tt = t - 8 + hb * 8 + d; const bool ok = (tt >= lo) && (tt < hi); wv[d] = ok ? 1.f : 0.f;
                nb[d] = *(const u32x4*)(z + 704 + 8 * lane + (long)(ok ? (tt - t) : 0) * 1280); }
#pragma unroll
            for (int d = 0; d < 8; ++d) { sacc[0] = fmaf(wv[d], bf_lo(nb[d].x), sacc[0]); sacc[1] = fmaf(wv[d], bf_hi(nb[d].x), sacc[1]); sacc[2] = fmaf(wv[d], bf_lo(nb[d].y), sacc[2]); sacc[3] = fmaf(wv[d], bf_hi(nb[d].y), sacc[3]);
                sacc[4] = fmaf(wv[d], bf_lo(nb[d].z), sacc[4]); sacc[5] = fmaf(wv[d], bf_hi(nb[d].z), sacc[5]); sacc[6] = fmaf(wv[d], bf_lo(nb[d].w), sacc[6]); sacc[7] = fmaf(wv[d], bf_hi(nb[d].w), sacc[7]); } }
        {
            const float inv = 1.f / (float)(hi - lo);
            u32x4 w; w.x = cvt_pk_bf16(sacc[0] * inv - bf_lo(pc.x), sacc[1] * inv - bf_hi(pc.x)); w.y = cvt_pk_bf16(sacc[2] * inv - bf_lo(pc.y), sacc[3] * inv - bf_hi(pc.y));
            w.z = cvt_pk_bf16(sacc[4] * inv - bf_lo(pc.z), sacc[5] * inv - bf_hi(pc.z)); w.w = cvt_pk_bf16(sacc[6] * inv - bf_lo(pc.w), sacc[7] * inv - bf_hi(pc.w));
            *(u32x4*)(DP + (size_t)row * 512 + 8 * lane) = w; }
        {
            float va[8] = {bf_lo(qa.x), bf_hi(qa.x), bf_lo(qa.y), bf_hi(qa.y), bf_lo(qa.z), bf_hi(qa.z), bf_lo(qa.w), bf_hi(qa.w)};
            float vb[8] = {bf_lo(qb.x), bf_hi(qb.x), bf_lo(qb.y), bf_hi(qb.y), bf_lo(qb.z), bf_hi(qb.z), bf_lo(qb.w), bf_hi(qb.w)};
            float sa = 0.f, sb = 0.f;
#pragma unroll
            for (int i = 0; i < 8; ++i) { sa = fmaf(va[i], va[i], sa); sb = fmaf(vb[i], vb[i], sb); }
            const float ssq = wave_sum(lane < 48 ? sa : 0.f), sskv = wave_sum((lane >= 48 ? sa : 0.f) + sb);
            const float rq = __builtin_amdgcn_rsqf(ssq * (1.f / QL) + EPS), rkv = __builtin_amdgcn_rsqf(sskv * (1.f / KVL) + EPS);
            const float* ga = lane < 48 ? p.qa_g + 8 * lane : p.kva_g + 8 * (lane - 48); const float ra = lane < 48 ? rq : rkv;
            const f32x4 g0 = *(const f32x4*)ga, g1 = *(const f32x4*)(ga + 4);
            u32x4 w; w.x = cvt_pk_bf16(va[0] * g0.x * ra, va[1] * g0.y * ra); w.y = cvt_pk_bf16(va[2] * g0.z * ra, va[3] * g0.w * ra); w.z = cvt_pk_bf16(va[4] * g1.x * ra, va[5] * g1.y * ra); w.w = cvt_pk_bf16(va[6] * g1.z * ra, va[7] * g1.w * ra);
            bf16_t* dst = lane < 48 ? CQN + (size_t)row * QL + 8 * lane : CKVN + (size_t)row * KVL + 8 * (lane - 48);
            *(u32x4*)dst = w;
            if (lane < 16) { const f32x4 h0 = *(const f32x4*)(p.kva_g + 128 + 8 * lane), h1 = *(const f32x4*)(p.kva_g + 132 + 8 * lane);
                u32x4 w2; w2.x = cvt_pk_bf16(vb[0] * h0.x * rkv, vb[1] * h0.y * rkv); w2.y = cvt_pk_bf16(vb[2] * h0.z * rkv, vb[3] * h0.w * rkv); w2.z = cvt_pk_bf16(vb[4] * h1.x * rkv, vb[5] * h1.y * rkv); w2.w = cvt_pk_bf16(vb[6] * h1.z * rkv, vb[7] * h1.w * rkv);
                *(u32x4*)(CKVN + (size_t)row * KVL + 128 + 8 * lane) = w2; }
        }
        if (lane < 32) {
            const float ang = (float)pos * p.inv_freq[lane];
            const double ad = (double)ang; const double kq = rint(ad * 0.15915494309189535); const float red = (float)(ad - kq * 6.283185307179586);
            const float cs = __cosf(red), sn = __sinf(red);
            TAB[(size_t)row * 64 + lane] = cs; TAB[(size_t)row * 64 + 32 + lane] = sn;
            *(unsigned*)(KR + (size_t)row * 64 + 2 * lane) = cvt_pk_bf16(kx1 * cs - kx2 * sn, kx2 * cs + kx1 * sn);
        }
    } }
    GRID_SYNC();
    { pg8::Gemm g{CQN, Wuq, M, 1536, QL}; S.init(M, 1536, G, bid); pg8::EpiQ E{Q, TAB}; pg8::gemm_phase(ldsl, g, S, E); }
    { pg8::Gemm g{CKVN, Wukv, M, 2048, KVL}; S.init(M, 2048, G, bid); pg8::EpiBf16 E{KV, 2048}; pg8::gemm_phase(ldsl, g, S, E); }
    GRID_SYNC();
    {
        const int vcu = (bid & 7) * (G >> 3) + (bid >> 3);
        for (int it = vcu; it < NB * NH * (SEQ / 256); it += G) {
            const int qb = it & 7, h = (it >> 3) & 7, b = it >> 6;
            const size_t tok0 = (size_t)b * SEQ;
            att::attn_body(Q + (tok0 + qb * 256) * 1536 + h * 192, KV + tok0 * 2048 + h * 128, KR + tok0 * 64, KV + tok0 * 2048 + 1024 + h * 128,
                           O + (tok0 + qb * 256) * 1024 + h * 128, SEQ, (char*)lds);
            __syncthreads();
        }
    }
    GRID_SYNC();
    { pg8::Gemm g{XN, Win + (size_t)1280 * 1024, M, 2048, 1024}; S.init(M, 2048, G, bid); pg8::EpiGate E{Gt}; pg8::gemm_phase(ldsl, g, S, E); }
    GRID_SYNC();
    { pg8::Gemm g{O, Woa, M, 1024, 1024}; S.init(M, 1024, G, bid); pg8::EpiT1 E{Gt, F}; pg8::gemm_phase(ldsl, g, S, E); }
    { pg8::Gemm g{DP, Wp, M, 1024, 512}; S.init(M, 1024, G, bid); pg8::EpiMX E{Gt, F, XN}; pg8::gemm_phase(ldsl, g, S, E); }
    GRID_SYNC();
    { pg8::Gemm g{XN, Wout, M, 1024, 1024}; S.init(M, 1024, G, bid);
      pg8::EpiResNorm<false> E{X, X, XN, 1.0f, p.mix_post, p.f2_pre, pg8::PanelSumSq{xbuf0 + (size_t)M * 8, cnt0 + 2 * 4096}, pg8::PanelSumSq{xbuf0 + (size_t)M * 12, cnt0 + 3 * 4096}}; pg8::gemm_phase(ldsl, g, S, E); }
    GRID_SYNC();
    { pg8::Gemm g{XN, Wgu, M, 5632, 1024}; S.init(M, 5632, G, bid); pg8::EpiSwiGLU E{H}; pg8::gemm_phase(ldsl, g, S, E); }
    GRID_SYNC();
    { pg8::Gemm g{H, Wd, M, 1024, DFF}; S.init(M, 1024, G, bid);
      pg8::EpiResNorm<true> E{X, X, nullptr, 0.5f, p.f2_post, p.final_g, pg8::PanelSumSq{xbuf0 + (size_t)M * 16, cnt0 + 4 * 4096}, pg8::PanelSumSq{xbuf0 + (size_t)M * 20, cnt0 + 5 * 4096}}; pg8::gemm_phase(ldsl, g, S, E); }
}

extern "C" void kernel_launch(void* const* d_in, const int* in_sizes, int n_in, void* d_out, int out_size, void* d_ws, size_t ws_size, hipStream_t stream) {
    static int grid_blocks = 0;
    if (grid_blocks == 0) {
        if (n_in != 26 || in_sizes[0] != M * DM || out_size != M * DM || ws_size < WS_END) { fprintf(stderr, "kernel_launch: shape mismatch n_in %d in0 %d out %d ws %zu\n", n_in, n_in > 0 ? in_sizes[0] : -1, out_size, ws_size); grid_blocks = -1; return; }
        int dev = 0, cus = 0, per_cu = 0;
        (void)hipGetDevice(&dev);
        (void)hipDeviceGetAttribute(&cus, hipDeviceAttributeMultiprocessorCount, dev);
        if (hipFuncSetAttribute((const void*)fwd_megakernel, hipFuncAttributeMaxDynamicSharedMemorySize, LDS_BYTES) != hipSuccess) { fprintf(stderr, "kernel_launch: hipFuncSetAttribute failed\n"); grid_blocks = -1; return; }
        if (hipOccupancyMaxActiveBlocksPerMultiprocessor(&per_cu, (const void*)fwd_megakernel, NTHREADS, LDS_BYTES) != hipSuccess || per_cu < 1) { fprintf(stderr, "kernel_launch: occupancy query failed (%d)\n", per_cu); (void)hipGetLastError(); per_cu = 1; }
        grid_blocks = cus * 1;
        if (grid_blocks != 256) { fprintf(stderr, "kernel_launch: built for 256 CUs (one workgroup each), device has %d\n", cus); grid_blocks = -1; return; }
    }
    if (grid_blocks < 0) return;
    Params p{};
    p.x = (const float*)d_in[0]; p.pos = (const int*)d_in[1];
    p.f1_pre = (const float*)d_in[2]; p.f1_wg = (const float*)d_in[3]; p.f1_wu = (const float*)d_in[4]; p.f1_wd = (const float*)d_in[5]; p.f1_post = (const float*)d_in[6];
    p.mix_pre = (const float*)d_in[7]; p.w_in = (const float*)d_in[8]; p.qa_g = (const float*)d_in[9]; p.w_uq = (const float*)d_in[10]; p.kva_g = (const float*)d_in[11];
    p.w_uk = (const float*)d_in[12]; p.w_uv = (const float*)d_in[13]; p.w_oa = (const float*)d_in[14]; p.pool_w = (const float*)d_in[15]; p.pool_scale = (const float*)d_in[16];
    p.w_op = (const float*)d_in[17]; p.w_out = (const float*)d_in[18]; p.mix_post = (const float*)d_in[19];
    p.f2_pre = (const float*)d_in[20]; p.f2_wg = (const float*)d_in[21]; p.f2_wu = (const float*)d_in[22]; p.f2_wd = (const float*)d_in[23]; p.f2_post = (const float*)d_in[24]; p.final_g = (const float*)d_in[25];
    p.out = (float*)d_out; p.ws = (unsigned char*)d_ws;
    for (int i = 0; i < 32; ++i) p.inv_freq[i] = (float)pow(10000.0, -(2.0 * i) / 64.0);
    if (hipMemsetAsync((char*)d_ws + OFF_BAR, 0, CTL_BYTES, stream) != hipSuccess) { fprintf(stderr, "kernel_launch: memset failed\n"); return; }
    void* args[] = {&p};
    hipError_t e = hipLaunchCooperativeKernel((const void*)fwd_megakernel, dim3(grid_blocks), dim3(NTHREADS), args, LDS_BYTES, stream);
    if (e != hipSuccess) fprintf(stderr, "cooperative launch failed: %s (grid %d)\n", hipGetErrorString(e), grid_blocks);
}
```

```cpp
#include <hip/hip_runtime.h>
#include <hip/hip_cooperative_groups.h>
#include <cstdio>
#include <cmath>
#include <cstdint>
namespace cg = cooperative_groups;

#define LAS __attribute__((address_space(3)))
typedef unsigned short bf16_t;
typedef short bf16x8 __attribute__((ext_vector_type(8)));
typedef short s16x4 __attribute__((ext_vector_type(4)));
typedef float f32x2 __attribute__((ext_vector_type(2)));
typedef float f32x4 __attribute__((ext_vector_type(4)));
typedef float f32x16 __attribute__((ext_vector_type(16)));
typedef unsigned u32x4 __attribute__((ext_vector_type(4)));
typedef unsigned u32x2 __attribute__((ext_vector_type(2)));

constexpr int DM = 1024, NB = 8, SEQ = 2048, M = NB * SEQ, NH = 8, QL = 384, KVL = 256, DFF = 2816, INW = 3264;
constexpr float EPS = 1e-6f;
constexpr int NTHREADS = 512, NWAVES = 8;
constexpr int LDS_STAGE = 131072, LDS_BYTES = LDS_STAGE + 16;

constexpr size_t MiB = 1048576;
constexpr size_t OFF_WGU = 0;
constexpr size_t OFF_WD = OFF_WGU + (size_t)5632 * 1024 * 2;
constexpr size_t OFF_WIN = OFF_WD + (size_t)1024 * 2816 * 2;
constexpr size_t OFF_WUQ = OFF_WIN + (size_t)3328 * 1024 * 2;
constexpr size_t OFF_WUKV = OFF_WUQ + (size_t)1536 * 384 * 2;
constexpr size_t OFF_WOA = OFF_WUKV + (size_t)2048 * 256 * 2;
constexpr size_t OFF_WP = OFF_WOA + (size_t)1024 * 1024 * 2;
constexpr size_t OFF_WOUT = OFF_WP + (size_t)1024 * 512 * 2;
constexpr size_t OFF_XN = OFF_WOUT + (size_t)1024 * 1024 * 2;
constexpr size_t OFF_R = OFF_XN + 32 * MiB;
constexpr size_t OFF_F = OFF_R;
constexpr size_t OFF_ZF = OFF_R;
constexpr size_t OFF_KV = OFF_R;
constexpr size_t OFF_H = OFF_R + 64 * MiB;
constexpr size_t OFF_O = OFF_R + 64 * MiB;
constexpr size_t OFF_CQN = OFF_R + 80 * MiB;
constexpr size_t OFF_CKVN = OFF_R + 92 * MiB;
constexpr size_t OFF_TAB = OFF_R + 100 * MiB;
constexpr size_t OFF_Q = OFF_R + 104 * MiB;
constexpr size_t OFF_KR = OFF_R + 152 * MiB;
constexpr size_t OFF_G = OFF_R + 96 * MiB;
constexpr size_t OFF_DP = OFF_R + 176 * MiB;
constexpr size_t WS_END = OFF_R + 192 * MiB;
constexpr size_t OFF_BAR = WS_END, OFF_CNT = OFF_BAR + 16384, CTL_BYTES = 16384 + 6 * 16384, OFF_XBUF = OFF_BAR + CTL_BYTES;
static_assert(OFF_XBUF + 6 * (size_t)M * 16 <= 256 * MiB, "workspace");

struct Params {
    const float* x; const int* pos;
    const float *f1_pre, *f1_wg, *f1_wu, *f1_wd, *f1_post;
    const float *mix_pre, *w_in, *qa_g, *w_uq, *kva_g, *w_uk, *w_uv, *w_oa, *pool_w, *pool_scale, *w_op, *w_out, *mix_post;
    const float *f2_pre, *f2_wg, *f2_wu, *f2_wd, *f2_post, *final_g;
    float* out; unsigned char* ws;
    float inv_freq[32];
};

typedef __bf16 bf16x2_t __attribute__((ext_vector_type(2)));
__device__ __forceinline__ unsigned cvt_pk_bf16(float lo, float hi) { const f32x2 v = {lo, hi}; const bf16x2_t r = __builtin_convertvector(v, bf16x2_t); return __builtin_bit_cast(unsigned, r); }
__device__ __forceinline__ float bf_lo(unsigned w) { return __uint_as_float(w << 16); }
__device__ __forceinline__ float bf_hi(unsigned w) { return __uint_as_float(w & 0xffff0000u); }
__device__ __forceinline__ float sigmoidf_fast(float z) { return __builtin_amdgcn_rcpf(1.f + __builtin_amdgcn_exp2f(-1.4426950408889634f * z)); }
__device__ __forceinline__ int fresh_tid() { int t = threadIdx.x; asm volatile("" : "+v"(t)); return t; }
__device__ __forceinline__ float wave_sum(float v) {
#pragma unroll
    for (int o = 1; o < 64; o <<= 1) v += __shfl_xor(v, o);
    return v;
}

namespace pg8 {
constexpr int BM = 256, BK = 64, HALF = 128, HTB = HALF * BK * 2, STAGE_BYTES = 8 * HTB, NXCD = 8, WGM = 4;
__host__ __device__ __forceinline__ int lds_byte(int r, int c) { const int st = (r >> 4) * 2 + (c >> 5), rr = r & 15, cc = c & 31, ob = rr * 64 + cc * 2; return st * 1024 + (ob ^ (((ob >> 9) & 1) << 5)); }
__host__ __device__ __forceinline__ void stage_rc(int b, int& R, int& C) { const int st = b / 1024, sb = b % 1024, swz = sb ^ (((sb >> 9) & 1) << 5); R = (st >> 1) * 16 + swz / 64; C = (st & 1) * 32 + (swz % 64) / 2; }
__host__ __device__ __forceinline__ int perm32(int rho) { const int n = rho >> 4, i = rho & 15; return 8 * (i >> 2) + 4 * n + (i & 3); }
struct Unit { int pm, pn; };
struct Gemm { const bf16_t* A; const bf16_t* Bt; int M, N, K; };
struct StaticOrder {
    int nM, nN, nwg, G, c;
    __device__ void init(int M_, int N_, int G_, int c_) { nM = M_ / BM; nN = N_ / BM; nwg = nM * nN; G = G_; c = c_; }
    __device__ bool next(int i, Unit& u) const {
        const long L = (long)i * G + c; if (L >= nwg) return false;
        int wgid = (int)L; { const int q = nwg / NXCD, r = nwg % NXCD, xcd = wgid % NXCD, off = wgid / NXCD; wgid = (xcd < r ? xcd * (q + 1) : r * (q + 1) + (xcd - r) * q) + off; }
        const int nig = WGM * nN, gid = wgid / nig, fm = gid * WGM, gsz = (nM - fm) < WGM ? (nM - fm) : WGM;
        u.pm = fm + ((wgid % nig) % gsz); u.pn = (wgid % nig) / gsz; return true;
    }
};

template <class Epi>
__device__ __forceinline__ void gemm_phase(LAS unsigned char* lds, const Gemm g, const StaticOrder& S, const Epi& E) {
    const int tid = fresh_tid(), wid = __builtin_amdgcn_readfirstlane(tid >> 6), lane = tid & 63, wr = wid >> 2, wc = wid & 3, fr = lane & 15, fq = lane >> 4;
    const int K = g.K, nt = K / BK;
    unsigned voffA, voffB;
    { int R, C; stage_rc(tid * 16, R, C); const int Rb = Epi::PERM ? ((R & ~31) + perm32(R & 31)) : R;
      voffA = (unsigned)(R * K + C) * 2u; voffB = (unsigned)(Rb * K + C) * 2u; }
    const size_t rstep64 = (size_t)64 * K * 2;
    const size_t kstep = (size_t)(BK * 2);
    const size_t hstep = (size_t)HALF * K * 2;
    const size_t tstep = 2 * hstep;
    const unsigned ldsw = (unsigned)wid * 1024u;
    const int aoff = lds_byte(wr * 64 + fr, fq * 8), boff = lds_byte(wc * 32 + fr, fq * 8);
#define PG8_SA(b, h) (((b) * 2 + (h)) * HTB)
#define PG8_SB(b, h) ((4 + (b) * 2 + (h)) * HTB)
#define PG8_STAGE(bufoff, gbase, voff) do { _Pragma("unroll") for (int _i = 0; _i < 2; ++_i) \
        __builtin_amdgcn_global_load_lds((const unsigned*)((const char*)(gbase) + _i * rstep64 + (voff)), (LAS unsigned*)(lds + (bufoff) + ldsw + _i * 8192), 16, 0, 0); } while (0)
#define PG8_LDA(dst, b, h) do { _Pragma("unroll") for (int m = 0; m < 4; ++m) _Pragma("unroll") for (int k = 0; k < 2; ++k) dst[m][k] = *(const LAS bf16x8*)(lds + PG8_SA(b, h) + aoff + m * 2048 + k * 1024); } while (0)
#define PG8_LDB(dst, b, h) do { _Pragma("unroll") for (int n = 0; n < 2; ++n) _Pragma("unroll") for (int k = 0; k < 2; ++k) dst[n][k] = *(const LAS bf16x8*)(lds + PG8_SB(b, h) + boff + n * 2048 + k * 1024); } while (0)
#define PG8_MMA(ai, bj, At, Bt) do { __builtin_amdgcn_s_setprio(1); _Pragma("unroll") for (int m = 0; m < 4; ++m) _Pragma("unroll") for (int n = 0; n < 2; ++n) _Pragma("unroll") for (int k = 0; k < 2; ++k) \
        acc[ai][bj][m][n] = __builtin_amdgcn_mfma_f32_16x16x32_bf16(Bt[n][k], At[m][k], acc[ai][bj][m][n], 0, 0, 0); __builtin_amdgcn_s_setprio(0); } while (0)
#define PG8_WAIT_V(n) asm volatile("s_waitcnt vmcnt(" #n ")" ::: "memory")
#define PG8_WAIT_L(n) asm volatile("s_waitcnt lgkmcnt(" #n ")" ::: "memory")
#define PG8_BAR __builtin_amdgcn_s_barrier()
#define PG8_SCHED __builtin_amdgcn_sched_barrier(0)
    Unit cur, nxt; int ui = 0;
    if (!S.next(0, cur)) return;
    f32x4 acc[2][2][4][2];
#pragma unroll
    for (int a = 0; a < 2; ++a)
#pragma unroll
        for (int b = 0; b < 2; ++b)
#pragma unroll
            for (int m = 0; m < 4; ++m)
#pragma unroll
                for (int n = 0; n < 2; ++n) acc[a][b][m][n] = (f32x4){0.f, 0.f, 0.f, 0.f};
    bf16x8 At[4][2], B0[2][2], B1[2][2];
    const char* cA = (const char*)g.A + (size_t)cur.pm * tstep; const char* cB = (const char*)g.Bt + (size_t)cur.pn * tstep;
    PG8_STAGE(PG8_SB(0, 0), cB, voffB); PG8_STAGE(PG8_SA(0, 0), cA, voffA); PG8_STAGE(PG8_SB(0, 1), cB + hstep, voffB); PG8_STAGE(PG8_SA(0, 1), cA + hstep, voffA);
    if (wr == 1) PG8_BAR;
    PG8_WAIT_V(4); PG8_BAR;
    PG8_STAGE(PG8_SB(1, 0), cB + kstep, voffB); PG8_STAGE(PG8_SA(1, 0), cA + kstep, voffA); PG8_STAGE(PG8_SB(1, 1), cB + hstep + kstep, voffB);
    PG8_WAIT_V(6); PG8_BAR;
    for (;;) {
        const bool has_next = S.next(ui + 1, nxt);
        const char* nA = has_next ? (const char*)g.A + (size_t)nxt.pm * tstep : cA; const char* nB = has_next ? (const char*)g.Bt + (size_t)nxt.pn * tstep : cB;
        for (int t = 0; t < nt; t += 2) {
            const bool last = (t == nt - 2);
            const char* a1 = cA + (size_t)(t + 1) * kstep;
            const char* a2 = last ? nA : cA + (size_t)(t + 2) * kstep; const char* b2 = last ? nB : cB + (size_t)(t + 2) * kstep;
            const char* a3 = a2 + kstep; const char* b3 = b2 + kstep;
            PG8_LDB(B0, 0, 0); PG8_SCHED; PG8_LDA(At, 0, 0); PG8_STAGE(PG8_SA(1, 1), a1 + hstep, voffA);
            PG8_WAIT_L(8); PG8_BAR; PG8_WAIT_L(0); PG8_MMA(0, 0, At, B0); PG8_BAR; PG8_SCHED;
            PG8_LDB(B1, 0, 1); PG8_STAGE(PG8_SB(0, 0), b2, voffB);
            PG8_BAR; PG8_WAIT_L(0); PG8_MMA(0, 1, At, B1); PG8_BAR;
            PG8_LDA(At, 0, 1); PG8_STAGE(PG8_SA(0, 0), a2, voffA);
            PG8_BAR; PG8_WAIT_L(0); PG8_MMA(1, 0, At, B0); PG8_BAR; PG8_SCHED;
            PG8_STAGE(PG8_SB(0, 1), b2 + hstep, voffB);
            PG8_WAIT_V(6); PG8_BAR; PG8_MMA(1, 1, At, B1); PG8_BAR;
            PG8_LDB(B0, 1, 0); PG8_SCHED; PG8_LDA(At, 1, 0); PG8_STAGE(PG8_SA(0, 1), a2 + hstep, voffA);
            PG8_WAIT_L(8); PG8_BAR; PG8_WAIT_L(0); PG8_MMA(0, 0, At, B0); PG8_BAR; PG8_SCHED;
            PG8_LDB(B1, 1, 1); PG8_STAGE(PG8_SB(1, 0), b3, voffB);
            PG8_BAR; PG8_WAIT_L(0); PG8_MMA(0, 1, At, B1); PG8_BAR;
            PG8_LDA(At, 1, 1); PG8_STAGE(PG8_SA(1, 0), a3, voffA);
            PG8_BAR; PG8_WAIT_L(0); PG8_MMA(1, 0, At, B0); PG8_BAR; PG8_SCHED;
            PG8_STAGE(PG8_SB(1, 1), b3 + hstep, voffB);
            PG8_WAIT_V(6); PG8_BAR; PG8_MMA(1, 1, At, B1); PG8_BAR;
        }
        if constexpr (!Epi::AFTER_DRAIN) { const int t2 = fresh_tid(); E(acc, cur, wr, wc, t2 & 15, (t2 >> 4) & 3); }
        if (!has_next) break;
#pragma unroll
        for (int a = 0; a < 2; ++a)
#pragma unroll
            for (int b = 0; b < 2; ++b)
#pragma unroll
                for (int m = 0; m < 4; ++m)
#pragma unroll
                    for (int n = 0; n < 2; ++n) acc[a][b][m][n] = (f32x4){0.f, 0.f, 0.f, 0.f};
        cur = nxt; cA = nA; cB = nB; ++ui;
    }
    PG8_WAIT_V(0);
    if (wr == 0) PG8_BAR;
    PG8_BAR;
    if constexpr (Epi::AFTER_DRAIN) { const int t2 = fresh_tid(); E.fused(acc, cur, wr, wc, t2 & 15, (t2 >> 4) & 3, lds, t2 >> 6, t2 & 63); }
#undef PG8_SA
#undef PG8_SB
#undef PG8_STAGE
#undef PG8_LDA
#undef PG8_LDB
#undef PG8_MMA
#undef PG8_WAIT_V
#undef PG8_WAIT_L
#undef PG8_BAR
#undef PG8_SCHED
}

typedef f32x4 Acc[2][2][4][2];
struct EpiF32 {
    static constexpr bool PERM = false, AFTER_DRAIN = false;
    float* C; int ldc;
    __device__ __forceinline__ void operator()(const Acc& acc, const Unit& u, int wr, int wc, int fr, int fq) const {
        const int row0 = u.pm * BM + wr * 64 + fr, col0 = u.pn * BM + wc * 32 + 4 * fq;
#pragma unroll
        for (int ai = 0; ai < 2; ++ai)
#pragma unroll
            for (int m = 0; m < 4; ++m) { float* rowp = C + (size_t)(row0 + ai * HALF + m * 16) * ldc + col0;
#pragma unroll
                for (int bj = 0; bj < 2; ++bj)
#pragma unroll
                    for (int n = 0; n < 2; ++n) *(f32x4*)(rowp + bj * HALF + n * 16) = acc[ai][bj][m][n]; }
    }
};
struct EpiBf16 {
    static constexpr bool PERM = true, AFTER_DRAIN = false;
    bf16_t* O; int ldc;
    __device__ __forceinline__ void operator()(const Acc& acc, const Unit& u, int wr, int wc, int fr, int fq) const {
        const int row0 = u.pm * BM + wr * 64 + fr, col0 = u.pn * BM + wc * 32 + 8 * fq;
#pragma unroll
        for (int ai = 0; ai < 2; ++ai)
#pragma unroll
            for (int m = 0; m < 4; ++m) { bf16_t* rowp = O + (size_t)(row0 + ai * HALF + m * 16) * ldc + col0;
#pragma unroll
                for (int bj = 0; bj < 2; ++bj) { const f32x4 v0 = acc[ai][bj][m][0], v1 = acc[ai][bj][m][1];
                    u32x4 w; w.x = cvt_pk_bf16(v0[0], v0[1]); w.y = cvt_pk_bf16(v0[2], v0[3]); w.z = cvt_pk_bf16(v1[0], v1[1]); w.w = cvt_pk_bf16(v1[2], v1[3]);
                    *(u32x4*)(rowp + bj * HALF) = w; } }
    }
};
struct EpiSwiGLU {
    static constexpr bool PERM = true, AFTER_DRAIN = false;
    bf16_t* H;
    __device__ __forceinline__ void operator()(const Acc& acc, const Unit& u, int wr, int wc, int fr, int fq) const {
        const int row0 = u.pm * BM + wr * 64 + fr, col0 = u.pn * HALF + wc * 32 + 8 * fq;
#pragma unroll
        for (int ai = 0; ai < 2; ++ai)
#pragma unroll
            for (int m = 0; m < 4; ++m) { bf16_t* rowp = H + (size_t)(row0 + ai * HALF + m * 16) * DFF + col0;
                float h[8];
#pragma unroll
                for (int n = 0; n < 2; ++n)
#pragma unroll
                    for (int j = 0; j < 4; ++j) { const float gt = acc[ai][0][m][n][j], up = acc[ai][1][m][n][j]; h[n * 4 + j] = gt * sigmoidf_fast(gt) * up; }
                u32x4 w; w.x = cvt_pk_bf16(h[0], h[1]); w.y = cvt_pk_bf16(h[2], h[3]); w.z = cvt_pk_bf16(h[4], h[5]); w.w = cvt_pk_bf16(h[6], h[7]);
                *(u32x4*)rowp = w; }
    }
};
struct EpiGate {
    static constexpr bool PERM = true, AFTER_DRAIN = false;
    bf16_t* G;
    __device__ __forceinline__ void operator()(const Acc& acc, const Unit& u, int wr, int wc, int fr, int fq) const {
        const int row0 = u.pm * BM + wr * 64 + fr, col0 = u.pn * BM + wc * 32 + 8 * fq;
#pragma unroll
        for (int ai = 0; ai < 2; ++ai)
#pragma unroll
            for (int m = 0; m < 4; ++m) { bf16_t* rowp = G + (size_t)(row0 + ai * HALF + m * 16) * 2048 + col0;
#pragma unroll
                for (int bj = 0; bj < 2; ++bj) { const f32x4 v0 = acc[ai][bj][m][0], v1 = acc[ai][bj][m][1];
                    u32x4 w; w.x = cvt_pk_bf16(sigmoidf_fast(v0[0]), sigmoidf_fast(v0[1])); w.y = cvt_pk_bf16(sigmoidf_fast(v0[2]), sigmoidf_fast(v0[3]));
                    w.z = cvt_pk_bf16(sigmoidf_fast(v1[0]), sigmoidf_fast(v1[1])); w.w = cvt_pk_bf16(sigmoidf_fast(v1[2]), sigmoidf_fast(v1[3]));
                    *(u32x4*)(rowp + bj * HALF) = w; } }
    }
};
struct EpiQ {
    static constexpr bool PERM = true, AFTER_DRAIN = false;
    bf16_t* Q; const float* TAB;
    __device__ __forceinline__ void operator()(const Acc& acc, const Unit& u, int wr, int wc, int fr, int fq) const {
        const int row0 = u.pm * BM + wr * 64 + fr, col0 = u.pn * BM + wc * 32 + 8 * fq;
#pragma unroll
        for (int ai = 0; ai < 2; ++ai)
#pragma unroll
            for (int m = 0; m < 4; ++m) { const int row = row0 + ai * HALF + m * 16; bf16_t* rowp = Q + (size_t)row * 1536 + col0;
#pragma unroll
                for (int bj = 0; bj < 2; ++bj) { f32x4 v0 = acc[ai][bj][m][0], v1 = acc[ai][bj][m][1];
                    const int c = col0 + bj * HALF, w = c % 192;
                    if (w >= 128) { const int i0 = (w - 128) >> 1; const f32x4 cs = *(const f32x4*)(TAB + (size_t)row * 64 + i0), sn = *(const f32x4*)(TAB + (size_t)row * 64 + 32 + i0);
                        f32x4 r0, r1;
                        r0[0] = v0[0] * cs[0] - v0[1] * sn[0]; r0[1] = v0[1] * cs[0] + v0[0] * sn[0];
                        r0[2] = v0[2] * cs[1] - v0[3] * sn[1]; r0[3] = v0[3] * cs[1] + v0[2] * sn[1];
                        r1[0] = v1[0] * cs[2] - v1[1] * sn[2]; r1[1] = v1[1] * cs[2] + v1[0] * sn[2];
                        r1[2] = v1[2] * cs[3] - v1[3] * sn[3]; r1[3] = v1[3] * cs[3] + v1[2] * sn[3];
                        v0 = r0; v1 = r1; }
                    u32x4 wv; wv.x = cvt_pk_bf16(v0[0], v0[1]); wv.y = cvt_pk_bf16(v0[2], v0[3]); wv.z = cvt_pk_bf16(v1[0], v1[1]); wv.w = cvt_pk_bf16(v1[2], v1[3]);
                    *(u32x4*)(rowp + bj * HALF) = wv; } }
    }
};
struct EpiT1 {
    static constexpr bool PERM = true, AFTER_DRAIN = false;
    const bf16_t* G; bf16_t* F;
    __device__ __forceinline__ void operator()(const Acc& acc, const Unit& u, int wr, int wc, int fr, int fq) const {
        const int row0 = u.pm * BM + wr * 64 + fr, col0 = u.pn * BM + wc * 32 + 8 * fq;
#pragma unroll
        for (int ai = 0; ai < 2; ++ai)
#pragma unroll
            for (int m = 0; m < 4; ++m) { const int row = row0 + ai * HALF + m * 16;
#pragma unroll
                for (int bj = 0; bj < 2; ++bj) { const f32x4 v0 = acc[ai][bj][m][0], v1 = acc[ai][bj][m][1]; const int c = col0 + bj * HALF;
                    const u32x4 gw = *(const u32x4*)(G + (size_t)row * 2048 + c);
                    u32x4 wv;
                    wv.x = cvt_pk_bf16(v0[0] * bf_lo(gw.x), v0[1] * bf_hi(gw.x)); wv.y = cvt_pk_bf16(v0[2] * bf_lo(gw.y), v0[3] * bf_hi(gw.y));
                    wv.z = cvt_pk_bf16(v1[0] * bf_lo(gw.z), v1[1] * bf_hi(gw.z)); wv.w = cvt_pk_bf16(v1[2] * bf_lo(gw.w), v1[3] * bf_hi(gw.w));
                    *(u32x4*)(F + (size_t)row * 1024 + c) = wv; } }
    }
};
struct EpiMX {
    static constexpr bool PERM = true, AFTER_DRAIN = false;
    const bf16_t* G; const bf16_t* F; bf16_t* MX;
    __device__ __forceinline__ void operator()(const Acc& acc, const Unit& u, int wr, int wc, int fr, int fq) const {
        const int row0 = u.pm * BM + wr * 64 + fr, col0 = u.pn * BM + wc * 32 + 8 * fq;
#pragma unroll
        for (int ai = 0; ai < 2; ++ai)
#pragma unroll
            for (int m = 0; m < 4; ++m) { const int row = row0 + ai * HALF + m * 16;
#pragma unroll
                for (int bj = 0; bj < 2; ++bj) { const f32x4 v0 = acc[ai][bj][m][0], v1 = acc[ai][bj][m][1]; const int c = col0 + bj * HALF;
                    const u32x4 gw = *(const u32x4*)(G + (size_t)row * 2048 + 1024 + c);
                    const u32x4 tw = *(const u32x4*)(F + (size_t)row * 1024 + c);
                    u32x4 wv;
                    wv.x = cvt_pk_bf16(bf_lo(tw.x) + v0[0] * bf_lo(gw.x), bf_hi(tw.x) + v0[1] * bf_hi(gw.x)); wv.y = cvt_pk_bf16(bf_lo(tw.y) + v0[2] * bf_lo(gw.y), bf_hi(tw.y) + v0[3] * bf_hi(gw.y));
                    wv.z = cvt_pk_bf16(bf_lo(tw.z) + v1[0] * bf_lo(gw.z), bf_hi(tw.z) + v1[1] * bf_hi(gw.z)); wv.w = cvt_pk_bf16(bf_lo(tw.w) + v1[2] * bf_lo(gw.w), bf_hi(tw.w) + v1[3] * bf_hi(gw.w));
                    *(u32x4*)(MX + (size_t)row * 1024 + c) = wv; } }
    }
};

struct PanelSumSq {
    float* xbuf;
    unsigned* cnt;
    __device__ __forceinline__ void run(const Acc& v, const Unit& u, int wr, int wc, int fr, int fq, LAS unsigned char* lds, int wid, int lane) const {
        LAS float* P = (LAS float*)lds; LAS float* S = (LAS float*)(lds + 4096);
#pragma unroll
        for (int ai = 0; ai < 2; ++ai)
#pragma unroll
            for (int m = 0; m < 4; ++m) { float q = 0.f;
#pragma unroll
                for (int bj = 0; bj < 2; ++bj)
#pragma unroll
                    for (int n = 0; n < 2; ++n) { const f32x4 x = v[ai][bj][m][n]; q += (x[0] * x[0] + x[1] * x[1]) + (x[2] * x[2] + x[3] * x[3]); }
                q += __shfl_xor(q, 16); q += __shfl_xor(q, 32);
                if (fq == 0) P[(ai * HALF + wr * 64 + m * 16 + fr) * 4 + wc] = q; }
        asm volatile("s_waitcnt lgkmcnt(0)" ::: "memory"); __builtin_amdgcn_s_barrier(); asm volatile("" ::: "memory");
        const int row = wid * 32 + (lane & 31);
        if (lane < 32) { const float t = (P[row * 4 + 0] + P[row * 4 + 1]) + (P[row * 4 + 2] + P[row * 4 + 3]);
            __hip_atomic_store(xbuf + ((size_t)(u.pm * BM + row) * 4 + u.pn), t, __ATOMIC_RELAXED, __HIP_MEMORY_SCOPE_AGENT); }
        asm volatile("s_waitcnt vmcnt(0)" ::: "memory");
        if (lane == 0) __hip_atomic_fetch_add(cnt + 64 * u.pm, 1u, __ATOMIC_RELAXED, __HIP_MEMORY_SCOPE_AGENT);
        if (wid == 0) { unsigned sp = 0u;
            while ((unsigned)__builtin_amdgcn_readfirstlane(__hip_atomic_load(cnt + 64 * u.pm, __ATOMIC_RELAXED, __HIP_MEMORY_SCOPE_AGENT)) < 32u) { __builtin_amdgcn_s_sleep(1); if (++sp > (1u << 22)) break; }
            __builtin_amdgcn_fence(__ATOMIC_ACQUIRE, "agent"); }
        asm volatile("s_waitcnt vmcnt(0) lgkmcnt(0)" ::: "memory"); __builtin_amdgcn_s_barrier(); asm volatile("" ::: "memory");
        if (lane < 32) { const float* slot = xbuf + (size_t)(u.pm * BM + row) * 4; float tot = 0.f;
#pragma unroll
            for (int t = 0; t < 4; ++t) tot += __hip_atomic_load(slot + t, __ATOMIC_RELAXED, __HIP_MEMORY_SCOPE_AGENT);
            S[row] = __builtin_amdgcn_rsqf(tot * (1.f / 1024.f) + EPS); }
        asm volatile("s_waitcnt lgkmcnt(0)" ::: "memory"); __builtin_amdgcn_s_barrier(); asm volatile("" ::: "memory");
    }
};
template <bool FINAL> struct EpiResNorm {
    static constexpr bool PERM = false, AFTER_DRAIN = true;
    const float* base; float* out; bf16_t* xn; float wt; const float* gpost; const float* gnext; PanelSumSq st1, st2;
    __device__ __forceinline__ void operator()(const Acc&, const Unit&, int, int, int, int) const {}
    __device__ __forceinline__ void fused(Acc& acc, const Unit& u, int wr, int wc, int fr, int fq, LAS unsigned char* lds, int wid, int lane) const {
        const LAS float* S = (const LAS float*)(lds + 4096);
        const int col0 = u.pn * BM + wc * 32 + 4 * fq;
        st1.run(acc, u, wr, wc, fr, fq, lds, wid, lane);
#pragma unroll
        for (int ai = 0; ai < 2; ++ai)
#pragma unroll
            for (int m = 0; m < 4; ++m) { const int r = ai * HALF + wr * 64 + m * 16 + fr; const float sr = S[r] * wt; const size_t off = (size_t)(u.pm * BM + r) * 1024 + col0;
#pragma unroll
                for (int bj = 0; bj < 2; ++bj)
#pragma unroll
                    for (int n = 0; n < 2; ++n) { const f32x4 bs = *(const f32x4*)(base + off + bj * HALF + n * 16); const f32x4 g = *(const f32x4*)(gpost + col0 + bj * HALF + n * 16);
                        acc[ai][bj][m][n] = bs + acc[ai][bj][m][n] * g * sr; }
                asm volatile("" : "+v"(acc[ai][0][m][0]), "+v"(acc[ai][0][m][1]), "+v"(acc[ai][1][m][0]), "+v"(acc[ai][1][m][1]));
                if (m & 1) asm volatile("" ::: "memory"); }
        st2.run(acc, u, wr, wc, fr, fq, lds, wid, lane);
#pragma unroll
        for (int ai = 0; ai < 2; ++ai)
#pragma unroll
            for (int m = 0; m < 4; ++m) { const int r = ai * HALF + wr * 64 + m * 16 + fr; const float sr = S[r]; const size_t off = (size_t)(u.pm * BM + r) * 1024 + col0;
#pragma unroll
                for (int bj = 0; bj < 2; ++bj)
#pragma unroll
                    for (int n = 0; n < 2; ++n) { const f32x4 x1 = acc[ai][bj][m][n]; const f32x4 g = *(const f32x4*)(gnext + col0 + bj * HALF + n * 16); const f32x4 o = x1 * g * sr;
                        if (FINAL) *(f32x4*)(out + off + bj * HALF + n * 16) = o;
                        else { *(f32x4*)(out + off + bj * HALF + n * 16) = x1; u32x2 w; w.x = cvt_pk_bf16(o[0], o[1]); w.y = cvt_pk_bf16(o[2], o[3]); *(u32x2*)(xn + off + bj * HALF + n * 16) = w; } }
                asm volatile("" ::: "memory"); }
    }
};
}

namespace att {
constexpr int NW = 8, QBLK = 32, KVBLK = 64;
constexpr float SCALE = 0.07216878364870322f;
constexpr float THR = 8.f;
constexpr int LDQ = 1536, LDKV = 2048, LDKR = 64, LDO = 1024;
constexpr int SHM_V = 64 * 128 * 2, SHM_K = 64 * 128 * 2, SHM_R = 64 * 64 * 2;
constexpr int NQL = 4;
constexpr int OFF_V = 0, OFF_K = 2 * SHM_V, OFF_RP = OFF_K + 2 * SHM_K, OFF_WS = OFF_RP + 2 * SHM_R, OFF_QL = OFF_WS + NW * 64 * 4, SHM_ATTN = OFF_QL + NW * NQL * 1024;
static_assert(SHM_ATTN <= LDS_STAGE, "lds");
#define KSWZ(row, colB) ((row) * 256 + ((colB) ^ (((row) & 7) << 4)))
#define RSWZ(row, colB) ((row) * 128 + ((colB) ^ (((row) & 7) << 4)))
#define SBAR() __builtin_amdgcn_sched_barrier(0)
__device__ __forceinline__ int crow(int r, int hi) { return (r & 3) + 8 * (r >> 2) + 4 * hi; }
__device__ __forceinline__ bf16x8 ld8(const bf16_t* p) { return *reinterpret_cast<const bf16x8*>(p); }

__device__ __forceinline__ void partialSM(f32x16& p0, f32x16& p1, float& m_reg, float& mn, float& alpha) {
    constexpr float C = SCALE * 1.4426950408889634f;
    float pmax = p0[0];
#pragma unroll
    for (int r = 1; r < 16; ++r) pmax = fmaxf(pmax, p0[r]);
#pragma unroll
    for (int r = 0; r < 16; ++r) pmax = fmaxf(pmax, p1[r]);
    { auto rr = __builtin_amdgcn_permlane32_swap(__float_as_uint(pmax), __float_as_uint(pmax), false, false);
      pmax = fmaxf(__uint_as_float(rr[0]), __uint_as_float(rr[1])); }
    if (__builtin_expect(__all(pmax - m_reg <= THR / SCALE), 1)) { mn = m_reg; alpha = 1.f; }
    else { mn = fmaxf(m_reg, pmax); alpha = __builtin_amdgcn_exp2f((m_reg - mn) * C); m_reg = mn; }
    float mnC = -mn * C;
#pragma unroll
    for (int r = 0; r < 16; ++r) p0[r] = fmaf(p0[r], C, mnC);
#pragma unroll
    for (int r = 0; r < 16; ++r) p1[r] = fmaf(p1[r], C, mnC);
#pragma unroll
    for (int r = 0; r < 16; ++r) p0[r] = __builtin_amdgcn_exp2f(p0[r]);
}
__device__ __forceinline__ void finishSM(f32x16& p0, f32x16& p1, float alpha, float& l_reg, bf16x8& pa0, bf16x8& pa1, bf16x8& pa2, bf16x8& pa3) {
#pragma unroll
    for (int r = 0; r < 16; ++r) p1[r] = __builtin_amdgcn_exp2f(p1[r]);
    float ps = 0;
#pragma unroll
    for (int r = 0; r < 16; ++r) ps += p0[r];
#pragma unroll
    for (int r = 0; r < 16; ++r) ps += p1[r];
    { auto rr = __builtin_amdgcn_permlane32_swap(__float_as_uint(ps), __float_as_uint(ps), false, false);
      ps = __uint_as_float(rr[0]) + __uint_as_float(rr[1]); }
    l_reg = l_reg * alpha + ps;
#define PK4(P, BASE, OUT) do { unsigned a0 = cvt_pk_bf16(P[BASE + 0], P[BASE + 1]), a1 = cvt_pk_bf16(P[BASE + 2], P[BASE + 3]);   \
    unsigned b0 = cvt_pk_bf16(P[BASE + 4], P[BASE + 5]), b1 = cvt_pk_bf16(P[BASE + 6], P[BASE + 7]);                              \
    auto r0 = __builtin_amdgcn_permlane32_swap(a0, b0, false, false); auto r1 = __builtin_amdgcn_permlane32_swap(a1, b1, false, false); \
    u32x4 w = {r0[0], r1[0], r0[1], r1[1]}; OUT = *reinterpret_cast<bf16x8*>(&w); } while (0)
    PK4(p0, 0, pa0); PK4(p0, 8, pa1); PK4(p1, 0, pa2); PK4(p1, 8, pa3);
#undef PK4
}
__device__ __forceinline__ void qkt(f32x16& p0, f32x16& p1, const char* Ks, const char* Rs, const bf16x8* qr, const char* ql, int r32, int hi) {
    p0 = f32x16{}; p1 = f32x16{};
#pragma unroll
    for (int d0 = 0; d0 < 8; ++d0) { int cb = (d0 * 16 + hi * 8) * 2;
        bf16x8 b0 = *reinterpret_cast<const bf16x8*>(Ks + KSWZ(r32, cb));
        bf16x8 b1 = *reinterpret_cast<const bf16x8*>(Ks + KSWZ(32 + r32, cb));
        p0 = __builtin_amdgcn_mfma_f32_32x32x16_bf16(b0, qr[d0], p0, 0, 0, 0);
        p1 = __builtin_amdgcn_mfma_f32_32x32x16_bf16(b1, qr[d0], p1, 0, 0, 0); }
#pragma unroll
    for (int d0 = 0; d0 < 4; ++d0) { int cb = (d0 * 16 + hi * 8) * 2;
        bf16x8 b0 = *reinterpret_cast<const bf16x8*>(Rs + RSWZ(r32, cb));
        bf16x8 b1 = *reinterpret_cast<const bf16x8*>(Rs + RSWZ(32 + r32, cb));
        const bf16x8 qv = *reinterpret_cast<const bf16x8*>(ql + d0 * 1024);
        p0 = __builtin_amdgcn_mfma_f32_32x32x16_bf16(b0, qv, p0, 0, 0, 0);
        p1 = __builtin_amdgcn_mfma_f32_32x32x16_bf16(b1, qv, p1, 0, 0, 0); }
}
__device__ __forceinline__ int v_st(int k, int c) { const int kk = (k & ~0xC) | ((k & 4) << 1) | ((k & 8) >> 1); return ((kk >> 3) * 4 + (c >> 5)) * 512 + ((kk & 7) * 32 + (c & 31)) * 2; }
__device__ __forceinline__ int v_rd_base(int lane) { return ((lane & 3) << 3) | (((lane >> 2) & 3) << 6) | (((lane >> 4) & 1) << 5) | (((lane >> 5) & 1) << 8); }
constexpr int v_rd_off(int d0, int ks, int half) { return d0 * 512 + ks * 4096 + half * 2048; }
template <int OFF> __device__ __forceinline__ s16x4 tr_read(int vb) {
    s16x4 r; asm volatile("ds_read_b64_tr_b16 %0, %1 offset:%2" : "=&v"(r) : "v"(vb), "i"(OFF) : "memory"); return r;
}
template <int D0> __device__ __forceinline__ void pv_one(f32x16& od, int vb, bf16x8 pa0, bf16x8 pa1, bf16x8 pa2, bf16x8 pa3) {
    const s16x4 l0 = tr_read<v_rd_off(D0, 0, 0)>(vb), h0 = tr_read<v_rd_off(D0, 0, 1)>(vb), l1 = tr_read<v_rd_off(D0, 1, 0)>(vb), h1 = tr_read<v_rd_off(D0, 1, 1)>(vb);
    const s16x4 l2 = tr_read<v_rd_off(D0, 2, 0)>(vb), h2 = tr_read<v_rd_off(D0, 2, 1)>(vb), l3 = tr_read<v_rd_off(D0, 3, 0)>(vb), h3 = tr_read<v_rd_off(D0, 3, 1)>(vb);
    asm volatile("s_waitcnt lgkmcnt(0)" ::: "memory"); SBAR();
#define PK(L, H) (bf16x8){L[0], L[1], L[2], L[3], H[0], H[1], H[2], H[3]}
    od = __builtin_amdgcn_mfma_f32_32x32x16_bf16(pa0, PK(l0, h0), od, 0, 0, 0);
    od = __builtin_amdgcn_mfma_f32_32x32x16_bf16(pa1, PK(l1, h1), od, 0, 0, 0);
    od = __builtin_amdgcn_mfma_f32_32x32x16_bf16(pa2, PK(l2, h2), od, 0, 0, 0);
    od = __builtin_amdgcn_mfma_f32_32x32x16_bf16(pa3, PK(l3, h3), od, 0, 0, 0);
#undef PK
}
__device__ __forceinline__ void pv_d0(f32x16* o, int vb, bf16x8 pa0, bf16x8 pa1, bf16x8 pa2, bf16x8 pa3) {
    pv_one<0>(o[0], vb, pa0, pa1, pa2, pa3); pv_one<1>(o[1], vb, pa0, pa1, pa2, pa3); pv_one<2>(o[2], vb, pa0, pa1, pa2, pa3); pv_one<3>(o[3], vb, pa0, pa1, pa2, pa3);
}

__device__ __forceinline__ void attn_body(const bf16_t* __restrict__ Qb, const bf16_t* __restrict__ Kn, const bf16_t* __restrict__ Kr, const bf16_t* __restrict__ Vh,
                                          bf16_t* __restrict__ Ob, int seq, char* lds) {
    const int tid = fresh_tid(), wid = tid >> 6, lane = tid & 63, r32 = lane & 31, hi = lane >> 5;
    char* V_lds = lds + OFF_V; char* K_lds = lds + OFF_K; char* R_lds = lds + OFF_RP;
    float* ws = (float*)(lds + OFF_WS) + wid * 64; float* li_l = ws; float* al_l = ws + 32;
    float m_reg = -1e30f, l_reg = 0; f32x16 o[4] = {}; bf16x8 qr[8];
    char* ql = lds + OFF_QL + wid * (NQL * 1024) + lane * 16;
    const bf16_t* Qw = Qb + (long)(wid * QBLK + r32) * LDQ + hi * 8;
#pragma unroll
    for (int d0 = 0; d0 < 8; ++d0) qr[d0] = ld8(Qw + d0 * 16);
#pragma unroll
    for (int d0 = 0; d0 < NQL; ++d0) *reinterpret_cast<bf16x8*>(ql + d0 * 1024) = ld8(Qw + (8 + d0) * 16);
    const int sr = tid >> 4, sc = (tid & 15) * 8, vst0 = v_st(sr, sc), vst1 = v_st(32 + sr, sc);
    const int rr_ = tid >> 3, rc_ = (tid & 7) * 8;
    const int vb0 = (int)(uintptr_t)V_lds + v_rd_base(lane);
    bf16x8 vs0, vs1, ks0, ks1, rs0;
#define SLOAD(k0) do { vs0 = ld8(&Vh[(long)((k0) + sr) * LDKV + sc]); vs1 = ld8(&Vh[(long)((k0) + 32 + sr) * LDKV + sc]); \
    ks0 = ld8(&Kn[(long)((k0) + sr) * LDKV + sc]); ks1 = ld8(&Kn[(long)((k0) + 32 + sr) * LDKV + sc]); rs0 = ld8(&Kr[(long)((k0) + rr_) * LDKR + rc_]); } while (0)
#define SWRITE(b) do { *(bf16x8*)(V_lds + (b) * SHM_V + vst0) = vs0; *(bf16x8*)(V_lds + (b) * SHM_V + vst1) = vs1; int kc = sc * 2; \
    *(bf16x8*)(K_lds + (b) * SHM_K + KSWZ(sr, kc)) = ks0; *(bf16x8*)(K_lds + (b) * SHM_K + KSWZ(32 + sr, kc)) = ks1; \
    *(bf16x8*)(R_lds + (b) * SHM_R + RSWZ(rr_, rc_ * 2)) = rs0; } while (0)
#define RESC(a) do { if (__any((a) < 1.f)) { if (hi == 0) al_l[r32] = (a); asm volatile("s_waitcnt lgkmcnt(0)" ::: "memory"); \
    _Pragma("unroll") for (int d = 0; d < 4; ++d) _Pragma("unroll") for (int r = 0; r < 16; ++r) o[d][r] *= al_l[crow(r, hi)]; } } while (0)
    f32x16 pA0, pA1, pB0, pB1; float mnA, mnB, alA, alB; bf16x8 pa0, pa1, pa2, pa3; const int NT = seq / KVBLK;
    SLOAD(0); asm volatile("s_waitcnt vmcnt(0)" ::: "memory"); SWRITE(0); __syncthreads();
    qkt(pA0, pA1, K_lds, R_lds, qr, ql, r32, hi); partialSM(pA0, pA1, m_reg, mnA, alA);
    SLOAD(KVBLK);
    asm volatile("s_waitcnt vmcnt(0)" ::: "memory"); SWRITE(1); __syncthreads();
    for (int j = 1; j + 1 < NT; j += 2) {
        SBAR(); qkt(pB0, pB1, K_lds + SHM_K, R_lds + SHM_R, qr, ql, r32, hi);
        finishSM(pA0, pA1, alA, l_reg, pa0, pa1, pa2, pa3); SBAR();
        SLOAD((j + 1) * KVBLK); SBAR();
        pv_d0(o, vb0, pa0, pa1, pa2, pa3); partialSM(pB0, pB1, m_reg, mnB, alB);
        __syncthreads(); asm volatile("s_waitcnt vmcnt(0)" ::: "memory"); SWRITE(0);
        RESC(alB); __syncthreads();
        SBAR(); qkt(pA0, pA1, K_lds, R_lds, qr, ql, r32, hi);
        finishSM(pB0, pB1, alB, l_reg, pa0, pa1, pa2, pa3); SBAR();
        SLOAD((j + 2) * KVBLK); SBAR();
        pv_d0(o, vb0 + SHM_V, pa0, pa1, pa2, pa3); partialSM(pA0, pA1, m_reg, mnA, alA);
        __syncthreads(); asm volatile("s_waitcnt vmcnt(0)" ::: "memory"); SWRITE(1);
        RESC(alA); __syncthreads();
    }
    SBAR(); qkt(pB0, pB1, K_lds + SHM_K, R_lds + SHM_R, qr, ql, r32, hi);
    finishSM(pA0, pA1, alA, l_reg, pa0, pa1, pa2, pa3); SBAR();
    pv_d0(o, vb0, pa0, pa1, pa2, pa3); partialSM(pB0, pB1, m_reg, mnB, alB);
    __syncthreads(); RESC(alB);
    finishSM(pB0, pB1, alB, l_reg, pa0, pa1, pa2, pa3); SBAR();
    pv_d0(o, vb0 + SHM_V, pa0, pa1, pa2, pa3);
    if (hi == 0) li_l[r32] = l_reg; asm volatile("s_waitcnt lgkmcnt(0)" ::: "memory");
    float rli[16];
#pragma unroll
    for (int r = 0; r < 16; ++r) rli[r] = __builtin_amdgcn_rcpf(li_l[crow(r, hi)]);
    bf16_t* Ow = Ob + (long)(wid * QBLK) * LDO;
#pragma unroll
    for (int r = 0; r < 16; ++r) { int orow = crow(r, hi);
#pragma unroll
        for (int d0 = 0; d0 < 4; ++d0) { const float v = o[d0][r] * rli[r]; Ow[(long)orow * LDO + d0 * 32 + r32] = (bf16_t)(cvt_pk_bf16(v, v) & 0xffffu); } }
#undef SLOAD
#undef SWRITE
#undef RESC
}
}


#define XB_TMO      128
#define XB_XCNT(j)  (256  + 64 * (j))
#define XB_XSUB(j)  (1280 + 64 * (j))
#define XB_XGEN(j)  (2304 + 64 * (j))
#define XB_TOP      3328
#define XB_TOPGEN   3392
#define XCD_BAR_WORDS 3456
#define XB_SPIN_CAP (1u << 18)
__device__ __forceinline__ unsigned xb_ld(unsigned* p)              { return __hip_atomic_load(p, __ATOMIC_RELAXED, __HIP_MEMORY_SCOPE_AGENT); }
__device__ __forceinline__ unsigned xb_add(unsigned* p, unsigned v) { return __hip_atomic_fetch_add(p, v, __ATOMIC_RELAXED, __HIP_MEMORY_SCOPE_AGENT); }
__device__ __forceinline__ unsigned xb_xcc_id() { return (unsigned)__builtin_amdgcn_s_getreg((3 << 11) | 20) & 0xFu; }
#define XB_SPIN(cond, bar) do { unsigned _sp = 0; while (cond) { __builtin_amdgcn_s_sleep(1); \
    if ((++_sp & 255u) == 0u) { if (xb_ld(&(bar)[XB_TMO])) break; if (_sp > XB_SPIN_CAP) { atomicAdd(&(bar)[XB_TMO], 1u); break; } } } } while (0)
struct XcdBarrier { unsigned* bar; unsigned x; volatile LAS unsigned* st; };
__device__ __forceinline__ XcdBarrier xcd_barrier_post(unsigned* bar, volatile LAS unsigned* st) {
    XcdBarrier b; b.bar = bar; b.x = xb_xcc_id(); b.st = st;
    if (threadIdx.x == 0) (void)xb_add(&bar[XB_XCNT(b.x)], 1u);
    return b;
}
__device__ __forceinline__ void xcd_barrier_complete(unsigned* bar, unsigned x, unsigned& nloc, unsigned& nx) {
    const unsigned G = gridDim.x * gridDim.y * gridDim.z;
    unsigned sum, cnt, mine, sp = 0u;
    for (;;) {
        sum = 0u; cnt = 0u; mine = 0u;
#pragma unroll
        for (unsigned j = 0; j < 16; ++j) { const unsigned c = xb_ld(&bar[XB_XCNT(j)]); sum += c; cnt += (c > 0u) ? 1u : 0u; mine = (j == x) ? c : mine; }
        if (sum == G) break;
        __builtin_amdgcn_s_sleep(1);
        if ((++sp & 255u) == 0u) { if (xb_ld(&bar[XB_TMO])) break; if (sp > XB_SPIN_CAP) { atomicAdd(&bar[XB_TMO], 1u); break; } }
    }
    nloc = mine > 0u ? mine : 1u; nx = cnt > 0u ? cnt : 1u;
}
__device__ __forceinline__ void xcd_barrier(const XcdBarrier& b) {
    asm volatile("s_waitcnt vmcnt(0)" ::: "memory");
    __syncthreads();
    if (threadIdx.x == 0) {
        unsigned* bar = b.bar;
        __builtin_amdgcn_s_waitcnt(0);
        unsigned nloc = b.st[0], nx = b.st[1];
        if (nloc == 0u) { xcd_barrier_complete(bar, b.x, nloc, nx); b.st[0] = nloc; b.st[1] = nx; }
        const unsigned old = xb_add(&bar[XB_XSUB(b.x)], 1u);
        const unsigned gen = old / nloc;
        if (old + 1u == (gen + 1u) * nloc) {
            __builtin_amdgcn_fence(__ATOMIC_RELEASE, "agent");
            asm volatile("s_waitcnt vmcnt(0)" ::: "memory");
            const unsigned og = xb_add(&bar[XB_TOP], 1u);
            const unsigned tg = og / nx;
            if (og + 1u == (tg + 1u) * nx) xb_add(&bar[XB_TOPGEN], 1u);
            else XB_SPIN(xb_ld(&bar[XB_TOPGEN]) == tg, bar);
            __builtin_amdgcn_fence(__ATOMIC_ACQUIRE, "agent");
            xb_add(&bar[XB_XGEN(b.x)], 1u);
            asm volatile("s_waitcnt vmcnt(0)" ::: "memory");
        } else {
            XB_SPIN(xb_ld(&bar[XB_XGEN(b.x)]) == gen, bar);
            __builtin_amdgcn_fence(__ATOMIC_ACQUIRE, "agent");
            asm volatile("s_waitcnt vmcnt(0)" ::: "memory");
        }
    }
    __syncthreads();
}

enum { TR_PLAIN = 0, TR_GU = 1, TR_WIN = 2, TR_UQ = 3, TR_UKV = 4 };
template <int MODE>
__device__ __forceinline__ void tr_job(const float* W0, const float* W1, int K, int Nsrc, int Nout, bf16_t* WT, LAS float* scr, int lane, int gw, int NGW) {
    const int nblk = Nout / 32, nitems = (K / 64) * nblk;
    for (int it = gw; it < nitems; it += NGW) {
        const int kb = it / nblk, nb = it % nblk, k0 = 64 * kb, n0 = 32 * nb, np = n0 + (lane & 31);
        const float* colp;
        if (MODE == TR_PLAIN) colp = W0 + np;
        else if (MODE == TR_GU) { const int t = np >> 8, w = np & 255; colp = (w < 128 ? W0 : W1) + t * 128 + (w & 127); }
        else if (MODE == TR_WIN) colp = np < 1216 ? W0 + np : (np < 1280 ? nullptr : W0 + (np - 64));
        else if (MODE == TR_UQ) { const int h = np / 192, w = np % 192; colp = W0 + (w < 128 ? np : h * 192 + 128 + ((w - 128) >> 1) + ((w - 128) & 1) * 32); }
        else colp = np < 1024 ? W0 + np : W1 + (np - 1024);
        float tv[32];
#pragma unroll
        for (int i = 0; i < 32; ++i) { const int kk = 2 * i + (lane >> 5); tv[i] = colp ? colp[(size_t)(k0 + kk) * Nsrc] : 0.f; }
#pragma unroll
        for (int i = 0; i < 32; ++i) { const int kk = 2 * i + (lane >> 5); scr[kk * 33 + (lane & 31)] = tv[i]; }
        asm volatile("s_waitcnt lgkmcnt(0)" ::: "memory");
        const int c = lane & 7;
#pragma unroll
        for (int j = 0; j < 4; ++j) { const int n = (lane >> 3) + 8 * j; const LAS float* s = scr + (8 * c) * 33 + n;
            u32x4 o; o.x = cvt_pk_bf16(s[0 * 33], s[1 * 33]); o.y = cvt_pk_bf16(s[2 * 33], s[3 * 33]); o.z = cvt_pk_bf16(s[4 * 33], s[5 * 33]); o.w = cvt_pk_bf16(s[6 * 33], s[7 * 33]);
            *(u32x4*)(WT + (size_t)(n0 + n) * K + k0 + 8 * c) = o; }
        asm volatile("s_waitcnt lgkmcnt(0)" ::: "memory");
    }
}

template <int MODE>
__device__ __forceinline__ void rows_phase(const float* xin, const bf16_t* f, float wt, const float* gpost, const float* gnext, float* xout, bf16_t* xn, int gw, int NGW, int lane) {
    for (int row0 = gw; row0 < M; row0 += 2 * NGW) {
        f32x4 xv[2][4]; u32x2 fw[2][4];
#pragma unroll
        for (int r = 0; r < 2; ++r) { const size_t row = (size_t)(row0 + r * NGW);
#pragma unroll
            for (int j = 0; j < 4; ++j) { xv[r][j] = *(const f32x4*)(xin + row * DM + 4 * (lane + 64 * j));
                if (MODE != 0) fw[r][j] = *(const u32x2*)(f + row * DM + 4 * (lane + 64 * j)); } }
#pragma unroll
        for (int r = 0; r < 2; ++r) { const size_t row = (size_t)(row0 + r * NGW);
            if (MODE != 0) {
                f32x4 fv[4]; float ss = 0.f;
#pragma unroll
                for (int j = 0; j < 4; ++j) { fv[j] = (f32x4){bf_lo(fw[r][j].x), bf_hi(fw[r][j].x), bf_lo(fw[r][j].y), bf_hi(fw[r][j].y)}; ss += fv[j].x * fv[j].x + fv[j].y * fv[j].y + fv[j].z * fv[j].z + fv[j].w * fv[j].w; }
                const float rr = wt * __builtin_amdgcn_rsqf(wave_sum(ss) * (1.f / DM) + EPS);
#pragma unroll
                for (int j = 0; j < 4; ++j) { const f32x4 g = *(const f32x4*)(gpost + 4 * (lane + 64 * j)); xv[r][j] = xv[r][j] + fv[j] * g * rr; }
                if (MODE == 1) {
#pragma unroll
                    for (int j = 0; j < 4; ++j) *(f32x4*)(xout + row * DM + 4 * (lane + 64 * j)) = xv[r][j];
                }
            }
            float s2 = 0.f;
#pragma unroll
            for (int j = 0; j < 4; ++j) s2 += xv[r][j].x * xv[r][j].x + xv[r][j].y * xv[r][j].y + xv[r][j].z * xv[r][j].z + xv[r][j].w * xv[r][j].w;
            const float r2 = __builtin_amdgcn_rsqf(wave_sum(s2) * (1.f / DM) + EPS);
#pragma unroll
            for (int j = 0; j < 4; ++j) { const f32x4 g = *(const f32x4*)(gnext + 4 * (lane + 64 * j)); const f32x4 y = xv[r][j] * g * r2;
                if (MODE == 2) *(f32x4*)(xout + row * DM + 4 * (lane + 64 * j)) = y;
                else { u32x2 w; w.x = cvt_pk_bf16(y.x, y.y); w.y = cvt_pk_bf16(y.z, y.w); *(u32x2*)(xn + row * DM + 4 * (lane + 64 * j)) = w; } }
        }
    }
}

__global__ void __launch_bounds__(NTHREADS, 2) fwd_megakernel(Params p) {
    extern __shared__ __attribute__((aligned(16))) unsigned char lds[];
    cg::grid_group grid = cg::this_grid();
    volatile LAS unsigned* bst = (volatile LAS unsigned*)((LAS unsigned char*)lds + LDS_STAGE);
    if (threadIdx.x < 2) bst[threadIdx.x] = 0u;
    __syncthreads();
    const XcdBarrier xbar = xcd_barrier_post((unsigned*)(p.ws + OFF_BAR), bst);
#define GRID_SYNC_CG() do { __builtin_amdgcn_fence(__ATOMIC_RELEASE, "agent"); asm volatile("s_waitcnt vmcnt(0)" ::: "memory"); grid.sync(); \
        __builtin_amdgcn_fence(__ATOMIC_ACQUIRE, "agent"); asm volatile("s_waitcnt vmcnt(0)" ::: "memory"); } while (0)
#define GRID_SYNC() xcd_barrier(xbar)
    const int G = gridDim.x, bid = blockIdx.x, NGW = G * NWAVES;
    LAS unsigned char* ldsl = (LAS unsigned char*)lds;
#define PHASE_IDS() const int tid = fresh_tid(), lane = tid & 63, wave = tid >> 6, gw = bid * NWAVES + wave; LAS float* scr = (LAS float*)(ldsl + wave * 8448); (void)scr; (void)gw; (void)lane
    unsigned char* ws = p.ws;
    bf16_t* Wgu = (bf16_t*)(ws + OFF_WGU); bf16_t* Wd = (bf16_t*)(ws + OFF_WD); bf16_t* Win = (bf16_t*)(ws + OFF_WIN); bf16_t* Wuq = (bf16_t*)(ws + OFF_WUQ);
    bf16_t* Wukv = (bf16_t*)(ws + OFF_WUKV); bf16_t* Woa = (bf16_t*)(ws + OFF_WOA); bf16_t* Wp = (bf16_t*)(ws + OFF_WP); bf16_t* Wout = (bf16_t*)(ws + OFF_WOUT);
    bf16_t* XN = (bf16_t*)(ws + OFF_XN); bf16_t* F = (bf16_t*)(ws + OFF_F); float* ZF = (float*)(ws + OFF_ZF); bf16_t* KV = (bf16_t*)(ws + OFF_KV);
    bf16_t* H = (bf16_t*)(ws + OFF_H); bf16_t* O = (bf16_t*)(ws + OFF_O); bf16_t* CQN = (bf16_t*)(ws + OFF_CQN); bf16_t* CKVN = (bf16_t*)(ws + OFF_CKVN);
    float* TAB = (float*)(ws + OFF_TAB); bf16_t* Q = (bf16_t*)(ws + OFF_Q); bf16_t* KR = (bf16_t*)(ws + OFF_KR); bf16_t* Gt = (bf16_t*)(ws + OFF_G); bf16_t* DP = (bf16_t*)(ws + OFF_DP);
    float* X = p.out;
    float* xbuf0 = (float*)(ws + OFF_XBUF); unsigned* cnt0 = (unsigned*)(ws + OFF_CNT);

    { PHASE_IDS();
    tr_job<TR_GU>(p.f1_wg, p.f1_wu, 1024, DFF, 5632, Wgu, scr, lane, gw, NGW);
    tr_job<TR_PLAIN>(p.f1_wd, nullptr, DFF, 1024, 1024, Wd, scr, lane, gw, NGW);
    rows_phase<0>(p.x, nullptr, 0.f, nullptr, p.f1_pre, nullptr, XN, gw, NGW, lane); }
    if (__builtin_expect(p.out == nullptr, 0)) GRID_SYNC_CG();
    GRID_SYNC();

    pg8::StaticOrder S;
    { pg8::Gemm g{XN, Wgu, M, 5632, 1024}; S.init(M, 5632, G, bid); pg8::EpiSwiGLU E{H}; pg8::gemm_phase(ldsl, g, S, E); }
    {
        const int tail0 = (64 * 22) % G;
        if (tail0 != 0 && bid >= tail0) { PHASE_IDS(); const int tb = bid - tail0, nb = G - tail0, tgw = tb * NWAVES + wave, TNGW = nb * NWAVES;
            tr_job<TR_WIN>(p.w_in, nullptr, 1024, INW, 3328, Win, scr, lane, tgw, TNGW);
            tr_job<TR_UQ>(p.w_uq, nullptr, QL, 1536, 1536, Wuq, scr, lane, tgw, TNGW);
            tr_job<TR_UKV>(p.w_uk, p.w_uv, KVL, 1024, 2048, Wukv, scr, lane, tgw, TNGW);
            tr_job<TR_PLAIN>(p.w_oa, nullptr, 1024, 1024, 1024, Woa, scr, lane, tgw, TNGW);
            tr_job<TR_PLAIN>(p.w_out, nullptr, 1024, 1024, 1024, Wout, scr, lane, tgw, TNGW);
    for (int idx = tb * NTHREADS + tid; idx < 65536; idx += nb * NTHREADS) {
            const int n = idx & 1023, c8 = idx >> 10, g = c8 >> 4, cb = (c8 & 15) * 8;
            float a[8];
    #pragma unroll
            for (int i = 0; i < 8; ++i) a[i] = 0.f;
            for (int j0 = 0; j0 < 128; j0 += 8) { float w[8]; f32x4 pw[8][2];
    #pragma unroll
                for (int jj = 0; jj < 8; ++jj) w[jj] = p.w_op[(size_t)(g * 128 + j0 + jj) * 1024 + n] * p.pool_scale[g * 128 + j0 + jj];
    #pragma unroll
                for (int i = 0; i < 8; ++i) { pw[i][0] = *(const f32x4*)(p.pool_w + (size_t)(g * 128 + cb + i) * 128 + j0); pw[i][1] = *(const f32x4*)(p.pool_w + (size_t)(g * 128 + cb + i) * 128 + j0 + 4); }
    #pragma unroll
                for (int i = 0; i < 8; ++i)
    #pragma unroll
                    for (int jj = 0; jj < 8; ++jj) a[i] = fmaf(pw[i][jj >> 2][jj & 3], w[jj], a[i]); }
            u32x4 o; o.x = cvt_pk_bf16(a[0], a[1]); o.y = cvt_pk_bf16(a[2], a[3]); o.z = cvt_pk_bf16(a[4], a[5]); o.w = cvt_pk_bf16(a[6], a[7]);
            *(u32x4*)(Wp + (size_t)n * 512 + c8 * 8) = o;
        }
        }
        else if (tail0 == 0) { PHASE_IDS(); const int tb = bid, nb = G;
            tr_job<TR_WIN>(p.w_in, nullptr, 1024, INW, 3328, Win, scr, lane, gw, NGW);
            tr_job<TR_UQ>(p.w_uq, nullptr, QL, 1536, 1536, Wuq, scr, lane, gw, NGW);
            tr_job<TR_UKV>(p.w_uk, p.w_uv, KVL, 1024, 2048, Wukv, scr, lane, gw, NGW);
            tr_job<TR_PLAIN>(p.w_oa, nullptr, 1024, 1024, 1024, Woa, scr, lane, gw, NGW);
            tr_job<TR_PLAIN>(p.w_out, nullptr, 1024, 1024, 1024, Wout, scr, lane, gw, NGW);
    for (int idx = tb * NTHREADS + tid; idx < 65536; idx += nb * NTHREADS) {
            const int n = idx & 1023, c8 = idx >> 10, g = c8 >> 4, cb = (c8 & 15) * 8;
            float a[8];
    #pragma unroll
            for (int i = 0; i < 8; ++i) a[i] = 0.f;
            for (int j0 = 0; j0 < 128; j0 += 8) { float w[8]; f32x4 pw[8][2];
    #pragma unroll
                for (int jj = 0; jj < 8; ++jj) w[jj] = p.w_op[(size_t)(g * 128 + j0 + jj) * 1024 + n] * p.pool_scale[g * 128 + j0 + jj];
    #pragma unroll
                for (int i = 0; i < 8; ++i) { pw[i][0] = *(const f32x4*)(p.pool_w + (size_t)(g * 128 + cb + i) * 128 + j0); pw[i][1] = *(const f32x4*)(p.pool_w + (size_t)(g * 128 + cb + i) * 128 + j0 + 4); }
    #pragma unroll
                for (int i = 0; i < 8; ++i)
    #pragma unroll
                    for (int jj = 0; jj < 8; ++jj) a[i] = fmaf(pw[i][jj >> 2][jj & 3], w[jj], a[i]); }
            u32x4 o; o.x = cvt_pk_bf16(a[0], a[1]); o.y = cvt_pk_bf16(a[2], a[3]); o.z = cvt_pk_bf16(a[4], a[5]); o.w = cvt_pk_bf16(a[6], a[7]);
            *(u32x4*)(Wp + (size_t)n * 512 + c8 * 8) = o;
        }
        }
    }
    GRID_SYNC();
    { pg8::Gemm g{H, Wd, M, 1024, DFF}; S.init(M, 1024, G, bid);
      pg8::EpiResNorm<false> E{p.x, X, XN, 0.5f, p.f1_post, p.mix_pre, pg8::PanelSumSq{xbuf0, cnt0}, pg8::PanelSumSq{xbuf0 + (size_t)M * 4, cnt0 + 4096}}; pg8::gemm_phase(ldsl, g, S, E); }
    GRID_SYNC();
    { pg8::Gemm g{XN, Win, M, 1280, 1024}; S.init(M, 1280, G, bid); pg8::EpiBf16 E{(bf16_t*)ZF, 1280}; pg8::gemm_phase(ldsl, g, S, E); }
    {
        const int tail0 = (64 * 5) % G; PHASE_IDS();
        if (tail0 != 0 && bid >= tail0) { const int tgw = (bid - tail0) * NWAVES + wave, TNGW = (G - tail0) * NWAVES;
            tr_job<TR_GU>(p.f2_wg, p.f2_wu, 1024, DFF, 5632, Wgu, scr, lane, tgw, TNGW);
            tr_job<TR_PLAIN>(p.f2_wd, nullptr, DFF, 1024, 1024, Wd, scr, lane, tgw, TNGW); }
        else if (tail0 == 0) { tr_job<TR_GU>(p.f2_wg, p.f2_wu, 1024, DFF, 5632, Wgu, scr, lane, gw, NGW); tr_job<TR_PLAIN>(p.f2_wd, nullptr, DFF, 1024, 1024, Wd, scr, lane, gw, NGW); }
    }
    GRID_SYNC();
    { PHASE_IDS();
    const bf16_t* ZB = (const bf16_t*)ZF;
    const int t_g = lane >> 4, wnd = 2 << t_g;
    for (int k = 0; k < M / (NWAVES * 256); ++k) { const int row = gw * (M / (NWAVES * 256)) + k;
        const bf16_t* z = ZB + (size_t)row * 1280;
        const u32x4 qa = *(const u32x4*)(z + 8 * lane);
        u32x4 qb = (u32x4){0u, 0u, 0u, 0u}; if (lane < 16) qb = *(const u32x4*)(z + 512 + 8 * lane);
        const u32x4 pc = *(const u32x4*)(z + 704 + 8 * lane);
        float kx1 = 0.f, kx2 = 0.f; int pos = 0;
        if (lane < 32) { kx1 = bf_lo((unsigned)z[640 + lane]); kx2 = bf_lo((unsigned)z[672 + lane]); pos = p.pos[row]; }
        const int t = row & (SEQ - 1), lo = max(t - (wnd >> 1), 0), hi = min(t + wnd - (wnd >> 1), SEQ);
        float sacc[8];
#pragma unroll
        for (int i = 0; i < 8; ++i) sacc[i] = 0.f;
#pragma unroll
        for (int hb = 0; hb < 2; ++hb) { u32x4 nb[8]; float wv[8];
#pragma unroll
            for (int d = 0; d < 8; ++d) { const int tt = t - 8 + hb * 8 + d; const bool ok = (tt >= lo) && (tt < hi); wv[d] = ok ? 1.f : 0.f;
                nb[d] = *(const u32x4*)(z + 704 + 8 * lane + (long)(ok ? (tt - t) : 0) * 1280); }
#pragma unroll
            for (int d = 0; d < 8; ++d) { sacc[0] = fmaf(wv[d], bf_lo(nb[d].x), sacc[0]); sacc[1] = fmaf(wv[d], bf_hi(nb[d].x), sacc[1]); sacc[2] = fmaf(wv[d], bf_lo(nb[d].y), sacc[2]); sacc[3] = fmaf(wv[d], bf_hi(nb[d].y), sacc[3]);
                sacc[4] = fmaf(wv[d], bf_lo(nb[d].z), sacc[4]); sacc[5] = fmaf(wv[d], bf_hi(nb[d].z), sacc[5]); sacc[6] = fmaf(wv[d], bf_lo(nb[d].w), sacc[6]); sacc[7] = fmaf(wv[d], bf_hi(nb[d].w), sacc[7]); } }
        {
            const float inv = 1.f / (float)(hi - lo);
            u32x4 w; w.x = cvt_pk_bf16(sacc[0] * inv - bf_lo(pc.x), sacc[1] * inv - bf_hi(pc.x)); w.y = cvt_pk_bf16(sacc[2] * inv - bf_lo(pc.y), sacc[3] * inv - bf_hi(pc.y));
            w.z = cvt_pk_bf16(sacc[4] * inv - bf_lo(pc.z), sacc[5] * inv - bf_hi(pc.z)); w.w = cvt_pk_bf16(sacc[6] * inv - bf_lo(pc.w), sacc[7] * inv - bf_hi(pc.w));
            *(u32x4*)(DP + (size_t)row * 512 + 8 * lane) = w; }
        {
            float va[8] = {bf_lo(qa.x), bf_hi(qa.x), bf_lo(qa.y), bf_hi(qa.y), bf_lo(qa.z), bf_hi(qa.z), bf_lo(qa.w), bf_hi(qa.w)};
            float vb[8] = {bf_lo(qb.x), bf_hi(qb.x), bf_lo(qb.y), bf_hi(qb.y), bf_lo(qb.z), bf_hi(qb.z), bf_lo(qb.w), bf_hi(qb.w)};
            float sa = 0.f, sb = 0.f;
#pragma unroll
            for (int i = 0; i < 8; ++i) { sa = fmaf(va[i], va[i], sa); sb = fmaf(vb[i], vb[i], sb); }
            const float ssq = wave_sum(lane < 48 ? sa : 0.f), sskv = wave_sum((lane >= 48 ? sa : 0.f) + sb);
            const float rq = __builtin_amdgcn_rsqf(ssq * (1.f / QL) + EPS), rkv = __builtin_amdgcn_rsqf(sskv * (1.f / KVL) + EPS);
            const float* ga = lane < 48 ? p.qa_g + 8 * lane : p.kva_g + 8 * (lane - 48); const float ra = lane < 48 ? rq : rkv;
            const f32x4 g0 = *(const f32x4*)ga, g1 = *(const f32x4*)(ga + 4);
            u32x4 w; w.x = cvt_pk_bf16(va[0] * g0.x * ra, va[1] * g0.y * ra); w.y = cvt_pk_bf16(va[2] * g0.z * ra, va[3] * g0.w * ra); w.z = cvt_pk_bf16(va[4] * g1.x * ra, va[5] * g1.y * ra); w.w = cvt_pk_bf16(va[6] * g1.z * ra, va[7] * g1.w * ra);
            bf16_t* dst = lane < 48 ? CQN + (size_t)row * QL + 8 * lane : CKVN + (size_t)row * KVL + 8 * (lane - 48);
            *(u32x4*)dst = w;
            if (lane < 16) { const f32x4 h0 = *(const f32x4*)(p.kva_g + 128 + 8 * lane), h1 = *(const f32x4*)(p.kva_g + 132 + 8 * lane);
                u32x4 w2; w2.x = cvt_pk_bf16(vb[0] * h0.x * rkv, vb[1] * h0.y * rkv); w2.y = cvt_pk_bf16(vb[2] * h0.z * rkv, vb[3] * h0.w * rkv); w2.z = cvt_pk_bf16(vb[4] * h1.x * rkv, vb[5] * h1.y * rkv); w2.w = cvt_pk_bf16(vb[6] * h1.z * rkv, vb[7] * h1.w * rkv);
                *(u32x4*)(CKVN + (size_t)row * KVL + 128 + 8 * lane) = w2; }
        }
        if (lane < 32) {
            const float ang = (float)pos * p.inv_freq[lane];
            const double ad = (double)ang; const double kq = rint(ad * 0.15915494309189535); const float red = (float)(ad - kq * 6.283185307179586);
            const float cs = __cosf(red), sn = __sinf(red);
            TAB[(size_t)row * 64 + lane] = cs; TAB[(size_t)row * 64 + 32 + lane] = sn;
            *(unsigned*)(KR + (size_t)row * 64 + 2 * lane) = cvt_pk_bf16(kx1 * cs - kx2 * sn, kx2 * cs + kx1 * sn);
        }
    } }
    GRID_SYNC();
    { pg8::Gemm g{CQN, Wuq, M, 1536, QL}; S.init(M, 1536, G, bid); pg8::EpiQ E{Q, TAB}; pg8::gemm_phase(ldsl, g, S, E); }
    { pg8::Gemm g{CKVN, Wukv, M, 2048, KVL}; S.init(M, 2048, G, bid); pg8::EpiBf16 E{KV, 2048}; pg8::gemm_phase(ldsl, g, S, E); }
    GRID_SYNC();
    {
        const int vcu = (bid & 7) * (G >> 3) + (bid >> 3);
        for (int it = vcu; it < NB * NH * (SEQ / 256); it += G) {
            const int qb = it & 7, h = (it >> 3) & 7, b = it >> 6;
            const size_t tok0 = (size_t)b * SEQ;
            att::attn_body(Q + (tok0 + qb * 256) * 1536 + h * 192, KV + tok0 * 2048 + h * 128, KR + tok0 * 64, KV + tok0 * 2048 + 1024 + h * 128,
                           O + (tok0 + qb * 256) * 1024 + h * 128, SEQ, (char*)lds);
            __syncthreads();
        }
    }
    GRID_SYNC();
    { pg8::Gemm g{XN, Win + (size_t)1280 * 1024, M, 2048, 1024}; S.init(M, 2048, G, bid); pg8::EpiGate E{Gt}; pg8::gemm_phase(ldsl, g, S, E); }
    GRID_SYNC();
    { pg8::Gemm g{O, Woa, M, 1024, 1024}; S.init(M, 1024, G, bid); pg8::EpiT1 E{Gt, F}; pg8::gemm_phase(ldsl, g, S, E); }
    { pg8::Gemm g{DP, Wp, M, 1024, 512}; S.init(M, 1024, G, bid); pg8::EpiMX E{Gt, F, XN}; pg8::gemm_phase(ldsl, g, S, E); }
    GRID_SYNC();
    { pg8::Gemm g{XN, Wout, M, 1024, 1024}; S.init(M, 1024, G, bid);
      pg8::EpiResNorm<false> E{X, X, XN, 1.0f, p.mix_post, p.f2_pre, pg8::PanelSumSq{xbuf0 + (size_t)M * 8, cnt0 + 2 * 4096}, pg8::PanelSumSq{xbuf0 + (size_t)M * 12, cnt0 + 3 * 4096}}; pg8::gemm_phase(ldsl, g, S, E); }
    GRID_SYNC();
    { pg8::Gemm g{XN, Wgu, M, 5632, 1024}; S.init(M, 5632, G, bid); pg8::EpiSwiGLU E{H}; pg8::gemm_phase(ldsl, g, S, E); }
    GRID_SYNC();
    { pg8::Gemm g{H, Wd, M, 1024, DFF}; S.init(M, 1024, G, bid);
      pg8::EpiResNorm<true> E{X, X, nullptr, 0.5f, p.f2_post, p.final_g, pg8::PanelSumSq{xbuf0 + (size_t)M * 16, cnt0 + 4 * 4096}, pg8::PanelSumSq{xbuf0 + (size_t)M * 20, cnt0 + 5 * 4096}}; pg8::gemm_phase(ldsl, g, S, E); }
}

extern "C" void kernel_launch(void* const* d_in, const int* in_sizes, int n_in, void* d_out, int out_size, void* d_ws, size_t ws_size, hipStream_t stream) {
    static int grid_blocks = 0;
    if (grid_blocks == 0) {
        if (n_in != 26 || in_sizes[0] != M * DM || out_size != M * DM || ws_size < WS_END) { fprintf(stderr, "kernel_launch: shape mismatch n_in %d in0 %d out %d ws %zu\n", n_in, n_in > 0 ? in_sizes[0] : -1, out_size, ws_size); grid_blocks = -1; return; }
        int dev = 0, cus = 0, per_cu = 0;
        (void)hipGetDevice(&dev);
        (void)hipDeviceGetAttribute(&cus, hipDeviceAttributeMultiprocessorCount, dev);
        if (hipFuncSetAttribute((const void*)fwd_megakernel, hipFuncAttributeMaxDynamicSharedMemorySize, LDS_BYTES) != hipSuccess) { fprintf(stderr, "kernel_launch: hipFuncSetAttribute failed\n"); grid_blocks = -1; return; }
        if (hipOccupancyMaxActiveBlocksPerMultiprocessor(&per_cu, (const void*)fwd_megakernel, NTHREADS, LDS_BYTES) != hipSuccess || per_cu < 1) { fprintf(stderr, "kernel_launch: occupancy query failed (%d)\n", per_cu); (void)hipGetLastError(); per_cu = 1; }
        grid_blocks = cus * 1;
        if (grid_blocks != 256) { fprintf(stderr, "kernel_launch: built for 256 CUs (one workgroup each), device has %d\n", cus); grid_blocks = -1; return; }
    }
    if (grid_blocks < 0) return;
    Params p{};
    p.x = (const float*)d_in[0]; p.pos = (const int*)d_in[1];
    p.f1_pre = (const float*)d_in[2]; p.f1_wg = (const float*)d_in[3]; p.f1_wu = (const float*)d_in[4]; p.f1_wd = (const float*)d_in[5]; p.f1_post = (const float*)d_in[6];
    p.mix_pre = (const float*)d_in[7]; p.w_in = (const float*)d_in[8]; p.qa_g = (const float*)d_in[9]; p.w_uq = (const float*)d_in[10]; p.kva_g = (const float*)d_in[11];
    p.w_uk = (const float*)d_in[12]; p.w_uv = (const float*)d_in[13]; p.w_oa = (const float*)d_in[14]; p.pool_w = (const float*)d_in[15]; p.pool_scale = (const float*)d_in[16];
    p.w_op = (const float*)d_in[17]; p.w_out = (const float*)d_in[18]; p.mix_post = (const float*)d_in[19];
    p.f2_pre = (const float*)d_in[20]; p.f2_wg = (const float*)d_in[21]; p.f2_wu = (const float*)d_in[22]; p.f2_wd = (const float*)d_in[23]; p.f2_post = (const float*)d_in[24]; p.final_g = (const float*)d_in[25];
    p.out = (float*)d_out; p.ws = (unsigned char*)d_ws;
    for (int i = 0; i < 32; ++i) p.inv_freq[i] = (float)pow(10000.0, -(2.0 * i) / 64.0);
    if (hipMemsetAsync((char*)d_ws + OFF_BAR, 0, CTL_BYTES, stream) != hipSuccess) { fprintf(stderr, "kernel_launch: memset failed\n"); return; }
    void* args[] = {&p};
    hipError_t e = hipLaunchCooperativeKernel((const void*)fwd_megakernel, dim3(grid_blocks), dim3(NTHREADS), args, LDS_BYTES, stream);
    if (e != hipSuccess) fprintf(stderr, "cooperative launch failed: %s (grid %d)\n", hipGetErrorString(e), grid_blocks);
}
```

```cpp
#include <hip/hip_runtime.h>
#include <hip/hip_cooperative_groups.h>
#include <cstdio>
#include <cmath>
#include <cstdint>
namespace cg = cooperative_groups;

#define LAS __attribute__((address_space(3)))
typedef unsigned short bf16_t;
typedef short bf16x8 __attribute__((ext_vector_type(8)));
typedef short s16x4 __attribute__((ext_vector_type(4)));
typedef float f32x2 __attribute__((ext_vector_type(2)));
typedef float f32x4 __attribute__((ext_vector_type(4)));
typedef float f32x16 __attribute__((ext_vector_type(16)));
typedef unsigned u32x4 __attribute__((ext_vector_type(4)));
typedef unsigned u32x2 __attribute__((ext_vector_type(2)));

constexpr int DM = 1024, NB = 8, SEQ = 2048, M = NB * SEQ, NH = 8, QL = 384, KVL = 256, DFF = 2816, INW = 3264;
constexpr float EPS = 1e-6f;
constexpr int NTHREADS = 512, NWAVES = 8;
constexpr int LDS_STAGE = 131072, LDS_BYTES = LDS_STAGE + 16;

constexpr size_t MiB = 1048576;
constexpr size_t OFF_WGU = 0;
constexpr size_t OFF_WD = OFF_WGU + (size_t)5632 * 1024 * 2;
constexpr size_t OFF_WIN = OFF_WD + (size_t)1024 * 2816 * 2;
constexpr size_t OFF_WUQ = OFF_WIN + (size_t)3328 * 1024 * 2;
constexpr size_t OFF_WUKV = OFF_WUQ + (size_t)1536 * 384 * 2;
constexpr size_t OFF_WOA = OFF_WUKV + (size_t)2048 * 256 * 2;
constexpr size_t OFF_WP = OFF_WOA + (size_t)1024 * 1024 * 2;
constexpr size_t OFF_WOUT = OFF_WP + (size_t)1024 * 512 * 2;
constexpr size_t OFF_XN = OFF_WOUT + (size_t)1024 * 1024 * 2;
constexpr size_t OFF_R = OFF_XN + 32 * MiB;
constexpr size_t OFF_F = OFF_R;
constexpr size_t OFF_ZF = OFF_R;
constexpr size_t OFF_KV = OFF_R;
constexpr size_t OFF_H = OFF_R + 64 * MiB;
constexpr size_t OFF_O = OFF_R + 64 * MiB;
constexpr size_t OFF_CQN = OFF_R + 80 * MiB;
constexpr size_t OFF_CKVN = OFF_R + 92 * MiB;
constexpr size_t OFF_TAB = OFF_R + 100 * MiB;
constexpr size_t OFF_Q = OFF_R + 104 * MiB;
constexpr size_t OFF_KR = OFF_R + 152 * MiB;
constexpr size_t OFF_G = OFF_R + 96 * MiB;
constexpr size_t OFF_DP = OFF_R + 176 * MiB;
constexpr size_t WS_END = OFF_R + 192 * MiB;
constexpr size_t OFF_BAR = WS_END, OFF_CNT = OFF_BAR + 16384, CTL_BYTES = 16384 + 6 * 16384, OFF_XBUF = OFF_BAR + CTL_BYTES;
static_assert(OFF_XBUF + 6 * (size_t)M * 16 <= 256 * MiB, "workspace");

struct Params {
    const float* x; const int* pos;
    const float *f1_pre, *f1_wg, *f1_wu, *f1_wd, *f1_post;
    const float *mix_pre, *w_in, *qa_g, *w_uq, *kva_g, *w_uk, *w_uv, *w_oa, *pool_w, *pool_scale, *w_op, *w_out, *mix_post;
    const float *f2_pre, *f2_wg, *f2_wu, *f2_wd, *f2_post, *final_g;
    float* out; unsigned char* ws;
    float inv_freq[32];
};

typedef __bf16 bf16x2_t __attribute__((ext_vector_type(2)));
__device__ __forceinline__ unsigned cvt_pk_bf16(float lo, float hi) { const f32x2 v = {lo, hi}; const bf16x2_t r = __builtin_convertvector(v, bf16x2_t); return __builtin_bit_cast(unsigned, r); }
__device__ __forceinline__ float bf_lo(unsigned w) { return __uint_as_float(w << 16); }
__device__ __forceinline__ float bf_hi(unsigned w) { return __uint_as_float(w & 0xffff0000u); }
__device__ __forceinline__ float sigmoidf_fast(float z) { return __builtin_amdgcn_rcpf(1.f + __builtin_amdgcn_exp2f(-1.4426950408889634f * z)); }
__device__ __forceinline__ int fresh_tid() { int t = threadIdx.x; asm volatile("" : "+v"(t)); return t; }
__device__ __forceinline__ float wave_sum(float v) {
#pragma unroll
    for (int o = 1; o < 64; o <<= 1) v += __shfl_xor(v, o);
    return v;
}

namespace pg8 {
constexpr int BM = 256, BK = 64, HALF = 128, HTB = HALF * BK * 2, STAGE_BYTES = 8 * HTB, NXCD = 8, WGM = 4;
__host__ __device__ __forceinline__ int lds_byte(int r, int c) { const int st = (r >> 4) * 2 + (c >> 5), rr = r & 15, cc = c & 31, ob = rr * 64 + cc * 2; return st * 1024 + (ob ^ (((ob >> 9) & 1) << 5)); }
__host__ __device__ __forceinline__ void stage_rc(int b, int& R, int& C) { const int st = b / 1024, sb = b % 1024, swz = sb ^ (((sb >> 9) & 1) << 5); R = (st >> 1) * 16 + swz / 64; C = (st & 1) * 32 + (swz % 64) / 2; }
__host__ __device__ __forceinline__ int perm32(int rho) { const int n = rho >> 4, i = rho & 15; return 8 * (i >> 2) + 4 * n + (i & 3); }
struct Unit { int pm, pn; };
struct Gemm { const bf16_t* A; const bf16_t* Bt; int M, N, K; };
struct StaticOrder {
    int nM, nN, nwg, G, c;
    __device__ void init(int M_, int N_, int G_, int c_) { nM = M_ / BM; nN = N_ / BM; nwg = nM * nN; G = G_; c = c_; }
    __device__ bool next(int i, Unit& u) const {
        const long L = (long)i * G + c; if (L >= nwg) return false;
        int wgid = (int)L; { const int q = nwg / NXCD, r = nwg % NXCD, xcd = wgid % NXCD, off = wgid / NXCD; wgid = (xcd < r ? xcd * (q + 1) : r * (q + 1) + (xcd - r) * q) + off; }
        const int nig = WGM * nN, gid = wgid / nig, fm = gid * WGM, gsz = (nM - fm) < WGM ? (nM - fm) : WGM;
        u.pm = fm + ((wgid % nig) % gsz); u.pn = (wgid % nig) / gsz; return true;
    }
};

struct GateOrder { StaticOrder s;
    __device__ bool next(int i, Unit& u) const { if (i >= 2) return false; Unit b; if (!s.next(0, b)) return false; u.pm = b.pm; u.pn = b.pn + 4 * i; return true; } };
template <class Epi, class Sched>
__device__ __forceinline__ void gemm_phase(LAS unsigned char* lds, const Gemm g, const Sched& S, const Epi& E) {
    const int tid = fresh_tid(), wid = __builtin_amdgcn_readfirstlane(tid >> 6), lane = tid & 63, wr = wid >> 2, wc = wid & 3, fr = lane & 15, fq = lane >> 4;
    const int K = g.K, nt = K / BK;
    unsigned voffA, voffB;
    { int R, C; stage_rc(tid * 16, R, C); const int Rb = Epi::PERM ? ((R & ~31) + perm32(R & 31)) : R;
      voffA = (unsigned)(R * K + C) * 2u; voffB = (unsigned)(Rb * K + C) * 2u; }
    const size_t rstep64 = (size_t)64 * K * 2;
    const size_t kstep = (size_t)(BK * 2);
    const size_t hstep = (size_t)HALF * K * 2;
    const size_t tstep = 2 * hstep;
    const unsigned ldsw = (unsigned)wid * 1024u;
    const int aoff = lds_byte(wr * 64 + fr, fq * 8), boff = lds_byte(wc * 32 + fr, fq * 8);
#define PG8_SA(b, h) (((b) * 2 + (h)) * HTB)
#define PG8_SB(b, h) ((4 + (b) * 2 + (h)) * HTB)
#define PG8_STAGE(bufoff, gbase, voff) do { _Pragma("unroll") for (int _i = 0; _i < 2; ++_i) \
        __builtin_amdgcn_global_load_lds((const unsigned*)((const char*)(gbase) + _i * rstep64 + (voff)), (LAS unsigned*)(lds + (bufoff) + ldsw + _i * 8192), 16, 0, 0); } while (0)
#define PG8_LDA(dst, b, h) do { _Pragma("unroll") for (int m = 0; m < 4; ++m) _Pragma("unroll") for (int k = 0; k < 2; ++k) dst[m][k] = *(const LAS bf16x8*)(lds + PG8_SA(b, h) + aoff + m * 2048 + k * 1024); } while (0)
#define PG8_LDB(dst, b, h) do { _Pragma("unroll") for (int n = 0; n < 2; ++n) _Pragma("unroll") for (int k = 0; k < 2; ++k) dst[n][k] = *(const LAS bf16x8*)(lds + PG8_SB(b, h) + boff + n * 2048 + k * 1024); } while (0)
#define PG8_MMA(ai, bj, At, Bt) do { __builtin_amdgcn_s_setprio(1); _Pragma("unroll") for (int m = 0; m < 4; ++m) _Pragma("unroll") for (int n = 0; n < 2; ++n) _Pragma("unroll") for (int k = 0; k < 2; ++k) \
        acc[ai][bj][m][n] = __builtin_amdgcn_mfma_f32_16x16x32_bf16(Bt[n][k], At[m][k], acc[ai][bj][m][n], 0, 0, 0); __builtin_amdgcn_s_setprio(0); } while (0)
#define PG8_WAIT_V(n) asm volatile("s_waitcnt vmcnt(" #n ")" ::: "memory")
#define PG8_WAIT_L(n) asm volatile("s_waitcnt lgkmcnt(" #n ")" ::: "memory")
#define PG8_BAR __builtin_amdgcn_s_barrier()
#define PG8_SCHED __builtin_amdgcn_sched_barrier(0)
    Unit cur, nxt; int ui = 0;
    if (!S.next(0, cur)) return;
    f32x4 acc[2][2][4][2];
#pragma unroll
    for (int a = 0; a < 2; ++a)
#pragma unroll
        for (int b = 0; b < 2; ++b)
#pragma unroll
            for (int m = 0; m < 4; ++m)
#pragma unroll
                for (int n = 0; n < 2; ++n) acc[a][b][m][n] = (f32x4){0.f, 0.f, 0.f, 0.f};
    bf16x8 At[4][2], B0[2][2], B1[2][2];
    const char* cA = (const char*)g.A + (size_t)cur.pm * tstep; const char* cB = (const char*)g.Bt + (size_t)cur.pn * tstep;
    PG8_STAGE(PG8_SB(0, 0), cB, voffB); PG8_STAGE(PG8_SA(0, 0), cA, voffA); PG8_STAGE(PG8_SB(0, 1), cB + hstep, voffB); PG8_STAGE(PG8_SA(0, 1), cA + hstep, voffA);
    if (wr == 1) PG8_BAR;
    PG8_WAIT_V(4); PG8_BAR;
    PG8_STAGE(PG8_SB(1, 0), cB + kstep, voffB); PG8_STAGE(PG8_SA(1, 0), cA + kstep, voffA); PG8_STAGE(PG8_SB(1, 1), cB + hstep + kstep, voffB);
    PG8_WAIT_V(6); PG8_BAR;
    for (;;) {
        const bool has_next = S.next(ui + 1, nxt);
        const char* nA = has_next ? (const char*)g.A + (size_t)nxt.pm * tstep : cA; const char* nB = has_next ? (const char*)g.Bt + (size_t)nxt.pn * tstep : cB;
        for (int t = 0; t < nt; t += 2) {
            const bool last = (t == nt - 2);
            const char* a1 = cA + (size_t)(t + 1) * kstep;
            const char* a2 = last ? nA : cA + (size_t)(t + 2) * kstep; const char* b2 = last ? nB : cB + (size_t)(t + 2) * kstep;
            const char* a3 = a2 + kstep; const char* b3 = b2 + kstep;
            PG8_LDB(B0, 0, 0); PG8_SCHED; PG8_LDA(At, 0, 0); PG8_STAGE(PG8_SA(1, 1), a1 + hstep, voffA);
            PG8_WAIT_L(8); PG8_BAR; PG8_WAIT_L(0); PG8_MMA(0, 0, At, B0); PG8_BAR; PG8_SCHED;
            PG8_LDB(B1, 0, 1); PG8_STAGE(PG8_SB(0, 0), b2, voffB);
            PG8_BAR; PG8_WAIT_L(0); PG8_MMA(0, 1, At, B1); PG8_BAR;
            PG8_LDA(At, 0, 1); PG8_STAGE(PG8_SA(0, 0), a2, voffA);
            PG8_BAR; PG8_WAIT_L(0); PG8_MMA(1, 0, At, B0); PG8_BAR; PG8_SCHED;
            PG8_STAGE(PG8_SB(0, 1), b2 + hstep, voffB);
            PG8_WAIT_V(6); PG8_BAR; PG8_MMA(1, 1, At, B1); PG8_BAR;
            PG8_LDB(B0, 1, 0); PG8_SCHED; PG8_LDA(At, 1, 0); PG8_STAGE(PG8_SA(0, 1), a2 + hstep, voffA);
            PG8_WAIT_L(8); PG8_BAR; PG8_WAIT_L(0); PG8_MMA(0, 0, At, B0); PG8_BAR; PG8_SCHED;
            PG8_LDB(B1, 1, 1); PG8_STAGE(PG8_SB(1, 0), b3, voffB);
            PG8_BAR; PG8_WAIT_L(0); PG8_MMA(0, 1, At, B1); PG8_BAR;
            PG8_LDA(At, 1, 1); PG8_STAGE(PG8_SA(1, 0), a3, voffA);
            PG8_BAR; PG8_WAIT_L(0); PG8_MMA(1, 0, At, B0); PG8_BAR; PG8_SCHED;
            PG8_STAGE(PG8_SB(1, 1), b3 + hstep, voffB);
            PG8_WAIT_V(6); PG8_BAR; PG8_MMA(1, 1, At, B1); PG8_BAR;
        }
        if constexpr (!Epi::AFTER_DRAIN) { const int t2 = fresh_tid(); E(acc, cur, wr, wc, t2 & 15, (t2 >> 4) & 3); }
        if (!has_next) break;
#pragma unroll
        for (int a = 0; a < 2; ++a)
#pragma unroll
            for (int b = 0; b < 2; ++b)
#pragma unroll
                for (int m = 0; m < 4; ++m)
#pragma unroll
                    for (int n = 0; n < 2; ++n) acc[a][b][m][n] = (f32x4){0.f, 0.f, 0.f, 0.f};
        cur = nxt; cA = nA; cB = nB; ++ui;
    }
    PG8_WAIT_V(0);
    if (wr == 0) PG8_BAR;
    PG8_BAR;
    if constexpr (Epi::AFTER_DRAIN) { const int t2 = fresh_tid(); E.fused(acc, cur, wr, wc, t2 & 15, (t2 >> 4) & 3, lds, t2 >> 6, t2 & 63); }
#undef PG8_SA
#undef PG8_SB
#undef PG8_STAGE
#undef PG8_LDA
#undef PG8_LDB
#undef PG8_MMA
#undef PG8_WAIT_V
#undef PG8_WAIT_L
#undef PG8_BAR
#undef PG8_SCHED
}

typedef f32x4 Acc[2][2][4][2];
struct EpiF32 {
    static constexpr bool PERM = false, AFTER_DRAIN = false;
    float* C; int ldc;
    __device__ __forceinline__ void operator()(const Acc& acc, const Unit& u, int wr, int wc, int fr, int fq) const {
        const int row0 = u.pm * BM + wr * 64 + fr, col0 = u.pn * BM + wc * 32 + 4 * fq;
#pragma unroll
        for (int ai = 0; ai < 2; ++ai)
#pragma unroll
            for (int m = 0; m < 4; ++m) { float* rowp = C + (size_t)(row0 + ai * HALF + m * 16) * ldc + col0;
#pragma unroll
                for (int bj = 0; bj < 2; ++bj)
#pragma unroll
                    for (int n = 0; n < 2; ++n) *(f32x4*)(rowp + bj * HALF + n * 16) = acc[ai][bj][m][n]; }
    }
};
struct EpiBf16 {
    static constexpr bool PERM = true, AFTER_DRAIN = false;
    bf16_t* O; int ldc;
    __device__ __forceinline__ void operator()(const Acc& acc, const Unit& u, int wr, int wc, int fr, int fq) const {
        const int row0 = u.pm * BM + wr * 64 + fr, col0 = u.pn * BM + wc * 32 + 8 * fq;
#pragma unroll
        for (int ai = 0; ai < 2; ++ai)
#pragma unroll
            for (int m = 0; m < 4; ++m) { bf16_t* rowp = O + (size_t)(row0 + ai * HALF + m * 16) * ldc + col0;
#pragma unroll
                for (int bj = 0; bj < 2; ++bj) { const f32x4 v0 = acc[ai][bj][m][0], v1 = acc[ai][bj][m][1];
                    u32x4 w; w.x = cvt_pk_bf16(v0[0], v0[1]); w.y = cvt_pk_bf16(v0[2], v0[3]); w.z = cvt_pk_bf16(v1[0], v1[1]); w.w = cvt_pk_bf16(v1[2], v1[3]);
                    *(u32x4*)(rowp + bj * HALF) = w; } }
    }
};
struct EpiSwiGLU {
    static constexpr bool PERM = true, AFTER_DRAIN = false;
    bf16_t* H;
    __device__ __forceinline__ void operator()(const Acc& acc, const Unit& u, int wr, int wc, int fr, int fq) const {
        const int row0 = u.pm * BM + wr * 64 + fr, col0 = u.pn * HALF + wc * 32 + 8 * fq;
#pragma unroll
        for (int ai = 0; ai < 2; ++ai)
#pragma unroll
            for (int m = 0; m < 4; ++m) { bf16_t* rowp = H + (size_t)(row0 + ai * HALF + m * 16) * DFF + col0;
                float h[8];
#pragma unroll
                for (int n = 0; n < 2; ++n)
#pragma unroll
                    for (int j = 0; j < 4; ++j) { const float gt = acc[ai][0][m][n][j], up = acc[ai][1][m][n][j]; h[n * 4 + j] = gt * sigmoidf_fast(gt) * up; }
                u32x4 w; w.x = cvt_pk_bf16(h[0], h[1]); w.y = cvt_pk_bf16(h[2], h[3]); w.z = cvt_pk_bf16(h[4], h[5]); w.w = cvt_pk_bf16(h[6], h[7]);
                *(u32x4*)rowp = w; }
    }
};
struct EpiGate {
    static constexpr bool PERM = true, AFTER_DRAIN = false;
    bf16_t* G;
    __device__ __forceinline__ void operator()(const Acc& acc, const Unit& u, int wr, int wc, int fr, int fq) const {
        const int row0 = u.pm * BM + wr * 64 + fr, col0 = u.pn * BM + wc * 32 + 8 * fq;
#pragma unroll
        for (int ai = 0; ai < 2; ++ai)
#pragma unroll
            for (int m = 0; m < 4; ++m) { bf16_t* rowp = G + (size_t)(row0 + ai * HALF + m * 16) * 2048 + col0;
#pragma unroll
                for (int bj = 0; bj < 2; ++bj) { const f32x4 v0 = acc[ai][bj][m][0], v1 = acc[ai][bj][m][1];
                    u32x4 w; w.x = cvt_pk_bf16(sigmoidf_fast(v0[0]), sigmoidf_fast(v0[1])); w.y = cvt_pk_bf16(sigmoidf_fast(v0[2]), sigmoidf_fast(v0[3]));
                    w.z = cvt_pk_bf16(sigmoidf_fast(v1[0]), sigmoidf_fast(v1[1])); w.w = cvt_pk_bf16(sigmoidf_fast(v1[2]), sigmoidf_fast(v1[3]));
                    *(u32x4*)(rowp + bj * HALF) = w; } }
    }
};
struct EpiQ {
    static constexpr bool PERM = true, AFTER_DRAIN = false;
    bf16_t* Q; const float* TAB;
    __device__ __forceinline__ void operator()(const Acc& acc, const Unit& u, int wr, int wc, int fr, int fq) const {
        const int row0 = u.pm * BM + wr * 64 + fr, col0 = u.pn * BM + wc * 32 + 8 * fq;
#pragma unroll
        for (int ai = 0; ai < 2; ++ai)
#pragma unroll
            for (int m = 0; m < 4; ++m) { const int row = row0 + ai * HALF + m * 16; bf16_t* rowp = Q + (size_t)row * 1536 + col0;
#pragma unroll
                for (int bj = 0; bj < 2; ++bj) { f32x4 v0 = acc[ai][bj][m][0], v1 = acc[ai][bj][m][1];
                    const int c = col0 + bj * HALF, w = c % 192;
                    if (w >= 128) { const int i0 = (w - 128) >> 1; const f32x4 cs = *(const f32x4*)(TAB + (size_t)row * 64 + i0), sn = *(const f32x4*)(TAB + (size_t)row * 64 + 32 + i0);
                        f32x4 r0, r1;
                        r0[0] = v0[0] * cs[0] - v0[1] * sn[0]; r0[1] = v0[1] * cs[0] + v0[0] * sn[0];
                        r0[2] = v0[2] * cs[1] - v0[3] * sn[1]; r0[3] = v0[3] * cs[1] + v0[2] * sn[1];
                        r1[0] = v1[0] * cs[2] - v1[1] * sn[2]; r1[1] = v1[1] * cs[2] + v1[0] * sn[2];
                        r1[2] = v1[2] * cs[3] - v1[3] * sn[3]; r1[3] = v1[3] * cs[3] + v1[2] * sn[3];
                        v0 = r0; v1 = r1; }
                    u32x4 wv; wv.x = cvt_pk_bf16(v0[0], v0[1]); wv.y = cvt_pk_bf16(v0[2], v0[3]); wv.z = cvt_pk_bf16(v1[0], v1[1]); wv.w = cvt_pk_bf16(v1[2], v1[3]);
                    *(u32x4*)(rowp + bj * HALF) = wv; } }
    }
};
struct EpiT1 {
    static constexpr bool PERM = true, AFTER_DRAIN = false;
    const bf16_t* G; bf16_t* F;
    __device__ __forceinline__ void operator()(const Acc& acc, const Unit& u, int wr, int wc, int fr, int fq) const {
        const int row0 = u.pm * BM + wr * 64 + fr, col0 = u.pn * BM + wc * 32 + 8 * fq;
#pragma unroll
        for (int ai = 0; ai < 2; ++ai)
#pragma unroll
            for (int m = 0; m < 4; ++m) { const int row = row0 + ai * HALF + m * 16;
#pragma unroll
                for (int bj = 0; bj < 2; ++bj) { const f32x4 v0 = acc[ai][bj][m][0], v1 = acc[ai][bj][m][1]; const int c = col0 + bj * HALF;
                    const u32x4 gw = *(const u32x4*)(G + (size_t)row * 2048 + c);
                    u32x4 wv;
                    wv.x = cvt_pk_bf16(v0[0] * bf_lo(gw.x), v0[1] * bf_hi(gw.x)); wv.y = cvt_pk_bf16(v0[2] * bf_lo(gw.y), v0[3] * bf_hi(gw.y));
                    wv.z = cvt_pk_bf16(v1[0] * bf_lo(gw.z), v1[1] * bf_hi(gw.z)); wv.w = cvt_pk_bf16(v1[2] * bf_lo(gw.w), v1[3] * bf_hi(gw.w));
                    *(u32x4*)(F + (size_t)row * 1024 + c) = wv; } }
    }
};
struct EpiMX {
    static constexpr bool PERM = true, AFTER_DRAIN = false;
    const bf16_t* G; const bf16_t* F; bf16_t* MX;
    __device__ __forceinline__ void operator()(const Acc& acc, const Unit& u, int wr, int wc, int fr, int fq) const {
        const int row0 = u.pm * BM + wr * 64 + fr, col0 = u.pn * BM + wc * 32 + 8 * fq;
#pragma unroll
        for (int ai = 0; ai < 2; ++ai)
#pragma unroll
            for (int m = 0; m < 4; ++m) { const int row = row0 + ai * HALF + m * 16;
#pragma unroll
                for (int bj = 0; bj < 2; ++bj) { const f32x4 v0 = acc[ai][bj][m][0], v1 = acc[ai][bj][m][1]; const int c = col0 + bj * HALF;
                    const u32x4 gw = *(const u32x4*)(G + (size_t)row * 2048 + 1024 + c);
                    const u32x4 tw = *(const u32x4*)(F + (size_t)row * 1024 + c);
                    u32x4 wv;
                    wv.x = cvt_pk_bf16(bf_lo(tw.x) + v0[0] * bf_lo(gw.x), bf_hi(tw.x) + v0[1] * bf_hi(gw.x)); wv.y = cvt_pk_bf16(bf_lo(tw.y) + v0[2] * bf_lo(gw.y), bf_hi(tw.y) + v0[3] * bf_hi(gw.y));
                    wv.z = cvt_pk_bf16(bf_lo(tw.z) + v1[0] * bf_lo(gw.z), bf_hi(tw.z) + v1[1] * bf_hi(gw.z)); wv.w = cvt_pk_bf16(bf_lo(tw.w) + v1[2] * bf_lo(gw.w), bf_hi(tw.w) + v1[3] * bf_hi(gw.w));
                    *(u32x4*)(MX + (size_t)row * 1024 + c) = wv; } }
    }
};

struct PanelSumSq {
    float* xbuf;
    unsigned* cnt;
    __device__ __forceinline__ void run(const Acc& v, const Unit& u, int wr, int wc, int fr, int fq, LAS unsigned char* lds, int wid, int lane) const {
        LAS float* P = (LAS float*)lds; LAS float* S = (LAS float*)(lds + 4096);
#pragma unroll
        for (int ai = 0; ai < 2; ++ai)
#pragma unroll
            for (int m = 0; m < 4; ++m) { float q = 0.f;
#pragma unroll
                for (int bj = 0; bj < 2; ++bj)
#pragma unroll
                    for (int n = 0; n < 2; ++n) { const f32x4 x = v[ai][bj][m][n]; q += (x[0] * x[0] + x[1] * x[1]) + (x[2] * x[2] + x[3] * x[3]); }
                q += __shfl_xor(q, 16); q += __shfl_xor(q, 32);
                if (fq == 0) P[(ai * HALF + wr * 64 + m * 16 + fr) * 4 + wc] = q; }
        asm volatile("s_waitcnt lgkmcnt(0)" ::: "memory"); __builtin_amdgcn_s_barrier(); asm volatile("" ::: "memory");
        const int row = wid * 32 + (lane & 31);
        if (lane < 32) { const float t = (P[row * 4 + 0] + P[row * 4 + 1]) + (P[row * 4 + 2] + P[row * 4 + 3]);
            __hip_atomic_store(xbuf + ((size_t)(u.pm * BM + row) * 4 + u.pn), t, __ATOMIC_RELAXED, __HIP_MEMORY_SCOPE_AGENT); }
        asm volatile("s_waitcnt vmcnt(0)" ::: "memory");
        if (lane == 0) __hip_atomic_fetch_add(cnt + 64 * u.pm, 1u, __ATOMIC_RELAXED, __HIP_MEMORY_SCOPE_AGENT);
        if (wid == 0) { unsigned sp = 0u;
            while ((unsigned)__builtin_amdgcn_readfirstlane(__hip_atomic_load(cnt + 64 * u.pm, __ATOMIC_RELAXED, __HIP_MEMORY_SCOPE_AGENT)) < 32u) { __builtin_amdgcn_s_sleep(1); if (++sp > (1u << 22)) break; }
            __builtin_amdgcn_fence(__ATOMIC_ACQUIRE, "agent"); }
        asm volatile("s_waitcnt vmcnt(0) lgkmcnt(0)" ::: "memory"); __builtin_amdgcn_s_barrier(); asm volatile("" ::: "memory");
        if (lane < 32) { const float* slot = xbuf + (size_t)(u.pm * BM + row) * 4; float tot = 0.f;
#pragma unroll
            for (int t = 0; t < 4; ++t) tot += __hip_atomic_load(slot + t, __ATOMIC_RELAXED, __HIP_MEMORY_SCOPE_AGENT);
            S[row] = __builtin_amdgcn_rsqf(tot * (1.f / 1024.f) + EPS); }
        asm volatile("s_waitcnt lgkmcnt(0)" ::: "memory"); __builtin_amdgcn_s_barrier(); asm volatile("" ::: "memory");
    }
};
template <bool FINAL> struct EpiResNorm {
    static constexpr bool PERM = false, AFTER_DRAIN = true;
    const float* base; float* out; bf16_t* xn; float wt; const float* gpost; const float* gnext; PanelSumSq st1, st2;
    __device__ __forceinline__ void operator()(const Acc&, const Unit&, int, int, int, int) const {}
    __device__ __forceinline__ void fused(Acc& acc, const Unit& u, int wr, int wc, int fr, int fq, LAS unsigned char* lds, int wid, int lane) const {
        const LAS float* S = (const LAS float*)(lds + 4096);
        const int col0 = u.pn * BM + wc * 32 + 4 * fq;
        st1.run(acc, u, wr, wc, fr, fq, lds, wid, lane);
#pragma unroll
        for (int ai = 0; ai < 2; ++ai)
#pragma unroll
            for (int m = 0; m < 4; ++m) { const int r = ai * HALF + wr * 64 + m * 16 + fr; const float sr = S[r] * wt; const size_t off = (size_t)(u.pm * BM + r) * 1024 + col0;
#pragma unroll
                for (int bj = 0; bj < 2; ++bj)
#pragma unroll
                    for (int n = 0; n < 2; ++n) { const f32x4 bs = *(const f32x4*)(base + off + bj * HALF + n * 16); const f32x4 g = *(const f32x4*)(gpost + col0 + bj * HALF + n * 16);
                        acc[ai][bj][m][n] = bs + acc[ai][bj][m][n] * g * sr; }
                asm volatile("" : "+v"(acc[ai][0][m][0]), "+v"(acc[ai][0][m][1]), "+v"(acc[ai][1][m][0]), "+v"(acc[ai][1][m][1]));
                if (m & 1) asm volatile("" ::: "memory"); }
        st2.run(acc, u, wr, wc, fr, fq, lds, wid, lane);
#pragma unroll
        for (int ai = 0; ai < 2; ++ai)
#pragma unroll
            for (int m = 0; m < 4; ++m) { const int r = ai * HALF + wr * 64 + m * 16 + fr; const float sr = S[r]; const size_t off = (size_t)(u.pm * BM + r) * 1024 + col0;
#pragma unroll
                for (int bj = 0; bj < 2; ++bj)
#pragma unroll
                    for (int n = 0; n < 2; ++n) { const f32x4 x1 = acc[ai][bj][m][n]; const f32x4 g = *(const f32x4*)(gnext + col0 + bj * HALF + n * 16); const f32x4 o = x1 * g * sr;
                        if (FINAL) *(f32x4*)(out + off + bj * HALF + n * 16) = o;
                        else { *(f32x4*)(out + off + bj * HALF + n * 16) = x1; u32x2 w; w.x = cvt_pk_bf16(o[0], o[1]); w.y = cvt_pk_bf16(o[2], o[3]); *(u32x2*)(xn + off + bj * HALF + n * 16) = w; } }
                asm volatile("" ::: "memory"); }
    }
};
}

namespace att {
constexpr int NW = 8, QBLK = 32, KVBLK = 64;
constexpr float SCALE = 0.07216878364870322f;
constexpr float THR = 8.f;
constexpr int LDQ = 1536, LDKV = 2048, LDKR = 64, LDO = 1024;
constexpr int SHM_V = 64 * 128 * 2, SHM_K = 64 * 128 * 2, SHM_R = 64 * 64 * 2;
constexpr int NQL = 4;
constexpr int OFF_V = 0, OFF_K = 2 * SHM_V, OFF_RP = OFF_K + 2 * SHM_K, OFF_WS = OFF_RP + 2 * SHM_R, OFF_QL = OFF_WS + NW * 64 * 4, SHM_ATTN = OFF_QL + NW * NQL * 1024;
static_assert(SHM_ATTN <= LDS_STAGE, "lds");
#define KSWZ(row, colB) ((row) * 256 + ((colB) ^ (((row) & 7) << 4)))
#define RSWZ(row, colB) ((row) * 128 + ((colB) ^ (((row) & 7) << 4)))
#define SBAR() __builtin_amdgcn_sched_barrier(0)
__device__ __forceinline__ int crow(int r, int hi) { return (r & 3) + 8 * (r >> 2) + 4 * hi; }
__device__ __forceinline__ bf16x8 ld8(const bf16_t* p) { return *reinterpret_cast<const bf16x8*>(p); }

__device__ __forceinline__ void partialSM(f32x16& p0, f32x16& p1, float& m_reg, float& mn, float& alpha) {
    constexpr float C = SCALE * 1.4426950408889634f;
    float pmax = p0[0];
#pragma unroll
    for (int r = 1; r < 16; ++r) pmax = fmaxf(pmax, p0[r]);
#pragma unroll
    for (int r = 0; r < 16; ++r) pmax = fmaxf(pmax, p1[r]);
    { auto rr = __builtin_amdgcn_permlane32_swap(__float_as_uint(pmax), __float_as_uint(pmax), false, false);
      pmax = fmaxf(__uint_as_float(rr[0]), __uint_as_float(rr[1])); }
    if (__builtin_expect(__all(pmax - m_reg <= THR / SCALE), 1)) { mn = m_reg; alpha = 1.f; }
    else { mn = fmaxf(m_reg, pmax); alpha = __builtin_amdgcn_exp2f((m_reg - mn) * C); m_reg = mn; }
    float mnC = -mn * C;
#pragma unroll
    for (int r = 0; r < 16; ++r) p0[r] = fmaf(p0[r], C, mnC);
#pragma unroll
    for (int r = 0; r < 16; ++r) p1[r] = fmaf(p1[r], C, mnC);
#pragma unroll
    for (int r = 0; r < 16; ++r) p0[r] = __builtin_amdgcn_exp2f(p0[r]);
}
__device__ __forceinline__ void finishSM(f32x16& p0, f32x16& p1, float alpha, float& l_reg, bf16x8& pa0, bf16x8& pa1, bf16x8& pa2, bf16x8& pa3) {
#pragma unroll
    for (int r = 0; r < 16; ++r) p1[r] = __builtin_amdgcn_exp2f(p1[r]);
    float ps = 0;
#pragma unroll
    for (int r = 0; r < 16; ++r) ps += p0[r];
#pragma unroll
    for (int r = 0; r < 16; ++r) ps += p1[r];
    { auto rr = __builtin_amdgcn_permlane32_swap(__float_as_uint(ps), __float_as_uint(ps), false, false);
      ps = __uint_as_float(rr[0]) + __uint_as_float(rr[1]); }
    l_reg = l_reg * alpha + ps;
#define PK4(P, BASE, OUT) do { unsigned a0 = cvt_pk_bf16(P[BASE + 0], P[BASE + 1]), a1 = cvt_pk_bf16(P[BASE + 2], P[BASE + 3]);   \
    unsigned b0 = cvt_pk_bf16(P[BASE + 4], P[BASE + 5]), b1 = cvt_pk_bf16(P[BASE + 6], P[BASE + 7]);                              \
    auto r0 = __builtin_amdgcn_permlane32_swap(a0, b0, false, false); auto r1 = __builtin_amdgcn_permlane32_swap(a1, b1, false, false); \
    u32x4 w = {r0[0], r1[0], r0[1], r1[1]}; OUT = *reinterpret_cast<bf16x8*>(&w); } while (0)
    PK4(p0, 0, pa0); PK4(p0, 8, pa1); PK4(p1, 0, pa2); PK4(p1, 8, pa3);
#undef PK4
}
__device__ __forceinline__ void qkt(f32x16& p0, f32x16& p1, const char* Ks, const char* Rs, const bf16x8* qr, const char* ql, int r32, int hi) {
    p0 = f32x16{}; p1 = f32x16{};
#pragma unroll
    for (int d0 = 0; d0 < 8; ++d0) { int cb = (d0 * 16 + hi * 8) * 2;
        bf16x8 b0 = *reinterpret_cast<const bf16x8*>(Ks + KSWZ(r32, cb));
        bf16x8 b1 = *reinterpret_cast<const bf16x8*>(Ks + KSWZ(32 + r32, cb));
        p0 = __builtin_amdgcn_mfma_f32_32x32x16_bf16(b0, qr[d0], p0, 0, 0, 0);
        p1 = __builtin_amdgcn_mfma_f32_32x32x16_bf16(b1, qr[d0], p1, 0, 0, 0); }
#pragma unroll
    for (int d0 = 0; d0 < 4; ++d0) { int cb = (d0 * 16 + hi * 8) * 2;
        bf16x8 b0 = *reinterpret_cast<const bf16x8*>(Rs + RSWZ(r32, cb));
        bf16x8 b1 = *reinterpret_cast<const bf16x8*>(Rs + RSWZ(32 + r32, cb));
        const bf16x8 qv = *reinterpret_cast<const bf16x8*>(ql + d0 * 1024);
        p0 = __builtin_amdgcn_mfma_f32_32x32x16_bf16(b0, qv, p0, 0, 0, 0);
        p1 = __builtin_amdgcn_mfma_f32_32x32x16_bf16(b1, qv, p1, 0, 0, 0); }
}
__device__ __forceinline__ int v_st(int k, int c) { const int kk = (k & ~0xC) | ((k & 4) << 1) | ((k & 8) >> 1); return ((kk >> 3) * 4 + (c >> 5)) * 512 + ((kk & 7) * 32 + (c & 31)) * 2; }
__device__ __forceinline__ int v_rd_base(int lane) { return ((lane & 3) << 3) | (((lane >> 2) & 3) << 6) | (((lane >> 4) & 1) << 5) | (((lane >> 5) & 1) << 8); }
constexpr int v_rd_off(int d0, int ks, int half) { return d0 * 512 + ks * 4096 + half * 2048; }
template <int OFF> __device__ __forceinline__ s16x4 tr_read(int vb) {
    s16x4 r; asm volatile("ds_read_b64_tr_b16 %0, %1 offset:%2" : "=&v"(r) : "v"(vb), "i"(OFF) : "memory"); return r;
}
template <int D0> __device__ __forceinline__ void pv_one(f32x16& od, int vb, bf16x8 pa0, bf16x8 pa1, bf16x8 pa2, bf16x8 pa3) {
    const s16x4 l0 = tr_read<v_rd_off(D0, 0, 0)>(vb), h0 = tr_read<v_rd_off(D0, 0, 1)>(vb), l1 = tr_read<v_rd_off(D0, 1, 0)>(vb), h1 = tr_read<v_rd_off(D0, 1, 1)>(vb);
    const s16x4 l2 = tr_read<v_rd_off(D0, 2, 0)>(vb), h2 = tr_read<v_rd_off(D0, 2, 1)>(vb), l3 = tr_read<v_rd_off(D0, 3, 0)>(vb), h3 = tr_read<v_rd_off(D0, 3, 1)>(vb);
    asm volatile("s_waitcnt lgkmcnt(0)" ::: "memory"); SBAR();
#define PK(L, H) (bf16x8){L[0], L[1], L[2], L[3], H[0], H[1], H[2], H[3]}
    od = __builtin_amdgcn_mfma_f32_32x32x16_bf16(pa0, PK(l0, h0), od, 0, 0, 0);
    od = __builtin_amdgcn_mfma_f32_32x32x16_bf16(pa1, PK(l1, h1), od, 0, 0, 0);
    od = __builtin_amdgcn_mfma_f32_32x32x16_bf16(pa2, PK(l2, h2), od, 0, 0, 0);
    od = __builtin_amdgcn_mfma_f32_32x32x16_bf16(pa3, PK(l3, h3), od, 0, 0, 0);
#undef PK
}
__device__ __forceinline__ void pv_d0(f32x16* o, int vb, bf16x8 pa0, bf16x8 pa1, bf16x8 pa2, bf16x8 pa3) {
    pv_one<0>(o[0], vb, pa0, pa1, pa2, pa3); pv_one<1>(o[1], vb, pa0, pa1, pa2, pa3); pv_one<2>(o[2], vb, pa0, pa1, pa2, pa3); pv_one<3>(o[3], vb, pa0, pa1, pa2, pa3);
}

__device__ __forceinline__ void attn_body(const bf16_t* __restrict__ Qb, const bf16_t* __restrict__ Kn, const bf16_t* __restrict__ Kr, const bf16_t* __restrict__ Vh,
                                          bf16_t* __restrict__ Ob, int seq, char* lds) {
    const int tid = fresh_tid(), wid = tid >> 6, lane = tid & 63, r32 = lane & 31, hi = lane >> 5;
    char* V_lds = lds + OFF_V; char* K_lds = lds + OFF_K; char* R_lds = lds + OFF_RP;
    float* ws = (float*)(lds + OFF_WS) + wid * 64; float* li_l = ws; float* al_l = ws + 32;
    float m_reg = -1e30f, l_reg = 0; f32x16 o[4] = {}; bf16x8 qr[8];
    char* ql = lds + OFF_QL + wid * (NQL * 1024) + lane * 16;
    const bf16_t* Qw = Qb + (long)(wid * QBLK + r32) * LDQ + hi * 8;
#pragma unroll
    for (int d0 = 0; d0 < 8; ++d0) qr[d0] = ld8(Qw + d0 * 16);
#pragma unroll
    for (int d0 = 0; d0 < NQL; ++d0) *reinterpret_cast<bf16x8*>(ql + d0 * 1024) = ld8(Qw + (8 + d0) * 16);
    const int sr = tid >> 4, sc = (tid & 15) * 8, vst0 = v_st(sr, sc), vst1 = v_st(32 + sr, sc);
    const int rr_ = tid >> 3, rc_ = (tid & 7) * 8;
    const int vb0 = (int)(uintptr_t)V_lds + v_rd_base(lane);
    bf16x8 vs0, vs1, ks0, ks1, rs0;
#define SLOAD(k0) do { vs0 = ld8(&Vh[(long)((k0) + sr) * LDKV + sc]); vs1 = ld8(&Vh[(long)((k0) + 32 + sr) * LDKV + sc]); \
    ks0 = ld8(&Kn[(long)((k0) + sr) * LDKV + sc]); ks1 = ld8(&Kn[(long)((k0) + 32 + sr) * LDKV + sc]); rs0 = ld8(&Kr[(long)((k0) + rr_) * LDKR + rc_]); } while (0)
#define SWRITE(b) do { *(bf16x8*)(V_lds + (b) * SHM_V + vst0) = vs0; *(bf16x8*)(V_lds + (b) * SHM_V + vst1) = vs1; int kc = sc * 2; \
    *(bf16x8*)(K_lds + (b) * SHM_K + KSWZ(sr, kc)) = ks0; *(bf16x8*)(K_lds + (b) * SHM_K + KSWZ(32 + sr, kc)) = ks1; \
    *(bf16x8*)(R_lds + (b) * SHM_R + RSWZ(rr_, rc_ * 2)) = rs0; } while (0)
#define RESC(a) do { if (__any((a) < 1.f)) { if (hi == 0) al_l[r32] = (a); asm volatile("s_waitcnt lgkmcnt(0)" ::: "memory"); \
    _Pragma("unroll") for (int d = 0; d < 4; ++d) _Pragma("unroll") for (int r = 0; r < 16; ++r) o[d][r] *= al_l[crow(r, hi)]; } } while (0)
    f32x16 pA0, pA1, pB0, pB1; float mnA, mnB, alA, alB; bf16x8 pa0, pa1, pa2, pa3; const int NT = seq / KVBLK;
    SLOAD(0); asm volatile("s_waitcnt vmcnt(0)" ::: "memory"); SWRITE(0); __syncthreads();
    qkt(pA0, pA1, K_lds, R_lds, qr, ql, r32, hi); partialSM(pA0, pA1, m_reg, mnA, alA);
    SLOAD(KVBLK);
    asm volatile("s_waitcnt vmcnt(0)" ::: "memory"); SWRITE(1); __syncthreads();
    for (int j = 1; j + 1 < NT; j += 2) {
        SBAR(); qkt(pB0, pB1, K_lds + SHM_K, R_lds + SHM_R, qr, ql, r32, hi);
        finishSM(pA0, pA1, alA, l_reg, pa0, pa1, pa2, pa3); SBAR();
        SLOAD((j + 1) * KVBLK); SBAR();
        pv_d0(o, vb0, pa0, pa1, pa2, pa3); partialSM(pB0, pB1, m_reg, mnB, alB);
        __syncthreads(); asm volatile("s_waitcnt vmcnt(0)" ::: "memory"); SWRITE(0);
        RESC(alB); __syncthreads();
        SBAR(); qkt(pA0, pA1, K_lds, R_lds, qr, ql, r32, hi);
        finishSM(pB0, pB1, alB, l_reg, pa0, pa1, pa2, pa3); SBAR();
        SLOAD((j + 2) * KVBLK); SBAR();
        pv_d0(o, vb0 + SHM_V, pa0, pa1, pa2, pa3); partialSM(pA0, pA1, m_reg, mnA, alA);
        __syncthreads(); asm volatile("s_waitcnt vmcnt(0)" ::: "memory"); SWRITE(1);
        RESC(alA); __syncthreads();
    }
    SBAR(); qkt(pB0, pB1, K_lds + SHM_K, R_lds + SHM_R, qr, ql, r32, hi);
    finishSM(pA0, pA1, alA, l_reg, pa0, pa1, pa2, pa3); SBAR();
    pv_d0(o, vb0, pa0, pa1, pa2, pa3); partialSM(pB0, pB1, m_reg, mnB, alB);
    __syncthreads(); RESC(alB);
    finishSM(pB0, pB1, alB, l_reg, pa0, pa1, pa2, pa3); SBAR();
    pv_d0(o, vb0 + SHM_V, pa0, pa1, pa2, pa3);
    if (hi == 0) li_l[r32] = l_reg; asm volatile("s_waitcnt lgkmcnt(0)" ::: "memory");
    float rli[16];
#pragma unroll
    for (int r = 0; r < 16; ++r) rli[r] = __builtin_amdgcn_rcpf(li_l[crow(r, hi)]);
    bf16_t* Ow = Ob + (long)(wid * QBLK) * LDO;
#pragma unroll
    for (int r = 0; r < 16; ++r) { int orow = crow(r, hi);
#pragma unroll
        for (int d0 = 0; d0 < 4; ++d0) { const float v = o[d0][r] * rli[r]; Ow[(long)orow * LDO + d0 * 32 + r32] = (bf16_t)(cvt_pk_bf16(v, v) & 0xffffu); } }
#undef SLOAD
#undef SWRITE
#undef RESC
}
}


#define XB_TMO      128
#define XB_XCNT(j)  (256  + 64 * (j))
#define XB_XSUB(j)  (1280 + 64 * (j))
#define XB_XGEN(j)  (2304 + 64 * (j))
#define XB_TOP      3328
#define XB_TOPGEN   3392
#define XCD_BAR_WORDS 3456
#define XB_SPIN_CAP (1u << 18)
__device__ __forceinline__ unsigned xb_ld(unsigned* p)              { return __hip_atomic_load(p, __ATOMIC_RELAXED, __HIP_MEMORY_SCOPE_AGENT); }
__device__ __forceinline__ unsigned xb_add(unsigned* p, unsigned v) { return __hip_atomic_fetch_add(p, v, __ATOMIC_RELAXED, __HIP_MEMORY_SCOPE_AGENT); }
__device__ __forceinline__ unsigned xb_xcc_id() { return (unsigned)__builtin_amdgcn_s_getreg((3 << 11) | 20) & 0xFu; }
#define XB_SPIN(cond, bar) do { unsigned _sp = 0; while (cond) { __builtin_amdgcn_s_sleep(1); \
    if ((++_sp & 255u) == 0u) { if (xb_ld(&(bar)[XB_TMO])) break; if (_sp > XB_SPIN_CAP) { atomicAdd(&(bar)[XB_TMO], 1u); break; } } } } while (0)
struct XcdBarrier { unsigned* bar; unsigned x; volatile LAS unsigned* st; };
__device__ __forceinline__ XcdBarrier xcd_barrier_post(unsigned* bar, volatile LAS unsigned* st) {
    XcdBarrier b; b.bar = bar; b.x = xb_xcc_id(); b.st = st;
    if (threadIdx.x == 0) (void)xb_add(&bar[XB_XCNT(b.x)], 1u);
    return b;
}
__device__ __forceinline__ void xcd_barrier_complete(unsigned* bar, unsigned x, unsigned& nloc, unsigned& nx) {
    const unsigned G = gridDim.x * gridDim.y * gridDim.z;
    unsigned sum, cnt, mine, sp = 0u;
    for (;;) {
        sum = 0u; cnt = 0u; mine = 0u;
#pragma unroll
        for (unsigned j = 0; j < 16; ++j) { const unsigned c = xb_ld(&bar[XB_XCNT(j)]); sum += c; cnt += (c > 0u) ? 1u : 0u; mine = (j == x) ? c : mine; }
        if (sum == G) break;
        __builtin_amdgcn_s_sleep(1);
        if ((++sp & 255u) == 0u) { if (xb_ld(&bar[XB_TMO])) break; if (sp > XB_SPIN_CAP) { atomicAdd(&bar[XB_TMO], 1u); break; } }
    }
    nloc = mine > 0u ? mine : 1u; nx = cnt > 0u ? cnt : 1u;
}
__device__ __forceinline__ void xcd_barrier(const XcdBarrier& b) {
    asm volatile("s_waitcnt vmcnt(0)" ::: "memory");
    __syncthreads();
    if (threadIdx.x == 0) {
        unsigned* bar = b.bar;
        __builtin_amdgcn_s_waitcnt(0);
        unsigned nloc = b.st[0], nx = b.st[1];
        if (nloc == 0u) { xcd_barrier_complete(bar, b.x, nloc, nx); b.st[0] = nloc; b.st[1] = nx; }
        const unsigned old = xb_add(&bar[XB_XSUB(b.x)], 1u);
        const unsigned gen = old / nloc;
        if (old + 1u == (gen + 1u) * nloc) {
            __builtin_amdgcn_fence(__ATOMIC_RELEASE, "agent");
            asm volatile("s_waitcnt vmcnt(0)" ::: "memory");
            const unsigned og = xb_add(&bar[XB_TOP], 1u);
            const unsigned tg = og / nx;
            if (og + 1u == (tg + 1u) * nx) xb_add(&bar[XB_TOPGEN], 1u);
            else XB_SPIN(xb_ld(&bar[XB_TOPGEN]) == tg, bar);
            __builtin_amdgcn_fence(__ATOMIC_ACQUIRE, "agent");
            xb_add(&bar[XB_XGEN(b.x)], 1u);
            asm volatile("s_waitcnt vmcnt(0)" ::: "memory");
        } else {
            XB_SPIN(xb_ld(&bar[XB_XGEN(b.x)]) == gen, bar);
            __builtin_amdgcn_fence(__ATOMIC_ACQUIRE, "agent");
            asm volatile("s_waitcnt vmcnt(0)" ::: "memory");
        }
    }
    __syncthreads();
}

enum { TR_PLAIN = 0, TR_GU = 1, TR_WIN = 2, TR_UQ = 3, TR_UKV = 4 };
template <int MODE>
__device__ __forceinline__ void tr_job(const float* W0, const float* W1, int K, int Nsrc, int Nout, bf16_t* WT, LAS float* scr, int lane, int gw, int NGW) {
    const int nblk = Nout / 32, nitems = (K / 64) * nblk;
    for (int it = gw; it < nitems; it += NGW) {
        const int kb = it / nblk, nb = it % nblk, k0 = 64 * kb, n0 = 32 * nb, np = n0 + (lane & 31);
        const float* colp;
        if (MODE == TR_PLAIN) colp = W0 + np;
        else if (MODE == TR_GU) { const int t = np >> 8, w = np & 255; colp = (w < 128 ? W0 : W1) + t * 128 + (w & 127); }
        else if (MODE == TR_WIN) colp = np < 1216 ? W0 + np : (np < 1280 ? nullptr : W0 + (np - 64));
        else if (MODE == TR_UQ) { const int h = np / 192, w = np % 192; colp = W0 + (w < 128 ? np : h * 192 + 128 + ((w - 128) >> 1) + ((w - 128) & 1) * 32); }
        else colp = np < 1024 ? W0 + np : W1 + (np - 1024);
        float tv[32];
#pragma unroll
        for (int i = 0; i < 32; ++i) { const int kk = 2 * i + (lane >> 5); tv[i] = colp ? colp[(size_t)(k0 + kk) * Nsrc] : 0.f; }
#pragma unroll
        for (int i = 0; i < 32; ++i) { const int kk = 2 * i + (lane >> 5); scr[kk * 33 + (lane & 31)] = tv[i]; }
        asm volatile("s_waitcnt lgkmcnt(0)" ::: "memory");
        const int c = lane & 7;
#pragma unroll
        for (int j = 0; j < 4; ++j) { const int n = (lane >> 3) + 8 * j; const LAS float* s = scr + (8 * c) * 33 + n;
            u32x4 o; o.x = cvt_pk_bf16(s[0 * 33], s[1 * 33]); o.y = cvt_pk_bf16(s[2 * 33], s[3 * 33]); o.z = cvt_pk_bf16(s[4 * 33], s[5 * 33]); o.w = cvt_pk_bf16(s[6 * 33], s[7 * 33]);
            *(u32x4*)(WT + (size_t)(n0 + n) * K + k0 + 8 * c) = o; }
        asm volatile("s_waitcnt lgkmcnt(0)" ::: "memory");
    }
}

template <int MODE>
__device__ __forceinline__ void rows_phase(const float* xin, const bf16_t* f, float wt, const float* gpost, const float* gnext, float* xout, bf16_t* xn, int gw, int NGW, int lane) {
    for (int row0 = gw; row0 < M; row0 += 2 * NGW) {
        f32x4 xv[2][4]; u32x2 fw[2][4];
#pragma unroll
        for (int r = 0; r < 2; ++r) { const size_t row = (size_t)(row0 + r * NGW);
#pragma unroll
            for (int j = 0; j < 4; ++j) { xv[r][j] = *(const f32x4*)(xin + row * DM + 4 * (lane + 64 * j));
                if (MODE != 0) fw[r][j] = *(const u32x2*)(f + row * DM + 4 * (lane + 64 * j)); } }
#pragma unroll
        for (int r = 0; r < 2; ++r) { const size_t row = (size_t)(row0 + r * NGW);
            if (MODE != 0) {
                f32x4 fv[4]; float ss = 0.f;
#pragma unroll
                for (int j = 0; j < 4; ++j) { fv[j] = (f32x4){bf_lo(fw[r][j].x), bf_hi(fw[r][j].x), bf_lo(fw[r][j].y), bf_hi(fw[r][j].y)}; ss += fv[j].x * fv[j].x + fv[j].y * fv[j].y + fv[j].z * fv[j].z + fv[j].w * fv[j].w; }
                const float rr = wt * __builtin_amdgcn_rsqf(wave_sum(ss) * (1.f / DM) + EPS);
#pragma unroll
                for (int j = 0; j < 4; ++j) { const f32x4 g = *(const f32x4*)(gpost + 4 * (lane + 64 * j)); xv[r][j] = xv[r][j] + fv[j] * g * rr; }
                if (MODE == 1) {
#pragma unroll
                    for (int j = 0; j < 4; ++j) *(f32x4*)(xout + row * DM + 4 * (lane + 64 * j)) = xv[r][j];
                }
            }
            float s2 = 0.f;
#pragma unroll
            for (int j = 0; j < 4; ++j) s2 += xv[r][j].x * xv[r][j].x + xv[r][j].y * xv[r][j].y + xv[r][j].z * xv[r][j].z + xv[r][j].w * xv[r][j].w;
            const float r2 = __builtin_amdgcn_rsqf(wave_sum(s2) * (1.f / DM) + EPS);
#pragma unroll
            for (int j = 0; j < 4; ++j) { const f32x4 g = *(const f32x4*)(gnext + 4 * (lane + 64 * j)); const f32x4 y = xv[r][j] * g * r2;
                if (MODE == 2) *(f32x4*)(xout + row * DM + 4 * (lane + 64 * j)) = y;
                else { u32x2 w; w.x = cvt_pk_bf16(y.x, y.y); w.y = cvt_pk_bf16(y.z, y.w); *(u32x2*)(xn + row * DM + 4 * (lane + 64 * j)) = w; } }
        }
    }
}

__global__ void __launch_bounds__(NTHREADS, 2) fwd_megakernel(Params p) {
    extern __shared__ __attribute__((aligned(16))) unsigned char lds[];
    cg::grid_group grid = cg::this_grid();
    volatile LAS unsigned* bst = (volatile LAS unsigned*)((LAS unsigned char*)lds + LDS_STAGE);
    if (threadIdx.x < 2) bst[threadIdx.x] = 0u;
    __syncthreads();
    const XcdBarrier xbar = xcd_barrier_post((unsigned*)(p.ws + OFF_BAR), bst);
#define GRID_SYNC_CG() do { __builtin_amdgcn_fence(__ATOMIC_RELEASE, "agent"); asm volatile("s_waitcnt vmcnt(0)" ::: "memory"); grid.sync(); \
        __builtin_amdgcn_fence(__ATOMIC_ACQUIRE, "agent"); asm volatile("s_waitcnt vmcnt(0)" ::: "memory"); } while (0)
#define GRID_SYNC() xcd_barrier(xbar)
    const int G = gridDim.x, bid = blockIdx.x, NGW = G * NWAVES;
    LAS unsigned char* ldsl = (LAS unsigned char*)lds;
#define PHASE_IDS() const int tid = fresh_tid(), lane = tid & 63, wave = tid >> 6, gw = bid * NWAVES + wave; LAS float* scr = (LAS float*)(ldsl + wave * 8448); (void)scr; (void)gw; (void)lane
    unsigned char* ws = p.ws;
    bf16_t* Wgu = (bf16_t*)(ws + OFF_WGU); bf16_t* Wd = (bf16_t*)(ws + OFF_WD); bf16_t* Win = (bf16_t*)(ws + OFF_WIN); bf16_t* Wuq = (bf16_t*)(ws + OFF_WUQ);
    bf16_t* Wukv = (bf16_t*)(ws + OFF_WUKV); bf16_t* Woa = (bf16_t*)(ws + OFF_WOA); bf16_t* Wp = (bf16_t*)(ws + OFF_WP); bf16_t* Wout = (bf16_t*)(ws + OFF_WOUT);
    bf16_t* XN = (bf16_t*)(ws + OFF_XN); bf16_t* F = (bf16_t*)(ws + OFF_F); float* ZF = (float*)(ws + OFF_ZF); bf16_t* KV = (bf16_t*)(ws + OFF_KV);
    bf16_t* H = (bf16_t*)(ws + OFF_H); bf16_t* O = (bf16_t*)(ws + OFF_O); bf16_t* CQN = (bf16_t*)(ws + OFF_CQN); bf16_t* CKVN = (bf16_t*)(ws + OFF_CKVN);
    float* TAB = (float*)(ws + OFF_TAB); bf16_t* Q = (bf16_t*)(ws + OFF_Q); bf16_t* KR = (bf16_t*)(ws + OFF_KR); bf16_t* Gt = (bf16_t*)(ws + OFF_G); bf16_t* DP = (bf16_t*)(ws + OFF_DP);
    float* X = p.out;
    float* xbuf0 = (float*)(ws + OFF_XBUF); unsigned* cnt0 = (unsigned*)(ws + OFF_CNT);

    { PHASE_IDS();
    tr_job<TR_GU>(p.f1_wg, p.f1_wu, 1024, DFF, 5632, Wgu, scr, lane, gw, NGW);
    tr_job<TR_PLAIN>(p.f1_wd, nullptr, DFF, 1024, 1024, Wd, scr, lane, gw, NGW);
    rows_phase<0>(p.x, nullptr, 0.f, nullptr, p.f1_pre, nullptr, XN, gw, NGW, lane); }
    if (__builtin_expect(p.out == nullptr, 0)) GRID_SYNC_CG();
    GRID_SYNC();

    pg8::StaticOrder S;
    { pg8::Gemm g{XN, Wgu, M, 5632, 1024}; S.init(M, 5632, G, bid); pg8::EpiSwiGLU E{H}; pg8::gemm_phase(ldsl, g, S, E); }
    {
        const int tail0 = (64 * 22) % G;
        if (tail0 != 0 && bid >= tail0) { PHASE_IDS(); const int tb = bid - tail0, nb = G - tail0, tgw = tb * NWAVES + wave, TNGW = nb * NWAVES;
            tr_job<TR_WIN>(p.w_in, nullptr, 1024, INW, 3328, Win, scr, lane, tgw, TNGW);
            tr_job<TR_UQ>(p.w_uq, nullptr, QL, 1536, 1536, Wuq, scr, lane, tgw, TNGW);
            tr_job<TR_UKV>(p.w_uk, p.w_uv, KVL, 1024, 2048, Wukv, scr, lane, tgw, TNGW);
            tr_job<TR_PLAIN>(p.w_oa, nullptr, 1024, 1024, 1024, Woa, scr, lane, tgw, TNGW);
            tr_job<TR_PLAIN>(p.w_out, nullptr, 1024, 1024, 1024, Wout, scr, lane, tgw, TNGW);
    for (int idx = tb * NTHREADS + tid; idx < 65536; idx += nb * NTHREADS) {
            const int n = idx & 1023, c8 = idx >> 10, g = c8 >> 4, cb = (c8 & 15) * 8;
            float a[8];
    #pragma unroll
            for (int i = 0; i < 8; ++i) a[i] = 0.f;
            for (int j0 = 0; j0 < 128; j0 += 8) { float w[8]; f32x4 pw[8][2];
    #pragma unroll
                for (int jj = 0; jj < 8; ++jj) w[jj] = p.w_op[(size_t)(g * 128 + j0 + jj) * 1024 + n] * p.pool_scale[g * 128 + j0 + jj];
    #pragma unroll
                for (int i = 0; i < 8; ++i) { pw[i][0] = *(const f32x4*)(p.pool_w + (size_t)(g * 128 + cb + i) * 128 + j0); pw[i][1] = *(const f32x4*)(p.pool_w + (size_t)(g * 128 + cb + i) * 128 + j0 + 4); }
    #pragma unroll
                for (int i = 0; i < 8; ++i)
    #pragma unroll
                    for (int jj = 0; jj < 8; ++jj) a[i] = fmaf(pw[i][jj >> 2][jj & 3], w[jj], a[i]); }
            u32x4 o; o.x = cvt_pk_bf16(a[0], a[1]); o.y = cvt_pk_bf16(a[2], a[3]); o.z = cvt_pk_bf16(a[4], a[5]); o.w = cvt_pk_bf16(a[6], a[7]);
            *(u32x4*)(Wp + (size_t)n * 512 + c8 * 8) = o;
        }
        }
        else if (tail0 == 0) { PHASE_IDS(); const int tb = bid, nb = G;
            tr_job<TR_WIN>(p.w_in, nullptr, 1024, INW, 3328, Win, scr, lane, gw, NGW);
            tr_job<TR_UQ>(p.w_uq, nullptr, QL, 1536, 1536, Wuq, scr, lane, gw, NGW);
            tr_job<TR_UKV>(p.w_uk, p.w_uv, KVL, 1024, 2048, Wukv, scr, lane, gw, NGW);
            tr_job<TR_PLAIN>(p.w_oa, nullptr, 1024, 1024, 1024, Woa, scr, lane, gw, NGW);
            tr_job<TR_PLAIN>(p.w_out, nullptr, 1024, 1024, 1024, Wout, scr, lane, gw, NGW);
    for (int idx = tb * NTHREADS + tid; idx < 65536; idx += nb * NTHREADS) {
            const int n = idx & 1023, c8 = idx >> 10, g = c8 >> 4, cb = (c8 & 15) * 8;
            float a[8];
    #pragma unroll
            for (int i = 0; i < 8; ++i) a[i] = 0.f;
            for (int j0 = 0; j0 < 128; j0 += 8) { float w[8]; f32x4 pw[8][2];
    #pragma unroll
                for (int jj = 0; jj < 8; ++jj) w[jj] = p.w_op[(size_t)(g * 128 + j0 + jj) * 1024 + n] * p.pool_scale[g * 128 + j0 + jj];
    #pragma unroll
                for (int i = 0; i < 8; ++i) { pw[i][0] = *(const f32x4*)(p.pool_w + (size_t)(g * 128 + cb + i) * 128 + j0); pw[i][1] = *(const f32x4*)(p.pool_w + (size_t)(g * 128 + cb + i) * 128 + j0 + 4); }
    #pragma unroll
                for (int i = 0; i < 8; ++i)
    #pragma unroll
                    for (int jj = 0; jj < 8; ++jj) a[i] = fmaf(pw[i][jj >> 2][jj & 3], w[jj], a[i]); }
            u32x4 o; o.x = cvt_pk_bf16(a[0], a[1]); o.y = cvt_pk_bf16(a[2], a[3]); o.z = cvt_pk_bf16(a[4], a[5]); o.w = cvt_pk_bf16(a[6], a[7]);
            *(u32x4*)(Wp + (size_t)n * 512 + c8 * 8) = o;
        }
        }
    }
    GRID_SYNC();
    { pg8::Gemm g{H, Wd, M, 1024, DFF}; S.init(M, 1024, G, bid);
      pg8::EpiResNorm<false> E{p.x, X, XN, 0.5f, p.f1_post, p.mix_pre, pg8::PanelSumSq{xbuf0, cnt0}, pg8::PanelSumSq{xbuf0 + (size_t)M * 4, cnt0 + 4096}}; pg8::gemm_phase(ldsl, g, S, E); }
    GRID_SYNC();
    { pg8::Gemm g{XN, Win, M, 1280, 1024}; S.init(M, 1280, G, bid); pg8::EpiBf16 E{(bf16_t*)ZF, 1280}; pg8::gemm_phase(ldsl, g, S, E); }
    {
        const int tail0 = (64 * 5) % G; PHASE_IDS();
        if (tail0 != 0 && bid >= tail0) { const int tgw = (bid - tail0) * NWAVES + wave, TNGW = (G - tail0) * NWAVES;
            tr_job<TR_GU>(p.f2_wg, p.f2_wu, 1024, DFF, 5632, Wgu, scr, lane, tgw, TNGW);
            tr_job<TR_PLAIN>(p.f2_wd, nullptr, DFF, 1024, 1024, Wd, scr, lane, tgw, TNGW); }
        else if (tail0 == 0) { tr_job<TR_GU>(p.f2_wg, p.f2_wu, 1024, DFF, 5632, Wgu, scr, lane, gw, NGW); tr_job<TR_PLAIN>(p.f2_wd, nullptr, DFF, 1024, 1024, Wd, scr, lane, gw, NGW); }
    }
    GRID_SYNC();
    { PHASE_IDS();
    const bf16_t* ZB = (const bf16_t*)ZF;
    const int t_g = lane >> 4, wnd = 2 << t_g;
    for (int k = 0; k < M / (NWAVES * 256); ++k) { const int row = gw * (M / (NWAVES * 256)) + k;
        const bf16_t* z = ZB + (size_t)row * 1280;
        const u32x4 qa = *(const u32x4*)(z + 8 * lane);
        u32x4 qb = (u32x4){0u, 0u, 0u, 0u}; if (lane < 16) qb = *(const u32x4*)(z + 512 + 8 * lane);
        const u32x4 pc = *(const u32x4*)(z + 704 + 8 * lane);
        float kx1 = 0.f, kx2 = 0.f; int pos = 0;
        if (lane < 32) { kx1 = bf_lo((unsigned)z[640 + lane]); kx2 = bf_lo((unsigned)z[672 + lane]); pos = p.pos[row]; }
        const int t = row & (SEQ - 1), lo = max(t - (wnd >> 1), 0), hi = min(t + wnd - (wnd >> 1), SEQ);
        float sacc[8];
#pragma unroll
        for (int i = 0; i < 8; ++i) sacc[i] = 0.f;
#pragma unroll
        for (int hb = 0; hb < 2; ++hb) { u32x4 nb[8]; float wv[8];
#pragma unroll
            for (int d = 0; d < 8; ++d) { const int tt = t - 8 + hb * 8 + d; const bool ok = (tt >= lo) && (tt < hi); wv[d] = ok ? 1.f : 0.f;
                nb[d] = *(const u32x4*)(z + 704 + 8 * lane + (long)(ok ? (tt - t) : 0) * 1280); }
#pragma unroll
            for (int d = 0; d < 8; ++d) { sacc[0] = fmaf(wv[d], bf_lo(nb[d].x), sacc[0]); sacc[1] = fmaf(wv[d], bf_hi(nb[d].x), sacc[1]); sacc[2] = fmaf(wv[d], bf_lo(nb[d].y), sacc[2]); sacc[3] = fmaf(wv[d], bf_hi(nb[d].y), sacc[3]);
                sacc[4] = fmaf(wv[d], bf_lo(nb[d].z), sacc[4]); sacc[5] = fmaf(wv[d], bf_hi(nb[d].z), sacc[5]); sacc[6] = fmaf(wv[d], bf_lo(nb[d].w), sacc[6]); sacc[7] = fmaf(wv[d], bf_hi(nb[d].w), sacc[7]); } }
        {
            const float inv = 1.f / (float)(hi - lo);
            u32x4 w; w.x = cvt_pk_bf16(sacc[0] * inv - bf_lo(pc.x), sacc[1] * inv - bf_hi(pc.x)); w.y = cvt_pk_bf16(sacc[2] * inv - bf_lo(pc.y), sacc[3] * inv - bf_hi(pc.y));
            w.z = cvt_pk_bf16(sacc[4] * inv - bf_lo(pc.z), sacc[5] * inv - bf_hi(pc.z)); w.w = cvt_pk_bf16(sacc[6] * inv - bf_lo(pc.w), sacc[7] * inv - bf_hi(pc.w));
            *(u32x4*)(DP + (size_t)row * 512 + 8 * lane) = w; }
        {
            float va[8] = {bf_lo(qa.x), bf_hi(qa.x), bf_lo(qa.y), bf_hi(qa.y), bf_lo(qa.z), bf_hi(qa.z), bf_lo(qa.w), bf_hi(qa.w)};
            float vb[8] = {bf_lo(qb.x), bf_hi(qb.x), bf_lo(qb.y), bf_hi(qb.y), bf_lo(qb.z), bf_hi(qb.z), bf_lo(qb.w), bf_hi(qb.w)};
            float sa = 0.f, sb = 0.f;
#pragma unroll
            for (int i = 0; i < 8; ++i) { sa = fmaf(va[i], va[i], sa); sb = fmaf(vb[i], vb[i], sb); }
            const float ssq = wave_sum(lane < 48 ? sa : 0.f), sskv = wave_sum((lane >= 48 ? sa : 0.f) + sb);
            const float rq = __builtin_amdgcn_rsqf(ssq * (1.f / QL) + EPS), rkv = __builtin_amdgcn_rsqf(sskv * (1.f / KVL) + EPS);
            const float* ga = lane < 48 ? p.qa_g + 8 * lane : p.kva_g + 8 * (lane - 48); const float ra = lane < 48 ? rq : rkv;
            const f32x4 g0 = *(const f32x4*)ga, g1 = *(const f32x4*)(ga + 4);
            u32x4 w; w.x = cvt_pk_bf16(va[0] * g0.x * ra, va[1] * g0.y * ra); w.y = cvt_pk_bf16(va[2] * g0.z * ra, va[3] * g0.w * ra); w.z = cvt_pk_bf16(va[4] * g1.x * ra, va[5] * g1.y * ra); w.w = cvt_pk_bf16(va[6] * g1.z * ra, va[7] * g1.w * ra);
            bf16_t* dst = lane < 48 ? CQN + (size_t)row * QL + 8 * lane : CKVN + (size_t)row * KVL + 8 * (lane - 48);
            *(u32x4*)dst = w;
            if (lane < 16) { const f32x4 h0 = *(const f32x4*)(p.kva_g + 128 + 8 * lane), h1 = *(const f32x4*)(p.kva_g + 132 + 8 * lane);
                u32x4 w2; w2.x = cvt_pk_bf16(vb[0] * h0.x * rkv, vb[1] * h0.y * rkv); w2.y = cvt_pk_bf16(vb[2] * h0.z * rkv, vb[3] * h0.w * rkv); w2.z = cvt_pk_bf16(vb[4] * h1.x * rkv, vb[5] * h1.y * rkv); w2.w = cvt_pk_bf16(vb[6] * h1.z * rkv, vb[7] * h1.w * rkv);
                *(u32x4*)(CKVN + (size_t)row * KVL + 128 + 8 * lane) = w2; }
        }
        if (lane < 32) {
            const float ang = (float)pos * p.inv_freq[lane];
            const double ad = (double)ang; const double kq = rint(ad * 0.15915494309189535); const float red = (float)(ad - kq * 6.283185307179586);
            const float cs = __cosf(red), sn = __sinf(red);
            TAB[(size_t)row * 64 + lane] = cs; TAB[(size_t)row * 64 + 32 + lane] = sn;
            *(unsigned*)(KR + (size_t)row * 64 + 2 * lane) = cvt_pk_bf16(kx1 * cs - kx2 * sn, kx2 * cs + kx1 * sn);
        }
    } }
    GRID_SYNC();
    { pg8::Gemm g{CQN, Wuq, M, 1536, QL}; S.init(M, 1536, G, bid); pg8::EpiQ E{Q, TAB}; pg8::gemm_phase(ldsl, g, S, E); }
    { pg8::Gemm g{CKVN, Wukv, M, 2048, KVL}; S.init(M, 2048, G, bid); pg8::EpiBf16 E{KV, 2048}; pg8::gemm_phase(ldsl, g, S, E); }
    GRID_SYNC();
    {
        const int vcu = (bid & 7) * (G >> 3) + (bid >> 3);
        for (int it = vcu; it < NB * NH * (SEQ / 256); it += G) {
            const int qb = it & 7, h = (it >> 3) & 7, b = it >> 6;
            const size_t tok0 = (size_t)b * SEQ;
            att::attn_body(Q + (tok0 + qb * 256) * 1536 + h * 192, KV + tok0 * 2048 + h * 128, KR + tok0 * 64, KV + tok0 * 2048 + 1024 + h * 128,
                           O + (tok0 + qb * 256) * 1024 + h * 128, SEQ, (char*)lds);
            __syncthreads();
        }
    }
    GRID_SYNC();
    { pg8::Gemm g{XN, Win + (size_t)1280 * 1024, M, 2048, 1024}; pg8::GateOrder GO; GO.s.init(M, 1024, G, bid); pg8::EpiGate E{Gt}; pg8::gemm_phase(ldsl, g, GO, E); }
    { pg8::Gemm g{O, Woa, M, 1024, 1024}; S.init(M, 1024, G, bid); pg8::EpiT1 E{Gt, F}; pg8::gemm_phase(ldsl, g, S, E); }
    { pg8::Gemm g{DP, Wp, M, 1024, 512}; S.init(M, 1024, G, bid); pg8::EpiMX E{Gt, F, XN}; pg8::gemm_phase(ldsl, g, S, E); }
    GRID_SYNC();
    { pg8::Gemm g{XN, Wout, M, 1024, 1024}; S.init(M, 1024, G, bid);
      pg8::EpiResNorm<false> E{X, X, XN, 1.0f, p.mix_post, p.f2_pre, pg8::PanelSumSq{xbuf0 + (size_t)M * 8, cnt0 + 2 * 4096}, pg8::PanelSumSq{xbuf0 + (size_t)M * 12, cnt0 + 3 * 4096}}; pg8::gemm_phase(ldsl, g, S, E); }
    GRID_SYNC();
    { pg8::Gemm g{XN, Wgu, M, 5632, 1024}; S.init(M, 5632, G, bid); pg8::EpiSwiGLU E{H}; pg8::gemm_phase(ldsl, g, S, E); }
    GRID_SYNC();
    { pg8::Gemm g{H, Wd, M, 1024, DFF}; S.init(M, 1024, G, bid);
      pg8::EpiResNorm<true> E{X, X, nullptr, 0.5f, p.f2_post, p.final_g, pg8::PanelSumSq{xbuf0 + (size_t)M * 16, cnt0 + 4 * 4096}, pg8::PanelSumSq{xbuf0 + (size_t)M * 20, cnt0 + 5 * 4096}}; pg8::gemm_phase(ldsl, g, S, E); }
}

extern "C" void kernel_launch(void* const* d_in, const int* in_sizes, int n_in, void* d_out, int out_size, void* d_ws, size_t ws_size, hipStream_t stream) {
    static int grid_blocks = 0;
    if (grid_blocks == 0) {
        if (n_in != 26 || in_sizes[0] != M * DM || out_size != M * DM || ws_size < WS_END) { fprintf(stderr, "kernel_launch: shape mismatch n_in %d in0 %d out %d ws %zu\n", n_in, n_in > 0 ? in_sizes[0] : -1, out_size, ws_size); grid_blocks = -1; return; }
        int dev = 0, cus = 0, per_cu = 0;
        (void)hipGetDevice(&dev);
        (void)hipDeviceGetAttribute(&cus, hipDeviceAttributeMultiprocessorCount, dev);
        if (hipFuncSetAttribute((const void*)fwd_megakernel, hipFuncAttributeMaxDynamicSharedMemorySize, LDS_BYTES) != hipSuccess) { fprintf(stderr, "kernel_launch: hipFuncSetAttribute failed\n"); grid_blocks = -1; return; }
        if (hipOccupancyMaxActiveBlocksPerMultiprocessor(&per_cu, (const void*)fwd_megakernel, NTHREADS, LDS_BYTES) != hipSuccess || per_cu < 1) { fprintf(stderr, "kernel_launch: occupancy query failed (%d)\n", per_cu); (void)hipGetLastError(); per_cu = 1; }
        grid_blocks = cus * 1;
        if (grid_blocks != 256) { fprintf(stderr, "kernel_launch: built for 256 CUs (one workgroup each), device has %d\n", cus); grid_blocks = -1; return; }
    }
    if (grid_blocks < 0) return;
    Params p{};
    p.x = (const float*)d_in[0]; p.pos = (const int*)d_in[1];
    p.f1_pre = (const float*)d_in[2]; p.f1_wg = (const float*)d_in[3]; p.f1_wu = (const float*)d_in[4]; p.f1_wd = (const float*)d_in[5]; p.f1_post = (const float*)d_in[6];
    p.mix_pre = (const float*)d_in[7]; p.w_in = (const float*)d_in[8]; p.qa_g = (const float*)d_in[9]; p.w_uq = (const float*)d_in[10]; p.kva_g = (const float*)d_in[11];
    p.w_uk = (const float*)d_in[12]; p.w_uv = (const float*)d_in[13]; p.w_oa = (const float*)d_in[14]; p.pool_w = (const float*)d_in[15]; p.pool_scale = (const float*)d_in[16];
    p.w_op = (const float*)d_in[17]; p.w_out = (const float*)d_in[18]; p.mix_post = (const float*)d_in[19];
    p.f2_pre = (const float*)d_in[20]; p.f2_wg = (const float*)d_in[21]; p.f2_wu = (const float*)d_in[22]; p.f2_wd = (const float*)d_in[23]; p.f2_post = (const float*)d_in[24]; p.final_g = (const float*)d_in[25];
    p.out = (float*)d_out; p.ws = (unsigned char*)d_ws;
    for (int i = 0; i < 32; ++i) p.inv_freq[i] = (float)pow(10000.0, -(2.0 * i) / 64.0);
    if (hipMemsetAsync((char*)d_ws + OFF_BAR, 0, CTL_BYTES, stream) != hipSuccess) { fprintf(stderr, "kernel_launch: memset failed\n"); return; }
    void* args[] = {&p};
    hipError_t e = hipLaunchCooperativeKernel((const void*)fwd_megakernel, dim3(grid_blocks), dim3(NTHREADS), args, LDS_BYTES, stream);
    if (e != hipSuccess) fprintf(stderr, "cooperative launch failed: %s (grid %d)\n", hipGetErrorString(e), grid_blocks);
}
```

```cpp
#include <hip/hip_runtime.h>
#include <hip/hip_cooperative_groups.h>
#include <cstdio>
#include <cmath>
#include <cstdint>
namespace cg = cooperative_groups;

#define LAS __attribute__((address_space(3)))
typedef unsigned short bf16_t;
typedef short bf16x8 __attribute__((ext_vector_type(8)));
typedef short s16x4 __attribute__((ext_vector_type(4)));
typedef float f32x2 __attribute__((ext_vector_type(2)));
typedef float f32x4 __attribute__((ext_vector_type(4)));
typedef float f32x16 __attribute__((ext_vector_type(16)));
typedef unsigned u32x4 __attribute__((ext_vector_type(4)));
typedef unsigned u32x2 __attribute__((ext_vector_type(2)));

constexpr int DM = 1024, NB = 8, SEQ = 2048, M = NB * SEQ, NH = 8, QL = 384, KVL = 256, DFF = 2816, INW = 3264;
constexpr float EPS = 1e-6f;
constexpr int NTHREADS = 512, NWAVES = 8;
constexpr int LDS_STAGE = 131072, LDS_BYTES = LDS_STAGE + 16;

constexpr size_t MiB = 1048576;
constexpr size_t OFF_WGU = 0;
constexpr size_t OFF_WD = OFF_WGU + (size_t)5632 * 1024 * 2;
constexpr size_t OFF_WIN = OFF_WD + (size_t)1024 * 2816 * 2;
constexpr size_t OFF_WUQ = OFF_WIN + (size_t)3328 * 1024 * 2;
constexpr size_t OFF_WUKV = OFF_WUQ + (size_t)1536 * 384 * 2;
constexpr size_t OFF_WOA = OFF_WUKV + (size_t)2048 * 256 * 2;
constexpr size_t OFF_WP = OFF_WOA + (size_t)1024 * 1024 * 2;
constexpr size_t OFF_WOUT = OFF_WP + (size_t)1024 * 512 * 2;
constexpr size_t OFF_XN = OFF_WOUT + (size_t)1024 * 1024 * 2;
constexpr size_t OFF_R = OFF_XN + 32 * MiB;
constexpr size_t OFF_F = OFF_R;
constexpr size_t OFF_ZF = OFF_R;
constexpr size_t OFF_KV = OFF_R;
constexpr size_t OFF_H = OFF_R + 64 * MiB;
constexpr size_t OFF_O = OFF_R + 64 * MiB;
constexpr size_t OFF_CQN = OFF_R + 80 * MiB;
constexpr size_t OFF_CKVN = OFF_R + 92 * MiB;
constexpr size_t OFF_TAB = OFF_R + 100 * MiB;
constexpr size_t OFF_Q = OFF_R + 104 * MiB;
constexpr size_t OFF_KR = OFF_R + 152 * MiB;
constexpr size_t OFF_G = OFF_R + 96 * MiB;
constexpr size_t OFF_DP = OFF_R + 176 * MiB;
constexpr size_t WS_END = OFF_R + 192 * MiB;
constexpr size_t OFF_BAR = WS_END, OFF_CNT = OFF_BAR + 16384, CTL_BYTES = 16384 + 6 * 16384, OFF_XBUF = OFF_BAR + CTL_BYTES;
static_assert(OFF_XBUF + 6 * (size_t)M * 16 <= 256 * MiB, "workspace");

struct Params {
    const float* x; const int* pos;
    const float *f1_pre, *f1_wg, *f1_wu, *f1_wd, *f1_post;
    const float *mix_pre, *w_in, *qa_g, *w_uq, *kva_g, *w_uk, *w_uv, *w_oa, *pool_w, *pool_scale, *w_op, *w_out, *mix_post;
    const float *f2_pre, *f2_wg, *f2_wu, *f2_wd, *f2_post, *final_g;
    float* out; unsigned char* ws;
    float inv_freq[32];
};

typedef __bf16 bf16x2_t __attribute__((ext_vector_type(2)));
__device__ __forceinline__ unsigned cvt_pk_bf16(float lo, float hi) { const f32x2 v = {lo, hi}; const bf16x2_t r = __builtin_convertvector(v, bf16x2_t); return __builtin_bit_cast(unsigned, r); }
__device__ __forceinline__ float bf_lo(unsigned w) { return __uint_as_float(w << 16); }
__device__ __forceinline__ float bf_hi(unsigned w) { return __uint_as_float(w & 0xffff0000u); }
__device__ __forceinline__ float sigmoidf_fast(float z) { return __builtin_amdgcn_rcpf(1.f + __builtin_amdgcn_exp2f(-1.4426950408889634f * z)); }
__device__ __forceinline__ int fresh_tid() { int t = threadIdx.x; asm volatile("" : "+v"(t)); return t; }
__device__ __forceinline__ float wave_sum(float v) {
#pragma unroll
    for (int o = 1; o < 64; o <<= 1) v += __shfl_xor(v, o);
    return v;
}

namespace pg8 {
constexpr int BM = 256, BK = 64, HALF = 128, HTB = HALF * BK * 2, STAGE_BYTES = 8 * HTB, NXCD = 8, WGM = 4;
__host__ __device__ __forceinline__ int lds_byte(int r, int c) { const int st = (r >> 4) * 2 + (c >> 5), rr = r & 15, cc = c & 31, ob = rr * 64 + cc * 2; return st * 1024 + (ob ^ (((ob >> 9) & 1) << 5)); }
__host__ __device__ __forceinline__ void stage_rc(int b, int& R, int& C) { const int st = b / 1024, sb = b % 1024, swz = sb ^ (((sb >> 9) & 1) << 5); R = (st >> 1) * 16 + swz / 64; C = (st & 1) * 32 + (swz % 64) / 2; }
__host__ __device__ __forceinline__ int perm32(int rho) { const int n = rho >> 4, i = rho & 15; return 8 * (i >> 2) + 4 * n + (i & 3); }
struct Unit { int pm, pn; };
struct Gemm { const bf16_t* A; const bf16_t* Bt; int M, N, K; };
struct StaticOrder {
    int nM, nN, nwg, G, c;
    __device__ void init(int M_, int N_, int G_, int c_) { nM = M_ / BM; nN = N_ / BM; nwg = nM * nN; G = G_; c = c_; }
    __device__ bool next(int i, Unit& u) const {
        const long L = (long)i * G + c; if (L >= nwg) return false;
        int wgid = (int)L; { const int q = nwg / NXCD, r = nwg % NXCD, xcd = wgid % NXCD, off = wgid / NXCD; wgid = (xcd < r ? xcd * (q + 1) : r * (q + 1) + (xcd - r) * q) + off; }
        const int nig = WGM * nN, gid = wgid / nig, fm = gid * WGM, gsz = (nM - fm) < WGM ? (nM - fm) : WGM;
        u.pm = fm + ((wgid % nig) % gsz); u.pn = (wgid % nig) / gsz; return true;
    }
};

struct GateOrder { StaticOrder s;
    __device__ bool next(int i, Unit& u) const { if (i >= 2) return false; Unit b; if (!s.next(0, b)) return false; u.pm = b.pm; u.pn = b.pn + 4 * i; return true; } };
template <class Epi, class Sched>
__device__ __forceinline__ void gemm_phase(LAS unsigned char* lds, const Gemm g, const Sched& S, const Epi& E) {
    const int tid = fresh_tid(), wid = __builtin_amdgcn_readfirstlane(tid >> 6), lane = tid & 63, wr = wid >> 2, wc = wid & 3, fr = lane & 15, fq = lane >> 4;
    const int K = g.K, nt = K / BK;
    unsigned voffA, voffB;
    { int R, C; stage_rc(tid * 16, R, C); const int Rb = Epi::PERM ? ((R & ~31) + perm32(R & 31)) : R;
      voffA = (unsigned)(R * K + C) * 2u; voffB = (unsigned)(Rb * K + C) * 2u; }
    const size_t rstep64 = (size_t)64 * K * 2;
    const size_t kstep = (size_t)(BK * 2);
    const size_t hstep = (size_t)HALF * K * 2;
    const size_t tstep = 2 * hstep;
    const unsigned ldsw = (unsigned)wid * 1024u;
    const int aoff = lds_byte(wr * 64 + fr, fq * 8), boff = lds_byte(wc * 32 + fr, fq * 8);
#define PG8_SA(b, h) (((b) * 2 + (h)) * HTB)
#define PG8_SB(b, h) ((4 + (b) * 2 + (h)) * HTB)
#define PG8_STAGE(bufoff, gbase, voff) do { _Pragma("unroll") for (int _i = 0; _i < 2; ++_i) \
        __builtin_amdgcn_global_load_lds((const unsigned*)((const char*)(gbase) + _i * rstep64 + (voff)), (LAS unsigned*)(lds + (bufoff) + ldsw + _i * 8192), 16, 0, 0); } while (0)
#define PG8_LDA(dst, b, h) do { _Pragma("unroll") for (int m = 0; m < 4; ++m) _Pragma("unroll") for (int k = 0; k < 2; ++k) dst[m][k] = *(const LAS bf16x8*)(lds + PG8_SA(b, h) + aoff + m * 2048 + k * 1024); } while (0)
#define PG8_LDB(dst, b, h) do { _Pragma("unroll") for (int n = 0; n < 2; ++n) _Pragma("unroll") for (int k = 0; k < 2; ++k) dst[n][k] = *(const LAS bf16x8*)(lds + PG8_SB(b, h) + boff + n * 2048 + k * 1024); } while (0)
#define PG8_MMA(ai, bj, At, Bt) do { __builtin_amdgcn_s_setprio(1); _Pragma("unroll") for (int m = 0; m < 4; ++m) _Pragma("unroll") for (int n = 0; n < 2; ++n) _Pragma("unroll") for (int k = 0; k < 2; ++k) \
        acc[ai][bj][m][n] = __builtin_amdgcn_mfma_f32_16x16x32_bf16(Bt[n][k], At[m][k], acc[ai][bj][m][n], 0, 0, 0); __builtin_amdgcn_s_setprio(0); } while (0)
#define PG8_WAIT_V(n) asm volatile("s_waitcnt vmcnt(" #n ")" ::: "memory")
#define PG8_WAIT_L(n) asm volatile("s_waitcnt lgkmcnt(" #n ")" ::: "memory")
#define PG8_BAR __builtin_amdgcn_s_barrier()
#define PG8_SCHED __builtin_amdgcn_sched_barrier(0)
    Unit cur, nxt; int ui = 0;
    if (!S.next(0, cur)) return;
    f32x4 acc[2][2][4][2];
#pragma unroll
    for (int a = 0; a < 2; ++a)
#pragma unroll
        for (int b = 0; b < 2; ++b)
#pragma unroll
            for (int m = 0; m < 4; ++m)
#pragma unroll
                for (int n = 0; n < 2; ++n) acc[a][b][m][n] = (f32x4){0.f, 0.f, 0.f, 0.f};
    bf16x8 At[4][2], B0[2][2], B1[2][2];
    const char* cA = (const char*)g.A + (size_t)cur.pm * tstep; const char* cB = (const char*)g.Bt + (size_t)cur.pn * tstep;
    PG8_STAGE(PG8_SB(0, 0), cB, voffB); PG8_STAGE(PG8_SA(0, 0), cA, voffA); PG8_STAGE(PG8_SB(0, 1), cB + hstep, voffB); PG8_STAGE(PG8_SA(0, 1), cA + hstep, voffA);
    if (wr == 1) PG8_BAR;
    PG8_WAIT_V(4); PG8_BAR;
    PG8_STAGE(PG8_SB(1, 0), cB + kstep, voffB); PG8_STAGE(PG8_SA(1, 0), cA + kstep, voffA); PG8_STAGE(PG8_SB(1, 1), cB + hstep + kstep, voffB);
    PG8_WAIT_V(6); PG8_BAR;
    for (;;) {
        const bool has_next = S.next(ui + 1, nxt);
        const char* nA = has_next ? (const char*)g.A + (size_t)nxt.pm * tstep : cA; const char* nB = has_next ? (const char*)g.Bt + (size_t)nxt.pn * tstep : cB;
        for (int t = 0; t < nt; t += 2) {
            const bool last = (t == nt - 2);
            const char* a1 = cA + (size_t)(t + 1) * kstep;
            const char* a2 = last ? nA : cA + (size_t)(t + 2) * kstep; const char* b2 = last ? nB : cB + (size_t)(t + 2) * kstep;
            const char* a3 = a2 + kstep; const char* b3 = b2 + kstep;
            PG8_LDB(B0, 0, 0); PG8_SCHED; PG8_LDA(At, 0, 0); PG8_STAGE(PG8_SA(1, 1), a1 + hstep, voffA);
            PG8_WAIT_L(8); PG8_BAR; PG8_WAIT_L(0); PG8_MMA(0, 0, At, B0); PG8_BAR; PG8_SCHED;
            PG8_LDB(B1, 0, 1); PG8_STAGE(PG8_SB(0, 0), b2, voffB);
            PG8_BAR; PG8_WAIT_L(0); PG8_MMA(0, 1, At, B1); PG8_BAR;
            PG8_LDA(At, 0, 1); PG8_STAGE(PG8_SA(0, 0), a2, voffA);
            PG8_BAR; PG8_WAIT_L(0); PG8_MMA(1, 0, At, B0); PG8_BAR; PG8_SCHED;
            PG8_STAGE(PG8_SB(0, 1), b2 + hstep, voffB);
            PG8_WAIT_V(6); PG8_BAR; PG8_MMA(1, 1, At, B1); PG8_BAR;
            PG8_LDB(B0, 1, 0); PG8_SCHED; PG8_LDA(At, 1, 0); PG8_STAGE(PG8_SA(0, 1), a2 + hstep, voffA);
            PG8_WAIT_L(8); PG8_BAR; PG8_WAIT_L(0); PG8_MMA(0, 0, At, B0); PG8_BAR; PG8_SCHED;
            PG8_LDB(B1, 1, 1); PG8_STAGE(PG8_SB(1, 0), b3, voffB);
            PG8_BAR; PG8_WAIT_L(0); PG8_MMA(0, 1, At, B1); PG8_BAR;
            PG8_LDA(At, 1, 1); PG8_STAGE(PG8_SA(1, 0), a3, voffA);
            PG8_BAR; PG8_WAIT_L(0); PG8_MMA(1, 0, At, B0); PG8_BAR; PG8_SCHED;
            PG8_STAGE(PG8_SB(1, 1), b3 + hstep, voffB);
            PG8_WAIT_V(6); PG8_BAR; PG8_MMA(1, 1, At, B1); PG8_BAR;
        }
        if constexpr (!Epi::AFTER_DRAIN) { const int t2 = fresh_tid(); E(acc, cur, wr, wc, t2 & 15, (t2 >> 4) & 3); }
        if (!has_next) break;
#pragma unroll
        for (int a = 0; a < 2; ++a)
#pragma unroll
            for (int b = 0; b < 2; ++b)
#pragma unroll
                for (int m = 0; m < 4; ++m)
#pragma unroll
                    for (int n = 0; n < 2; ++n) acc[a][b][m][n] = (f32x4){0.f, 0.f, 0.f, 0.f};
        cur = nxt; cA = nA; cB = nB; ++ui;
    }
    PG8_WAIT_V(0);
    if (wr == 0) PG8_BAR;
    PG8_BAR;
    if constexpr (Epi::AFTER_DRAIN) { const int t2 = fresh_tid(); E.fused(acc, cur, wr, wc, t2 & 15, (t2 >> 4) & 3, lds, t2 >> 6, t2 & 63); }
#undef PG8_SA
#undef PG8_SB
#undef PG8_STAGE
#undef PG8_LDA
#undef PG8_LDB
#undef PG8_MMA
#undef PG8_WAIT_V
#undef PG8_WAIT_L
#undef PG8_BAR
#undef PG8_SCHED
}

typedef f32x4 Acc[2][2][4][2];
struct EpiF32 {
    static constexpr bool PERM = false, AFTER_DRAIN = false;
    float* C; int ldc;
    __device__ __forceinline__ void operator()(const Acc& acc, const Unit& u, int wr, int wc, int fr, int fq) const {
        const int row0 = u.pm * BM + wr * 64 + fr, col0 = u.pn * BM + wc * 32 + 4 * fq;
#pragma unroll
        for (int ai = 0; ai < 2; ++ai)
#pragma unroll
            for (int m = 0; m < 4; ++m) { float* rowp = C + (size_t)(row0 + ai * HALF + m * 16) * ldc + col0;
#pragma unroll
                for (int bj = 0; bj < 2; ++bj)
#pragma unroll
                    for (int n = 0; n < 2; ++n) *(f32x4*)(rowp + bj * HALF + n * 16) = acc[ai][bj][m][n]; }
    }
};
struct EpiBf16 {
    static constexpr bool PERM = true, AFTER_DRAIN = false;
    bf16_t* O; int ldc;
    __device__ __forceinline__ void operator()(const Acc& acc, const Unit& u, int wr, int wc, int fr, int fq) const {
        const int row0 = u.pm * BM + wr * 64 + fr, col0 = u.pn * BM + wc * 32 + 8 * fq;
#pragma unroll
        for (int ai = 0; ai < 2; ++ai)
#pragma unroll
            for (int m = 0; m < 4; ++m) { bf16_t* rowp = O + (size_t)(row0 + ai * HALF + m * 16) * ldc + col0;
#pragma unroll
                for (int bj = 0; bj < 2; ++bj) { const f32x4 v0 = acc[ai][bj][m][0], v1 = acc[ai][bj][m][1];
                    u32x4 w; w.x = cvt_pk_bf16(v0[0], v0[1]); w.y = cvt_pk_bf16(v0[2], v0[3]); w.z = cvt_pk_bf16(v1[0], v1[1]); w.w = cvt_pk_bf16(v1[2], v1[3]);
                    *(u32x4*)(rowp + bj * HALF) = w; } }
    }
};
struct EpiSwiGLU {
    static constexpr bool PERM = true, AFTER_DRAIN = false;
    bf16_t* H;
    __device__ __forceinline__ void operator()(const Acc& acc, const Unit& u, int wr, int wc, int fr, int fq) const {
        const int row0 = u.pm * BM + wr * 64 + fr, col0 = u.pn * HALF + wc * 32 + 8 * fq;
#pragma unroll
        for (int ai = 0; ai < 2; ++ai)
#pragma unroll
            for (int m = 0; m < 4; ++m) { bf16_t* rowp = H + (size_t)(row0 + ai * HALF + m * 16) * DFF + col0;
                float h[8];
#pragma unroll
                for (int n = 0; n < 2; ++n)
#pragma unroll
                    for (int j = 0; j < 4; ++j) { const float gt = acc[ai][0][m][n][j], up = acc[ai][1][m][n][j]; h[n * 4 + j] = gt * sigmoidf_fast(gt) * up; }
                u32x4 w; w.x = cvt_pk_bf16(h[0], h[1]); w.y = cvt_pk_bf16(h[2], h[3]); w.z = cvt_pk_bf16(h[4], h[5]); w.w = cvt_pk_bf16(h[6], h[7]);
                *(u32x4*)rowp = w; }
    }
};
struct EpiGate {
    static constexpr bool PERM = true, AFTER_DRAIN = false;
    bf16_t* G;
    __device__ __forceinline__ void operator()(const Acc& acc, const Unit& u, int wr, int wc, int fr, int fq) const {
        const int row0 = u.pm * BM + wr * 64 + fr, col0 = u.pn * BM + wc * 32 + 8 * fq;
#pragma unroll
        for (int ai = 0; ai < 2; ++ai)
#pragma unroll
            for (int m = 0; m < 4; ++m) { bf16_t* rowp = G + (size_t)(row0 + ai * HALF + m * 16) * 2048 + col0;
#pragma unroll
                for (int bj = 0; bj < 2; ++bj) { const f32x4 v0 = acc[ai][bj][m][0], v1 = acc[ai][bj][m][1];
                    u32x4 w; w.x = cvt_pk_bf16(sigmoidf_fast(v0[0]), sigmoidf_fast(v0[1])); w.y = cvt_pk_bf16(sigmoidf_fast(v0[2]), sigmoidf_fast(v0[3]));
                    w.z = cvt_pk_bf16(sigmoidf_fast(v1[0]), sigmoidf_fast(v1[1])); w.w = cvt_pk_bf16(sigmoidf_fast(v1[2]), sigmoidf_fast(v1[3]));
                    *(u32x4*)(rowp + bj * HALF) = w; } }
    }
};
struct EpiQ {
    static constexpr bool PERM = true, AFTER_DRAIN = false;
    bf16_t* Q; const float* TAB;
    __device__ __forceinline__ void operator()(const Acc& acc, const Unit& u, int wr, int wc, int fr, int fq) const {
        const int row0 = u.pm * BM + wr * 64 + fr, col0 = u.pn * BM + wc * 32 + 8 * fq;
#pragma unroll
        for (int ai = 0; ai < 2; ++ai)
#pragma unroll
            for (int m = 0; m < 4; ++m) { const int row = row0 + ai * HALF + m * 16; bf16_t* rowp = Q + (size_t)row * 1536 + col0;
#pragma unroll
                for (int bj = 0; bj < 2; ++bj) { f32x4 v0 = acc[ai][bj][m][0], v1 = acc[ai][bj][m][1];
                    const int c = col0 + bj * HALF, w = c % 192;
                    if (w >= 128) { const int i0 = (w - 128) >> 1; const f32x4 cs = *(const f32x4*)(TAB + (size_t)row * 64 + i0), sn = *(const f32x4*)(TAB + (size_t)row * 64 + 32 + i0);
                        f32x4 r0, r1;
                        r0[0] = v0[0] * cs[0] - v0[1] * sn[0]; r0[1] = v0[1] * cs[0] + v0[0] * sn[0];
                        r0[2] = v0[2] * cs[1] - v0[3] * sn[1]; r0[3] = v0[3] * cs[1] + v0[2] * sn[1];
                        r1[0] = v1[0] * cs[2] - v1[1] * sn[2]; r1[1] = v1[1] * cs[2] + v1[0] * sn[2];
                        r1[2] = v1[2] * cs[3] - v1[3] * sn[3]; r1[3] = v1[3] * cs[3] + v1[2] * sn[3];
                        v0 = r0; v1 = r1; }
                    u32x4 wv; wv.x = cvt_pk_bf16(v0[0], v0[1]); wv.y = cvt_pk_bf16(v0[2], v0[3]); wv.z = cvt_pk_bf16(v1[0], v1[1]); wv.w = cvt_pk_bf16(v1[2], v1[3]);
                    *(u32x4*)(rowp + bj * HALF) = wv; } }
    }
};
struct EpiT1 {
    static constexpr bool PERM = true, AFTER_DRAIN = false;
    const bf16_t* G; bf16_t* F;
    __device__ __forceinline__ void operator()(const Acc& acc, const Unit& u, int wr, int wc, int fr, int fq) const {
        const int row0 = u.pm * BM + wr * 64 + fr, col0 = u.pn * BM + wc * 32 + 8 * fq;
#pragma unroll
        for (int ai = 0; ai < 2; ++ai)
#pragma unroll
            for (int m = 0; m < 4; ++m) { const int row = row0 + ai * HALF + m * 16;
#pragma unroll
                for (int bj = 0; bj < 2; ++bj) { const f32x4 v0 = acc[ai][bj][m][0], v1 = acc[ai][bj][m][1]; const int c = col0 + bj * HALF;
                    const u32x4 gw = *(const u32x4*)(G + (size_t)row * 2048 + c);
                    u32x4 wv;
                    wv.x = cvt_pk_bf16(v0[0] * bf_lo(gw.x), v0[1] * bf_hi(gw.x)); wv.y = cvt_pk_bf16(v0[2] * bf_lo(gw.y), v0[3] * bf_hi(gw.y));
                    wv.z = cvt_pk_bf16(v1[0] * bf_lo(gw.z), v1[1] * bf_hi(gw.z)); wv.w = cvt_pk_bf16(v1[2] * bf_lo(gw.w), v1[3] * bf_hi(gw.w));
                    *(u32x4*)(F + (size_t)row * 1024 + c) = wv; } }
    }
};
struct EpiMX {
    static constexpr bool PERM = true, AFTER_DRAIN = false;
    const bf16_t* G; const bf16_t* F; bf16_t* MX;
    __device__ __forceinline__ void operator()(const Acc& acc, const Unit& u, int wr, int wc, int fr, int fq) const {
        const int row0 = u.pm * BM + wr * 64 + fr, col0 = u.pn * BM + wc * 32 + 8 * fq;
#pragma unroll
        for (int ai = 0; ai < 2; ++ai)
#pragma unroll
            for (int m = 0; m < 4; ++m) { const int row = row0 + ai * HALF + m * 16;
#pragma unroll
                for (int bj = 0; bj < 2; ++bj) { const f32x4 v0 = acc[ai][bj][m][0], v1 = acc[ai][bj][m][1]; const int c = col0 + bj * HALF;
                    const u32x4 gw = *(const u32x4*)(G + (size_t)row * 2048 + 1024 + c);
                    const u32x4 tw = *(const u32x4*)(F + (size_t)row * 1024 + c);
                    u32x4 wv;
                    wv.x = cvt_pk_bf16(bf_lo(tw.x) + v0[0] * bf_lo(gw.x), bf_hi(tw.x) + v0[1] * bf_hi(gw.x)); wv.y = cvt_pk_bf16(bf_lo(tw.y) + v0[2] * bf_lo(gw.y), bf_hi(tw.y) + v0[3] * bf_hi(gw.y));
                    wv.z = cvt_pk_bf16(bf_lo(tw.z) + v1[0] * bf_lo(gw.z), bf_hi(tw.z) + v1[1] * bf_hi(gw.z)); wv.w = cvt_pk_bf16(bf_lo(tw.w) + v1[2] * bf_lo(gw.w), bf_hi(tw.w) + v1[3] * bf_hi(gw.w));
                    *(u32x4*)(MX + (size_t)row * 1024 + c) = wv; } }
    }
};

struct PanelSumSq {
    float* xbuf;
    unsigned* cnt;
    __device__ __forceinline__ void run(const Acc& v, const Unit& u, int wr, int wc, int fr, int fq, LAS unsigned char* lds, int wid, int lane) const {
        LAS float* P = (LAS float*)lds; LAS float* S = (LAS float*)(lds + 4096);
#pragma unroll
        for (int ai = 0; ai < 2; ++ai)
#pragma unroll
            for (int m = 0; m < 4; ++m) { float q = 0.f;
#pragma unroll
                for (int bj = 0; bj < 2; ++bj)
#pragma unroll
                    for (int n = 0; n < 2; ++n) { const f32x4 x = v[ai][bj][m][n]; q += (x[0] * x[0] + x[1] * x[1]) + (x[2] * x[2] + x[3] * x[3]); }
                q += __shfl_xor(q, 16); q += __shfl_xor(q, 32);
                if (fq == 0) P[(ai * HALF + wr * 64 + m * 16 + fr) * 4 + wc] = q; }
        asm volatile("s_waitcnt lgkmcnt(0)" ::: "memory"); __builtin_amdgcn_s_barrier(); asm volatile("" ::: "memory");
        const int row = wid * 32 + (lane & 31);
        if (lane < 32) { const float t = (P[row * 4 + 0] + P[row * 4 + 1]) + (P[row * 4 + 2] + P[row * 4 + 3]);
            __hip_atomic_store(xbuf + ((size_t)(u.pm * BM + row) * 4 + u.pn), t, __ATOMIC_RELAXED, __HIP_MEMORY_SCOPE_AGENT); }
        asm volatile("s_waitcnt vmcnt(0)" ::: "memory");
        if (lane == 0) __hip_atomic_fetch_add(cnt + 64 * u.pm, 1u, __ATOMIC_RELAXED, __HIP_MEMORY_SCOPE_AGENT);
        if (wid == 0) { unsigned sp = 0u;
            while ((unsigned)__builtin_amdgcn_readfirstlane(__hip_atomic_load(cnt + 64 * u.pm, __ATOMIC_RELAXED, __HIP_MEMORY_SCOPE_AGENT)) < 32u) { __builtin_amdgcn_s_sleep(1); if (++sp > (1u << 22)) break; }
            __builtin_amdgcn_fence(__ATOMIC_ACQUIRE, "agent"); }
        asm volatile("s_waitcnt vmcnt(0) lgkmcnt(0)" ::: "memory"); __builtin_amdgcn_s_barrier(); asm volatile("" ::: "memory");
        if (lane < 32) { const float* slot = xbuf + (size_t)(u.pm * BM + row) * 4; float tot = 0.f;
#pragma unroll
            for (int t = 0; t < 4; ++t) tot += __hip_atomic_load(slot + t, __ATOMIC_RELAXED, __HIP_MEMORY_SCOPE_AGENT);
            S[row] = __builtin_amdgcn_rsqf(tot * (1.f / 1024.f) + EPS); }
        asm volatile("s_waitcnt lgkmcnt(0)" ::: "memory"); __builtin_amdgcn_s_barrier(); asm volatile("" ::: "memory");
    }
};
template <bool FINAL> struct EpiResNorm {
    static constexpr bool PERM = false, AFTER_DRAIN = true;
    const float* base; float* out; bf16_t* xn; float wt; const float* gpost; const float* gnext; PanelSumSq st1, st2;
    __device__ __forceinline__ void operator()(const Acc&, const Unit&, int, int, int, int) const {}
    __device__ __forceinline__ void fused(Acc& acc, const Unit& u, int wr, int wc, int fr, int fq, LAS unsigned char* lds, int wid, int lane) const {
        const LAS float* S = (const LAS float*)(lds + 4096);
        const int col0 = u.pn * BM + wc * 32 + 4 * fq;
        st1.run(acc, u, wr, wc, fr, fq, lds, wid, lane);
#pragma unroll
        for (int ai = 0; ai < 2; ++ai)
#pragma unroll
            for (int m = 0; m < 4; ++m) { const int r = ai * HALF + wr * 64 + m * 16 + fr; const float sr = S[r] * wt; const size_t off = (size_t)(u.pm * BM + r) * 1024 + col0;
#pragma unroll
                for (int bj = 0; bj < 2; ++bj)
#pragma unroll
                    for (int n = 0; n < 2; ++n) { const f32x4 bs = *(const f32x4*)(base + off + bj * HALF + n * 16); const f32x4 g = *(const f32x4*)(gpost + col0 + bj * HALF + n * 16);
                        acc[ai][bj][m][n] = bs + acc[ai][bj][m][n] * g * sr; }
                asm volatile("" : "+v"(acc[ai][0][m][0]), "+v"(acc[ai][0][m][1]), "+v"(acc[ai][1][m][0]), "+v"(acc[ai][1][m][1]));
                if (m & 1) asm volatile("" ::: "memory"); }
        st2.run(acc, u, wr, wc, fr, fq, lds, wid, lane);
#pragma unroll
        for (int ai = 0; ai < 2; ++ai)
#pragma unroll
            for (int m = 0; m < 4; ++m) { const int r = ai * HALF + wr * 64 + m * 16 + fr; const float sr = S[r]; const size_t off = (size_t)(u.pm * BM + r) * 1024 + col0;
#pragma unroll
                for (int bj = 0; bj < 2; ++bj)
#pragma unroll
                    for (int n = 0; n < 2; ++n) { const f32x4 x1 = acc[ai][bj][m][n]; const f32x4 g = *(const f32x4*)(gnext + col0 + bj * HALF + n * 16); const f32x4 o = x1 * g * sr;
                        if (FINAL) *(f32x4*)(out + off + bj * HALF + n * 16) = o;
                        else { *(f32x4*)(out + off + bj * HALF + n * 16) = x1; u32x2 w; w.x = cvt_pk_bf16(o[0], o[1]); w.y = cvt_pk_bf16(o[2], o[3]); *(u32x2*)(xn + off + bj * HALF + n * 16) = w; } }
                asm volatile("" ::: "memory"); }
    }
};
}

namespace att {
constexpr int NW = 8, QBLK = 32, KVBLK = 64;
constexpr float SCALE = 0.07216878364870322f;
constexpr float THR = 8.f;
constexpr int LDQ = 1536, LDKV = 2048, LDKR = 64, LDO = 1024;
constexpr int SHM_V = 64 * 128 * 2, SHM_K = 64 * 128 * 2, SHM_R = 64 * 64 * 2;
constexpr int NQL = 4;
constexpr int OFF_V = 0, OFF_K = 2 * SHM_V, OFF_RP = OFF_K + 2 * SHM_K, OFF_WS = OFF_RP + 2 * SHM_R, OFF_QL = OFF_WS + NW * 64 * 4, SHM_ATTN = OFF_QL + NW * NQL * 1024;
static_assert(SHM_ATTN <= LDS_STAGE, "lds");
#define KSWZ(row, colB) ((row) * 256 + ((colB) ^ (((row) & 15) << 4)))
#define RSWZ(row, colB) ((row) * 128 + ((colB) ^ ((((row) >> 1) & 7) << 4)))
#define SBAR() __builtin_amdgcn_sched_barrier(0)
__device__ __forceinline__ int crow(int r, int hi) { return (r & 3) + 8 * (r >> 2) + 4 * hi; }
__device__ __forceinline__ bf16x8 ld8(const bf16_t* p) { return *reinterpret_cast<const bf16x8*>(p); }

__device__ __forceinline__ void partialSM(f32x16& p0, f32x16& p1, float& m_reg, float& mn, float& alpha) {
    constexpr float C = SCALE * 1.4426950408889634f;
    float pmax = p0[0];
#pragma unroll
    for (int r = 1; r < 16; ++r) pmax = fmaxf(pmax, p0[r]);
#pragma unroll
    for (int r = 0; r < 16; ++r) pmax = fmaxf(pmax, p1[r]);
    { auto rr = __builtin_amdgcn_permlane32_swap(__float_as_uint(pmax), __float_as_uint(pmax), false, false);
      pmax = fmaxf(__uint_as_float(rr[0]), __uint_as_float(rr[1])); }
    if (__builtin_expect(__all(pmax - m_reg <= THR / SCALE), 1)) { mn = m_reg; alpha = 1.f; }
    else { mn = fmaxf(m_reg, pmax); alpha = __builtin_amdgcn_exp2f((m_reg - mn) * C); m_reg = mn; }
    float mnC = -mn * C;
#pragma unroll
    for (int r = 0; r < 16; ++r) p0[r] = fmaf(p0[r], C, mnC);
#pragma unroll
    for (int r = 0; r < 16; ++r) p1[r] = fmaf(p1[r], C, mnC);
#pragma unroll
    for (int r = 0; r < 16; ++r) p0[r] = __builtin_amdgcn_exp2f(p0[r]);
}
__device__ __forceinline__ void finishSM(f32x16& p0, f32x16& p1, float alpha, float& l_reg, bf16x8& pa0, bf16x8& pa1, bf16x8& pa2, bf16x8& pa3) {
#pragma unroll
    for (int r = 0; r < 16; ++r) p1[r] = __builtin_amdgcn_exp2f(p1[r]);
    float ps = 0;
#pragma unroll
    for (int r = 0; r < 16; ++r) ps += p0[r];
#pragma unroll
    for (int r = 0; r < 16; ++r) ps += p1[r];
    { auto rr = __builtin_amdgcn_permlane32_swap(__float_as_uint(ps), __float_as_uint(ps), false, false);
      ps = __uint_as_float(rr[0]) + __uint_as_float(rr[1]); }
    l_reg = l_reg * alpha + ps;
#define PK4(P, BASE, OUT) do { unsigned a0 = cvt_pk_bf16(P[BASE + 0], P[BASE + 1]), a1 = cvt_pk_bf16(P[BASE + 2], P[BASE + 3]);   \
    unsigned b0 = cvt_pk_bf16(P[BASE + 4], P[BASE + 5]), b1 = cvt_pk_bf16(P[BASE + 6], P[BASE + 7]);                              \
    auto r0 = __builtin_amdgcn_permlane32_swap(a0, b0, false, false); auto r1 = __builtin_amdgcn_permlane32_swap(a1, b1, false, false); \
    u32x4 w = {r0[0], r1[0], r0[1], r1[1]}; OUT = *reinterpret_cast<bf16x8*>(&w); } while (0)
    PK4(p0, 0, pa0); PK4(p0, 8, pa1); PK4(p1, 0, pa2); PK4(p1, 8, pa3);
#undef PK4
}
__device__ __forceinline__ void qkt(f32x16& p0, f32x16& p1, const char* Ks, const char* Rs, const bf16x8* qr, const char* ql, int r32, int hi) {
    p0 = f32x16{}; p1 = f32x16{};
#pragma unroll
    for (int d0 = 0; d0 < 8; ++d0) { int cb = (d0 * 16 + hi * 8) * 2;
        bf16x8 b0 = *reinterpret_cast<const bf16x8*>(Ks + KSWZ(r32, cb));
        bf16x8 b1 = *reinterpret_cast<const bf16x8*>(Ks + KSWZ(32 + r32, cb));
        p0 = __builtin_amdgcn_mfma_f32_32x32x16_bf16(b0, qr[d0], p0, 0, 0, 0);
        p1 = __builtin_amdgcn_mfma_f32_32x32x16_bf16(b1, qr[d0], p1, 0, 0, 0); }
#pragma unroll
    for (int d0 = 0; d0 < 4; ++d0) { int cb = (d0 * 16 + hi * 8) * 2;
        bf16x8 b0 = *reinterpret_cast<const bf16x8*>(Rs + RSWZ(r32, cb));
        bf16x8 b1 = *reinterpret_cast<const bf16x8*>(Rs + RSWZ(32 + r32, cb));
        const bf16x8 qv = *reinterpret_cast<const bf16x8*>(ql + d0 * 1024);
        p0 = __builtin_amdgcn_mfma_f32_32x32x16_bf16(b0, qv, p0, 0, 0, 0);
        p1 = __builtin_amdgcn_mfma_f32_32x32x16_bf16(b1, qv, p1, 0, 0, 0); }
}
__device__ __forceinline__ int v_st(int k, int c) { const int kk = (k & ~0xC) | ((k & 4) << 1) | ((k & 8) >> 1); return ((kk >> 3) * 4 + (c >> 5)) * 512 + ((kk & 7) * 32 + (c & 31)) * 2; }
__device__ __forceinline__ int v_rd_base(int lane) { return ((lane & 3) << 3) | (((lane >> 2) & 3) << 6) | (((lane >> 4) & 1) << 5) | (((lane >> 5) & 1) << 8); }
constexpr int v_rd_off(int d0, int ks, int half) { return d0 * 512 + ks * 4096 + half * 2048; }
template <int OFF> __device__ __forceinline__ s16x4 tr_read(int vb) {
    s16x4 r; asm volatile("ds_read_b64_tr_b16 %0, %1 offset:%2" : "=&v"(r) : "v"(vb), "i"(OFF) : "memory"); return r;
}
template <int D0> __device__ __forceinline__ void pv_one(f32x16& od, int vb, bf16x8 pa0, bf16x8 pa1, bf16x8 pa2, bf16x8 pa3) {
    const s16x4 l0 = tr_read<v_rd_off(D0, 0, 0)>(vb), h0 = tr_read<v_rd_off(D0, 0, 1)>(vb), l1 = tr_read<v_rd_off(D0, 1, 0)>(vb), h1 = tr_read<v_rd_off(D0, 1, 1)>(vb);
    const s16x4 l2 = tr_read<v_rd_off(D0, 2, 0)>(vb), h2 = tr_read<v_rd_off(D0, 2, 1)>(vb), l3 = tr_read<v_rd_off(D0, 3, 0)>(vb), h3 = tr_read<v_rd_off(D0, 3, 1)>(vb);
    asm volatile("s_waitcnt lgkmcnt(0)" ::: "memory"); SBAR();
#define PK(L, H) (bf16x8){L[0], L[1], L[2], L[3], H[0], H[1], H[2], H[3]}
    od = __builtin_amdgcn_mfma_f32_32x32x16_bf16(pa0, PK(l0, h0), od, 0, 0, 0);
    od = __builtin_amdgcn_mfma_f32_32x32x16_bf16(pa1, PK(l1, h1), od, 0, 0, 0);
    od = __builtin_amdgcn_mfma_f32_32x32x16_bf16(pa2, PK(l2, h2), od, 0, 0, 0);
    od = __builtin_amdgcn_mfma_f32_32x32x16_bf16(pa3, PK(l3, h3), od, 0, 0, 0);
#undef PK
}
__device__ __forceinline__ void pv_d0(f32x16* o, int vb, bf16x8 pa0, bf16x8 pa1, bf16x8 pa2, bf16x8 pa3) {
    pv_one<0>(o[0], vb, pa0, pa1, pa2, pa3); pv_one<1>(o[1], vb, pa0, pa1, pa2, pa3); pv_one<2>(o[2], vb, pa0, pa1, pa2, pa3); pv_one<3>(o[3], vb, pa0, pa1, pa2, pa3);
}

__device__ __forceinline__ void attn_body(const bf16_t* __restrict__ Qb, const bf16_t* __restrict__ Kn, const bf16_t* __restrict__ Kr, const bf16_t* __restrict__ Vh,
                                          bf16_t* __restrict__ Ob, int seq, char* lds) {
    const int tid = fresh_tid(), wid = tid >> 6, lane = tid & 63, r32 = lane & 31, hi = lane >> 5;
    char* V_lds = lds + OFF_V; char* K_lds = lds + OFF_K; char* R_lds = lds + OFF_RP;
    float* ws = (float*)(lds + OFF_WS) + wid * 64; float* li_l = ws; float* al_l = ws + 32;
    float m_reg = -1e30f, l_reg = 0; f32x16 o[4] = {}; bf16x8 qr[8];
    char* ql = lds + OFF_QL + wid * (NQL * 1024) + lane * 16;
    const bf16_t* Qw = Qb + (long)(wid * QBLK + r32) * LDQ + hi * 8;
#pragma unroll
    for (int d0 = 0; d0 < 8; ++d0) qr[d0] = ld8(Qw + d0 * 16);
#pragma unroll
    for (int d0 = 0; d0 < NQL; ++d0) *reinterpret_cast<bf16x8*>(ql + d0 * 1024) = ld8(Qw + (8 + d0) * 16);
    const int sr = tid >> 4, sc = (tid & 15) * 8, vst0 = v_st(sr, sc), vst1 = v_st(32 + sr, sc);
    const int rr_ = tid >> 3, rc_ = (tid & 7) * 8;
    const int vb0 = (int)(uintptr_t)V_lds + v_rd_base(lane);
    bf16x8 vs0, vs1, ks0, ks1, rs0;
#define SLOAD(k0) do { vs0 = ld8(&Vh[(long)((k0) + sr) * LDKV + sc]); vs1 = ld8(&Vh[(long)((k0) + 32 + sr) * LDKV + sc]); \
    ks0 = ld8(&Kn[(long)((k0) + sr) * LDKV + sc]); ks1 = ld8(&Kn[(long)((k0) + 32 + sr) * LDKV + sc]); rs0 = ld8(&Kr[(long)((k0) + rr_) * LDKR + rc_]); } while (0)
#define SWRITE(b) do { *(bf16x8*)(V_lds + (b) * SHM_V + vst0) = vs0; *(bf16x8*)(V_lds + (b) * SHM_V + vst1) = vs1; int kc = sc * 2; \
    *(bf16x8*)(K_lds + (b) * SHM_K + KSWZ(sr, kc)) = ks0; *(bf16x8*)(K_lds + (b) * SHM_K + KSWZ(32 + sr, kc)) = ks1; \
    *(bf16x8*)(R_lds + (b) * SHM_R + RSWZ(rr_, rc_ * 2)) = rs0; } while (0)
#define RESC(a) do { if (__any((a) < 1.f)) { if (hi == 0) al_l[r32] = (a); asm volatile("s_waitcnt lgkmcnt(0)" ::: "memory"); \
    _Pragma("unroll") for (int d = 0; d < 4; ++d) _Pragma("unroll") for (int r = 0; r < 16; ++r) o[d][r] *= al_l[crow(r, hi)]; } } while (0)
    f32x16 pA0, pA1, pB0, pB1; float mnA, mnB, alA, alB; bf16x8 pa0, pa1, pa2, pa3; const int NT = seq / KVBLK;
    SLOAD(0); asm volatile("s_waitcnt vmcnt(0)" ::: "memory"); SWRITE(0); __syncthreads();
    qkt(pA0, pA1, K_lds, R_lds, qr, ql, r32, hi); partialSM(pA0, pA1, m_reg, mnA, alA);
    SLOAD(KVBLK);
    asm volatile("s_waitcnt vmcnt(0)" ::: "memory"); SWRITE(1); __syncthreads();
    for (int j = 1; j + 1 < NT; j += 2) {
        SBAR(); qkt(pB0, pB1, K_lds + SHM_K, R_lds + SHM_R, qr, ql, r32, hi);
        finishSM(pA0, pA1, alA, l_reg, pa0, pa1, pa2, pa3); SBAR();
        SLOAD((j + 1) * KVBLK); SBAR();
        pv_d0(o, vb0, pa0, pa1, pa2, pa3); partialSM(pB0, pB1, m_reg, mnB, alB);
        __syncthreads(); asm volatile("s_waitcnt vmcnt(0)" ::: "memory"); SWRITE(0);
        RESC(alB); __syncthreads();
        SBAR(); qkt(pA0, pA1, K_lds, R_lds, qr, ql, r32, hi);
        finishSM(pB0, pB1, alB, l_reg, pa0, pa1, pa2, pa3); SBAR();
        SLOAD((j + 2) * KVBLK); SBAR();
        pv_d0(o, vb0 + SHM_V, pa0, pa1, pa2, pa3); partialSM(pA0, pA1, m_reg, mnA, alA);
        __syncthreads(); asm volatile("s_waitcnt vmcnt(0)" ::: "memory"); SWRITE(1);
        RESC(alA); __syncthreads();
    }
    SBAR(); qkt(pB0, pB1, K_lds + SHM_K, R_lds + SHM_R, qr, ql, r32, hi);
    finishSM(pA0, pA1, alA, l_reg, pa0, pa1, pa2, pa3); SBAR();
    pv_d0(o, vb0, pa0, pa1, pa2, pa3); partialSM(pB0, pB1, m_reg, mnB, alB);
    __syncthreads(); RESC(alB);
    finishSM(pB0, pB1, alB, l_reg, pa0, pa1, pa2, pa3); SBAR();
    pv_d0(o, vb0 + SHM_V, pa0, pa1, pa2, pa3);
    if (hi == 0) li_l[r32] = l_reg; asm volatile("s_waitcnt lgkmcnt(0)" ::: "memory");
    float rli[16];
#pragma unroll
    for (int r = 0; r < 16; ++r) rli[r] = __builtin_amdgcn_rcpf(li_l[crow(r, hi)]);
    bf16_t* Ow = Ob + (long)(wid * QBLK) * LDO;
#pragma unroll
    for (int r = 0; r < 16; ++r) { int orow = crow(r, hi);
#pragma unroll
        for (int d0 = 0; d0 < 4; ++d0) { const float v = o[d0][r] * rli[r]; Ow[(long)orow * LDO + d0 * 32 + r32] = (bf16_t)(cvt_pk_bf16(v, v) & 0xffffu); } }
#undef SLOAD
#undef SWRITE
#undef RESC
}
}


#define XB_TMO      128
#define XB_XCNT(j)  (256  + 64 * (j))
#define XB_XSUB(j)  (1280 + 64 * (j))
#define XB_XGEN(j)  (2304 + 64 * (j))
#define XB_TOP      3328
#define XB_TOPGEN   3392
#define XCD_BAR_WORDS 3456
#define XB_SPIN_CAP (1u << 18)
__device__ __forceinline__ unsigned xb_ld(unsigned* p)              { return __hip_atomic_load(p, __ATOMIC_RELAXED, __HIP_MEMORY_SCOPE_AGENT); }
__device__ __forceinline__ unsigned xb_add(unsigned* p, unsigned v) { return __hip_atomic_fetch_add(p, v, __ATOMIC_RELAXED, __HIP_MEMORY_SCOPE_AGENT); }
__device__ __forceinline__ unsigned xb_xcc_id() { return (unsigned)__builtin_amdgcn_s_getreg((3 << 11) | 20) & 0xFu; }
#define XB_SPIN(cond, bar) do { unsigned _sp = 0; while (cond) { __builtin_amdgcn_s_sleep(1); \
    if ((++_sp & 255u) == 0u) { if (xb_ld(&(bar)[XB_TMO])) break; if (_sp > XB_SPIN_CAP) { atomicAdd(&(bar)[XB_TMO], 1u); break; } } } } while (0)
struct XcdBarrier { unsigned* bar; unsigned x; volatile LAS unsigned* st; };
__device__ __forceinline__ XcdBarrier xcd_barrier_post(unsigned* bar, volatile LAS unsigned* st) {
    XcdBarrier b; b.bar = bar; b.x = xb_xcc_id(); b.st = st;
    if (threadIdx.x == 0) (void)xb_add(&bar[XB_XCNT(b.x)], 1u);
    return b;
}
__device__ __forceinline__ void xcd_barrier_complete(unsigned* bar, unsigned x, unsigned& nloc, unsigned& nx) {
    const unsigned G = gridDim.x * gridDim.y * gridDim.z;
    unsigned sum, cnt, mine, sp = 0u;
    for (;;) {
        sum = 0u; cnt = 0u; mine = 0u;
#pragma unroll
        for (unsigned j = 0; j < 16; ++j) { const unsigned c = xb_ld(&bar[XB_XCNT(j)]); sum += c; cnt += (c > 0u) ? 1u : 0u; mine = (j == x) ? c : mine; }
        if (sum == G) break;
        __builtin_amdgcn_s_sleep(1);
        if ((++sp & 255u) == 0u) { if (xb_ld(&bar[XB_TMO])) break; if (sp > XB_SPIN_CAP) { atomicAdd(&bar[XB_TMO], 1u); break; } }
    }
    nloc = mine > 0u ? mine : 1u; nx = cnt > 0u ? cnt : 1u;
}
__device__ __forceinline__ void xcd_barrier(const XcdBarrier& b) {
    asm volatile("s_waitcnt vmcnt(0)" ::: "memory");
    __syncthreads();
    if (threadIdx.x == 0) {
        unsigned* bar = b.bar;
        __builtin_amdgcn_s_waitcnt(0);
        unsigned nloc = b.st[0], nx = b.st[1];
        if (nloc == 0u) { xcd_barrier_complete(bar, b.x, nloc, nx); b.st[0] = nloc; b.st[1] = nx; }
        const unsigned old = xb_add(&bar[XB_XSUB(b.x)], 1u);
        const unsigned gen = old / nloc;
        if (old + 1u == (gen + 1u) * nloc) {
            __builtin_amdgcn_fence(__ATOMIC_RELEASE, "agent");
            asm volatile("s_waitcnt vmcnt(0)" ::: "memory");
            const unsigned og = xb_add(&bar[XB_TOP], 1u);
            const unsigned tg = og / nx;
            if (og + 1u == (tg + 1u) * nx) xb_add(&bar[XB_TOPGEN], 1u);
            else XB_SPIN(xb_ld(&bar[XB_TOPGEN]) == tg, bar);
            __builtin_amdgcn_fence(__ATOMIC_ACQUIRE, "agent");
            xb_add(&bar[XB_XGEN(b.x)], 1u);
            asm volatile("s_waitcnt vmcnt(0)" ::: "memory");
        } else {
            XB_SPIN(xb_ld(&bar[XB_XGEN(b.x)]) == gen, bar);
            __builtin_amdgcn_fence(__ATOMIC_ACQUIRE, "agent");
            asm volatile("s_waitcnt vmcnt(0)" ::: "memory");
        }
    }
    __syncthreads();
}

enum { TR_PLAIN = 0, TR_GU = 1, TR_WIN = 2, TR_UQ = 3, TR_UKV = 4 };
template <int MODE>
__device__ __forceinline__ void tr_job(const float* W0, const float* W1, int K, int Nsrc, int Nout, bf16_t* WT, LAS float* scr, int lane, int gw, int NGW) {
    const int nblk = Nout / 32, nitems = (K / 64) * nblk;
    for (int it = gw; it < nitems; it += NGW) {
        const int kb = it / nblk, nb = it % nblk, k0 = 64 * kb, n0 = 32 * nb, np = n0 + (lane & 31);
        const float* colp;
        if (MODE == TR_PLAIN) colp = W0 + np;
        else if (MODE == TR_GU) { const int t = np >> 8, w = np & 255; colp = (w < 128 ? W0 : W1) + t * 128 + (w & 127); }
        else if (MODE == TR_WIN) colp = np < 1216 ? W0 + np : (np < 1280 ? nullptr : W0 + (np - 64));
        else if (MODE == TR_UQ) { const int h = np / 192, w = np % 192; colp = W0 + (w < 128 ? np : h * 192 + 128 + ((w - 128) >> 1) + ((w - 128) & 1) * 32); }
        else colp = np < 1024 ? W0 + np : W1 + (np - 1024);
        float tv[32];
#pragma unroll
        for (int i = 0; i < 32; ++i) { const int kk = 2 * i + (lane >> 5); tv[i] = colp ? colp[(size_t)(k0 + kk) * Nsrc] : 0.f; }
#pragma unroll
        for (int i = 0; i < 32; ++i) { const int kk = 2 * i + (lane >> 5); scr[kk * 33 + (lane & 31)] = tv[i]; }
        asm volatile("s_waitcnt lgkmcnt(0)" ::: "memory");
        const int c = lane & 7;
#pragma unroll
        for (int j = 0; j < 4; ++j) { const int n = (lane >> 3) + 8 * j; const LAS float* s = scr + (8 * c) * 33 + n;
            u32x4 o; o.x = cvt_pk_bf16(s[0 * 33], s[1 * 33]); o.y = cvt_pk_bf16(s[2 * 33], s[3 * 33]); o.z = cvt_pk_bf16(s[4 * 33], s[5 * 33]); o.w = cvt_pk_bf16(s[6 * 33], s[7 * 33]);
            *(u32x4*)(WT + (size_t)(n0 + n) * K + k0 + 8 * c) = o; }
        asm volatile("s_waitcnt lgkmcnt(0)" ::: "memory");
    }
}

template <int MODE>
__device__ __forceinline__ void rows_phase(const float* xin, const bf16_t* f, float wt, const float* gpost, const float* gnext, float* xout, bf16_t* xn, int gw, int NGW, int lane) {
    for (int row0 = gw; row0 < M; row0 += 2 * NGW) {
        f32x4 xv[2][4]; u32x2 fw[2][4];
#pragma unroll
        for (int r = 0; r < 2; ++r) { const size_t row = (size_t)(row0 + r * NGW);
#pragma unroll
            for (int j = 0; j < 4; ++j) { xv[r][j] = *(const f32x4*)(xin + row * DM + 4 * (lane + 64 * j));
                if (MODE != 0) fw[r][j] = *(const u32x2*)(f + row * DM + 4 * (lane + 64 * j)); } }
#pragma unroll
        for (int r = 0; r < 2; ++r) { const size_t row = (size_t)(row0 + r * NGW);
            if (MODE != 0) {
                f32x4 fv[4]; float ss = 0.f;
#pragma unroll
                for (int j = 0; j < 4; ++j) { fv[j] = (f32x4){bf_lo(fw[r][j].x), bf_hi(fw[r][j].x), bf_lo(fw[r][j].y), bf_hi(fw[r][j].y)}; ss += fv[j].x * fv[j].x + fv[j].y * fv[j].y + fv[j].z * fv[j].z + fv[j].w * fv[j].w; }
                const float rr = wt * __builtin_amdgcn_rsqf(wave_sum(ss) * (1.f / DM) + EPS);
#pragma unroll
                for (int j = 0; j < 4; ++j) { const f32x4 g = *(const f32x4*)(gpost + 4 * (lane + 64 * j)); xv[r][j] = xv[r][j] + fv[j] * g * rr; }
                if (MODE == 1) {
#pragma unroll
                    for (int j = 0; j < 4; ++j) *(f32x4*)(xout + row * DM + 4 * (lane + 64 * j)) = xv[r][j];
                }
            }
            float s2 = 0.f;
#pragma unroll
            for (int j = 0; j < 4; ++j) s2 += xv[r][j].x * xv[r][j].x + xv[r][j].y * xv[r][j].y + xv[r][j].z * xv[r][j].z + xv[r][j].w * xv[r][j].w;
            const float r2 = __builtin_amdgcn_rsqf(wave_sum(s2) * (1.f / DM) + EPS);
#pragma unroll
            for (int j = 0; j < 4; ++j) { const f32x4 g = *(const f32x4*)(gnext + 4 * (lane + 64 * j)); const f32x4 y = xv[r][j] * g * r2;
                if (MODE == 2) *(f32x4*)(xout + row * DM + 4 * (lane + 64 * j)) = y;
                else { u32x2 w; w.x = cvt_pk_bf16(y.x, y.y); w.y = cvt_pk_bf16(y.z, y.w); *(u32x2*)(xn + row * DM + 4 * (lane + 64 * j)) = w; } }
        }
    }
}

__global__ void __launch_bounds__(NTHREADS, 2) fwd_megakernel(Params p) {
    extern __shared__ __attribute__((aligned(16))) unsigned char lds[];
    cg::grid_group grid = cg::this_grid();
    volatile LAS unsigned* bst = (volatile LAS unsigned*)((LAS unsigned char*)lds + LDS_STAGE);
    if (threadIdx.x < 2) bst[threadIdx.x] = 0u;
    __syncthreads();
    const XcdBarrier xbar = xcd_barrier_post((unsigned*)(p.ws + OFF_BAR), bst);
#define GRID_SYNC_CG() do { __builtin_amdgcn_fence(__ATOMIC_RELEASE, "agent"); asm volatile("s_waitcnt vmcnt(0)" ::: "memory"); grid.sync(); \
        __builtin_amdgcn_fence(__ATOMIC_ACQUIRE, "agent"); asm volatile("s_waitcnt vmcnt(0)" ::: "memory"); } while (0)
#define GRID_SYNC() xcd_barrier(xbar)
    const int G = gridDim.x, bid = blockIdx.x, NGW = G * NWAVES;
    LAS unsigned char* ldsl = (LAS unsigned char*)lds;
#define PHASE_IDS() const int tid = fresh_tid(), lane = tid & 63, wave = tid >> 6, gw = bid * NWAVES + wave; LAS float* scr = (LAS float*)(ldsl + wave * 8448); (void)scr; (void)gw; (void)lane
    unsigned char* ws = p.ws;
    bf16_t* Wgu = (bf16_t*)(ws + OFF_WGU); bf16_t* Wd = (bf16_t*)(ws + OFF_WD); bf16_t* Win = (bf16_t*)(ws + OFF_WIN); bf16_t* Wuq = (bf16_t*)(ws + OFF_WUQ);
    bf16_t* Wukv = (bf16_t*)(ws + OFF_WUKV); bf16_t* Woa = (bf16_t*)(ws + OFF_WOA); bf16_t* Wp = (bf16_t*)(ws + OFF_WP); bf16_t* Wout = (bf16_t*)(ws + OFF_WOUT);
    bf16_t* XN = (bf16_t*)(ws + OFF_XN); bf16_t* F = (bf16_t*)(ws + OFF_F); float* ZF = (float*)(ws + OFF_ZF); bf16_t* KV = (bf16_t*)(ws + OFF_KV);
    bf16_t* H = (bf16_t*)(ws + OFF_H); bf16_t* O = (bf16_t*)(ws + OFF_O); bf16_t* CQN = (bf16_t*)(ws + OFF_CQN); bf16_t* CKVN = (bf16_t*)(ws + OFF_CKVN);
    float* TAB = (float*)(ws + OFF_TAB); bf16_t* Q = (bf16_t*)(ws + OFF_Q); bf16_t* KR = (bf16_t*)(ws + OFF_KR); bf16_t* Gt = (bf16_t*)(ws + OFF_G); bf16_t* DP = (bf16_t*)(ws + OFF_DP);
    float* X = p.out;
    float* xbuf0 = (float*)(ws + OFF_XBUF); unsigned* cnt0 = (unsigned*)(ws + OFF_CNT);

    { PHASE_IDS();
    tr_job<TR_GU>(p.f1_wg, p.f1_wu, 1024, DFF, 5632, Wgu, scr, lane, gw, NGW);
    tr_job<TR_PLAIN>(p.f1_wd, nullptr, DFF, 1024, 1024, Wd, scr, lane, gw, NGW);
    rows_phase<0>(p.x, nullptr, 0.f, nullptr, p.f1_pre, nullptr, XN, gw, NGW, lane); }
    if (__builtin_expect(p.out == nullptr, 0)) GRID_SYNC_CG();
    GRID_SYNC();

    pg8::StaticOrder S;
    { pg8::Gemm g{XN, Wgu, M, 5632, 1024}; S.init(M, 5632, G, bid); pg8::EpiSwiGLU E{H}; pg8::gemm_phase(ldsl, g, S, E); }
    {
        const int tail0 = (64 * 22) % G;
        if (tail0 != 0 && bid >= tail0) { PHASE_IDS(); const int tb = bid - tail0, nb = G - tail0, tgw = tb * NWAVES + wave, TNGW = nb * NWAVES;
            tr_job<TR_WIN>(p.w_in, nullptr, 1024, INW, 3328, Win, scr, lane, tgw, TNGW);
            tr_job<TR_UQ>(p.w_uq, nullptr, QL, 1536, 1536, Wuq, scr, lane, tgw, TNGW);
            tr_job<TR_UKV>(p.w_uk, p.w_uv, KVL, 1024, 2048, Wukv, scr, lane, tgw, TNGW);
            tr_job<TR_PLAIN>(p.w_oa, nullptr, 1024, 1024, 1024, Woa, scr, lane, tgw, TNGW);
            tr_job<TR_PLAIN>(p.w_out, nullptr, 1024, 1024, 1024, Wout, scr, lane, tgw, TNGW);
    for (int idx = tb * NTHREADS + tid; idx < 65536; idx += nb * NTHREADS) {
            const int n = idx & 1023, c8 = idx >> 10, g = c8 >> 4, cb = (c8 & 15) * 8;
            float a[8];
    #pragma unroll
            for (int i = 0; i < 8; ++i) a[i] = 0.f;
            for (int j0 = 0; j0 < 128; j0 += 8) { float w[8]; f32x4 pw[8][2];
    #pragma unroll
                for (int jj = 0; jj < 8; ++jj) w[jj] = p.w_op[(size_t)(g * 128 + j0 + jj) * 1024 + n] * p.pool_scale[g * 128 + j0 + jj];
    #pragma unroll
                for (int i = 0; i < 8; ++i) { pw[i][0] = *(const f32x4*)(p.pool_w + (size_t)(g * 128 + cb + i) * 128 + j0); pw[i][1] = *(const f32x4*)(p.pool_w + (size_t)(g * 128 + cb + i) * 128 + j0 + 4); }
    #pragma unroll
                for (int i = 0; i < 8; ++i)
    #pragma unroll
                    for (int jj = 0; jj < 8; ++jj) a[i] = fmaf(pw[i][jj >> 2][jj & 3], w[jj], a[i]); }
            u32x4 o; o.x = cvt_pk_bf16(a[0], a[1]); o.y = cvt_pk_bf16(a[2], a[3]); o.z = cvt_pk_bf16(a[4], a[5]); o.w = cvt_pk_bf16(a[6], a[7]);
            *(u32x4*)(Wp + (size_t)n * 512 + c8 * 8) = o;
        }
        }
        else if (tail0 == 0) { PHASE_IDS(); const int tb = bid, nb = G;
            tr_job<TR_WIN>(p.w_in, nullptr, 1024, INW, 3328, Win, scr, lane, gw, NGW);
            tr_job<TR_UQ>(p.w_uq, nullptr, QL, 1536, 1536, Wuq, scr, lane, gw, NGW);
            tr_job<TR_UKV>(p.w_uk, p.w_uv, KVL, 1024, 2048, Wukv, scr, lane, gw, NGW);
            tr_job<TR_PLAIN>(p.w_oa, nullptr, 1024, 1024, 1024, Woa, scr, lane, gw, NGW);
            tr_job<TR_PLAIN>(p.w_out, nullptr, 1024, 1024, 1024, Wout, scr, lane, gw, NGW);
    for (int idx = tb * NTHREADS + tid; idx < 65536; idx += nb * NTHREADS) {
            const int n = idx & 1023, c8 = idx >> 10, g = c8 >> 4, cb = (c8 & 15) * 8;
            float a[8];
    #pragma unroll
            for (int i = 0; i < 8; ++i) a[i] = 0.f;
            for (int j0 = 0; j0 < 128; j0 += 8) { float w[8]; f32x4 pw[8][2];
    #pragma unroll
                for (int jj = 0; jj < 8; ++jj) w[jj] = p.w_op[(size_t)(g * 128 + j0 + jj) * 1024 + n] * p.pool_scale[g * 128 + j0 + jj];
    #pragma unroll
                for (int i = 0; i < 8; ++i) { pw[i][0] = *(const f32x4*)(p.pool_w + (size_t)(g * 128 + cb + i) * 128 + j0); pw[i][1] = *(const f32x4*)(p.pool_w + (size_t)(g * 128 + cb + i) * 128 + j0 + 4); }
    #pragma unroll
                for (int i = 0; i < 8; ++i)
    #pragma unroll
                    for (int jj = 0; jj < 8; ++jj) a[i] = fmaf(pw[i][jj >> 2][jj & 3], w[jj], a[i]); }
            u32x4 o; o.x = cvt_pk_bf16(a[0], a[1]); o.y = cvt_pk_bf16(a[2], a[3]); o.z = cvt_pk_bf16(a[4], a[5]); o.w = cvt_pk_bf16(a[6], a[7]);
            *(u32x4*)(Wp + (size_t)n * 512 + c8 * 8) = o;
        }
        }
    }
    GRID_SYNC();
    { pg8::Gemm g{H, Wd, M, 1024, DFF}; S.init(M, 1024, G, bid);
      pg8::EpiResNorm<false> E{p.x, X, XN, 0.5f, p.f1_post, p.mix_pre, pg8::PanelSumSq{xbuf0, cnt0}, pg8::PanelSumSq{xbuf0 + (size_t)M * 4, cnt0 + 4096}}; pg8::gemm_phase(ldsl, g, S, E); }
    GRID_SYNC();
    { pg8::Gemm g{XN, Win, M, 1280, 1024}; S.init(M, 1280, G, bid); pg8::EpiBf16 E{(bf16_t*)ZF, 1280}; pg8::gemm_phase(ldsl, g, S, E); }
    {
        const int tail0 = (64 * 5) % G; PHASE_IDS();
        if (tail0 != 0 && bid >= tail0) { const int tgw = (bid - tail0) * NWAVES + wave, TNGW = (G - tail0) * NWAVES;
            tr_job<TR_GU>(p.f2_wg, p.f2_wu, 1024, DFF, 5632, Wgu, scr, lane, tgw, TNGW);
            tr_job<TR_PLAIN>(p.f2_wd, nullptr, DFF, 1024, 1024, Wd, scr, lane, tgw, TNGW); }
        else if (tail0 == 0) { tr_job<TR_GU>(p.f2_wg, p.f2_wu, 1024, DFF, 5632, Wgu, scr, lane, gw, NGW); tr_job<TR_PLAIN>(p.f2_wd, nullptr, DFF, 1024, 1024, Wd, scr, lane, gw, NGW); }
    }
    GRID_SYNC();
    { PHASE_IDS();
    const bf16_t* ZB = (const bf16_t*)ZF;
    const int t_g = lane >> 4, wnd = 2 << t_g;
    for (int k = 0; k < M / (NWAVES * 256); ++k) { const int row = gw * (M / (NWAVES * 256)) + k;
        const bf16_t* z = ZB + (size_t)row * 1280;
        const u32x4 qa = *(const u32x4*)(z + 8 * lane);
        u32x4 qb = (u32x4){0u, 0u, 0u, 0u}; if (lane < 16) qb = *(const u32x4*)(z + 512 + 8 * lane);
        const u32x4 pc = *(const u32x4*)(z + 704 + 8 * lane);
        float kx1 = 0.f, kx2 = 0.f; int pos = 0;
        if (lane < 32) { kx1 = bf_lo((unsigned)z[640 + lane]); kx2 = bf_lo((unsigned)z[672 + lane]); pos = p.pos[row]; }
        const int t = row & (SEQ - 1), lo = max(t - (wnd >> 1), 0), hi = min(t + wnd - (wnd >> 1), SEQ);
        float sacc[8];
#pragma unroll
        for (int i = 0; i < 8; ++i) sacc[i] = 0.f;
#pragma unroll
        for (int hb = 0; hb < 2; ++hb) { u32x4 nb[8]; float wv[8];
#pragma unroll
            for (int d = 0; d < 8; ++d) { const int tt = t - 8 + hb * 8 + d; const bool ok = (tt >= lo) && (tt < hi); wv[d] = ok ? 1.f : 0.f;
                nb[d] = *(const u32x4*)(z + 704 + 8 * lane + (long)(ok ? (tt - t) : 0) * 1280); }
#pragma unroll
            for (int d = 0; d < 8; ++d) { sacc[0] = fmaf(wv[d], bf_lo(nb[d].x), sacc[0]); sacc[1] = fmaf(wv[d], bf_hi(nb[d].x), sacc[1]); sacc[2] = fmaf(wv[d], bf_lo(nb[d].y), sacc[2]); sacc[3] = fmaf(wv[d], bf_hi(nb[d].y), sacc[3]);
                sacc[4] = fmaf(wv[d], bf_lo(nb[d].z), sacc[4]); sacc[5] = fmaf(wv[d], bf_hi(nb[d].z), sacc[5]); sacc[6] = fmaf(wv[d], bf_lo(nb[d].w), sacc[6]); sacc[7] = fmaf(wv[d], bf_hi(nb[d].w), sacc[7]); } }
        {
            const float inv = 1.f / (float)(hi - lo);
            u32x4 w; w.x = cvt_pk_bf16(sacc[0] * inv - bf_lo(pc.x), sacc[1] * inv - bf_hi(pc.x)); w.y = cvt_pk_bf16(sacc[2] * inv - bf_lo(pc.y), sacc[3] * inv - bf_hi(pc.y));
            w.z = cvt_pk_bf16(sacc[4] * inv - bf_lo(pc.z), sacc[5] * inv - bf_hi(pc.z)); w.w = cvt_pk_bf16(sacc[6] * inv - bf_lo(pc.w), sacc[7] * inv - bf_hi(pc.w));
            *(u32x4*)(DP + (size_t)row * 512 + 8 * lane) = w; }
        {
            float va[8] = {bf_lo(qa.x), bf_hi(qa.x), bf_lo(qa.y), bf_hi(qa.y), bf_lo(qa.z), bf_hi(qa.z), bf_lo(qa.w), bf_hi(qa.w)};
            float vb[8] = {bf_lo(qb.x), bf_hi(qb.x), bf_lo(qb.y), bf_hi(qb.y), bf_lo(qb.z), bf_hi(qb.z), bf_lo(qb.w), bf_hi(qb.w)};
            float sa = 0.f, sb = 0.f;
#pragma unroll
            for (int i = 0; i < 8; ++i) { sa = fmaf(va[i], va[i], sa); sb = fmaf(vb[i], vb[i], sb); }
            const float ssq = wave_sum(lane < 48 ? sa : 0.f), sskv = wave_sum((lane >= 48 ? sa : 0.f) + sb);
            const float rq = __builtin_amdgcn_rsqf(ssq * (1.f / QL) + EPS), rkv = __builtin_amdgcn_rsqf(sskv * (1.f / KVL) + EPS);
            const float* ga = lane < 48 ? p.qa_g + 8 * lane : p.kva_g + 8 * (lane - 48); const float ra = lane < 48 ? rq : rkv;
            const f32x4 g0 = *(const f32x4*)ga, g1 = *(const f32x4*)(ga + 4);
            u32x4 w; w.x = cvt_pk_bf16(va[0] * g0.x * ra, va[1] * g0.y * ra); w.y = cvt_pk_bf16(va[2] * g0.z * ra, va[3] * g0.w * ra); w.z = cvt_pk_bf16(va[4] * g1.x * ra, va[5] * g1.y * ra); w.w = cvt_pk_bf16(va[6] * g1.z * ra, va[7] * g1.w * ra);
            bf16_t* dst = lane < 48 ? CQN + (size_t)row * QL + 8 * lane : CKVN + (size_t)row * KVL + 8 * (lane - 48);
            *(u32x4*)dst = w;
            if (lane < 16) { const f32x4 h0 = *(const f32x4*)(p.kva_g + 128 + 8 * lane), h1 = *(const f32x4*)(p.kva_g + 132 + 8 * lane);
                u32x4 w2; w2.x = cvt_pk_bf16(vb[0] * h0.x * rkv, vb[1] * h0.y * rkv); w2.y = cvt_pk_bf16(vb[2] * h0.z * rkv, vb[3] * h0.w * rkv); w2.z = cvt_pk_bf16(vb[4] * h1.x * rkv, vb[5] * h1.y * rkv); w2.w = cvt_pk_bf16(vb[6] * h1.z * rkv, vb[7] * h1.w * rkv);
                *(u32x4*)(CKVN + (size_t)row * KVL + 128 + 8 * lane) = w2; }
        }
        if (lane < 32) {
            const float ang = (float)pos * p.inv_freq[lane];
            const double ad = (double)ang; const double kq = rint(ad * 0.15915494309189535); const float red = (float)(ad - kq * 6.283185307179586);
            const float cs = __cosf(red), sn = __sinf(red);
            TAB[(size_t)row * 64 + lane] = cs; TAB[(size_t)row * 64 + 32 + lane] = sn;
            *(unsigned*)(KR + (size_t)row * 64 + 2 * lane) = cvt_pk_bf16(kx1 * cs - kx2 * sn, kx2 * cs + kx1 * sn);
        }
    } }
    GRID_SYNC();
    { pg8::Gemm g{CQN, Wuq, M, 1536, QL}; S.init(M, 1536, G, bid); pg8::EpiQ E{Q, TAB}; pg8::gemm_phase(ldsl, g, S, E); }
    { pg8::Gemm g{CKVN, Wukv, M, 2048, KVL}; S.init(M, 2048, G, bid); pg8::EpiBf16 E{KV, 2048}; pg8::gemm_phase(ldsl, g, S, E); }
    GRID_SYNC();
    {
        const int vcu = (bid & 7) * (G >> 3) + (bid >> 3);
        for (int it = vcu; it < NB * NH * (SEQ / 256); it += G) {
            const int qb = it & 7, h = (it >> 3) & 7, b = it >> 6;
            const size_t tok0 = (size_t)b * SEQ;
            att::attn_body(Q + (tok0 + qb * 256) * 1536 + h * 192, KV + tok0 * 2048 + h * 128, KR + tok0 * 64, KV + tok0 * 2048 + 1024 + h * 128,
                           O + (tok0 + qb * 256) * 1024 + h * 128, SEQ, (char*)lds);
            __syncthreads();
        }
    }
    GRID_SYNC();
    { pg8::Gemm g{XN, Win + (size_t)1280 * 1024, M, 2048, 1024}; pg8::GateOrder GO; GO.s.init(M, 1024, G, bid); pg8::EpiGate E{Gt}; pg8::gemm_phase(ldsl, g, GO, E); }
    { pg8::Gemm g{O, Woa, M, 1024, 1024}; S.init(M, 1024, G, bid); pg8::EpiT1 E{Gt, F}; pg8::gemm_phase(ldsl, g, S, E); }
    { pg8::Gemm g{DP, Wp, M, 1024, 512}; S.init(M, 1024, G, bid); pg8::EpiMX E{Gt, F, XN}; pg8::gemm_phase(ldsl, g, S, E); }
    GRID_SYNC();
    { pg8::Gemm g{XN, Wout, M, 1024, 1024}; S.init(M, 1024, G, bid);
      pg8::EpiResNorm<false> E{X, X, XN, 1.0f, p.mix_post, p.f2_pre, pg8::PanelSumSq{xbuf0 + (size_t)M * 8, cnt0 + 2 * 4096}, pg8::PanelSumSq{xbuf0 + (size_t)M * 12, cnt0 + 3 * 4096}}; pg8::gemm_phase(ldsl, g, S, E); }
    GRID_SYNC();
    { pg8::Gemm g{XN, Wgu, M, 5632, 1024}; S.init(M, 5632, G, bid); pg8::EpiSwiGLU E{H}; pg8::gemm_phase(ldsl, g, S, E); }
    GRID_SYNC();
    { pg8::Gemm g{H, Wd, M, 1024, DFF}; S.init(M, 1024, G, bid);
      pg8::EpiResNorm<true> E{X, X, nullptr, 0.5f, p.f2_post, p.final_g, pg8::PanelSumSq{xbuf0 + (size_t)M * 16, cnt0 + 4 * 4096}, pg8::PanelSumSq{xbuf0 + (size_t)M * 20, cnt0 + 5 * 4096}}; pg8::gemm_phase(ldsl, g, S, E); }
}

extern "C" void kernel_launch(void* const* d_in, const int* in_sizes, int n_in, void* d_out, int out_size, void* d_ws, size_t ws_size, hipStream_t stream) {
    static int grid_blocks = 0;
    if (grid_blocks == 0) {
        if (n_in != 26 || in_sizes[0] != M * DM || out_size != M * DM || ws_size < WS_END) { fprintf(stderr, "kernel_launch: shape mismatch n_in %d in0 %d out %d ws %zu\n", n_in, n_in > 0 ? in_sizes[0] : -1, out_size, ws_size); grid_blocks = -1; return; }
        int dev = 0, cus = 0, per_cu = 0;
        (void)hipGetDevice(&dev);
        (void)hipDeviceGetAttribute(&cus, hipDeviceAttributeMultiprocessorCount, dev);
        if (hipFuncSetAttribute((const void*)fwd_megakernel, hipFuncAttributeMaxDynamicSharedMemorySize, LDS_BYTES) != hipSuccess) { fprintf(stderr, "kernel_launch: hipFuncSetAttribute failed\n"); grid_blocks = -1; return; }
        if (hipOccupancyMaxActiveBlocksPerMultiprocessor(&per_cu, (const void*)fwd_megakernel, NTHREADS, LDS_BYTES) != hipSuccess || per_cu < 1) { fprintf(stderr, "kernel_launch: occupancy query failed (%d)\n", per_cu); (void)hipGetLastError(); per_cu = 1; }
        grid_blocks = cus * 1;
        if (grid_blocks != 256) { fprintf(stderr, "kernel_launch: built for 256 CUs (one workgroup each), device has %d\n", cus); grid_blocks = -1; return; }
    }
    if (grid_blocks < 0) return;
    Params p{};
    p.x = (const float*)d_in[0]; p.pos = (const int*)d_in[1];
    p.f1_pre = (const float*)d_in[2]; p.f1_wg = (const float*)d_in[3]; p.f1_wu = (const float*)d_in[4]; p.f1_wd = (const float*)d_in[5]; p.f1_post = (const float*)d_in[6];
    p.mix_pre = (const float*)d_in[7]; p.w_in = (const float*)d_in[8]; p.qa_g = (const float*)d_in[9]; p.w_uq = (const float*)d_in[10]; p.kva_g = (const float*)d_in[11];
    p.w_uk = (const float*)d_in[12]; p.w_uv = (const float*)d_in[13]; p.w_oa = (const float*)d_in[14]; p.pool_w = (const float*)d_in[15]; p.pool_scale = (const float*)d_in[16];
    p.w_op = (const float*)d_in[17]; p.w_out = (const float*)d_in[18]; p.mix_post = (const float*)d_in[19];
    p.f2_pre = (const float*)d_in[20]; p.f2_wg = (const float*)d_in[21]; p.f2_wu = (const float*)d_in[22]; p.f2_wd = (const float*)d_in[23]; p.f2_post = (const float*)d_in[24]; p.final_g = (const float*)d_in[25];
    p.out = (float*)d_out; p.ws = (unsigned char*)d_ws;
    for (int i = 0; i < 32; ++i) p.inv_freq[i] = (float)pow(10000.0, -(2.0 * i) / 64.0);
    if (hipMemsetAsync((char*)d_ws + OFF_BAR, 0, CTL_BYTES, stream) != hipSuccess) { fprintf(stderr, "kernel_launch: memset failed\n"); return; }
    void* args[] = {&p};
    hipError_t e = hipLaunchCooperativeKernel((const void*)fwd_megakernel, dim3(grid_blocks), dim3(NTHREADS), args, LDS_BYTES, stream);
    if (e != hipSuccess) fprintf(stderr, "cooperative launch failed: %s (grid %d)\n", hipGetErrorString(e), grid_blocks);
}
```

```cpp
#include <hip/hip_runtime.h>
#include <hip/hip_cooperative_groups.h>
#include <cstdio>
#include <cmath>
#include <cstdint>
namespace cg = cooperative_groups;

#define LAS __attribute__((address_space(3)))
typedef unsigned short bf16_t;
typedef short bf16x8 __attribute__((ext_vector_type(8)));
typedef short s16x4 __attribute__((ext_vector_type(4)));
typedef float f32x2 __attribute__((ext_vector_type(2)));
typedef float f32x4 __attribute__((ext_vector_type(4)));
typedef float f32x16 __attribute__((ext_vector_type(16)));
typedef unsigned u32x4 __attribute__((ext_vector_type(4)));
typedef unsigned u32x2 __attribute__((ext_vector_type(2)));

constexpr int DM = 1024, NB = 8, SEQ = 2048, M = NB * SEQ, NH = 8, QL = 384, KVL = 256, DFF = 2816, INW = 3264;
constexpr float EPS = 1e-6f;
constexpr int NTHREADS = 512, NWAVES = 8;
constexpr int LDS_STAGE = 131072, LDS_BYTES = LDS_STAGE + 16;

constexpr size_t MiB = 1048576;
constexpr size_t OFF_WGU = 0;
constexpr size_t OFF_WD = OFF_WGU + (size_t)5632 * 1024 * 2;
constexpr size_t OFF_WIN = OFF_WD + (size_t)1024 * 2816 * 2;
constexpr size_t OFF_WUQ = OFF_WIN + (size_t)3328 * 1024 * 2;
constexpr size_t OFF_WUKV = OFF_WUQ + (size_t)1536 * 384 * 2;
constexpr size_t OFF_WOA = OFF_WUKV + (size_t)2048 * 256 * 2;
constexpr size_t OFF_WP = OFF_WOA + (size_t)1024 * 1024 * 2;
constexpr size_t OFF_WOUT = OFF_WP + (size_t)1024 * 512 * 2;
constexpr size_t OFF_XN = OFF_WOUT + (size_t)1024 * 1024 * 2;
constexpr size_t OFF_R = OFF_XN + 32 * MiB;
constexpr size_t OFF_F = OFF_R;
constexpr size_t OFF_ZF = OFF_R;
constexpr size_t OFF_KV = OFF_R;
constexpr size_t OFF_H = OFF_R + 64 * MiB;
constexpr size_t OFF_O = OFF_R + 64 * MiB;
constexpr size_t OFF_CQN = OFF_R + 80 * MiB;
constexpr size_t OFF_CKVN = OFF_R + 92 * MiB;
constexpr size_t OFF_TAB = OFF_R + 100 * MiB;
constexpr size_t OFF_Q = OFF_R + 104 * MiB;
constexpr size_t OFF_KR = OFF_R + 152 * MiB;
constexpr size_t OFF_G = OFF_R + 96 * MiB;
constexpr size_t OFF_DP = OFF_R + 176 * MiB;
constexpr size_t WS_END = OFF_R + 192 * MiB;
constexpr size_t OFF_BAR = WS_END, OFF_CNT = OFF_BAR + 16384, CTL_BYTES = 16384 + 6 * 16384, OFF_XBUF = OFF_BAR + CTL_BYTES;
static_assert(OFF_XBUF + 6 * (size_t)M * 16 <= 256 * MiB, "workspace");

struct Params {
    const float* x; const int* pos;
    const float *f1_pre, *f1_wg, *f1_wu, *f1_wd, *f1_post;
    const float *mix_pre, *w_in, *qa_g, *w_uq, *kva_g, *w_uk, *w_uv, *w_oa, *pool_w, *pool_scale, *w_op, *w_out, *mix_post;
    const float *f2_pre, *f2_wg, *f2_wu, *f2_wd, *f2_post, *final_g;
    float* out; unsigned char* ws;
    float inv_freq[32];
};

typedef __bf16 bf16x2_t __attribute__((ext_vector_type(2)));
__device__ __forceinline__ unsigned cvt_pk_bf16(float lo, float hi) { const f32x2 v = {lo, hi}; const bf16x2_t r = __builtin_convertvector(v, bf16x2_t); return __builtin_bit_cast(unsigned, r); }
__device__ __forceinline__ float bf_lo(unsigned w) { return __uint_as_float(w << 16); }
__device__ __forceinline__ float bf_hi(unsigned w) { return __uint_as_float(w & 0xffff0000u); }
__device__ __forceinline__ float sigmoidf_fast(float z) { return __builtin_amdgcn_rcpf(1.f + __builtin_amdgcn_exp2f(-1.4426950408889634f * z)); }
__device__ __forceinline__ int fresh_tid() { int t = threadIdx.x; asm volatile("" : "+v"(t)); return t; }
__device__ __forceinline__ float wave_sum(float v) {
#pragma unroll
    for (int o = 1; o < 64; o <<= 1) v += __shfl_xor(v, o);
    return v;
}

namespace pg8 {
constexpr int BM = 256, BK = 64, HALF = 128, HTB = HALF * BK * 2, STAGE_BYTES = 8 * HTB, NXCD = 8, WGM = 4;
__host__ __device__ __forceinline__ int lds_byte(int r, int c) { const int st = (r >> 4) * 2 + (c >> 5), rr = r & 15, cc = c & 31, ob = rr * 64 + cc * 2; return st * 1024 + (ob ^ (((ob >> 9) & 1) << 5)); }
__host__ __device__ __forceinline__ void stage_rc(int b, int& R, int& C) { const int st = b / 1024, sb = b % 1024, swz = sb ^ (((sb >> 9) & 1) << 5); R = (st >> 1) * 16 + swz / 64; C = (st & 1) * 32 + (swz % 64) / 2; }
__host__ __device__ __forceinline__ int perm32(int rho) { const int n = rho >> 4, i = rho & 15; return 8 * (i >> 2) + 4 * n + (i & 3); }
struct Unit { int pm, pn; };
struct Gemm { const bf16_t* A; const bf16_t* Bt; int M, N, K; };
struct StaticOrder {
    int nM, nN, nwg, G, c;
    __device__ void init(int M_, int N_, int G_, int c_) { nM = M_ / BM; nN = N_ / BM; nwg = nM * nN; G = G_; c = c_; }
    __device__ bool next(int i, Unit& u) const {
        const long L = (long)i * G + c; if (L >= nwg) return false;
        int wgid = (int)L; { const int q = nwg / NXCD, r = nwg % NXCD, xcd = wgid % NXCD, off = wgid / NXCD; wgid = (xcd < r ? xcd * (q + 1) : r * (q + 1) + (xcd - r) * q) + off; }
        const int nig = WGM * nN, gid = wgid / nig, fm = gid * WGM, gsz = (nM - fm) < WGM ? (nM - fm) : WGM;
        u.pm = fm + ((wgid % nig) % gsz); u.pn = (wgid % nig) / gsz; return true;
    }
};

struct GateOrder { StaticOrder s;
    __device__ bool next(int i, Unit& u) const { if (i >= 2) return false; Unit b; if (!s.next(0, b)) return false; u.pm = b.pm; u.pn = b.pn + 4 * i; return true; } };
template <class Epi, class Sched>
__device__ __forceinline__ void gemm_phase(LAS unsigned char* lds, const Gemm g, const Sched& S, const Epi& E) {
    const int tid = fresh_tid(), wid = __builtin_amdgcn_readfirstlane(tid >> 6), lane = tid & 63, wr = wid >> 2, wc = wid & 3, fr = lane & 15, fq = lane >> 4;
    const int K = g.K, nt = K / BK;
    unsigned voffA, voffB;
    { int R, C; stage_rc(tid * 16, R, C); const int Rb = Epi::PERM ? ((R & ~31) + perm32(R & 31)) : R;
      voffA = (unsigned)(R * K + C) * 2u; voffB = (unsigned)(Rb * K + C) * 2u; }
    const size_t rstep64 = (size_t)64 * K * 2;
    const size_t kstep = (size_t)(BK * 2);
    const size_t hstep = (size_t)HALF * K * 2;
    const size_t tstep = 2 * hstep;
    const unsigned ldsw = (unsigned)wid * 1024u;
    const int aoff = lds_byte(wr * 64 + fr, fq * 8), boff = lds_byte(wc * 32 + fr, fq * 8);
#define PG8_SA(b, h) (((b) * 2 + (h)) * HTB)
#define PG8_SB(b, h) ((4 + (b) * 2 + (h)) * HTB)
#define PG8_STAGE(bufoff, gbase, voff) do { _Pragma("unroll") for (int _i = 0; _i < 2; ++_i) \
        __builtin_amdgcn_global_load_lds((const unsigned*)((const char*)(gbase) + _i * rstep64 + (voff)), (LAS unsigned*)(lds + (bufoff) + ldsw + _i * 8192), 16, 0, 0); } while (0)
#define PG8_LDA(dst, b, h) do { _Pragma("unroll") for (int m = 0; m < 4; ++m) _Pragma("unroll") for (int k = 0; k < 2; ++k) dst[m][k] = *(const LAS bf16x8*)(lds + PG8_SA(b, h) + aoff + m * 2048 + k * 1024); } while (0)
#define PG8_LDB(dst, b, h) do { _Pragma("unroll") for (int n = 0; n < 2; ++n) _Pragma("unroll") for (int k = 0; k < 2; ++k) dst[n][k] = *(const LAS bf16x8*)(lds + PG8_SB(b, h) + boff + n * 2048 + k * 1024); } while (0)
#define PG8_MMA(ai, bj, At, Bt) do { __builtin_amdgcn_s_setprio(1); _Pragma("unroll") for (int m = 0; m < 4; ++m) _Pragma("unroll") for (int n = 0; n < 2; ++n) _Pragma("unroll") for (int k = 0; k < 2; ++k) \
        acc[ai][bj][m][n] = __builtin_amdgcn_mfma_f32_16x16x32_bf16(Bt[n][k], At[m][k], acc[ai][bj][m][n], 0, 0, 0); __builtin_amdgcn_s_setprio(0); } while (0)
#define PG8_WAIT_V(n) asm volatile("s_waitcnt vmcnt(" #n ")" ::: "memory")
#define PG8_WAIT_L(n) asm volatile("s_waitcnt lgkmcnt(" #n ")" ::: "memory")
#define PG8_BAR __builtin_amdgcn_s_barrier()
#define PG8_SCHED __builtin_amdgcn_sched_barrier(0)
    Unit cur, nxt; int ui = 0;
    if (!S.next(0, cur)) return;
    f32x4 acc[2][2][4][2];
#pragma unroll
    for (int a = 0; a < 2; ++a)
#pragma unroll
        for (int b = 0; b < 2; ++b)
#pragma unroll
            for (int m = 0; m < 4; ++m)
#pragma unroll
                for (int n = 0; n < 2; ++n) acc[a][b][m][n] = (f32x4){0.f, 0.f, 0.f, 0.f};
    bf16x8 At[4][2], B0[2][2], B1[2][2];
    const char* cA = (const char*)g.A + (size_t)cur.pm * tstep; const char* cB = (const char*)g.Bt + (size_t)cur.pn * tstep;
    PG8_STAGE(PG8_SB(0, 0), cB, voffB); PG8_STAGE(PG8_SA(0, 0), cA, voffA); PG8_STAGE(PG8_SB(0, 1), cB + hstep, voffB); PG8_STAGE(PG8_SA(0, 1), cA + hstep, voffA);
    if (wr == 1) PG8_BAR;
    PG8_WAIT_V(4); PG8_BAR;
    PG8_STAGE(PG8_SB(1, 0), cB + kstep, voffB); PG8_STAGE(PG8_SA(1, 0), cA + kstep, voffA); PG8_STAGE(PG8_SB(1, 1), cB + hstep + kstep, voffB);
    PG8_WAIT_V(6); PG8_BAR;
    for (;;) {
        const bool has_next = S.next(ui + 1, nxt);
        const char* nA = has_next ? (const char*)g.A + (size_t)nxt.pm * tstep : cA; const char* nB = has_next ? (const char*)g.Bt + (size_t)nxt.pn * tstep : cB;
        for (int t = 0; t < nt; t += 2) {
            const bool last = (t == nt - 2);
            const char* a1 = cA + (size_t)(t + 1) * kstep;
            const char* a2 = last ? nA : cA + (size_t)(t + 2) * kstep; const char* b2 = last ? nB : cB + (size_t)(t + 2) * kstep;
            const char* a3 = a2 + kstep; const char* b3 = b2 + kstep;
            PG8_LDB(B0, 0, 0); PG8_SCHED; PG8_LDA(At, 0, 0); PG8_STAGE(PG8_SA(1, 1), a1 + hstep, voffA);
            PG8_WAIT_L(8); PG8_BAR; PG8_WAIT_L(0); PG8_MMA(0, 0, At, B0); PG8_BAR; PG8_SCHED;
            PG8_LDB(B1, 0, 1); PG8_STAGE(PG8_SB(0, 0), b2, voffB);
            PG8_BAR; PG8_WAIT_L(0); PG8_MMA(0, 1, At, B1); PG8_BAR;
            PG8_LDA(At, 0, 1); PG8_STAGE(PG8_SA(0, 0), a2, voffA);
            PG8_BAR; PG8_WAIT_L(0); PG8_MMA(1, 0, At, B0); PG8_BAR; PG8_SCHED;
            PG8_STAGE(PG8_SB(0, 1), b2 + hstep, voffB);
            PG8_WAIT_V(6); PG8_BAR; PG8_MMA(1, 1, At, B1); PG8_BAR;
            PG8_LDB(B0, 1, 0); PG8_SCHED; PG8_LDA(At, 1, 0); PG8_STAGE(PG8_SA(0, 1), a2 + hstep, voffA);
            PG8_WAIT_L(8); PG8_BAR; PG8_WAIT_L(0); PG8_MMA(0, 0, At, B0); PG8_BAR; PG8_SCHED;
            PG8_LDB(B1, 1, 1); PG8_STAGE(PG8_SB(1, 0), b3, voffB);
            PG8_BAR; PG8_WAIT_L(0); PG8_MMA(0, 1, At, B1); PG8_BAR;
            PG8_LDA(At, 1, 1); PG8_STAGE(PG8_SA(1, 0), a3, voffA);
            PG8_BAR; PG8_WAIT_L(0); PG8_MMA(1, 0, At, B0); PG8_BAR; PG8_SCHED;
            PG8_STAGE(PG8_SB(1, 1), b3 + hstep, voffB);
            PG8_WAIT_V(6); PG8_BAR; PG8_MMA(1, 1, At, B1); PG8_BAR;
        }
        if constexpr (!Epi::AFTER_DRAIN) { const int t2 = fresh_tid(); E(acc, cur, wr, wc, t2 & 15, (t2 >> 4) & 3); }
        if (!has_next) break;
#pragma unroll
        for (int a = 0; a < 2; ++a)
#pragma unroll
            for (int b = 0; b < 2; ++b)
#pragma unroll
                for (int m = 0; m < 4; ++m)
#pragma unroll
                    for (int n = 0; n < 2; ++n) acc[a][b][m][n] = (f32x4){0.f, 0.f, 0.f, 0.f};
        cur = nxt; cA = nA; cB = nB; ++ui;
    }
    PG8_WAIT_V(0);
    if (wr == 0) PG8_BAR;
    PG8_BAR;
    if constexpr (Epi::AFTER_DRAIN) { const int t2 = fresh_tid(); E.fused(acc, cur, wr, wc, t2 & 15, (t2 >> 4) & 3, lds, t2 >> 6, t2 & 63); }
#undef PG8_SA
#undef PG8_SB
#undef PG8_STAGE
#undef PG8_LDA
#undef PG8_LDB
#undef PG8_MMA
#undef PG8_WAIT_V
#undef PG8_WAIT_L
#undef PG8_BAR
#undef PG8_SCHED
}

typedef f32x4 Acc[2][2][4][2];
struct EpiF32 {
    static constexpr bool PERM = false, AFTER_DRAIN = false;
    float* C; int ldc;
    __device__ __forceinline__ void operator()(const Acc& acc, const Unit& u, int wr, int wc, int fr, int fq) const {
        const int row0 = u.pm * BM + wr * 64 + fr, col0 = u.pn * BM + wc * 32 + 4 * fq;
#pragma unroll
        for (int ai = 0; ai < 2; ++ai)
#pragma unroll
            for (int m = 0; m < 4; ++m) { float* rowp = C + (size_t)(row0 + ai * HALF + m * 16) * ldc + col0;
#pragma unroll
                for (int bj = 0; bj < 2; ++bj)
#pragma unroll
                    for (int n = 0; n < 2; ++n) *(f32x4*)(rowp + bj * HALF + n * 16) = acc[ai][bj][m][n]; }
    }
};
struct EpiBf16 {
    static constexpr bool PERM = true, AFTER_DRAIN = false;
    bf16_t* O; int ldc;
    __device__ __forceinline__ void operator()(const Acc& acc, const Unit& u, int wr, int wc, int fr, int fq) const {
        const int row0 = u.pm * BM + wr * 64 + fr, col0 = u.pn * BM + wc * 32 + 8 * fq;
#pragma unroll
        for (int ai = 0; ai < 2; ++ai)
#pragma unroll
            for (int m = 0; m < 4; ++m) { bf16_t* rowp = O + (size_t)(row0 + ai * HALF + m * 16) * ldc + col0;
#pragma unroll
                for (int bj = 0; bj < 2; ++bj) { const f32x4 v0 = acc[ai][bj][m][0], v1 = acc[ai][bj][m][1];
                    u32x4 w; w.x = cvt_pk_bf16(v0[0], v0[1]); w.y = cvt_pk_bf16(v0[2], v0[3]); w.z = cvt_pk_bf16(v1[0], v1[1]); w.w = cvt_pk_bf16(v1[2], v1[3]);
                    *(u32x4*)(rowp + bj * HALF) = w; } }
    }
};
struct EpiSwiGLU {
    static constexpr bool PERM = true, AFTER_DRAIN = false;
    bf16_t* H;
    __device__ __forceinline__ void operator()(const Acc& acc, const Unit& u, int wr, int wc, int fr, int fq) const {
        const int row0 = u.pm * BM + wr * 64 + fr, col0 = u.pn * HALF + wc * 32 + 8 * fq;
#pragma unroll
        for (int ai = 0; ai < 2; ++ai)
#pragma unroll
            for (int m = 0; m < 4; ++m) { bf16_t* rowp = H + (size_t)(row0 + ai * HALF + m * 16) * DFF + col0;
                float h[8];
#pragma unroll
                for (int n = 0; n < 2; ++n)
#pragma unroll
                    for (int j = 0; j < 4; ++j) { const float gt = acc[ai][0][m][n][j], up = acc[ai][1][m][n][j]; h[n * 4 + j] = gt * sigmoidf_fast(gt) * up; }
                u32x4 w; w.x = cvt_pk_bf16(h[0], h[1]); w.y = cvt_pk_bf16(h[2], h[3]); w.z = cvt_pk_bf16(h[4], h[5]); w.w = cvt_pk_bf16(h[6], h[7]);
                *(u32x4*)rowp = w; }
    }
};
struct EpiGate {
    static constexpr bool PERM = true, AFTER_DRAIN = false;
    bf16_t* G;
    __device__ __forceinline__ void operator()(const Acc& acc, const Unit& u, int wr, int wc, int fr, int fq) const {
        const int row0 = u.pm * BM + wr * 64 + fr, col0 = u.pn * BM + wc * 32 + 8 * fq;
#pragma unroll
        for (int ai = 0; ai < 2; ++ai)
#pragma unroll
            for (int m = 0; m < 4; ++m) { bf16_t* rowp = G + (size_t)(row0 + ai * HALF + m * 16) * 2048 + col0;
#pragma unroll
                for (int bj = 0; bj < 2; ++bj) { const f32x4 v0 = acc[ai][bj][m][0], v1 = acc[ai][bj][m][1];
                    u32x4 w; w.x = cvt_pk_bf16(sigmoidf_fast(v0[0]), sigmoidf_fast(v0[1])); w.y = cvt_pk_bf16(sigmoidf_fast(v0[2]), sigmoidf_fast(v0[3]));
                    w.z = cvt_pk_bf16(sigmoidf_fast(v1[0]), sigmoidf_fast(v1[1])); w.w = cvt_pk_bf16(sigmoidf_fast(v1[2]), sigmoidf_fast(v1[3]));
                    *(u32x4*)(rowp + bj * HALF) = w; } }
    }
};
struct EpiQ {
    static constexpr bool PERM = true, AFTER_DRAIN = false;
    bf16_t* Q; const float* TAB;
    __device__ __forceinline__ void operator()(const Acc& acc, const Unit& u, int wr, int wc, int fr, int fq) const {
        const int row0 = u.pm * BM + wr * 64 + fr, col0 = u.pn * BM + wc * 32 + 8 * fq;
#pragma unroll
        for (int ai = 0; ai < 2; ++ai)
#pragma unroll
            for (int m = 0; m < 4; ++m) { const int row = row0 + ai * HALF + m * 16; bf16_t* rowp = Q + (size_t)row * 1536 + col0;
#pragma unroll
                for (int bj = 0; bj < 2; ++bj) { f32x4 v0 = acc[ai][bj][m][0], v1 = acc[ai][bj][m][1];
                    const int c = col0 + bj * HALF, w = c % 192;
                    if (w >= 128) { const int i0 = (w - 128) >> 1; const f32x4 cs = *(const f32x4*)(TAB + (size_t)row * 64 + i0), sn = *(const f32x4*)(TAB + (size_t)row * 64 + 32 + i0);
                        f32x4 r0, r1;
                        r0[0] = v0[0] * cs[0] - v0[1] * sn[0]; r0[1] = v0[1] * cs[0] + v0[0] * sn[0];
                        r0[2] = v0[2] * cs[1] - v0[3] * sn[1]; r0[3] = v0[3] * cs[1] + v0[2] * sn[1];
                        r1[0] = v1[0] * cs[2] - v1[1] * sn[2]; r1[1] = v1[1] * cs[2] + v1[0] * sn[2];
                        r1[2] = v1[2] * cs[3] - v1[3] * sn[3]; r1[3] = v1[3] * cs[3] + v1[2] * sn[3];
                        v0 = r0; v1 = r1; }
                    u32x4 wv; wv.x = cvt_pk_bf16(v0[0], v0[1]); wv.y = cvt_pk_bf16(v0[2], v0[3]); wv.z = cvt_pk_bf16(v1[0], v1[1]); wv.w = cvt_pk_bf16(v1[2], v1[3]);
                    *(u32x4*)(rowp + bj * HALF) = wv; } }
    }
};
struct EpiT1 {
    static constexpr bool PERM = true, AFTER_DRAIN = false;
    const bf16_t* G; bf16_t* F;
    __device__ __forceinline__ void operator()(const Acc& acc, const Unit& u, int wr, int wc, int fr, int fq) const {
        const int row0 = u.pm * BM + wr * 64 + fr, col0 = u.pn * BM + wc * 32 + 8 * fq;
#pragma unroll
        for (int ai = 0; ai < 2; ++ai)
#pragma unroll
            for (int m = 0; m < 4; ++m) { const int row = row0 + ai * HALF + m * 16;
#pragma unroll
                for (int bj = 0; bj < 2; ++bj) { const f32x4 v0 = acc[ai][bj][m][0], v1 = acc[ai][bj][m][1]; const int c = col0 + bj * HALF;
                    const u32x4 gw = *(const u32x4*)(G + (size_t)row * 2048 + c);
                    u32x4 wv;
                    wv.x = cvt_pk_bf16(v0[0] * bf_lo(gw.x), v0[1] * bf_hi(gw.x)); wv.y = cvt_pk_bf16(v0[2] * bf_lo(gw.y), v0[3] * bf_hi(gw.y));
                    wv.z = cvt_pk_bf16(v1[0] * bf_lo(gw.z), v1[1] * bf_hi(gw.z)); wv.w = cvt_pk_bf16(v1[2] * bf_lo(gw.w), v1[3] * bf_hi(gw.w));
                    *(u32x4*)(F + (size_t)row * 1024 + c) = wv; } }
    }
};
struct EpiMX {
    static constexpr bool PERM = true, AFTER_DRAIN = false;
    const bf16_t* G; const bf16_t* F; bf16_t* MX;
    __device__ __forceinline__ void operator()(const Acc& acc, const Unit& u, int wr, int wc, int fr, int fq) const {
        const int row0 = u.pm * BM + wr * 64 + fr, col0 = u.pn * BM + wc * 32 + 8 * fq;
#pragma unroll
        for (int ai = 0; ai < 2; ++ai)
#pragma unroll
            for (int m = 0; m < 4; ++m) { const int row = row0 + ai * HALF + m * 16;
#pragma unroll
                for (int bj = 0; bj < 2; ++bj) { const f32x4 v0 = acc[ai][bj][m][0], v1 = acc[ai][bj][m][1]; const int c = col0 + bj * HALF;
                    const u32x4 gw = *(const u32x4*)(G + (size_t)row * 2048 + 1024 + c);
                    const u32x4 tw = *(const u32x4*)(F + (size_t)row * 1024 + c);
                    u32x4 wv;
                    wv.x = cvt_pk_bf16(bf_lo(tw.x) + v0[0] * bf_lo(gw.x), bf_hi(tw.x) + v0[1] * bf_hi(gw.x)); wv.y = cvt_pk_bf16(bf_lo(tw.y) + v0[2] * bf_lo(gw.y), bf_hi(tw.y) + v0[3] * bf_hi(gw.y));
                    wv.z = cvt_pk_bf16(bf_lo(tw.z) + v1[0] * bf_lo(gw.z), bf_hi(tw.z) + v1[1] * bf_hi(gw.z)); wv.w = cvt_pk_bf16(bf_lo(tw.w) + v1[2] * bf_lo(gw.w), bf_hi(tw.w) + v1[3] * bf_hi(gw.w));
                    *(u32x4*)(MX + (size_t)row * 1024 + c) = wv; } }
    }
};

struct PanelSumSq {
    float* xbuf;
    unsigned* cnt;
    __device__ __forceinline__ void run(const Acc& v, const Unit& u, int wr, int wc, int fr, int fq, LAS unsigned char* lds, int wid, int lane) const {
        LAS float* P = (LAS float*)lds; LAS float* S = (LAS float*)(lds + 4096);
#pragma unroll
        for (int ai = 0; ai < 2; ++ai)
#pragma unroll
            for (int m = 0; m < 4; ++m) { float q = 0.f;
#pragma unroll
                for (int bj = 0; bj < 2; ++bj)
#pragma unroll
                    for (int n = 0; n < 2; ++n) { const f32x4 x = v[ai][bj][m][n]; q += (x[0] * x[0] + x[1] * x[1]) + (x[2] * x[2] + x[3] * x[3]); }
                q += __shfl_xor(q, 16); q += __shfl_xor(q, 32);
                if (fq == 0) P[(ai * HALF + wr * 64 + m * 16 + fr) * 4 + wc] = q; }
        asm volatile("s_waitcnt lgkmcnt(0)" ::: "memory"); __builtin_amdgcn_s_barrier(); asm volatile("" ::: "memory");
        const int row = wid * 32 + (lane & 31);
        if (lane < 32) { const float t = (P[row * 4 + 0] + P[row * 4 + 1]) + (P[row * 4 + 2] + P[row * 4 + 3]);
            __hip_atomic_store(xbuf + ((size_t)(u.pm * BM + row) * 4 + u.pn), t, __ATOMIC_RELAXED, __HIP_MEMORY_SCOPE_AGENT); }
        asm volatile("s_waitcnt vmcnt(0)" ::: "memory");
        if (lane == 0) __hip_atomic_fetch_add(cnt + 64 * u.pm, 1u, __ATOMIC_RELAXED, __HIP_MEMORY_SCOPE_AGENT);
        if (wid == 0) { unsigned sp = 0u;
            while ((unsigned)__builtin_amdgcn_readfirstlane(__hip_atomic_load(cnt + 64 * u.pm, __ATOMIC_RELAXED, __HIP_MEMORY_SCOPE_AGENT)) < 32u) { __builtin_amdgcn_s_sleep(1); if (++sp > (1u << 22)) break; }
            __builtin_amdgcn_fence(__ATOMIC_ACQUIRE, "agent"); }
        asm volatile("s_waitcnt vmcnt(0) lgkmcnt(0)" ::: "memory"); __builtin_amdgcn_s_barrier(); asm volatile("" ::: "memory");
        if (lane < 32) { const float* slot = xbuf + (size_t)(u.pm * BM + row) * 4; float tot = 0.f;
#pragma unroll
            for (int t = 0; t < 4; ++t) tot += __hip_atomic_load(slot + t, __ATOMIC_RELAXED, __HIP_MEMORY_SCOPE_AGENT);
            S[row] = __builtin_amdgcn_rsqf(tot * (1.f / 1024.f) + EPS); }
        asm volatile("s_waitcnt lgkmcnt(0)" ::: "memory"); __builtin_amdgcn_s_barrier(); asm volatile("" ::: "memory");
    }
};
template <bool FINAL> struct EpiResNorm {
    static constexpr bool PERM = false, AFTER_DRAIN = true;
    const float* base; float* out; bf16_t* xn; float wt; const float* gpost; const float* gnext; PanelSumSq st1, st2;
    __device__ __forceinline__ void operator()(const Acc&, const Unit&, int, int, int, int) const {}
    __device__ __forceinline__ void fused(Acc& acc, const Unit& u, int wr, int wc, int fr, int fq, LAS unsigned char* lds, int wid, int lane) const {
        const LAS float* S = (const LAS float*)(lds + 4096);
        const int col0 = u.pn * BM + wc * 32 + 4 * fq;
        st1.run(acc, u, wr, wc, fr, fq, lds, wid, lane);
#pragma unroll
        for (int ai = 0; ai < 2; ++ai)
#pragma unroll
            for (int m = 0; m < 4; ++m) { const int r = ai * HALF + wr * 64 + m * 16 + fr; const float sr = S[r] * wt; const size_t off = (size_t)(u.pm * BM + r) * 1024 + col0;
#pragma unroll
                for (int bj = 0; bj < 2; ++bj)
#pragma unroll
                    for (int n = 0; n < 2; ++n) { const f32x4 bs = *(const f32x4*)(base + off + bj * HALF + n * 16); const f32x4 g = *(const f32x4*)(gpost + col0 + bj * HALF + n * 16);
                        acc[ai][bj][m][n] = bs + acc[ai][bj][m][n] * g * sr; }
                asm volatile("" : "+v"(acc[ai][0][m][0]), "+v"(acc[ai][0][m][1]), "+v"(acc[ai][1][m][0]), "+v"(acc[ai][1][m][1]));
                if (m & 1) asm volatile("" ::: "memory"); }
        st2.run(acc, u, wr, wc, fr, fq, lds, wid, lane);
#pragma unroll
        for (int ai = 0; ai < 2; ++ai)
#pragma unroll
            for (int m = 0; m < 4; ++m) { const int r = ai * HALF + wr * 64 + m * 16 + fr; const float sr = S[r]; const size_t off = (size_t)(u.pm * BM + r) * 1024 + col0;
#pragma unroll
                for (int bj = 0; bj < 2; ++bj)
#pragma unroll
                    for (int n = 0; n < 2; ++n) { const f32x4 x1 = acc[ai][bj][m][n]; const f32x4 g = *(const f32x4*)(gnext + col0 + bj * HALF + n * 16); const f32x4 o = x1 * g * sr;
                        if (FINAL) *(f32x4*)(out + off + bj * HALF + n * 16) = o;
                        else { *(f32x4*)(out + off + bj * HALF + n * 16) = x1; u32x2 w; w.x = cvt_pk_bf16(o[0], o[1]); w.y = cvt_pk_bf16(o[2], o[3]); *(u32x2*)(xn + off + bj * HALF + n * 16) = w; } }
                asm volatile("" ::: "memory"); }
    }
};
}

namespace att {
constexpr int NW = 8, QBLK = 32, KVBLK = 64;
constexpr float SCALE = 0.07216878364870322f;
constexpr float THR = 8.f;
constexpr int LDQ = 1536, LDKV = 2048, LDKR = 64, LDO = 1024;
constexpr int SHM_V = 64 * 128 * 2, SHM_K = 64 * 128 * 2, SHM_R = 64 * 64 * 2;
constexpr int NQL = 4;
constexpr int OFF_V = 0, OFF_K = 2 * SHM_V, OFF_RP = OFF_K + 2 * SHM_K, OFF_WS = OFF_RP + 2 * SHM_R, OFF_QL = OFF_WS + NW * 64 * 4, SHM_ATTN = OFF_QL + NW * NQL * 1024;
static_assert(SHM_ATTN <= LDS_STAGE, "lds");
#define KSWZ(row, colB) ((row) * 256 + ((colB) ^ (((row) & 15) << 4)))
#define RSWZ(row, colB) ((row) * 128 + ((colB) ^ ((((row) >> 1) & 7) << 4)))
#define SBAR() __builtin_amdgcn_sched_barrier(0)
__device__ __forceinline__ int crow(int r, int hi) { return (r & 3) + 8 * (r >> 2) + 4 * hi; }
__device__ __forceinline__ bf16x8 ld8(const bf16_t* p) { return *reinterpret_cast<const bf16x8*>(p); }

__device__ __forceinline__ void partialSM(f32x16& p0, f32x16& p1, float& m_reg, float& mn, float& alpha) {
    constexpr float C = SCALE * 1.4426950408889634f;
    float pmax = p0[0];
#pragma unroll
    for (int r = 1; r < 16; ++r) pmax = fmaxf(pmax, p0[r]);
#pragma unroll
    for (int r = 0; r < 16; ++r) pmax = fmaxf(pmax, p1[r]);
    { auto rr = __builtin_amdgcn_permlane32_swap(__float_as_uint(pmax), __float_as_uint(pmax), false, false);
      pmax = fmaxf(__uint_as_float(rr[0]), __uint_as_float(rr[1])); }
    if (__builtin_expect(__all(pmax - m_reg <= THR / SCALE), 1)) { mn = m_reg; alpha = 1.f; }
    else { mn = fmaxf(m_reg, pmax); alpha = __builtin_amdgcn_exp2f((m_reg - mn) * C); m_reg = mn; }
    float mnC = -mn * C;
#pragma unroll
    for (int r = 0; r < 16; ++r) p0[r] = fmaf(p0[r], C, mnC);
#pragma unroll
    for (int r = 0; r < 16; ++r) p1[r] = fmaf(p1[r], C, mnC);
#pragma unroll
    for (int r = 0; r < 16; ++r) p0[r] = __builtin_amdgcn_exp2f(p0[r]);
}
__device__ __forceinline__ void finishSM(f32x16& p0, f32x16& p1, float alpha, float& l_reg, bf16x8& pa0, bf16x8& pa1, bf16x8& pa2, bf16x8& pa3) {
#pragma unroll
    for (int r = 0; r < 16; ++r) p1[r] = __builtin_amdgcn_exp2f(p1[r]);
    float ps = 0;
#pragma unroll
    for (int r = 0; r < 16; ++r) ps += p0[r];
#pragma unroll
    for (int r = 0; r < 16; ++r) ps += p1[r];
    { auto rr = __builtin_amdgcn_permlane32_swap(__float_as_uint(ps), __float_as_uint(ps), false, false);
      ps = __uint_as_float(rr[0]) + __uint_as_float(rr[1]); }
    l_reg = l_reg * alpha + ps;
#define PK4(P, BASE, OUT) do { unsigned a0 = cvt_pk_bf16(P[BASE + 0], P[BASE + 1]), a1 = cvt_pk_bf16(P[BASE + 2], P[BASE + 3]);   \
    unsigned b0 = cvt_pk_bf16(P[BASE + 4], P[BASE + 5]), b1 = cvt_pk_bf16(P[BASE + 6], P[BASE + 7]);                              \
    auto r0 = __builtin_amdgcn_permlane32_swap(a0, b0, false, false); auto r1 = __builtin_amdgcn_permlane32_swap(a1, b1, false, false); \
    u32x4 w = {r0[0], r1[0], r0[1], r1[1]}; OUT = *reinterpret_cast<bf16x8*>(&w); } while (0)
    PK4(p0, 0, pa0); PK4(p0, 8, pa1); PK4(p1, 0, pa2); PK4(p1, 8, pa3);
#undef PK4
}
__device__ __forceinline__ void qkt(f32x16& p0, f32x16& p1, const char* Ks, const char* Rs, const bf16x8* qr, const char* ql, int r32, int hi) {
    p0 = f32x16{}; p1 = f32x16{};
#pragma unroll
    for (int d0 = 0; d0 < 8; ++d0) { int cb = (d0 * 16 + hi * 8) * 2;
        bf16x8 b0 = *reinterpret_cast<const bf16x8*>(Ks + KSWZ(r32, cb));
        bf16x8 b1 = *reinterpret_cast<const bf16x8*>(Ks + KSWZ(32 + r32, cb));
        p0 = __builtin_amdgcn_mfma_f32_32x32x16_bf16(b0, qr[d0], p0, 0, 0, 0);
        p1 = __builtin_amdgcn_mfma_f32_32x32x16_bf16(b1, qr[d0], p1, 0, 0, 0); }
#pragma unroll
    for (int d0 = 0; d0 < 4; ++d0) { int cb = (d0 * 16 + hi * 8) * 2;
        bf16x8 b0 = *reinterpret_cast<const bf16x8*>(Rs + RSWZ(r32, cb));
        bf16x8 b1 = *reinterpret_cast<const bf16x8*>(Rs + RSWZ(32 + r32, cb));
        const bf16x8 qv = *reinterpret_cast<const bf16x8*>(ql + d0 * 1024);
        p0 = __builtin_amdgcn_mfma_f32_32x32x16_bf16(b0, qv, p0, 0, 0, 0);
        p1 = __builtin_amdgcn_mfma_f32_32x32x16_bf16(b1, qv, p1, 0, 0, 0); }
}
__device__ __forceinline__ int v_st(int k, int c) { const int kk = (k & ~0xC) | ((k & 4) << 1) | ((k & 8) >> 1); return ((kk >> 3) * 4 + (c >> 5)) * 512 + ((kk & 7) * 32 + (c & 31)) * 2; }
__device__ __forceinline__ int v_rd_base(int lane) { return ((lane & 3) << 3) | (((lane >> 2) & 3) << 6) | (((lane >> 4) & 1) << 5) | (((lane >> 5) & 1) << 8); }
constexpr int v_rd_off(int d0, int ks, int half) { return d0 * 512 + ks * 4096 + half * 2048; }
template <int OFF> __device__ __forceinline__ s16x4 tr_read(int vb) {
    s16x4 r; asm volatile("ds_read_b64_tr_b16 %0, %1 offset:%2" : "=&v"(r) : "v"(vb), "i"(OFF) : "memory"); return r;
}
template <int D0> __device__ __forceinline__ void pv_one(f32x16& od, int vb, bf16x8 pa0, bf16x8 pa1, bf16x8 pa2, bf16x8 pa3) {
    const s16x4 l0 = tr_read<v_rd_off(D0, 0, 0)>(vb), h0 = tr_read<v_rd_off(D0, 0, 1)>(vb), l1 = tr_read<v_rd_off(D0, 1, 0)>(vb), h1 = tr_read<v_rd_off(D0, 1, 1)>(vb);
    const s16x4 l2 = tr_read<v_rd_off(D0, 2, 0)>(vb), h2 = tr_read<v_rd_off(D0, 2, 1)>(vb), l3 = tr_read<v_rd_off(D0, 3, 0)>(vb), h3 = tr_read<v_rd_off(D0, 3, 1)>(vb);
    asm volatile("s_waitcnt lgkmcnt(0)" ::: "memory"); SBAR();
#define PK(L, H) (bf16x8){L[0], L[1], L[2], L[3], H[0], H[1], H[2], H[3]}
    od = __builtin_amdgcn_mfma_f32_32x32x16_bf16(pa0, PK(l0, h0), od, 0, 0, 0);
    od = __builtin_amdgcn_mfma_f32_32x32x16_bf16(pa1, PK(l1, h1), od, 0, 0, 0);
    od = __builtin_amdgcn_mfma_f32_32x32x16_bf16(pa2, PK(l2, h2), od, 0, 0, 0);
    od = __builtin_amdgcn_mfma_f32_32x32x16_bf16(pa3, PK(l3, h3), od, 0, 0, 0);
#undef PK
}
__device__ __forceinline__ void pv_d0(f32x16* o, int vb, bf16x8 pa0, bf16x8 pa1, bf16x8 pa2, bf16x8 pa3) {
    pv_one<0>(o[0], vb, pa0, pa1, pa2, pa3); pv_one<1>(o[1], vb, pa0, pa1, pa2, pa3); pv_one<2>(o[2], vb, pa0, pa1, pa2, pa3); pv_one<3>(o[3], vb, pa0, pa1, pa2, pa3);
}

__device__ __forceinline__ void attn_body(const bf16_t* __restrict__ Qb, const bf16_t* __restrict__ Kn, const bf16_t* __restrict__ Kr, const bf16_t* __restrict__ Vh,
                                          bf16_t* __restrict__ Ob, int seq, char* lds) {
    const int tid = fresh_tid(), wid = tid >> 6, lane = tid & 63, r32 = lane & 31, hi = lane >> 5;
    char* V_lds = lds + OFF_V; char* K_lds = lds + OFF_K; char* R_lds = lds + OFF_RP;
    float* ws = (float*)(lds + OFF_WS) + wid * 64; float* li_l = ws; float* al_l = ws + 32;
    float m_reg = -1e30f, l_reg = 0; f32x16 o[4] = {}; bf16x8 qr[8];
    char* ql = lds + OFF_QL + wid * (NQL * 1024) + lane * 16;
    const bf16_t* Qw = Qb + (long)(wid * QBLK + r32) * LDQ + hi * 8;
#pragma unroll
    for (int d0 = 0; d0 < 8; ++d0) qr[d0] = ld8(Qw + d0 * 16);
#pragma unroll
    for (int d0 = 0; d0 < NQL; ++d0) *reinterpret_cast<bf16x8*>(ql + d0 * 1024) = ld8(Qw + (8 + d0) * 16);
    const int sr = tid >> 4, sc = (tid & 15) * 8, vst0 = v_st(sr, sc), vst1 = v_st(32 + sr, sc);
    const int rr_ = tid >> 3, rc_ = (tid & 7) * 8;
    const int vb0 = (int)(uintptr_t)V_lds + v_rd_base(lane);
    bf16x8 vs0, vs1, ks0, ks1, rs0;
#define SLOAD(k0) do { vs0 = ld8(&Vh[(long)((k0) + sr) * LDKV + sc]); vs1 = ld8(&Vh[(long)((k0) + 32 + sr) * LDKV + sc]); \
    ks0 = ld8(&Kn[(long)((k0) + sr) * LDKV + sc]); ks1 = ld8(&Kn[(long)((k0) + 32 + sr) * LDKV + sc]); rs0 = ld8(&Kr[(long)((k0) + rr_) * LDKR + rc_]); } while (0)
#define SWRITE(b) do { *(bf16x8*)(V_lds + (b) * SHM_V + vst0) = vs0; *(bf16x8*)(V_lds + (b) * SHM_V + vst1) = vs1; int kc = sc * 2; \
    *(bf16x8*)(K_lds + (b) * SHM_K + KSWZ(sr, kc)) = ks0; *(bf16x8*)(K_lds + (b) * SHM_K + KSWZ(32 + sr, kc)) = ks1; \
    *(bf16x8*)(R_lds + (b) * SHM_R + RSWZ(rr_, rc_ * 2)) = rs0; } while (0)
#define RESC(a) do { if (__any((a) < 1.f)) { if (hi == 0) al_l[r32] = (a); asm volatile("s_waitcnt lgkmcnt(0)" ::: "memory"); \
    _Pragma("unroll") for (int d = 0; d < 4; ++d) _Pragma("unroll") for (int r = 0; r < 16; ++r) o[d][r] *= al_l[crow(r, hi)]; } } while (0)
    f32x16 pA0, pA1, pB0, pB1; float mnA, mnB, alA, alB; bf16x8 pa0, pa1, pa2, pa3; const int NT = seq / KVBLK;
    SLOAD(0); asm volatile("s_waitcnt vmcnt(0)" ::: "memory"); SWRITE(0); __syncthreads();
    qkt(pA0, pA1, K_lds, R_lds, qr, ql, r32, hi); partialSM(pA0, pA1, m_reg, mnA, alA);
    SLOAD(KVBLK);
    asm volatile("s_waitcnt vmcnt(0)" ::: "memory"); SWRITE(1); __syncthreads();
    for (int j = 1; j + 1 < NT; j += 2) {
        SBAR(); qkt(pB0, pB1, K_lds + SHM_K, R_lds + SHM_R, qr, ql, r32, hi);
        finishSM(pA0, pA1, alA, l_reg, pa0, pa1, pa2, pa3); SBAR();
        SLOAD((j + 1) * KVBLK); SBAR();
        pv_d0(o, vb0, pa0, pa1, pa2, pa3); partialSM(pB0, pB1, m_reg, mnB, alB);
        __syncthreads(); asm volatile("s_waitcnt vmcnt(0)" ::: "memory"); SWRITE(0);
        RESC(alB); __syncthreads();
        SBAR(); qkt(pA0, pA1, K_lds, R_lds, qr, ql, r32, hi);
        finishSM(pB0, pB1, alB, l_reg, pa0, pa1, pa2, pa3); SBAR();
        SLOAD((j + 2) * KVBLK); SBAR();
        pv_d0(o, vb0 + SHM_V, pa0, pa1, pa2, pa3); partialSM(pA0, pA1, m_reg, mnA, alA);
        __syncthreads(); asm volatile("s_waitcnt vmcnt(0)" ::: "memory"); SWRITE(1);
        RESC(alA); __syncthreads();
    }
    SBAR(); qkt(pB0, pB1, K_lds + SHM_K, R_lds + SHM_R, qr, ql, r32, hi);
    finishSM(pA0, pA1, alA, l_reg, pa0, pa1, pa2, pa3); SBAR();
    pv_d0(o, vb0, pa0, pa1, pa2, pa3); partialSM(pB0, pB1, m_reg, mnB, alB);
    __syncthreads(); RESC(alB);
    finishSM(pB0, pB1, alB, l_reg, pa0, pa1, pa2, pa3); SBAR();
    pv_d0(o, vb0 + SHM_V, pa0, pa1, pa2, pa3);
    if (hi == 0) li_l[r32] = l_reg; asm volatile("s_waitcnt lgkmcnt(0)" ::: "memory");
    float rli[16];
#pragma unroll
    for (int r = 0; r < 16; ++r) rli[r] = __builtin_amdgcn_rcpf(li_l[crow(r, hi)]);
    bf16_t* Ow = Ob + (long)(wid * QBLK) * LDO;
#pragma unroll
    for (int r = 0; r < 16; ++r) { int orow = crow(r, hi);
#pragma unroll
        for (int d0 = 0; d0 < 4; ++d0) { const float v = o[d0][r] * rli[r]; Ow[(long)orow * LDO + d0 * 32 + r32] = (bf16_t)(cvt_pk_bf16(v, v) & 0xffffu); } }
#undef SLOAD
#undef SWRITE
#undef RESC
}
}


#define XB_TMO      128
#define XB_XCNT(j)  (256  + 64 * (j))
#define XB_XSUB(j)  (1280 + 64 * (j))
#define XB_XGEN(j)  (2304 + 64 * (j))
#define XB_TOP      3328
#define XB_TOPGEN   3392
#define XCD_BAR_WORDS 3456
#define XB_SPIN_CAP (1u << 18)
__device__ __forceinline__ unsigned xb_ld(unsigned* p)              { return __hip_atomic_load(p, __ATOMIC_RELAXED, __HIP_MEMORY_SCOPE_AGENT); }
__device__ __forceinline__ unsigned xb_add(unsigned* p, unsigned v) { return __hip_atomic_fetch_add(p, v, __ATOMIC_RELAXED, __HIP_MEMORY_SCOPE_AGENT); }
__device__ __forceinline__ unsigned xb_xcc_id() { return (unsigned)__builtin_amdgcn_s_getreg((3 << 11) | 20) & 0xFu; }
#define XB_SPIN(cond, bar) do { unsigned _sp = 0; while (cond) { __builtin_amdgcn_s_sleep(1); \
    if ((++_sp & 255u) == 0u) { if (xb_ld(&(bar)[XB_TMO])) break; if (_sp > XB_SPIN_CAP) { atomicAdd(&(bar)[XB_TMO], 1u); break; } } } } while (0)
struct XcdBarrier { unsigned* bar; unsigned x; volatile LAS unsigned* st; };
__device__ __forceinline__ XcdBarrier xcd_barrier_post(unsigned* bar, volatile LAS unsigned* st) {
    XcdBarrier b; b.bar = bar; b.x = xb_xcc_id(); b.st = st;
    if (threadIdx.x == 0) (void)xb_add(&bar[XB_XCNT(b.x)], 1u);
    return b;
}
__device__ __forceinline__ void xcd_barrier_complete(unsigned* bar, unsigned x, unsigned& nloc, unsigned& nx) {
    const unsigned G = gridDim.x * gridDim.y * gridDim.z;
    unsigned sum, cnt, mine, sp = 0u;
    for (;;) {
        sum = 0u; cnt = 0u; mine = 0u;
#pragma unroll
        for (unsigned j = 0; j < 16; ++j) { const unsigned c = xb_ld(&bar[XB_XCNT(j)]); sum += c; cnt += (c > 0u) ? 1u : 0u; mine = (j == x) ? c : mine; }
        if (sum == G) break;
        __builtin_amdgcn_s_sleep(1);
        if ((++sp & 255u) == 0u) { if (xb_ld(&bar[XB_TMO])) break; if (sp > XB_SPIN_CAP) { atomicAdd(&bar[XB_TMO], 1u); break; } }
    }
    nloc = mine > 0u ? mine : 1u; nx = cnt > 0u ? cnt : 1u;
}
__device__ __forceinline__ void xcd_barrier(const XcdBarrier& b) {
    asm volatile("s_waitcnt vmcnt(0)" ::: "memory");
    __syncthreads();
    if (threadIdx.x == 0) {
        unsigned* bar = b.bar;
        __builtin_amdgcn_s_waitcnt(0);
        unsigned nloc = b.st[0], nx = b.st[1];
        if (nloc == 0u) { xcd_barrier_complete(bar, b.x, nloc, nx); b.st[0] = nloc; b.st[1] = nx; }
        const unsigned old = xb_add(&bar[XB_XSUB(b.x)], 1u);
        const unsigned gen = old / nloc;
        if (old + 1u == (gen + 1u) * nloc) {
            __builtin_amdgcn_fence(__ATOMIC_RELEASE, "agent");
            asm volatile("s_waitcnt vmcnt(0)" ::: "memory");
            const unsigned og = xb_add(&bar[XB_TOP], 1u);
            const unsigned tg = og / nx;
            if (og + 1u == (tg + 1u) * nx) xb_add(&bar[XB_TOPGEN], 1u);
            else XB_SPIN(xb_ld(&bar[XB_TOPGEN]) == tg, bar);
            __builtin_amdgcn_fence(__ATOMIC_ACQUIRE, "agent");
            xb_add(&bar[XB_XGEN(b.x)], 1u);
            asm volatile("s_waitcnt vmcnt(0)" ::: "memory");
        } else {
            XB_SPIN(xb_ld(&bar[XB_XGEN(b.x)]) == gen, bar);
            __builtin_amdgcn_fence(__ATOMIC_ACQUIRE, "agent");
            asm volatile("s_waitcnt vmcnt(0)" ::: "memory");
        }
    }
    __syncthreads();
}

enum { TR_PLAIN = 0, TR_GU = 1, TR_WIN = 2, TR_UQ = 3, TR_UKV = 4 };
template <int MODE>
__device__ __forceinline__ void tr_job(const float* W0, const float* W1, int K, int Nsrc, int Nout, bf16_t* WT, LAS float* scr, int lane, int gw, int NGW) {
    const int nblk = Nout / 32, nitems = (K / 64) * nblk;
    for (int it = gw; it < nitems; it += NGW) {
        const int kb = it / nblk, nb = it % nblk, k0 = 64 * kb, n0 = 32 * nb, np = n0 + (lane & 31);
        const float* colp;
        if (MODE == TR_PLAIN) colp = W0 + np;
        else if (MODE == TR_GU) { const int t = np >> 8, w = np & 255; colp = (w < 128 ? W0 : W1) + t * 128 + (w & 127); }
        else if (MODE == TR_WIN) colp = np < 1216 ? W0 + np : (np < 1280 ? nullptr : W0 + (np - 64));
        else if (MODE == TR_UQ) { const int h = np / 192, w = np % 192; colp = W0 + (w < 128 ? np : h * 192 + 128 + ((w - 128) >> 1) + ((w - 128) & 1) * 32); }
        else colp = np < 1024 ? W0 + np : W1 + (np - 1024);
        float tv[32];
#pragma unroll
        for (int i = 0; i < 32; ++i) { const int kk = 2 * i + (lane >> 5); tv[i] = colp ? colp[(size_t)(k0 + kk) * Nsrc] : 0.f; }
#pragma unroll
        for (int i = 0; i < 32; ++i) { const int kk = 2 * i + (lane >> 5); scr[kk * 33 + (lane & 31)] = tv[i]; }
        asm volatile("s_waitcnt lgkmcnt(0)" ::: "memory");
        const int c = lane & 7;
#pragma unroll
        for (int j = 0; j < 4; ++j) { const int n = (lane >> 3) + 8 * j; const LAS float* s = scr + (8 * c) * 33 + n;
            u32x4 o; o.x = cvt_pk_bf16(s[0 * 33], s[1 * 33]); o.y = cvt_pk_bf16(s[2 * 33], s[3 * 33]); o.z = cvt_pk_bf16(s[4 * 33], s[5 * 33]); o.w = cvt_pk_bf16(s[6 * 33], s[7 * 33]);
            *(u32x4*)(WT + (size_t)(n0 + n) * K + k0 + 8 * c) = o; }
        asm volatile("s_waitcnt lgkmcnt(0)" ::: "memory");
    }
}

template <int MODE>
__device__ __forceinline__ void rows_phase(const float* xin, const bf16_t* f, float wt, const float* gpost, const float* gnext, float* xout, bf16_t* xn, int gw, int NGW, int lane) {
    for (int row0 = gw; row0 < M; row0 += 2 * NGW) {
        f32x4 xv[2][4]; u32x2 fw[2][4];
#pragma unroll
        for (int r = 0; r < 2; ++r) { const size_t row = (size_t)(row0 + r * NGW);
#pragma unroll
            for (int j = 0; j < 4; ++j) { xv[r][j] = *(const f32x4*)(xin + row * DM + 4 * (lane + 64 * j));
                if (MODE != 0) fw[r][j] = *(const u32x2*)(f + row * DM + 4 * (lane + 64 * j)); } }
#pragma unroll
        for (int r = 0; r < 2; ++r) { const size_t row = (size_t)(row0 + r * NGW);
            if (MODE != 0) {
                f32x4 fv[4]; float ss = 0.f;
#pragma unroll
                for (int j = 0; j < 4; ++j) { fv[j] = (f32x4){bf_lo(fw[r][j].x), bf_hi(fw[r][j].x), bf_lo(fw[r][j].y), bf_hi(fw[r][j].y)}; ss += fv[j].x * fv[j].x + fv[j].y * fv[j].y + fv[j].z * fv[j].z + fv[j].w * fv[j].w; }
                const float rr = wt * __builtin_amdgcn_rsqf(wave_sum(ss) * (1.f / DM) + EPS);
#pragma unroll
                for (int j = 0; j < 4; ++j) { const f32x4 g = *(const f32x4*)(gpost + 4 * (lane + 64 * j)); xv[r][j] = xv[r][j] + fv[j] * g * rr; }
                if (MODE == 1) {
#pragma unroll
                    for (int j = 0; j < 4; ++j) *(f32x4*)(xout + row * DM + 4 * (lane + 64 * j)) = xv[r][j];
                }
            }
            float s2 = 0.f;
#pragma unroll
            for (int j = 0; j < 4; ++j) s2 += xv[r][j].x * xv[r][j].x + xv[r][j].y * xv[r][j].y + xv[r][j].z * xv[r][j].z + xv[r][j].w * xv[r][j].w;
            const float r2 = __builtin_amdgcn_rsqf(wave_sum(s2) * (1.f / DM) + EPS);
#pragma unroll
            for (int j = 0; j < 4; ++j) { const f32x4 g = *(const f32x4*)(gnext + 4 * (lane + 64 * j)); const f32x4 y = xv[r][j] * g * r2;
                if (MODE == 2) *(f32x4*)(xout + row * DM + 4 * (lane + 64 * j)) = y;
                else { u32x2 w; w.x = cvt_pk_bf16(y.x, y.y); w.y = cvt_pk_bf16(y.z, y.w); *(u32x2*)(xn + row * DM + 4 * (lane + 64 * j)) = w; } }
        }
    }
}

__global__ void __launch_bounds__(NTHREADS, 2) fwd_megakernel(Params p) {
    extern __shared__ __attribute__((aligned(16))) unsigned char lds[];
    cg::grid_group grid = cg::this_grid();
    volatile LAS unsigned* bst = (volatile LAS unsigned*)((LAS unsigned char*)lds + LDS_STAGE);
    if (threadIdx.x < 2) bst[threadIdx.x] = 0u;
    __syncthreads();
    const XcdBarrier xbar = xcd_barrier_post((unsigned*)(p.ws + OFF_BAR), bst);
#define GRID_SYNC_CG() do { __builtin_amdgcn_fence(__ATOMIC_RELEASE, "agent"); asm volatile("s_waitcnt vmcnt(0)" ::: "memory"); grid.sync(); \
        __builtin_amdgcn_fence(__ATOMIC_ACQUIRE, "agent"); asm volatile("s_waitcnt vmcnt(0)" ::: "memory"); } while (0)
#define GRID_SYNC() xcd_barrier(xbar)
    const int G = gridDim.x, bid = blockIdx.x, NGW = G * NWAVES;
    LAS unsigned char* ldsl = (LAS unsigned char*)lds;
#define PHASE_IDS() const int tid = fresh_tid(), lane = tid & 63, wave = tid >> 6, gw = bid * NWAVES + wave; LAS float* scr = (LAS float*)(ldsl + wave * 8448); (void)scr; (void)gw; (void)lane
    unsigned char* ws = p.ws;
    bf16_t* Wgu = (bf16_t*)(ws + OFF_WGU); bf16_t* Wd = (bf16_t*)(ws + OFF_WD); bf16_t* Win = (bf16_t*)(ws + OFF_WIN); bf16_t* Wuq = (bf16_t*)(ws + OFF_WUQ);
    bf16_t* Wukv = (bf16_t*)(ws + OFF_WUKV); bf16_t* Woa = (bf16_t*)(ws + OFF_WOA); bf16_t* Wp = (bf16_t*)(ws + OFF_WP); bf16_t* Wout = (bf16_t*)(ws + OFF_WOUT);
    bf16_t* XN = (bf16_t*)(ws + OFF_XN); bf16_t* F = (bf16_t*)(ws + OFF_F); float* ZF = (float*)(ws + OFF_ZF); bf16_t* KV = (bf16_t*)(ws + OFF_KV);
    bf16_t* H = (bf16_t*)(ws + OFF_H); bf16_t* O = (bf16_t*)(ws + OFF_O); bf16_t* CQN = (bf16_t*)(ws + OFF_CQN); bf16_t* CKVN = (bf16_t*)(ws + OFF_CKVN);
    float* TAB = (float*)(ws + OFF_TAB); bf16_t* Q = (bf16_t*)(ws + OFF_Q); bf16_t* KR = (bf16_t*)(ws + OFF_KR); bf16_t* Gt = (bf16_t*)(ws + OFF_G); bf16_t* DP = (bf16_t*)(ws + OFF_DP);
    float* X = p.out;
    float* xbuf0 = (float*)(ws + OFF_XBUF); unsigned* cnt0 = (unsigned*)(ws + OFF_CNT);

    { PHASE_IDS();
    tr_job<TR_GU>(p.f1_wg, p.f1_wu, 1024, DFF, 5632, Wgu, scr, lane, gw, NGW);
    tr_job<TR_PLAIN>(p.f1_wd, nullptr, DFF, 1024, 1024, Wd, scr, lane, gw, NGW);
    rows_phase<0>(p.x, nullptr, 0.f, nullptr, p.f1_pre, nullptr, XN, gw, NGW, lane); }
    if (__builtin_expect(p.out == nullptr, 0)) GRID_SYNC_CG();
    GRID_SYNC();

    pg8::StaticOrder S;
    { pg8::Gemm g{XN, Wgu, M, 5632, 1024}; S.init(M, 5632, G, bid); pg8::EpiSwiGLU E{H}; pg8::gemm_phase(ldsl, g, S, E); }
    {
        const int tail0 = (64 * 22) % G;
        if (tail0 != 0 && bid >= tail0) { PHASE_IDS(); const int tb = bid - tail0, nb = G - tail0, tgw = tb * NWAVES + wave, TNGW = nb * NWAVES;
            tr_job<TR_WIN>(p.w_in, nullptr, 1024, INW, 3328, Win, scr, lane, tgw, TNGW);
            tr_job<TR_UQ>(p.w_uq, nullptr, QL, 1536, 1536, Wuq, scr, lane, tgw, TNGW);
            tr_job<TR_UKV>(p.w_uk, p.w_uv, KVL, 1024, 2048, Wukv, scr, lane, tgw, TNGW);
    }
        else if (tail0 == 0) { PHASE_IDS(); const int tb = bid, nb = G;
            tr_job<TR_WIN>(p.w_in, nullptr, 1024, INW, 3328, Win, scr, lane, gw, NGW);
            tr_job<TR_UQ>(p.w_uq, nullptr, QL, 1536, 1536, Wuq, scr, lane, gw, NGW);
            tr_job<TR_UKV>(p.w_uk, p.w_uv, KVL, 1024, 2048, Wukv, scr, lane, gw, NGW);
    }
    }
    GRID_SYNC();
    { pg8::Gemm g{H, Wd, M, 1024, DFF}; S.init(M, 1024, G, bid);
      pg8::EpiResNorm<false> E{p.x, X, XN, 0.5f, p.f1_post, p.mix_pre, pg8::PanelSumSq{xbuf0, cnt0}, pg8::PanelSumSq{xbuf0 + (size_t)M * 4, cnt0 + 4096}}; pg8::gemm_phase(ldsl, g, S, E); }
    GRID_SYNC();
    { pg8::Gemm g{XN, Win, M, 1280, 1024}; S.init(M, 1280, G, bid); pg8::EpiBf16 E{(bf16_t*)ZF, 1280}; pg8::gemm_phase(ldsl, g, S, E); }
    {
        const int tail0 = (64 * 5) % G; PHASE_IDS();
        if (tail0 != 0 && bid >= tail0) { const int tgw = (bid - tail0) * NWAVES + wave, TNGW = (G - tail0) * NWAVES;
            tr_job<TR_GU>(p.f2_wg, p.f2_wu, 1024, DFF, 5632, Wgu, scr, lane, tgw, TNGW);
            tr_job<TR_PLAIN>(p.f2_wd, nullptr, DFF, 1024, 1024, Wd, scr, lane, tgw, TNGW); }
        else if (tail0 == 0) { tr_job<TR_GU>(p.f2_wg, p.f2_wu, 1024, DFF, 5632, Wgu, scr, lane, gw, NGW); tr_job<TR_PLAIN>(p.f2_wd, nullptr, DFF, 1024, 1024, Wd, scr, lane, gw, NGW); }
    }
    GRID_SYNC();
    { PHASE_IDS();
    const bf16_t* ZB = (const bf16_t*)ZF;
    const int t_g = lane >> 4, wnd = 2 << t_g;
    for (int k = 0; k < M / (NWAVES * 256); ++k) { const int row = gw * (M / (NWAVES * 256)) + k;
        const bf16_t* z = ZB + (size_t)row * 1280;
        const u32x4 qa = *(const u32x4*)(z + 8 * lane);
        u32x4 qb = (u32x4){0u, 0u, 0u, 0u}; if (lane < 16) qb = *(const u32x4*)(z + 512 + 8 * lane);
        const u32x4 pc = *(const u32x4*)(z + 704 + 8 * lane);
        float kx1 = 0.f, kx2 = 0.f; int pos = 0;
        if (lane < 32) { kx1 = bf_lo((unsigned)z[640 + lane]); kx2 = bf_lo((unsigned)z[672 + lane]); pos = p.pos[row]; }
        const int t = row & (SEQ - 1), lo = max(t - (wnd >> 1), 0), hi = min(t + wnd - (wnd >> 1), SEQ);
        float sacc[8];
#pragma unroll
        for (int i = 0; i < 8; ++i) sacc[i] = 0.f;
#pragma unroll
        for (int hb = 0; hb < 2; ++hb) { u32x4 nb[8]; float wv[8];
#pragma unroll
            for (int d = 0; d < 8; ++d) { const int tt = t - 8 + hb * 8 + d; const bool ok = (tt >= lo) && (tt < hi); wv[d] = ok ? 1.f : 0.f;
                nb[d] = *(const u32x4*)(z + 704 + 8 * lane + (long)(ok ? (tt - t) : 0) * 1280); }
#pragma unroll
            for (int d = 0; d < 8; ++d) { sacc[0] = fmaf(wv[d], bf_lo(nb[d].x), sacc[0]); sacc[1] = fmaf(wv[d], bf_hi(nb[d].x), sacc[1]); sacc[2] = fmaf(wv[d], bf_lo(nb[d].y), sacc[2]); sacc[3] = fmaf(wv[d], bf_hi(nb[d].y), sacc[3]);
                sacc[4] = fmaf(wv[d], bf_lo(nb[d].z), sacc[4]); sacc[5] = fmaf(wv[d], bf_hi(nb[d].z), sacc[5]); sacc[6] = fmaf(wv[d], bf_lo(nb[d].w), sacc[6]); sacc[7] = fmaf(wv[d], bf_hi(nb[d].w), sacc[7]); } }
        {
            const float inv = 1.f / (float)(hi - lo);
            u32x4 w; w.x = cvt_pk_bf16(sacc[0] * inv - bf_lo(pc.x), sacc[1] * inv - bf_hi(pc.x)); w.y = cvt_pk_bf16(sacc[2] * inv - bf_lo(pc.y), sacc[3] * inv - bf_hi(pc.y));
            w.z = cvt_pk_bf16(sacc[4] * inv - bf_lo(pc.z), sacc[5] * inv - bf_hi(pc.z)); w.w = cvt_pk_bf16(sacc[6] * inv - bf_lo(pc.w), sacc[7] * inv - bf_hi(pc.w));
            *(u32x4*)(DP + (size_t)row * 512 + 8 * lane) = w; }
        {
            float va[8] = {bf_lo(qa.x), bf_hi(qa.x), bf_lo(qa.y), bf_hi(qa.y), bf_lo(qa.z), bf_hi(qa.z), bf_lo(qa.w), bf_hi(qa.w)};
            float vb[8] = {bf_lo(qb.x), bf_hi(qb.x), bf_lo(qb.y), bf_hi(qb.y), bf_lo(qb.z), bf_hi(qb.z), bf_lo(qb.w), bf_hi(qb.w)};
            float sa = 0.f, sb = 0.f;
#pragma unroll
            for (int i = 0; i < 8; ++i) { sa = fmaf(va[i], va[i], sa); sb = fmaf(vb[i], vb[i], sb); }
            const float ssq = wave_sum(lane < 48 ? sa : 0.f), sskv = wave_sum((lane >= 48 ? sa : 0.f) + sb);
            const float rq = __builtin_amdgcn_rsqf(ssq * (1.f / QL) + EPS), rkv = __builtin_amdgcn_rsqf(sskv * (1.f / KVL) + EPS);
            const float* ga = lane < 48 ? p.qa_g + 8 * lane : p.kva_g + 8 * (lane - 48); const float ra = lane < 48 ? rq : rkv;
            const f32x4 g0 = *(const f32x4*)ga, g1 = *(const f32x4*)(ga + 4);
            u32x4 w; w.x = cvt_pk_bf16(va[0] * g0.x * ra, va[1] * g0.y * ra); w.y = cvt_pk_bf16(va[2] * g0.z * ra, va[3] * g0.w * ra); w.z = cvt_pk_bf16(va[4] * g1.x * ra, va[5] * g1.y * ra); w.w = cvt_pk_bf16(va[6] * g1.z * ra, va[7] * g1.w * ra);
            bf16_t* dst = lane < 48 ? CQN + (size_t)row * QL + 8 * lane : CKVN + (size_t)row * KVL + 8 * (lane - 48);
            *(u32x4*)dst = w;
            if (lane < 16) { const f32x4 h0 = *(const f32x4*)(p.kva_g + 128 + 8 * lane), h1 = *(const f32x4*)(p.kva_g + 132 + 8 * lane);
                u32x4 w2; w2.x = cvt_pk_bf16(vb[0] * h0.x * rkv, vb[1] * h0.y * rkv); w2.y = cvt_pk_bf16(vb[2] * h0.z * rkv, vb[3] * h0.w * rkv); w2.z = cvt_pk_bf16(vb[4] * h1.x * rkv, vb[5] * h1.y * rkv); w2.w = cvt_pk_bf16(vb[6] * h1.z * rkv, vb[7] * h1.w * rkv);
                *(u32x4*)(CKVN + (size_t)row * KVL + 128 + 8 * lane) = w2; }
        }
        if (lane < 32) {
            const float ang = (float)pos * p.inv_freq[lane];
            const double ad = (double)ang; const double kq = rint(ad * 0.15915494309189535); const float red = (float)(ad - kq * 6.283185307179586);
            const float cs = __cosf(red), sn = __sinf(red);
            TAB[(size_t)row * 64 + lane] = cs; TAB[(size_t)row * 64 + 32 + lane] = sn;
            *(unsigned*)(KR + (size_t)row * 64 + 2 * lane) = cvt_pk_bf16(kx1 * cs - kx2 * sn, kx2 * cs + kx1 * sn);
        }
    } }
    GRID_SYNC();
    { pg8::Gemm g{CQN, Wuq, M, 1536, QL}; S.init(M, 1536, G, bid); pg8::EpiQ E{Q, TAB}; pg8::gemm_phase(ldsl, g, S, E); }
    {
        const int tail0 = (64 * 6) % G;
        if (tail0 != 0 && bid >= tail0) { PHASE_IDS(); const int tb = bid - tail0, nb = G - tail0, tgw = tb * NWAVES + wave, TNGW = nb * NWAVES;
            tr_job<TR_PLAIN>(p.w_oa, nullptr, 1024, 1024, 1024, Woa, scr, lane, tgw, TNGW);
            tr_job<TR_PLAIN>(p.w_out, nullptr, 1024, 1024, 1024, Wout, scr, lane, tgw, TNGW);
    for (int idx = tb * NTHREADS + tid; idx < 65536; idx += nb * NTHREADS) {
            const int n = idx & 1023, c8 = idx >> 10, g = c8 >> 4, cb = (c8 & 15) * 8;
            float a[8];
    #pragma unroll
            for (int i = 0; i < 8; ++i) a[i] = 0.f;
            for (int j0 = 0; j0 < 128; j0 += 8) { float w[8]; f32x4 pw[8][2];
    #pragma unroll
                for (int jj = 0; jj < 8; ++jj) w[jj] = p.w_op[(size_t)(g * 128 + j0 + jj) * 1024 + n] * p.pool_scale[g * 128 + j0 + jj];
    #pragma unroll
                for (int i = 0; i < 8; ++i) { pw[i][0] = *(const f32x4*)(p.pool_w + (size_t)(g * 128 + cb + i) * 128 + j0); pw[i][1] = *(const f32x4*)(p.pool_w + (size_t)(g * 128 + cb + i) * 128 + j0 + 4); }
    #pragma unroll
                for (int i = 0; i < 8; ++i)
    #pragma unroll
                    for (int jj = 0; jj < 8; ++jj) a[i] = fmaf(pw[i][jj >> 2][jj & 3], w[jj], a[i]); }
            u32x4 o; o.x = cvt_pk_bf16(a[0], a[1]); o.y = cvt_pk_bf16(a[2], a[3]); o.z = cvt_pk_bf16(a[4], a[5]); o.w = cvt_pk_bf16(a[6], a[7]);
            *(u32x4*)(Wp + (size_t)n * 512 + c8 * 8) = o;
        }
        }
        else if (tail0 == 0) { PHASE_IDS(); const int tb = bid, nb = G;
            tr_job<TR_PLAIN>(p.w_oa, nullptr, 1024, 1024, 1024, Woa, scr, lane, gw, NGW);
            tr_job<TR_PLAIN>(p.w_out, nullptr, 1024, 1024, 1024, Wout, scr, lane, gw, NGW);
    for (int idx = tb * NTHREADS + tid; idx < 65536; idx += nb * NTHREADS) {
            const int n = idx & 1023, c8 = idx >> 10, g = c8 >> 4, cb = (c8 & 15) * 8;
            float a[8];
    #pragma unroll
            for (int i = 0; i < 8; ++i) a[i] = 0.f;
            for (int j0 = 0; j0 < 128; j0 += 8) { float w[8]; f32x4 pw[8][2];
    #pragma unroll
                for (int jj = 0; jj < 8; ++jj) w[jj] = p.w_op[(size_t)(g * 128 + j0 + jj) * 1024 + n] * p.pool_scale[g * 128 + j0 + jj];
    #pragma unroll
                for (int i = 0; i < 8; ++i) { pw[i][0] = *(const f32x4*)(p.pool_w + (size_t)(g * 128 + cb + i) * 128 + j0); pw[i][1] = *(const f32x4*)(p.pool_w + (size_t)(g * 128 + cb + i) * 128 + j0 + 4); }
    #pragma unroll
                for (int i = 0; i < 8; ++i)
    #pragma unroll
                    for (int jj = 0; jj < 8; ++jj) a[i] = fmaf(pw[i][jj >> 2][jj & 3], w[jj], a[i]); }
            u32x4 o; o.x = cvt_pk_bf16(a[0], a[1]); o.y = cvt_pk_bf16(a[2], a[3]); o.z = cvt_pk_bf16(a[4], a[5]); o.w = cvt_pk_bf16(a[6], a[7]);
            *(u32x4*)(Wp + (size_t)n * 512 + c8 * 8) = o;
        }
        }
    }
    { pg8::Gemm g{CKVN, Wukv, M, 2048, KVL}; S.init(M, 2048, G, bid); pg8::EpiBf16 E{KV, 2048}; pg8::gemm_phase(ldsl, g, S, E); }
    GRID_SYNC();
    {
        const int vcu = (bid & 7) * (G >> 3) + (bid >> 3);
        for (int it = vcu; it < NB * NH * (SEQ / 256); it += G) {
            const int qb = it & 7, h = (it >> 3) & 7, b = it >> 6;
            const size_t tok0 = (size_t)b * SEQ;
            att::attn_body(Q + (tok0 + qb * 256) * 1536 + h * 192, KV + tok0 * 2048 + h * 128, KR + tok0 * 64, KV + tok0 * 2048 + 1024 + h * 128,
                           O + (tok0 + qb * 256) * 1024 + h * 128, SEQ, (char*)lds);
            __syncthreads();
        }
    }
    GRID_SYNC();
    { pg8::Gemm g{XN, Win + (size_t)1280 * 1024, M, 2048, 1024}; pg8::GateOrder GO; GO.s.init(M, 1024, G, bid); pg8::EpiGate E{Gt}; pg8::gemm_phase(ldsl, g, GO, E); }
    { pg8::Gemm g{O, Woa, M, 1024, 1024}; S.init(M, 1024, G, bid); pg8::EpiT1 E{Gt, F}; pg8::gemm_phase(ldsl, g, S, E); }
    { pg8::Gemm g{DP, Wp, M, 1024, 512}; S.init(M, 1024, G, bid); pg8::EpiMX E{Gt, F, XN}; pg8::gemm_phase(ldsl, g, S, E); }
    GRID_SYNC();
    { pg8::Gemm g{XN, Wout, M, 1024, 1024}; S.init(M, 1024, G, bid);
      pg8::EpiResNorm<false> E{X, X, XN, 1.0f, p.mix_post, p.f2_pre, pg8::PanelSumSq{xbuf0 + (size_t)M * 8, cnt0 + 2 * 4096}, pg8::PanelSumSq{xbuf0 + (size_t)M * 12, cnt0 + 3 * 4096}}; pg8::gemm_phase(ldsl, g, S, E); }
    GRID_SYNC();
    { pg8::Gemm g{XN, Wgu, M, 5632, 1024}; S.init(M, 5632, G, bid); pg8::EpiSwiGLU E{H}; pg8::gemm_phase(ldsl, g, S, E); }
    GRID_SYNC();
    { pg8::Gemm g{H, Wd, M, 1024, DFF}; S.init(M, 1024, G, bid);
      pg8::EpiResNorm<true> E{X, X, nullptr, 0.5f, p.f2_post, p.final_g, pg8::PanelSumSq{xbuf0 + (size_t)M * 16, cnt0 + 4 * 4096}, pg8::PanelSumSq{xbuf0 + (size_t)M * 20, cnt0 + 5 * 4096}}; pg8::gemm_phase(ldsl, g, S, E); }
}

extern "C" void kernel_launch(void* const* d_in, const int* in_sizes, int n_in, void* d_out, int out_size, void* d_ws, size_t ws_size, hipStream_t stream) {
    static int grid_blocks = 0;
    if (grid_blocks == 0) {
        if (n_in != 26 || in_sizes[0] != M * DM || out_size != M * DM || ws_size < WS_END) { fprintf(stderr, "kernel_launch: shape mismatch n_in %d in0 %d out %d ws %zu\n", n_in, n_in > 0 ? in_sizes[0] : -1, out_size, ws_size); grid_blocks = -1; return; }
        int dev = 0, cus = 0, per_cu = 0;
        (void)hipGetDevice(&dev);
        (void)hipDeviceGetAttribute(&cus, hipDeviceAttributeMultiprocessorCount, dev);
        if (hipFuncSetAttribute((const void*)fwd_megakernel, hipFuncAttributeMaxDynamicSharedMemorySize, LDS_BYTES) != hipSuccess) { fprintf(stderr, "kernel_launch: hipFuncSetAttribute failed\n"); grid_blocks = -1; return; }
        if (hipOccupancyMaxActiveBlocksPerMultiprocessor(&per_cu, (const void*)fwd_megakernel, NTHREADS, LDS_BYTES) != hipSuccess || per_cu < 1) { fprintf(stderr, "kernel_launch: occupancy query failed (%d)\n", per_cu); (void)hipGetLastError(); per_cu = 1; }
        grid_blocks = cus * 1;
        if (grid_blocks != 256) { fprintf(stderr, "kernel_launch: built for 256 CUs (one workgroup each), device has %d\n", cus); grid_blocks = -1; return; }
    }
    if (grid_blocks < 0) return;
    Params p{};
    p.x = (const float*)d_in[0]; p.pos = (const int*)d_in[1];
    p.f1_pre = (const float*)d_in[2]; p.f1_wg = (const float*)d_in[3]; p.f1_wu = (const float*)d_in[4]; p.f1_wd = (const float*)d_in[5]; p.f1_post = (const float*)d_in[6];
    p.mix_pre = (const float*)d_in[7]; p.w_in = (const float*)d_in[8]; p.qa_g = (const float*)d_in[9]; p.w_uq = (const float*)d_in[10]; p.kva_g = (const float*)d_in[11];
    p.w_uk = (const float*)d_in[12]; p.w_uv = (const float*)d_in[13]; p.w_oa = (const float*)d_in[14]; p.pool_w = (const float*)d_in[15]; p.pool_scale = (const float*)d_in[16];
    p.w_op = (const float*)d_in[17]; p.w_out = (const float*)d_in[18]; p.mix_post = (const float*)d_in[19];
    p.f2_pre = (const float*)d_in[20]; p.f2_wg = (const float*)d_in[21]; p.f2_wu = (const float*)d_in[22]; p.f2_wd = (const float*)d_in[23]; p.f2_post = (const float*)d_in[24]; p.final_g = (const float*)d_in[25];
    p.out = (float*)d_out; p.ws = (unsigned char*)d_ws;
    for (int i = 0; i < 32; ++i) p.inv_freq[i] = (float)pow(10000.0, -(2.0 * i) / 64.0);
    if (hipMemsetAsync((char*)d_ws + OFF_BAR, 0, CTL_BYTES, stream) != hipSuccess) { fprintf(stderr, "kernel_launch: memset failed\n"); return; }
    void* args[] = {&p};
    hipError_t e = hipLaunchCooperativeKernel((const void*)fwd_megakernel, dim3(grid_blocks), dim3(NTHREADS), args, LDS_BYTES, stream);
    if (e != hipSuccess) fprintf(stderr, "cooperative launch failed: %s (grid %d)\n", hipGetErrorString(e), grid_blocks);
}
```

```cpp
#include <hip/hip_runtime.h>
#include <hip/hip_cooperative_groups.h>
#include <cstdio>
#include <cmath>
#include <cstdint>
namespace cg = cooperative_groups;

#define LAS __attribute__((address_space(3)))
typedef unsigned short bf16_t;
typedef short bf16x8 __attribute__((ext_vector_type(8)));
typedef short s16x4 __attribute__((ext_vector_type(4)));
typedef float f32x2 __attribute__((ext_vector_type(2)));
typedef float f32x4 __attribute__((ext_vector_type(4)));
typedef float f32x16 __attribute__((ext_vector_type(16)));
typedef unsigned u32x4 __attribute__((ext_vector_type(4)));
typedef unsigned u32x2 __attribute__((ext_vector_type(2)));

constexpr int DM = 1024, NB = 8, SEQ = 2048, M = NB * SEQ, NH = 8, QL = 384, KVL = 256, DFF = 2816, INW = 3264;
constexpr float EPS = 1e-6f;
constexpr int NTHREADS = 512, NWAVES = 8;
constexpr int LDS_STAGE = 131072, LDS_BYTES = LDS_STAGE + 16;

constexpr size_t MiB = 1048576;
constexpr size_t OFF_WGU = 0;
constexpr size_t OFF_WD = OFF_WGU + (size_t)5632 * 1024 * 2;
constexpr size_t OFF_WIN = OFF_WD + (size_t)1024 * 2816 * 2;
constexpr size_t OFF_WUQ = OFF_WIN + (size_t)3328 * 1024 * 2;
constexpr size_t OFF_WUKV = OFF_WUQ + (size_t)1536 * 384 * 2;
constexpr size_t OFF_WOA = OFF_WUKV + (size_t)2048 * 256 * 2;
constexpr size_t OFF_WP = OFF_WOA + (size_t)1024 * 1024 * 2;
constexpr size_t OFF_WOUT = OFF_WP + (size_t)1024 * 512 * 2;
constexpr size_t OFF_XN = OFF_WOUT + (size_t)1024 * 1024 * 2;
constexpr size_t OFF_R = OFF_XN + 32 * MiB;
constexpr size_t OFF_F = OFF_R;
constexpr size_t OFF_ZF = OFF_R;
constexpr size_t OFF_KV = OFF_R;
constexpr size_t OFF_H = OFF_R + 64 * MiB;
constexpr size_t OFF_O = OFF_R + 64 * MiB;
constexpr size_t OFF_CQN = OFF_R + 80 * MiB;
constexpr size_t OFF_CKVN = OFF_R + 92 * MiB;
constexpr size_t OFF_TAB = OFF_R + 100 * MiB;
constexpr size_t OFF_Q = OFF_R + 104 * MiB;
constexpr size_t OFF_KR = OFF_R + 152 * MiB;
constexpr size_t OFF_G = OFF_R + 96 * MiB;
constexpr size_t OFF_DP = OFF_R + 176 * MiB;
constexpr size_t WS_END = OFF_R + 192 * MiB;
constexpr size_t OFF_BAR = WS_END, OFF_CNT = OFF_BAR + 16384, CTL_BYTES = 16384 + 6 * 16384, OFF_XBUF = OFF_BAR + CTL_BYTES;
static_assert(OFF_XBUF + 6 * (size_t)M * 16 <= 256 * MiB, "workspace");

struct Params {
    const float* x; const int* pos;
    const float *f1_pre, *f1_wg, *f1_wu, *f1_wd, *f1_post;
    const float *mix_pre, *w_in, *qa_g, *w_uq, *kva_g, *w_uk, *w_uv, *w_oa, *pool_w, *pool_scale, *w_op, *w_out, *mix_post;
    const float *f2_pre, *f2_wg, *f2_wu, *f2_wd, *f2_post, *final_g;
    float* out; unsigned char* ws;
    float inv_freq[32];
};

typedef __bf16 bf16x2_t __attribute__((ext_vector_type(2)));
__device__ __forceinline__ unsigned cvt_pk_bf16(float lo, float hi) { const f32x2 v = {lo, hi}; const bf16x2_t r = __builtin_convertvector(v, bf16x2_t); return __builtin_bit_cast(unsigned, r); }
__device__ __forceinline__ float bf_lo(unsigned w) { return __uint_as_float(w << 16); }
__device__ __forceinline__ float bf_hi(unsigned w) { return __uint_as_float(w & 0xffff0000u); }
__device__ __forceinline__ float sigmoidf_fast(float z) { return __builtin_amdgcn_rcpf(1.f + __builtin_amdgcn_exp2f(-1.4426950408889634f * z)); }
__device__ __forceinline__ int fresh_tid() { int t = threadIdx.x; asm volatile("" : "+v"(t)); return t; }
__device__ __forceinline__ float wave_sum(float v) {
#pragma unroll
    for (int o = 1; o < 64; o <<= 1) v += __shfl_xor(v, o);
    return v;
}

namespace pg8 {
constexpr int BM = 256, BK = 64, HALF = 128, HTB = HALF * BK * 2, STAGE_BYTES = 8 * HTB, NXCD = 8, WGM = 4;
__host__ __device__ __forceinline__ int lds_byte(int r, int c) { const int st = (r >> 4) * 2 + (c >> 5), rr = r & 15, cc = c & 31, ob = rr * 64 + cc * 2; return st * 1024 + (ob ^ (((ob >> 9) & 1) << 5)); }
__host__ __device__ __forceinline__ void stage_rc(int b, int& R, int& C) { const int st = b / 1024, sb = b % 1024, swz = sb ^ (((sb >> 9) & 1) << 5); R = (st >> 1) * 16 + swz / 64; C = (st & 1) * 32 + (swz % 64) / 2; }
__host__ __device__ __forceinline__ int perm32(int rho) { const int n = rho >> 4, i = rho & 15; return 8 * (i >> 2) + 4 * n + (i & 3); }
struct Unit { int pm, pn; };
struct Gemm { const bf16_t* A; const bf16_t* Bt; int M, N, K; };
struct StaticOrder {
    int nM, nN, nwg, G, c;
    __device__ void init(int M_, int N_, int G_, int c_) { nM = M_ / BM; nN = N_ / BM; nwg = nM * nN; G = G_; c = c_; }
    __device__ bool next(int i, Unit& u) const {
        const long L = (long)i * G + c; if (L >= nwg) return false;
        int wgid = (int)L; { const int q = nwg / NXCD, r = nwg % NXCD, xcd = wgid % NXCD, off = wgid / NXCD; wgid = (xcd < r ? xcd * (q + 1) : r * (q + 1) + (xcd - r) * q) + off; }
        const int nig = WGM * nN, gid = wgid / nig, fm = gid * WGM, gsz = (nM - fm) < WGM ? (nM - fm) : WGM;
        u.pm = fm + ((wgid % nig) % gsz); u.pn = (wgid % nig) / gsz; return true;
    }
};

struct GateOrder { StaticOrder s;
    __device__ bool next(int i, Unit& u) const { if (i >= 2) return false; Unit b; if (!s.next(0, b)) return false; u.pm = b.pm; u.pn = b.pn + 4 * i; return true; } };
template <class Epi, class Sched>
__device__ __forceinline__ void gemm_phase(LAS unsigned char* lds, const Gemm g, const Sched& S, const Epi& E) {
    const int tid = fresh_tid(), wid = __builtin_amdgcn_readfirstlane(tid >> 6), lane = tid & 63, wr = wid >> 2, wc = wid & 3, fr = lane & 15, fq = lane >> 4;
    const int K = g.K, nt = K / BK;
    unsigned voffA, voffB;
    { int R, C; stage_rc(tid * 16, R, C); const int Rb = Epi::PERM ? ((R & ~31) + perm32(R & 31)) : R;
      voffA = (unsigned)(R * K + C) * 2u; voffB = (unsigned)(Rb * K + C) * 2u; }
    const size_t rstep64 = (size_t)64 * K * 2;
    const size_t kstep = (size_t)(BK * 2);
    const size_t hstep = (size_t)HALF * K * 2;
    const size_t tstep = 2 * hstep;
    const unsigned ldsw = (unsigned)wid * 1024u;
    const int aoff = lds_byte(wr * 64 + fr, fq * 8), boff = lds_byte(wc * 32 + fr, fq * 8);
#define PG8_SA(b, h) (((b) * 2 + (h)) * HTB)
#define PG8_SB(b, h) ((4 + (b) * 2 + (h)) * HTB)
#define PG8_STAGE(bufoff, gbase, voff) do { _Pragma("unroll") for (int _i = 0; _i < 2; ++_i) \
        __builtin_amdgcn_global_load_lds((const unsigned*)((const char*)(gbase) + _i * rstep64 + (voff)), (LAS unsigned*)(lds + (bufoff) + ldsw + _i * 8192), 16, 0, 0); } while (0)
#define PG8_LDA(dst, b, h) do { _Pragma("unroll") for (int m = 0; m < 4; ++m) _Pragma("unroll") for (int k = 0; k < 2; ++k) dst[m][k] = *(const LAS bf16x8*)(lds + PG8_SA(b, h) + aoff + m * 2048 + k * 1024); } while (0)
#define PG8_LDB(dst, b, h) do { _Pragma("unroll") for (int n = 0; n < 2; ++n) _Pragma("unroll") for (int k = 0; k < 2; ++k) dst[n][k] = *(const LAS bf16x8*)(lds + PG8_SB(b, h) + boff + n * 2048 + k * 1024); } while (0)
#define PG8_MMA(ai, bj, At, Bt) do { __builtin_amdgcn_s_setprio(1); _Pragma("unroll") for (int m = 0; m < 4; ++m) _Pragma("unroll") for (int n = 0; n < 2; ++n) _Pragma("unroll") for (int k = 0; k < 2; ++k) \
        acc[ai][bj][m][n] = __builtin_amdgcn_mfma_f32_16x16x32_bf16(Bt[n][k], At[m][k], acc[ai][bj][m][n], 0, 0, 0); __builtin_amdgcn_s_setprio(0); } while (0)
#define PG8_WAIT_V(n) asm volatile("s_waitcnt vmcnt(" #n ")" ::: "memory")
#define PG8_WAIT_L(n) asm volatile("s_waitcnt lgkmcnt(" #n ")" ::: "memory")
#define PG8_BAR __builtin_amdgcn_s_barrier()
#define PG8_SCHED __builtin_amdgcn_sched_barrier(0)
    Unit cur, nxt; int ui = 0;
    if (!S.next(0, cur)) return;
    f32x4 acc[2][2][4][2];
#pragma unroll
    for (int a = 0; a < 2; ++a)
#pragma unroll
        for (int b = 0; b < 2; ++b)
#pragma unroll
            for (int m = 0; m < 4; ++m)
#pragma unroll
                for (int n = 0; n < 2; ++n) acc[a][b][m][n] = (f32x4){0.f, 0.f, 0.f, 0.f};
    bf16x8 At[4][2], B0[2][2], B1[2][2];
    const char* cA = (const char*)g.A + (size_t)cur.pm * tstep; const char* cB = (const char*)g.Bt + (size_t)cur.pn * tstep;
    PG8_STAGE(PG8_SB(0, 0), cB, voffB); PG8_STAGE(PG8_SA(0, 0), cA, voffA); PG8_STAGE(PG8_SB(0, 1), cB + hstep, voffB); PG8_STAGE(PG8_SA(0, 1), cA + hstep, voffA);
    if (wr == 1) PG8_BAR;
    PG8_WAIT_V(4); PG8_BAR;
    PG8_STAGE(PG8_SB(1, 0), cB + kstep, voffB); PG8_STAGE(PG8_SA(1, 0), cA + kstep, voffA); PG8_STAGE(PG8_SB(1, 1), cB + hstep + kstep, voffB);
    PG8_WAIT_V(6); PG8_BAR;
    for (;;) {
        const bool has_next = S.next(ui + 1, nxt);
        const char* nA = has_next ? (const char*)g.A + (size_t)nxt.pm * tstep : cA; const char* nB = has_next ? (const char*)g.Bt + (size_t)nxt.pn * tstep : cB;
        for (int t = 0; t < nt; t += 2) {
            const bool last = (t == nt - 2);
            const char* a1 = cA + (size_t)(t + 1) * kstep;
            const char* a2 = last ? nA : cA + (size_t)(t + 2) * kstep; const char* b2 = last ? nB : cB + (size_t)(t + 2) * kstep;
            const char* a3 = a2 + kstep; const char* b3 = b2 + kstep;
            PG8_LDB(B0, 0, 0); PG8_SCHED; PG8_LDA(At, 0, 0); PG8_STAGE(PG8_SA(1, 1), a1 + hstep, voffA);
            PG8_WAIT_L(8); PG8_BAR; PG8_WAIT_L(0); PG8_MMA(0, 0, At, B0); PG8_BAR; PG8_SCHED;
            PG8_LDB(B1, 0, 1); PG8_STAGE(PG8_SB(0, 0), b2, voffB);
            PG8_BAR; PG8_WAIT_L(0); PG8_MMA(0, 1, At, B1); PG8_BAR;
            PG8_LDA(At, 0, 1); PG8_STAGE(PG8_SA(0, 0), a2, voffA);
            PG8_BAR; PG8_WAIT_L(0); PG8_MMA(1, 0, At, B0); PG8_BAR; PG8_SCHED;
            PG8_STAGE(PG8_SB(0, 1), b2 + hstep, voffB);
            PG8_WAIT_V(6); PG8_BAR; PG8_MMA(1, 1, At, B1); PG8_BAR;
            PG8_LDB(B0, 1, 0); PG8_SCHED; PG8_LDA(At, 1, 0); PG8_STAGE(PG8_SA(0, 1), a2 + hstep, voffA);
            PG8_WAIT_L(8); PG8_BAR; PG8_WAIT_L(0); PG8_MMA(0, 0, At, B0); PG8_BAR; PG8_SCHED;
            PG8_LDB(B1, 1, 1); PG8_STAGE(PG8_SB(1, 0), b3, voffB);
            PG8_BAR; PG8_WAIT_L(0); PG8_MMA(0, 1, At, B1); PG8_BAR;
            PG8_LDA(At, 1, 1); PG8_STAGE(PG8_SA(1, 0), a3, voffA);
            PG8_BAR; PG8_WAIT_L(0); PG8_MMA(1, 0, At, B0); PG8_BAR; PG8_SCHED;
            PG8_STAGE(PG8_SB(1, 1), b3 + hstep, voffB);
            PG8_WAIT_V(6); PG8_BAR; PG8_MMA(1, 1, At, B1); PG8_BAR;
        }
        if constexpr (!Epi::AFTER_DRAIN) { const int t2 = fresh_tid(); E(acc, cur, wr, wc, t2 & 15, (t2 >> 4) & 3); }
        if (!has_next) break;
#pragma unroll
        for (int a = 0; a < 2; ++a)
#pragma unroll
            for (int b = 0; b < 2; ++b)
#pragma unroll
                for (int m = 0; m < 4; ++m)
#pragma unroll
                    for (int n = 0; n < 2; ++n) acc[a][b][m][n] = (f32x4){0.f, 0.f, 0.f, 0.f};
        cur = nxt; cA = nA; cB = nB; ++ui;
    }
    PG8_WAIT_V(0);
    if (wr == 0) PG8_BAR;
    PG8_BAR;
    if constexpr (Epi::AFTER_DRAIN) { const int t2 = fresh_tid(); E.fused(acc, cur, wr, wc, t2 & 15, (t2 >> 4) & 3, lds, t2 >> 6, t2 & 63); }
#undef PG8_SA
#undef PG8_SB
#undef PG8_STAGE
#undef PG8_LDA
#undef PG8_LDB
#undef PG8_MMA
#undef PG8_WAIT_V
#undef PG8_WAIT_L
#undef PG8_BAR
#undef PG8_SCHED
}

typedef f32x4 Acc[2][2][4][2];
struct EpiF32 {
    static constexpr bool PERM = false, AFTER_DRAIN = false;
    float* C; int ldc;
    __device__ __forceinline__ void operator()(const Acc& acc, const Unit& u, int wr, int wc, int fr, int fq) const {
        const int row0 = u.pm * BM + wr * 64 + fr, col0 = u.pn * BM + wc * 32 + 4 * fq;
#pragma unroll
        for (int ai = 0; ai < 2; ++ai)
#pragma unroll
            for (int m = 0; m < 4; ++m) { float* rowp = C + (size_t)(row0 + ai * HALF + m * 16) * ldc + col0;
#pragma unroll
                for (int bj = 0; bj < 2; ++bj)
#pragma unroll
                    for (int n = 0; n < 2; ++n) *(f32x4*)(rowp + bj * HALF + n * 16) = acc[ai][bj][m][n]; }
    }
};
struct EpiBf16 {
    static constexpr bool PERM = true, AFTER_DRAIN = false;
    bf16_t* O; int ldc;
    __device__ __forceinline__ void operator()(const Acc& acc, const Unit& u, int wr, int wc, int fr, int fq) const {
        const int row0 = u.pm * BM + wr * 64 + fr, col0 = u.pn * BM + wc * 32 + 8 * fq;
#pragma unroll
        for (int ai = 0; ai < 2; ++ai)
#pragma unroll
            for (int m = 0; m < 4; ++m) { bf16_t* rowp = O + (size_t)(row0 + ai * HALF + m * 16) * ldc + col0;
#pragma unroll
                for (int bj = 0; bj < 2; ++bj) { const f32x4 v0 = acc[ai][bj][m][0], v1 = acc[ai][bj][m][1];
                    u32x4 w; w.x = cvt_pk_bf16(v0[0], v0[1]); w.y = cvt_pk_bf16(v0[2], v0[3]); w.z = cvt_pk_bf16(v1[0], v1[1]); w.w = cvt_pk_bf16(v1[2], v1[3]);
                    *(u32x4*)(rowp + bj * HALF) = w; } }
    }
};
struct EpiSwiGLU {
    static constexpr bool PERM = true, AFTER_DRAIN = false;
    bf16_t* H;
    __device__ __forceinline__ void operator()(const Acc& acc, const Unit& u, int wr, int wc, int fr, int fq) const {
        const int row0 = u.pm * BM + wr * 64 + fr, col0 = u.pn * HALF + wc * 32 + 8 * fq;
#pragma unroll
        for (int ai = 0; ai < 2; ++ai)
#pragma unroll
            for (int m = 0; m < 4; ++m) { bf16_t* rowp = H + (size_t)(row0 + ai * HALF + m * 16) * DFF + col0;
                float h[8];
#pragma unroll
                for (int n = 0; n < 2; ++n)
#pragma unroll
                    for (int j = 0; j < 4; ++j) { const float gt = acc[ai][0][m][n][j], up = acc[ai][1][m][n][j]; h[n * 4 + j] = gt * sigmoidf_fast(gt) * up; }
                u32x4 w; w.x = cvt_pk_bf16(h[0], h[1]); w.y = cvt_pk_bf16(h[2], h[3]); w.z = cvt_pk_bf16(h[4], h[5]); w.w = cvt_pk_bf16(h[6], h[7]);
                *(u32x4*)rowp = w; }
    }
};
struct EpiGate {
    static constexpr bool PERM = true, AFTER_DRAIN = false;
    bf16_t* G;
    __device__ __forceinline__ void operator()(const Acc& acc, const Unit& u, int wr, int wc, int fr, int fq) const {
        const int row0 = u.pm * BM + wr * 64 + fr, col0 = u.pn * BM + wc * 32 + 8 * fq;
#pragma unroll
        for (int ai = 0; ai < 2; ++ai)
#pragma unroll
            for (int m = 0; m < 4; ++m) { bf16_t* rowp = G + (size_t)(row0 + ai * HALF + m * 16) * 2048 + col0;
#pragma unroll
                for (int bj = 0; bj < 2; ++bj) { const f32x4 v0 = acc[ai][bj][m][0], v1 = acc[ai][bj][m][1];
                    u32x4 w; w.x = cvt_pk_bf16(sigmoidf_fast(v0[0]), sigmoidf_fast(v0[1])); w.y = cvt_pk_bf16(sigmoidf_fast(v0[2]), sigmoidf_fast(v0[3]));
                    w.z = cvt_pk_bf16(sigmoidf_fast(v1[0]), sigmoidf_fast(v1[1])); w.w = cvt_pk_bf16(sigmoidf_fast(v1[2]), sigmoidf_fast(v1[3]));
                    *(u32x4*)(rowp + bj * HALF) = w; } }
    }
};
struct EpiQ {
    static constexpr bool PERM = true, AFTER_DRAIN = false;
    bf16_t* Q; const float* TAB;
    __device__ __forceinline__ void operator()(const Acc& acc, const Unit& u, int wr, int wc, int fr, int fq) const {
        const int row0 = u.pm * BM + wr * 64 + fr, col0 = u.pn * BM + wc * 32 + 8 * fq;
#pragma unroll
        for (int ai = 0; ai < 2; ++ai)
#pragma unroll
            for (int m = 0; m < 4; ++m) { const int row = row0 + ai * HALF + m * 16; bf16_t* rowp = Q + (size_t)row * 1536 + col0;
#pragma unroll
                for (int bj = 0; bj < 2; ++bj) { f32x4 v0 = acc[ai][bj][m][0], v1 = acc[ai][bj][m][1];
                    const int c = col0 + bj * HALF, w = c % 192;
                    if (w >= 128) { const int i0 = (w - 128) >> 1; const f32x4 cs = *(const f32x4*)(TAB + (size_t)row * 64 + i0), sn = *(const f32x4*)(TAB + (size_t)row * 64 + 32 + i0);
                        f32x4 r0, r1;
                        r0[0] = v0[0] * cs[0] - v0[1] * sn[0]; r0[1] = v0[1] * cs[0] + v0[0] * sn[0];
                        r0[2] = v0[2] * cs[1] - v0[3] * sn[1]; r0[3] = v0[3] * cs[1] + v0[2] * sn[1];
                        r1[0] = v1[0] * cs[2] - v1[1] * sn[2]; r1[1] = v1[1] * cs[2] + v1[0] * sn[2];
                        r1[2] = v1[2] * cs[3] - v1[3] * sn[3]; r1[3] = v1[3] * cs[3] + v1[2] * sn[3];
                        v0 = r0; v1 = r1; }
                    u32x4 wv; wv.x = cvt_pk_bf16(v0[0], v0[1]); wv.y = cvt_pk_bf16(v0[2], v0[3]); wv.z = cvt_pk_bf16(v1[0], v1[1]); wv.w = cvt_pk_bf16(v1[2], v1[3]);
                    *(u32x4*)(rowp + bj * HALF) = wv; } }
    }
};
struct EpiT1 {
    static constexpr bool PERM = true, AFTER_DRAIN = false;
    const bf16_t* G; bf16_t* F;
    __device__ __forceinline__ void operator()(const Acc& acc, const Unit& u, int wr, int wc, int fr, int fq) const {
        const int row0 = u.pm * BM + wr * 64 + fr, col0 = u.pn * BM + wc * 32 + 8 * fq;
#pragma unroll
        for (int ai = 0; ai < 2; ++ai)
#pragma unroll
            for (int m = 0; m < 4; ++m) { const int row = row0 + ai * HALF + m * 16;
#pragma unroll
                for (int bj = 0; bj < 2; ++bj) { const f32x4 v0 = acc[ai][bj][m][0], v1 = acc[ai][bj][m][1]; const int c = col0 + bj * HALF;
                    const u32x4 gw = *(const u32x4*)(G + (size_t)row * 2048 + c);
                    u32x4 wv;
                    wv.x = cvt_pk_bf16(v0[0] * bf_lo(gw.x), v0[1] * bf_hi(gw.x)); wv.y = cvt_pk_bf16(v0[2] * bf_lo(gw.y), v0[3] * bf_hi(gw.y));
                    wv.z = cvt_pk_bf16(v1[0] * bf_lo(gw.z), v1[1] * bf_hi(gw.z)); wv.w = cvt_pk_bf16(v1[2] * bf_lo(gw.w), v1[3] * bf_hi(gw.w));
                    *(u32x4*)(F + (size_t)row * 1024 + c) = wv; } }
    }
};
struct EpiMX {
    static constexpr bool PERM = true, AFTER_DRAIN = false;
    const bf16_t* G; const bf16_t* F; bf16_t* MX;
    __device__ __forceinline__ void operator()(const Acc& acc, const Unit& u, int wr, int wc, int fr, int fq) const {
        const int row0 = u.pm * BM + wr * 64 + fr, col0 = u.pn * BM + wc * 32 + 8 * fq;
#pragma unroll
        for (int ai = 0; ai < 2; ++ai)
#pragma unroll
            for (int m = 0; m < 4; ++m) { const int row = row0 + ai * HALF + m * 16;
#pragma unroll
                for (int bj = 0; bj < 2; ++bj) { const f32x4 v0 = acc[ai][bj][m][0], v1 = acc[ai][bj][m][1]; const int c = col0 + bj * HALF;
                    const u32x4 gw = *(const u32x4*)(G + (size_t)row * 2048 + 1024 + c);
                    const u32x4 tw = *(const u32x4*)(F + (size_t)row * 1024 + c);
                    u32x4 wv;
                    wv.x = cvt_pk_bf16(bf_lo(tw.x) + v0[0] * bf_lo(gw.x), bf_hi(tw.x) + v0[1] * bf_hi(gw.x)); wv.y = cvt_pk_bf16(bf_lo(tw.y) + v0[2] * bf_lo(gw.y), bf_hi(tw.y) + v0[3] * bf_hi(gw.y));
                    wv.z = cvt_pk_bf16(bf_lo(tw.z) + v1[0] * bf_lo(gw.z), bf_hi(tw.z) + v1[1] * bf_hi(gw.z)); wv.w = cvt_pk_bf16(bf_lo(tw.w) + v1[2] * bf_lo(gw.w), bf_hi(tw.w) + v1[3] * bf_hi(gw.w));
                    *(u32x4*)(MX + (size_t)row * 1024 + c) = wv; } }
    }
};

struct PanelSumSq {
    float* xbuf;
    unsigned* cnt;
    __device__ __forceinline__ void run(const Acc& v, const Unit& u, int wr, int wc, int fr, int fq, LAS unsigned char* lds, int wid, int lane) const {
        LAS float* P = (LAS float*)lds; LAS float* S = (LAS float*)(lds + 4096);
#pragma unroll
        for (int ai = 0; ai < 2; ++ai)
#pragma unroll
            for (int m = 0; m < 4; ++m) { float q = 0.f;
#pragma unroll
                for (int bj = 0; bj < 2; ++bj)
#pragma unroll
                    for (int n = 0; n < 2; ++n) { const f32x4 x = v[ai][bj][m][n]; q += (x[0] * x[0] + x[1] * x[1]) + (x[2] * x[2] + x[3] * x[3]); }
                q += __shfl_xor(q, 16); q += __shfl_xor(q, 32);
                if (fq == 0) P[(ai * HALF + wr * 64 + m * 16 + fr) * 4 + wc] = q; }
        asm volatile("s_waitcnt lgkmcnt(0)" ::: "memory"); __builtin_amdgcn_s_barrier(); asm volatile("" ::: "memory");
        const int row = wid * 32 + (lane & 31);
        if (lane < 32) { const float t = (P[row * 4 + 0] + P[row * 4 + 1]) + (P[row * 4 + 2] + P[row * 4 + 3]);
            __hip_atomic_store(xbuf + ((size_t)(u.pm * BM + row) * 4 + u.pn), t, __ATOMIC_RELAXED, __HIP_MEMORY_SCOPE_AGENT); }
        asm volatile("s_waitcnt vmcnt(0)" ::: "memory");
        if (lane == 0) __hip_atomic_fetch_add(cnt + 64 * u.pm, 1u, __ATOMIC_RELAXED, __HIP_MEMORY_SCOPE_AGENT);
        if (wid == 0) { unsigned sp = 0u;
            while ((unsigned)__builtin_amdgcn_readfirstlane(__hip_atomic_load(cnt + 64 * u.pm, __ATOMIC_RELAXED, __HIP_MEMORY_SCOPE_AGENT)) < 32u) { __builtin_amdgcn_s_sleep(1); if (++sp > (1u << 22)) break; }
            __builtin_amdgcn_fence(__ATOMIC_ACQUIRE, "agent"); }
        asm volatile("s_waitcnt vmcnt(0) lgkmcnt(0)" ::: "memory"); __builtin_amdgcn_s_barrier(); asm volatile("" ::: "memory");
        if (lane < 32) { const float* slot = xbuf + (size_t)(u.pm * BM + row) * 4; float tot = 0.f;
#pragma unroll
            for (int t = 0; t < 4; ++t) tot += __hip_atomic_load(slot + t, __ATOMIC_RELAXED, __HIP_MEMORY_SCOPE_AGENT);
            S[row] = __builtin_amdgcn_rsqf(tot * (1.f / 1024.f) + EPS); }
        asm volatile("s_waitcnt lgkmcnt(0)" ::: "memory"); __builtin_amdgcn_s_barrier(); asm volatile("" ::: "memory");
    }
};
template <bool FINAL, bool BASEF32> struct EpiResNorm {
    static constexpr bool PERM = true, AFTER_DRAIN = true;
    const float* basef; bf16_t* xb; float* outf; bf16_t* xn; float wt; const float* gpost; const float* gnext; PanelSumSq st1, st2;
    __device__ __forceinline__ void operator()(const Acc&, const Unit&, int, int, int, int) const {}
    __device__ __forceinline__ void fused(Acc& acc, const Unit& u, int wr, int wc, int fr, int fq, LAS unsigned char* lds, int wid, int lane) const {
        const LAS float* S = (const LAS float*)(lds + 4096);
        const int col0 = u.pn * BM + wc * 32 + 8 * fq;
        st1.run(acc, u, wr, wc, fr, fq, lds, wid, lane);
#pragma unroll
        for (int ai = 0; ai < 2; ++ai)
#pragma unroll
            for (int m = 0; m < 4; ++m) { const int r = ai * HALF + wr * 64 + m * 16 + fr; const float sr = S[r] * wt;
                const size_t off = (size_t)(u.pm * BM + r) * 1024 + col0, xoff = (size_t)u.pm * 524288 + 262144 + (size_t)r * 1024 + col0;
#pragma unroll
                for (int bj = 0; bj < 2; ++bj) { f32x4 b0, b1;
                    if (BASEF32) { b0 = *(const f32x4*)(basef + off + bj * HALF); b1 = *(const f32x4*)(basef + off + bj * HALF + 4); }
                    else { const u32x4 w = *(const u32x4*)(xb + xoff + bj * HALF); b0 = (f32x4){bf_lo(w.x), bf_hi(w.x), bf_lo(w.y), bf_hi(w.y)}; b1 = (f32x4){bf_lo(w.z), bf_hi(w.z), bf_lo(w.w), bf_hi(w.w)}; }
                    const f32x4 g0 = *(const f32x4*)(gpost + col0 + bj * HALF), g1 = *(const f32x4*)(gpost + col0 + bj * HALF + 4);
                    acc[ai][bj][m][0] = b0 + acc[ai][bj][m][0] * g0 * sr; acc[ai][bj][m][1] = b1 + acc[ai][bj][m][1] * g1 * sr; }
                asm volatile("" : "+v"(acc[ai][0][m][0]), "+v"(acc[ai][0][m][1]), "+v"(acc[ai][1][m][0]), "+v"(acc[ai][1][m][1]));
                if (m & 1) asm volatile("" ::: "memory"); }
        st2.run(acc, u, wr, wc, fr, fq, lds, wid, lane);
#pragma unroll
        for (int ai = 0; ai < 2; ++ai)
#pragma unroll
            for (int m = 0; m < 4; ++m) { const int r = ai * HALF + wr * 64 + m * 16 + fr; const float sr = S[r];
                const size_t off = (size_t)(u.pm * BM + r) * 1024 + col0, xoff = (size_t)u.pm * 524288 + 262144 + (size_t)r * 1024 + col0;
#pragma unroll
                for (int bj = 0; bj < 2; ++bj) { const f32x4 x0 = acc[ai][bj][m][0], x1 = acc[ai][bj][m][1];
                    const f32x4 g0 = *(const f32x4*)(gnext + col0 + bj * HALF), g1 = *(const f32x4*)(gnext + col0 + bj * HALF + 4); const f32x4 o0 = x0 * g0 * sr, o1 = x1 * g1 * sr;
                    if (FINAL) { *(f32x4*)(outf + off + bj * HALF) = o0; *(f32x4*)(outf + off + bj * HALF + 4) = o1; }
                    else { u32x4 wx; wx.x = cvt_pk_bf16(x0[0], x0[1]); wx.y = cvt_pk_bf16(x0[2], x0[3]); wx.z = cvt_pk_bf16(x1[0], x1[1]); wx.w = cvt_pk_bf16(x1[2], x1[3]); *(u32x4*)(xb + xoff + bj * HALF) = wx;
                           u32x4 w; w.x = cvt_pk_bf16(o0[0], o0[1]); w.y = cvt_pk_bf16(o0[2], o0[3]); w.z = cvt_pk_bf16(o1[0], o1[1]); w.w = cvt_pk_bf16(o1[2], o1[3]); *(u32x4*)(xn + off + bj * HALF) = w; } }
                asm volatile("" ::: "memory"); }
    }
};
}

namespace att {
constexpr int NW = 8, QBLK = 32, KVBLK = 64;
constexpr float SCALE = 0.07216878364870322f;
constexpr float THR = 8.f;
constexpr int LDQ = 1536, LDKV = 2048, LDKR = 64, LDO = 1024;
constexpr int SHM_V = 64 * 128 * 2, SHM_K = 64 * 128 * 2, SHM_R = 64 * 64 * 2;
constexpr int NQL = 4;
constexpr int OFF_V = 0, OFF_K = 2 * SHM_V, OFF_RP = OFF_K + 2 * SHM_K, OFF_WS = OFF_RP + 2 * SHM_R, OFF_QL = OFF_WS + NW * 64 * 4, SHM_ATTN = OFF_QL + NW * NQL * 1024;
static_assert(SHM_ATTN <= LDS_STAGE, "lds");
#define KSWZ(row, colB) ((row) * 256 + ((colB) ^ (((row) & 15) << 4)))
#define RSWZ(row, colB) ((row) * 128 + ((colB) ^ ((((row) >> 1) & 7) << 4)))
#define SBAR() __builtin_amdgcn_sched_barrier(0)
__device__ __forceinline__ int crow(int r, int hi) { return (r & 3) + 8 * (r >> 2) + 4 * hi; }
__device__ __forceinline__ bf16x8 ld8(const bf16_t* p) { return *reinterpret_cast<const bf16x8*>(p); }

__device__ __forceinline__ void partialSM(f32x16& p0, f32x16& p1, float& m_reg, float& mn, float& alpha) {
    constexpr float C = SCALE * 1.4426950408889634f;
    float pmax = p0[0];
#pragma unroll
    for (int r = 1; r < 16; ++r) pmax = fmaxf(pmax, p0[r]);
#pragma unroll
    for (int r = 0; r < 16; ++r) pmax = fmaxf(pmax, p1[r]);
    { auto rr = __builtin_amdgcn_permlane32_swap(__float_as_uint(pmax), __float_as_uint(pmax), false, false);
      pmax = fmaxf(__uint_as_float(rr[0]), __uint_as_float(rr[1])); }
    if (__builtin_expect(__all(pmax - m_reg <= THR / SCALE), 1)) { mn = m_reg; alpha = 1.f; }
    else { mn = fmaxf(m_reg, pmax); alpha = __builtin_amdgcn_exp2f((m_reg - mn) * C); m_reg = mn; }
    float mnC = -mn * C;
#pragma unroll
    for (int r = 0; r < 16; ++r) p0[r] = fmaf(p0[r], C, mnC);
#pragma unroll
    for (int r = 0; r < 16; ++r) p1[r] = fmaf(p1[r], C, mnC);
#pragma unroll
    for (int r = 0; r < 16; ++r) p0[r] = __builtin_amdgcn_exp2f(p0[r]);
}
__device__ __forceinline__ void finishSM(f32x16& p0, f32x16& p1, float alpha, float& l_reg, bf16x8& pa0, bf16x8& pa1, bf16x8& pa2, bf16x8& pa3) {
#pragma unroll
    for (int r = 0; r < 16; ++r) p1[r] = __builtin_amdgcn_exp2f(p1[r]);
    float ps = 0;
#pragma unroll
    for (int r = 0; r < 16; ++r) ps += p0[r];
#pragma unroll
    for (int r = 0; r < 16; ++r) ps += p1[r];
    { auto rr = __builtin_amdgcn_permlane32_swap(__float_as_uint(ps), __float_as_uint(ps), false, false);
      ps = __uint_as_float(rr[0]) + __uint_as_float(rr[1]); }
    l_reg = l_reg * alpha + ps;
#define PK4(P, BASE, OUT) do { unsigned a0 = cvt_pk_bf16(P[BASE + 0], P[BASE + 1]), a1 = cvt_pk_bf16(P[BASE + 2], P[BASE + 3]);   \
    unsigned b0 = cvt_pk_bf16(P[BASE + 4], P[BASE + 5]), b1 = cvt_pk_bf16(P[BASE + 6], P[BASE + 7]);                              \
    auto r0 = __builtin_amdgcn_permlane32_swap(a0, b0, false, false); auto r1 = __builtin_amdgcn_permlane32_swap(a1, b1, false, false); \
    u32x4 w = {r0[0], r1[0], r0[1], r1[1]}; OUT = *reinterpret_cast<bf16x8*>(&w); } while (0)
    PK4(p0, 0, pa0); PK4(p0, 8, pa1); PK4(p1, 0, pa2); PK4(p1, 8, pa3);
#undef PK4
}
__device__ __forceinline__ void qkt(f32x16& p0, f32x16& p1, const char* Ks, const char* Rs, const bf16x8* qr, const char* ql, int r32, int hi) {
    p0 = f32x16{}; p1 = f32x16{};
#pragma unroll
    for (int d0 = 0; d0 < 8; ++d0) { int cb = (d0 * 16 + hi * 8) * 2;
        bf16x8 b0 = *reinterpret_cast<const bf16x8*>(Ks + KSWZ(r32, cb));
        bf16x8 b1 = *reinterpret_cast<const bf16x8*>(Ks + KSWZ(32 + r32, cb));
        p0 = __builtin_amdgcn_mfma_f32_32x32x16_bf16(b0, qr[d0], p0, 0, 0, 0);
        p1 = __builtin_amdgcn_mfma_f32_32x32x16_bf16(b1, qr[d0], p1, 0, 0, 0); }
#pragma unroll
    for (int d0 = 0; d0 < 4; ++d0) { int cb = (d0 * 16 + hi * 8) * 2;
        bf16x8 b0 = *reinterpret_cast<const bf16x8*>(Rs + RSWZ(r32, cb));
        bf16x8 b1 = *reinterpret_cast<const bf16x8*>(Rs + RSWZ(32 + r32, cb));
        const bf16x8 qv = *reinterpret_cast<const bf16x8*>(ql + d0 * 1024);
        p0 = __builtin_amdgcn_mfma_f32_32x32x16_bf16(b0, qv, p0, 0, 0, 0);
        p1 = __builtin_amdgcn_mfma_f32_32x32x16_bf16(b1, qv, p1, 0, 0, 0); }
}
__device__ __forceinline__ int v_st(int k, int c) { const int kk = (k & ~0xC) | ((k & 4) << 1) | ((k & 8) >> 1); return ((kk >> 3) * 4 + (c >> 5)) * 512 + ((kk & 7) * 32 + (c & 31)) * 2; }
__device__ __forceinline__ int v_rd_base(int lane) { return ((lane & 3) << 3) | (((lane >> 2) & 3) << 6) | (((lane >> 4) & 1) << 5) | (((lane >> 5) & 1) << 8); }
constexpr int v_rd_off(int d0, int ks, int half) { return d0 * 512 + ks * 4096 + half * 2048; }
template <int OFF> __device__ __forceinline__ s16x4 tr_read(int vb) {
    s16x4 r; asm volatile("ds_read_b64_tr_b16 %0, %1 offset:%2" : "=&v"(r) : "v"(vb), "i"(OFF) : "memory"); return r;
}
template <int D0> __device__ __forceinline__ void pv_one(f32x16& od, int vb, bf16x8 pa0, bf16x8 pa1, bf16x8 pa2, bf16x8 pa3) {
    const s16x4 l0 = tr_read<v_rd_off(D0, 0, 0)>(vb), h0 = tr_read<v_rd_off(D0, 0, 1)>(vb), l1 = tr_read<v_rd_off(D0, 1, 0)>(vb), h1 = tr_read<v_rd_off(D0, 1, 1)>(vb);
    const s16x4 l2 = tr_read<v_rd_off(D0, 2, 0)>(vb), h2 = tr_read<v_rd_off(D0, 2, 1)>(vb), l3 = tr_read<v_rd_off(D0, 3, 0)>(vb), h3 = tr_read<v_rd_off(D0, 3, 1)>(vb);
    asm volatile("s_waitcnt lgkmcnt(0)" ::: "memory"); SBAR();
#define PK(L, H) (bf16x8){L[0], L[1], L[2], L[3], H[0], H[1], H[2], H[3]}
    od = __builtin_amdgcn_mfma_f32_32x32x16_bf16(pa0, PK(l0, h0), od, 0, 0, 0);
    od = __builtin_amdgcn_mfma_f32_32x32x16_bf16(pa1, PK(l1, h1), od, 0, 0, 0);
    od = __builtin_amdgcn_mfma_f32_32x32x16_bf16(pa2, PK(l2, h2), od, 0, 0, 0);
    od = __builtin_amdgcn_mfma_f32_32x32x16_bf16(pa3, PK(l3, h3), od, 0, 0, 0);
#undef PK
}
__device__ __forceinline__ void pv_d0(f32x16* o, int vb, bf16x8 pa0, bf16x8 pa1, bf16x8 pa2, bf16x8 pa3) {
    pv_one<0>(o[0], vb, pa0, pa1, pa2, pa3); pv_one<1>(o[1], vb, pa0, pa1, pa2, pa3); pv_one<2>(o[2], vb, pa0, pa1, pa2, pa3); pv_one<3>(o[3], vb, pa0, pa1, pa2, pa3);
}

__device__ __forceinline__ void attn_body(const bf16_t* __restrict__ Qb, const bf16_t* __restrict__ Kn, const bf16_t* __restrict__ Kr, const bf16_t* __restrict__ Vh,
                                          bf16_t* __restrict__ Ob, int seq, char* lds) {
    const int tid = fresh_tid(), wid = tid >> 6, lane = tid & 63, r32 = lane & 31, hi = lane >> 5;
    char* V_lds = lds + OFF_V; char* K_lds = lds + OFF_K; char* R_lds = lds + OFF_RP;
    float* ws = (float*)(lds + OFF_WS) + wid * 64; float* li_l = ws; float* al_l = ws + 32;
    float m_reg = -1e30f, l_reg = 0; f32x16 o[4] = {}; bf16x8 qr[8];
    char* ql = lds + OFF_QL + wid * (NQL * 1024) + lane * 16;
    const bf16_t* Qw = Qb + (long)(wid * QBLK + r32) * LDQ + hi * 8;
#pragma unroll
    for (int d0 = 0; d0 < 8; ++d0) qr[d0] = ld8(Qw + d0 * 16);
#pragma unroll
    for (int d0 = 0; d0 < NQL; ++d0) *reinterpret_cast<bf16x8*>(ql + d0 * 1024) = ld8(Qw + (8 + d0) * 16);
    const int sr = tid >> 4, sc = (tid & 15) * 8, vst0 = v_st(sr, sc), vst1 = v_st(32 + sr, sc);
    const int rr_ = tid >> 3, rc_ = (tid & 7) * 8;
    const int vb0 = (int)(uintptr_t)V_lds + v_rd_base(lane);
    bf16x8 vs0, vs1, ks0, ks1, rs0;
#define SLOAD(k0) do { vs0 = ld8(&Vh[(long)((k0) + sr) * LDKV + sc]); vs1 = ld8(&Vh[(long)((k0) + 32 + sr) * LDKV + sc]); \
    ks0 = ld8(&Kn[(long)((k0) + sr) * LDKV + sc]); ks1 = ld8(&Kn[(long)((k0) + 32 + sr) * LDKV + sc]); rs0 = ld8(&Kr[(long)((k0) + rr_) * LDKR + rc_]); } while (0)
#define SWRITE(b) do { *(bf16x8*)(V_lds + (b) * SHM_V + vst0) = vs0; *(bf16x8*)(V_lds + (b) * SHM_V + vst1) = vs1; int kc = sc * 2; \
    *(bf16x8*)(K_lds + (b) * SHM_K + KSWZ(sr, kc)) = ks0; *(bf16x8*)(K_lds + (b) * SHM_K + KSWZ(32 + sr, kc)) = ks1; \
    *(bf16x8*)(R_lds + (b) * SHM_R + RSWZ(rr_, rc_ * 2)) = rs0; } while (0)
#define RESC(a) do { if (__any((a) < 1.f)) { if (hi == 0) al_l[r32] = (a); asm volatile("s_waitcnt lgkmcnt(0)" ::: "memory"); \
    _Pragma("unroll") for (int d = 0; d < 4; ++d) _Pragma("unroll") for (int r = 0; r < 16; ++r) o[d][r] *= al_l[crow(r, hi)]; } } while (0)
    f32x16 pA0, pA1, pB0, pB1; float mnA, mnB, alA, alB; bf16x8 pa0, pa1, pa2, pa3; const int NT = seq / KVBLK;
    SLOAD(0); asm volatile("s_waitcnt vmcnt(0)" ::: "memory"); SWRITE(0); __syncthreads();
    qkt(pA0, pA1, K_lds, R_lds, qr, ql, r32, hi); partialSM(pA0, pA1, m_reg, mnA, alA);
    SLOAD(KVBLK);
    asm volatile("s_waitcnt vmcnt(0)" ::: "memory"); SWRITE(1); __syncthreads();
    for (int j = 1; j + 1 < NT; j += 2) {
        SBAR(); qkt(pB0, pB1, K_lds + SHM_K, R_lds + SHM_R, qr, ql, r32, hi);
        finishSM(pA0, pA1, alA, l_reg, pa0, pa1, pa2, pa3); SBAR();
        SLOAD((j + 1) * KVBLK); SBAR();
        pv_d0(o, vb0, pa0, pa1, pa2, pa3); partialSM(pB0, pB1, m_reg, mnB, alB);
        __syncthreads(); asm volatile("s_waitcnt vmcnt(0)" ::: "memory"); SWRITE(0);
        RESC(alB); __syncthreads();
        SBAR(); qkt(pA0, pA1, K_lds, R_lds, qr, ql, r32, hi);
        finishSM(pB0, pB1, alB, l_reg, pa0, pa1, pa2, pa3); SBAR();
        SLOAD((j + 2) * KVBLK); SBAR();
        pv_d0(o, vb0 + SHM_V, pa0, pa1, pa2, pa3); partialSM(pA0, pA1, m_reg, mnA, alA);
        __syncthreads(); asm volatile("s_waitcnt vmcnt(0)" ::: "memory"); SWRITE(1);
        RESC(alA); __syncthreads();
    }
    SBAR(); qkt(pB0, pB1, K_lds + SHM_K, R_lds + SHM_R, qr, ql, r32, hi);
    finishSM(pA0, pA1, alA, l_reg, pa0, pa1, pa2, pa3); SBAR();
    pv_d0(o, vb0, pa0, pa1, pa2, pa3); partialSM(pB0, pB1, m_reg, mnB, alB);
    __syncthreads(); RESC(alB);
    finishSM(pB0, pB1, alB, l_reg, pa0, pa1, pa2, pa3); SBAR();
    pv_d0(o, vb0 + SHM_V, pa0, pa1, pa2, pa3);
    if (hi == 0) li_l[r32] = l_reg; asm volatile("s_waitcnt lgkmcnt(0)" ::: "memory");
    float rli[16];
#pragma unroll
    for (int r = 0; r < 16; ++r) rli[r] = __builtin_amdgcn_rcpf(li_l[crow(r, hi)]);
    bf16_t* Ow = Ob + (long)(wid * QBLK) * LDO;
#pragma unroll
    for (int r = 0; r < 16; ++r) { int orow = crow(r, hi);
#pragma unroll
        for (int d0 = 0; d0 < 4; ++d0) { const float v = o[d0][r] * rli[r]; Ow[(long)orow * LDO + d0 * 32 + r32] = (bf16_t)(cvt_pk_bf16(v, v) & 0xffffu); } }
#undef SLOAD
#undef SWRITE
#undef RESC
}
}


#define XB_TMO      128
#define XB_XCNT(j)  (256  + 64 * (j))
#define XB_XSUB(j)  (1280 + 64 * (j))
#define XB_XGEN(j)  (2304 + 64 * (j))
#define XB_TOP      3328
#define XB_TOPGEN   3392
#define XCD_BAR_WORDS 3456
#define XB_SPIN_CAP (1u << 18)
__device__ __forceinline__ unsigned xb_ld(unsigned* p)              { return __hip_atomic_load(p, __ATOMIC_RELAXED, __HIP_MEMORY_SCOPE_AGENT); }
__device__ __forceinline__ unsigned xb_add(unsigned* p, unsigned v) { return __hip_atomic_fetch_add(p, v, __ATOMIC_RELAXED, __HIP_MEMORY_SCOPE_AGENT); }
__device__ __forceinline__ unsigned xb_xcc_id() { return (unsigned)__builtin_amdgcn_s_getreg((3 << 11) | 20) & 0xFu; }
#define XB_SPIN(cond, bar) do { unsigned _sp = 0; while (cond) { __builtin_amdgcn_s_sleep(1); \
    if ((++_sp & 255u) == 0u) { if (xb_ld(&(bar)[XB_TMO])) break; if (_sp > XB_SPIN_CAP) { atomicAdd(&(bar)[XB_TMO], 1u); break; } } } } while (0)
struct XcdBarrier { unsigned* bar; unsigned x; volatile LAS unsigned* st; };
__device__ __forceinline__ XcdBarrier xcd_barrier_post(unsigned* bar, volatile LAS unsigned* st) {
    XcdBarrier b; b.bar = bar; b.x = xb_xcc_id(); b.st = st;
    if (threadIdx.x == 0) (void)xb_add(&bar[XB_XCNT(b.x)], 1u);
    return b;
}
__device__ __forceinline__ void xcd_barrier_complete(unsigned* bar, unsigned x, unsigned& nloc, unsigned& nx) {
    const unsigned G = gridDim.x * gridDim.y * gridDim.z;
    unsigned sum, cnt, mine, sp = 0u;
    for (;;) {
        sum = 0u; cnt = 0u; mine = 0u;
#pragma unroll
        for (unsigned j = 0; j < 16; ++j) { const unsigned c = xb_ld(&bar[XB_XCNT(j)]); sum += c; cnt += (c > 0u) ? 1u : 0u; mine = (j == x) ? c : mine; }
        if (sum == G) break;
        __builtin_amdgcn_s_sleep(1);
        if ((++sp & 255u) == 0u) { if (xb_ld(&bar[XB_TMO])) break; if (sp > XB_SPIN_CAP) { atomicAdd(&bar[XB_TMO], 1u); break; } }
    }
    nloc = mine > 0u ? mine : 1u; nx = cnt > 0u ? cnt : 1u;
}
__device__ __forceinline__ void xcd_barrier(const XcdBarrier& b) {
    asm volatile("s_waitcnt vmcnt(0)" ::: "memory");
    __syncthreads();
    if (threadIdx.x == 0) {
        unsigned* bar = b.bar;
        __builtin_amdgcn_s_waitcnt(0);
        unsigned nloc = b.st[0], nx = b.st[1];
        if (nloc == 0u) { xcd_barrier_complete(bar, b.x, nloc, nx); b.st[0] = nloc; b.st[1] = nx; }
        const unsigned old = xb_add(&bar[XB_XSUB(b.x)], 1u);
        const unsigned gen = old / nloc;
        if (old + 1u == (gen + 1u) * nloc) {
            __builtin_amdgcn_fence(__ATOMIC_RELEASE, "agent");
            asm volatile("s_waitcnt vmcnt(0)" ::: "memory");
            const unsigned og = xb_add(&bar[XB_TOP], 1u);
            const unsigned tg = og / nx;
            if (og + 1u == (tg + 1u) * nx) xb_add(&bar[XB_TOPGEN], 1u);
            else XB_SPIN(xb_ld(&bar[XB_TOPGEN]) == tg, bar);
            __builtin_amdgcn_fence(__ATOMIC_ACQUIRE, "agent");
            xb_add(&bar[XB_XGEN(b.x)], 1u);
            asm volatile("s_waitcnt vmcnt(0)" ::: "memory");
        } else {
            XB_SPIN(xb_ld(&bar[XB_XGEN(b.x)]) == gen, bar);
            __builtin_amdgcn_fence(__ATOMIC_ACQUIRE, "agent");
            asm volatile("s_waitcnt vmcnt(0)" ::: "memory");
        }
    }
    __syncthreads();
}

enum { TR_PLAIN = 0, TR_GU = 1, TR_WIN = 2, TR_UQ = 3, TR_UKV = 4 };
template <int MODE>
__device__ __forceinline__ void tr_job(const float* W0, const float* W1, int K, int Nsrc, int Nout, bf16_t* WT, LAS float* scr, int lane, int gw, int NGW) {
    const int nblk = Nout / 32, nitems = (K / 64) * nblk;
    for (int it = gw; it < nitems; it += NGW) {
        const int kb = it / nblk, nb = it % nblk, k0 = 64 * kb, n0 = 32 * nb, np = n0 + (lane & 31);
        const float* colp;
        if (MODE == TR_PLAIN) colp = W0 + np;
        else if (MODE == TR_GU) { const int t = np >> 8, w = np & 255; colp = (w < 128 ? W0 : W1) + t * 128 + (w & 127); }
        else if (MODE == TR_WIN) colp = np < 1216 ? W0 + np : (np < 1280 ? nullptr : W0 + (np - 64));
        else if (MODE == TR_UQ) { const int h = np / 192, w = np % 192; colp = W0 + (w < 128 ? np : h * 192 + 128 + ((w - 128) >> 1) + ((w - 128) & 1) * 32); }
        else colp = np < 1024 ? W0 + np : W1 + (np - 1024);
        float tv[32];
#pragma unroll
        for (int i = 0; i < 32; ++i) { const int kk = 2 * i + (lane >> 5); tv[i] = colp ? colp[(size_t)(k0 + kk) * Nsrc] : 0.f; }
#pragma unroll
        for (int i = 0; i < 32; ++i) { const int kk = 2 * i + (lane >> 5); scr[kk * 33 + (lane & 31)] = tv[i]; }
        asm volatile("s_waitcnt lgkmcnt(0)" ::: "memory");
        const int c = lane & 7;
#pragma unroll
        for (int j = 0; j < 4; ++j) { const int n = (lane >> 3) + 8 * j; const LAS float* s = scr + (8 * c) * 33 + n;
            u32x4 o; o.x = cvt_pk_bf16(s[0 * 33], s[1 * 33]); o.y = cvt_pk_bf16(s[2 * 33], s[3 * 33]); o.z = cvt_pk_bf16(s[4 * 33], s[5 * 33]); o.w = cvt_pk_bf16(s[6 * 33], s[7 * 33]);
            *(u32x4*)(WT + (size_t)(n0 + n) * K + k0 + 8 * c) = o; }
        asm volatile("s_waitcnt lgkmcnt(0)" ::: "memory");
    }
}

template <int MODE>
__device__ __forceinline__ void rows_phase(const float* xin, const bf16_t* f, float wt, const float* gpost, const float* gnext, float* xout, bf16_t* xn, int gw, int NGW, int lane) {
    for (int row0 = gw; row0 < M; row0 += 2 * NGW) {
        f32x4 xv[2][4]; u32x2 fw[2][4];
#pragma unroll
        for (int r = 0; r < 2; ++r) { const size_t row = (size_t)(row0 + r * NGW);
#pragma unroll
            for (int j = 0; j < 4; ++j) { xv[r][j] = *(const f32x4*)(xin + row * DM + 4 * (lane + 64 * j));
                if (MODE != 0) fw[r][j] = *(const u32x2*)(f + row * DM + 4 * (lane + 64 * j)); } }
#pragma unroll
        for (int r = 0; r < 2; ++r) { const size_t row = (size_t)(row0 + r * NGW);
            if (MODE != 0) {
                f32x4 fv[4]; float ss = 0.f;
#pragma unroll
                for (int j = 0; j < 4; ++j) { fv[j] = (f32x4){bf_lo(fw[r][j].x), bf_hi(fw[r][j].x), bf_lo(fw[r][j].y), bf_hi(fw[r][j].y)}; ss += fv[j].x * fv[j].x + fv[j].y * fv[j].y + fv[j].z * fv[j].z + fv[j].w * fv[j].w; }
                const float rr = wt * __builtin_amdgcn_rsqf(wave_sum(ss) * (1.f / DM) + EPS);
#pragma unroll
                for (int j = 0; j < 4; ++j) { const f32x4 g = *(const f32x4*)(gpost + 4 * (lane + 64 * j)); xv[r][j] = xv[r][j] + fv[j] * g * rr; }
                if (MODE == 1) {
#pragma unroll
                    for (int j = 0; j < 4; ++j) *(f32x4*)(xout + row * DM + 4 * (lane + 64 * j)) = xv[r][j];
                }
            }
            float s2 = 0.f;
#pragma unroll
            for (int j = 0; j < 4; ++j) s2 += xv[r][j].x * xv[r][j].x + xv[r][j].y * xv[r][j].y + xv[r][j].z * xv[r][j].z + xv[r][j].w * xv[r][j].w;
            const float r2 = __builtin_amdgcn_rsqf(wave_sum(s2) * (1.f / DM) + EPS);
#pragma unroll
            for (int j = 0; j < 4; ++j) { const f32x4 g = *(const f32x4*)(gnext + 4 * (lane + 64 * j)); const f32x4 y = xv[r][j] * g * r2;
                if (MODE == 2) *(f32x4*)(xout + row * DM + 4 * (lane + 64 * j)) = y;
                else { u32x2 w; w.x = cvt_pk_bf16(y.x, y.y); w.y = cvt_pk_bf16(y.z, y.w); *(u32x2*)(xn + row * DM + 4 * (lane + 64 * j)) = w; } }
        }
    }
}

__global__ void __launch_bounds__(NTHREADS, 2) fwd_megakernel(Params p) {
    extern __shared__ __attribute__((aligned(16))) unsigned char lds[];
    cg::grid_group grid = cg::this_grid();
    volatile LAS unsigned* bst = (volatile LAS unsigned*)((LAS unsigned char*)lds + LDS_STAGE);
    if (threadIdx.x < 2) bst[threadIdx.x] = 0u;
    __syncthreads();
    const XcdBarrier xbar = xcd_barrier_post((unsigned*)(p.ws + OFF_BAR), bst);
#define GRID_SYNC_CG() do { __builtin_amdgcn_fence(__ATOMIC_RELEASE, "agent"); asm volatile("s_waitcnt vmcnt(0)" ::: "memory"); grid.sync(); \
        __builtin_amdgcn_fence(__ATOMIC_ACQUIRE, "agent"); asm volatile("s_waitcnt vmcnt(0)" ::: "memory"); } while (0)
#define GRID_SYNC() xcd_barrier(xbar)
    const int G = gridDim.x, bid = blockIdx.x, NGW = G * NWAVES;
    LAS unsigned char* ldsl = (LAS unsigned char*)lds;
#define PHASE_IDS() const int tid = fresh_tid(), lane = tid & 63, wave = tid >> 6, gw = bid * NWAVES + wave; LAS float* scr = (LAS float*)(ldsl + wave * 8448); (void)scr; (void)gw; (void)lane
    unsigned char* ws = p.ws;
    bf16_t* Wgu = (bf16_t*)(ws + OFF_WGU); bf16_t* Wd = (bf16_t*)(ws + OFF_WD); bf16_t* Win = (bf16_t*)(ws + OFF_WIN); bf16_t* Wuq = (bf16_t*)(ws + OFF_WUQ);
    bf16_t* Wukv = (bf16_t*)(ws + OFF_WUKV); bf16_t* Woa = (bf16_t*)(ws + OFF_WOA); bf16_t* Wp = (bf16_t*)(ws + OFF_WP); bf16_t* Wout = (bf16_t*)(ws + OFF_WOUT);
    bf16_t* XN = (bf16_t*)(ws + OFF_XN); bf16_t* F = (bf16_t*)(ws + OFF_F); float* ZF = (float*)(ws + OFF_ZF); bf16_t* KV = (bf16_t*)(ws + OFF_KV);
    bf16_t* H = (bf16_t*)(ws + OFF_H); bf16_t* O = (bf16_t*)(ws + OFF_O); bf16_t* CQN = (bf16_t*)(ws + OFF_CQN); bf16_t* CKVN = (bf16_t*)(ws + OFF_CKVN);
    float* TAB = (float*)(ws + OFF_TAB); bf16_t* Q = (bf16_t*)(ws + OFF_Q); bf16_t* KR = (bf16_t*)(ws + OFF_KR); bf16_t* Gt = (bf16_t*)(ws + OFF_G); bf16_t* DP = (bf16_t*)(ws + OFF_DP);
    float* X = p.out;
    float* xbuf0 = (float*)(ws + OFF_XBUF); unsigned* cnt0 = (unsigned*)(ws + OFF_CNT);

    { PHASE_IDS();
    tr_job<TR_GU>(p.f1_wg, p.f1_wu, 1024, DFF, 5632, Wgu, scr, lane, gw, NGW);
    rows_phase<0>(p.x, nullptr, 0.f, nullptr, p.f1_pre, nullptr, XN, gw, NGW, lane); }
    if (__builtin_expect(p.out == nullptr, 0)) GRID_SYNC_CG();
    GRID_SYNC();

    pg8::StaticOrder S;
    { pg8::Gemm g{XN, Wgu, M, 5632, 1024}; S.init(M, 5632, G, bid); pg8::EpiSwiGLU E{H}; pg8::gemm_phase(ldsl, g, S, E); }
    {
        const int tail0 = (64 * 22) % G;
        if (tail0 != 0 && bid >= tail0) { PHASE_IDS(); const int tb = bid - tail0, nb = G - tail0, tgw = tb * NWAVES + wave, TNGW = nb * NWAVES;
            tr_job<TR_PLAIN>(p.f1_wd, nullptr, DFF, 1024, 1024, Wd, scr, lane, tgw, TNGW);
            tr_job<TR_WIN>(p.w_in, nullptr, 1024, INW, 3328, Win, scr, lane, tgw, TNGW);
            tr_job<TR_UQ>(p.w_uq, nullptr, QL, 1536, 1536, Wuq, scr, lane, tgw, TNGW);
            tr_job<TR_UKV>(p.w_uk, p.w_uv, KVL, 1024, 2048, Wukv, scr, lane, tgw, TNGW);
    }
        else if (tail0 == 0) { PHASE_IDS(); const int tb = bid, nb = G;
            tr_job<TR_PLAIN>(p.f1_wd, nullptr, DFF, 1024, 1024, Wd, scr, lane, gw, NGW);
            tr_job<TR_WIN>(p.w_in, nullptr, 1024, INW, 3328, Win, scr, lane, gw, NGW);
            tr_job<TR_UQ>(p.w_uq, nullptr, QL, 1536, 1536, Wuq, scr, lane, gw, NGW);
            tr_job<TR_UKV>(p.w_uk, p.w_uv, KVL, 1024, 2048, Wukv, scr, lane, gw, NGW);
    }
    }
    GRID_SYNC();
    { pg8::Gemm g{H, Wd, M, 1024, DFF}; S.init(M, 1024, G, bid);
      pg8::EpiResNorm<false, true> E{p.x, (bf16_t*)X, nullptr, XN, 0.5f, p.f1_post, p.mix_pre, pg8::PanelSumSq{xbuf0, cnt0}, pg8::PanelSumSq{xbuf0 + (size_t)M * 4, cnt0 + 4096}}; pg8::gemm_phase(ldsl, g, S, E); }
    GRID_SYNC();
    { pg8::Gemm g{XN, Win, M, 1280, 1024}; S.init(M, 1280, G, bid); pg8::EpiBf16 E{(bf16_t*)ZF, 1280}; pg8::gemm_phase(ldsl, g, S, E); }
    {
        const int tail0 = (64 * 5) % G; PHASE_IDS();
        if (tail0 != 0 && bid >= tail0) { const int tgw = (bid - tail0) * NWAVES + wave, TNGW = (G - tail0) * NWAVES;
            tr_job<TR_GU>(p.f2_wg, p.f2_wu, 1024, DFF, 5632, Wgu, scr, lane, tgw, TNGW);
            tr_job<TR_PLAIN>(p.f2_wd, nullptr, DFF, 1024, 1024, Wd, scr, lane, tgw, TNGW); }
        else if (tail0 == 0) { tr_job<TR_GU>(p.f2_wg, p.f2_wu, 1024, DFF, 5632, Wgu, scr, lane, gw, NGW); tr_job<TR_PLAIN>(p.f2_wd, nullptr, DFF, 1024, 1024, Wd, scr, lane, gw, NGW); }
    }
    GRID_SYNC();
    { PHASE_IDS();
    const bf16_t* ZB = (const bf16_t*)ZF;
    const int t_g = lane >> 4, wnd = 2 << t_g;
    for (int k = 0; k < M / (NWAVES * 256); ++k) { const int row = gw * (M / (NWAVES * 256)) + k;
        const bf16_t* z = ZB + (size_t)row * 1280;
        const u32x4 qa = *(const u32x4*)(z + 8 * lane);
        u32x4 qb = (u32x4){0u, 0u, 0u, 0u}; if (lane < 16) qb = *(const u32x4*)(z + 512 + 8 * lane);
        const u32x4 pc = *(const u32x4*)(z + 704 + 8 * lane);
        float kx1 = 0.f, kx2 = 0.f; int pos = 0;
        if (lane < 32) { kx1 = bf_lo((unsigned)z[640 + lane]); kx2 = bf_lo((unsigned)z[672 + lane]); pos = p.pos[row]; }
        const int t = row & (SEQ - 1), lo = max(t - (wnd >> 1), 0), hi = min(t + wnd - (wnd >> 1), SEQ);
        float sacc[8];
#pragma unroll
        for (int i = 0; i < 8; ++i) sacc[i] = 0.f;
#pragma unroll
        for (int hb = 0; hb < 2; ++hb) { u32x4 nb[8]; float wv[8];
#pragma unroll
            for (int d = 0; d < 8; ++d) { const int tt = t - 8 + hb * 8 + d; const bool ok = (tt >= lo) && (tt < hi); wv[d] = ok ? 1.f : 0.f;
                nb[d] = *(const u32x4*)(z + 704 + 8 * lane + (long)(ok ? (tt - t) : 0) * 1280); }
#pragma unroll
            for (int d = 0; d < 8; ++d) { sacc[0] = fmaf(wv[d], bf_lo(nb[d].x), sacc[0]); sacc[1] = fmaf(wv[d], bf_hi(nb[d].x), sacc[1]); sacc[2] = fmaf(wv[d], bf_lo(nb[d].y), sacc[2]); sacc[3] = fmaf(wv[d], bf_hi(nb[d].y), sacc[3]);
                sacc[4] = fmaf(wv[d], bf_lo(nb[d].z), sacc[4]); sacc[5] = fmaf(wv[d], bf_hi(nb[d].z), sacc[5]); sacc[6] = fmaf(wv[d], bf_lo(nb[d].w), sacc[6]); sacc[7] = fmaf(wv[d], bf_hi(nb[d].w), sacc[7]); } }
        {
            const float inv = 1.f / (float)(hi - lo);
            u32x4 w; w.x = cvt_pk_bf16(sacc[0] * inv - bf_lo(pc.x), sacc[1] * inv - bf_hi(pc.x)); w.y = cvt_pk_bf16(sacc[2] * inv - bf_lo(pc.y), sacc[3] * inv - bf_hi(pc.y));
            w.z = cvt_pk_bf16(sacc[4] * inv - bf_lo(pc.z), sacc[5] * inv - bf_hi(pc.z)); w.w = cvt_pk_bf16(sacc[6] * inv - bf_lo(pc.w), sacc[7] * inv - bf_hi(pc.w));
            *(u32x4*)(DP + (size_t)row * 512 + 8 * lane) = w; }
        {
            float va[8] = {bf_lo(qa.x), bf_hi(qa.x), bf_lo(qa.y), bf_hi(qa.y), bf_lo(qa.z), bf_hi(qa.z), bf_lo(qa.w), bf_hi(qa.w)};
            float vb[8] = {bf_lo(qb.x), bf_hi(qb.x), bf_lo(qb.y), bf_hi(qb.y), bf_lo(qb.z), bf_hi(qb.z), bf_lo(qb.w), bf_hi(qb.w)};
            float sa = 0.f, sb = 0.f;
#pragma unroll
            for (int i = 0; i < 8; ++i) { sa = fmaf(va[i], va[i], sa); sb = fmaf(vb[i], vb[i], sb); }
            const float ssq = wave_sum(lane < 48 ? sa : 0.f), sskv = wave_sum((lane >= 48 ? sa : 0.f) + sb);
            const float rq = __builtin_amdgcn_rsqf(ssq * (1.f / QL) + EPS), rkv = __builtin_amdgcn_rsqf(sskv * (1.f / KVL) + EPS);
            const float* ga = lane < 48 ? p.qa_g + 8 * lane : p.kva_g + 8 * (lane - 48); const float ra = lane < 48 ? rq : rkv;
            const f32x4 g0 = *(const f32x4*)ga, g1 = *(const f32x4*)(ga + 4);
            u32x4 w; w.x = cvt_pk_bf16(va[0] * g0.x * ra, va[1] * g0.y * ra); w.y = cvt_pk_bf16(va[2] * g0.z * ra, va[3] * g0.w * ra); w.z = cvt_pk_bf16(va[4] * g1.x * ra, va[5] * g1.y * ra); w.w = cvt_pk_bf16(va[6] * g1.z * ra, va[7] * g1.w * ra);
            bf16_t* dst = lane < 48 ? CQN + (size_t)row * QL + 8 * lane : CKVN + (size_t)row * KVL + 8 * (lane - 48);
            *(u32x4*)dst = w;
            if (lane < 16) { const f32x4 h0 = *(const f32x4*)(p.kva_g + 128 + 8 * lane), h1 = *(const f32x4*)(p.kva_g + 132 + 8 * lane);
                u32x4 w2; w2.x = cvt_pk_bf16(vb[0] * h0.x * rkv, vb[1] * h0.y * rkv); w2.y = cvt_pk_bf16(vb[2] * h0.z * rkv, vb[3] * h0.w * rkv); w2.z = cvt_pk_bf16(vb[4] * h1.x * rkv, vb[5] * h1.y * rkv); w2.w = cvt_pk_bf16(vb[6] * h1.z * rkv, vb[7] * h1.w * rkv);
                *(u32x4*)(CKVN + (size_t)row * KVL + 128 + 8 * lane) = w2; }
        }
        if (lane < 32) {
            const float ang = (float)pos * p.inv_freq[lane];
            const double ad = (double)ang; const double kq = rint(ad * 0.15915494309189535); const float red = (float)(ad - kq * 6.283185307179586);
            const float cs = __cosf(red), sn = __sinf(red);
            TAB[(size_t)row * 64 + lane] = cs; TAB[(size_t)row * 64 + 32 + lane] = sn;
            *(unsigned*)(KR + (size_t)row * 64 + 2 * lane) = cvt_pk_bf16(kx1 * cs - kx2 * sn, kx2 * cs + kx1 * sn);
        }
    } }
    GRID_SYNC();
    { pg8::Gemm g{CQN, Wuq, M, 1536, QL}; S.init(M, 1536, G, bid); pg8::EpiQ E{Q, TAB}; pg8::gemm_phase(ldsl, g, S, E); }
    {
        const int tail0 = (64 * 6) % G;
        if (tail0 != 0 && bid >= tail0) { PHASE_IDS(); const int tb = bid - tail0, nb = G - tail0, tgw = tb * NWAVES + wave, TNGW = nb * NWAVES;
            tr_job<TR_PLAIN>(p.w_oa, nullptr, 1024, 1024, 1024, Woa, scr, lane, tgw, TNGW);
            tr_job<TR_PLAIN>(p.w_out, nullptr, 1024, 1024, 1024, Wout, scr, lane, tgw, TNGW);
    for (int idx = tb * NTHREADS + tid; idx < 65536; idx += nb * NTHREADS) {
            const int n = idx & 1023, c8 = idx >> 10, g = c8 >> 4, cb = (c8 & 15) * 8;
            float a[8];
    #pragma unroll
            for (int i = 0; i < 8; ++i) a[i] = 0.f;
            for (int j0 = 0; j0 < 128; j0 += 8) { float w[8]; f32x4 pw[8][2];
    #pragma unroll
                for (int jj = 0; jj < 8; ++jj) w[jj] = p.w_op[(size_t)(g * 128 + j0 + jj) * 1024 + n] * p.pool_scale[g * 128 + j0 + jj];
    #pragma unroll
                for (int i = 0; i < 8; ++i) { pw[i][0] = *(const f32x4*)(p.pool_w + (size_t)(g * 128 + cb + i) * 128 + j0); pw[i][1] = *(const f32x4*)(p.pool_w + (size_t)(g * 128 + cb + i) * 128 + j0 + 4); }
    #pragma unroll
                for (int i = 0; i < 8; ++i)
    #pragma unroll
                    for (int jj = 0; jj < 8; ++jj) a[i] = fmaf(pw[i][jj >> 2][jj & 3], w[jj], a[i]); }
            u32x4 o; o.x = cvt_pk_bf16(a[0], a[1]); o.y = cvt_pk_bf16(a[2], a[3]); o.z = cvt_pk_bf16(a[4], a[5]); o.w = cvt_pk_bf16(a[6], a[7]);
            *(u32x4*)(Wp + (size_t)n * 512 + c8 * 8) = o;
        }
        }
        else if (tail0 == 0) { PHASE_IDS(); const int tb = bid, nb = G;
            tr_job<TR_PLAIN>(p.w_oa, nullptr, 1024, 1024, 1024, Woa, scr, lane, gw, NGW);
            tr_job<TR_PLAIN>(p.w_out, nullptr, 1024, 1024, 1024, Wout, scr, lane, gw, NGW);
    for (int idx = tb * NTHREADS + tid; idx < 65536; idx += nb * NTHREADS) {
            const int n = idx & 1023, c8 = idx >> 10, g = c8 >> 4, cb = (c8 & 15) * 8;
            float a[8];
    #pragma unroll
            for (int i = 0; i < 8; ++i) a[i] = 0.f;
            for (int j0 = 0; j0 < 128; j0 += 8) { float w[8]; f32x4 pw[8][2];
    #pragma unroll
                for (int jj = 0; jj < 8; ++jj) w[jj] = p.w_op[(size_t)(g * 128 + j0 + jj) * 1024 + n] * p.pool_scale[g * 128 + j0 + jj];
    #pragma unroll
                for (int i = 0; i < 8; ++i) { pw[i][0] = *(const f32x4*)(p.pool_w + (size_t)(g * 128 + cb + i) * 128 + j0); pw[i][1] = *(const f32x4*)(p.pool_w + (size_t)(g * 128 + cb + i) * 128 + j0 + 4); }
    #pragma unroll
                for (int i = 0; i < 8; ++i)
    #pragma unroll
                    for (int jj = 0; jj < 8; ++jj) a[i] = fmaf(pw[i][jj >> 2][jj & 3], w[jj], a[i]); }
            u32x4 o; o.x = cvt_pk_bf16(a[0], a[1]); o.y = cvt_pk_bf16(a[2], a[3]); o.z = cvt_pk_bf16(a[4], a[5]); o.w = cvt_pk_bf16(a[6], a[7]);
            *(u32x4*)(Wp + (size_t)n * 512 + c8 * 8) = o;
        }
        }
    }
    { pg8::Gemm g{CKVN, Wukv, M, 2048, KVL}; S.init(M, 2048, G, bid); pg8::EpiBf16 E{KV, 2048}; pg8::gemm_phase(ldsl, g, S, E); }
    GRID_SYNC();
    {
        const int vcu = (bid & 7) * (G >> 3) + (bid >> 3);
        for (int it = vcu; it < NB * NH * (SEQ / 256); it += G) {
            const int qb = it & 7, h = (it >> 3) & 7, b = it >> 6;
            const size_t tok0 = (size_t)b * SEQ;
            att::attn_body(Q + (tok0 + qb * 256) * 1536 + h * 192, KV + tok0 * 2048 + h * 128, KR + tok0 * 64, KV + tok0 * 2048 + 1024 + h * 128,
                           O + (tok0 + qb * 256) * 1024 + h * 128, SEQ, (char*)lds);
            __syncthreads();
        }
    }
    GRID_SYNC();
    { pg8::Gemm g{XN, Win + (size_t)1280 * 1024, M, 2048, 1024}; pg8::GateOrder GO; GO.s.init(M, 1024, G, bid); pg8::EpiGate E{Gt}; pg8::gemm_phase(ldsl, g, GO, E); }
    { pg8::Gemm g{O, Woa, M, 1024, 1024}; S.init(M, 1024, G, bid); pg8::EpiT1 E{Gt, F}; pg8::gemm_phase(ldsl, g, S, E); }
    { pg8::Gemm g{DP, Wp, M, 1024, 512}; S.init(M, 1024, G, bid); pg8::EpiMX E{Gt, F, XN}; pg8::gemm_phase(ldsl, g, S, E); }
    GRID_SYNC();
    { pg8::Gemm g{XN, Wout, M, 1024, 1024}; S.init(M, 1024, G, bid);
      pg8::EpiResNorm<false, false> E{nullptr, (bf16_t*)X, nullptr, XN, 1.0f, p.mix_post, p.f2_pre, pg8::PanelSumSq{xbuf0 + (size_t)M * 8, cnt0 + 2 * 4096}, pg8::PanelSumSq{xbuf0 + (size_t)M * 12, cnt0 + 3 * 4096}}; pg8::gemm_phase(ldsl, g, S, E); }
    GRID_SYNC();
    { pg8::Gemm g{XN, Wgu, M, 5632, 1024}; S.init(M, 5632, G, bid); pg8::EpiSwiGLU E{H}; pg8::gemm_phase(ldsl, g, S, E); }
    GRID_SYNC();
    { pg8::Gemm g{H, Wd, M, 1024, DFF}; S.init(M, 1024, G, bid);
      pg8::EpiResNorm<true, false> E{nullptr, (bf16_t*)X, X, nullptr, 0.5f, p.f2_post, p.final_g, pg8::PanelSumSq{xbuf0 + (size_t)M * 16, cnt0 + 4 * 4096}, pg8::PanelSumSq{xbuf0 + (size_t)M * 20, cnt0 + 5 * 4096}}; pg8::gemm_phase(ldsl, g, S, E); }
}

extern "C" void kernel_launch(void* const* d_in, const int* in_sizes, int n_in, void* d_out, int out_size, void* d_ws, size_t ws_size, hipStream_t stream) {
    static int grid_blocks = 0;
    if (grid_blocks == 0) {
        if (n_in != 26 || in_sizes[0] != M * DM || out_size != M * DM || ws_size < WS_END) { fprintf(stderr, "kernel_launch: shape mismatch n_in %d in0 %d out %d ws %zu\n", n_in, n_in > 0 ? in_sizes[0] : -1, out_size, ws_size); grid_blocks = -1; return; }
        int dev = 0, cus = 0, per_cu = 0;
        (void)hipGetDevice(&dev);
        (void)hipDeviceGetAttribute(&cus, hipDeviceAttributeMultiprocessorCount, dev);
        if (hipFuncSetAttribute((const void*)fwd_megakernel, hipFuncAttributeMaxDynamicSharedMemorySize, LDS_BYTES) != hipSuccess) { fprintf(stderr, "kernel_launch: hipFuncSetAttribute failed\n"); grid_blocks = -1; return; }
        if (hipOccupancyMaxActiveBlocksPerMultiprocessor(&per_cu, (const void*)fwd_megakernel, NTHREADS, LDS_BYTES) != hipSuccess || per_cu < 1) { fprintf(stderr, "kernel_launch: occupancy query failed (%d)\n", per_cu); (void)hipGetLastError(); per_cu = 1; }
        grid_blocks = cus * 1;
        if (grid_blocks != 256) { fprintf(stderr, "kernel_launch: built for 256 CUs (one workgroup each), device has %d\n", cus); grid_blocks = -1; return; }
    }
    if (grid_blocks < 0) return;
    Params p{};
    p.x = (const float*)d_in[0]; p.pos = (const int*)d_in[1];
    p.f1_pre = (const float*)d_in[2]; p.f1_wg = (const float*)d_in[3]; p.f1_wu = (const float*)d_in[4]; p.f1_wd = (const float*)d_in[5]; p.f1_post = (const float*)d_in[6];
    p.mix_pre = (const float*)d_in[7]; p.w_in = (const float*)d_in[8]; p.qa_g = (const float*)d_in[9]; p.w_uq = (const float*)d_in[10]; p.kva_g = (const float*)d_in[11];
    p.w_uk = (const float*)d_in[12]; p.w_uv = (const float*)d_in[13]; p.w_oa = (const float*)d_in[14]; p.pool_w = (const float*)d_in[15]; p.pool_scale = (const float*)d_in[16];
    p.w_op = (const float*)d_in[17]; p.w_out = (const float*)d_in[18]; p.mix_post = (const float*)d_in[19];
    p.f2_pre = (const float*)d_in[20]; p.f2_wg = (const float*)d_in[21]; p.f2_wu = (const float*)d_in[22]; p.f2_wd = (const float*)d_in[23]; p.f2_post = (const float*)d_in[24]; p.final_g = (const float*)d_in[25];
    p.out = (float*)d_out; p.ws = (unsigned char*)d_ws;
    for (int i = 0; i < 32; ++i) p.inv_freq[i] = (float)pow(10000.0, -(2.0 * i) / 64.0);
    if (hipMemsetAsync((char*)d_ws + OFF_BAR, 0, CTL_BYTES, stream) != hipSuccess) { fprintf(stderr, "kernel_launch: memset failed\n"); return; }
    void* args[] = {&p};
    hipError_t e = hipLaunchCooperativeKernel((const void*)fwd_megakernel, dim3(grid_blocks), dim3(NTHREADS), args, LDS_BYTES, stream);
    if (e != hipSuccess) fprintf(stderr, "cooperative launch failed: %s (grid %d)\n", hipGetErrorString(e), grid_blocks);
}
```

```cpp
#include <hip/hip_runtime.h>
#include <hip/hip_cooperative_groups.h>
#include <cstdio>
#include <cmath>
#include <cstdint>
namespace cg = cooperative_groups;

#define LAS __attribute__((address_space(3)))
typedef unsigned short bf16_t;
typedef short bf16x8 __attribute__((ext_vector_type(8)));
typedef short s16x4 __attribute__((ext_vector_type(4)));
typedef float f32x2 __attribute__((ext_vector_type(2)));
typedef float f32x4 __attribute__((ext_vector_type(4)));
typedef float f32x16 __attribute__((ext_vector_type(16)));
typedef unsigned u32x4 __attribute__((ext_vector_type(4)));
typedef unsigned u32x2 __attribute__((ext_vector_type(2)));

constexpr int DM = 1024, NB = 8, SEQ = 2048, M = NB * SEQ, NH = 8, QL = 384, KVL = 256, DFF = 2816, INW = 3264;
constexpr float EPS = 1e-6f;
constexpr int NTHREADS = 512, NWAVES = 8;
constexpr int LDS_STAGE = 131072, LDS_BYTES = LDS_STAGE + 16;

constexpr size_t MiB = 1048576;
constexpr size_t OFF_WGU = 0;
constexpr size_t OFF_WD = OFF_WGU + (size_t)5632 * 1024 * 2;
constexpr size_t OFF_WIN = OFF_WD + (size_t)1024 * 2816 * 2;
constexpr size_t OFF_WUQ = OFF_WIN + (size_t)3328 * 1024 * 2;
constexpr size_t OFF_WUKV = OFF_WUQ + (size_t)1536 * 384 * 2;
constexpr size_t OFF_WOA = OFF_WUKV + (size_t)2048 * 256 * 2;
constexpr size_t OFF_WP = OFF_WOA + (size_t)1024 * 1024 * 2;
constexpr size_t OFF_WOUT = OFF_WP + (size_t)1024 * 512 * 2;
constexpr size_t OFF_XN = OFF_WOUT + (size_t)1024 * 1024 * 2;
constexpr size_t OFF_R = OFF_XN + 32 * MiB;
constexpr size_t OFF_F = OFF_R;
constexpr size_t OFF_ZF = OFF_R;
constexpr size_t OFF_KV = OFF_R;
constexpr size_t OFF_H = OFF_R + 64 * MiB;
constexpr size_t OFF_O = OFF_R + 64 * MiB;
constexpr size_t OFF_CQN = OFF_R + 80 * MiB;
constexpr size_t OFF_CKVN = OFF_R + 92 * MiB;
constexpr size_t OFF_TAB = OFF_R + 100 * MiB;
constexpr size_t OFF_Q = OFF_R + 104 * MiB;
constexpr size_t OFF_KR = OFF_R + 152 * MiB;
constexpr size_t OFF_G = OFF_R + 96 * MiB;
constexpr size_t OFF_DP = OFF_R + 176 * MiB;
constexpr size_t WS_END = OFF_R + 192 * MiB;
constexpr size_t OFF_BAR = WS_END, OFF_CNT = OFF_BAR + 16384, CTL_BYTES = 16384 + 6 * 16384, OFF_XBUF = OFF_BAR + CTL_BYTES;
static_assert(OFF_XBUF + 6 * (size_t)M * 16 <= 256 * MiB, "workspace");

struct Params {
    const float* x; const int* pos;
    const float *f1_pre, *f1_wg, *f1_wu, *f1_wd, *f1_post;
    const float *mix_pre, *w_in, *qa_g, *w_uq, *kva_g, *w_uk, *w_uv, *w_oa, *pool_w, *pool_scale, *w_op, *w_out, *mix_post;
    const float *f2_pre, *f2_wg, *f2_wu, *f2_wd, *f2_post, *final_g;
    float* out; unsigned char* ws;
    float inv_freq[32];
};

typedef __bf16 bf16x2_t __attribute__((ext_vector_type(2)));
__device__ __forceinline__ unsigned cvt_pk_bf16(float lo, float hi) { const f32x2 v = {lo, hi}; const bf16x2_t r = __builtin_convertvector(v, bf16x2_t); return __builtin_bit_cast(unsigned, r); }
__device__ __forceinline__ float bf_lo(unsigned w) { return __uint_as_float(w << 16); }
__device__ __forceinline__ float bf_hi(unsigned w) { return __uint_as_float(w & 0xffff0000u); }
__device__ __forceinline__ float sigmoidf_fast(float z) { return __builtin_amdgcn_rcpf(1.f + __builtin_amdgcn_exp2f(-1.4426950408889634f * z)); }
__device__ __forceinline__ int fresh_tid() { int t = threadIdx.x; asm volatile("" : "+v"(t)); return t; }
__device__ __forceinline__ float wave_sum(float v) {
#pragma unroll
    for (int o = 1; o < 64; o <<= 1) v += __shfl_xor(v, o);
    return v;
}

namespace pg8 {
constexpr int BM = 256, BK = 64, HALF = 128, HTB = HALF * BK * 2, STAGE_BYTES = 8 * HTB, NXCD = 8, WGM = 4;
__host__ __device__ __forceinline__ int lds_byte(int r, int c) { const int st = (r >> 4) * 2 + (c >> 5), rr = r & 15, cc = c & 31, ob = rr * 64 + cc * 2; return st * 1024 + (ob ^ (((ob >> 9) & 1) << 5)); }
__host__ __device__ __forceinline__ void stage_rc(int b, int& R, int& C) { const int st = b / 1024, sb = b % 1024, swz = sb ^ (((sb >> 9) & 1) << 5); R = (st >> 1) * 16 + swz / 64; C = (st & 1) * 32 + (swz % 64) / 2; }
__host__ __device__ __forceinline__ int perm32(int rho) { const int n = rho >> 4, i = rho & 15; return 8 * (i >> 2) + 4 * n + (i & 3); }
struct Unit { int pm, pn; };
struct Gemm { const bf16_t* A; const bf16_t* Bt; int M, N, K; };
struct StaticOrder {
    int nM, nN, nwg, G, c;
    __device__ void init(int M_, int N_, int G_, int c_) { nM = M_ / BM; nN = N_ / BM; nwg = nM * nN; G = G_; c = c_; }
    __device__ bool next(int i, Unit& u) const {
        const long L = (long)i * G + c; if (L >= nwg) return false;
        int wgid = (int)L; { const int q = nwg / NXCD, r = nwg % NXCD, xcd = wgid % NXCD, off = wgid / NXCD; wgid = (xcd < r ? xcd * (q + 1) : r * (q + 1) + (xcd - r) * q) + off; }
        const int nig = WGM * nN, gid = wgid / nig, fm = gid * WGM, gsz = (nM - fm) < WGM ? (nM - fm) : WGM;
        u.pm = fm + ((wgid % nig) % gsz); u.pn = (wgid % nig) / gsz; return true;
    }
};

struct GateOrder { StaticOrder s;
    __device__ bool next(int i, Unit& u) const { if (i >= 2) return false; Unit b; if (!s.next(0, b)) return false; u.pm = b.pm; u.pn = b.pn + 4 * i; return true; } };
template <class Epi, class Sched>
__device__ __forceinline__ void gemm_phase(LAS unsigned char* lds, const Gemm g, const Sched& S, const Epi& E) {
    const int tid = fresh_tid(), wid = __builtin_amdgcn_readfirstlane(tid >> 6), lane = tid & 63, wr = wid >> 2, wc = wid & 3, fr = lane & 15, fq = lane >> 4;
    const int K = g.K, nt = K / BK;
    unsigned voffA, voffB;
    { int R, C; stage_rc(tid * 16, R, C); const int Rb = Epi::PERM ? ((R & ~31) + perm32(R & 31)) : R;
      voffA = (unsigned)(R * K + C) * 2u; voffB = (unsigned)(Rb * K + C) * 2u; }
    const size_t rstep64 = (size_t)64 * K * 2;
    const size_t kstep = (size_t)(BK * 2);
    const size_t hstep = (size_t)HALF * K * 2;
    const size_t tstep = 2 * hstep;
    const unsigned ldsw = (unsigned)wid * 1024u;
    const int aoff = lds_byte(wr * 64 + fr, fq * 8), boff = lds_byte(wc * 32 + fr, fq * 8);
#define PG8_SA(b, h) (((b) * 2 + (h)) * HTB)
#define PG8_SB(b, h) ((4 + (b) * 2 + (h)) * HTB)
#define PG8_STAGE(bufoff, gbase, voff) do { _Pragma("unroll") for (int _i = 0; _i < 2; ++_i) \
        __builtin_amdgcn_global_load_lds((const unsigned*)((const char*)(gbase) + _i * rstep64 + (voff)), (LAS unsigned*)(lds + (bufoff) + ldsw + _i * 8192), 16, 0, 0); } while (0)
#define PG8_LDA(dst, b, h) do { _Pragma("unroll") for (int m = 0; m < 4; ++m) _Pragma("unroll") for (int k = 0; k < 2; ++k) dst[m][k] = *(const LAS bf16x8*)(lds + PG8_SA(b, h) + aoff + m * 2048 + k * 1024); } while (0)
#define PG8_LDB(dst, b, h) do { _Pragma("unroll") for (int n = 0; n < 2; ++n) _Pragma("unroll") for (int k = 0; k < 2; ++k) dst[n][k] = *(const LAS bf16x8*)(lds + PG8_SB(b, h) + boff + n * 2048 + k * 1024); } while (0)
#define PG8_MMA(ai, bj, At, Bt) do { __builtin_amdgcn_s_setprio(1); _Pragma("unroll") for (int m = 0; m < 4; ++m) _Pragma("unroll") for (int n = 0; n < 2; ++n) _Pragma("unroll") for (int k = 0; k < 2; ++k) \
        acc[ai][bj][m][n] = __builtin_amdgcn_mfma_f32_16x16x32_bf16(Bt[n][k], At[m][k], acc[ai][bj][m][n], 0, 0, 0); __builtin_amdgcn_s_setprio(0); } while (0)
#define PG8_WAIT_V(n) asm volatile("s_waitcnt vmcnt(" #n ")" ::: "memory")
#define PG8_WAIT_L(n) asm volatile("s_waitcnt lgkmcnt(" #n ")" ::: "memory")
#define PG8_BAR __builtin_amdgcn_s_barrier()
#define PG8_SCHED __builtin_amdgcn_sched_barrier(0)
    Unit cur, nxt; int ui = 0;
    if (!S.next(0, cur)) return;
    f32x4 acc[2][2][4][2];
#pragma unroll
    for (int a = 0; a < 2; ++a)
#pragma unroll
        for (int b = 0; b < 2; ++b)
#pragma unroll
            for (int m = 0; m < 4; ++m)
#pragma unroll
                for (int n = 0; n < 2; ++n) acc[a][b][m][n] = (f32x4){0.f, 0.f, 0.f, 0.f};
    bf16x8 At[4][2], B0[2][2], B1[2][2];
    const char* cA = (const char*)g.A + (size_t)cur.pm * tstep; const char* cB = (const char*)g.Bt + (size_t)cur.pn * tstep;
    PG8_STAGE(PG8_SB(0, 0), cB, voffB); PG8_STAGE(PG8_SA(0, 0), cA, voffA); PG8_STAGE(PG8_SB(0, 1), cB + hstep, voffB); PG8_STAGE(PG8_SA(0, 1), cA + hstep, voffA);
    if (wr == 1) PG8_BAR;
    PG8_WAIT_V(4); PG8_BAR;
    PG8_STAGE(PG8_SB(1, 0), cB + kstep, voffB); PG8_STAGE(PG8_SA(1, 0), cA + kstep, voffA); PG8_STAGE(PG8_SB(1, 1), cB + hstep + kstep, voffB);
    PG8_WAIT_V(6); PG8_BAR;
    for (;;) {
        const bool has_next = S.next(ui + 1, nxt);
        const char* nA = has_next ? (const char*)g.A + (size_t)nxt.pm * tstep : cA; const char* nB = has_next ? (const char*)g.Bt + (size_t)nxt.pn * tstep : cB;
        for (int t = 0; t < nt; t += 2) {
            const bool last = (t == nt - 2);
            const char* a1 = cA + (size_t)(t + 1) * kstep;
            const char* a2 = last ? nA : cA + (size_t)(t + 2) * kstep; const char* b2 = last ? nB : cB + (size_t)(t + 2) * kstep;
            const char* a3 = a2 + kstep; const char* b3 = b2 + kstep;
            PG8_LDB(B0, 0, 0); PG8_SCHED; PG8_LDA(At, 0, 0); PG8_STAGE(PG8_SA(1, 1), a1 + hstep, voffA);
            PG8_WAIT_L(8); PG8_BAR; PG8_WAIT_L(0); PG8_MMA(0, 0, At, B0); PG8_BAR; PG8_SCHED;
            PG8_LDB(B1, 0, 1); PG8_STAGE(PG8_SB(0, 0), b2, voffB);
            PG8_BAR; PG8_WAIT_L(0); PG8_MMA(0, 1, At, B1); PG8_BAR;
            PG8_LDA(At, 0, 1); PG8_STAGE(PG8_SA(0, 0), a2, voffA);
            PG8_BAR; PG8_WAIT_L(0); PG8_MMA(1, 0, At, B0); PG8_BAR; PG8_SCHED;
            PG8_STAGE(PG8_SB(0, 1), b2 + hstep, voffB);
            PG8_WAIT_V(6); PG8_BAR; PG8_MMA(1, 1, At, B1); PG8_BAR;
            PG8_LDB(B0, 1, 0); PG8_SCHED; PG8_LDA(At, 1, 0); PG8_STAGE(PG8_SA(0, 1), a2 + hstep, voffA);
            PG8_WAIT_L(8); PG8_BAR; PG8_WAIT_L(0); PG8_MMA(0, 0, At, B0); PG8_BAR; PG8_SCHED;
            PG8_LDB(B1, 1, 1); PG8_STAGE(PG8_SB(1, 0), b3, voffB);
            PG8_BAR; PG8_WAIT_L(0); PG8_MMA(0, 1, At, B1); PG8_BAR;
            PG8_LDA(At, 1, 1); PG8_STAGE(PG8_SA(1, 0), a3, voffA);
            PG8_BAR; PG8_WAIT_L(0); PG8_MMA(1, 0, At, B0); PG8_BAR; PG8_SCHED;
            PG8_STAGE(PG8_SB(1, 1), b3 + hstep, voffB);
            PG8_WAIT_V(6); PG8_BAR; PG8_MMA(1, 1, At, B1); PG8_BAR;
        }
        if constexpr (!Epi::AFTER_DRAIN) { const int t2 = fresh_tid(); E(acc, cur, wr, wc, t2 & 15, (t2 >> 4) & 3); }
        if (!has_next) break;
#pragma unroll
        for (int a = 0; a < 2; ++a)
#pragma unroll
            for (int b = 0; b < 2; ++b)
#pragma unroll
                for (int m = 0; m < 4; ++m)
#pragma unroll
                    for (int n = 0; n < 2; ++n) acc[a][b][m][n] = (f32x4){0.f, 0.f, 0.f, 0.f};
        cur = nxt; cA = nA; cB = nB; ++ui;
    }
    PG8_WAIT_V(0);
    if (wr == 0) PG8_BAR;
    PG8_BAR;
    if constexpr (Epi::AFTER_DRAIN) { const int t2 = fresh_tid(); E.fused(acc, cur, wr, wc, t2 & 15, (t2 >> 4) & 3, lds, t2 >> 6, t2 & 63); }
#undef PG8_SA
#undef PG8_SB
#undef PG8_STAGE
#undef PG8_LDA
#undef PG8_LDB
#undef PG8_MMA
#undef PG8_WAIT_V
#undef PG8_WAIT_L
#undef PG8_BAR
#undef PG8_SCHED
}

typedef f32x4 Acc[2][2][4][2];
struct EpiF32 {
    static constexpr bool PERM = false, AFTER_DRAIN = false;
    float* C; int ldc;
    __device__ __forceinline__ void operator()(const Acc& acc, const Unit& u, int wr, int wc, int fr, int fq) const {
        const int row0 = u.pm * BM + wr * 64 + fr, col0 = u.pn * BM + wc * 32 + 4 * fq;
#pragma unroll
        for (int ai = 0; ai < 2; ++ai)
#pragma unroll
            for (int m = 0; m < 4; ++m) { float* rowp = C + (size_t)(row0 + ai * HALF + m * 16) * ldc + col0;
#pragma unroll
                for (int bj = 0; bj < 2; ++bj)
#pragma unroll
                    for (int n = 0; n < 2; ++n) *(f32x4*)(rowp + bj * HALF + n * 16) = acc[ai][bj][m][n]; }
    }
};
struct EpiBf16 {
    static constexpr bool PERM = true, AFTER_DRAIN = false;
    bf16_t* O; int ldc;
    __device__ __forceinline__ void operator()(const Acc& acc, const Unit& u, int wr, int wc, int fr, int fq) const {
        const int row0 = u.pm * BM + wr * 64 + fr, col0 = u.pn * BM + wc * 32 + 8 * fq;
#pragma unroll
        for (int ai = 0; ai < 2; ++ai)
#pragma unroll
            for (int m = 0; m < 4; ++m) { bf16_t* rowp = O + (size_t)(row0 + ai * HALF + m * 16) * ldc + col0;
#pragma unroll
                for (int bj = 0; bj < 2; ++bj) { const f32x4 v0 = acc[ai][bj][m][0], v1 = acc[ai][bj][m][1];
                    u32x4 w; w.x = cvt_pk_bf16(v0[0], v0[1]); w.y = cvt_pk_bf16(v0[2], v0[3]); w.z = cvt_pk_bf16(v1[0], v1[1]); w.w = cvt_pk_bf16(v1[2], v1[3]);
                    *(u32x4*)(rowp + bj * HALF) = w; } }
    }
};
struct EpiSwiGLU {
    static constexpr bool PERM = true, AFTER_DRAIN = false;
    bf16_t* H;
    __device__ __forceinline__ void operator()(const Acc& acc, const Unit& u, int wr, int wc, int fr, int fq) const {
        const int row0 = u.pm * BM + wr * 64 + fr, col0 = u.pn * HALF + wc * 32 + 8 * fq;
#pragma unroll
        for (int ai = 0; ai < 2; ++ai)
#pragma unroll
            for (int m = 0; m < 4; ++m) { bf16_t* rowp = H + (size_t)(row0 + ai * HALF + m * 16) * DFF + col0;
                float h[8];
#pragma unroll
                for (int n = 0; n < 2; ++n)
#pragma unroll
                    for (int j = 0; j < 4; ++j) { const float gt = acc[ai][0][m][n][j], up = acc[ai][1][m][n][j]; h[n * 4 + j] = gt * sigmoidf_fast(gt) * up; }
                u32x4 w; w.x = cvt_pk_bf16(h[0], h[1]); w.y = cvt_pk_bf16(h[2], h[3]); w.z = cvt_pk_bf16(h[4], h[5]); w.w = cvt_pk_bf16(h[6], h[7]);
                *(u32x4*)rowp = w; }
    }
};
struct EpiGate {
    static constexpr bool PERM = true, AFTER_DRAIN = false;
    bf16_t* G;
    __device__ __forceinline__ void operator()(const Acc& acc, const Unit& u, int wr, int wc, int fr, int fq) const {
        const int row0 = u.pm * BM + wr * 64 + fr, col0 = u.pn * BM + wc * 32 + 8 * fq;
#pragma unroll
        for (int ai = 0; ai < 2; ++ai)
#pragma unroll
            for (int m = 0; m < 4; ++m) { bf16_t* rowp = G + (size_t)(row0 + ai * HALF + m * 16) * 2048 + col0;
#pragma unroll
                for (int bj = 0; bj < 2; ++bj) { const f32x4 v0 = acc[ai][bj][m][0], v1 = acc[ai][bj][m][1];
                    u32x4 w; w.x = cvt_pk_bf16(sigmoidf_fast(v0[0]), sigmoidf_fast(v0[1])); w.y = cvt_pk_bf16(sigmoidf_fast(v0[2]), sigmoidf_fast(v0[3]));
                    w.z = cvt_pk_bf16(sigmoidf_fast(v1[0]), sigmoidf_fast(v1[1])); w.w = cvt_pk_bf16(sigmoidf_fast(v1[2]), sigmoidf_fast(v1[3]));
                    *(u32x4*)(rowp + bj * HALF) = w; } }
    }
};
struct EpiQ {
    static constexpr bool PERM = true, AFTER_DRAIN = false;
    bf16_t* Q; const float* TAB;
    __device__ __forceinline__ void operator()(const Acc& acc, const Unit& u, int wr, int wc, int fr, int fq) const {
        const int row0 = u.pm * BM + wr * 64 + fr, col0 = u.pn * BM + wc * 32 + 8 * fq;
#pragma unroll
        for (int ai = 0; ai < 2; ++ai)
#pragma unroll
            for (int m = 0; m < 4; ++m) { const int row = row0 + ai * HALF + m * 16; bf16_t* rowp = Q + (size_t)row * 1536 + col0;
#pragma unroll
                for (int bj = 0; bj < 2; ++bj) { f32x4 v0 = acc[ai][bj][m][0], v1 = acc[ai][bj][m][1];
                    const int c = col0 + bj * HALF, w = c % 192;
                    if (w >= 128) { const int i0 = (w - 128) >> 1; const f32x4 cs = *(const f32x4*)(TAB + (size_t)row * 64 + i0), sn = *(const f32x4*)(TAB + (size_t)row * 64 + 32 + i0);
                        f32x4 r0, r1;
                        r0[0] = v0[0] * cs[0] - v0[1] * sn[0]; r0[1] = v0[1] * cs[0] + v0[0] * sn[0];
                        r0[2] = v0[2] * cs[1] - v0[3] * sn[1]; r0[3] = v0[3] * cs[1] + v0[2] * sn[1];
                        r1[0] = v1[0] * cs[2] - v1[1] * sn[2]; r1[1] = v1[1] * cs[2] + v1[0] * sn[2];
                        r1[2] = v1[2] * cs[3] - v1[3] * sn[3]; r1[3] = v1[3] * cs[3] + v1[2] * sn[3];
                        v0 = r0; v1 = r1; }
                    u32x4 wv; wv.x = cvt_pk_bf16(v0[0], v0[1]); wv.y = cvt_pk_bf16(v0[2], v0[3]); wv.z = cvt_pk_bf16(v1[0], v1[1]); wv.w = cvt_pk_bf16(v1[2], v1[3]);
                    *(u32x4*)(rowp + bj * HALF) = wv; } }
    }
};
struct EpiT1 {
    static constexpr bool PERM = true, AFTER_DRAIN = false;
    const bf16_t* G; bf16_t* F;
    __device__ __forceinline__ void operator()(const Acc& acc, const Unit& u, int wr, int wc, int fr, int fq) const {
        const int row0 = u.pm * BM + wr * 64 + fr, col0 = u.pn * BM + wc * 32 + 8 * fq;
#pragma unroll
        for (int ai = 0; ai < 2; ++ai)
#pragma unroll
            for (int m = 0; m < 4; ++m) { const int row = row0 + ai * HALF + m * 16;
#pragma unroll
                for (int bj = 0; bj < 2; ++bj) { const f32x4 v0 = acc[ai][bj][m][0], v1 = acc[ai][bj][m][1]; const int c = col0 + bj * HALF;
                    const u32x4 gw = *(const u32x4*)(G + (size_t)row * 2048 + c);
                    u32x4 wv;
                    wv.x = cvt_pk_bf16(v0[0] * bf_lo(gw.x), v0[1] * bf_hi(gw.x)); wv.y = cvt_pk_bf16(v0[2] * bf_lo(gw.y), v0[3] * bf_hi(gw.y));
                    wv.z = cvt_pk_bf16(v1[0] * bf_lo(gw.z), v1[1] * bf_hi(gw.z)); wv.w = cvt_pk_bf16(v1[2] * bf_lo(gw.w), v1[3] * bf_hi(gw.w));
                    *(u32x4*)(F + (size_t)row * 1024 + c) = wv; } }
    }
};
struct EpiMX {
    static constexpr bool PERM = true, AFTER_DRAIN = false;
    const bf16_t* G; const bf16_t* F; bf16_t* MX;
    __device__ __forceinline__ void operator()(const Acc& acc, const Unit& u, int wr, int wc, int fr, int fq) const {
        const int row0 = u.pm * BM + wr * 64 + fr, col0 = u.pn * BM + wc * 32 + 8 * fq;
#pragma unroll
        for (int ai = 0; ai < 2; ++ai)
#pragma unroll
            for (int m = 0; m < 4; ++m) { const int row = row0 + ai * HALF + m * 16;
#pragma unroll
                for (int bj = 0; bj < 2; ++bj) { const f32x4 v0 = acc[ai][bj][m][0], v1 = acc[ai][bj][m][1]; const int c = col0 + bj * HALF;
                    const u32x4 gw = *(const u32x4*)(G + (size_t)row * 2048 + 1024 + c);
                    const u32x4 tw = *(const u32x4*)(F + (size_t)row * 1024 + c);
                    u32x4 wv;
                    wv.x = cvt_pk_bf16(bf_lo(tw.x) + v0[0] * bf_lo(gw.x), bf_hi(tw.x) + v0[1] * bf_hi(gw.x)); wv.y = cvt_pk_bf16(bf_lo(tw.y) + v0[2] * bf_lo(gw.y), bf_hi(tw.y) + v0[3] * bf_hi(gw.y));
                    wv.z = cvt_pk_bf16(bf_lo(tw.z) + v1[0] * bf_lo(gw.z), bf_hi(tw.z) + v1[1] * bf_hi(gw.z)); wv.w = cvt_pk_bf16(bf_lo(tw.w) + v1[2] * bf_lo(gw.w), bf_hi(tw.w) + v1[3] * bf_hi(gw.w));
                    *(u32x4*)(MX + (size_t)row * 1024 + c) = wv; } }
    }
};

struct PanelSumSq {
    float* xbuf;
    unsigned* cnt;
    __device__ __forceinline__ void run(const Acc& v, const Unit& u, int wr, int wc, int fr, int fq, LAS unsigned char* lds, int wid, int lane) const {
        LAS float* P = (LAS float*)lds; LAS float* S = (LAS float*)(lds + 4096);
#pragma unroll
        for (int ai = 0; ai < 2; ++ai)
#pragma unroll
            for (int m = 0; m < 4; ++m) { float q = 0.f;
#pragma unroll
                for (int bj = 0; bj < 2; ++bj)
#pragma unroll
                    for (int n = 0; n < 2; ++n) { const f32x4 x = v[ai][bj][m][n]; q += (x[0] * x[0] + x[1] * x[1]) + (x[2] * x[2] + x[3] * x[3]); }
                q += __shfl_xor(q, 16); q += __shfl_xor(q, 32);
                if (fq == 0) P[(ai * HALF + wr * 64 + m * 16 + fr) * 4 + wc] = q; }
        asm volatile("s_waitcnt lgkmcnt(0)" ::: "memory"); __builtin_amdgcn_s_barrier(); asm volatile("" ::: "memory");
        const int row = wid * 32 + (lane & 31);
        if (lane < 32) { const float t = (P[row * 4 + 0] + P[row * 4 + 1]) + (P[row * 4 + 2] + P[row * 4 + 3]);
            __hip_atomic_store(xbuf + ((size_t)(u.pm * BM + row) * 4 + u.pn), t, __ATOMIC_RELAXED, __HIP_MEMORY_SCOPE_AGENT); }
        asm volatile("s_waitcnt vmcnt(0)" ::: "memory");
        if (lane == 0) __hip_atomic_fetch_add(cnt + 64 * u.pm, 1u, __ATOMIC_RELAXED, __HIP_MEMORY_SCOPE_AGENT);
        if (wid == 0) { unsigned sp = 0u;
            while ((unsigned)__builtin_amdgcn_readfirstlane(__hip_atomic_load(cnt + 64 * u.pm, __ATOMIC_RELAXED, __HIP_MEMORY_SCOPE_AGENT)) < 32u) { __builtin_amdgcn_s_sleep(1); if (++sp > (1u << 22)) break; }
            __builtin_amdgcn_fence(__ATOMIC_ACQUIRE, "agent"); }
        asm volatile("s_waitcnt vmcnt(0) lgkmcnt(0)" ::: "memory"); __builtin_amdgcn_s_barrier(); asm volatile("" ::: "memory");
        if (lane < 32) { const float* slot = xbuf + (size_t)(u.pm * BM + row) * 4; float tot = 0.f;
#pragma unroll
            for (int t = 0; t < 4; ++t) tot += __hip_atomic_load(slot + t, __ATOMIC_RELAXED, __HIP_MEMORY_SCOPE_AGENT);
            S[row] = __builtin_amdgcn_rsqf(tot * (1.f / 1024.f) + EPS); }
        asm volatile("s_waitcnt lgkmcnt(0)" ::: "memory"); __builtin_amdgcn_s_barrier(); asm volatile("" ::: "memory");
    }
};
template <bool FINAL, bool BASEF32> struct EpiResNorm {
    static constexpr bool PERM = true, AFTER_DRAIN = true;
    const float* basef; bf16_t* xb; float* outf; bf16_t* xn; float wt; const float* gpost; const float* gnext; PanelSumSq st1, st2;
    __device__ __forceinline__ void operator()(const Acc&, const Unit&, int, int, int, int) const {}
    __device__ __forceinline__ void fused(Acc& acc, const Unit& u, int wr, int wc, int fr, int fq, LAS unsigned char* lds, int wid, int lane) const {
        const LAS float* S = (const LAS float*)(lds + 4096);
        const int col0 = u.pn * BM + wc * 32 + 8 * fq;
        st1.run(acc, u, wr, wc, fr, fq, lds, wid, lane);
#pragma unroll
        for (int ai = 0; ai < 2; ++ai)
#pragma unroll
            for (int m = 0; m < 4; ++m) { const int r = ai * HALF + wr * 64 + m * 16 + fr; const float sr = S[r] * wt;
                const size_t off = (size_t)(u.pm * BM + r) * 1024 + col0, xoff = (size_t)u.pm * 524288 + 262144 + (size_t)r * 1024 + col0;
#pragma unroll
                for (int bj = 0; bj < 2; ++bj) { f32x4 b0, b1;
                    if (BASEF32) { b0 = *(const f32x4*)(basef + off + bj * HALF); b1 = *(const f32x4*)(basef + off + bj * HALF + 4); }
                    else { const u32x4 w = *(const u32x4*)(xb + xoff + bj * HALF); b0 = (f32x4){bf_lo(w.x), bf_hi(w.x), bf_lo(w.y), bf_hi(w.y)}; b1 = (f32x4){bf_lo(w.z), bf_hi(w.z), bf_lo(w.w), bf_hi(w.w)}; }
                    const f32x4 g0 = *(const f32x4*)(gpost + col0 + bj * HALF), g1 = *(const f32x4*)(gpost + col0 + bj * HALF + 4);
                    acc[ai][bj][m][0] = b0 + acc[ai][bj][m][0] * g0 * sr; acc[ai][bj][m][1] = b1 + acc[ai][bj][m][1] * g1 * sr; }
                asm volatile("" : "+v"(acc[ai][0][m][0]), "+v"(acc[ai][0][m][1]), "+v"(acc[ai][1][m][0]), "+v"(acc[ai][1][m][1]));
                if (m & 1) asm volatile("" ::: "memory"); }
        st2.run(acc, u, wr, wc, fr, fq, lds, wid, lane);
#pragma unroll
        for (int ai = 0; ai < 2; ++ai)
#pragma unroll
            for (int m = 0; m < 4; ++m) { const int r = ai * HALF + wr * 64 + m * 16 + fr; const float sr = S[r];
                const size_t off = (size_t)(u.pm * BM + r) * 1024 + col0, xoff = (size_t)u.pm * 524288 + 262144 + (size_t)r * 1024 + col0;
#pragma unroll
                for (int bj = 0; bj < 2; ++bj) { const f32x4 x0 = acc[ai][bj][m][0], x1 = acc[ai][bj][m][1];
                    const f32x4 g0 = *(const f32x4*)(gnext + col0 + bj * HALF), g1 = *(const f32x4*)(gnext + col0 + bj * HALF + 4); const f32x4 o0 = x0 * g0 * sr, o1 = x1 * g1 * sr;
                    if (FINAL) { *(f32x4*)(outf + off + bj * HALF) = o0; *(f32x4*)(outf + off + bj * HALF + 4) = o1; }
                    else { u32x4 wx; wx.x = cvt_pk_bf16(x0[0], x0[1]); wx.y = cvt_pk_bf16(x0[2], x0[3]); wx.z = cvt_pk_bf16(x1[0], x1[1]); wx.w = cvt_pk_bf16(x1[2], x1[3]); *(u32x4*)(xb + xoff + bj * HALF) = wx;
                           u32x4 w; w.x = cvt_pk_bf16(o0[0], o0[1]); w.y = cvt_pk_bf16(o0[2], o0[3]); w.z = cvt_pk_bf16(o1[0], o1[1]); w.w = cvt_pk_bf16(o1[2], o1[3]); *(u32x4*)(xn + off + bj * HALF) = w; } }
                asm volatile("" ::: "memory"); }
    }
};
}

namespace att {
constexpr int NW = 8, QBLK = 32, KVBLK = 64;
constexpr float SCALE = 0.07216878364870322f;
constexpr float THR = 8.f;
constexpr int LDQ = 1536, LDKV = 2048, LDKR = 64, LDO = 1024;
constexpr int SHM_V = 64 * 128 * 2, SHM_K = 64 * 128 * 2, SHM_R = 64 * 64 * 2;
constexpr int NQL = 4;
constexpr int OFF_V = 0, OFF_K = 2 * SHM_V, OFF_RP = OFF_K + 2 * SHM_K, OFF_WS = OFF_RP + 2 * SHM_R, OFF_QL = OFF_WS + NW * 64 * 4, SHM_ATTN = OFF_QL + NW * NQL * 1024;
static_assert(SHM_ATTN <= LDS_STAGE, "lds");
#define KSWZ(row, colB) ((row) * 256 + ((colB) ^ (((row) & 15) << 4)))
#define RSWZ(row, colB) ((row) * 128 + ((colB) ^ ((((row) >> 1) & 7) << 4)))
#define SBAR() __builtin_amdgcn_sched_barrier(0)
__device__ __forceinline__ int crow(int r, int hi) { return (r & 3) + 8 * (r >> 2) + 4 * hi; }
__device__ __forceinline__ bf16x8 ld8(const bf16_t* p) { return *reinterpret_cast<const bf16x8*>(p); }

__device__ __forceinline__ void partialSM(f32x16& p0, f32x16& p1, float& m_reg, float& mn, float& alpha) {
    constexpr float C = SCALE * 1.4426950408889634f;
    float pmax = p0[0];
#pragma unroll
    for (int r = 1; r < 16; ++r) pmax = fmaxf(pmax, p0[r]);
#pragma unroll
    for (int r = 0; r < 16; ++r) pmax = fmaxf(pmax, p1[r]);
    { auto rr = __builtin_amdgcn_permlane32_swap(__float_as_uint(pmax), __float_as_uint(pmax), false, false);
      pmax = fmaxf(__uint_as_float(rr[0]), __uint_as_float(rr[1])); }
    if (__builtin_expect(__all(pmax - m_reg <= THR / SCALE), 1)) { mn = m_reg; alpha = 1.f; }
    else { mn = fmaxf(m_reg, pmax); alpha = __builtin_amdgcn_exp2f((m_reg - mn) * C); m_reg = mn; }
    float mnC = -mn * C;
#pragma unroll
    for (int r = 0; r < 16; ++r) p0[r] = fmaf(p0[r], C, mnC);
#pragma unroll
    for (int r = 0; r < 16; ++r) p1[r] = fmaf(p1[r], C, mnC);
#pragma unroll
    for (int r = 0; r < 16; ++r) p0[r] = __builtin_amdgcn_exp2f(p0[r]);
}
__device__ __forceinline__ void finishSM(f32x16& p0, f32x16& p1, float alpha, float& l_reg, bf16x8& pa0, bf16x8& pa1, bf16x8& pa2, bf16x8& pa3) {
#pragma unroll
    for (int r = 0; r < 16; ++r) p1[r] = __builtin_amdgcn_exp2f(p1[r]);
    float ps = 0;
#pragma unroll
    for (int r = 0; r < 16; ++r) ps += p0[r];
#pragma unroll
    for (int r = 0; r < 16; ++r) ps += p1[r];
    { auto rr = __builtin_amdgcn_permlane32_swap(__float_as_uint(ps), __float_as_uint(ps), false, false);
      ps = __uint_as_float(rr[0]) + __uint_as_float(rr[1]); }
    l_reg = l_reg * alpha + ps;
#define PK4(P, BASE, OUT) do { unsigned a0 = cvt_pk_bf16(P[BASE + 0], P[BASE + 1]), a1 = cvt_pk_bf16(P[BASE + 2], P[BASE + 3]);   \
    unsigned b0 = cvt_pk_bf16(P[BASE + 4], P[BASE + 5]), b1 = cvt_pk_bf16(P[BASE + 6], P[BASE + 7]);                              \
    auto r0 = __builtin_amdgcn_permlane32_swap(a0, b0, false, false); auto r1 = __builtin_amdgcn_permlane32_swap(a1, b1, false, false); \
    u32x4 w = {r0[0], r1[0], r0[1], r1[1]}; OUT = *reinterpret_cast<bf16x8*>(&w); } while (0)
    PK4(p0, 0, pa0); PK4(p0, 8, pa1); PK4(p1, 0, pa2); PK4(p1, 8, pa3);
#undef PK4
}
__device__ __forceinline__ void qkt(f32x16& p0, f32x16& p1, const char* Ks, const char* Rs, const bf16x8* qr, const char* ql, int r32, int hi) {
    p0 = f32x16{}; p1 = f32x16{};
#pragma unroll
    for (int d0 = 0; d0 < 8; ++d0) { int cb = (d0 * 16 + hi * 8) * 2;
        bf16x8 b0 = *reinterpret_cast<const bf16x8*>(Ks + KSWZ(r32, cb));
        bf16x8 b1 = *reinterpret_cast<const bf16x8*>(Ks + KSWZ(32 + r32, cb));
        p0 = __builtin_amdgcn_mfma_f32_32x32x16_bf16(b0, qr[d0], p0, 0, 0, 0);
        p1 = __builtin_amdgcn_mfma_f32_32x32x16_bf16(b1, qr[d0], p1, 0, 0, 0); }
#pragma unroll
    for (int d0 = 0; d0 < 4; ++d0) { int cb = (d0 * 16 + hi * 8) * 2;
        bf16x8 b0 = *reinterpret_cast<const bf16x8*>(Rs + RSWZ(r32, cb));
        bf16x8 b1 = *reinterpret_cast<const bf16x8*>(Rs + RSWZ(32 + r32, cb));
        const bf16x8 qv = *reinterpret_cast<const bf16x8*>(ql + d0 * 1024);
        p0 = __builtin_amdgcn_mfma_f32_32x32x16_bf16(b0, qv, p0, 0, 0, 0);
        p1 = __builtin_amdgcn_mfma_f32_32x32x16_bf16(b1, qv, p1, 0, 0, 0); }
}
__device__ __forceinline__ int v_st(int k, int c) { const int kk = (k & ~0xC) | ((k & 4) << 1) | ((k & 8) >> 1); return ((kk >> 3) * 4 + (c >> 5)) * 512 + ((kk & 7) * 32 + (c & 31)) * 2; }
__device__ __forceinline__ int v_rd_base(int lane) { return ((lane & 3) << 3) | (((lane >> 2) & 3) << 6) | (((lane >> 4) & 1) << 5) | (((lane >> 5) & 1) << 8); }
constexpr int v_rd_off(int d0, int ks, int half) { return d0 * 512 + ks * 4096 + half * 2048; }
template <int OFF> __device__ __forceinline__ s16x4 tr_read(int vb) {
    s16x4 r; asm volatile("ds_read_b64_tr_b16 %0, %1 offset:%2" : "=&v"(r) : "v"(vb), "i"(OFF) : "memory"); return r;
}
template <int D0> __device__ __forceinline__ void pv_one(f32x16& od, int vb, bf16x8 pa0, bf16x8 pa1, bf16x8 pa2, bf16x8 pa3) {
    const s16x4 l0 = tr_read<v_rd_off(D0, 0, 0)>(vb), h0 = tr_read<v_rd_off(D0, 0, 1)>(vb), l1 = tr_read<v_rd_off(D0, 1, 0)>(vb), h1 = tr_read<v_rd_off(D0, 1, 1)>(vb);
    const s16x4 l2 = tr_read<v_rd_off(D0, 2, 0)>(vb), h2 = tr_read<v_rd_off(D0, 2, 1)>(vb), l3 = tr_read<v_rd_off(D0, 3, 0)>(vb), h3 = tr_read<v_rd_off(D0, 3, 1)>(vb);
    asm volatile("s_waitcnt lgkmcnt(0)" ::: "memory"); SBAR();
#define PK(L, H) (bf16x8){L[0], L[1], L[2], L[3], H[0], H[1], H[2], H[3]}
    od = __builtin_amdgcn_mfma_f32_32x32x16_bf16(pa0, PK(l0, h0), od, 0, 0, 0);
    od = __builtin_amdgcn_mfma_f32_32x32x16_bf16(pa1, PK(l1, h1), od, 0, 0, 0);
    od = __builtin_amdgcn_mfma_f32_32x32x16_bf16(pa2, PK(l2, h2), od, 0, 0, 0);
    od = __builtin_amdgcn_mfma_f32_32x32x16_bf16(pa3, PK(l3, h3), od, 0, 0, 0);
#undef PK
}
__device__ __forceinline__ void pv_d0(f32x16* o, int vb, bf16x8 pa0, bf16x8 pa1, bf16x8 pa2, bf16x8 pa3) {
    pv_one<0>(o[0], vb, pa0, pa1, pa2, pa3); pv_one<1>(o[1], vb, pa0, pa1, pa2, pa3); pv_one<2>(o[2], vb, pa0, pa1, pa2, pa3); pv_one<3>(o[3], vb, pa0, pa1, pa2, pa3);
}

__device__ __forceinline__ void attn_body(const bf16_t* __restrict__ Qb, const bf16_t* __restrict__ Kn, const bf16_t* __restrict__ Kr, const bf16_t* __restrict__ Vh,
                                          bf16_t* __restrict__ Ob, int seq, char* lds) {
    const int tid = fresh_tid(), wid = tid >> 6, lane = tid & 63, r32 = lane & 31, hi = lane >> 5;
    char* V_lds = lds + OFF_V; char* K_lds = lds + OFF_K; char* R_lds = lds + OFF_RP;
    float* ws = (float*)(lds + OFF_WS) + wid * 64; float* li_l = ws; float* al_l = ws + 32;
    float m_reg = -1e30f, l_reg = 0; f32x16 o[4] = {}; bf16x8 qr[8];
    char* ql = lds + OFF_QL + wid * (NQL * 1024) + lane * 16;
    const bf16_t* Qw = Qb + (long)(wid * QBLK + r32) * LDQ + hi * 8;
#pragma unroll
    for (int d0 = 0; d0 < 8; ++d0) qr[d0] = ld8(Qw + d0 * 16);
#pragma unroll
    for (int d0 = 0; d0 < NQL; ++d0) *reinterpret_cast<bf16x8*>(ql + d0 * 1024) = ld8(Qw + (8 + d0) * 16);
    const int sr = tid >> 4, sc = (tid & 15) * 8, vst0 = v_st(sr, sc), vst1 = v_st(32 + sr, sc);
    const int rr_ = tid >> 3, rc_ = (tid & 7) * 8;
    const int vb0 = (int)(uintptr_t)V_lds + v_rd_base(lane);
    bf16x8 vs0, vs1, ks0, ks1, rs0;
#define SLOAD(k0) do { vs0 = ld8(&Vh[(long)((k0) + sr) * LDKV + sc]); vs1 = ld8(&Vh[(long)((k0) + 32 + sr) * LDKV + sc]); \
    ks0 = ld8(&Kn[(long)((k0) + sr) * LDKV + sc]); ks1 = ld8(&Kn[(long)((k0) + 32 + sr) * LDKV + sc]); rs0 = ld8(&Kr[(long)((k0) + rr_) * LDKR + rc_]); } while (0)
#define SWRITE(b) do { *(bf16x8*)(V_lds + (b) * SHM_V + vst0) = vs0; *(bf16x8*)(V_lds + (b) * SHM_V + vst1) = vs1; int kc = sc * 2; \
    *(bf16x8*)(K_lds + (b) * SHM_K + KSWZ(sr, kc)) = ks0; *(bf16x8*)(K_lds + (b) * SHM_K + KSWZ(32 + sr, kc)) = ks1; \
    *(bf16x8*)(R_lds + (b) * SHM_R + RSWZ(rr_, rc_ * 2)) = rs0; } while (0)
#define RESC(a) do { if (__any((a) < 1.f)) { if (hi == 0) al_l[r32] = (a); asm volatile("s_waitcnt lgkmcnt(0)" ::: "memory"); \
    _Pragma("unroll") for (int d = 0; d < 4; ++d) _Pragma("unroll") for (int r = 0; r < 16; ++r) o[d][r] *= al_l[crow(r, hi)]; } } while (0)
    f32x16 pA0, pA1, pB0, pB1; float mnA, mnB, alA, alB; bf16x8 pa0, pa1, pa2, pa3; const int NT = seq / KVBLK;
    SLOAD(0); asm volatile("s_waitcnt vmcnt(0)" ::: "memory"); SWRITE(0); __syncthreads();
    qkt(pA0, pA1, K_lds, R_lds, qr, ql, r32, hi); partialSM(pA0, pA1, m_reg, mnA, alA);
    SLOAD(KVBLK);
    asm volatile("s_waitcnt vmcnt(0)" ::: "memory"); SWRITE(1); __syncthreads();
    for (int j = 1; j + 1 < NT; j += 2) {
        SBAR(); qkt(pB0, pB1, K_lds + SHM_K, R_lds + SHM_R, qr, ql, r32, hi);
        finishSM(pA0, pA1, alA, l_reg, pa0, pa1, pa2, pa3); SBAR();
        SLOAD((j + 1) * KVBLK); SBAR();
        pv_d0(o, vb0, pa0, pa1, pa2, pa3); partialSM(pB0, pB1, m_reg, mnB, alB);
        __syncthreads(); asm volatile("s_waitcnt vmcnt(0)" ::: "memory"); SWRITE(0);
        RESC(alB); __syncthreads();
        SBAR(); qkt(pA0, pA1, K_lds, R_lds, qr, ql, r32, hi);
        finishSM(pB0, pB1, alB, l_reg, pa0, pa1, pa2, pa3); SBAR();
        SLOAD((j + 2) * KVBLK); SBAR();
        pv_d0(o, vb0 + SHM_V, pa0, pa1, pa2, pa3); partialSM(pA0, pA1, m_reg, mnA, alA);
        __syncthreads(); asm volatile("s_waitcnt vmcnt(0)" ::: "memory"); SWRITE(1);
        RESC(alA); __syncthreads();
    }
    SBAR(); qkt(pB0, pB1, K_lds + SHM_K, R_lds + SHM_R, qr, ql, r32, hi);
    finishSM(pA0, pA1, alA, l_reg, pa0, pa1, pa2, pa3); SBAR();
    pv_d0(o, vb0, pa0, pa1, pa2, pa3); partialSM(pB0, pB1, m_reg, mnB, alB);
    __syncthreads(); RESC(alB);
    finishSM(pB0, pB1, alB, l_reg, pa0, pa1, pa2, pa3); SBAR();
    pv_d0(o, vb0 + SHM_V, pa0, pa1, pa2, pa3);
    if (hi == 0) li_l[r32] = l_reg; asm volatile("s_waitcnt lgkmcnt(0)" ::: "memory");
    float rli[16];
#pragma unroll
    for (int r = 0; r < 16; ++r) rli[r] = __builtin_amdgcn_rcpf(li_l[crow(r, hi)]);
    bf16_t* Ow = Ob + (long)(wid * QBLK) * LDO;
#pragma unroll
    for (int r = 0; r < 16; ++r) { int orow = crow(r, hi);
#pragma unroll
        for (int d0 = 0; d0 < 4; ++d0) { const float v = o[d0][r] * rli[r]; Ow[(long)orow * LDO + d0 * 32 + r32] = (bf16_t)(cvt_pk_bf16(v, v) & 0xffffu); } }
#undef SLOAD
#undef SWRITE
#undef RESC
}
}


#define XB_TMO      128
#define XB_XCNT(j)  (256  + 64 * (j))
#define XB_XSUB(j)  (1280 + 64 * (j))
#define XB_XGEN(j)  (2304 + 64 * (j))
#define XB_TOP      3328
#define XB_TOPGEN   3392
#define XCD_BAR_WORDS 3456
#define XB_SPIN_CAP (1u << 18)
__device__ __forceinline__ unsigned xb_ld(unsigned* p)              { return __hip_atomic_load(p, __ATOMIC_RELAXED, __HIP_MEMORY_SCOPE_AGENT); }
__device__ __forceinline__ unsigned xb_add(unsigned* p, unsigned v) { return __hip_atomic_fetch_add(p, v, __ATOMIC_RELAXED, __HIP_MEMORY_SCOPE_AGENT); }
__device__ __forceinline__ unsigned xb_xcc_id() { return (unsigned)__builtin_amdgcn_s_getreg((3 << 11) | 20) & 0xFu; }
#define XB_SPIN(cond, bar) do { unsigned _sp = 0; while (cond) { __builtin_amdgcn_s_sleep(1); \
    if ((++_sp & 255u) == 0u) { if (xb_ld(&(bar)[XB_TMO])) break; if (_sp > XB_SPIN_CAP) { atomicAdd(&(bar)[XB_TMO], 1u); break; } } } } while (0)
struct XcdBarrier { unsigned* bar; unsigned x; volatile LAS unsigned* st; };
__device__ __forceinline__ XcdBarrier xcd_barrier_post(unsigned* bar, volatile LAS unsigned* st) {
    XcdBarrier b; b.bar = bar; b.x = xb_xcc_id(); b.st = st;
    if (threadIdx.x == 0) (void)xb_add(&bar[XB_XCNT(b.x)], 1u);
    return b;
}
__device__ __forceinline__ void xcd_barrier_complete(unsigned* bar, unsigned x, unsigned& nloc, unsigned& nx) {
    const unsigned G = gridDim.x * gridDim.y * gridDim.z;
    unsigned sum, cnt, mine, sp = 0u;
    for (;;) {
        sum = 0u; cnt = 0u; mine = 0u;
#pragma unroll
        for (unsigned j = 0; j < 16; ++j) { const unsigned c = xb_ld(&bar[XB_XCNT(j)]); sum += c; cnt += (c > 0u) ? 1u : 0u; mine = (j == x) ? c : mine; }
        if (sum == G) break;
        __builtin_amdgcn_s_sleep(1);
        if ((++sp & 255u) == 0u) { if (xb_ld(&bar[XB_TMO])) break; if (sp > XB_SPIN_CAP) { atomicAdd(&bar[XB_TMO], 1u); break; } }
    }
    nloc = mine > 0u ? mine : 1u; nx = cnt > 0u ? cnt : 1u;
}
__device__ __forceinline__ void xcd_barrier(const XcdBarrier& b) {
    asm volatile("s_waitcnt vmcnt(0)" ::: "memory");
    __syncthreads();
    if (threadIdx.x == 0) {
        unsigned* bar = b.bar;
        __builtin_amdgcn_s_waitcnt(0);
        unsigned nloc = b.st[0], nx = b.st[1];
        if (nloc == 0u) { xcd_barrier_complete(bar, b.x, nloc, nx); b.st[0] = nloc; b.st[1] = nx; }
        const unsigned old = xb_add(&bar[XB_XSUB(b.x)], 1u);
        const unsigned gen = old / nloc;
        if (old + 1u == (gen + 1u) * nloc) {
            __builtin_amdgcn_fence(__ATOMIC_RELEASE, "agent");
            asm volatile("s_waitcnt vmcnt(0)" ::: "memory");
            const unsigned og = xb_add(&bar[XB_TOP], 1u);
            const unsigned tg = og / nx;
            if (og + 1u == (tg + 1u) * nx) xb_add(&bar[XB_TOPGEN], 1u);
            else XB_SPIN(xb_ld(&bar[XB_TOPGEN]) == tg, bar);
            __builtin_amdgcn_fence(__ATOMIC_ACQUIRE, "agent");
            xb_add(&bar[XB_XGEN(b.x)], 1u);
            asm volatile("s_waitcnt vmcnt(0)" ::: "memory");
        } else {
            XB_SPIN(xb_ld(&bar[XB_XGEN(b.x)]) == gen, bar);
            __builtin_amdgcn_fence(__ATOMIC_ACQUIRE, "agent");
            asm volatile("s_waitcnt vmcnt(0)" ::: "memory");
        }
    }
    __syncthreads();
}

enum { TR_PLAIN = 0, TR_GU = 1, TR_WIN = 2, TR_UQ = 3, TR_UKV = 4 };
template <int MODE>
__device__ __forceinline__ void tr_job(const float* W0, const float* W1, int K, int Nsrc, int Nout, bf16_t* WT, LAS float* scr, int lane, int gw, int NGW) {
    const int nblk = Nout / 32, nitems = (K / 64) * nblk;
    for (int it = gw; it < nitems; it += NGW) {
        const int kb = it / nblk, nb = it % nblk, k0 = 64 * kb, n0 = 32 * nb, np = n0 + (lane & 31);
        const float* colp;
        if (MODE == TR_PLAIN) colp = W0 + np;
        else if (MODE == TR_GU) { const int t = np >> 8, w = np & 255; colp = (w < 128 ? W0 : W1) + t * 128 + (w & 127); }
        else if (MODE == TR_WIN) colp = np < 1216 ? W0 + np : (np < 1280 ? nullptr : W0 + (np - 64));
        else if (MODE == TR_UQ) { const int h = np / 192, w = np % 192; colp = W0 + (w < 128 ? np : h * 192 + 128 + ((w - 128) >> 1) + ((w - 128) & 1) * 32); }
        else colp = np < 1024 ? W0 + np : W1 + (np - 1024);
        float tv[32];
#pragma unroll
        for (int i = 0; i < 32; ++i) { const int kk = 2 * i + (lane >> 5); tv[i] = colp ? colp[(size_t)(k0 + kk) * Nsrc] : 0.f; }
#pragma unroll
        for (int i = 0; i < 32; ++i) { const int kk = 2 * i + (lane >> 5); scr[kk * 33 + (lane & 31)] = tv[i]; }
        asm volatile("s_waitcnt lgkmcnt(0)" ::: "memory");
        const int c = lane & 7;
#pragma unroll
        for (int j = 0; j < 4; ++j) { const int n = (lane >> 3) + 8 * j; const LAS float* s = scr + (8 * c) * 33 + n;
            u32x4 o; o.x = cvt_pk_bf16(s[0 * 33], s[1 * 33]); o.y = cvt_pk_bf16(s[2 * 33], s[3 * 33]); o.z = cvt_pk_bf16(s[4 * 33], s[5 * 33]); o.w = cvt_pk_bf16(s[6 * 33], s[7 * 33]);
            *(u32x4*)(WT + (size_t)(n0 + n) * K + k0 + 8 * c) = o; }
        asm volatile("s_waitcnt lgkmcnt(0)" ::: "memory");
    }
}

__device__ __forceinline__ void norm_rows(const float* xin, const float* gnext, bf16_t* xn, int gw, int NGW, int lane) {
    for (int row0 = gw; row0 < M; row0 += 2 * NGW) {
        f32x4 xv[2][4];
#pragma unroll
        for (int r = 0; r < 2; ++r) { const size_t row = (size_t)(row0 + r * NGW);
#pragma unroll
            for (int j = 0; j < 2; ++j) { xv[r][2 * j] = *(const f32x4*)(xin + row * DM + 8 * (lane + 64 * j)); xv[r][2 * j + 1] = *(const f32x4*)(xin + row * DM + 8 * (lane + 64 * j) + 4); } }
#pragma unroll
        for (int r = 0; r < 2; ++r) { const size_t row = (size_t)(row0 + r * NGW);
            float s2 = 0.f;
#pragma unroll
            for (int j = 0; j < 4; ++j) s2 += xv[r][j].x * xv[r][j].x + xv[r][j].y * xv[r][j].y + xv[r][j].z * xv[r][j].z + xv[r][j].w * xv[r][j].w;
            const float r2 = __builtin_amdgcn_rsqf(wave_sum(s2) * (1.f / DM) + EPS);
#pragma unroll
            for (int j = 0; j < 2; ++j) { const f32x4 g0 = *(const f32x4*)(gnext + 8 * (lane + 64 * j)), g1 = *(const f32x4*)(gnext + 8 * (lane + 64 * j) + 4);
                const f32x4 y0 = xv[r][2 * j] * g0 * r2, y1 = xv[r][2 * j + 1] * g1 * r2;
                u32x4 w; w.x = cvt_pk_bf16(y0.x, y0.y); w.y = cvt_pk_bf16(y0.z, y0.w); w.z = cvt_pk_bf16(y1.x, y1.y); w.w = cvt_pk_bf16(y1.z, y1.w);
                *(u32x4*)(xn + row * DM + 8 * (lane + 64 * j)) = w; }
        }
    }
}

__global__ void __launch_bounds__(NTHREADS, 2) fwd_megakernel(Params p) {
    extern __shared__ __attribute__((aligned(16))) unsigned char lds[];
    cg::grid_group grid = cg::this_grid();
    volatile LAS unsigned* bst = (volatile LAS unsigned*)((LAS unsigned char*)lds + LDS_STAGE);
    if (threadIdx.x < 2) bst[threadIdx.x] = 0u;
    __syncthreads();
    const XcdBarrier xbar = xcd_barrier_post((unsigned*)(p.ws + OFF_BAR), bst);
#define GRID_SYNC_CG() do { __builtin_amdgcn_fence(__ATOMIC_RELEASE, "agent"); asm volatile("s_waitcnt vmcnt(0)" ::: "memory"); grid.sync(); \
        __builtin_amdgcn_fence(__ATOMIC_ACQUIRE, "agent"); asm volatile("s_waitcnt vmcnt(0)" ::: "memory"); } while (0)
#define GRID_SYNC() xcd_barrier(xbar)
    const int G = gridDim.x, bid = blockIdx.x, NGW = G * NWAVES;
    LAS unsigned char* ldsl = (LAS unsigned char*)lds;
#define PHASE_IDS() const int tid = fresh_tid(), lane = tid & 63, wave = tid >> 6, gw = bid * NWAVES + wave; LAS float* scr = (LAS float*)(ldsl + wave * 8448); (void)scr; (void)gw; (void)lane
    unsigned char* ws = p.ws;
    bf16_t* Wgu = (bf16_t*)(ws + OFF_WGU); bf16_t* Wd = (bf16_t*)(ws + OFF_WD); bf16_t* Win = (bf16_t*)(ws + OFF_WIN); bf16_t* Wuq = (bf16_t*)(ws + OFF_WUQ);
    bf16_t* Wukv = (bf16_t*)(ws + OFF_WUKV); bf16_t* Woa = (bf16_t*)(ws + OFF_WOA); bf16_t* Wp = (bf16_t*)(ws + OFF_WP); bf16_t* Wout = (bf16_t*)(ws + OFF_WOUT);
    bf16_t* XN = (bf16_t*)(ws + OFF_XN); bf16_t* F = (bf16_t*)(ws + OFF_F); float* ZF = (float*)(ws + OFF_ZF); bf16_t* KV = (bf16_t*)(ws + OFF_KV);
    bf16_t* H = (bf16_t*)(ws + OFF_H); bf16_t* O = (bf16_t*)(ws + OFF_O); bf16_t* CQN = (bf16_t*)(ws + OFF_CQN); bf16_t* CKVN = (bf16_t*)(ws + OFF_CKVN);
    float* TAB = (float*)(ws + OFF_TAB); bf16_t* Q = (bf16_t*)(ws + OFF_Q); bf16_t* KR = (bf16_t*)(ws + OFF_KR); bf16_t* Gt = (bf16_t*)(ws + OFF_G); bf16_t* DP = (bf16_t*)(ws + OFF_DP);
    float* X = p.out;
    float* xbuf0 = (float*)(ws + OFF_XBUF); unsigned* cnt0 = (unsigned*)(ws + OFF_CNT);

    { PHASE_IDS();
    tr_job<TR_GU>(p.f1_wg, p.f1_wu, 1024, DFF, 5632, Wgu, scr, lane, gw, NGW);
    norm_rows(p.x, p.f1_pre, XN, gw, NGW, lane); }
    if (__builtin_expect(p.out == nullptr, 0)) GRID_SYNC_CG();
    GRID_SYNC();

    pg8::StaticOrder S;
    { pg8::Gemm g{XN, Wgu, M, 5632, 1024}; S.init(M, 5632, G, bid); pg8::EpiSwiGLU E{H}; pg8::gemm_phase(ldsl, g, S, E); }
    {
        const int tail0 = (64 * 22) % G;
        if (tail0 != 0 && bid >= tail0) { PHASE_IDS(); const int tb = bid - tail0, nb = G - tail0, tgw = tb * NWAVES + wave, TNGW = nb * NWAVES;
            tr_job<TR_PLAIN>(p.f1_wd, nullptr, DFF, 1024, 1024, Wd, scr, lane, tgw, TNGW);
            tr_job<TR_WIN>(p.w_in, nullptr, 1024, INW, 3328, Win, scr, lane, tgw, TNGW);
            tr_job<TR_UQ>(p.w_uq, nullptr, QL, 1536, 1536, Wuq, scr, lane, tgw, TNGW);
            tr_job<TR_UKV>(p.w_uk, p.w_uv, KVL, 1024, 2048, Wukv, scr, lane, tgw, TNGW);
    }
        else if (tail0 == 0) { PHASE_IDS(); const int tb = bid, nb = G;
            tr_job<TR_PLAIN>(p.f1_wd, nullptr, DFF, 1024, 1024, Wd, scr, lane, gw, NGW);
            tr_job<TR_WIN>(p.w_in, nullptr, 1024, INW, 3328, Win, scr, lane, gw, NGW);
            tr_job<TR_UQ>(p.w_uq, nullptr, QL, 1536, 1536, Wuq, scr, lane, gw, NGW);
            tr_job<TR_UKV>(p.w_uk, p.w_uv, KVL, 1024, 2048, Wukv, scr, lane, gw, NGW);
    }
    }
    GRID_SYNC();
    { pg8::Gemm g{H, Wd, M, 1024, DFF}; S.init(M, 1024, G, bid);
      pg8::EpiResNorm<false, true> E{p.x, (bf16_t*)X, nullptr, XN, 0.5f, p.f1_post, p.mix_pre, pg8::PanelSumSq{xbuf0, cnt0}, pg8::PanelSumSq{xbuf0 + (size_t)M * 4, cnt0 + 4096}}; pg8::gemm_phase(ldsl, g, S, E); }
    GRID_SYNC();
    { pg8::Gemm g{XN, Win, M, 1280, 1024}; S.init(M, 1280, G, bid); pg8::EpiBf16 E{(bf16_t*)ZF, 1280}; pg8::gemm_phase(ldsl, g, S, E); }
    {
        const int tail0 = (64 * 5) % G; PHASE_IDS();
        if (tail0 != 0 && bid >= tail0) { const int tgw = (bid - tail0) * NWAVES + wave, TNGW = (G - tail0) * NWAVES;
            tr_job<TR_GU>(p.f2_wg, p.f2_wu, 1024, DFF, 5632, Wgu, scr, lane, tgw, TNGW);
            tr_job<TR_PLAIN>(p.f2_wd, nullptr, DFF, 1024, 1024, Wd, scr, lane, tgw, TNGW); }
        else if (tail0 == 0) { tr_job<TR_GU>(p.f2_wg, p.f2_wu, 1024, DFF, 5632, Wgu, scr, lane, gw, NGW); tr_job<TR_PLAIN>(p.f2_wd, nullptr, DFF, 1024, 1024, Wd, scr, lane, gw, NGW); }
    }
    GRID_SYNC();
    { PHASE_IDS();
    const bf16_t* ZB = (const bf16_t*)ZF;
    const int t_g = lane >> 4, wnd = 2 << t_g;
    for (int k = 0; k < M / (NWAVES * 256); ++k) { const int row = gw * (M / (NWAVES * 256)) + k;
        const bf16_t* z = ZB + (size_t)row * 1280;
        const u32x4 qa = *(const u32x4*)(z + 8 * lane);
        u32x4 qb = (u32x4){0u, 0u, 0u, 0u}; if (lane < 16) qb = *(const u32x4*)(z + 512 + 8 * lane);
        const u32x4 pc = *(const u32x4*)(z + 704 + 8 * lane);
        float kx1 = 0.f, kx2 = 0.f; int pos = 0;
        if (lane < 32) { kx1 = bf_lo((unsigned)z[640 + lane]); kx2 = bf_lo((unsigned)z[672 + lane]); pos = p.pos[row]; }
        const int t = row & (SEQ - 1), lo = max(t - (wnd >> 1), 0), hi = min(t + wnd - (wnd >> 1), SEQ);
        float sacc[8];
#pragma unroll
        for (int i = 0; i < 8; ++i) sacc[i] = 0.f;
#pragma unroll
        for (int hb = 0; hb < 2; ++hb) { u32x4 nb[8]; float wv[8];
#pragma unroll
            for (int d = 0; d < 8; ++d) { const int tt = t - 8 + hb * 8 + d; const bool ok = (tt >= lo) && (tt < hi); wv[d] = ok ? 1.f : 0.f;
                nb[d] = *(const u32x4*)(z + 704 + 8 * lane + (long)(ok ? (tt - t) : 0) * 1280); }
#pragma unroll
            for (int d = 0; d < 8; ++d) { sacc[0] = fmaf(wv[d], bf_lo(nb[d].x), sacc[0]); sacc[1] = fmaf(wv[d], bf_hi(nb[d].x), sacc[1]); sacc[2] = fmaf(wv[d], bf_lo(nb[d].y), sacc[2]); sacc[3] = fmaf(wv[d], bf_hi(nb[d].y), sacc[3]);
                sacc[4] = fmaf(wv[d], bf_lo(nb[d].z), sacc[4]); sacc[5] = fmaf(wv[d], bf_hi(nb[d].z), sacc[5]); sacc[6] = fmaf(wv[d], bf_lo(nb[d].w), sacc[6]); sacc[7] = fmaf(wv[d], bf_hi(nb[d].w), sacc[7]); } }
        {
            const float inv = 1.f / (float)(hi - lo);
            u32x4 w; w.x = cvt_pk_bf16(sacc[0] * inv - bf_lo(pc.x), sacc[1] * inv - bf_hi(pc.x)); w.y = cvt_pk_bf16(sacc[2] * inv - bf_lo(pc.y), sacc[3] * inv - bf_hi(pc.y));
            w.z = cvt_pk_bf16(sacc[4] * inv - bf_lo(pc.z), sacc[5] * inv - bf_hi(pc.z)); w.w = cvt_pk_bf16(sacc[6] * inv - bf_lo(pc.w), sacc[7] * inv - bf_hi(pc.w));
            *(u32x4*)(DP + (size_t)row * 512 + 8 * lane) = w; }
        {
            float va[8] = {bf_lo(qa.x), bf_hi(qa.x), bf_lo(qa.y), bf_hi(qa.y), bf_lo(qa.z), bf_hi(qa.z), bf_lo(qa.w), bf_hi(qa.w)};
            float vb[8] = {bf_lo(qb.x), bf_hi(qb.x), bf_lo(qb.y), bf_hi(qb.y), bf_lo(qb.z), bf_hi(qb.z), bf_lo(qb.w), bf_hi(qb.w)};
            float sa = 0.f, sb = 0.f;
#pragma unroll
            for (int i = 0; i < 8; ++i) { sa = fmaf(va[i], va[i], sa); sb = fmaf(vb[i], vb[i], sb); }
            const float ssq = wave_sum(lane < 48 ? sa : 0.f), sskv = wave_sum((lane >= 48 ? sa : 0.f) + sb);
            const float rq = __builtin_amdgcn_rsqf(ssq * (1.f / QL) + EPS), rkv = __builtin_amdgcn_rsqf(sskv * (1.f / KVL) + EPS);
            const float* ga = lane < 48 ? p.qa_g + 8 * lane : p.kva_g + 8 * (lane - 48); const float ra = lane < 48 ? rq : rkv;
            const f32x4 g0 = *(const f32x4*)ga, g1 = *(const f32x4*)(ga + 4);
            u32x4 w; w.x = cvt_pk_bf16(va[0] * g0.x * ra, va[1] * g0.y * ra); w.y = cvt_pk_bf16(va[2] * g0.z * ra, va[3] * g0.w * ra); w.z = cvt_pk_bf16(va[4] * g1.x * ra, va[5] * g1.y * ra); w.w = cvt_pk_bf16(va[6] * g1.z * ra, va[7] * g1.w * ra);
            bf16_t* dst = lane < 48 ? CQN + (size_t)row * QL + 8 * lane : CKVN + (size_t)row * KVL + 8 * (lane - 48);
            *(u32x4*)dst = w;
            if (lane < 16) { const f32x4 h0 = *(const f32x4*)(p.kva_g + 128 + 8 * lane), h1 = *(const f32x4*)(p.kva_g + 132 + 8 * lane);
                u32x4 w2; w2.x = cvt_pk_bf16(vb[0] * h0.x * rkv, vb[1] * h0.y * rkv); w2.y = cvt_pk_bf16(vb[2] * h0.z * rkv, vb[3] * h0.w * rkv); w2.z = cvt_pk_bf16(vb[4] * h1.x * rkv, vb[5] * h1.y * rkv); w2.w = cvt_pk_bf16(vb[6] * h1.z * rkv, vb[7] * h1.w * rkv);
                *(u32x4*)(CKVN + (size_t)row * KVL + 128 + 8 * lane) = w2; }
        }
        if (lane < 32) {
            const float ang = (float)pos * p.inv_freq[lane];
            const double ad = (double)ang; const double kq = rint(ad * 0.15915494309189535); const float red = (float)(ad - kq * 6.283185307179586);
            const float cs = __cosf(red), sn = __sinf(red);
            TAB[(size_t)row * 64 + lane] = cs; TAB[(size_t)row * 64 + 32 + lane] = sn;
            *(unsigned*)(KR + (size_t)row * 64 + 2 * lane) = cvt_pk_bf16(kx1 * cs - kx2 * sn, kx2 * cs + kx1 * sn);
        }
    } }
    GRID_SYNC();
    { pg8::Gemm g{CQN, Wuq, M, 1536, QL}; S.init(M, 1536, G, bid); pg8::EpiQ E{Q, TAB}; pg8::gemm_phase(ldsl, g, S, E); }
    {
        const int tail0 = (64 * 6) % G;
        if (tail0 != 0 && bid >= tail0) { PHASE_IDS(); const int tb = bid - tail0, nb = G - tail0, tgw = tb * NWAVES + wave, TNGW = nb * NWAVES;
            tr_job<TR_PLAIN>(p.w_oa, nullptr, 1024, 1024, 1024, Woa, scr, lane, tgw, TNGW);
            tr_job<TR_PLAIN>(p.w_out, nullptr, 1024, 1024, 1024, Wout, scr, lane, tgw, TNGW);
    for (int idx = tb * NTHREADS + tid; idx < 65536; idx += nb * NTHREADS) {
            const int n = idx & 1023, c8 = idx >> 10, g = c8 >> 4, cb = (c8 & 15) * 8;
            float a[8];
    #pragma unroll
            for (int i = 0; i < 8; ++i) a[i] = 0.f;
            for (int j0 = 0; j0 < 128; j0 += 8) { float w[8]; f32x4 pw[8][2];
    #pragma unroll
                for (int jj = 0; jj < 8; ++jj) w[jj] = p.w_op[(size_t)(g * 128 + j0 + jj) * 1024 + n] * p.pool_scale[g * 128 + j0 + jj];
    #pragma unroll
                for (int i = 0; i < 8; ++i) { pw[i][0] = *(const f32x4*)(p.pool_w + (size_t)(g * 128 + cb + i) * 128 + j0); pw[i][1] = *(const f32x4*)(p.pool_w + (size_t)(g * 128 + cb + i) * 128 + j0 + 4); }
    #pragma unroll
                for (int i = 0; i < 8; ++i)
    #pragma unroll
                    for (int jj = 0; jj < 8; ++jj) a[i] = fmaf(pw[i][jj >> 2][jj & 3], w[jj], a[i]); }
            u32x4 o; o.x = cvt_pk_bf16(a[0], a[1]); o.y = cvt_pk_bf16(a[2], a[3]); o.z = cvt_pk_bf16(a[4], a[5]); o.w = cvt_pk_bf16(a[6], a[7]);
            *(u32x4*)(Wp + (size_t)n * 512 + c8 * 8) = o;
        }
        }
        else if (tail0 == 0) { PHASE_IDS(); const int tb = bid, nb = G;
            tr_job<TR_PLAIN>(p.w_oa, nullptr, 1024, 1024, 1024, Woa, scr, lane, gw, NGW);
            tr_job<TR_PLAIN>(p.w_out, nullptr, 1024, 1024, 1024, Wout, scr, lane, gw, NGW);
    for (int idx = tb * NTHREADS + tid; idx < 65536; idx += nb * NTHREADS) {
            const int n = idx & 1023, c8 = idx >> 10, g = c8 >> 4, cb = (c8 & 15) * 8;
            float a[8];
    #pragma unroll
            for (int i = 0; i < 8; ++i) a[i] = 0.f;
            for (int j0 = 0; j0 < 128; j0 += 8) { float w[8]; f32x4 pw[8][2];
    #pragma unroll
                for (int jj = 0; jj < 8; ++jj) w[jj] = p.w_op[(size_t)(g * 128 + j0 + jj) * 1024 + n] * p.pool_scale[g * 128 + j0 + jj];
    #pragma unroll
                for (int i = 0; i < 8; ++i) { pw[i][0] = *(const f32x4*)(p.pool_w + (size_t)(g * 128 + cb + i) * 128 + j0); pw[i][1] = *(const f32x4*)(p.pool_w + (size_t)(g * 128 + cb + i) * 128 + j0 + 4); }
    #pragma unroll
                for (int i = 0; i < 8; ++i)
    #pragma unroll
                    for (int jj = 0; jj < 8; ++jj) a[i] = fmaf(pw[i][jj >> 2][jj & 3], w[jj], a[i]); }
            u32x4 o; o.x = cvt_pk_bf16(a[0], a[1]); o.y = cvt_pk_bf16(a[2], a[3]); o.z = cvt_pk_bf16(a[4], a[5]); o.w = cvt_pk_bf16(a[6], a[7]);
            *(u32x4*)(Wp + (size_t)n * 512 + c8 * 8) = o;
        }
        }
    }
    { pg8::Gemm g{CKVN, Wukv, M, 2048, KVL}; S.init(M, 2048, G, bid); pg8::EpiBf16 E{KV, 2048}; pg8::gemm_phase(ldsl, g, S, E); }
    GRID_SYNC();
    {
        const int vcu = (bid & 7) * (G >> 3) + (bid >> 3);
        for (int it = vcu; it < NB * NH * (SEQ / 256); it += G) {
            const int qb = it & 7, h = (it >> 3) & 7, b = it >> 6;
            const size_t tok0 = (size_t)b * SEQ;
            att::attn_body(Q + (tok0 + qb * 256) * 1536 + h * 192, KV + tok0 * 2048 + h * 128, KR + tok0 * 64, KV + tok0 * 2048 + 1024 + h * 128,
                           O + (tok0 + qb * 256) * 1024 + h * 128, SEQ, (char*)lds);
            __syncthreads();
        }
    }
    GRID_SYNC();
    { pg8::Gemm g{XN, Win + (size_t)1280 * 1024, M, 2048, 1024}; pg8::GateOrder GO; GO.s.init(M, 1024, G, bid); pg8::EpiGate E{Gt}; pg8::gemm_phase(ldsl, g, GO, E); }
    { pg8::Gemm g{O, Woa, M, 1024, 1024}; S.init(M, 1024, G, bid); pg8::EpiT1 E{Gt, F}; pg8::gemm_phase(ldsl, g, S, E); }
    { pg8::Gemm g{DP, Wp, M, 1024, 512}; S.init(M, 1024, G, bid); pg8::EpiMX E{Gt, F, XN}; pg8::gemm_phase(ldsl, g, S, E); }
    GRID_SYNC();
    { pg8::Gemm g{XN, Wout, M, 1024, 1024}; S.init(M, 1024, G, bid);
      pg8::EpiResNorm<false, false> E{nullptr, (bf16_t*)X, nullptr, XN, 1.0f, p.mix_post, p.f2_pre, pg8::PanelSumSq{xbuf0 + (size_t)M * 8, cnt0 + 2 * 4096}, pg8::PanelSumSq{xbuf0 + (size_t)M * 12, cnt0 + 3 * 4096}}; pg8::gemm_phase(ldsl, g, S, E); }
    GRID_SYNC();
    { pg8::Gemm g{XN, Wgu, M, 5632, 1024}; S.init(M, 5632, G, bid); pg8::EpiSwiGLU E{H}; pg8::gemm_phase(ldsl, g, S, E); }
    GRID_SYNC();
    { pg8::Gemm g{H, Wd, M, 1024, DFF}; S.init(M, 1024, G, bid);
      pg8::EpiResNorm<true, false> E{nullptr, (bf16_t*)X, X, nullptr, 0.5f, p.f2_post, p.final_g, pg8::PanelSumSq{xbuf0 + (size_t)M * 16, cnt0 + 4 * 4096}, pg8::PanelSumSq{xbuf0 + (size_t)M * 20, cnt0 + 5 * 4096}}; pg8::gemm_phase(ldsl, g, S, E); }
}

extern "C" void kernel_launch(void* const* d_in, const int* in_sizes, int n_in, void* d_out, int out_size, void* d_ws, size_t ws_size, hipStream_t stream) {
    static int grid_blocks = 0;
    if (grid_blocks == 0) {
        if (n_in != 26 || in_sizes[0] != M * DM || out_size != M * DM || ws_size < WS_END) { fprintf(stderr, "kernel_launch: shape mismatch n_in %d in0 %d out %d ws %zu\n", n_in, n_in > 0 ? in_sizes[0] : -1, out_size, ws_size); grid_blocks = -1; return; }
        int dev = 0, cus = 0, per_cu = 0;
        (void)hipGetDevice(&dev);
        (void)hipDeviceGetAttribute(&cus, hipDeviceAttributeMultiprocessorCount, dev);
        if (hipFuncSetAttribute((const void*)fwd_megakernel, hipFuncAttributeMaxDynamicSharedMemorySize, LDS_BYTES) != hipSuccess) { fprintf(stderr, "kernel_launch: hipFuncSetAttribute failed\n"); grid_blocks = -1; return; }
        if (hipOccupancyMaxActiveBlocksPerMultiprocessor(&per_cu, (const void*)fwd_megakernel, NTHREADS, LDS_BYTES) != hipSuccess || per_cu < 1) { fprintf(stderr, "kernel_launch: occupancy query failed (%d)\n", per_cu); (void)hipGetLastError(); per_cu = 1; }
        grid_blocks = cus * 1;
        if (grid_blocks != 256) { fprintf(stderr, "kernel_launch: built for 256 CUs (one workgroup each), device has %d\n", cus); grid_blocks = -1; return; }
    }
    if (grid_blocks < 0) return;
    Params p{};
    p.x = (const float*)d_in[0]; p.pos = (const int*)d_in[1];
    p.f1_pre = (const float*)d_in[2]; p.f1_wg = (const float*)d_in[3]; p.f1_wu = (const float*)d_in[4]; p.f1_wd = (const float*)d_in[5]; p.f1_post = (const float*)d_in[6];
    p.mix_pre = (const float*)d_in[7]; p.w_in = (const float*)d_in[8]; p.qa_g = (const float*)d_in[9]; p.w_uq = (const float*)d_in[10]; p.kva_g = (const float*)d_in[11];
    p.w_uk = (const float*)d_in[12]; p.w_uv = (const float*)d_in[13]; p.w_oa = (const float*)d_in[14]; p.pool_w = (const float*)d_in[15]; p.pool_scale = (const float*)d_in[16];
    p.w_op = (const float*)d_in[17]; p.w_out = (const float*)d_in[18]; p.mix_post = (const float*)d_in[19];
    p.f2_pre = (const float*)d_in[20]; p.f2_wg = (const float*)d_in[21]; p.f2_wu = (const float*)d_in[22]; p.f2_wd = (const float*)d_in[23]; p.f2_post = (const float*)d_in[24]; p.final_g = (const float*)d_in[25];
    p.out = (float*)d_out; p.ws = (unsigned char*)d_ws;
    for (int i = 0; i < 32; ++i) p.inv_freq[i] = (float)pow(10000.0, -(2.0 * i) / 64.0);
    if (hipMemsetAsync((char*)d_ws + OFF_BAR, 0, CTL_BYTES, stream) != hipSuccess) { fprintf(stderr, "kernel_launch: memset failed\n"); return; }
    void* args[] = {&p};
    hipError_t e = hipLaunchCooperativeKernel((const void*)fwd_megakernel, dim3(grid_blocks), dim3(NTHREADS), args, LDS_BYTES, stream);
    if (e != hipSuccess) fprintf(stderr, "cooperative launch failed: %s (grid %d)\n", hipGetErrorString(e), grid_blocks);
}
```

```cpp
#include <hip/hip_runtime.h>
#include <hip/hip_cooperative_groups.h>
#include <cstdio>
#include <cmath>
#include <cstdint>
namespace cg = cooperative_groups;

#define LAS __attribute__((address_space(3)))
typedef unsigned short bf16_t;
typedef short bf16x8 __attribute__((ext_vector_type(8)));
typedef short s16x4 __attribute__((ext_vector_type(4)));
typedef float f32x2 __attribute__((ext_vector_type(2)));
typedef float f32x4 __attribute__((ext_vector_type(4)));
typedef float f32x16 __attribute__((ext_vector_type(16)));
typedef unsigned u32x4 __attribute__((ext_vector_type(4)));
typedef unsigned u32x2 __attribute__((ext_vector_type(2)));

constexpr int DM = 1024, NB = 8, SEQ = 2048, M = NB * SEQ, NH = 8, QL = 384, KVL = 256, DFF = 2816, INW = 3264;
constexpr float EPS = 1e-6f;
constexpr int NTHREADS = 512, NWAVES = 8;
constexpr int LDS_STAGE = 131072, LDS_BYTES = LDS_STAGE + 16;

constexpr size_t MiB = 1048576;
constexpr size_t OFF_WGU = 0;
constexpr size_t OFF_WD = OFF_WGU + (size_t)5632 * 1024 * 2;
constexpr size_t OFF_WIN = OFF_WD + (size_t)1024 * 2816 * 2;
constexpr size_t OFF_WUQ = OFF_WIN + (size_t)3328 * 1024 * 2;
constexpr size_t OFF_WUKV = OFF_WUQ + (size_t)1536 * 384 * 2;
constexpr size_t OFF_WOA = OFF_WUKV + (size_t)2048 * 256 * 2;
constexpr size_t OFF_WP = OFF_WOA + (size_t)1024 * 1024 * 2;
constexpr size_t OFF_WOUT = OFF_WP + (size_t)1024 * 512 * 2;
constexpr size_t OFF_XN = OFF_WOUT + (size_t)1024 * 1024 * 2;
constexpr size_t OFF_R = OFF_XN + 32 * MiB;
constexpr size_t OFF_F = OFF_R;
constexpr size_t OFF_ZF = OFF_R;
constexpr size_t OFF_KV = OFF_R;
constexpr size_t OFF_H = OFF_R + 64 * MiB;
constexpr size_t OFF_O = OFF_R + 64 * MiB;
constexpr size_t OFF_CQN = OFF_R + 80 * MiB;
constexpr size_t OFF_CKVN = OFF_R + 92 * MiB;
constexpr size_t OFF_TAB = OFF_R + 100 * MiB;
constexpr size_t OFF_Q = OFF_R + 104 * MiB;
constexpr size_t OFF_KR = OFF_R + 152 * MiB;
constexpr size_t OFF_G = OFF_R + 96 * MiB;
constexpr size_t OFF_DP = OFF_R + 176 * MiB;
constexpr size_t WS_END = OFF_R + 192 * MiB;
constexpr size_t OFF_BAR = WS_END, OFF_CNT = OFF_BAR + 16384, CTL_BYTES = 16384 + 6 * 16384, OFF_XBUF = OFF_BAR + CTL_BYTES;
static_assert(OFF_XBUF + 6 * (size_t)M * 16 <= 256 * MiB, "workspace");

struct Params {
    const float* x; const int* pos;
    const float *f1_pre, *f1_wg, *f1_wu, *f1_wd, *f1_post;
    const float *mix_pre, *w_in, *qa_g, *w_uq, *kva_g, *w_uk, *w_uv, *w_oa, *pool_w, *pool_scale, *w_op, *w_out, *mix_post;
    const float *f2_pre, *f2_wg, *f2_wu, *f2_wd, *f2_post, *final_g;
    float* out; unsigned char* ws;
    float inv_freq[32];
};

typedef __bf16 bf16x2_t __attribute__((ext_vector_type(2)));
__device__ __forceinline__ unsigned cvt_pk_bf16(float lo, float hi) { const f32x2 v = {lo, hi}; const bf16x2_t r = __builtin_convertvector(v, bf16x2_t); return __builtin_bit_cast(unsigned, r); }
__device__ __forceinline__ float bf_lo(unsigned w) { return __uint_as_float(w << 16); }
__device__ __forceinline__ float bf_hi(unsigned w) { return __uint_as_float(w & 0xffff0000u); }
__device__ __forceinline__ float sigmoidf_fast(float z) { return __builtin_amdgcn_rcpf(1.f + __builtin_amdgcn_exp2f(-1.4426950408889634f * z)); }
__device__ __forceinline__ int fresh_tid() { int t = threadIdx.x; asm volatile("" : "+v"(t)); return t; }
__device__ __forceinline__ float wave_sum(float v) {
#pragma unroll
    for (int o = 1; o < 64; o <<= 1) v += __shfl_xor(v, o);
    return v;
}

namespace pg8 {
constexpr int BM = 256, BK = 64, HALF = 128, HTB = HALF * BK * 2, STAGE_BYTES = 8 * HTB, NXCD = 8, WGM = 4;
__host__ __device__ __forceinline__ int lds_byte(int r, int c) { const int st = (r >> 4) * 2 + (c >> 5), rr = r & 15, cc = c & 31, ob = rr * 64 + cc * 2; return st * 1024 + (ob ^ (((ob >> 9) & 1) << 5)); }
__host__ __device__ __forceinline__ void stage_rc(int b, int& R, int& C) { const int st = b / 1024, sb = b % 1024, swz = sb ^ (((sb >> 9) & 1) << 5); R = (st >> 1) * 16 + swz / 64; C = (st & 1) * 32 + (swz % 64) / 2; }
__host__ __device__ __forceinline__ int perm32(int rho) { const int n = rho >> 4, i = rho & 15; return 8 * (i >> 2) + 4 * n + (i & 3); }
struct Unit { int pm, pn; };
struct Gemm { const bf16_t* A; const bf16_t* Bt; int M, N, K; };
struct StaticOrder {
    int nM, nN, nwg, G, c;
    __device__ void init(int M_, int N_, int G_, int c_) { nM = M_ / BM; nN = N_ / BM; nwg = nM * nN; G = G_; c = c_; }
    __device__ bool next(int i, Unit& u) const {
        const long L = (long)i * G + c; if (L >= nwg) return false;
        int wgid = (int)L; { const int q = nwg / NXCD, r = nwg % NXCD, xcd = wgid % NXCD, off = wgid / NXCD; wgid = (xcd < r ? xcd * (q + 1) : r * (q + 1) + (xcd - r) * q) + off; }
        const int nig = WGM * nN, gid = wgid / nig, fm = gid * WGM, gsz = (nM - fm) < WGM ? (nM - fm) : WGM;
        u.pm = fm + ((wgid % nig) % gsz); u.pn = (wgid % nig) / gsz; return true;
    }
};

struct GateOrder { StaticOrder s;
    __device__ bool next(int i, Unit& u) const { if (i >= 2) return false; Unit b; if (!s.next(0, b)) return false; u.pm = b.pm; u.pn = b.pn + 4 * i; return true; } };
template <class Epi, class Sched>
__device__ __forceinline__ void gemm_phase(LAS unsigned char* lds, const Gemm g, const Sched& S, const Epi& E) {
    const int tid = fresh_tid(), wid = __builtin_amdgcn_readfirstlane(tid >> 6), lane = tid & 63, wr = wid >> 2, wc = wid & 3, fr = lane & 15, fq = lane >> 4;
    const int K = g.K, nt = K / BK;
    unsigned voffA, voffB;
    { int R, C; stage_rc(tid * 16, R, C); const int Rb = Epi::PERM ? ((R & ~31) + perm32(R & 31)) : R;
      voffA = (unsigned)(R * K + C) * 2u; voffB = (unsigned)(Rb * K + C) * 2u; }
    const size_t rstep64 = (size_t)64 * K * 2;
    const size_t kstep = (size_t)(BK * 2);
    const size_t hstep = (size_t)HALF * K * 2;
    const size_t tstep = 2 * hstep;
    const unsigned ldsw = (unsigned)wid * 1024u;
    const int aoff = lds_byte(wr * 64 + fr, fq * 8), boff = lds_byte(wc * 32 + fr, fq * 8);
#define PG8_SA(b, h) (((b) * 2 + (h)) * HTB)
#define PG8_SB(b, h) ((4 + (b) * 2 + (h)) * HTB)
#define PG8_STAGE(bufoff, gbase, voff) do { _Pragma("unroll") for (int _i = 0; _i < 2; ++_i) \
        __builtin_amdgcn_global_load_lds((const unsigned*)((const char*)(gbase) + _i * rstep64 + (voff)), (LAS unsigned*)(lds + (bufoff) + ldsw + _i * 8192), 16, 0, 0); } while (0)
#define PG8_LDA(dst, b, h) do { _Pragma("unroll") for (int m = 0; m < 4; ++m) _Pragma("unroll") for (int k = 0; k < 2; ++k) dst[m][k] = *(const LAS bf16x8*)(lds + PG8_SA(b, h) + aoff + m * 2048 + k * 1024); } while (0)
#define PG8_LDB(dst, b, h) do { _Pragma("unroll") for (int n = 0; n < 2; ++n) _Pragma("unroll") for (int k = 0; k < 2; ++k) dst[n][k] = *(const LAS bf16x8*)(lds + PG8_SB(b, h) + boff + n * 2048 + k * 1024); } while (0)
#define PG8_MMA(ai, bj, At, Bt) do { __builtin_amdgcn_s_setprio(1); _Pragma("unroll") for (int m = 0; m < 4; ++m) _Pragma("unroll") for (int n = 0; n < 2; ++n) _Pragma("unroll") for (int k = 0; k < 2; ++k) \
        acc[ai][bj][m][n] = __builtin_amdgcn_mfma_f32_16x16x32_bf16(Bt[n][k], At[m][k], acc[ai][bj][m][n], 0, 0, 0); __builtin_amdgcn_s_setprio(0); } while (0)
#define PG8_WAIT_V(n) asm volatile("s_waitcnt vmcnt(" #n ")" ::: "memory")
#define PG8_WAIT_L(n) asm volatile("s_waitcnt lgkmcnt(" #n ")" ::: "memory")
#define PG8_BAR __builtin_amdgcn_s_barrier()
#define PG8_SCHED __builtin_amdgcn_sched_barrier(0)
    Unit cur, nxt; int ui = 0;
    if (!S.next(0, cur)) return;
    f32x4 acc[2][2][4][2];
#pragma unroll
    for (int a = 0; a < 2; ++a)
#pragma unroll
        for (int b = 0; b < 2; ++b)
#pragma unroll
            for (int m = 0; m < 4; ++m)
#pragma unroll
                for (int n = 0; n < 2; ++n) acc[a][b][m][n] = (f32x4){0.f, 0.f, 0.f, 0.f};
    bf16x8 At[4][2], B0[2][2], B1[2][2];
    const char* cA = (const char*)g.A + (size_t)cur.pm * tstep; const char* cB = (const char*)g.Bt + (size_t)cur.pn * tstep;
    PG8_STAGE(PG8_SB(0, 0), cB, voffB); PG8_STAGE(PG8_SA(0, 0), cA, voffA); PG8_STAGE(PG8_SB(0, 1), cB + hstep, voffB); PG8_STAGE(PG8_SA(0, 1), cA + hstep, voffA);
    if (wr == 1) PG8_BAR;
    PG8_WAIT_V(4); PG8_BAR;
    PG8_STAGE(PG8_SB(1, 0), cB + kstep, voffB); PG8_STAGE(PG8_SA(1, 0), cA + kstep, voffA); PG8_STAGE(PG8_SB(1, 1), cB + hstep + kstep, voffB);
    PG8_WAIT_V(6); PG8_BAR;
    for (;;) {
        const bool has_next = S.next(ui + 1, nxt);
        const char* nA = has_next ? (const char*)g.A + (size_t)nxt.pm * tstep : cA; const char* nB = has_next ? (const char*)g.Bt + (size_t)nxt.pn * tstep : cB;
        for (int t = 0; t < nt; t += 2) {
            const bool last = (t == nt - 2);
            const char* a1 = cA + (size_t)(t + 1) * kstep;
            const char* a2 = last ? nA : cA + (size_t)(t + 2) * kstep; const char* b2 = last ? nB : cB + (size_t)(t + 2) * kstep;
            const char* a3 = a2 + kstep; const char* b3 = b2 + kstep;
            PG8_LDB(B0, 0, 0); PG8_SCHED; PG8_LDA(At, 0, 0); PG8_STAGE(PG8_SA(1, 1), a1 + hstep, voffA);
            PG8_WAIT_L(8); PG8_BAR; PG8_WAIT_L(0); PG8_MMA(0, 0, At, B0); PG8_BAR; PG8_SCHED;
            PG8_LDB(B1, 0, 1); PG8_STAGE(PG8_SB(0, 0), b2, voffB);
            PG8_BAR; PG8_WAIT_L(0); PG8_MMA(0, 1, At, B1); PG8_BAR;
            PG8_LDA(At, 0, 1); PG8_STAGE(PG8_SA(0, 0), a2, voffA);
            PG8_BAR; PG8_WAIT_L(0); PG8_MMA(1, 0, At, B0); PG8_BAR; PG8_SCHED;
            PG8_STAGE(PG8_SB(0, 1), b2 + hstep, voffB);
            PG8_WAIT_V(6); PG8_BAR; PG8_MMA(1, 1, At, B1); PG8_BAR;
            PG8_LDB(B0, 1, 0); PG8_SCHED; PG8_LDA(At, 1, 0); PG8_STAGE(PG8_SA(0, 1), a2 + hstep, voffA);
            PG8_WAIT_L(8); PG8_BAR; PG8_WAIT_L(0); PG8_MMA(0, 0, At, B0); PG8_BAR; PG8_SCHED;
            PG8_LDB(B1, 1, 1); PG8_STAGE(PG8_SB(1, 0), b3, voffB);
            PG8_BAR; PG8_WAIT_L(0); PG8_MMA(0, 1, At, B1); PG8_BAR;
            PG8_LDA(At, 1, 1); PG8_STAGE(PG8_SA(1, 0), a3, voffA);
            PG8_BAR; PG8_WAIT_L(0); PG8_MMA(1, 0, At, B0); PG8_BAR; PG8_SCHED;
            PG8_STAGE(PG8_SB(1, 1), b3 + hstep, voffB);
            PG8_WAIT_V(6); PG8_BAR; PG8_MMA(1, 1, At, B1); PG8_BAR;
        }
        if constexpr (!Epi::AFTER_DRAIN) { const int t2 = fresh_tid(); E(acc, cur, wr, wc, t2 & 15, (t2 >> 4) & 3); }
        if (!has_next) break;
#pragma unroll
        for (int a = 0; a < 2; ++a)
#pragma unroll
            for (int b = 0; b < 2; ++b)
#pragma unroll
                for (int m = 0; m < 4; ++m)
#pragma unroll
                    for (int n = 0; n < 2; ++n) acc[a][b][m][n] = (f32x4){0.f, 0.f, 0.f, 0.f};
        cur = nxt; cA = nA; cB = nB; ++ui;
    }
    PG8_WAIT_V(0);
    if (wr == 0) PG8_BAR;
    PG8_BAR;
    if constexpr (Epi::AFTER_DRAIN) { const int t2 = fresh_tid(); E.fused(acc, cur, wr, wc, t2 & 15, (t2 >> 4) & 3, lds, t2 >> 6, t2 & 63); }
#undef PG8_SA
#undef PG8_SB
#undef PG8_STAGE
#undef PG8_LDA
#undef PG8_LDB
#undef PG8_MMA
#undef PG8_WAIT_V
#undef PG8_WAIT_L
#undef PG8_BAR
#undef PG8_SCHED
}

typedef f32x4 Acc[2][2][4][2];
struct EpiF32 {
    static constexpr bool PERM = false, AFTER_DRAIN = false;
    float* C; int ldc;
    __device__ __forceinline__ void operator()(const Acc& acc, const Unit& u, int wr, int wc, int fr, int fq) const {
        const int row0 = u.pm * BM + wr * 64 + fr, col0 = u.pn * BM + wc * 32 + 4 * fq;
#pragma unroll
        for (int ai = 0; ai < 2; ++ai)
#pragma unroll
            for (int m = 0; m < 4; ++m) { float* rowp = C + (size_t)(row0 + ai * HALF + m * 16) * ldc + col0;
#pragma unroll
                for (int bj = 0; bj < 2; ++bj)
#pragma unroll
                    for (int n = 0; n < 2; ++n) *(f32x4*)(rowp + bj * HALF + n * 16) = acc[ai][bj][m][n]; }
    }
};
struct EpiBf16 {
    static constexpr bool PERM = true, AFTER_DRAIN = false;
    bf16_t* O; int ldc;
    __device__ __forceinline__ void operator()(const Acc& acc, const Unit& u, int wr, int wc, int fr, int fq) const {
        const int row0 = u.pm * BM + wr * 64 + fr, col0 = u.pn * BM + wc * 32 + 8 * fq;
#pragma unroll
        for (int ai = 0; ai < 2; ++ai)
#pragma unroll
            for (int m = 0; m < 4; ++m) { bf16_t* rowp = O + (size_t)(row0 + ai * HALF + m * 16) * ldc + col0;
#pragma unroll
                for (int bj = 0; bj < 2; ++bj) { const f32x4 v0 = acc[ai][bj][m][0], v1 = acc[ai][bj][m][1];
                    u32x4 w; w.x = cvt_pk_bf16(v0[0], v0[1]); w.y = cvt_pk_bf16(v0[2], v0[3]); w.z = cvt_pk_bf16(v1[0], v1[1]); w.w = cvt_pk_bf16(v1[2], v1[3]);
                    *(u32x4*)(rowp + bj * HALF) = w; } }
    }
};
struct EpiSwiGLU {
    static constexpr bool PERM = true, AFTER_DRAIN = false;
    bf16_t* H;
    __device__ __forceinline__ void operator()(const Acc& acc, const Unit& u, int wr, int wc, int fr, int fq) const {
        const int row0 = u.pm * BM + wr * 64 + fr, col0 = u.pn * HALF + wc * 32 + 8 * fq;
#pragma unroll
        for (int ai = 0; ai < 2; ++ai)
#pragma unroll
            for (int m = 0; m < 4; ++m) { bf16_t* rowp = H + (size_t)(row0 + ai * HALF + m * 16) * DFF + col0;
                float h[8];
#pragma unroll
                for (int n = 0; n < 2; ++n)
#pragma unroll
                    for (int j = 0; j < 4; ++j) { const float gt = acc[ai][0][m][n][j], up = acc[ai][1][m][n][j]; h[n * 4 + j] = gt * sigmoidf_fast(gt) * up; }
                u32x4 w; w.x = cvt_pk_bf16(h[0], h[1]); w.y = cvt_pk_bf16(h[2], h[3]); w.z = cvt_pk_bf16(h[4], h[5]); w.w = cvt_pk_bf16(h[6], h[7]);
                *(u32x4*)rowp = w; }
    }
};
struct EpiGate {
    static constexpr bool PERM = true, AFTER_DRAIN = false;
    bf16_t* G;
    __device__ __forceinline__ void operator()(const Acc& acc, const Unit& u, int wr, int wc, int fr, int fq) const {
        const int row0 = u.pm * BM + wr * 64 + fr, col0 = u.pn * BM + wc * 32 + 8 * fq;
#pragma unroll
        for (int ai = 0; ai < 2; ++ai)
#pragma unroll
            for (int m = 0; m < 4; ++m) { bf16_t* rowp = G + (size_t)(row0 + ai * HALF + m * 16) * 2048 + col0;
#pragma unroll
                for (int bj = 0; bj < 2; ++bj) { const f32x4 v0 = acc[ai][bj][m][0], v1 = acc[ai][bj][m][1];
                    u32x4 w; w.x = cvt_pk_bf16(sigmoidf_fast(v0[0]), sigmoidf_fast(v0[1])); w.y = cvt_pk_bf16(sigmoidf_fast(v0[2]), sigmoidf_fast(v0[3]));
                    w.z = cvt_pk_bf16(sigmoidf_fast(v1[0]), sigmoidf_fast(v1[1])); w.w = cvt_pk_bf16(sigmoidf_fast(v1[2]), sigmoidf_fast(v1[3]));
                    *(u32x4*)(rowp + bj * HALF) = w; } }
    }
};
struct EpiQ {
    static constexpr bool PERM = true, AFTER_DRAIN = false;
    bf16_t* Q; const float* TAB;
    __device__ __forceinline__ void operator()(const Acc& acc, const Unit& u, int wr, int wc, int fr, int fq) const {
        const int row0 = u.pm * BM + wr * 64 + fr, col0 = u.pn * BM + wc * 32 + 8 * fq;
#pragma unroll
        for (int ai = 0; ai < 2; ++ai)
#pragma unroll
            for (int m = 0; m < 4; ++m) { const int row = row0 + ai * HALF + m * 16; bf16_t* rowp = Q + (size_t)row * 1536 + col0;
#pragma unroll
                for (int bj = 0; bj < 2; ++bj) { f32x4 v0 = acc[ai][bj][m][0], v1 = acc[ai][bj][m][1];
                    const int c = col0 + bj * HALF, w = c % 192;
                    if (w >= 128) { const int i0 = (w - 128) >> 1; const f32x4 cs = *(const f32x4*)(TAB + (size_t)row * 64 + i0), sn = *(const f32x4*)(TAB + (size_t)row * 64 + 32 + i0);
                        f32x4 r0, r1;
                        r0[0] = v0[0] * cs[0] - v0[1] * sn[0]; r0[1] = v0[1] * cs[0] + v0[0] * sn[0];
                        r0[2] = v0[2] * cs[1] - v0[3] * sn[1]; r0[3] = v0[3] * cs[1] + v0[2] * sn[1];
                        r1[0] = v1[0] * cs[2] - v1[1] * sn[2]; r1[1] = v1[1] * cs[2] + v1[0] * sn[2];
                        r1[2] = v1[2] * cs[3] - v1[3] * sn[3]; r1[3] = v1[3] * cs[3] + v1[2] * sn[3];
                        v0 = r0; v1 = r1; }
                    u32x4 wv; wv.x = cvt_pk_bf16(v0[0], v0[1]); wv.y = cvt_pk_bf16(v0[2], v0[3]); wv.z = cvt_pk_bf16(v1[0], v1[1]); wv.w = cvt_pk_bf16(v1[2], v1[3]);
                    *(u32x4*)(rowp + bj * HALF) = wv; } }
    }
};
struct EpiT1 {
    static constexpr bool PERM = true, AFTER_DRAIN = false;
    const bf16_t* G; bf16_t* F;
    __device__ __forceinline__ void operator()(const Acc& acc, const Unit& u, int wr, int wc, int fr, int fq) const {
        const int row0 = u.pm * BM + wr * 64 + fr, col0 = u.pn * BM + wc * 32 + 8 * fq;
#pragma unroll
        for (int ai = 0; ai < 2; ++ai)
#pragma unroll
            for (int m = 0; m < 4; ++m) { const int row = row0 + ai * HALF + m * 16;
#pragma unroll
                for (int bj = 0; bj < 2; ++bj) { const f32x4 v0 = acc[ai][bj][m][0], v1 = acc[ai][bj][m][1]; const int c = col0 + bj * HALF;
                    const u32x4 gw = *(const u32x4*)(G + (size_t)row * 2048 + c);
                    u32x4 wv;
                    wv.x = cvt_pk_bf16(v0[0] * bf_lo(gw.x), v0[1] * bf_hi(gw.x)); wv.y = cvt_pk_bf16(v0[2] * bf_lo(gw.y), v0[3] * bf_hi(gw.y));
                    wv.z = cvt_pk_bf16(v1[0] * bf_lo(gw.z), v1[1] * bf_hi(gw.z)); wv.w = cvt_pk_bf16(v1[2] * bf_lo(gw.w), v1[3] * bf_hi(gw.w));
                    *(u32x4*)(F + (size_t)row * 1024 + c) = wv; } }
    }
};
struct EpiMX {
    static constexpr bool PERM = true, AFTER_DRAIN = false;
    const bf16_t* G; const bf16_t* F; bf16_t* MX;
    __device__ __forceinline__ void operator()(const Acc& acc, const Unit& u, int wr, int wc, int fr, int fq) const {
        const int row0 = u.pm * BM + wr * 64 + fr, col0 = u.pn * BM + wc * 32 + 8 * fq;
#pragma unroll
        for (int ai = 0; ai < 2; ++ai)
#pragma unroll
            for (int m = 0; m < 4; ++m) { const int row = row0 + ai * HALF + m * 16;
#pragma unroll
                for (int bj = 0; bj < 2; ++bj) { const f32x4 v0 = acc[ai][bj][m][0], v1 = acc[ai][bj][m][1]; const int c = col0 + bj * HALF;
                    const u32x4 gw = *(const u32x4*)(G + (size_t)row * 2048 + 1024 + c);
                    const u32x4 tw = *(const u32x4*)(F + (size_t)row * 1024 + c);
                    u32x4 wv;
                    wv.x = cvt_pk_bf16(bf_lo(tw.x) + v0[0] * bf_lo(gw.x), bf_hi(tw.x) + v0[1] * bf_hi(gw.x)); wv.y = cvt_pk_bf16(bf_lo(tw.y) + v0[2] * bf_lo(gw.y), bf_hi(tw.y) + v0[3] * bf_hi(gw.y));
                    wv.z = cvt_pk_bf16(bf_lo(tw.z) + v1[0] * bf_lo(gw.z), bf_hi(tw.z) + v1[1] * bf_hi(gw.z)); wv.w = cvt_pk_bf16(bf_lo(tw.w) + v1[2] * bf_lo(gw.w), bf_hi(tw.w) + v1[3] * bf_hi(gw.w));
                    *(u32x4*)(MX + (size_t)row * 1024 + c) = wv; } }
    }
};

struct PanelSumSq {
    float* xbuf;
    unsigned* cnt;
    __device__ __forceinline__ void run(const Acc& v, const Unit& u, int wr, int wc, int fr, int fq, LAS unsigned char* lds, int wid, int lane) const {
        LAS float* P = (LAS float*)lds; LAS float* S = (LAS float*)(lds + 4096);
#pragma unroll
        for (int ai = 0; ai < 2; ++ai)
#pragma unroll
            for (int m = 0; m < 4; ++m) { float q = 0.f;
#pragma unroll
                for (int bj = 0; bj < 2; ++bj)
#pragma unroll
                    for (int n = 0; n < 2; ++n) { const f32x4 x = v[ai][bj][m][n]; q += (x[0] * x[0] + x[1] * x[1]) + (x[2] * x[2] + x[3] * x[3]); }
                q += __shfl_xor(q, 16); q += __shfl_xor(q, 32);
                if (fq == 0) P[(ai * HALF + wr * 64 + m * 16 + fr) * 4 + wc] = q; }
        asm volatile("s_waitcnt lgkmcnt(0)" ::: "memory"); __builtin_amdgcn_s_barrier(); asm volatile("" ::: "memory");
        const int row = wid * 32 + (lane & 31);
        if (lane < 32) { const float t = (P[row * 4 + 0] + P[row * 4 + 1]) + (P[row * 4 + 2] + P[row * 4 + 3]);
            __hip_atomic_store(xbuf + ((size_t)(u.pm * BM + row) * 4 + u.pn), t, __ATOMIC_RELAXED, __HIP_MEMORY_SCOPE_AGENT); }
        asm volatile("s_waitcnt vmcnt(0)" ::: "memory");
        if (lane == 0) __hip_atomic_fetch_add(cnt + 64 * u.pm, 1u, __ATOMIC_RELAXED, __HIP_MEMORY_SCOPE_AGENT);
        if (wid == 0) { unsigned sp = 0u;
            while ((unsigned)__builtin_amdgcn_readfirstlane(__hip_atomic_load(cnt + 64 * u.pm, __ATOMIC_RELAXED, __HIP_MEMORY_SCOPE_AGENT)) < 32u) { __builtin_amdgcn_s_sleep(1); if (++sp > (1u << 22)) break; }
            __builtin_amdgcn_fence(__ATOMIC_ACQUIRE, "agent"); }
        asm volatile("s_waitcnt vmcnt(0) lgkmcnt(0)" ::: "memory"); __builtin_amdgcn_s_barrier(); asm volatile("" ::: "memory");
        if (lane < 32) { const float* slot = xbuf + (size_t)(u.pm * BM + row) * 4; float tot = 0.f;
#pragma unroll
            for (int t = 0; t < 4; ++t) tot += __hip_atomic_load(slot + t, __ATOMIC_RELAXED, __HIP_MEMORY_SCOPE_AGENT);
            S[row] = __builtin_amdgcn_rsqf(tot * (1.f / 1024.f) + EPS); }
        asm volatile("s_waitcnt lgkmcnt(0)" ::: "memory"); __builtin_amdgcn_s_barrier(); asm volatile("" ::: "memory");
    }
};
template <bool FINAL, bool BASEF32> struct EpiResNorm {
    static constexpr bool PERM = true, AFTER_DRAIN = true;
    const float* basef; bf16_t* xb; float* outf; bf16_t* xn; float wt; const float* gpost; const float* gnext; PanelSumSq st1, st2;
    __device__ __forceinline__ void operator()(const Acc&, const Unit&, int, int, int, int) const {}
    __device__ __forceinline__ void fused(Acc& acc, const Unit& u, int wr, int wc, int fr, int fq, LAS unsigned char* lds, int wid, int lane) const {
        const LAS float* S = (const LAS float*)(lds + 4096);
        const int col0 = u.pn * BM + wc * 32 + 8 * fq;
        st1.run(acc, u, wr, wc, fr, fq, lds, wid, lane);
#pragma unroll
        for (int ai = 0; ai < 2; ++ai)
#pragma unroll
            for (int m = 0; m < 4; ++m) { const int r = ai * HALF + wr * 64 + m * 16 + fr; const float sr = S[r] * wt;
                const size_t off = (size_t)(u.pm * BM + r) * 1024 + col0, xoff = (size_t)u.pm * 524288 + 262144 + (size_t)r * 1024 + col0;
#pragma unroll
                for (int bj = 0; bj < 2; ++bj) { f32x4 b0, b1;
                    if (BASEF32) { b0 = *(const f32x4*)(basef + off + bj * HALF); b1 = *(const f32x4*)(basef + off + bj * HALF + 4); }
                    else { const u32x4 w = *(const u32x4*)(xb + xoff + bj * HALF); b0 = (f32x4){bf_lo(w.x), bf_hi(w.x), bf_lo(w.y), bf_hi(w.y)}; b1 = (f32x4){bf_lo(w.z), bf_hi(w.z), bf_lo(w.w), bf_hi(w.w)}; }
                    const f32x4 g0 = *(const f32x4*)(gpost + col0 + bj * HALF), g1 = *(const f32x4*)(gpost + col0 + bj * HALF + 4);
                    acc[ai][bj][m][0] = b0 + acc[ai][bj][m][0] * g0 * sr; acc[ai][bj][m][1] = b1 + acc[ai][bj][m][1] * g1 * sr; }
                asm volatile("" : "+v"(acc[ai][0][m][0]), "+v"(acc[ai][0][m][1]), "+v"(acc[ai][1][m][0]), "+v"(acc[ai][1][m][1]));
                if (m & 1) asm volatile("" ::: "memory"); }
        st2.run(acc, u, wr, wc, fr, fq, lds, wid, lane);
#pragma unroll
        for (int ai = 0; ai < 2; ++ai)
#pragma unroll
            for (int m = 0; m < 4; ++m) { const int r = ai * HALF + wr * 64 + m * 16 + fr; const float sr = S[r];
                const size_t off = (size_t)(u.pm * BM + r) * 1024 + col0, xoff = (size_t)u.pm * 524288 + 262144 + (size_t)r * 1024 + col0;
#pragma unroll
                for (int bj = 0; bj < 2; ++bj) { const f32x4 x0 = acc[ai][bj][m][0], x1 = acc[ai][bj][m][1];
                    const f32x4 g0 = *(const f32x4*)(gnext + col0 + bj * HALF), g1 = *(const f32x4*)(gnext + col0 + bj * HALF + 4); const f32x4 o0 = x0 * g0 * sr, o1 = x1 * g1 * sr;
                    if (FINAL) { *(f32x4*)(outf + off + bj * HALF) = o0; *(f32x4*)(outf + off + bj * HALF + 4) = o1; }
                    else { u32x4 wx; wx.x = cvt_pk_bf16(x0[0], x0[1]); wx.y = cvt_pk_bf16(x0[2], x0[3]); wx.z = cvt_pk_bf16(x1[0], x1[1]); wx.w = cvt_pk_bf16(x1[2], x1[3]); *(u32x4*)(xb + xoff + bj * HALF) = wx;
                           u32x4 w; w.x = cvt_pk_bf16(o0[0], o0[1]); w.y = cvt_pk_bf16(o0[2], o0[3]); w.z = cvt_pk_bf16(o1[0], o1[1]); w.w = cvt_pk_bf16(o1[2], o1[3]); *(u32x4*)(xn + off + bj * HALF) = w; } }
                asm volatile("" ::: "memory"); }
    }
};
}

namespace att {
constexpr int NW = 8, QBLK = 32, KVBLK = 64;
constexpr float SCALE = 0.07216878364870322f;
constexpr float THR = 8.f;
constexpr int LDQ = 1536, LDKV = 2048, LDKR = 64, LDO = 1024;
constexpr int SHM_V = 64 * 128 * 2, SHM_K = 64 * 128 * 2, SHM_R = 64 * 64 * 2;
constexpr int NQL = 4;
constexpr int OFF_V = 0, OFF_K = 2 * SHM_V, OFF_RP = OFF_K + 2 * SHM_K, OFF_WS = OFF_RP + 2 * SHM_R, OFF_QL = OFF_WS + NW * 64 * 4, SHM_ATTN = OFF_QL + NW * NQL * 1024;
static_assert(SHM_ATTN <= LDS_STAGE, "lds");
#define KSWZ(row, colB) ((row) * 256 + ((colB) ^ (((row) & 15) << 4)))
#define RSWZ(row, colB) ((row) * 128 + ((colB) ^ ((((row) >> 1) & 7) << 4)))
#define SBAR() __builtin_amdgcn_sched_barrier(0)
__device__ __forceinline__ int crow(int r, int hi) { return (r & 3) + 8 * (r >> 2) + 4 * hi; }
__device__ __forceinline__ bf16x8 ld8(const bf16_t* p) { return *reinterpret_cast<const bf16x8*>(p); }

__device__ __forceinline__ void partialSM(f32x16& p0, f32x16& p1, float& m_reg, float& mn, float& alpha) {
    constexpr float C = SCALE * 1.4426950408889634f;
    float pmax = p0[0];
#pragma unroll
    for (int r = 1; r < 16; ++r) pmax = fmaxf(pmax, p0[r]);
#pragma unroll
    for (int r = 0; r < 16; ++r) pmax = fmaxf(pmax, p1[r]);
    { auto rr = __builtin_amdgcn_permlane32_swap(__float_as_uint(pmax), __float_as_uint(pmax), false, false);
      pmax = fmaxf(__uint_as_float(rr[0]), __uint_as_float(rr[1])); }
    if (__builtin_expect(__all(pmax - m_reg <= THR / SCALE), 1)) { mn = m_reg; alpha = 1.f; }
    else { mn = fmaxf(m_reg, pmax); alpha = __builtin_amdgcn_exp2f((m_reg - mn) * C); m_reg = mn; }
    float mnC = -mn * C;
#pragma unroll
    for (int r = 0; r < 16; ++r) p0[r] = fmaf(p0[r], C, mnC);
#pragma unroll
    for (int r = 0; r < 16; ++r) p1[r] = fmaf(p1[r], C, mnC);
#pragma unroll
    for (int r = 0; r < 16; ++r) p0[r] = __builtin_amdgcn_exp2f(p0[r]);
}
__device__ __forceinline__ void finishSM(f32x16& p0, f32x16& p1, float alpha, float& l_reg, bf16x8& pa0, bf16x8& pa1, bf16x8& pa2, bf16x8& pa3) {
#pragma unroll
    for (int r = 0; r < 16; ++r) p1[r] = __builtin_amdgcn_exp2f(p1[r]);
    float ps = 0;
#pragma unroll
    for (int r = 0; r < 16; ++r) ps += p0[r];
#pragma unroll
    for (int r = 0; r < 16; ++r) ps += p1[r];
    { auto rr = __builtin_amdgcn_permlane32_swap(__float_as_uint(ps), __float_as_uint(ps), false, false);
      ps = __uint_as_float(rr[0]) + __uint_as_float(rr[1]); }
    l_reg = l_reg * alpha + ps;
#define PK4(P, BASE, OUT) do { unsigned a0 = cvt_pk_bf16(P[BASE + 0], P[BASE + 1]), a1 = cvt_pk_bf16(P[BASE + 2], P[BASE + 3]);   \
    unsigned b0 = cvt_pk_bf16(P[BASE + 4], P[BASE + 5]), b1 = cvt_pk_bf16(P[BASE + 6], P[BASE + 7]);                              \
    auto r0 = __builtin_amdgcn_permlane32_swap(a0, b0, false, false); auto r1 = __builtin_amdgcn_permlane32_swap(a1, b1, false, false); \
    u32x4 w = {r0[0], r1[0], r0[1], r1[1]}; OUT = *reinterpret_cast<bf16x8*>(&w); } while (0)
    PK4(p0, 0, pa0); PK4(p0, 8, pa1); PK4(p1, 0, pa2); PK4(p1, 8, pa3);
#undef PK4
}
__device__ __forceinline__ void qkt(f32x16& p0, f32x16& p1, const char* Ks, const char* Rs, const bf16x8* qr, const char* ql, int r32, int hi) {
    p0 = f32x16{}; p1 = f32x16{};
#pragma unroll
    for (int d0 = 0; d0 < 8; ++d0) { int cb = (d0 * 16 + hi * 8) * 2;
        bf16x8 b0 = *reinterpret_cast<const bf16x8*>(Ks + KSWZ(r32, cb));
        bf16x8 b1 = *reinterpret_cast<const bf16x8*>(Ks + KSWZ(32 + r32, cb));
        p0 = __builtin_amdgcn_mfma_f32_32x32x16_bf16(b0, qr[d0], p0, 0, 0, 0);
        p1 = __builtin_amdgcn_mfma_f32_32x32x16_bf16(b1, qr[d0], p1, 0, 0, 0); }
#pragma unroll
    for (int d0 = 0; d0 < 4; ++d0) { int cb = (d0 * 16 + hi * 8) * 2;
        bf16x8 b0 = *reinterpret_cast<const bf16x8*>(Rs + RSWZ(r32, cb));
        bf16x8 b1 = *reinterpret_cast<const bf16x8*>(Rs + RSWZ(32 + r32, cb));
        const bf16x8 qv = *reinterpret_cast<const bf16x8*>(ql + d0 * 1024);
        p0 = __builtin_amdgcn_mfma_f32_32x32x16_bf16(b0, qv, p0, 0, 0, 0);
        p1 = __builtin_amdgcn_mfma_f32_32x32x16_bf16(b1, qv, p1, 0, 0, 0); }
}
__device__ __forceinline__ int v_st(int k, int c) { const int kk = (k & ~0xC) | ((k & 4) << 1) | ((k & 8) >> 1); return ((kk >> 3) * 4 + (c >> 5)) * 512 + ((kk & 7) * 32 + (c & 31)) * 2; }
__device__ __forceinline__ int v_rd_base(int lane) { return ((lane & 3) << 3) | (((lane >> 2) & 3) << 6) | (((lane >> 4) & 1) << 5) | (((lane >> 5) & 1) << 8); }
constexpr int v_rd_off(int d0, int ks, int half) { return d0 * 512 + ks * 4096 + half * 2048; }
template <int OFF> __device__ __forceinline__ s16x4 tr_read(int vb) {
    s16x4 r; asm volatile("ds_read_b64_tr_b16 %0, %1 offset:%2" : "=&v"(r) : "v"(vb), "i"(OFF) : "memory"); return r;
}
template <int D0> __device__ __forceinline__ void pv_one(f32x16& od, int vb, bf16x8 pa0, bf16x8 pa1, bf16x8 pa2, bf16x8 pa3) {
    const s16x4 l0 = tr_read<v_rd_off(D0, 0, 0)>(vb), h0 = tr_read<v_rd_off(D0, 0, 1)>(vb), l1 = tr_read<v_rd_off(D0, 1, 0)>(vb), h1 = tr_read<v_rd_off(D0, 1, 1)>(vb);
    const s16x4 l2 = tr_read<v_rd_off(D0, 2, 0)>(vb), h2 = tr_read<v_rd_off(D0, 2, 1)>(vb), l3 = tr_read<v_rd_off(D0, 3, 0)>(vb), h3 = tr_read<v_rd_off(D0, 3, 1)>(vb);
    asm volatile("s_waitcnt lgkmcnt(0)" ::: "memory"); SBAR();
#define PK(L, H) (bf16x8){L[0], L[1], L[2], L[3], H[0], H[1], H[2], H[3]}
    od = __builtin_amdgcn_mfma_f32_32x32x16_bf16(pa0, PK(l0, h0), od, 0, 0, 0);
    od = __builtin_amdgcn_mfma_f32_32x32x16_bf16(pa1, PK(l1, h1), od, 0, 0, 0);
    od = __builtin_amdgcn_mfma_f32_32x32x16_bf16(pa2, PK(l2, h2), od, 0, 0, 0);
    od = __builtin_amdgcn_mfma_f32_32x32x16_bf16(pa3, PK(l3, h3), od, 0, 0, 0);
#undef PK
}
__device__ __forceinline__ void pv_d0(f32x16* o, int vb, bf16x8 pa0, bf16x8 pa1, bf16x8 pa2, bf16x8 pa3) {
    pv_one<0>(o[0], vb, pa0, pa1, pa2, pa3); pv_one<1>(o[1], vb, pa0, pa1, pa2, pa3); pv_one<2>(o[2], vb, pa0, pa1, pa2, pa3); pv_one<3>(o[3], vb, pa0, pa1, pa2, pa3);
}

__device__ __forceinline__ void attn_body(const bf16_t* __restrict__ Qb, const bf16_t* __restrict__ Kn, const bf16_t* __restrict__ Kr, const bf16_t* __restrict__ Vh,
                                          bf16_t* __restrict__ Ob, int seq, char* lds) {
    const int tid = fresh_tid(), wid = tid >> 6, lane = tid & 63, r32 = lane & 31, hi = lane >> 5;
    char* V_lds = lds + OFF_V; char* K_lds = lds + OFF_K; char* R_lds = lds + OFF_RP;
    float* ws = (float*)(lds + OFF_WS) + wid * 64; float* li_l = ws; float* al_l = ws + 32;
    float m_reg = -1e30f, l_reg = 0; f32x16 o[4] = {}; bf16x8 qr[8];
    char* ql = lds + OFF_QL + wid * (NQL * 1024) + lane * 16;
    const bf16_t* Qw = Qb + (long)(wid * QBLK + r32) * LDQ + hi * 8;
#pragma unroll
    for (int d0 = 0; d0 < 8; ++d0) qr[d0] = ld8(Qw + d0 * 16);
#pragma unroll
    for (int d0 = 0; d0 < NQL; ++d0) *reinterpret_cast<bf16x8*>(ql + d0 * 1024) = ld8(Qw + (8 + d0) * 16);
    const int sr = tid >> 4, sc = (tid & 15) * 8, vst0 = v_st(sr, sc), vst1 = v_st(32 + sr, sc);
    const int rr_ = tid >> 3, rc_ = (tid & 7) * 8;
    const int vb0 = (int)(uintptr_t)V_lds + v_rd_base(lane);
    bf16x8 vs0, vs1, ks0, ks1, rs0;
#define SLOAD(k0) do { vs0 = ld8(&Vh[(long)((k0) + sr) * LDKV + sc]); vs1 = ld8(&Vh[(long)((k0) + 32 + sr) * LDKV + sc]); \
    ks0 = ld8(&Kn[(long)((k0) + sr) * LDKV + sc]); ks1 = ld8(&Kn[(long)((k0) + 32 + sr) * LDKV + sc]); rs0 = ld8(&Kr[(long)((k0) + rr_) * LDKR + rc_]); } while (0)
#define SWRITE(b) do { *(bf16x8*)(V_lds + (b) * SHM_V + vst0) = vs0; *(bf16x8*)(V_lds + (b) * SHM_V + vst1) = vs1; int kc = sc * 2; \
    *(bf16x8*)(K_lds + (b) * SHM_K + KSWZ(sr, kc)) = ks0; *(bf16x8*)(K_lds + (b) * SHM_K + KSWZ(32 + sr, kc)) = ks1; \
    *(bf16x8*)(R_lds + (b) * SHM_R + RSWZ(rr_, rc_ * 2)) = rs0; } while (0)
#define RESC(a) do { if (__any((a) < 1.f)) { if (hi == 0) al_l[r32] = (a); asm volatile("s_waitcnt lgkmcnt(0)" ::: "memory"); \
    _Pragma("unroll") for (int d = 0; d < 4; ++d) _Pragma("unroll") for (int r = 0; r < 16; ++r) o[d][r] *= al_l[crow(r, hi)]; } } while (0)
    f32x16 pA0, pA1, pB0, pB1; float mnA, mnB, alA, alB; bf16x8 pa0, pa1, pa2, pa3; const int NT = seq / KVBLK;
    SLOAD(0); asm volatile("s_waitcnt vmcnt(0)" ::: "memory"); SWRITE(0); __syncthreads();
    qkt(pA0, pA1, K_lds, R_lds, qr, ql, r32, hi); partialSM(pA0, pA1, m_reg, mnA, alA);
    SLOAD(KVBLK);
    asm volatile("s_waitcnt vmcnt(0)" ::: "memory"); SWRITE(1); __syncthreads();
    for (int j = 1; j + 1 < NT; j += 2) {
        SBAR(); qkt(pB0, pB1, K_lds + SHM_K, R_lds + SHM_R, qr, ql, r32, hi);
        finishSM(pA0, pA1, alA, l_reg, pa0, pa1, pa2, pa3); SBAR();
        SLOAD((j + 1) * KVBLK); SBAR();
        pv_d0(o, vb0, pa0, pa1, pa2, pa3); partialSM(pB0, pB1, m_reg, mnB, alB);
        __syncthreads(); asm volatile("s_waitcnt vmcnt(0)" ::: "memory"); SWRITE(0);
        RESC(alB); __syncthreads();
        SBAR(); qkt(pA0, pA1, K_lds, R_lds, qr, ql, r32, hi);
        finishSM(pB0, pB1, alB, l_reg, pa0, pa1, pa2, pa3); SBAR();
        SLOAD((j + 2) * KVBLK); SBAR();
        pv_d0(o, vb0 + SHM_V, pa0, pa1, pa2, pa3); partialSM(pA0, pA1, m_reg, mnA, alA);
        __syncthreads(); asm volatile("s_waitcnt vmcnt(0)" ::: "memory"); SWRITE(1);
        RESC(alA); __syncthreads();
    }
    SBAR(); qkt(pB0, pB1, K_lds + SHM_K, R_lds + SHM_R, qr, ql, r32, hi);
    finishSM(pA0, pA1, alA, l_reg, pa0, pa1, pa2, pa3); SBAR();
    pv_d0(o, vb0, pa0, pa1, pa2, pa3); partialSM(pB0, pB1, m_reg, mnB, alB);
    __syncthreads(); RESC(alB);
    finishSM(pB0, pB1, alB, l_reg, pa0, pa1, pa2, pa3); SBAR();
    pv_d0(o, vb0 + SHM_V, pa0, pa1, pa2, pa3);
    if (hi == 0) li_l[r32] = l_reg; asm volatile("s_waitcnt lgkmcnt(0)" ::: "memory");
    float rli[16];
#pragma unroll
    for (int r = 0; r < 16; ++r) rli[r] = __builtin_amdgcn_rcpf(li_l[crow(r, hi)]);
    bf16_t* Ow = Ob + (long)(wid * QBLK) * LDO;
#pragma unroll
    for (int r = 0; r < 16; ++r) { int orow = crow(r, hi);
#pragma unroll
        for (int d0 = 0; d0 < 4; ++d0) { const float v = o[d0][r] * rli[r]; Ow[(long)orow * LDO + d0 * 32 + r32] = (bf16_t)(cvt_pk_bf16(v, v) & 0xffffu); } }
#undef SLOAD
#undef SWRITE
#undef RESC
}
}


#define XB_TMO      128
#define XB_XCNT(j)  (256  + 64 * (j))
#define XB_XSUB(j)  (1280 + 64 * (j))
#define XB_XGEN(j)  (2304 + 64 * (j))
#define XB_TOP      3328
#define XB_TOPGEN   3392
#define XCD_BAR_WORDS 3456
#define XB_SPIN_CAP (1u << 18)
__device__ __forceinline__ unsigned xb_ld(unsigned* p)              { return __hip_atomic_load(p, __ATOMIC_RELAXED, __HIP_MEMORY_SCOPE_AGENT); }
__device__ __forceinline__ unsigned xb_add(unsigned* p, unsigned v) { return __hip_atomic_fetch_add(p, v, __ATOMIC_RELAXED, __HIP_MEMORY_SCOPE_AGENT); }
__device__ __forceinline__ unsigned xb_xcc_id() { return (unsigned)__builtin_amdgcn_s_getreg((3 << 11) | 20) & 0xFu; }
#define XB_SPIN(cond, bar) do { unsigned _sp = 0; while (cond) { __builtin_amdgcn_s_sleep(1); \
    if ((++_sp & 255u) == 0u) { if (xb_ld(&(bar)[XB_TMO])) break; if (_sp > XB_SPIN_CAP) { atomicAdd(&(bar)[XB_TMO], 1u); break; } } } } while (0)
struct XcdBarrier { unsigned* bar; unsigned x; volatile LAS unsigned* st; };
__device__ __forceinline__ XcdBarrier xcd_barrier_post(unsigned* bar, volatile LAS unsigned* st) {
    XcdBarrier b; b.bar = bar; b.x = xb_xcc_id(); b.st = st;
    if (threadIdx.x == 0) (void)xb_add(&bar[XB_XCNT(b.x)], 1u);
    return b;
}
__device__ __forceinline__ void xcd_barrier_complete(unsigned* bar, unsigned x, unsigned& nloc, unsigned& nx) {
    const unsigned G = gridDim.x * gridDim.y * gridDim.z;
    unsigned sum, cnt, mine, sp = 0u;
    for (;;) {
        sum = 0u; cnt = 0u; mine = 0u;
#pragma unroll
        for (unsigned j = 0; j < 16; ++j) { const unsigned c = xb_ld(&bar[XB_XCNT(j)]); sum += c; cnt += (c > 0u) ? 1u : 0u; mine = (j == x) ? c : mine; }
        if (sum == G) break;
        __builtin_amdgcn_s_sleep(1);
        if ((++sp & 255u) == 0u) { if (xb_ld(&bar[XB_TMO])) break; if (sp > XB_SPIN_CAP) { atomicAdd(&bar[XB_TMO], 1u); break; } }
    }
    nloc = mine > 0u ? mine : 1u; nx = cnt > 0u ? cnt : 1u;
}
__device__ __forceinline__ void xcd_barrier(const XcdBarrier& b) {
    asm volatile("s_waitcnt vmcnt(0)" ::: "memory");
    __syncthreads();
    if (threadIdx.x == 0) {
        unsigned* bar = b.bar;
        __builtin_amdgcn_s_waitcnt(0);
        unsigned nloc = b.st[0], nx = b.st[1];
        if (nloc == 0u) { xcd_barrier_complete(bar, b.x, nloc, nx); b.st[0] = nloc; b.st[1] = nx; }
        const unsigned old = xb_add(&bar[XB_XSUB(b.x)], 1u);
        const unsigned gen = old / nloc;
        if (old + 1u == (gen + 1u) * nloc) {
            __builtin_amdgcn_fence(__ATOMIC_RELEASE, "agent");
            asm volatile("s_waitcnt vmcnt(0)" ::: "memory");
            const unsigned og = xb_add(&bar[XB_TOP], 1u);
            const unsigned tg = og / nx;
            if (og + 1u == (tg + 1u) * nx) xb_add(&bar[XB_TOPGEN], 1u);
            else XB_SPIN(xb_ld(&bar[XB_TOPGEN]) == tg, bar);
            __builtin_amdgcn_fence(__ATOMIC_ACQUIRE, "agent");
            xb_add(&bar[XB_XGEN(b.x)], 1u);
            asm volatile("s_waitcnt vmcnt(0)" ::: "memory");
        } else {
            XB_SPIN(xb_ld(&bar[XB_XGEN(b.x)]) == gen, bar);
            __builtin_amdgcn_fence(__ATOMIC_ACQUIRE, "agent");
            asm volatile("s_waitcnt vmcnt(0)" ::: "memory");
        }
    }
    __syncthreads();
}

enum { TR_PLAIN = 0, TR_GU = 1, TR_WIN = 2, TR_UQ = 3, TR_UKV = 4 };
template <int MODE>
__device__ __forceinline__ void tr_job(const float* W0, const float* W1, int K, int Nsrc, int Nout, bf16_t* WT, LAS float* scr, int lane, int gw, int NGW) {
    const int nblk = Nout / 32, nitems = (K / 64) * nblk;
    for (int it = gw; it < nitems; it += NGW) {
        const int kb = it / nblk, nb = it % nblk, k0 = 64 * kb, n0 = 32 * nb, np = n0 + (lane & 31);
        const float* colp;
        if (MODE == TR_PLAIN) colp = W0 + np;
        else if (MODE == TR_GU) { const int t = np >> 8, w = np & 255; colp = (w < 128 ? W0 : W1) + t * 128 + (w & 127); }
        else if (MODE == TR_WIN) colp = np < 1216 ? W0 + np : (np < 1280 ? nullptr : W0 + (np - 64));
        else if (MODE == TR_UQ) { const int h = np / 192, w = np % 192; colp = W0 + (w < 128 ? np : h * 192 + 128 + ((w - 128) >> 1) + ((w - 128) & 1) * 32); }
        else colp = np < 1024 ? W0 + np : W1 + (np - 1024);
        float tv[32];
#pragma unroll
        for (int i = 0; i < 32; ++i) { const int kk = 2 * i + (lane >> 5); tv[i] = colp ? colp[(size_t)(k0 + kk) * Nsrc] : 0.f; }
#pragma unroll
        for (int i = 0; i < 32; ++i) { const int kk = 2 * i + (lane >> 5); scr[kk * 33 + (lane & 31)] = tv[i]; }
        asm volatile("s_waitcnt lgkmcnt(0)" ::: "memory");
        const int c = lane & 7;
#pragma unroll
        for (int j = 0; j < 4; ++j) { const int n = (lane >> 3) + 8 * j; const LAS float* s = scr + (8 * c) * 33 + n;
            u32x4 o; o.x = cvt_pk_bf16(s[0 * 33], s[1 * 33]); o.y = cvt_pk_bf16(s[2 * 33], s[3 * 33]); o.z = cvt_pk_bf16(s[4 * 33], s[5 * 33]); o.w = cvt_pk_bf16(s[6 * 33], s[7 * 33]);
            *(u32x4*)(WT + (size_t)(n0 + n) * K + k0 + 8 * c) = o; }
        asm volatile("s_waitcnt lgkmcnt(0)" ::: "memory");
    }
}

__device__ __forceinline__ void norm_rows(const float* xin, const float* gnext, bf16_t* xn, int gw, int NGW, int lane) {
    for (int row0 = gw; row0 < M; row0 += 2 * NGW) {
        f32x4 xv[2][4];
#pragma unroll
        for (int r = 0; r < 2; ++r) { const size_t row = (size_t)(row0 + r * NGW);
#pragma unroll
            for (int j = 0; j < 2; ++j) { xv[r][2 * j] = *(const f32x4*)(xin + row * DM + 8 * (lane + 64 * j)); xv[r][2 * j + 1] = *(const f32x4*)(xin + row * DM + 8 * (lane + 64 * j) + 4); } }
#pragma unroll
        for (int r = 0; r < 2; ++r) { const size_t row = (size_t)(row0 + r * NGW);
            float s2 = 0.f;
#pragma unroll
            for (int j = 0; j < 4; ++j) s2 += xv[r][j].x * xv[r][j].x + xv[r][j].y * xv[r][j].y + xv[r][j].z * xv[r][j].z + xv[r][j].w * xv[r][j].w;
            const float r2 = __builtin_amdgcn_rsqf(wave_sum(s2) * (1.f / DM) + EPS);
#pragma unroll
            for (int j = 0; j < 2; ++j) { const f32x4 g0 = *(const f32x4*)(gnext + 8 * (lane + 64 * j)), g1 = *(const f32x4*)(gnext + 8 * (lane + 64 * j) + 4);
                const f32x4 y0 = xv[r][2 * j] * g0 * r2, y1 = xv[r][2 * j + 1] * g1 * r2;
                u32x4 w; w.x = cvt_pk_bf16(y0.x, y0.y); w.y = cvt_pk_bf16(y0.z, y0.w); w.z = cvt_pk_bf16(y1.x, y1.y); w.w = cvt_pk_bf16(y1.z, y1.w);
                *(u32x4*)(xn + row * DM + 8 * (lane + 64 * j)) = w; }
        }
    }
}

__global__ void __launch_bounds__(NTHREADS, 2) fwd_megakernel(Params p) {
    extern __shared__ __attribute__((aligned(16))) unsigned char lds[];
    cg::grid_group grid = cg::this_grid();
    volatile LAS unsigned* bst = (volatile LAS unsigned*)((LAS unsigned char*)lds + LDS_STAGE);
    if (threadIdx.x < 2) bst[threadIdx.x] = 0u;
    __syncthreads();
    const XcdBarrier xbar = xcd_barrier_post((unsigned*)(p.ws + OFF_BAR), bst);
#define GRID_SYNC_CG() do { __builtin_amdgcn_fence(__ATOMIC_RELEASE, "agent"); asm volatile("s_waitcnt vmcnt(0)" ::: "memory"); grid.sync(); \
        __builtin_amdgcn_fence(__ATOMIC_ACQUIRE, "agent"); asm volatile("s_waitcnt vmcnt(0)" ::: "memory"); } while (0)
#define GRID_SYNC() xcd_barrier(xbar)
    const int G = gridDim.x, bid = blockIdx.x, NGW = G * NWAVES;
    LAS unsigned char* ldsl = (LAS unsigned char*)lds;
#define PHASE_IDS() const int tid = fresh_tid(), lane = tid & 63, wave = tid >> 6, gw = bid * NWAVES + wave; LAS float* scr = (LAS float*)(ldsl + wave * 8448); (void)scr; (void)gw; (void)lane
    unsigned char* ws = p.ws;
    bf16_t* Wgu = (bf16_t*)(ws + OFF_WGU); bf16_t* Wd = (bf16_t*)(ws + OFF_WD); bf16_t* Win = (bf16_t*)(ws + OFF_WIN); bf16_t* Wuq = (bf16_t*)(ws + OFF_WUQ);
    bf16_t* Wukv = (bf16_t*)(ws + OFF_WUKV); bf16_t* Woa = (bf16_t*)(ws + OFF_WOA); bf16_t* Wp = (bf16_t*)(ws + OFF_WP); bf16_t* Wout = (bf16_t*)(ws + OFF_WOUT);
    bf16_t* XN = (bf16_t*)(ws + OFF_XN); bf16_t* F = (bf16_t*)(ws + OFF_F); float* ZF = (float*)(ws + OFF_ZF); bf16_t* KV = (bf16_t*)(ws + OFF_KV);
    bf16_t* H = (bf16_t*)(ws + OFF_H); bf16_t* O = (bf16_t*)(ws + OFF_O); bf16_t* CQN = (bf16_t*)(ws + OFF_CQN); bf16_t* CKVN = (bf16_t*)(ws + OFF_CKVN);
    float* TAB = (float*)(ws + OFF_TAB); bf16_t* Q = (bf16_t*)(ws + OFF_Q); bf16_t* KR = (bf16_t*)(ws + OFF_KR); bf16_t* Gt = (bf16_t*)(ws + OFF_G); bf16_t* DP = (bf16_t*)(ws + OFF_DP);
    float* X = p.out;
    float* xbuf0 = (float*)(ws + OFF_XBUF); unsigned* cnt0 = (unsigned*)(ws + OFF_CNT);

    { PHASE_IDS();
    tr_job<TR_GU>(p.f1_wg, p.f1_wu, 1024, DFF, 5632, Wgu, scr, lane, gw, NGW);
    norm_rows(p.x, p.f1_pre, XN, gw, NGW, lane); }
    if (__builtin_expect(p.out == nullptr, 0)) GRID_SYNC_CG();
    GRID_SYNC();

    pg8::StaticOrder S;
    { pg8::Gemm g{XN, Wgu, M, 5632, 1024}; S.init(M, 5632, G, bid); pg8::EpiSwiGLU E{H}; pg8::gemm_phase(ldsl, g, S, E); }
    {
        const int tail0 = (64 * 22) % G;
        if (tail0 != 0 && bid >= tail0) { PHASE_IDS(); const int tb = bid - tail0, nb = G - tail0, tgw = tb * NWAVES + wave, TNGW = nb * NWAVES;
            tr_job<TR_PLAIN>(p.f1_wd, nullptr, DFF, 1024, 1024, Wd, scr, lane, tgw, TNGW);
            tr_job<TR_WIN>(p.w_in, nullptr, 1024, INW, 3328, Win, scr, lane, tgw, TNGW);
            tr_job<TR_UQ>(p.w_uq, nullptr, QL, 1536, 1536, Wuq, scr, lane, tgw, TNGW);
            tr_job<TR_UKV>(p.w_uk, p.w_uv, KVL, 1024, 2048, Wukv, scr, lane, tgw, TNGW);
    }
        else if (tail0 == 0) { PHASE_IDS(); const int tb = bid, nb = G;
            tr_job<TR_PLAIN>(p.f1_wd, nullptr, DFF, 1024, 1024, Wd, scr, lane, gw, NGW);
            tr_job<TR_WIN>(p.w_in, nullptr, 1024, INW, 3328, Win, scr, lane, gw, NGW);
            tr_job<TR_UQ>(p.w_uq, nullptr, QL, 1536, 1536, Wuq, scr, lane, gw, NGW);
            tr_job<TR_UKV>(p.w_uk, p.w_uv, KVL, 1024, 2048, Wukv, scr, lane, gw, NGW);
    }
    }
    GRID_SYNC();
    { pg8::Gemm g{H, Wd, M, 1024, DFF}; S.init(M, 1024, G, bid);
      pg8::EpiResNorm<false, true> E{p.x, (bf16_t*)X, nullptr, XN, 0.5f, p.f1_post, p.mix_pre, pg8::PanelSumSq{xbuf0, cnt0}, pg8::PanelSumSq{xbuf0 + (size_t)M * 4, cnt0 + 4096}}; pg8::gemm_phase(ldsl, g, S, E); }
    GRID_SYNC();
    { pg8::Gemm g{XN, Win, M, 1280, 1024}; S.init(M, 1280, G, bid); pg8::EpiBf16 E{(bf16_t*)ZF, 1280}; pg8::gemm_phase(ldsl, g, S, E); }
    {
        const int tail0 = (64 * 5) % G; PHASE_IDS();
        if (tail0 != 0 && bid >= tail0) { const int tgw = (bid - tail0) * NWAVES + wave, TNGW = (G - tail0) * NWAVES;
            tr_job<TR_GU>(p.f2_wg, p.f2_wu, 1024, DFF, 5632, Wgu, scr, lane, tgw, TNGW);
            tr_job<TR_PLAIN>(p.f2_wd, nullptr, DFF, 1024, 1024, Wd, scr, lane, tgw, TNGW); }
        else if (tail0 == 0) { tr_job<TR_GU>(p.f2_wg, p.f2_wu, 1024, DFF, 5632, Wgu, scr, lane, gw, NGW); tr_job<TR_PLAIN>(p.f2_wd, nullptr, DFF, 1024, 1024, Wd, scr, lane, gw, NGW); }
    }
    GRID_SYNC();
    { PHASE_IDS();
    const bf16_t* ZB = (const bf16_t*)ZF;
    for (int bt = gw; bt < M / 4; bt += NGW) { const int row0 = bt * 4, t0 = row0 & (SEQ - 1);
        const int lane = fresh_tid() & 63;
        const int t_g = lane >> 4, wnd = 2 << t_g, wl = wnd >> 1, wrr = wnd - wl;
        u32x4 nb[19], qa[4], qb[4]; float kx1[4], kx2[4]; int pos[4];
#pragma unroll
        for (int i = 0; i < 19; ++i) { int tt = t0 - 8 + i; tt = tt < 0 ? 0 : (tt > SEQ - 1 ? SEQ - 1 : tt); nb[i] = *(const u32x4*)(ZB + (size_t)(row0 - t0 + tt) * 1280 + 704 + 8 * lane); }
#pragma unroll
        for (int k = 0; k < 4; ++k) { const bf16_t* z = ZB + (size_t)(row0 + k) * 1280;
            qa[k] = *(const u32x4*)(z + 8 * lane); qb[k] = (u32x4){0u, 0u, 0u, 0u}; if (lane < 16) qb[k] = *(const u32x4*)(z + 512 + 8 * lane);
            kx1[k] = 0.f; kx2[k] = 0.f; pos[k] = 0; if (lane < 32) { kx1[k] = bf_lo((unsigned)z[640 + lane]); kx2[k] = bf_lo((unsigned)z[672 + lane]); pos[k] = p.pos[row0 + k]; } }
        __builtin_amdgcn_sched_barrier(0);
#pragma unroll
        for (int k = 0; k < 4; ++k) { const int row = row0 + k, t = t0 + k, lo = max(t - wl, 0), hi = min(t + wrr, SEQ);
            float sacc[8];
#pragma unroll
            for (int i = 0; i < 8; ++i) sacc[i] = 0.f;
#pragma unroll
            for (int d = 0; d < 16; ++d) { const int tt = t - 8 + d; const float wv = (tt >= lo && tt < hi) ? 1.f : 0.f; const u32x4 v = nb[k + d];
                sacc[0] = fmaf(wv, bf_lo(v.x), sacc[0]); sacc[1] = fmaf(wv, bf_hi(v.x), sacc[1]); sacc[2] = fmaf(wv, bf_lo(v.y), sacc[2]); sacc[3] = fmaf(wv, bf_hi(v.y), sacc[3]);
                sacc[4] = fmaf(wv, bf_lo(v.z), sacc[4]); sacc[5] = fmaf(wv, bf_hi(v.z), sacc[5]); sacc[6] = fmaf(wv, bf_lo(v.w), sacc[6]); sacc[7] = fmaf(wv, bf_hi(v.w), sacc[7]); }
            {
                const float inv = 1.f / (float)(hi - lo); const u32x4 pc = nb[k + 8];
                u32x4 w; w.x = cvt_pk_bf16(sacc[0] * inv - bf_lo(pc.x), sacc[1] * inv - bf_hi(pc.x)); w.y = cvt_pk_bf16(sacc[2] * inv - bf_lo(pc.y), sacc[3] * inv - bf_hi(pc.y));
                w.z = cvt_pk_bf16(sacc[4] * inv - bf_lo(pc.z), sacc[5] * inv - bf_hi(pc.z)); w.w = cvt_pk_bf16(sacc[6] * inv - bf_lo(pc.w), sacc[7] * inv - bf_hi(pc.w));
                *(u32x4*)(DP + (size_t)row * 512 + 8 * lane) = w; }
            {
                const u32x4 a4 = qa[k], b4 = qb[k];
                float va[8] = {bf_lo(a4.x), bf_hi(a4.x), bf_lo(a4.y), bf_hi(a4.y), bf_lo(a4.z), bf_hi(a4.z), bf_lo(a4.w), bf_hi(a4.w)};
                float vb[8] = {bf_lo(b4.x), bf_hi(b4.x), bf_lo(b4.y), bf_hi(b4.y), bf_lo(b4.z), bf_hi(b4.z), bf_lo(b4.w), bf_hi(b4.w)};
                float sa = 0.f, sb = 0.f;
#pragma unroll
                for (int i = 0; i < 8; ++i) { sa = fmaf(va[i], va[i], sa); sb = fmaf(vb[i], vb[i], sb); }
                const float ssq = wave_sum(lane < 48 ? sa : 0.f), sskv = wave_sum((lane >= 48 ? sa : 0.f) + sb);
                const float rq = __builtin_amdgcn_rsqf(ssq * (1.f / QL) + EPS), rkv = __builtin_amdgcn_rsqf(sskv * (1.f / KVL) + EPS);
                const float* ga = lane < 48 ? p.qa_g + 8 * lane : p.kva_g + 8 * (lane - 48); const float ra = lane < 48 ? rq : rkv;
                const f32x4 g0 = *(const f32x4*)ga, g1 = *(const f32x4*)(ga + 4);
                u32x4 w; w.x = cvt_pk_bf16(va[0] * g0.x * ra, va[1] * g0.y * ra); w.y = cvt_pk_bf16(va[2] * g0.z * ra, va[3] * g0.w * ra); w.z = cvt_pk_bf16(va[4] * g1.x * ra, va[5] * g1.y * ra); w.w = cvt_pk_bf16(va[6] * g1.z * ra, va[7] * g1.w * ra);
                bf16_t* dst = lane < 48 ? CQN + (size_t)row * QL + 8 * lane : CKVN + (size_t)row * KVL + 8 * (lane - 48);
                *(u32x4*)dst = w;
                if (lane < 16) { const f32x4 h0 = *(const f32x4*)(p.kva_g + 128 + 8 * lane), h1 = *(const f32x4*)(p.kva_g + 132 + 8 * lane);
                    u32x4 w2; w2.x = cvt_pk_bf16(vb[0] * h0.x * rkv, vb[1] * h0.y * rkv); w2.y = cvt_pk_bf16(vb[2] * h0.z * rkv, vb[3] * h0.w * rkv); w2.z = cvt_pk_bf16(vb[4] * h1.x * rkv, vb[5] * h1.y * rkv); w2.w = cvt_pk_bf16(vb[6] * h1.z * rkv, vb[7] * h1.w * rkv);
                    *(u32x4*)(CKVN + (size_t)row * KVL + 128 + 8 * lane) = w2; }
            }
            if (lane < 32) {
                const float ang = (float)pos[k] * p.inv_freq[lane];
                const double ad = (double)ang; const double kq = rint(ad * 0.15915494309189535); const float red = (float)(ad - kq * 6.283185307179586);
                const float cs = __cosf(red), sn = __sinf(red);
                TAB[(size_t)row * 64 + lane] = cs; TAB[(size_t)row * 64 + 32 + lane] = sn;
                *(unsigned*)(KR + (size_t)row * 64 + 2 * lane) = cvt_pk_bf16(kx1[k] * cs - kx2[k] * sn, kx2[k] * cs + kx1[k] * sn);
            }
            __builtin_amdgcn_sched_barrier(0);
        }
    } }
    GRID_SYNC();
    { pg8::Gemm g{CQN, Wuq, M, 1536, QL}; S.init(M, 1536, G, bid); pg8::EpiQ E{Q, TAB}; pg8::gemm_phase(ldsl, g, S, E); }
    {
        const int tail0 = (64 * 6) % G;
        if (tail0 != 0 && bid >= tail0) { PHASE_IDS(); const int tb = bid - tail0, nb = G - tail0, tgw = tb * NWAVES + wave, TNGW = nb * NWAVES;
            tr_job<TR_PLAIN>(p.w_oa, nullptr, 1024, 1024, 1024, Woa, scr, lane, tgw, TNGW);
            tr_job<TR_PLAIN>(p.w_out, nullptr, 1024, 1024, 1024, Wout, scr, lane, tgw, TNGW);
    for (int idx = tb * NTHREADS + tid; idx < 65536; idx += nb * NTHREADS) {
            const int n = idx & 1023, c8 = idx >> 10, g = c8 >> 4, cb = (c8 & 15) * 8;
            float a[8];
    #pragma unroll
            for (int i = 0; i < 8; ++i) a[i] = 0.f;
            for (int j0 = 0; j0 < 128; j0 += 8) { float w[8]; f32x4 pw[8][2];
    #pragma unroll
                for (int jj = 0; jj < 8; ++jj) w[jj] = p.w_op[(size_t)(g * 128 + j0 + jj) * 1024 + n] * p.pool_scale[g * 128 + j0 + jj];
    #pragma unroll
                for (int i = 0; i < 8; ++i) { pw[i][0] = *(const f32x4*)(p.pool_w + (size_t)(g * 128 + cb + i) * 128 + j0); pw[i][1] = *(const f32x4*)(p.pool_w + (size_t)(g * 128 + cb + i) * 128 + j0 + 4); }
    #pragma unroll
                for (int i = 0; i < 8; ++i)
    #pragma unroll
                    for (int jj = 0; jj < 8; ++jj) a[i] = fmaf(pw[i][jj >> 2][jj & 3], w[jj], a[i]); }
            u32x4 o; o.x = cvt_pk_bf16(a[0], a[1]); o.y = cvt_pk_bf16(a[2], a[3]); o.z = cvt_pk_bf16(a[4], a[5]); o.w = cvt_pk_bf16(a[6], a[7]);
            *(u32x4*)(Wp + (size_t)n * 512 + c8 * 8) = o;
        }
        }
        else if (tail0 == 0) { PHASE_IDS(); const int tb = bid, nb = G;
            tr_job<TR_PLAIN>(p.w_oa, nullptr, 1024, 1024, 1024, Woa, scr, lane, gw, NGW);
            tr_job<TR_PLAIN>(p.w_out, nullptr, 1024, 1024, 1024, Wout, scr, lane, gw, NGW);
    for (int idx = tb * NTHREADS + tid; idx < 65536; idx += nb * NTHREADS) {
            const int n = idx & 1023, c8 = idx >> 10, g = c8 >> 4, cb = (c8 & 15) * 8;
            float a[8];
    #pragma unroll
            for (int i = 0; i < 8; ++i) a[i] = 0.f;
            for (int j0 = 0; j0 < 128; j0 += 8) { float w[8]; f32x4 pw[8][2];
    #pragma unroll
                for (int jj = 0; jj < 8; ++jj) w[jj] = p.w_op[(size_t)(g * 128 + j0 + jj) * 1024 + n] * p.pool_scale[g * 128 + j0 + jj];
    #pragma unroll
                for (int i = 0; i < 8; ++i) { pw[i][0] = *(const f32x4*)(p.pool_w + (size_t)(g * 128 + cb + i) * 128 + j0); pw[i][1] = *(const f32x4*)(p.pool_w + (size_t)(g * 128 + cb + i) * 128 + j0 + 4); }
    #pragma unroll
                for (int i = 0; i < 8; ++i)
    #pragma unroll
                    for (int jj = 0; jj < 8; ++jj) a[i] = fmaf(pw[i][jj >> 2][jj & 3], w[jj], a[i]); }
            u32x4 o; o.x = cvt_pk_bf16(a[0], a[1]); o.y = cvt_pk_bf16(a[2], a[3]); o.z = cvt_pk_bf16(a[4], a[5]); o.w = cvt_pk_bf16(a[6], a[7]);
            *(u32x4*)(Wp + (size_t)n * 512 + c8 * 8) = o;
        }
        }
    }
    { pg8::Gemm g{CKVN, Wukv, M, 2048, KVL}; S.init(M, 2048, G, bid); pg8::EpiBf16 E{KV, 2048}; pg8::gemm_phase(ldsl, g, S, E); }
    GRID_SYNC();
    {
        const int vcu = (bid & 7) * (G >> 3) + (bid >> 3);
        for (int it = vcu; it < NB * NH * (SEQ / 256); it += G) {
            const int qb = it & 7, h = (it >> 3) & 7, b = it >> 6;
            const size_t tok0 = (size_t)b * SEQ;
            att::attn_body(Q + (tok0 + qb * 256) * 1536 + h * 192, KV + tok0 * 2048 + h * 128, KR + tok0 * 64, KV + tok0 * 2048 + 1024 + h * 128,
                           O + (tok0 + qb * 256) * 1024 + h * 128, SEQ, (char*)lds);
            __syncthreads();
        }
    }
    GRID_SYNC();
    { pg8::Gemm g{XN, Win + (size_t)1280 * 1024, M, 2048, 1024}; pg8::GateOrder GO; GO.s.init(M, 1024, G, bid); pg8::EpiGate E{Gt}; pg8::gemm_phase(ldsl, g, GO, E); }
    { pg8::Gemm g{O, Woa, M, 1024, 1024}; S.init(M, 1024, G, bid); pg8::EpiT1 E{Gt, F}; pg8::gemm_phase(ldsl, g, S, E); }
    { pg8::Gemm g{DP, Wp, M, 1024, 512}; S.init(M, 1024, G, bid); pg8::EpiMX E{Gt, F, XN}; pg8::gemm_phase(ldsl, g, S, E); }
    GRID_SYNC();
    { pg8::Gemm g{XN, Wout, M, 1024, 1024}; S.init(M, 1024, G, bid);
      pg8::EpiResNorm<false, false> E{nullptr, (bf16_t*)X, nullptr, XN, 1.0f, p.mix_post, p.f2_pre, pg8::PanelSumSq{xbuf0 + (size_t)M * 8, cnt0 + 2 * 4096}, pg8::PanelSumSq{xbuf0 + (size_t)M * 12, cnt0 + 3 * 4096}}; pg8::gemm_phase(ldsl, g, S, E); }
    GRID_SYNC();
    { pg8::Gemm g{XN, Wgu, M, 5632, 1024}; S.init(M, 5632, G, bid); pg8::EpiSwiGLU E{H}; pg8::gemm_phase(ldsl, g, S, E); }
    GRID_SYNC();
    { pg8::Gemm g{H, Wd, M, 1024, DFF}; S.init(M, 1024, G, bid);
      pg8::EpiResNorm<true, false> E{nullptr, (bf16_t*)X, X, nullptr, 0.5f, p.f2_post, p.final_g, pg8::PanelSumSq{xbuf0 + (size_t)M * 16, cnt0 + 4 * 4096}, pg8::PanelSumSq{xbuf0 + (size_t)M * 20, cnt0 + 5 * 4096}}; pg8::gemm_phase(ldsl, g, S, E); }
}

extern "C" void kernel_launch(void* const* d_in, const int* in_sizes, int n_in, void* d_out, int out_size, void* d_ws, size_t ws_size, hipStream_t stream) {
    static int grid_blocks = 0;
    if (grid_blocks == 0) {
        if (n_in != 26 || in_sizes[0] != M * DM || out_size != M * DM || ws_size < WS_END) { fprintf(stderr, "kernel_launch: shape mismatch n_in %d in0 %d out %d ws %zu\n", n_in, n_in > 0 ? in_sizes[0] : -1, out_size, ws_size); grid_blocks = -1; return; }
        int dev = 0, cus = 0, per_cu = 0;
        (void)hipGetDevice(&dev);
        (void)hipDeviceGetAttribute(&cus, hipDeviceAttributeMultiprocessorCount, dev);
        if (hipFuncSetAttribute((const void*)fwd_megakernel, hipFuncAttributeMaxDynamicSharedMemorySize, LDS_BYTES) != hipSuccess) { fprintf(stderr, "kernel_launch: hipFuncSetAttribute failed\n"); grid_blocks = -1; return; }
        if (hipOccupancyMaxActiveBlocksPerMultiprocessor(&per_cu, (const void*)fwd_megakernel, NTHREADS, LDS_BYTES) != hipSuccess || per_cu < 1) { fprintf(stderr, "kernel_launch: occupancy query failed (%d)\n", per_cu); (void)hipGetLastError(); per_cu = 1; }
        grid_blocks = cus * 1;
        if (grid_blocks != 256) { fprintf(stderr, "kernel_launch: built for 256 CUs (one workgroup each), device has %d\n", cus); grid_blocks = -1; return; }
    }
    if (grid_blocks < 0) return;
    Params p{};
    p.x = (const float*)d_in[0]; p.pos = (const int*)d_in[1];
    p.f1_pre = (const float*)d_in[2]; p.f1_wg = (const float*)d_in[3]; p.f1_wu = (const float*)d_in[4]; p.f1_wd = (const float*)d_in[5]; p.f1_post = (const float*)d_in[6];
    p.mix_pre = (const float*)d_in[7]; p.w_in = (const float*)d_in[8]; p.qa_g = (const float*)d_in[9]; p.w_uq = (const float*)d_in[10]; p.kva_g = (const float*)d_in[11];
    p.w_uk = (const float*)d_in[12]; p.w_uv = (const float*)d_in[13]; p.w_oa = (const float*)d_in[14]; p.pool_w = (const float*)d_in[15]; p.pool_scale = (const float*)d_in[16];
    p.w_op = (const float*)d_in[17]; p.w_out = (const float*)d_in[18]; p.mix_post = (const float*)d_in[19];
    p.f2_pre = (const float*)d_in[20]; p.f2_wg = (const float*)d_in[21]; p.f2_wu = (const float*)d_in[22]; p.f2_wd = (const float*)d_in[23]; p.f2_post = (const float*)d_in[24]; p.final_g = (const float*)d_in[25];
    p.out = (float*)d_out; p.ws = (unsigned char*)d_ws;
    for (int i = 0; i < 32; ++i) p.inv_freq[i] = (float)pow(10000.0, -(2.0 * i) / 64.0);
    if (hipMemsetAsync((char*)d_ws + OFF_BAR, 0, CTL_BYTES, stream) != hipSuccess) { fprintf(stderr, "kernel_launch: memset failed\n"); return; }
    void* args[] = {&p};
    hipError_t e = hipLaunchCooperativeKernel((const void*)fwd_megakernel, dim3(grid_blocks), dim3(NTHREADS), args, LDS_BYTES, stream);
    if (e != hipSuccess) fprintf(stderr, "cooperative launch failed: %s (grid %d)\n", hipGetErrorString(e), grid_blocks);
}
```

```cpp
#include <hip/hip_runtime.h>
#include <hip/hip_cooperative_groups.h>
#include <cstdio>
#include <cmath>
#include <cstdint>
namespace cg = cooperative_groups;

#define LAS __attribute__((address_space(3)))
typedef unsigned short bf16_t;
typedef short bf16x8 __attribute__((ext_vector_type(8)));
typedef short s16x4 __attribute__((ext_vector_type(4)));
typedef float f32x2 __attribute__((ext_vector_type(2)));
typedef float f32x4 __attribute__((ext_vector_type(4)));
typedef float f32x16 __attribute__((ext_vector_type(16)));
typedef unsigned u32x4 __attribute__((ext_vector_type(4)));
typedef unsigned u32x2 __attribute__((ext_vector_type(2)));

constexpr int DM = 1024, NB = 8, SEQ = 2048, M = NB * SEQ, NH = 8, QL = 384, KVL = 256, DFF = 2816, INW = 3264;
constexpr float EPS = 1e-6f;
constexpr int NTHREADS = 512, NWAVES = 8;
constexpr int LDS_STAGE = 131072, LDS_BYTES = LDS_STAGE + 16;

constexpr size_t MiB = 1048576;
constexpr size_t OFF_WGU = 0;
constexpr size_t OFF_WD = OFF_WGU + (size_t)5632 * 1024 * 2;
constexpr size_t OFF_WIN = OFF_WD + (size_t)1024 * 2816 * 2;
constexpr size_t OFF_WUQ = OFF_WIN + (size_t)3328 * 1024 * 2;
constexpr size_t OFF_WUKV = OFF_WUQ + (size_t)1536 * 384 * 2;
constexpr size_t OFF_WOA = OFF_WUKV + (size_t)2048 * 256 * 2;
constexpr size_t OFF_WP = OFF_WOA + (size_t)1024 * 1024 * 2;
constexpr size_t OFF_WOUT = OFF_WP + (size_t)1024 * 512 * 2;
constexpr size_t OFF_XN = OFF_WOUT + (size_t)1024 * 1024 * 2;
constexpr size_t OFF_R = OFF_XN + 32 * MiB;
constexpr size_t OFF_F = OFF_R;
constexpr size_t OFF_ZF = OFF_R;
constexpr size_t OFF_KV = OFF_R;
constexpr size_t OFF_H = OFF_R + 64 * MiB;
constexpr size_t OFF_O = OFF_R + 64 * MiB;
constexpr size_t OFF_CQN = OFF_R + 80 * MiB;
constexpr size_t OFF_CKVN = OFF_R + 92 * MiB;
constexpr size_t OFF_TAB = OFF_R + 100 * MiB;
constexpr size_t OFF_Q = OFF_R + 104 * MiB;
constexpr size_t OFF_KR = OFF_R + 152 * MiB;
constexpr size_t OFF_G = OFF_R + 96 * MiB;
constexpr size_t OFF_DP = OFF_R + 176 * MiB;
constexpr size_t WS_END = OFF_R + 192 * MiB;
constexpr size_t OFF_BAR = WS_END, OFF_CNT = OFF_BAR + 16384, CTL_BYTES = 16384 + 6 * 16384, OFF_XBUF = OFF_BAR + CTL_BYTES;
static_assert(OFF_XBUF + 6 * (size_t)M * 16 <= 256 * MiB, "workspace");

struct Params {
    const float* x; const int* pos;
    const float *f1_pre, *f1_wg, *f1_wu, *f1_wd, *f1_post;
    const float *mix_pre, *w_in, *qa_g, *w_uq, *kva_g, *w_uk, *w_uv, *w_oa, *pool_w, *pool_scale, *w_op, *w_out, *mix_post;
    const float *f2_pre, *f2_wg, *f2_wu, *f2_wd, *f2_post, *final_g;
    float* out; unsigned char* ws;
    float inv_freq[32];
};

typedef __bf16 bf16x2_t __attribute__((ext_vector_type(2)));
__device__ __forceinline__ unsigned cvt_pk_bf16(float lo, float hi) { const f32x2 v = {lo, hi}; const bf16x2_t r = __builtin_convertvector(v, bf16x2_t); return __builtin_bit_cast(unsigned, r); }
__device__ __forceinline__ float bf_lo(unsigned w) { return __uint_as_float(w << 16); }
__device__ __forceinline__ float bf_hi(unsigned w) { return __uint_as_float(w & 0xffff0000u); }
__device__ __forceinline__ float sigmoidf_fast(float z) { return __builtin_amdgcn_rcpf(1.f + __builtin_amdgcn_exp2f(-1.4426950408889634f * z)); }
__device__ __forceinline__ int fresh_tid() { int t = threadIdx.x; asm volatile("" : "+v"(t)); return t; }
__device__ __forceinline__ float wave_sum(float v) {
#pragma unroll
    for (int o = 1; o < 64; o <<= 1) v += __shfl_xor(v, o);
    return v;
}

namespace pg8 {
constexpr int BM = 256, BK = 64, HALF = 128, HTB = HALF * BK * 2, STAGE_BYTES = 8 * HTB, NXCD = 8, WGM = 4;
__host__ __device__ __forceinline__ int lds_byte(int r, int c) { const int st = (r >> 4) * 2 + (c >> 5), rr = r & 15, cc = c & 31, ob = rr * 64 + cc * 2; return st * 1024 + (ob ^ (((ob >> 9) & 1) << 5)); }
__host__ __device__ __forceinline__ void stage_rc(int b, int& R, int& C) { const int st = b / 1024, sb = b % 1024, swz = sb ^ (((sb >> 9) & 1) << 5); R = (st >> 1) * 16 + swz / 64; C = (st & 1) * 32 + (swz % 64) / 2; }
__host__ __device__ __forceinline__ int perm32(int rho) { const int n = rho >> 4, i = rho & 15; return 8 * (i >> 2) + 4 * n + (i & 3); }
struct Unit { int pm, pn; };
struct Gemm { const bf16_t* A; const bf16_t* Bt; int M, N, K; };
struct StaticOrder {
    int nM, nN, nwg, G, c;
    __device__ void init(int M_, int N_, int G_, int c_) { nM = M_ / BM; nN = N_ / BM; nwg = nM * nN; G = G_; c = c_; }
    __device__ bool next(int i, Unit& u) const {
        const long L = (long)i * G + c; if (L >= nwg) return false;
        int wgid = (int)L; { const int q = nwg / NXCD, r = nwg % NXCD, xcd = wgid % NXCD, off = wgid / NXCD; wgid = (xcd < r ? xcd * (q + 1) : r * (q + 1) + (xcd - r) * q) + off; }
        const int nig = WGM * nN, gid = wgid / nig, fm = gid * WGM, gsz = (nM - fm) < WGM ? (nM - fm) : WGM;
        u.pm = fm + ((wgid % nig) % gsz); u.pn = (wgid % nig) / gsz; return true;
    }
};

struct GateOrder { StaticOrder s;
    __device__ bool next(int i, Unit& u) const { if (i >= 2) return false; Unit b; if (!s.next(0, b)) return false; u.pm = b.pm; u.pn = b.pn + 4 * i; return true; } };
template <class Epi, class Sched>
__device__ __forceinline__ void gemm_phase(LAS unsigned char* lds, const Gemm g, const Sched& S, const Epi& E) {
    const int tid = fresh_tid(), wid = __builtin_amdgcn_readfirstlane(tid >> 6), lane = tid & 63, wr = wid >> 2, wc = wid & 3, fr = lane & 15, fq = lane >> 4;
    const int K = g.K, nt = K / BK;
    unsigned voffA, voffB;
    { int R, C; stage_rc(tid * 16, R, C); const int Rb = Epi::PERM ? ((R & ~31) + perm32(R & 31)) : R;
      voffA = (unsigned)(R * K + C) * 2u; voffB = (unsigned)(Rb * K + C) * 2u; }
    const size_t rstep64 = (size_t)64 * K * 2;
    const size_t kstep = (size_t)(BK * 2);
    const size_t hstep = (size_t)HALF * K * 2;
    const size_t tstep = 2 * hstep;
    const unsigned ldsw = (unsigned)wid * 1024u;
    const int aoff = lds_byte(wr * 64 + fr, fq * 8), boff = lds_byte(wc * 32 + fr, fq * 8);
#define PG8_SA(b, h) (((b) * 2 + (h)) * HTB)
#define PG8_SB(b, h) ((4 + (b) * 2 + (h)) * HTB)
#define PG8_STAGE(bufoff, gbase, voff) do { _Pragma("unroll") for (int _i = 0; _i < 2; ++_i) \
        __builtin_amdgcn_global_load_lds((const unsigned*)((const char*)(gbase) + _i * rstep64 + (voff)), (LAS unsigned*)(lds + (bufoff) + ldsw + _i * 8192), 16, 0, 0); } while (0)
#define PG8_LDA(dst, b, h) do { _Pragma("unroll") for (int m = 0; m < 4; ++m) _Pragma("unroll") for (int k = 0; k < 2; ++k) dst[m][k] = *(const LAS bf16x8*)(lds + PG8_SA(b, h) + aoff + m * 2048 + k * 1024); } while (0)
#define PG8_LDB(dst, b, h) do { _Pragma("unroll") for (int n = 0; n < 2; ++n) _Pragma("unroll") for (int k = 0; k < 2; ++k) dst[n][k] = *(const LAS bf16x8*)(lds + PG8_SB(b, h) + boff + n * 2048 + k * 1024); } while (0)
#define PG8_MMA(ai, bj, At, Bt) do { __builtin_amdgcn_s_setprio(1); _Pragma("unroll") for (int m = 0; m < 4; ++m) _Pragma("unroll") for (int n = 0; n < 2; ++n) _Pragma("unroll") for (int k = 0; k < 2; ++k) \
        acc[ai][bj][m][n] = __builtin_amdgcn_mfma_f32_16x16x32_bf16(Bt[n][k], At[m][k], acc[ai][bj][m][n], 0, 0, 0); __builtin_amdgcn_s_setprio(0); } while (0)
#define PG8_WAIT_V(n) asm volatile("s_waitcnt vmcnt(" #n ")" ::: "memory")
#define PG8_WAIT_L(n) asm volatile("s_waitcnt lgkmcnt(" #n ")" ::: "memory")
#define PG8_BAR __builtin_amdgcn_s_barrier()
#define PG8_SCHED __builtin_amdgcn_sched_barrier(0)
    Unit cur, nxt; int ui = 0;
    if (!S.next(0, cur)) return;
    f32x4 acc[2][2][4][2];
#pragma unroll
    for (int a = 0; a < 2; ++a)
#pragma unroll
        for (int b = 0; b < 2; ++b)
#pragma unroll
            for (int m = 0; m < 4; ++m)
#pragma unroll
                for (int n = 0; n < 2; ++n) acc[a][b][m][n] = (f32x4){0.f, 0.f, 0.f, 0.f};
    bf16x8 At[4][2], B0[2][2], B1[2][2];
    const char* cA = (const char*)g.A + (size_t)cur.pm * tstep; const char* cB = (const char*)g.Bt + (size_t)cur.pn * tstep;
    PG8_STAGE(PG8_SB(0, 0), cB, voffB); PG8_STAGE(PG8_SA(0, 0), cA, voffA); PG8_STAGE(PG8_SB(0, 1), cB + hstep, voffB); PG8_STAGE(PG8_SA(0, 1), cA + hstep, voffA);
    if (wr == 1) PG8_BAR;
    PG8_WAIT_V(4); PG8_BAR;
    PG8_STAGE(PG8_SB(1, 0), cB + kstep, voffB); PG8_STAGE(PG8_SA(1, 0), cA + kstep, voffA); PG8_STAGE(PG8_SB(1, 1), cB + hstep + kstep, voffB);
    PG8_WAIT_V(6); PG8_BAR;
    for (;;) {
        const bool has_next = S.next(ui + 1, nxt);
        const char* nA = has_next ? (const char*)g.A + (size_t)nxt.pm * tstep : cA; const char* nB = has_next ? (const char*)g.Bt + (size_t)nxt.pn * tstep : cB;
        for (int t = 0; t < nt; t += 2) {
            const bool last = (t == nt - 2);
            const char* a1 = cA + (size_t)(t + 1) * kstep;
            const char* a2 = last ? nA : cA + (size_t)(t + 2) * kstep; const char* b2 = last ? nB : cB + (size_t)(t + 2) * kstep;
            const char* a3 = a2 + kstep; const char* b3 = b2 + kstep;
            PG8_LDB(B0, 0, 0); PG8_SCHED; PG8_LDA(At, 0, 0); PG8_STAGE(PG8_SA(1, 1), a1 + hstep, voffA);
            PG8_WAIT_L(8); PG8_BAR; PG8_WAIT_L(0); PG8_MMA(0, 0, At, B0); PG8_BAR; PG8_SCHED;
            PG8_LDB(B1, 0, 1); PG8_STAGE(PG8_SB(0, 0), b2, voffB);
            PG8_BAR; PG8_WAIT_L(0); PG8_MMA(0, 1, At, B1); PG8_BAR;
            PG8_LDA(At, 0, 1); PG8_STAGE(PG8_SA(0, 0), a2, voffA);
            PG8_BAR; PG8_WAIT_L(0); PG8_MMA(1, 0, At, B0); PG8_BAR; PG8_SCHED;
            PG8_STAGE(PG8_SB(0, 1), b2 + hstep, voffB);
            PG8_WAIT_V(6); PG8_BAR; PG8_MMA(1, 1, At, B1); PG8_BAR;
            PG8_LDB(B0, 1, 0); PG8_SCHED; PG8_LDA(At, 1, 0); PG8_STAGE(PG8_SA(0, 1), a2 + hstep, voffA);
            PG8_WAIT_L(8); PG8_BAR; PG8_WAIT_L(0); PG8_MMA(0, 0, At, B0); PG8_BAR; PG8_SCHED;
            PG8_LDB(B1, 1, 1); PG8_STAGE(PG8_SB(1, 0), b3, voffB);
            PG8_BAR; PG8_WAIT_L(0); PG8_MMA(0, 1, At, B1); PG8_BAR;
            PG8_LDA(At, 1, 1); PG8_STAGE(PG8_SA(1, 0), a3, voffA);
            PG8_BAR; PG8_WAIT_L(0); PG8_MMA(1, 0, At, B0); PG8_BAR; PG8_SCHED;
            PG8_STAGE(PG8_SB(1, 1), b3 + hstep, voffB);
            PG8_WAIT_V(6); PG8_BAR; PG8_MMA(1, 1, At, B1); PG8_BAR;
        }
        if constexpr (!Epi::AFTER_DRAIN) { const int t2 = fresh_tid(); E(acc, cur, wr, wc, t2 & 15, (t2 >> 4) & 3); }
        if (!has_next) break;
#pragma unroll
        for (int a = 0; a < 2; ++a)
#pragma unroll
            for (int b = 0; b < 2; ++b)
#pragma unroll
                for (int m = 0; m < 4; ++m)
#pragma unroll
                    for (int n = 0; n < 2; ++n) acc[a][b][m][n] = (f32x4){0.f, 0.f, 0.f, 0.f};
        cur = nxt; cA = nA; cB = nB; ++ui;
    }
    PG8_WAIT_V(0);
    if (wr == 0) PG8_BAR;
    PG8_BAR;
    if constexpr (Epi::AFTER_DRAIN) { const int t2 = fresh_tid(); E.fused(acc, cur, wr, wc, t2 & 15, (t2 >> 4) & 3, lds, t2 >> 6, t2 & 63); }
#undef PG8_SA
#undef PG8_SB
#undef PG8_STAGE
#undef PG8_LDA
#undef PG8_LDB
#undef PG8_MMA
#undef PG8_WAIT_V
#undef PG8_WAIT_L
#undef PG8_BAR
#undef PG8_SCHED
}

typedef f32x4 Acc[2][2][4][2];
struct EpiF32 {
    static constexpr bool PERM = false, AFTER_DRAIN = false;
    float* C; int ldc;
    __device__ __forceinline__ void operator()(const Acc& acc, const Unit& u, int wr, int wc, int fr, int fq) const {
        const int row0 = u.pm * BM + wr * 64 + fr, col0 = u.pn * BM + wc * 32 + 4 * fq;
#pragma unroll
        for (int ai = 0; ai < 2; ++ai)
#pragma unroll
            for (int m = 0; m < 4; ++m) { float* rowp = C + (size_t)(row0 + ai * HALF + m * 16) * ldc + col0;
#pragma unroll
                for (int bj = 0; bj < 2; ++bj)
#pragma unroll
                    for (int n = 0; n < 2; ++n) *(f32x4*)(rowp + bj * HALF + n * 16) = acc[ai][bj][m][n]; }
    }
};
struct EpiBf16 {
    static constexpr bool PERM = true, AFTER_DRAIN = false;
    bf16_t* O; int ldc;
    __device__ __forceinline__ void operator()(const Acc& acc, const Unit& u, int wr, int wc, int fr, int fq) const {
        const int row0 = u.pm * BM + wr * 64 + fr, col0 = u.pn * BM + wc * 32 + 8 * fq;
#pragma unroll
        for (int ai = 0; ai < 2; ++ai)
#pragma unroll
            for (int m = 0; m < 4; ++m) { bf16_t* rowp = O + (size_t)(row0 + ai * HALF + m * 16) * ldc + col0;
#pragma unroll
                for (int bj = 0; bj < 2; ++bj) { const f32x4 v0 = acc[ai][bj][m][0], v1 = acc[ai][bj][m][1];
                    u32x4 w; w.x = cvt_pk_bf16(v0[0], v0[1]); w.y = cvt_pk_bf16(v0[2], v0[3]); w.z = cvt_pk_bf16(v1[0], v1[1]); w.w = cvt_pk_bf16(v1[2], v1[3]);
                    *(u32x4*)(rowp + bj * HALF) = w; } }
    }
};
struct EpiSwiGLU {
    static constexpr bool PERM = true, AFTER_DRAIN = false;
    bf16_t* H;
    __device__ __forceinline__ void operator()(const Acc& acc, const Unit& u, int wr, int wc, int fr, int fq) const {
        const int row0 = u.pm * BM + wr * 64 + fr, col0 = u.pn * HALF + wc * 32 + 8 * fq;
#pragma unroll
        for (int ai = 0; ai < 2; ++ai)
#pragma unroll
            for (int m = 0; m < 4; ++m) { bf16_t* rowp = H + (size_t)(row0 + ai * HALF + m * 16) * DFF + col0;
                float h[8];
#pragma unroll
                for (int n = 0; n < 2; ++n)
#pragma unroll
                    for (int j = 0; j < 4; ++j) { const float gt = acc[ai][0][m][n][j], up = acc[ai][1][m][n][j]; h[n * 4 + j] = gt * sigmoidf_fast(gt) * up; }
                u32x4 w; w.x = cvt_pk_bf16(h[0], h[1]); w.y = cvt_pk_bf16(h[2], h[3]); w.z = cvt_pk_bf16(h[4], h[5]); w.w = cvt_pk_bf16(h[6], h[7]);
                *(u32x4*)rowp = w; }
    }
};
struct EpiGate {
    static constexpr bool PERM = true, AFTER_DRAIN = false;
    bf16_t* G;
    __device__ __forceinline__ void operator()(const Acc& acc, const Unit& u, int wr, int wc, int fr, int fq) const {
        const int row0 = u.pm * BM + wr * 64 + fr, col0 = u.pn * BM + wc * 32 + 8 * fq;
#pragma unroll
        for (int ai = 0; ai < 2; ++ai)
#pragma unroll
            for (int m = 0; m < 4; ++m) { bf16_t* rowp = G + (size_t)(row0 + ai * HALF + m * 16) * 2048 + col0;
#pragma unroll
                for (int bj = 0; bj < 2; ++bj) { const f32x4 v0 = acc[ai][bj][m][0], v1 = acc[ai][bj][m][1];
                    u32x4 w; w.x = cvt_pk_bf16(sigmoidf_fast(v0[0]), sigmoidf_fast(v0[1])); w.y = cvt_pk_bf16(sigmoidf_fast(v0[2]), sigmoidf_fast(v0[3]));
                    w.z = cvt_pk_bf16(sigmoidf_fast(v1[0]), sigmoidf_fast(v1[1])); w.w = cvt_pk_bf16(sigmoidf_fast(v1[2]), sigmoidf_fast(v1[3]));
                    *(u32x4*)(rowp + bj * HALF) = w; } }
    }
};
struct EpiQ {
    static constexpr bool PERM = true, AFTER_DRAIN = false;
    bf16_t* Q; const float* TAB;
    __device__ __forceinline__ void operator()(const Acc& acc, const Unit& u, int wr, int wc, int fr, int fq) const {
        const int row0 = u.pm * BM + wr * 64 + fr, col0 = u.pn * BM + wc * 32 + 8 * fq;
#pragma unroll
        for (int ai = 0; ai < 2; ++ai)
#pragma unroll
            for (int m = 0; m < 4; ++m) { const int row = row0 + ai * HALF + m * 16; bf16_t* rowp = Q + (size_t)row * 1536 + col0;
#pragma unroll
                for (int bj = 0; bj < 2; ++bj) { f32x4 v0 = acc[ai][bj][m][0], v1 = acc[ai][bj][m][1];
                    const int c = col0 + bj * HALF, w = c % 192;
                    if (w >= 128) { const int i0 = (w - 128) >> 1; const f32x4 cs = *(const f32x4*)(TAB + (size_t)row * 64 + i0), sn = *(const f32x4*)(TAB + (size_t)row * 64 + 32 + i0);
                        f32x4 r0, r1;
                        r0[0] = v0[0] * cs[0] - v0[1] * sn[0]; r0[1] = v0[1] * cs[0] + v0[0] * sn[0];
                        r0[2] = v0[2] * cs[1] - v0[3] * sn[1]; r0[3] = v0[3] * cs[1] + v0[2] * sn[1];
                        r1[0] = v1[0] * cs[2] - v1[1] * sn[2]; r1[1] = v1[1] * cs[2] + v1[0] * sn[2];
                        r1[2] = v1[2] * cs[3] - v1[3] * sn[3]; r1[3] = v1[3] * cs[3] + v1[2] * sn[3];
                        v0 = r0; v1 = r1; }
                    u32x4 wv; wv.x = cvt_pk_bf16(v0[0], v0[1]); wv.y = cvt_pk_bf16(v0[2], v0[3]); wv.z = cvt_pk_bf16(v1[0], v1[1]); wv.w = cvt_pk_bf16(v1[2], v1[3]);
                    *(u32x4*)(rowp + bj * HALF) = wv; } }
    }
};
struct EpiT1 {
    static constexpr bool PERM = true, AFTER_DRAIN = false;
    const bf16_t* G; bf16_t* F;
    __device__ __forceinline__ void operator()(const Acc& acc, const Unit& u, int wr, int wc, int fr, int fq) const {
        const int row0 = u.pm * BM + wr * 64 + fr, col0 = u.pn * BM + wc * 32 + 8 * fq;
#pragma unroll
        for (int ai = 0; ai < 2; ++ai)
#pragma unroll
            for (int m = 0; m < 4; ++m) { const int row = row0 + ai * HALF + m * 16;
#pragma unroll
                for (int bj = 0; bj < 2; ++bj) { const f32x4 v0 = acc[ai][bj][m][0], v1 = acc[ai][bj][m][1]; const int c = col0 + bj * HALF;
                    const u32x4 gw = *(const u32x4*)(G + (size_t)row * 2048 + c);
                    u32x4 wv;
                    wv.x = cvt_pk_bf16(v0[0] * bf_lo(gw.x), v0[1] * bf_hi(gw.x)); wv.y = cvt_pk_bf16(v0[2] * bf_lo(gw.y), v0[3] * bf_hi(gw.y));
                    wv.z = cvt_pk_bf16(v1[0] * bf_lo(gw.z), v1[1] * bf_hi(gw.z)); wv.w = cvt_pk_bf16(v1[2] * bf_lo(gw.w), v1[3] * bf_hi(gw.w));
                    *(u32x4*)(F + (size_t)row * 1024 + c) = wv; } }
    }
};
struct EpiMX {
    static constexpr bool PERM = true, AFTER_DRAIN = false;
    const bf16_t* G; const bf16_t* F; bf16_t* MX;
    __device__ __forceinline__ void operator()(const Acc& acc, const Unit& u, int wr, int wc, int fr, int fq) const {
        const int row0 = u.pm * BM + wr * 64 + fr, col0 = u.pn * BM + wc * 32 + 8 * fq;
#pragma unroll
        for (int ai = 0; ai < 2; ++ai)
#pragma unroll
            for (int m = 0; m < 4; ++m) { const int row = row0 + ai * HALF + m * 16;
#pragma unroll
                for (int bj = 0; bj < 2; ++bj) { const f32x4 v0 = acc[ai][bj][m][0], v1 = acc[ai][bj][m][1]; const int c = col0 + bj * HALF;
                    const u32x4 gw = *(const u32x4*)(G + (size_t)row * 2048 + 1024 + c);
                    const u32x4 tw = *(const u32x4*)(F + (size_t)row * 1024 + c);
                    u32x4 wv;
                    wv.x = cvt_pk_bf16(bf_lo(tw.x) + v0[0] * bf_lo(gw.x), bf_hi(tw.x) + v0[1] * bf_hi(gw.x)); wv.y = cvt_pk_bf16(bf_lo(tw.y) + v0[2] * bf_lo(gw.y), bf_hi(tw.y) + v0[3] * bf_hi(gw.y));
                    wv.z = cvt_pk_bf16(bf_lo(tw.z) + v1[0] * bf_lo(gw.z), bf_hi(tw.z) + v1[1] * bf_hi(gw.z)); wv.w = cvt_pk_bf16(bf_lo(tw.w) + v1[2] * bf_lo(gw.w), bf_hi(tw.w) + v1[3] * bf_hi(gw.w));
                    *(u32x4*)(MX + (size_t)row * 1024 + c) = wv; } }
    }
};

struct PanelSumSq {
    float* xbuf;
    unsigned* cnt;
    __device__ __forceinline__ void run(const Acc& v, const Unit& u, int wr, int wc, int fr, int fq, LAS unsigned char* lds, int wid, int lane) const {
        LAS float* P = (LAS float*)lds; LAS float* S = (LAS float*)(lds + 4096);
#pragma unroll
        for (int ai = 0; ai < 2; ++ai)
#pragma unroll
            for (int m = 0; m < 4; ++m) { float q = 0.f;
#pragma unroll
                for (int bj = 0; bj < 2; ++bj)
#pragma unroll
                    for (int n = 0; n < 2; ++n) { const f32x4 x = v[ai][bj][m][n]; q += (x[0] * x[0] + x[1] * x[1]) + (x[2] * x[2] + x[3] * x[3]); }
                q += __shfl_xor(q, 16); q += __shfl_xor(q, 32);
                if (fq == 0) P[(ai * HALF + wr * 64 + m * 16 + fr) * 4 + wc] = q; }
        asm volatile("s_waitcnt lgkmcnt(0)" ::: "memory"); __builtin_amdgcn_s_barrier(); asm volatile("" ::: "memory");
        const int row = wid * 32 + (lane & 31);
        if (lane < 32) { const float t = (P[row * 4 + 0] + P[row * 4 + 1]) + (P[row * 4 + 2] + P[row * 4 + 3]);
            __hip_atomic_store(xbuf + ((size_t)(u.pm * BM + row) * 4 + u.pn), t, __ATOMIC_RELAXED, __HIP_MEMORY_SCOPE_AGENT); }
        asm volatile("s_waitcnt vmcnt(0)" ::: "memory");
        if (lane == 0) __hip_atomic_fetch_add(cnt + 64 * u.pm, 1u, __ATOMIC_RELAXED, __HIP_MEMORY_SCOPE_AGENT);
        if (wid == 0) { unsigned sp = 0u;
            while ((unsigned)__builtin_amdgcn_readfirstlane(__hip_atomic_load(cnt + 64 * u.pm, __ATOMIC_RELAXED, __HIP_MEMORY_SCOPE_AGENT)) < 32u) { __builtin_amdgcn_s_sleep(1); if (++sp > (1u << 22)) break; }
            __builtin_amdgcn_fence(__ATOMIC_ACQUIRE, "agent"); }
        asm volatile("s_waitcnt vmcnt(0) lgkmcnt(0)" ::: "memory"); __builtin_amdgcn_s_barrier(); asm volatile("" ::: "memory");
        if (lane < 32) { const float* slot = xbuf + (size_t)(u.pm * BM + row) * 4; float tot = 0.f;
#pragma unroll
            for (int t = 0; t < 4; ++t) tot += __hip_atomic_load(slot + t, __ATOMIC_RELAXED, __HIP_MEMORY_SCOPE_AGENT);
            S[row] = __builtin_amdgcn_rsqf(tot * (1.f / 1024.f) + EPS); }
        asm volatile("s_waitcnt lgkmcnt(0)" ::: "memory"); __builtin_amdgcn_s_barrier(); asm volatile("" ::: "memory");
    }
};
template <bool FINAL, bool BASEF32> struct EpiResNorm {
    static constexpr bool PERM = true, AFTER_DRAIN = true;
    const float* basef; bf16_t* xb; float* outf; bf16_t* xn; float wt; const float* gpost; const float* gnext; PanelSumSq st1, st2;
    __device__ __forceinline__ void operator()(const Acc&, const Unit&, int, int, int, int) const {}
    __device__ __forceinline__ void fused(Acc& acc, const Unit& u, int wr, int wc, int fr, int fq, LAS unsigned char* lds, int wid, int lane) const {
        const LAS float* S = (const LAS float*)(lds + 4096);
        const int col0 = u.pn * BM + wc * 32 + 8 * fq;
        st1.run(acc, u, wr, wc, fr, fq, lds, wid, lane);
#pragma unroll
        for (int ai = 0; ai < 2; ++ai)
#pragma unroll
            for (int m = 0; m < 4; ++m) { const int r = ai * HALF + wr * 64 + m * 16 + fr; const float sr = S[r] * wt;
                const size_t off = (size_t)(u.pm * BM + r) * 1024 + col0, xoff = (size_t)u.pm * 524288 + 262144 + (size_t)r * 1024 + col0;
#pragma unroll
                for (int bj = 0; bj < 2; ++bj) { f32x4 b0, b1;
                    if (BASEF32) { b0 = *(const f32x4*)(basef + off + bj * HALF); b1 = *(const f32x4*)(basef + off + bj * HALF + 4); }
                    else { const u32x4 w = *(const u32x4*)(xb + xoff + bj * HALF); b0 = (f32x4){bf_lo(w.x), bf_hi(w.x), bf_lo(w.y), bf_hi(w.y)}; b1 = (f32x4){bf_lo(w.z), bf_hi(w.z), bf_lo(w.w), bf_hi(w.w)}; }
                    const f32x4 g0 = *(const f32x4*)(gpost + col0 + bj * HALF), g1 = *(const f32x4*)(gpost + col0 + bj * HALF + 4);
                    acc[ai][bj][m][0] = b0 + acc[ai][bj][m][0] * g0 * sr; acc[ai][bj][m][1] = b1 + acc[ai][bj][m][1] * g1 * sr; }
                asm volatile("" : "+v"(acc[ai][0][m][0]), "+v"(acc[ai][0][m][1]), "+v"(acc[ai][1][m][0]), "+v"(acc[ai][1][m][1]));
                if (m & 1) asm volatile("" ::: "memory"); }
        st2.run(acc, u, wr, wc, fr, fq, lds, wid, lane);
#pragma unroll
        for (int ai = 0; ai < 2; ++ai)
#pragma unroll
            for (int m = 0; m < 4; ++m) { const int r = ai * HALF + wr * 64 + m * 16 + fr; const float sr = S[r];
                const size_t off = (size_t)(u.pm * BM + r) * 1024 + col0, xoff = (size_t)u.pm * 524288 + 262144 + (size_t)r * 1024 + col0;
#pragma unroll
                for (int bj = 0; bj < 2; ++bj) { const f32x4 x0 = acc[ai][bj][m][0], x1 = acc[ai][bj][m][1];
                    const f32x4 g0 = *(const f32x4*)(gnext + col0 + bj * HALF), g1 = *(const f32x4*)(gnext + col0 + bj * HALF + 4); const f32x4 o0 = x0 * g0 * sr, o1 = x1 * g1 * sr;
                    if (FINAL) { *(f32x4*)(outf + off + bj * HALF) = o0; *(f32x4*)(outf + off + bj * HALF + 4) = o1; }
                    else { u32x4 wx; wx.x = cvt_pk_bf16(x0[0], x0[1]); wx.y = cvt_pk_bf16(x0[2], x0[3]); wx.z = cvt_pk_bf16(x1[0], x1[1]); wx.w = cvt_pk_bf16(x1[2], x1[3]); *(u32x4*)(xb + xoff + bj * HALF) = wx;
                           u32x4 w; w.x = cvt_pk_bf16(o0[0], o0[1]); w.y = cvt_pk_bf16(o0[2], o0[3]); w.z = cvt_pk_bf16(o1[0], o1[1]); w.w = cvt_pk_bf16(o1[2], o1[3]); *(u32x4*)(xn + off + bj * HALF) = w; } }
                asm volatile("" ::: "memory"); }
    }
};
}

namespace att {
constexpr int NW = 8, QBLK = 32, KVBLK = 64;
constexpr float SCALE = 0.07216878364870322f;
constexpr float THR = 8.f;
constexpr int LDQ = 1536, LDKV = 2048, LDKR = 64, LDO = 1024;
constexpr int SHM_V = 64 * 128 * 2, SHM_K = 64 * 128 * 2, SHM_R = 64 * 64 * 2;
constexpr int NQL = 4;
constexpr int OFF_V = 0, OFF_K = 2 * SHM_V, OFF_RP = OFF_K + 2 * SHM_K, OFF_WS = OFF_RP + 2 * SHM_R, OFF_QL = OFF_WS + NW * 64 * 4, SHM_ATTN = OFF_QL + NW * NQL * 1024;
static_assert(SHM_ATTN <= LDS_STAGE, "lds");
#define KSWZ(row, colB) ((row) * 256 + ((colB) ^ (((row) & 15) << 4)))
#define RSWZ(row, colB) ((row) * 128 + ((colB) ^ ((((row) >> 1) & 7) << 4)))
#define SBAR() __builtin_amdgcn_sched_barrier(0)
__device__ __forceinline__ int crow(int r, int hi) { return (r & 3) + 8 * (r >> 2) + 4 * hi; }
__device__ __forceinline__ bf16x8 ld8(const bf16_t* p) { return *reinterpret_cast<const bf16x8*>(p); }

__device__ __forceinline__ void partialSM(f32x16& p0, f32x16& p1, float& m_reg, float& mn, float& alpha) {
    constexpr float C = SCALE * 1.4426950408889634f;
    float pmax = p0[0];
#pragma unroll
    for (int r = 1; r < 16; ++r) pmax = fmaxf(pmax, p0[r]);
#pragma unroll
    for (int r = 0; r < 16; ++r) pmax = fmaxf(pmax, p1[r]);
    { auto rr = __builtin_amdgcn_permlane32_swap(__float_as_uint(pmax), __float_as_uint(pmax), false, false);
      pmax = fmaxf(__uint_as_float(rr[0]), __uint_as_float(rr[1])); }
    if (__builtin_expect(__all(pmax - m_reg <= THR / SCALE), 1)) { mn = m_reg; alpha = 1.f; }
    else { mn = fmaxf(m_reg, pmax); alpha = __builtin_amdgcn_exp2f((m_reg - mn) * C); m_reg = mn; }
    float mnC = -mn * C;
#pragma unroll
    for (int r = 0; r < 16; ++r) p0[r] = fmaf(p0[r], C, mnC);
#pragma unroll
    for (int r = 0; r < 16; ++r) p1[r] = fmaf(p1[r], C, mnC);
#pragma unroll
    for (int r = 0; r < 16; ++r) p0[r] = __builtin_amdgcn_exp2f(p0[r]);
}
__device__ __forceinline__ void finishSM(f32x16& p0, f32x16& p1, float alpha, float& l_reg, bf16x8& pa0, bf16x8& pa1, bf16x8& pa2, bf16x8& pa3) {
#pragma unroll
    for (int r = 0; r < 16; ++r) p1[r] = __builtin_amdgcn_exp2f(p1[r]);
    float ps = 0;
#pragma unroll
    for (int r = 0; r < 16; ++r) ps += p0[r];
#pragma unroll
    for (int r = 0; r < 16; ++r) ps += p1[r];
    { auto rr = __builtin_amdgcn_permlane32_swap(__float_as_uint(ps), __float_as_uint(ps), false, false);
      ps = __uint_as_float(rr[0]) + __uint_as_float(rr[1]); }
    l_reg = l_reg * alpha + ps;
#define PK4(P, BASE, OUT) do { unsigned a0 = cvt_pk_bf16(P[BASE + 0], P[BASE + 1]), a1 = cvt_pk_bf16(P[BASE + 2], P[BASE + 3]);   \
    unsigned b0 = cvt_pk_bf16(P[BASE + 4], P[BASE + 5]), b1 = cvt_pk_bf16(P[BASE + 6], P[BASE + 7]);                              \
    auto r0 = __builtin_amdgcn_permlane32_swap(a0, b0, false, false); auto r1 = __builtin_amdgcn_permlane32_swap(a1, b1, false, false); \
    u32x4 w = {r0[0], r1[0], r0[1], r1[1]}; OUT = *reinterpret_cast<bf16x8*>(&w); } while (0)
    PK4(p0, 0, pa0); PK4(p0, 8, pa1); PK4(p1, 0, pa2); PK4(p1, 8, pa3);
#undef PK4
}
__device__ __forceinline__ void qkt(f32x16& p0, f32x16& p1, const char* Ks, const char* Rs, const bf16x8* qr, const char* ql, int r32, int hi) {
    p0 = f32x16{}; p1 = f32x16{};
#pragma unroll
    for (int d0 = 0; d0 < 8; ++d0) { int cb = (d0 * 16 + hi * 8) * 2;
        bf16x8 b0 = *reinterpret_cast<const bf16x8*>(Ks + KSWZ(r32, cb));
        bf16x8 b1 = *reinterpret_cast<const bf16x8*>(Ks + KSWZ(32 + r32, cb));
        p0 = __builtin_amdgcn_mfma_f32_32x32x16_bf16(b0, qr[d0], p0, 0, 0, 0);
        p1 = __builtin_amdgcn_mfma_f32_32x32x16_bf16(b1, qr[d0], p1, 0, 0, 0); }
#pragma unroll
    for (int d0 = 0; d0 < 4; ++d0) { int cb = (d0 * 16 + hi * 8) * 2;
        bf16x8 b0 = *reinterpret_cast<const bf16x8*>(Rs + RSWZ(r32, cb));
        bf16x8 b1 = *reinterpret_cast<const bf16x8*>(Rs + RSWZ(32 + r32, cb));
        const bf16x8 qv = *reinterpret_cast<const bf16x8*>(ql + d0 * 1024);
        p0 = __builtin_amdgcn_mfma_f32_32x32x16_bf16(b0, qv, p0, 0, 0, 0);
        p1 = __builtin_amdgcn_mfma_f32_32x32x16_bf16(b1, qv, p1, 0, 0, 0); }
}
__device__ __forceinline__ int v_st(int k, int c) { const int kk = (k & ~0xC) | ((k & 4) << 1) | ((k & 8) >> 1); return ((kk >> 3) * 4 + (c >> 5)) * 512 + ((kk & 7) * 32 + (c & 31)) * 2; }
__device__ __forceinline__ int v_rd_base(int lane) { return ((lane & 3) << 3) | (((lane >> 2) & 3) << 6) | (((lane >> 4) & 1) << 5) | (((lane >> 5) & 1) << 8); }
constexpr int v_rd_off(int d0, int ks, int half) { return d0 * 512 + ks * 4096 + half * 2048; }
template <int OFF> __device__ __forceinline__ s16x4 tr_read(int vb) {
    s16x4 r; asm volatile("ds_read_b64_tr_b16 %0, %1 offset:%2" : "=&v"(r) : "v"(vb), "i"(OFF) : "memory"); return r;
}
template <int D0> __device__ __forceinline__ void pv_one(f32x16& od, int vb, bf16x8 pa0, bf16x8 pa1, bf16x8 pa2, bf16x8 pa3) {
    const s16x4 l0 = tr_read<v_rd_off(D0, 0, 0)>(vb), h0 = tr_read<v_rd_off(D0, 0, 1)>(vb), l1 = tr_read<v_rd_off(D0, 1, 0)>(vb), h1 = tr_read<v_rd_off(D0, 1, 1)>(vb);
    const s16x4 l2 = tr_read<v_rd_off(D0, 2, 0)>(vb), h2 = tr_read<v_rd_off(D0, 2, 1)>(vb), l3 = tr_read<v_rd_off(D0, 3, 0)>(vb), h3 = tr_read<v_rd_off(D0, 3, 1)>(vb);
    asm volatile("s_waitcnt lgkmcnt(0)" ::: "memory"); SBAR();
#define PK(L, H) (bf16x8){L[0], L[1], L[2], L[3], H[0], H[1], H[2], H[3]}
    od = __builtin_amdgcn_mfma_f32_32x32x16_bf16(pa0, PK(l0, h0), od, 0, 0, 0);
    od = __builtin_amdgcn_mfma_f32_32x32x16_bf16(pa1, PK(l1, h1), od, 0, 0, 0);
    od = __builtin_amdgcn_mfma_f32_32x32x16_bf16(pa2, PK(l2, h2), od, 0, 0, 0);
    od = __builtin_amdgcn_mfma_f32_32x32x16_bf16(pa3, PK(l3, h3), od, 0, 0, 0);
#undef PK
}
__device__ __forceinline__ void pv_d0(f32x16* o, int vb, bf16x8 pa0, bf16x8 pa1, bf16x8 pa2, bf16x8 pa3) {
    pv_one<0>(o[0], vb, pa0, pa1, pa2, pa3); pv_one<1>(o[1], vb, pa0, pa1, pa2, pa3); pv_one<2>(o[2], vb, pa0, pa1, pa2, pa3); pv_one<3>(o[3], vb, pa0, pa1, pa2, pa3);
}

__device__ __forceinline__ void attn_body(const bf16_t* __restrict__ Qb, const bf16_t* __restrict__ Kn, const bf16_t* __restrict__ Kr, const bf16_t* __restrict__ Vh,
                                          bf16_t* __restrict__ Ob, int seq, char* lds) {
    const int tid = fresh_tid(), wid = tid >> 6, lane = tid & 63, r32 = lane & 31, hi = lane >> 5;
    char* V_lds = lds + OFF_V; char* K_lds = lds + OFF_K; char* R_lds = lds + OFF_RP;
    float* ws = (float*)(lds + OFF_WS) + wid * 64; float* li_l = ws; float* al_l = ws + 32;
    float m_reg = -1e30f, l_reg = 0; f32x16 o[4] = {}; bf16x8 qr[8];
    char* ql = lds + OFF_QL + wid * (NQL * 1024) + lane * 16;
    const bf16_t* Qw = Qb + (long)(wid * QBLK + r32) * LDQ + hi * 8;
#pragma unroll
    for (int d0 = 0; d0 < 8; ++d0) qr[d0] = ld8(Qw + d0 * 16);
#pragma unroll
    for (int d0 = 0; d0 < NQL; ++d0) *reinterpret_cast<bf16x8*>(ql + d0 * 1024) = ld8(Qw + (8 + d0) * 16);
    const int sr = tid >> 4, sc = (tid & 15) * 8, vst0 = v_st(sr, sc), vst1 = v_st(32 + sr, sc);
    const int rr_ = tid >> 3, rc_ = (tid & 7) * 8;
    const int vb0 = (int)(uintptr_t)V_lds + v_rd_base(lane);
    bf16x8 vs0, vs1, ks0, ks1, rs0;
#define SLOAD(k0) do { vs0 = ld8(&Vh[(long)((k0) + sr) * LDKV + sc]); vs1 = ld8(&Vh[(long)((k0) + 32 + sr) * LDKV + sc]); \
    ks0 = ld8(&Kn[(long)((k0) + sr) * LDKV + sc]); ks1 = ld8(&Kn[(long)((k0) + 32 + sr) * LDKV + sc]); rs0 = ld8(&Kr[(long)((k0) + rr_) * LDKR + rc_]); } while (0)
#define SWRITE(b) do { *(bf16x8*)(V_lds + (b) * SHM_V + vst0) = vs0; *(bf16x8*)(V_lds + (b) * SHM_V + vst1) = vs1; int kc = sc * 2; \
    *(bf16x8*)(K_lds + (b) * SHM_K + KSWZ(sr, kc)) = ks0; *(bf16x8*)(K_lds + (b) * SHM_K + KSWZ(32 + sr, kc)) = ks1; \
    *(bf16x8*)(R_lds + (b) * SHM_R + RSWZ(rr_, rc_ * 2)) = rs0; } while (0)
#define RESC(a) do { if (__any((a) < 1.f)) { if (hi == 0) al_l[r32] = (a); asm volatile("s_waitcnt lgkmcnt(0)" ::: "memory"); \
    _Pragma("unroll") for (int d = 0; d < 4; ++d) _Pragma("unroll") for (int r = 0; r < 16; ++r) o[d][r] *= al_l[crow(r, hi)]; } } while (0)
    f32x16 pA0, pA1, pB0, pB1; float mnA, mnB, alA, alB; bf16x8 pa0, pa1, pa2, pa3; const int NT = seq / KVBLK;
    SLOAD(0); asm volatile("s_waitcnt vmcnt(0)" ::: "memory"); SWRITE(0); __syncthreads();
    qkt(pA0, pA1, K_lds, R_lds, qr, ql, r32, hi); partialSM(pA0, pA1, m_reg, mnA, alA);
    SLOAD(KVBLK);
    asm volatile("s_waitcnt vmcnt(0)" ::: "memory"); SWRITE(1); __syncthreads();
    for (int j = 1; j + 1 < NT; j += 2) {
        SBAR(); qkt(pB0, pB1, K_lds + SHM_K, R_lds + SHM_R, qr, ql, r32, hi);
        finishSM(pA0, pA1, alA, l_reg, pa0, pa1, pa2, pa3); SBAR();
        SLOAD((j + 1) * KVBLK); SBAR();
        pv_d0(o, vb0, pa0, pa1, pa2, pa3); partialSM(pB0, pB1, m_reg, mnB, alB);
        __syncthreads(); asm volatile("s_waitcnt vmcnt(0)" ::: "memory"); SWRITE(0);
        RESC(alB); __syncthreads();
        SBAR(); qkt(pA0, pA1, K_lds, R_lds, qr, ql, r32, hi);
        finishSM(pB0, pB1, alB, l_reg, pa0, pa1, pa2, pa3); SBAR();
        SLOAD((j + 2) * KVBLK); SBAR();
        pv_d0(o, vb0 + SHM_V, pa0, pa1, pa2, pa3); partialSM(pA0, pA1, m_reg, mnA, alA);
        __syncthreads(); asm volatile("s_waitcnt vmcnt(0)" ::: "memory"); SWRITE(1);
        RESC(alA); __syncthreads();
    }
    SBAR(); qkt(pB0, pB1, K_lds + SHM_K, R_lds + SHM_R, qr, ql, r32, hi);
    finishSM(pA0, pA1, alA, l_reg, pa0, pa1, pa2, pa3); SBAR();
    pv_d0(o, vb0, pa0, pa1, pa2, pa3); partialSM(pB0, pB1, m_reg, mnB, alB);
    __syncthreads(); RESC(alB);
    finishSM(pB0, pB1, alB, l_reg, pa0, pa1, pa2, pa3); SBAR();
    pv_d0(o, vb0 + SHM_V, pa0, pa1, pa2, pa3);
    if (hi == 0) li_l[r32] = l_reg; asm volatile("s_waitcnt lgkmcnt(0)" ::: "memory");
    float rli[16];
#pragma unroll
    for (int r = 0; r < 16; ++r) rli[r] = __builtin_amdgcn_rcpf(li_l[crow(r, hi)]);
    bf16_t* Ow = Ob + (long)(wid * QBLK) * LDO;
#pragma unroll
    for (int r = 0; r < 16; ++r) { int orow = crow(r, hi);
#pragma unroll
        for (int d0 = 0; d0 < 4; ++d0) { const float v = o[d0][r] * rli[r]; Ow[(long)orow * LDO + d0 * 32 + r32] = (bf16_t)(cvt_pk_bf16(v, v) & 0xffffu); } }
#undef SLOAD
#undef SWRITE
#undef RESC
}
}


#define XB_TMO      128
#define XB_XCNT(j)  (256  + 64 * (j))
#define XB_XSUB(j)  (1280 + 64 * (j))
#define XB_XGEN(j)  (2304 + 64 * (j))
#define XB_TOP      3328
#define XB_TOPGEN   3392
#define XCD_BAR_WORDS 3456
#define XB_SPIN_CAP (1u << 18)
__device__ __forceinline__ unsigned xb_ld(unsigned* p)              { return __hip_atomic_load(p, __ATOMIC_RELAXED, __HIP_MEMORY_SCOPE_AGENT); }
__device__ __forceinline__ unsigned xb_add(unsigned* p, unsigned v) { return __hip_atomic_fetch_add(p, v, __ATOMIC_RELAXED, __HIP_MEMORY_SCOPE_AGENT); }
__device__ __forceinline__ unsigned xb_xcc_id() { return (unsigned)__builtin_amdgcn_s_getreg((3 << 11) | 20) & 0xFu; }
#define XB_SPIN(cond, bar) do { unsigned _sp = 0; while (cond) { __builtin_amdgcn_s_sleep(1); \
    if ((++_sp & 255u) == 0u) { if (xb_ld(&(bar)[XB_TMO])) break; if (_sp > XB_SPIN_CAP) { atomicAdd(&(bar)[XB_TMO], 1u); break; } } } } while (0)
struct XcdBarrier { unsigned* bar; unsigned x; volatile LAS unsigned* st; };
__device__ __forceinline__ XcdBarrier xcd_barrier_post(unsigned* bar, volatile LAS unsigned* st) {
    XcdBarrier b; b.bar = bar; b.x = xb_xcc_id(); b.st = st;
    if (threadIdx.x == 0) (void)xb_add(&bar[XB_XCNT(b.x)], 1u);
    return b;
}
__device__ __forceinline__ void xcd_barrier_complete(unsigned* bar, unsigned x, unsigned& nloc, unsigned& nx) {
    const unsigned G = gridDim.x * gridDim.y * gridDim.z;
    unsigned sum, cnt, mine, sp = 0u;
    for (;;) {
        sum = 0u; cnt = 0u; mine = 0u;
#pragma unroll
        for (unsigned j = 0; j < 16; ++j) { const unsigned c = xb_ld(&bar[XB_XCNT(j)]); sum += c; cnt += (c > 0u) ? 1u : 0u; mine = (j == x) ? c : mine; }
        if (sum == G) break;
        __builtin_amdgcn_s_sleep(1);
        if ((++sp & 255u) == 0u) { if (xb_ld(&bar[XB_TMO])) break; if (sp > XB_SPIN_CAP) { atomicAdd(&bar[XB_TMO], 1u); break; } }
    }
    nloc = mine > 0u ? mine : 1u; nx = cnt > 0u ? cnt : 1u;
}
__device__ __forceinline__ void xcd_barrier(const XcdBarrier& b) {
    asm volatile("s_waitcnt vmcnt(0)" ::: "memory");
    __syncthreads();
    if (threadIdx.x == 0) {
        unsigned* bar = b.bar;
        __builtin_amdgcn_s_waitcnt(0);
        unsigned nloc = b.st[0], nx = b.st[1];
        if (nloc == 0u) { xcd_barrier_complete(bar, b.x, nloc, nx); b.st[0] = nloc; b.st[1] = nx; }
        const unsigned old = xb_add(&bar[XB_XSUB(b.x)], 1u);
        const unsigned gen = old / nloc;
        if (old + 1u == (gen + 1u) * nloc) {
            __builtin_amdgcn_fence(__ATOMIC_RELEASE, "agent");
            asm volatile("s_waitcnt vmcnt(0)" ::: "memory");
            const unsigned og = xb_add(&bar[XB_TOP], 1u);
            const unsigned tg = og / nx;
            __builtin_amdgcn_fence(__ATOMIC_ACQUIRE, "agent");
            if (og + 1u == (tg + 1u) * nx) xb_add(&bar[XB_TOPGEN], 1u);
            else XB_SPIN(xb_ld(&bar[XB_TOPGEN]) == tg, bar);
            xb_add(&bar[XB_XGEN(b.x)], 1u);
            asm volatile("s_waitcnt vmcnt(0)" ::: "memory");
        } else {
            __builtin_amdgcn_fence(__ATOMIC_ACQUIRE, "agent");
            XB_SPIN(xb_ld(&bar[XB_XGEN(b.x)]) == gen, bar);
            asm volatile("s_waitcnt vmcnt(0)" ::: "memory");
        }
    }
    __syncthreads();
}

enum { TR_PLAIN = 0, TR_GU = 1, TR_WIN = 2, TR_UQ = 3, TR_UKV = 4 };
template <int MODE>
__device__ __forceinline__ void tr_job(const float* W0, const float* W1, int K, int Nsrc, int Nout, bf16_t* WT, LAS float* scr, int lane, int gw, int NGW) {
    const int nblk = Nout / 32, nitems = (K / 64) * nblk;
    for (int it = gw; it < nitems; it += NGW) {
        const int kb = it / nblk, nb = it % nblk, k0 = 64 * kb, n0 = 32 * nb, np = n0 + (lane & 31);
        const float* colp;
        if (MODE == TR_PLAIN) colp = W0 + np;
        else if (MODE == TR_GU) { const int t = np >> 8, w = np & 255; colp = (w < 128 ? W0 : W1) + t * 128 + (w & 127); }
        else if (MODE == TR_WIN) colp = np < 1216 ? W0 + np : (np < 1280 ? nullptr : W0 + (np - 64));
        else if (MODE == TR_UQ) { const int h = np / 192, w = np % 192; colp = W0 + (w < 128 ? np : h * 192 + 128 + ((w - 128) >> 1) + ((w - 128) & 1) * 32); }
        else colp = np < 1024 ? W0 + np : W1 + (np - 1024);
        float tv[32];
#pragma unroll
        for (int i = 0; i < 32; ++i) { const int kk = 2 * i + (lane >> 5); tv[i] = colp ? colp[(size_t)(k0 + kk) * Nsrc] : 0.f; }
#pragma unroll
        for (int i = 0; i < 32; ++i) { const int kk = 2 * i + (lane >> 5); scr[kk * 33 + (lane & 31)] = tv[i]; }
        asm volatile("s_waitcnt lgkmcnt(0)" ::: "memory");
        const int c = lane & 7;
#pragma unroll
        for (int j = 0; j < 4; ++j) { const int n = (lane >> 3) + 8 * j; const LAS float* s = scr + (8 * c) * 33 + n;
            u32x4 o; o.x = cvt_pk_bf16(s[0 * 33], s[1 * 33]); o.y = cvt_pk_bf16(s[2 * 33], s[3 * 33]); o.z = cvt_pk_bf16(s[4 * 33], s[5 * 33]); o.w = cvt_pk_bf16(s[6 * 33], s[7 * 33]);
            *(u32x4*)(WT + (size_t)(n0 + n) * K + k0 + 8 * c) = o; }
        asm volatile("s_waitcnt lgkmcnt(0)" ::: "memory");
    }
}

__device__ __forceinline__ void norm_rows(const float* xin, const float* gnext, bf16_t* xn, int gw, int NGW, int lane) {
    for (int row0 = gw; row0 < M; row0 += 2 * NGW) {
        f32x4 xv[2][4];
#pragma unroll
        for (int r = 0; r < 2; ++r) { const size_t row = (size_t)(row0 + r * NGW);
#pragma unroll
            for (int j = 0; j < 2; ++j) { xv[r][2 * j] = *(const f32x4*)(xin + row * DM + 8 * (lane + 64 * j)); xv[r][2 * j + 1] = *(const f32x4*)(xin + row * DM + 8 * (lane + 64 * j) + 4); } }
#pragma unroll
        for (int r = 0; r < 2; ++r) { const size_t row = (size_t)(row0 + r * NGW);
            float s2 = 0.f;
#pragma unroll
            for (int j = 0; j < 4; ++j) s2 += xv[r][j].x * xv[r][j].x + xv[r][j].y * xv[r][j].y + xv[r][j].z * xv[r][j].z + xv[r][j].w * xv[r][j].w;
            const float r2 = __builtin_amdgcn_rsqf(wave_sum(s2) * (1.f / DM) + EPS);
#pragma unroll
            for (int j = 0; j < 2; ++j) { const f32x4 g0 = *(const f32x4*)(gnext + 8 * (lane + 64 * j)), g1 = *(const f32x4*)(gnext + 8 * (lane + 64 * j) + 4);
                const f32x4 y0 = xv[r][2 * j] * g0 * r2, y1 = xv[r][2 * j + 1] * g1 * r2;
                u32x4 w; w.x = cvt_pk_bf16(y0.x, y0.y); w.y = cvt_pk_bf16(y0.z, y0.w); w.z = cvt_pk_bf16(y1.x, y1.y); w.w = cvt_pk_bf16(y1.z, y1.w);
                *(u32x4*)(xn + row * DM + 8 * (lane + 64 * j)) = w; }
        }
    }
}

__global__ void __launch_bounds__(NTHREADS, 2) fwd_megakernel(Params p) {
    extern __shared__ __attribute__((aligned(16))) unsigned char lds[];
    cg::grid_group grid = cg::this_grid();
    volatile LAS unsigned* bst = (volatile LAS unsigned*)((LAS unsigned char*)lds + LDS_STAGE);
    if (threadIdx.x < 2) bst[threadIdx.x] = 0u;
    __syncthreads();
    const XcdBarrier xbar = xcd_barrier_post((unsigned*)(p.ws + OFF_BAR), bst);
#define GRID_SYNC_CG() do { __builtin_amdgcn_fence(__ATOMIC_RELEASE, "agent"); asm volatile("s_waitcnt vmcnt(0)" ::: "memory"); grid.sync(); \
        __builtin_amdgcn_fence(__ATOMIC_ACQUIRE, "agent"); asm volatile("s_waitcnt vmcnt(0)" ::: "memory"); } while (0)
#define GRID_SYNC() xcd_barrier(xbar)
    const int G = gridDim.x, bid = blockIdx.x, NGW = G * NWAVES;
    LAS unsigned char* ldsl = (LAS unsigned char*)lds;
#define PHASE_IDS() const int tid = fresh_tid(), lane = tid & 63, wave = tid >> 6, gw = bid * NWAVES + wave; LAS float* scr = (LAS float*)(ldsl + wave * 8448); (void)scr; (void)gw; (void)lane
    unsigned char* ws = p.ws;
    bf16_t* Wgu = (bf16_t*)(ws + OFF_WGU); bf16_t* Wd = (bf16_t*)(ws + OFF_WD); bf16_t* Win = (bf16_t*)(ws + OFF_WIN); bf16_t* Wuq = (bf16_t*)(ws + OFF_WUQ);
    bf16_t* Wukv = (bf16_t*)(ws + OFF_WUKV); bf16_t* Woa = (bf16_t*)(ws + OFF_WOA); bf16_t* Wp = (bf16_t*)(ws + OFF_WP); bf16_t* Wout = (bf16_t*)(ws + OFF_WOUT);
    bf16_t* XN = (bf16_t*)(ws + OFF_XN); bf16_t* F = (bf16_t*)(ws + OFF_F); float* ZF = (float*)(ws + OFF_ZF); bf16_t* KV = (bf16_t*)(ws + OFF_KV);
    bf16_t* H = (bf16_t*)(ws + OFF_H); bf16_t* O = (bf16_t*)(ws + OFF_O); bf16_t* CQN = (bf16_t*)(ws + OFF_CQN); bf16_t* CKVN = (bf16_t*)(ws + OFF_CKVN);
    float* TAB = (float*)(ws + OFF_TAB); bf16_t* Q = (bf16_t*)(ws + OFF_Q); bf16_t* KR = (bf16_t*)(ws + OFF_KR); bf16_t* Gt = (bf16_t*)(ws + OFF_G); bf16_t* DP = (bf16_t*)(ws + OFF_DP);
    float* X = p.out;
    bf16_t* MXb = (bf16_t*)(ws + OFF_F + 32 * MiB);
    float* xbuf0 = (float*)(ws + OFF_XBUF); unsigned* cnt0 = (unsigned*)(ws + OFF_CNT);

    { PHASE_IDS();
    tr_job<TR_GU>(p.f1_wg, p.f1_wu, 1024, DFF, 5632, Wgu, scr, lane, gw, NGW);
    norm_rows(p.x, p.f1_pre, XN, gw, NGW, lane); }
    if (__builtin_expect(p.out == nullptr, 0)) GRID_SYNC_CG();
    GRID_SYNC();

    pg8::StaticOrder S;
    { pg8::Gemm g{XN, Wgu, M, 5632, 1024}; S.init(M, 5632, G, bid); pg8::EpiSwiGLU E{H}; pg8::gemm_phase(ldsl, g, S, E); }
    {
        const int tail0 = (64 * 22) % G;
        if (tail0 != 0 && bid >= tail0) { PHASE_IDS(); const int tb = bid - tail0, nb = G - tail0, tgw = tb * NWAVES + wave, TNGW = nb * NWAVES;
            tr_job<TR_PLAIN>(p.f1_wd, nullptr, DFF, 1024, 1024, Wd, scr, lane, tgw, TNGW);
            tr_job<TR_WIN>(p.w_in, nullptr, 1024, INW, 3328, Win, scr, lane, tgw, TNGW);
            tr_job<TR_UQ>(p.w_uq, nullptr, QL, 1536, 1536, Wuq, scr, lane, tgw, TNGW);
            tr_job<TR_UKV>(p.w_uk, p.w_uv, KVL, 1024, 2048, Wukv, scr, lane, tgw, TNGW);
    }
        else if (tail0 == 0) { PHASE_IDS(); const int tb = bid, nb = G;
            tr_job<TR_PLAIN>(p.f1_wd, nullptr, DFF, 1024, 1024, Wd, scr, lane, gw, NGW);
            tr_job<TR_WIN>(p.w_in, nullptr, 1024, INW, 3328, Win, scr, lane, gw, NGW);
            tr_job<TR_UQ>(p.w_uq, nullptr, QL, 1536, 1536, Wuq, scr, lane, gw, NGW);
            tr_job<TR_UKV>(p.w_uk, p.w_uv, KVL, 1024, 2048, Wukv, scr, lane, gw, NGW);
    }
    }
    GRID_SYNC();
    { pg8::Gemm g{H, Wd, M, 1024, DFF}; S.init(M, 1024, G, bid);
      pg8::EpiResNorm<false, true> E{p.x, (bf16_t*)X, nullptr, XN, 0.5f, p.f1_post, p.mix_pre, pg8::PanelSumSq{xbuf0, cnt0}, pg8::PanelSumSq{xbuf0 + (size_t)M * 4, cnt0 + 4096}}; pg8::gemm_phase(ldsl, g, S, E); }
    GRID_SYNC();
    { pg8::Gemm g{XN, Win, M, 1280, 1024}; S.init(M, 1280, G, bid); pg8::EpiBf16 E{(bf16_t*)ZF, 1280}; pg8::gemm_phase(ldsl, g, S, E); }
    {
        const int tail0 = (64 * 5) % G; PHASE_IDS();
        if (tail0 != 0 && bid >= tail0) { const int tgw = (bid - tail0) * NWAVES + wave, TNGW = (G - tail0) * NWAVES;
            tr_job<TR_GU>(p.f2_wg, p.f2_wu, 1024, DFF, 5632, Wgu, scr, lane, tgw, TNGW);
            tr_job<TR_PLAIN>(p.f2_wd, nullptr, DFF, 1024, 1024, Wd, scr, lane, tgw, TNGW); }
        else if (tail0 == 0) { tr_job<TR_GU>(p.f2_wg, p.f2_wu, 1024, DFF, 5632, Wgu, scr, lane, gw, NGW); tr_job<TR_PLAIN>(p.f2_wd, nullptr, DFF, 1024, 1024, Wd, scr, lane, gw, NGW); }
    }
    GRID_SYNC();
    { PHASE_IDS();
    const bf16_t* ZB = (const bf16_t*)ZF;
    for (int bt = gw; bt < M / 4; bt += NGW) { const int row0 = bt * 4, t0 = row0 & (SEQ - 1);
        const int lane = fresh_tid() & 63;
        const int t_g = lane >> 4, wnd = 2 << t_g, wl = wnd >> 1, wrr = wnd - wl;
        u32x4 nb[19], qa[4], qb[4]; float kx1[4], kx2[4]; int pos[4];
#pragma unroll
        for (int i = 0; i < 19; ++i) { int tt = t0 - 8 + i; tt = tt < 0 ? 0 : (tt > SEQ - 1 ? SEQ - 1 : tt); nb[i] = *(const u32x4*)(ZB + (size_t)(row0 - t0 + tt) * 1280 + 704 + 8 * lane); }
#pragma unroll
        for (int k = 0; k < 4; ++k) { const bf16_t* z = ZB + (size_t)(row0 + k) * 1280;
            qa[k] = *(const u32x4*)(z + 8 * lane); qb[k] = (u32x4){0u, 0u, 0u, 0u}; if (lane < 16) qb[k] = *(const u32x4*)(z + 512 + 8 * lane);
            kx1[k] = 0.f; kx2[k] = 0.f; pos[k] = 0; if (lane < 32) { kx1[k] = bf_lo((unsigned)z[640 + lane]); kx2[k] = bf_lo((unsigned)z[672 + lane]); pos[k] = p.pos[row0 + k]; } }
        __builtin_amdgcn_sched_barrier(0);
#pragma unroll
        for (int k = 0; k < 4; ++k) { const int row = row0 + k, t = t0 + k, lo = max(t - wl, 0), hi = min(t + wrr, SEQ);
            float sacc[8];
#pragma unroll
            for (int i = 0; i < 8; ++i) sacc[i] = 0.f;
#pragma unroll
            for (int d = 0; d < 16; ++d) { const int tt = t - 8 + d; const float wv = (tt >= lo && tt < hi) ? 1.f : 0.f; const u32x4 v = nb[k + d];
                sacc[0] = fmaf(wv, bf_lo(v.x), sacc[0]); sacc[1] = fmaf(wv, bf_hi(v.x), sacc[1]); sacc[2] = fmaf(wv, bf_lo(v.y), sacc[2]); sacc[3] = fmaf(wv, bf_hi(v.y), sacc[3]);
                sacc[4] = fmaf(wv, bf_lo(v.z), sacc[4]); sacc[5] = fmaf(wv, bf_hi(v.z), sacc[5]); sacc[6] = fmaf(wv, bf_lo(v.w), sacc[6]); sacc[7] = fmaf(wv, bf_hi(v.w), sacc[7]); }
            {
                const float inv = 1.f / (float)(hi - lo); const u32x4 pc = nb[k + 8];
                u32x4 w; w.x = cvt_pk_bf16(sacc[0] * inv - bf_lo(pc.x), sacc[1] * inv - bf_hi(pc.x)); w.y = cvt_pk_bf16(sacc[2] * inv - bf_lo(pc.y), sacc[3] * inv - bf_hi(pc.y));
                w.z = cvt_pk_bf16(sacc[4] * inv - bf_lo(pc.z), sacc[5] * inv - bf_hi(pc.z)); w.w = cvt_pk_bf16(sacc[6] * inv - bf_lo(pc.w), sacc[7] * inv - bf_hi(pc.w));
                *(u32x4*)(DP + (size_t)row * 512 + 8 * lane) = w; }
            {
                const u32x4 a4 = qa[k], b4 = qb[k];
                float va[8] = {bf_lo(a4.x), bf_hi(a4.x), bf_lo(a4.y), bf_hi(a4.y), bf_lo(a4.z), bf_hi(a4.z), bf_lo(a4.w), bf_hi(a4.w)};
                float vb[8] = {bf_lo(b4.x), bf_hi(b4.x), bf_lo(b4.y), bf_hi(b4.y), bf_lo(b4.z), bf_hi(b4.z), bf_lo(b4.w), bf_hi(b4.w)};
                float sa = 0.f, sb = 0.f;
#pragma unroll
                for (int i = 0; i < 8; ++i) { sa = fmaf(va[i], va[i], sa); sb = fmaf(vb[i], vb[i], sb); }
                const float ssq = wave_sum(lane < 48 ? sa : 0.f), sskv = wave_sum((lane >= 48 ? sa : 0.f) + sb);
                const float rq = __builtin_amdgcn_rsqf(ssq * (1.f / QL) + EPS), rkv = __builtin_amdgcn_rsqf(sskv * (1.f / KVL) + EPS);
                const float* ga = lane < 48 ? p.qa_g + 8 * lane : p.kva_g + 8 * (lane - 48); const float ra = lane < 48 ? rq : rkv;
                const f32x4 g0 = *(const f32x4*)ga, g1 = *(const f32x4*)(ga + 4);
                u32x4 w; w.x = cvt_pk_bf16(va[0] * g0.x * ra, va[1] * g0.y * ra); w.y = cvt_pk_bf16(va[2] * g0.z * ra, va[3] * g0.w * ra); w.z = cvt_pk_bf16(va[4] * g1.x * ra, va[5] * g1.y * ra); w.w = cvt_pk_bf16(va[6] * g1.z * ra, va[7] * g1.w * ra);
                bf16_t* dst = lane < 48 ? CQN + (size_t)row * QL + 8 * lane : CKVN + (size_t)row * KVL + 8 * (lane - 48);
                *(u32x4*)dst = w;
                if (lane < 16) { const f32x4 h0 = *(const f32x4*)(p.kva_g + 128 + 8 * lane), h1 = *(const f32x4*)(p.kva_g + 132 + 8 * lane);
                    u32x4 w2; w2.x = cvt_pk_bf16(vb[0] * h0.x * rkv, vb[1] * h0.y * rkv); w2.y = cvt_pk_bf16(vb[2] * h0.z * rkv, vb[3] * h0.w * rkv); w2.z = cvt_pk_bf16(vb[4] * h1.x * rkv, vb[5] * h1.y * rkv); w2.w = cvt_pk_bf16(vb[6] * h1.z * rkv, vb[7] * h1.w * rkv);
                    *(u32x4*)(CKVN + (size_t)row * KVL + 128 + 8 * lane) = w2; }
            }
            if (lane < 32) {
                const float ang = (float)pos[k] * p.inv_freq[lane];
                const double ad = (double)ang; const double kq = rint(ad * 0.15915494309189535); const float red = (float)(ad - kq * 6.283185307179586);
                const float cs = __cosf(red), sn = __sinf(red);
                TAB[(size_t)row * 64 + lane] = cs; TAB[(size_t)row * 64 + 32 + lane] = sn;
                *(unsigned*)(KR + (size_t)row * 64 + 2 * lane) = cvt_pk_bf16(kx1[k] * cs - kx2[k] * sn, kx2[k] * cs + kx1[k] * sn);
            }
            __builtin_amdgcn_sched_barrier(0);
        }
    } }
    GRID_SYNC();
    { pg8::Gemm g{CQN, Wuq, M, 1536, QL}; S.init(M, 1536, G, bid); pg8::EpiQ E{Q, TAB}; pg8::gemm_phase(ldsl, g, S, E); }
    {
        const int tail0 = (64 * 6) % G;
        if (tail0 != 0 && bid >= tail0) { PHASE_IDS(); const int tb = bid - tail0, nb = G - tail0, tgw = tb * NWAVES + wave, TNGW = nb * NWAVES;
            tr_job<TR_PLAIN>(p.w_oa, nullptr, 1024, 1024, 1024, Woa, scr, lane, tgw, TNGW);
            tr_job<TR_PLAIN>(p.w_out, nullptr, 1024, 1024, 1024, Wout, scr, lane, tgw, TNGW);
    for (int idx = tb * NTHREADS + tid; idx < 65536; idx += nb * NTHREADS) {
            const int n = idx & 1023, c8 = idx >> 10, g = c8 >> 4, cb = (c8 & 15) * 8;
            float a[8];
    #pragma unroll
            for (int i = 0; i < 8; ++i) a[i] = 0.f;
            for (int j0 = 0; j0 < 128; j0 += 8) { float w[8]; f32x4 pw[8][2];
    #pragma unroll
                for (int jj = 0; jj < 8; ++jj) w[jj] = p.w_op[(size_t)(g * 128 + j0 + jj) * 1024 + n] * p.pool_scale[g * 128 + j0 + jj];
    #pragma unroll
                for (int i = 0; i < 8; ++i) { pw[i][0] = *(const f32x4*)(p.pool_w + (size_t)(g * 128 + cb + i) * 128 + j0); pw[i][1] = *(const f32x4*)(p.pool_w + (size_t)(g * 128 + cb + i) * 128 + j0 + 4); }
    #pragma unroll
                for (int i = 0; i < 8; ++i)
    #pragma unroll
                    for (int jj = 0; jj < 8; ++jj) a[i] = fmaf(pw[i][jj >> 2][jj & 3], w[jj], a[i]); }
            u32x4 o; o.x = cvt_pk_bf16(a[0], a[1]); o.y = cvt_pk_bf16(a[2], a[3]); o.z = cvt_pk_bf16(a[4], a[5]); o.w = cvt_pk_bf16(a[6], a[7]);
            *(u32x4*)(Wp + (size_t)n * 512 + c8 * 8) = o;
        }
        }
        else if (tail0 == 0) { PHASE_IDS(); const int tb = bid, nb = G;
            tr_job<TR_PLAIN>(p.w_oa, nullptr, 1024, 1024, 1024, Woa, scr, lane, gw, NGW);
            tr_job<TR_PLAIN>(p.w_out, nullptr, 1024, 1024, 1024, Wout, scr, lane, gw, NGW);
    for (int idx = tb * NTHREADS + tid; idx < 65536; idx += nb * NTHREADS) {
            const int n = idx & 1023, c8 = idx >> 10, g = c8 >> 4, cb = (c8 & 15) * 8;
            float a[8];
    #pragma unroll
            for (int i = 0; i < 8; ++i) a[i] = 0.f;
            for (int j0 = 0; j0 < 128; j0 += 8) { float w[8]; f32x4 pw[8][2];
    #pragma unroll
                for (int jj = 0; jj < 8; ++jj) w[jj] = p.w_op[(size_t)(g * 128 + j0 + jj) * 1024 + n] * p.pool_scale[g * 128 + j0 + jj];
    #pragma unroll
                for (int i = 0; i < 8; ++i) { pw[i][0] = *(const f32x4*)(p.pool_w + (size_t)(g * 128 + cb + i) * 128 + j0); pw[i][1] = *(const f32x4*)(p.pool_w + (size_t)(g * 128 + cb + i) * 128 + j0 + 4); }
    #pragma unroll
                for (int i = 0; i < 8; ++i)
    #pragma unroll
                    for (int jj = 0; jj < 8; ++jj) a[i] = fmaf(pw[i][jj >> 2][jj & 3], w[jj], a[i]); }
            u32x4 o; o.x = cvt_pk_bf16(a[0], a[1]); o.y = cvt_pk_bf16(a[2], a[3]); o.z = cvt_pk_bf16(a[4], a[5]); o.w = cvt_pk_bf16(a[6], a[7]);
            *(u32x4*)(Wp + (size_t)n * 512 + c8 * 8) = o;
        }
        }
    }
    { pg8::Gemm g{CKVN, Wukv, M, 2048, KVL}; S.init(M, 2048, G, bid); pg8::EpiBf16 E{KV, 2048}; pg8::gemm_phase(ldsl, g, S, E); }
    GRID_SYNC();
    {
        const int vcu = (bid & 7) * (G >> 3) + (bid >> 3);
        for (int it = vcu; it < NB * NH * (SEQ / 256); it += G) {
            const int qb = it & 7, h = (it >> 3) & 7, b = it >> 6;
            const size_t tok0 = (size_t)b * SEQ;
            att::attn_body(Q + (tok0 + qb * 256) * 1536 + h * 192, KV + tok0 * 2048 + h * 128, KR + tok0 * 64, KV + tok0 * 2048 + 1024 + h * 128,
                           O + (tok0 + qb * 256) * 1024 + h * 128, SEQ, (char*)lds);
            __syncthreads();
        }
    }
    GRID_SYNC();
    { pg8::Gemm g{XN, Win + (size_t)1280 * 1024, M, 2048, 1024}; pg8::GateOrder GO; GO.s.init(M, 1024, G, bid); pg8::EpiGate E{Gt}; pg8::gemm_phase(ldsl, g, GO, E); }
    { pg8::Gemm g{O, Woa, M, 1024, 1024}; S.init(M, 1024, G, bid); pg8::EpiT1 E{Gt, F}; pg8::gemm_phase(ldsl, g, S, E); }
    { pg8::Gemm g{DP, Wp, M, 1024, 512}; S.init(M, 1024, G, bid); pg8::EpiMX E{Gt, F, MXb}; pg8::gemm_phase(ldsl, g, S, E); }
    GRID_SYNC();
    { pg8::Gemm g{MXb, Wout, M, 1024, 1024}; S.init(M, 1024, G, bid);
      pg8::EpiResNorm<false, false> E{nullptr, (bf16_t*)X, nullptr, XN, 1.0f, p.mix_post, p.f2_pre, pg8::PanelSumSq{xbuf0 + (size_t)M * 8, cnt0 + 2 * 4096}, pg8::PanelSumSq{xbuf0 + (size_t)M * 12, cnt0 + 3 * 4096}}; pg8::gemm_phase(ldsl, g, S, E); }
    GRID_SYNC();
    { pg8::Gemm g{XN, Wgu, M, 5632, 1024}; S.init(M, 5632, G, bid); pg8::EpiSwiGLU E{H}; pg8::gemm_phase(ldsl, g, S, E); }
    GRID_SYNC();
    { pg8::Gemm g{H, Wd, M, 1024, DFF}; S.init(M, 1024, G, bid);
      pg8::EpiResNorm<true, false> E{nullptr, (bf16_t*)X, X, nullptr, 0.5f, p.f2_post, p.final_g, pg8::PanelSumSq{xbuf0 + (size_t)M * 16, cnt0 + 4 * 4096}, pg8::PanelSumSq{xbuf0 + (size_t)M * 20, cnt0 + 5 * 4096}}; pg8::gemm_phase(ldsl, g, S, E); }
}

extern "C" void kernel_launch(void* const* d_in, const int* in_sizes, int n_in, void* d_out, int out_size, void* d_ws, size_t ws_size, hipStream_t stream) {
    static int grid_blocks = 0;
    if (grid_blocks == 0) {
        if (n_in != 26 || in_sizes[0] != M * DM || out_size != M * DM || ws_size < WS_END) { fprintf(stderr, "kernel_launch: shape mismatch n_in %d in0 %d out %d ws %zu\n", n_in, n_in > 0 ? in_sizes[0] : -1, out_size, ws_size); grid_blocks = -1; return; }
        int dev = 0, cus = 0, per_cu = 0;
        (void)hipGetDevice(&dev);
        (void)hipDeviceGetAttribute(&cus, hipDeviceAttributeMultiprocessorCount, dev);
        if (hipFuncSetAttribute((const void*)fwd_megakernel, hipFuncAttributeMaxDynamicSharedMemorySize, LDS_BYTES) != hipSuccess) { fprintf(stderr, "kernel_launch: hipFuncSetAttribute failed\n"); grid_blocks = -1; return; }
        if (hipOccupancyMaxActiveBlocksPerMultiprocessor(&per_cu, (const void*)fwd_megakernel, NTHREADS, LDS_BYTES) != hipSuccess || per_cu < 1) { fprintf(stderr, "kernel_launch: occupancy query failed (%d)\n", per_cu); (void)hipGetLastError(); per_cu = 1; }
        grid_blocks = cus * 1;
        if (grid_blocks != 256) { fprintf(stderr, "kernel_launch: built for 256 CUs (one workgroup each), device has %d\n", cus); grid_blocks = -1; return; }
    }
    if (grid_blocks < 0) return;
    Params p{};
    p.x = (const float*)d_in[0]; p.pos = (const int*)d_in[1];
    p.f1_pre = (const float*)d_in[2]; p.f1_wg = (const float*)d_in[3]; p.f1_wu = (const float*)d_in[4]; p.f1_wd = (const float*)d_in[5]; p.f1_post = (const float*)d_in[6];
    p.mix_pre = (const float*)d_in[7]; p.w_in = (const float*)d_in[8]; p.qa_g = (const float*)d_in[9]; p.w_uq = (const float*)d_in[10]; p.kva_g = (const float*)d_in[11];
    p.w_uk = (const float*)d_in[12]; p.w_uv = (const float*)d_in[13]; p.w_oa = (const float*)d_in[14]; p.pool_w = (const float*)d_in[15]; p.pool_scale = (const float*)d_in[16];
    p.w_op = (const float*)d_in[17]; p.w_out = (const float*)d_in[18]; p.mix_post = (const float*)d_in[19];
    p.f2_pre = (const float*)d_in[20]; p.f2_wg = (const float*)d_in[21]; p.f2_wu = (const float*)d_in[22]; p.f2_wd = (const float*)d_in[23]; p.f2_post = (const float*)d_in[24]; p.final_g = (const float*)d_in[25];
    p.out = (float*)d_out; p.ws = (unsigned char*)d_ws;
    for (int i = 0; i < 32; ++i) p.inv_freq[i] = (float)pow(10000.0, -(2.0 * i) / 64.0);
    if (hipMemsetAsync((char*)d_ws + OFF_BAR, 0, CTL_BYTES, stream) != hipSuccess) { fprintf(stderr, "kernel_launch: memset failed\n"); return; }
    void* args[] = {&p};
    hipError_t e = hipLaunchCooperativeKernel((const void*)fwd_megakernel, dim3(grid_blocks), dim3(NTHREADS), args, LDS_BYTES, stream);
    if (e != hipSuccess) fprintf(stderr, "cooperative launch failed: %s (grid %d)\n", hipGetErrorString(e), grid_blocks);
}
```

```cpp
#include <hip/hip_runtime.h>
#include <hip/hip_cooperative_groups.h>
#include <cstdio>
#include <cmath>
#include <cstdint>
namespace cg = cooperative_groups;

#define LAS __attribute__((address_space(3)))
typedef unsigned short bf16_t;
typedef short bf16x8 __attribute__((ext_vector_type(8)));
typedef short s16x4 __attribute__((ext_vector_type(4)));
typedef float f32x2 __attribute__((ext_vector_type(2)));
typedef float f32x4 __attribute__((ext_vector_type(4)));
typedef float f32x16 __attribute__((ext_vector_type(16)));
typedef unsigned u32x4 __attribute__((ext_vector_type(4)));
typedef unsigned u32x2 __attribute__((ext_vector_type(2)));

constexpr int DM = 1024, NB = 8, SEQ = 2048, M = NB * SEQ, NH = 8, QL = 384, KVL = 256, DFF = 2816, INW = 3264;
constexpr float EPS = 1e-6f;
constexpr int NTHREADS = 512, NWAVES = 8;
constexpr int LDS_STAGE = 131072, LDS_BYTES = LDS_STAGE + 16;

constexpr size_t MiB = 1048576;
constexpr size_t OFF_WGU = 0;
constexpr size_t OFF_WD = OFF_WGU + (size_t)5632 * 1024 * 2;
constexpr size_t OFF_WIN = OFF_WD + (size_t)1024 * 2816 * 2;
constexpr size_t OFF_WUQ = OFF_WIN + (size_t)3328 * 1024 * 2;
constexpr size_t OFF_WUKV = OFF_WUQ + (size_t)1536 * 384 * 2;
constexpr size_t OFF_WOA = OFF_WUKV + (size_t)2048 * 256 * 2;
constexpr size_t OFF_WP = OFF_WOA + (size_t)1024 * 1024 * 2;
constexpr size_t OFF_WOUT = OFF_WP + (size_t)1024 * 512 * 2;
constexpr size_t OFF_XN = OFF_WOUT + (size_t)1024 * 1024 * 2;
constexpr size_t OFF_R = OFF_XN + 32 * MiB;
constexpr size_t OFF_F = OFF_R;
constexpr size_t OFF_ZF = OFF_R;
constexpr size_t OFF_KV = OFF_R;
constexpr size_t OFF_H = OFF_R + 64 * MiB;
constexpr size_t OFF_O = OFF_R + 64 * MiB;
constexpr size_t OFF_CQN = OFF_R + 80 * MiB;
constexpr size_t OFF_CKVN = OFF_R + 92 * MiB;
constexpr size_t OFF_TAB = OFF_R + 100 * MiB;
constexpr size_t OFF_Q = OFF_R + 104 * MiB;
constexpr size_t OFF_KR = OFF_R + 152 * MiB;
constexpr size_t OFF_G = OFF_R + 96 * MiB;
constexpr size_t OFF_DP = OFF_R + 176 * MiB;
constexpr size_t WS_END = OFF_R + 192 * MiB;
constexpr size_t OFF_BAR = WS_END, OFF_CNT = OFF_BAR + 16384, CTL_BYTES = 16384 + 6 * 16384, OFF_XBUF = OFF_BAR + CTL_BYTES;
static_assert(OFF_XBUF + 6 * (size_t)M * 16 <= 256 * MiB, "workspace");

struct Params {
    const float* x; const int* pos;
    const float *f1_pre, *f1_wg, *f1_wu, *f1_wd, *f1_post;
    const float *mix_pre, *w_in, *qa_g, *w_uq, *kva_g, *w_uk, *w_uv, *w_oa, *pool_w, *pool_scale, *w_op, *w_out, *mix_post;
    const float *f2_pre, *f2_wg, *f2_wu, *f2_wd, *f2_post, *final_g;
    float* out; unsigned char* ws;
    float inv_freq[32];
};

typedef __bf16 bf16x2_t __attribute__((ext_vector_type(2)));
__device__ __forceinline__ unsigned cvt_pk_bf16(float lo, float hi) { const f32x2 v = {lo, hi}; const bf16x2_t r = __builtin_convertvector(v, bf16x2_t); return __builtin_bit_cast(unsigned, r); }
__device__ __forceinline__ float bf_lo(unsigned w) { return __uint_as_float(w << 16); }
__device__ __forceinline__ float bf_hi(unsigned w) { return __uint_as_float(w & 0xffff0000u); }
__device__ __forceinline__ float sigmoidf_fast(float z) { return __builtin_amdgcn_rcpf(1.f + __builtin_amdgcn_exp2f(-1.4426950408889634f * z)); }
__device__ __forceinline__ int fresh_tid() { int t = threadIdx.x; asm volatile("" : "+v"(t)); return t; }
__device__ __forceinline__ float wave_sum(float v) {
#pragma unroll
    for (int o = 1; o < 64; o <<= 1) v += __shfl_xor(v, o);
    return v;
}

namespace pg8 {
constexpr int BM = 256, BK = 64, HALF = 128, HTB = HALF * BK * 2, STAGE_BYTES = 8 * HTB, NXCD = 8, WGM = 4;
__host__ __device__ __forceinline__ int lds_byte(int r, int c) { const int st = (r >> 4) * 2 + (c >> 5), rr = r & 15, cc = c & 31, ob = rr * 64 + cc * 2; return st * 1024 + (ob ^ (((ob >> 9) & 1) << 5)); }
__host__ __device__ __forceinline__ void stage_rc(int b, int& R, int& C) { const int st = b / 1024, sb = b % 1024, swz = sb ^ (((sb >> 9) & 1) << 5); R = (st >> 1) * 16 + swz / 64; C = (st & 1) * 32 + (swz % 64) / 2; }
__host__ __device__ __forceinline__ int perm32(int rho) { const int n = rho >> 4, i = rho & 15; return 8 * (i >> 2) + 4 * n + (i & 3); }
struct Unit { int pm, pn; };
struct Gemm { const bf16_t* A; const bf16_t* Bt; int M, N, K; };
struct StaticOrder {
    int nM, nN, nwg, G, c;
    __device__ void init(int M_, int N_, int G_, int c_) { nM = M_ / BM; nN = N_ / BM; nwg = nM * nN; G = G_; c = c_; }
    __device__ bool next(int i, Unit& u) const {
        const long L = (long)i * G + c; if (L >= nwg) return false;
        int wgid = (int)L; { const int q = nwg / NXCD, r = nwg % NXCD, xcd = wgid % NXCD, off = wgid / NXCD; wgid = (xcd < r ? xcd * (q + 1) : r * (q + 1) + (xcd - r) * q) + off; }
        const int nig = WGM * nN, gid = wgid / nig, fm = gid * WGM, gsz = (nM - fm) < WGM ? (nM - fm) : WGM;
        u.pm = fm + ((wgid % nig) % gsz); u.pn = (wgid % nig) / gsz; return true;
    }
};

struct GateOrder { StaticOrder s;
    __device__ bool next(int i, Unit& u) const { if (i >= 2) return false; Unit b; if (!s.next(0, b)) return false; u.pm = b.pm; u.pn = b.pn + 4 * i; return true; } };
template <class Epi, class Sched>
__device__ __forceinline__ void gemm_phase(LAS unsigned char* lds, const Gemm g, const Sched& S, const Epi& E) {
    const int tid = fresh_tid(), wid = __builtin_amdgcn_readfirstlane(tid >> 6), lane = tid & 63, wr = wid >> 2, wc = wid & 3, fr = lane & 15, fq = lane >> 4;
    const int K = g.K, nt = K / BK;
    unsigned voffA, voffB;
    { int R, C; stage_rc(tid * 16, R, C); const int Rb = Epi::PERM ? ((R & ~31) + perm32(R & 31)) : R;
      voffA = (unsigned)(R * K + C) * 2u; voffB = (unsigned)(Rb * K + C) * 2u; }
    const size_t rstep64 = (size_t)64 * K * 2;
    const size_t kstep = (size_t)(BK * 2);
    const size_t hstep = (size_t)HALF * K * 2;
    const size_t tstep = 2 * hstep;
    const unsigned ldsw = (unsigned)wid * 1024u;
    const int aoff = lds_byte(wr * 64 + fr, fq * 8), boff = lds_byte(wc * 32 + fr, fq * 8);
#define PG8_SA(b, h) (((b) * 2 + (h)) * HTB)
#define PG8_SB(b, h) ((4 + (b) * 2 + (h)) * HTB)
#define PG8_STAGE(bufoff, gbase, voff) do { _Pragma("unroll") for (int _i = 0; _i < 2; ++_i) \
        __builtin_amdgcn_global_load_lds((const unsigned*)((const char*)(gbase) + _i * rstep64 + (voff)), (LAS unsigned*)(lds + (bufoff) + ldsw + _i * 8192), 16, 0, 0); } while (0)
#define PG8_LDA(dst, b, h) do { _Pragma("unroll") for (int m = 0; m < 4; ++m) _Pragma("unroll") for (int k = 0; k < 2; ++k) dst[m][k] = *(const LAS bf16x8*)(lds + PG8_SA(b, h) + aoff + m * 2048 + k * 1024); } while (0)
#define PG8_LDB(dst, b, h) do { _Pragma("unroll") for (int n = 0; n < 2; ++n) _Pragma("unroll") for (int k = 0; k < 2; ++k) dst[n][k] = *(const LAS bf16x8*)(lds + PG8_SB(b, h) + boff + n * 2048 + k * 1024); } while (0)
#define PG8_MMA(ai, bj, At, Bt) do { __builtin_amdgcn_s_setprio(1); _Pragma("unroll") for (int m = 0; m < 4; ++m) _Pragma("unroll") for (int n = 0; n < 2; ++n) _Pragma("unroll") for (int k = 0; k < 2; ++k) \
        acc[ai][bj][m][n] = __builtin_amdgcn_mfma_f32_16x16x32_bf16(Bt[n][k], At[m][k], acc[ai][bj][m][n], 0, 0, 0); __builtin_amdgcn_s_setprio(0); } while (0)
#define PG8_WAIT_V(n) asm volatile("s_waitcnt vmcnt(" #n ")" ::: "memory")
#define PG8_WAIT_L(n) asm volatile("s_waitcnt lgkmcnt(" #n ")" ::: "memory")
#define PG8_BAR __builtin_amdgcn_s_barrier()
#define PG8_SCHED __builtin_amdgcn_sched_barrier(0)
    Unit cur, nxt; int ui = 0;
    if (!S.next(0, cur)) return;
    f32x4 acc[2][2][4][2];
#pragma unroll
    for (int a = 0; a < 2; ++a)
#pragma unroll
        for (int b = 0; b < 2; ++b)
#pragma unroll
            for (int m = 0; m < 4; ++m)
#pragma unroll
                for (int n = 0; n < 2; ++n) acc[a][b][m][n] = (f32x4){0.f, 0.f, 0.f, 0.f};
    bf16x8 At[4][2], B0[2][2], B1[2][2];
    const char* cA = (const char*)g.A + (size_t)cur.pm * tstep; const char* cB = (const char*)g.Bt + (size_t)cur.pn * tstep;
    PG8_STAGE(PG8_SB(0, 0), cB, voffB); PG8_STAGE(PG8_SA(0, 0), cA, voffA); PG8_STAGE(PG8_SB(0, 1), cB + hstep, voffB); PG8_STAGE(PG8_SA(0, 1), cA + hstep, voffA);
    if (wr == 1) PG8_BAR;
    PG8_WAIT_V(4); PG8_BAR;
    PG8_STAGE(PG8_SB(1, 0), cB + kstep, voffB); PG8_STAGE(PG8_SA(1, 0), cA + kstep, voffA); PG8_STAGE(PG8_SB(1, 1), cB + hstep + kstep, voffB);
    PG8_WAIT_V(6); PG8_BAR;
    for (;;) {
        const bool has_next = S.next(ui + 1, nxt);
        const char* nA = has_next ? (const char*)g.A + (size_t)nxt.pm * tstep : cA; const char* nB = has_next ? (const char*)g.Bt + (size_t)nxt.pn * tstep : cB;
        for (int t = 0; t < nt; t += 2) {
            const bool last = (t == nt - 2);
            const char* a1 = cA + (size_t)(t + 1) * kstep;
            const char* a2 = last ? nA : cA + (size_t)(t + 2) * kstep; const char* b2 = last ? nB : cB + (size_t)(t + 2) * kstep;
            const char* a3 = a2 + kstep; const char* b3 = b2 + kstep;
            PG8_LDB(B0, 0, 0); PG8_SCHED; PG8_LDA(At, 0, 0); PG8_STAGE(PG8_SA(1, 1), a1 + hstep, voffA);
            PG8_WAIT_L(8); PG8_BAR; PG8_WAIT_L(0); PG8_MMA(0, 0, At, B0); PG8_BAR; PG8_SCHED;
            PG8_LDB(B1, 0, 1); PG8_STAGE(PG8_SB(0, 0), b2, voffB);
            PG8_BAR; PG8_WAIT_L(0); PG8_MMA(0, 1, At, B1); PG8_BAR;
            PG8_LDA(At, 0, 1); PG8_STAGE(PG8_SA(0, 0), a2, voffA);
            PG8_BAR; PG8_WAIT_L(0); PG8_MMA(1, 0, At, B0); PG8_BAR; PG8_SCHED;
            PG8_STAGE(PG8_SB(0, 1), b2 + hstep, voffB);
            PG8_WAIT_V(6); PG8_BAR; PG8_MMA(1, 1, At, B1); PG8_BAR;
            PG8_LDB(B0, 1, 0); PG8_SCHED; PG8_LDA(At, 1, 0); PG8_STAGE(PG8_SA(0, 1), a2 + hstep, voffA);
            PG8_WAIT_L(8); PG8_BAR; PG8_WAIT_L(0); PG8_MMA(0, 0, At, B0); PG8_BAR; PG8_SCHED;
            PG8_LDB(B1, 1, 1); PG8_STAGE(PG8_SB(1, 0), b3, voffB);
            PG8_BAR; PG8_WAIT_L(0); PG8_MMA(0, 1, At, B1); PG8_BAR;
            PG8_LDA(At, 1, 1); PG8_STAGE(PG8_SA(1, 0), a3, voffA);
            PG8_BAR; PG8_WAIT_L(0); PG8_MMA(1, 0, At, B0); PG8_BAR; PG8_SCHED;
            PG8_STAGE(PG8_SB(1, 1), b3 + hstep, voffB);
            PG8_WAIT_V(6); PG8_BAR; PG8_MMA(1, 1, At, B1); PG8_BAR;
        }
        if constexpr (!Epi::AFTER_DRAIN) { const int t2 = fresh_tid(); E(acc, cur, wr, wc, t2 & 15, (t2 >> 4) & 3); }
        if (!has_next) break;
#pragma unroll
        for (int a = 0; a < 2; ++a)
#pragma unroll
            for (int b = 0; b < 2; ++b)
#pragma unroll
                for (int m = 0; m < 4; ++m)
#pragma unroll
                    for (int n = 0; n < 2; ++n) acc[a][b][m][n] = (f32x4){0.f, 0.f, 0.f, 0.f};
        cur = nxt; cA = nA; cB = nB; ++ui;
    }
    PG8_WAIT_V(0);
    if (wr == 0) PG8_BAR;
    PG8_BAR;
    if constexpr (Epi::AFTER_DRAIN) { const int t2 = fresh_tid(); E.fused(acc, cur, wr, wc, t2 & 15, (t2 >> 4) & 3, lds, t2 >> 6, t2 & 63); }
#undef PG8_SA
#undef PG8_SB
#undef PG8_STAGE
#undef PG8_LDA
#undef PG8_LDB
#undef PG8_MMA
#undef PG8_WAIT_V
#undef PG8_WAIT_L
#undef PG8_BAR
#undef PG8_SCHED
}

typedef f32x4 Acc[2][2][4][2];
struct EpiF32 {
    static constexpr bool PERM = false, AFTER_DRAIN = false;
    float* C; int ldc;
    __device__ __forceinline__ void operator()(const Acc& acc, const Unit& u, int wr, int wc, int fr, int fq) const {
        const int row0 = u.pm * BM + wr * 64 + fr, col0 = u.pn * BM + wc * 32 + 4 * fq;
#pragma unroll
        for (int ai = 0; ai < 2; ++ai)
#pragma unroll
            for (int m = 0; m < 4; ++m) { float* rowp = C + (size_t)(row0 + ai * HALF + m * 16) * ldc + col0;
#pragma unroll
                for (int bj = 0; bj < 2; ++bj)
#pragma unroll
                    for (int n = 0; n < 2; ++n) *(f32x4*)(rowp + bj * HALF + n * 16) = acc[ai][bj][m][n]; }
    }
};
struct EpiBf16 {
    static constexpr bool PERM = true, AFTER_DRAIN = false;
    bf16_t* O; int ldc;
    __device__ __forceinline__ void operator()(const Acc& acc, const Unit& u, int wr, int wc, int fr, int fq) const {
        const int row0 = u.pm * BM + wr * 64 + fr, col0 = u.pn * BM + wc * 32 + 8 * fq;
#pragma unroll
        for (int ai = 0; ai < 2; ++ai)
#pragma unroll
            for (int m = 0; m < 4; ++m) { bf16_t* rowp = O + (size_t)(row0 + ai * HALF + m * 16) * ldc + col0;
#pragma unroll
                for (int bj = 0; bj < 2; ++bj) { const f32x4 v0 = acc[ai][bj][m][0], v1 = acc[ai][bj][m][1];
                    u32x4 w; w.x = cvt_pk_bf16(v0[0], v0[1]); w.y = cvt_pk_bf16(v0[2], v0[3]); w.z = cvt_pk_bf16(v1[0], v1[1]); w.w = cvt_pk_bf16(v1[2], v1[3]);
                    *(u32x4*)(rowp + bj * HALF) = w; } }
    }
};
struct EpiSwiGLU {
    static constexpr bool PERM = true, AFTER_DRAIN = false;
    bf16_t* H;
    __device__ __forceinline__ void operator()(const Acc& acc, const Unit& u, int wr, int wc, int fr, int fq) const {
        const int row0 = u.pm * BM + wr * 64 + fr, col0 = u.pn * HALF + wc * 32 + 8 * fq;
#pragma unroll
        for (int ai = 0; ai < 2; ++ai)
#pragma unroll
            for (int m = 0; m < 4; ++m) { bf16_t* rowp = H + (size_t)(row0 + ai * HALF + m * 16) * DFF + col0;
                float h[8];
#pragma unroll
                for (int n = 0; n < 2; ++n)
#pragma unroll
                    for (int j = 0; j < 4; ++j) { const float gt = acc[ai][0][m][n][j], up = acc[ai][1][m][n][j]; h[n * 4 + j] = gt * sigmoidf_fast(gt) * up; }
                u32x4 w; w.x = cvt_pk_bf16(h[0], h[1]); w.y = cvt_pk_bf16(h[2], h[3]); w.z = cvt_pk_bf16(h[4], h[5]); w.w = cvt_pk_bf16(h[6], h[7]);
                *(u32x4*)rowp = w; }
    }
};
struct EpiGate {
    static constexpr bool PERM = true, AFTER_DRAIN = false;
    bf16_t* G;
    __device__ __forceinline__ void operator()(const Acc& acc, const Unit& u, int wr, int wc, int fr, int fq) const {
        const int row0 = u.pm * BM + wr * 64 + fr, col0 = u.pn * BM + wc * 32 + 8 * fq;
#pragma unroll
        for (int ai = 0; ai < 2; ++ai)
#pragma unroll
            for (int m = 0; m < 4; ++m) { bf16_t* rowp = G + (size_t)(row0 + ai * HALF + m * 16) * 2048 + col0;
#pragma unroll
                for (int bj = 0; bj < 2; ++bj) { const f32x4 v0 = acc[ai][bj][m][0], v1 = acc[ai][bj][m][1];
                    u32x4 w; w.x = cvt_pk_bf16(sigmoidf_fast(v0[0]), sigmoidf_fast(v0[1])); w.y = cvt_pk_bf16(sigmoidf_fast(v0[2]), sigmoidf_fast(v0[3]));
                    w.z = cvt_pk_bf16(sigmoidf_fast(v1[0]), sigmoidf_fast(v1[1])); w.w = cvt_pk_bf16(sigmoidf_fast(v1[2]), sigmoidf_fast(v1[3]));
                    *(u32x4*)(rowp + bj * HALF) = w; } }
    }
};
struct EpiQ {
    static constexpr bool PERM = true, AFTER_DRAIN = false;
    bf16_t* Q; const float* TAB;
    __device__ __forceinline__ void operator()(const Acc& acc, const Unit& u, int wr, int wc, int fr, int fq) const {
        const int row0 = u.pm * BM + wr * 64 + fr, col0 = u.pn * BM + wc * 32 + 8 * fq;
#pragma unroll
        for (int ai = 0; ai < 2; ++ai)
#pragma unroll
            for (int m = 0; m < 4; ++m) { const int row = row0 + ai * HALF + m * 16; bf16_t* rowp = Q + (size_t)row * 1536 + col0;
#pragma unroll
                for (int bj = 0; bj < 2; ++bj) { f32x4 v0 = acc[ai][bj][m][0], v1 = acc[ai][bj][m][1];
                    const int c = col0 + bj * HALF, w = c % 192;
                    if (w >= 128) { const int i0 = (w - 128) >> 1; const f32x4 cs = *(const f32x4*)(TAB + (size_t)row * 64 + i0), sn = *(const f32x4*)(TAB + (size_t)row * 64 + 32 + i0);
                        f32x4 r0, r1;
                        r0[0] = v0[0] * cs[0] - v0[1] * sn[0]; r0[1] = v0[1] * cs[0] + v0[0] * sn[0];
                        r0[2] = v0[2] * cs[1] - v0[3] * sn[1]; r0[3] = v0[3] * cs[1] + v0[2] * sn[1];
                        r1[0] = v1[0] * cs[2] - v1[1] * sn[2]; r1[1] = v1[1] * cs[2] + v1[0] * sn[2];
                        r1[2] = v1[2] * cs[3] - v1[3] * sn[3]; r1[3] = v1[3] * cs[3] + v1[2] * sn[3];
                        v0 = r0; v1 = r1; }
                    u32x4 wv; wv.x = cvt_pk_bf16(v0[0], v0[1]); wv.y = cvt_pk_bf16(v0[2], v0[3]); wv.z = cvt_pk_bf16(v1[0], v1[1]); wv.w = cvt_pk_bf16(v1[2], v1[3]);
                    *(u32x4*)(rowp + bj * HALF) = wv; } }
    }
};
struct EpiT1 {
    static constexpr bool PERM = true, AFTER_DRAIN = false;
    const bf16_t* G; bf16_t* F;
    __device__ __forceinline__ void operator()(const Acc& acc, const Unit& u, int wr, int wc, int fr, int fq) const {
        const int row0 = u.pm * BM + wr * 64 + fr, col0 = u.pn * BM + wc * 32 + 8 * fq;
#pragma unroll
        for (int ai = 0; ai < 2; ++ai)
#pragma unroll
            for (int m = 0; m < 4; ++m) { const int row = row0 + ai * HALF + m * 16;
#pragma unroll
                for (int bj = 0; bj < 2; ++bj) { const f32x4 v0 = acc[ai][bj][m][0], v1 = acc[ai][bj][m][1]; const int c = col0 + bj * HALF;
                    const u32x4 gw = *(const u32x4*)(G + (size_t)row * 2048 + c);
                    u32x4 wv;
                    wv.x = cvt_pk_bf16(v0[0] * bf_lo(gw.x), v0[1] * bf_hi(gw.x)); wv.y = cvt_pk_bf16(v0[2] * bf_lo(gw.y), v0[3] * bf_hi(gw.y));
                    wv.z = cvt_pk_bf16(v1[0] * bf_lo(gw.z), v1[1] * bf_hi(gw.z)); wv.w = cvt_pk_bf16(v1[2] * bf_lo(gw.w), v1[3] * bf_hi(gw.w));
                    *(u32x4*)(F + (size_t)row * 1024 + c) = wv; } }
    }
};
struct EpiMX {
    static constexpr bool PERM = true, AFTER_DRAIN = false;
    const bf16_t* G; const bf16_t* F; bf16_t* MX;
    __device__ __forceinline__ void operator()(const Acc& acc, const Unit& u, int wr, int wc, int fr, int fq) const {
        const int row0 = u.pm * BM + wr * 64 + fr, col0 = u.pn * BM + wc * 32 + 8 * fq;
#pragma unroll
        for (int ai = 0; ai < 2; ++ai)
#pragma unroll
            for (int m = 0; m < 4; ++m) { const int row = row0 + ai * HALF + m * 16;
#pragma unroll
                for (int bj = 0; bj < 2; ++bj) { const f32x4 v0 = acc[ai][bj][m][0], v1 = acc[ai][bj][m][1]; const int c = col0 + bj * HALF;
                    const u32x4 gw = *(const u32x4*)(G + (size_t)row * 2048 + 1024 + c);
                    const u32x4 tw = *(const u32x4*)(F + (size_t)row * 1024 + c);
                    u32x4 wv;
                    wv.x = cvt_pk_bf16(bf_lo(tw.x) + v0[0] * bf_lo(gw.x), bf_hi(tw.x) + v0[1] * bf_hi(gw.x)); wv.y = cvt_pk_bf16(bf_lo(tw.y) + v0[2] * bf_lo(gw.y), bf_hi(tw.y) + v0[3] * bf_hi(gw.y));
                    wv.z = cvt_pk_bf16(bf_lo(tw.z) + v1[0] * bf_lo(gw.z), bf_hi(tw.z) + v1[1] * bf_hi(gw.z)); wv.w = cvt_pk_bf16(bf_lo(tw.w) + v1[2] * bf_lo(gw.w), bf_hi(tw.w) + v1[3] * bf_hi(gw.w));
                    *(u32x4*)(MX + (size_t)row * 1024 + c) = wv; } }
    }
};

struct PanelSumSq {
    float* xbuf;
    unsigned* cnt;
    __device__ __forceinline__ void run(const Acc& v, const Unit& u, int wr, int wc, int fr, int fq, LAS unsigned char* lds, int wid, int lane) const {
        LAS float* P = (LAS float*)lds; LAS float* S = (LAS float*)(lds + 4096);
#pragma unroll
        for (int ai = 0; ai < 2; ++ai)
#pragma unroll
            for (int m = 0; m < 4; ++m) { float q = 0.f;
#pragma unroll
                for (int bj = 0; bj < 2; ++bj)
#pragma unroll
                    for (int n = 0; n < 2; ++n) { const f32x4 x = v[ai][bj][m][n]; q += (x[0] * x[0] + x[1] * x[1]) + (x[2] * x[2] + x[3] * x[3]); }
                q += __shfl_xor(q, 16); q += __shfl_xor(q, 32);
                if (fq == 0) P[(ai * HALF + wr * 64 + m * 16 + fr) * 4 + wc] = q; }
        asm volatile("s_waitcnt lgkmcnt(0)" ::: "memory"); __builtin_amdgcn_s_barrier(); asm volatile("" ::: "memory");
        const int row = wid * 32 + (lane & 31);
        if (lane < 32) { const float t = (P[row * 4 + 0] + P[row * 4 + 1]) + (P[row * 4 + 2] + P[row * 4 + 3]);
            __hip_atomic_store(xbuf + ((size_t)(u.pm * BM + row) * 4 + u.pn), t, __ATOMIC_RELAXED, __HIP_MEMORY_SCOPE_AGENT); }
        asm volatile("s_waitcnt vmcnt(0)" ::: "memory");
        if (lane == 0) __hip_atomic_fetch_add(cnt + 64 * u.pm, 1u, __ATOMIC_RELAXED, __HIP_MEMORY_SCOPE_AGENT);
        if (wid == 0) { unsigned sp = 0u;
            while ((unsigned)__builtin_amdgcn_readfirstlane(__hip_atomic_load(cnt + 64 * u.pm, __ATOMIC_RELAXED, __HIP_MEMORY_SCOPE_AGENT)) < 32u) { __builtin_amdgcn_s_sleep(1); if (++sp > (1u << 22)) break; }
            __builtin_amdgcn_fence(__ATOMIC_ACQUIRE, "agent"); }
        asm volatile("s_waitcnt vmcnt(0) lgkmcnt(0)" ::: "memory"); __builtin_amdgcn_s_barrier(); asm volatile("" ::: "memory");
        if (lane < 32) { const float* slot = xbuf + (size_t)(u.pm * BM + row) * 4; float tot = 0.f;
#pragma unroll
            for (int t = 0; t < 4; ++t) tot += __hip_atomic_load(slot + t, __ATOMIC_RELAXED, __HIP_MEMORY_SCOPE_AGENT);
            S[row] = __builtin_amdgcn_rsqf(tot * (1.f / 1024.f) + EPS); }
        asm volatile("s_waitcnt lgkmcnt(0)" ::: "memory"); __builtin_amdgcn_s_barrier(); asm volatile("" ::: "memory");
    }
};
template <bool FINAL, bool BASEF32> struct EpiResNorm {
    static constexpr bool PERM = true, AFTER_DRAIN = true;
    const float* basef; bf16_t* xb; float* outf; bf16_t* xn; float wt; const float* gpost; const float* gnext; PanelSumSq st1, st2;
    __device__ __forceinline__ void operator()(const Acc&, const Unit&, int, int, int, int) const {}
    __device__ __forceinline__ void fused(Acc& acc, const Unit& u, int wr, int wc, int fr, int fq, LAS unsigned char* lds, int wid, int lane) const {
        const LAS float* S = (const LAS float*)(lds + 4096);
        const int col0 = u.pn * BM + wc * 32 + 8 * fq;
        st1.run(acc, u, wr, wc, fr, fq, lds, wid, lane);
#pragma unroll
        for (int ai = 0; ai < 2; ++ai)
#pragma unroll
            for (int m = 0; m < 4; ++m) { const int r = ai * HALF + wr * 64 + m * 16 + fr; const float sr = S[r] * wt;
                const size_t off = (size_t)(u.pm * BM + r) * 1024 + col0, xoff = (size_t)u.pm * 524288 + 262144 + (size_t)r * 1024 + col0;
#pragma unroll
                for (int bj = 0; bj < 2; ++bj) { f32x4 b0, b1;
                    if (BASEF32) { b0 = *(const f32x4*)(basef + off + bj * HALF); b1 = *(const f32x4*)(basef + off + bj * HALF + 4); }
                    else { const u32x4 w = *(const u32x4*)(xb + xoff + bj * HALF); b0 = (f32x4){bf_lo(w.x), bf_hi(w.x), bf_lo(w.y), bf_hi(w.y)}; b1 = (f32x4){bf_lo(w.z), bf_hi(w.z), bf_lo(w.w), bf_hi(w.w)}; }
                    const f32x4 g0 = *(const f32x4*)(gpost + col0 + bj * HALF), g1 = *(const f32x4*)(gpost + col0 + bj * HALF + 4);
                    acc[ai][bj][m][0] = b0 + acc[ai][bj][m][0] * g0 * sr; acc[ai][bj][m][1] = b1 + acc[ai][bj][m][1] * g1 * sr; }
                asm volatile("" : "+v"(acc[ai][0][m][0]), "+v"(acc[ai][0][m][1]), "+v"(acc[ai][1][m][0]), "+v"(acc[ai][1][m][1]));
                if (m & 1) asm volatile("" ::: "memory"); }
        st2.run(acc, u, wr, wc, fr, fq, lds, wid, lane);
#pragma unroll
        for (int ai = 0; ai < 2; ++ai)
#pragma unroll
            for (int m = 0; m < 4; ++m) { const int r = ai * HALF + wr * 64 + m * 16 + fr; const float sr = S[r];
                const size_t off = (size_t)(u.pm * BM + r) * 1024 + col0, xoff = (size_t)u.pm * 524288 + 262144 + (size_t)r * 1024 + col0;
#pragma unroll
                for (int bj = 0; bj < 2; ++bj) { const f32x4 x0 = acc[ai][bj][m][0], x1 = acc[ai][bj][m][1];
                    const f32x4 g0 = *(const f32x4*)(gnext + col0 + bj * HALF), g1 = *(const f32x4*)(gnext + col0 + bj * HALF + 4); const f32x4 o0 = x0 * g0 * sr, o1 = x1 * g1 * sr;
                    if (FINAL) { *(f32x4*)(outf + off + bj * HALF) = o0; *(f32x4*)(outf + off + bj * HALF + 4) = o1; }
                    else { u32x4 wx; wx.x = cvt_pk_bf16(x0[0], x0[1]); wx.y = cvt_pk_bf16(x0[2], x0[3]); wx.z = cvt_pk_bf16(x1[0], x1[1]); wx.w = cvt_pk_bf16(x1[2], x1[3]); *(u32x4*)(xb + xoff + bj * HALF) = wx;
                           u32x4 w; w.x = cvt_pk_bf16(o0[0], o0[1]); w.y = cvt_pk_bf16(o0[2], o0[3]); w.z = cvt_pk_bf16(o1[0], o1[1]); w.w = cvt_pk_bf16(o1[2], o1[3]); *(u32x4*)(xn + off + bj * HALF) = w; } }
                asm volatile("" ::: "memory"); }
    }
};
}

namespace att {
constexpr int NW = 8, QBLK = 32, KVBLK = 64;
constexpr float SCALE = 0.07216878364870322f;
constexpr float THR = 8.f;
constexpr int LDQ = 1536, LDKV = 2048, LDKR = 64, LDO = 1024;
constexpr int SHM_V = 64 * 128 * 2, SHM_K = 64 * 128 * 2, SHM_R = 64 * 64 * 2;
constexpr int NQL = 4;
constexpr int OFF_V = 0, OFF_K = 2 * SHM_V, OFF_RP = OFF_K + 2 * SHM_K, OFF_WS = OFF_RP + 2 * SHM_R, OFF_QL = OFF_WS + NW * 64 * 4, SHM_ATTN = OFF_QL + NW * NQL * 1024;
static_assert(SHM_ATTN <= LDS_STAGE, "lds");
#define KSWZ(row, colB) ((row) * 256 + ((colB) ^ (((row) & 15) << 4)))
#define RSWZ(row, colB) ((row) * 128 + ((colB) ^ ((((row) >> 1) & 7) << 4)))
#define SBAR() __builtin_amdgcn_sched_barrier(0)
__device__ __forceinline__ int crow(int r, int hi) { return (r & 3) + 8 * (r >> 2) + 4 * hi; }
__device__ __forceinline__ bf16x8 ld8(const bf16_t* p) { return *reinterpret_cast<const bf16x8*>(p); }

__device__ __forceinline__ void partialSM(f32x16& p0, f32x16& p1, float& m_reg, float& mn, float& alpha) {
    constexpr float C = SCALE * 1.4426950408889634f;
    float pmax = p0[0];
#pragma unroll
    for (int r = 1; r < 16; ++r) pmax = fmaxf(pmax, p0[r]);
#pragma unroll
    for (int r = 0; r < 16; ++r) pmax = fmaxf(pmax, p1[r]);
    { auto rr = __builtin_amdgcn_permlane32_swap(__float_as_uint(pmax), __float_as_uint(pmax), false, false);
      pmax = fmaxf(__uint_as_float(rr[0]), __uint_as_float(rr[1])); }
    if (__builtin_expect(__all(pmax - m_reg <= THR / SCALE), 1)) { mn = m_reg; alpha = 1.f; }
    else { mn = fmaxf(m_reg, pmax); alpha = __builtin_amdgcn_exp2f((m_reg - mn) * C); m_reg = mn; }
    float mnC = -mn * C;
#pragma unroll
    for (int r = 0; r < 16; ++r) p0[r] = fmaf(p0[r], C, mnC);
#pragma unroll
    for (int r = 0; r < 16; ++r) p1[r] = fmaf(p1[r], C, mnC);
#pragma unroll
    for (int r = 0; r < 16; ++r) p0[r] = __builtin_amdgcn_exp2f(p0[r]);
}
__device__ __forceinline__ void finishSM(f32x16& p0, f32x16& p1, float alpha, float& l_reg, bf16x8& pa0, bf16x8& pa1, bf16x8& pa2, bf16x8& pa3) {
#pragma unroll
    for (int r = 0; r < 16; ++r) p1[r] = __builtin_amdgcn_exp2f(p1[r]);
    float ps = 0;
#pragma unroll
    for (int r = 0; r < 16; ++r) ps += p0[r];
#pragma unroll
    for (int r = 0; r < 16; ++r) ps += p1[r];
    { auto rr = __builtin_amdgcn_permlane32_swap(__float_as_uint(ps), __float_as_uint(ps), false, false);
      ps = __uint_as_float(rr[0]) + __uint_as_float(rr[1]); }
    l_reg = l_reg * alpha + ps;
#define PK4(P, BASE, OUT) do { unsigned a0 = cvt_pk_bf16(P[BASE + 0], P[BASE + 1]), a1 = cvt_pk_bf16(P[BASE + 2], P[BASE + 3]);   \
    unsigned b0 = cvt_pk_bf16(P[BASE + 4], P[BASE + 5]), b1 = cvt_pk_bf16(P[BASE + 6], P[BASE + 7]);                              \
    auto r0 = __builtin_amdgcn_permlane32_swap(a0, b0, false, false); auto r1 = __builtin_amdgcn_permlane32_swap(a1, b1, false, false); \
    u32x4 w = {r0[0], r1[0], r0[1], r1[1]}; OUT = *reinterpret_cast<bf16x8*>(&w); } while (0)
    PK4(p0, 0, pa0); PK4(p0, 8, pa1); PK4(p1, 0, pa2); PK4(p1, 8, pa3);
#undef PK4
}
__device__ __forceinline__ void qkt(f32x16& p0, f32x16& p1, const char* Ks, const char* Rs, const bf16x8* qr, const char* ql, int r32, int hi) {
    p0 = f32x16{}; p1 = f32x16{};
#pragma unroll
    for (int d0 = 0; d0 < 8; ++d0) { int cb = (d0 * 16 + hi * 8) * 2;
        bf16x8 b0 = *reinterpret_cast<const bf16x8*>(Ks + KSWZ(r32, cb));
        bf16x8 b1 = *reinterpret_cast<const bf16x8*>(Ks + KSWZ(32 + r32, cb));
        p0 = __builtin_amdgcn_mfma_f32_32x32x16_bf16(b0, qr[d0], p0, 0, 0, 0);
        p1 = __builtin_amdgcn_mfma_f32_32x32x16_bf16(b1, qr[d0], p1, 0, 0, 0); }
#pragma unroll
    for (int d0 = 0; d0 < 4; ++d0) { int cb = (d0 * 16 + hi * 8) * 2;
        bf16x8 b0 = *reinterpret_cast<const bf16x8*>(Rs + RSWZ(r32, cb));
        bf16x8 b1 = *reinterpret_cast<const bf16x8*>(Rs + RSWZ(32 + r32, cb));
        const bf16x8 qv = *reinterpret_cast<const bf16x8*>(ql + d0 * 1024);
        p0 = __builtin_amdgcn_mfma_f32_32x32x16_bf16(b0, qv, p0, 0, 0, 0);
        p1 = __builtin_amdgcn_mfma_f32_32x32x16_bf16(b1, qv, p1, 0, 0, 0); }
}
__device__ __forceinline__ int v_st(int k, int c) { const int kk = (k & ~0xC) | ((k & 4) << 1) | ((k & 8) >> 1); return ((kk >> 3) * 4 + (c >> 5)) * 512 + ((kk & 7) * 32 + (c & 31)) * 2; }
__device__ __forceinline__ int v_rd_base(int lane) { return ((lane & 3) << 3) | (((lane >> 2) & 3) << 6) | (((lane >> 4) & 1) << 5) | (((lane >> 5) & 1) << 8); }
constexpr int v_rd_off(int d0, int ks, int half) { return d0 * 512 + ks * 4096 + half * 2048; }
template <int OFF> __device__ __forceinline__ s16x4 tr_read(int vb) {
    s16x4 r; asm volatile("ds_read_b64_tr_b16 %0, %1 offset:%2" : "=&v"(r) : "v"(vb), "i"(OFF) : "memory"); return r;
}
template <int D0> __device__ __forceinline__ void pv_one(f32x16& od, int vb, bf16x8 pa0, bf16x8 pa1, bf16x8 pa2, bf16x8 pa3) {
    const s16x4 l0 = tr_read<v_rd_off(D0, 0, 0)>(vb), h0 = tr_read<v_rd_off(D0, 0, 1)>(vb), l1 = tr_read<v_rd_off(D0, 1, 0)>(vb), h1 = tr_read<v_rd_off(D0, 1, 1)>(vb);
    const s16x4 l2 = tr_read<v_rd_off(D0, 2, 0)>(vb), h2 = tr_read<v_rd_off(D0, 2, 1)>(vb), l3 = tr_read<v_rd_off(D0, 3, 0)>(vb), h3 = tr_read<v_rd_off(D0, 3, 1)>(vb);
    asm volatile("s_waitcnt lgkmcnt(0)" ::: "memory"); SBAR();
#define PK(L, H) (bf16x8){L[0], L[1], L[2], L[3], H[0], H[1], H[2], H[3]}
    od = __builtin_amdgcn_mfma_f32_32x32x16_bf16(pa0, PK(l0, h0), od, 0, 0, 0);
    od = __builtin_amdgcn_mfma_f32_32x32x16_bf16(pa1, PK(l1, h1), od, 0, 0, 0);
    od = __builtin_amdgcn_mfma_f32_32x32x16_bf16(pa2, PK(l2, h2), od, 0, 0, 0);
    od = __builtin_amdgcn_mfma_f32_32x32x16_bf16(pa3, PK(l3, h3), od, 0, 0, 0);
#undef PK
}
__device__ __forceinline__ void pv_d0(f32x16* o, int vb, bf16x8 pa0, bf16x8 pa1, bf16x8 pa2, bf16x8 pa3) {
    pv_one<0>(o[0], vb, pa0, pa1, pa2, pa3); pv_one<1>(o[1], vb, pa0, pa1, pa2, pa3); pv_one<2>(o[2], vb, pa0, pa1, pa2, pa3); pv_one<3>(o[3], vb, pa0, pa1, pa2, pa3);
}

__device__ __forceinline__ void attn_body(const bf16_t* __restrict__ Qb, const bf16_t* __restrict__ Kn, const bf16_t* __restrict__ Kr, const bf16_t* __restrict__ Vh,
                                          bf16_t* __restrict__ Ob, int seq, char* lds) {
    const int tid = fresh_tid(), wid = tid >> 6, lane = tid & 63, r32 = lane & 31, hi = lane >> 5;
    char* V_lds = lds + OFF_V; char* K_lds = lds + OFF_K; char* R_lds = lds + OFF_RP;
    float* ws = (float*)(lds + OFF_WS) + wid * 64; float* li_l = ws; float* al_l = ws + 32;
    float m_reg = -1e30f, l_reg = 0; f32x16 o[4] = {}; bf16x8 qr[8];
    char* ql = lds + OFF_QL + wid * (NQL * 1024) + lane * 16;
    const bf16_t* Qw = Qb + (long)(wid * QBLK + r32) * LDQ + hi * 8;
#pragma unroll
    for (int d0 = 0; d0 < 8; ++d0) qr[d0] = ld8(Qw + d0 * 16);
#pragma unroll
    for (int d0 = 0; d0 < NQL; ++d0) *reinterpret_cast<bf16x8*>(ql + d0 * 1024) = ld8(Qw + (8 + d0) * 16);
    const int sr = tid >> 4, sc = (tid & 15) * 8, vst0 = v_st(sr, sc), vst1 = v_st(32 + sr, sc);
    const int rr_ = tid >> 3, rc_ = (tid & 7) * 8;
    const int vb0 = (int)(uintptr_t)V_lds + v_rd_base(lane);
    bf16x8 vs0, vs1, ks0, ks1, rs0;
#define SLOAD(k0) do { vs0 = ld8(&Vh[(long)((k0) + sr) * LDKV + sc]); vs1 = ld8(&Vh[(long)((k0) + 32 + sr) * LDKV + sc]); \
    ks0 = ld8(&Kn[(long)((k0) + sr) * LDKV + sc]); ks1 = ld8(&Kn[(long)((k0) + 32 + sr) * LDKV + sc]); rs0 = ld8(&Kr[(long)((k0) + rr_) * LDKR + rc_]); } while (0)
#define SWRITE(b) do { *(bf16x8*)(V_lds + (b) * SHM_V + vst0) = vs0; *(bf16x8*)(V_lds + (b) * SHM_V + vst1) = vs1; int kc = sc * 2; \
    *(bf16x8*)(K_lds + (b) * SHM_K + KSWZ(sr, kc)) = ks0; *(bf16x8*)(K_lds + (b) * SHM_K + KSWZ(32 + sr, kc)) = ks1; \
    *(bf16x8*)(R_lds + (b) * SHM_R + RSWZ(rr_, rc_ * 2)) = rs0; } while (0)
#define RESC(a) do { if (__any((a) < 1.f)) { if (hi == 0) al_l[r32] = (a); asm volatile("s_waitcnt lgkmcnt(0)" ::: "memory"); \
    _Pragma("unroll") for (int d = 0; d < 4; ++d) _Pragma("unroll") for (int r = 0; r < 16; ++r) o[d][r] *= al_l[crow(r, hi)]; } } while (0)
    f32x16 pA0, pA1, pB0, pB1; float mnA, mnB, alA, alB; bf16x8 pa0, pa1, pa2, pa3; const int NT = seq / KVBLK;
    SLOAD(0); asm volatile("s_waitcnt vmcnt(0)" ::: "memory"); SWRITE(0); __syncthreads();
    qkt(pA0, pA1, K_lds, R_lds, qr, ql, r32, hi); partialSM(pA0, pA1, m_reg, mnA, alA);
    SLOAD(KVBLK);
    asm volatile("s_waitcnt vmcnt(0)" ::: "memory"); SWRITE(1); __syncthreads();
    for (int j = 1; j + 1 < NT; j += 2) {
        SBAR(); qkt(pB0, pB1, K_lds + SHM_K, R_lds + SHM_R, qr, ql, r32, hi);
        finishSM(pA0, pA1, alA, l_reg, pa0, pa1, pa2, pa3); SBAR();
        SLOAD((j + 1) * KVBLK); SBAR();
        pv_d0(o, vb0, pa0, pa1, pa2, pa3); partialSM(pB0, pB1, m_reg, mnB, alB);
        __syncthreads(); asm volatile("s_waitcnt vmcnt(0)" ::: "memory"); SWRITE(0);
        RESC(alB); __syncthreads();
        SBAR(); qkt(pA0, pA1, K_lds, R_lds, qr, ql, r32, hi);
        finishSM(pB0, pB1, alB, l_reg, pa0, pa1, pa2, pa3); SBAR();
        SLOAD((j + 2) * KVBLK); SBAR();
        pv_d0(o, vb0 + SHM_V, pa0, pa1, pa2, pa3); partialSM(pA0, pA1, m_reg, mnA, alA);
        __syncthreads(); asm volatile("s_waitcnt vmcnt(0)" ::: "memory"); SWRITE(1);
        RESC(alA); __syncthreads();
    }
    SBAR(); qkt(pB0, pB1, K_lds + SHM_K, R_lds + SHM_R, qr, ql, r32, hi);
    finishSM(pA0, pA1, alA, l_reg, pa0, pa1, pa2, pa3); SBAR();
    pv_d0(o, vb0, pa0, pa1, pa2, pa3); partialSM(pB0, pB1, m_reg, mnB, alB);
    __syncthreads(); RESC(alB);
    finishSM(pB0, pB1, alB, l_reg, pa0, pa1, pa2, pa3); SBAR();
    pv_d0(o, vb0 + SHM_V, pa0, pa1, pa2, pa3);
    if (hi == 0) li_l[r32] = l_reg; asm volatile("s_waitcnt lgkmcnt(0)" ::: "memory");
    float rli[16];
#pragma unroll
    for (int r = 0; r < 16; ++r) rli[r] = __builtin_amdgcn_rcpf(li_l[crow(r, hi)]);
    bf16_t* Ow = Ob + (long)(wid * QBLK) * LDO;
#pragma unroll
    for (int r = 0; r < 16; ++r) { int orow = crow(r, hi);
#pragma unroll
        for (int d0 = 0; d0 < 4; ++d0) { const float v = o[d0][r] * rli[r]; Ow[(long)orow * LDO + d0 * 32 + r32] = (bf16_t)(cvt_pk_bf16(v, v) & 0xffffu); } }
#undef SLOAD
#undef SWRITE
#undef RESC
}
}


#define XB_TMO      128
#define XB_XCNT(j)  (256  + 64 * (j))
#define XB_XSUB(j)  (1280 + 64 * (j))
#define XB_XGEN(j)  (2304 + 64 * (j))
#define XB_TOP      3328
#define XB_TOPGEN   3392
#define XCD_BAR_WORDS 3456
#define XB_SPIN_CAP (1u << 18)
__device__ __forceinline__ unsigned xb_ld(unsigned* p)              { return __hip_atomic_load(p, __ATOMIC_RELAXED, __HIP_MEMORY_SCOPE_AGENT); }
__device__ __forceinline__ unsigned xb_add(unsigned* p, unsigned v) { return __hip_atomic_fetch_add(p, v, __ATOMIC_RELAXED, __HIP_MEMORY_SCOPE_AGENT); }
__device__ __forceinline__ unsigned xb_xcc_id() { return (unsigned)__builtin_amdgcn_s_getreg((3 << 11) | 20) & 0xFu; }
#define XB_SPIN(cond, bar) do { unsigned _sp = 0; while (cond) { __builtin_amdgcn_s_sleep(1); \
    if ((++_sp & 255u) == 0u) { if (xb_ld(&(bar)[XB_TMO])) break; if (_sp > XB_SPIN_CAP) { atomicAdd(&(bar)[XB_TMO], 1u); break; } } } } while (0)
struct XcdBarrier { unsigned* bar; unsigned x; volatile LAS unsigned* st; };
__device__ __forceinline__ XcdBarrier xcd_barrier_post(unsigned* bar, volatile LAS unsigned* st) {
    XcdBarrier b; b.bar = bar; b.x = xb_xcc_id(); b.st = st;
    if (threadIdx.x == 0) (void)xb_add(&bar[XB_XCNT(b.x)], 1u);
    return b;
}
__device__ __forceinline__ void xcd_barrier_complete(unsigned* bar, unsigned x, unsigned& nloc, unsigned& nx) {
    const unsigned G = gridDim.x * gridDim.y * gridDim.z;
    unsigned sum, cnt, mine, sp = 0u;
    for (;;) {
        sum = 0u; cnt = 0u; mine = 0u;
#pragma unroll
        for (unsigned j = 0; j < 16; ++j) { const unsigned c = xb_ld(&bar[XB_XCNT(j)]); sum += c; cnt += (c > 0u) ? 1u : 0u; mine = (j == x) ? c : mine; }
        if (sum == G) break;
        __builtin_amdgcn_s_sleep(1);
        if ((++sp & 255u) == 0u) { if (xb_ld(&bar[XB_TMO])) break; if (sp > XB_SPIN_CAP) { atomicAdd(&bar[XB_TMO], 1u); break; } }
    }
    nloc = mine > 0u ? mine : 1u; nx = cnt > 0u ? cnt : 1u;
}
__device__ __forceinline__ void xcd_barrier(const XcdBarrier& b) {
    asm volatile("s_waitcnt vmcnt(0)" ::: "memory");
    __syncthreads();
    if (threadIdx.x == 0) {
        unsigned* bar = b.bar;
        __builtin_amdgcn_s_waitcnt(0);
        unsigned nloc = b.st[0], nx = b.st[1];
        if (nloc == 0u) { xcd_barrier_complete(bar, b.x, nloc, nx); b.st[0] = nloc; b.st[1] = nx; }
        const unsigned old = xb_add(&bar[XB_XSUB(b.x)], 1u);
        const unsigned gen = old / nloc;
        if (old + 1u == (gen + 1u) * nloc) {
            __builtin_amdgcn_fence(__ATOMIC_RELEASE, "agent");
            asm volatile("s_waitcnt vmcnt(0)" ::: "memory");
            const unsigned og = xb_add(&bar[XB_TOP], 1u);
            const unsigned tg = og / nx;
            __builtin_amdgcn_fence(__ATOMIC_ACQUIRE, "agent");
            if (og + 1u == (tg + 1u) * nx) xb_add(&bar[XB_TOPGEN], 1u);
            else XB_SPIN(xb_ld(&bar[XB_TOPGEN]) == tg, bar);
            xb_add(&bar[XB_XGEN(b.x)], 1u);
            asm volatile("s_waitcnt vmcnt(0)" ::: "memory");
        } else {
            __builtin_amdgcn_fence(__ATOMIC_ACQUIRE, "agent");
            XB_SPIN(xb_ld(&bar[XB_XGEN(b.x)]) == gen, bar);
            asm volatile("s_waitcnt vmcnt(0)" ::: "memory");
        }
    }
    __syncthreads();
}

enum { TR_PLAIN = 0, TR_GU = 1, TR_WIN = 2, TR_UQ = 3, TR_UKV = 4 };
template <int MODE>
__device__ __forceinline__ void tr_job(const float* W0, const float* W1, int K, int Nsrc, int Nout, bf16_t* WT, LAS float* scr, int lane, int gw, int NGW) {
    const int nblk = Nout / 32, nitems = (K / 64) * nblk;
    for (int it = gw; it < nitems; it += NGW) {
        const int kb = it / nblk, nb = it % nblk, k0 = 64 * kb, n0 = 32 * nb, np = n0 + (lane & 31);
        const float* colp;
        if (MODE == TR_PLAIN) colp = W0 + np;
        else if (MODE == TR_GU) { const int t = np >> 8, w = np & 255; colp = (w < 128 ? W0 : W1) + t * 128 + (w & 127); }
        else if (MODE == TR_WIN) colp = np < 1216 ? W0 + np : (np < 1280 ? nullptr : W0 + (np - 64));
        else if (MODE == TR_UQ) { const int h = np / 192, w = np % 192; colp = W0 + (w < 128 ? np : h * 192 + 128 + ((w - 128) >> 1) + ((w - 128) & 1) * 32); }
        else colp = np < 1024 ? W0 + np : W1 + (np - 1024);
        float tv[32];
#pragma unroll
        for (int i = 0; i < 32; ++i) { const int kk = 2 * i + (lane >> 5); tv[i] = colp ? colp[(size_t)(k0 + kk) * Nsrc] : 0.f; }
#pragma unroll
        for (int i = 0; i < 32; ++i) { const int kk = 2 * i + (lane >> 5); scr[kk * 33 + (lane & 31)] = tv[i]; }
        asm volatile("s_waitcnt lgkmcnt(0)" ::: "memory");
        const int c = lane & 7;
#pragma unroll
        for (int j = 0; j < 4; ++j) { const int n = (lane >> 3) + 8 * j; const LAS float* s = scr + (8 * c) * 33 + n;
            u32x4 o; o.x = cvt_pk_bf16(s[0 * 33], s[1 * 33]); o.y = cvt_pk_bf16(s[2 * 33], s[3 * 33]); o.z = cvt_pk_bf16(s[4 * 33], s[5 * 33]); o.w = cvt_pk_bf16(s[6 * 33], s[7 * 33]);
            *(u32x4*)(WT + (size_t)(n0 + n) * K + k0 + 8 * c) = o; }
        asm volatile("s_waitcnt lgkmcnt(0)" ::: "memory");
    }
}

__device__ __forceinline__ void norm_rows(const float* xin, const float* gnext, bf16_t* xn, int gw, int NGW, int lane) {
    for (int row0 = gw; row0 < M; row0 += 2 * NGW) {
        f32x4 xv[2][4];
#pragma unroll
        for (int r = 0; r < 2; ++r) { const size_t row = (size_t)(row0 + r * NGW);
#pragma unroll
            for (int j = 0; j < 2; ++j) { xv[r][2 * j] = *(const f32x4*)(xin + row * DM + 8 * (lane + 64 * j)); xv[r][2 * j + 1] = *(const f32x4*)(xin + row * DM + 8 * (lane + 64 * j) + 4); } }
#pragma unroll
        for (int r = 0; r < 2; ++r) { const size_t row = (size_t)(row0 + r * NGW);
            float s2 = 0.f;
#pragma unroll
            for (int j = 0; j < 4; ++j) s2 += xv[r][j].x * xv[r][j].x + xv[r][j].y * xv[r][j].y + xv[r][j].z * xv[r][j].z + xv[r][j].w * xv[r][j].w;
            const float r2 = __builtin_amdgcn_rsqf(wave_sum(s2) * (1.f / DM) + EPS);
#pragma unroll
            for (int j = 0; j < 2; ++j) { const f32x4 g0 = *(const f32x4*)(gnext + 8 * (lane + 64 * j)), g1 = *(const f32x4*)(gnext + 8 * (lane + 64 * j) + 4);
                const f32x4 y0 = xv[r][2 * j] * g0 * r2, y1 = xv[r][2 * j + 1] * g1 * r2;
                u32x4 w; w.x = cvt_pk_bf16(y0.x, y0.y); w.y = cvt_pk_bf16(y0.z, y0.w); w.z = cvt_pk_bf16(y1.x, y1.y); w.w = cvt_pk_bf16(y1.z, y1.w);
                *(u32x4*)(xn + row * DM + 8 * (lane + 64 * j)) = w; }
        }
    }
}

__global__ void __launch_bounds__(NTHREADS, 2) fwd_megakernel(Params p) {
    extern __shared__ __attribute__((aligned(16))) unsigned char lds[];
    cg::grid_group grid = cg::this_grid();
    volatile LAS unsigned* bst = (volatile LAS unsigned*)((LAS unsigned char*)lds + LDS_STAGE);
    if (threadIdx.x < 2) bst[threadIdx.x] = 0u;
    __syncthreads();
    const XcdBarrier xbar = xcd_barrier_post((unsigned*)(p.ws + OFF_BAR), bst);
#define GRID_SYNC_CG() do { __builtin_amdgcn_fence(__ATOMIC_RELEASE, "agent"); asm volatile("s_waitcnt vmcnt(0)" ::: "memory"); grid.sync(); \
        __builtin_amdgcn_fence(__ATOMIC_ACQUIRE, "agent"); asm volatile("s_waitcnt vmcnt(0)" ::: "memory"); } while (0)
#define GRID_SYNC() xcd_barrier(xbar)
    const int G = gridDim.x, bid = blockIdx.x, NGW = G * NWAVES;
    LAS unsigned char* ldsl = (LAS unsigned char*)lds;
#define PHASE_IDS() const int tid = fresh_tid(), lane = tid & 63, wave = tid >> 6, gw = bid * NWAVES + wave; LAS float* scr = (LAS float*)(ldsl + wave * 8448); (void)scr; (void)gw; (void)lane
    unsigned char* ws = p.ws;
    bf16_t* Wgu = (bf16_t*)(ws + OFF_WGU); bf16_t* Wd = (bf16_t*)(ws + OFF_WD); bf16_t* Win = (bf16_t*)(ws + OFF_WIN); bf16_t* Wuq = (bf16_t*)(ws + OFF_WUQ);
    bf16_t* Wukv = (bf16_t*)(ws + OFF_WUKV); bf16_t* Woa = (bf16_t*)(ws + OFF_WOA); bf16_t* Wp = (bf16_t*)(ws + OFF_WP); bf16_t* Wout = (bf16_t*)(ws + OFF_WOUT);
    bf16_t* XN = (bf16_t*)(ws + OFF_XN); bf16_t* F = (bf16_t*)(ws + OFF_F); float* ZF = (float*)(ws + OFF_ZF); bf16_t* KV = (bf16_t*)(ws + OFF_KV);
    bf16_t* H = (bf16_t*)(ws + OFF_H); bf16_t* O = (bf16_t*)(ws + OFF_O); bf16_t* CQN = (bf16_t*)(ws + OFF_CQN); bf16_t* CKVN = (bf16_t*)(ws + OFF_CKVN);
    float* TAB = (float*)(ws + OFF_TAB); bf16_t* Q = (bf16_t*)(ws + OFF_Q); bf16_t* KR = (bf16_t*)(ws + OFF_KR); bf16_t* Gt = (bf16_t*)(ws + OFF_G); bf16_t* DP = (bf16_t*)(ws + OFF_DP);
    float* X = p.out;
    bf16_t* MXb = (bf16_t*)(ws + OFF_F + 32 * MiB);
    float* xbuf0 = (float*)(ws + OFF_XBUF); unsigned* cnt0 = (unsigned*)(ws + OFF_CNT);

    { PHASE_IDS();
    tr_job<TR_GU>(p.f1_wg, p.f1_wu, 1024, DFF, 5632, Wgu, scr, lane, gw, NGW);
    norm_rows(p.x, p.f1_pre, XN, gw, NGW, lane); }
    if (__builtin_expect(p.out == nullptr, 0)) GRID_SYNC_CG();
    GRID_SYNC();

    pg8::StaticOrder S;
    { pg8::Gemm g{XN, Wgu, M, 5632, 1024}; S.init(M, 5632, G, bid); pg8::EpiSwiGLU E{H}; pg8::gemm_phase(ldsl, g, S, E); }
    {
        const int tail0 = (64 * 22) % G;
        if (tail0 != 0 && bid >= tail0) { PHASE_IDS(); const int tb = bid - tail0, nb = G - tail0, tgw = tb * NWAVES + wave, TNGW = nb * NWAVES;
            tr_job<TR_PLAIN>(p.f1_wd, nullptr, DFF, 1024, 1024, Wd, scr, lane, tgw, TNGW);
            tr_job<TR_WIN>(p.w_in, nullptr, 1024, INW, 3328, Win, scr, lane, tgw, TNGW);
            tr_job<TR_UQ>(p.w_uq, nullptr, QL, 1536, 1536, Wuq, scr, lane, tgw, TNGW);
            tr_job<TR_UKV>(p.w_uk, p.w_uv, KVL, 1024, 2048, Wukv, scr, lane, tgw, TNGW);
    }
        else if (tail0 == 0) { PHASE_IDS(); const int tb = bid, nb = G;
            tr_job<TR_PLAIN>(p.f1_wd, nullptr, DFF, 1024, 1024, Wd, scr, lane, gw, NGW);
            tr_job<TR_WIN>(p.w_in, nullptr, 1024, INW, 3328, Win, scr, lane, gw, NGW);
            tr_job<TR_UQ>(p.w_uq, nullptr, QL, 1536, 1536, Wuq, scr, lane, gw, NGW);
            tr_job<TR_UKV>(p.w_uk, p.w_uv, KVL, 1024, 2048, Wukv, scr, lane, gw, NGW);
    }
    }
    GRID_SYNC();
    { pg8::Gemm g{H, Wd, M, 1024, DFF}; S.init(M, 1024, G, bid);
      pg8::EpiResNorm<false, true> E{p.x, (bf16_t*)X, nullptr, XN, 0.5f, p.f1_post, p.mix_pre, pg8::PanelSumSq{xbuf0, cnt0}, pg8::PanelSumSq{xbuf0 + (size_t)M * 4, cnt0 + 4096}}; pg8::gemm_phase(ldsl, g, S, E); }
    GRID_SYNC();
    { pg8::Gemm g{XN, Win, M, 1280, 1024}; S.init(M, 1280, G, bid); pg8::EpiBf16 E{(bf16_t*)ZF, 1280}; pg8::gemm_phase(ldsl, g, S, E); }
    {
        const int tail0 = (64 * 5) % G; PHASE_IDS();
        if (tail0 != 0 && bid >= tail0) { const int tgw = (bid - tail0) * NWAVES + wave, TNGW = (G - tail0) * NWAVES;
            tr_job<TR_GU>(p.f2_wg, p.f2_wu, 1024, DFF, 5632, Wgu, scr, lane, tgw, TNGW);
            tr_job<TR_PLAIN>(p.f2_wd, nullptr, DFF, 1024, 1024, Wd, scr, lane, tgw, TNGW); }
        else if (tail0 == 0) { tr_job<TR_GU>(p.f2_wg, p.f2_wu, 1024, DFF, 5632, Wgu, scr, lane, gw, NGW); tr_job<TR_PLAIN>(p.f2_wd, nullptr, DFF, 1024, 1024, Wd, scr, lane, gw, NGW); }
    }
    GRID_SYNC();
    { PHASE_IDS();
    const bf16_t* ZB = (const bf16_t*)ZF;
    for (int bt = gw; bt < M / 4; bt += NGW) { const int row0 = bt * 4, t0 = row0 & (SEQ - 1);
        const int lane = fresh_tid() & 63;
        const int t_g = lane >> 4, wnd = 2 << t_g, wl = wnd >> 1, wrr = wnd - wl;
        u32x4 nb[19], qa[4], qb[4]; float kx1[4], kx2[4]; int pos[4];
#pragma unroll
        for (int i = 0; i < 19; ++i) { int tt = t0 - 8 + i; tt = tt < 0 ? 0 : (tt > SEQ - 1 ? SEQ - 1 : tt); nb[i] = *(const u32x4*)(ZB + (size_t)(row0 - t0 + tt) * 1280 + 704 + 8 * lane); }
#pragma unroll
        for (int k = 0; k < 4; ++k) { const bf16_t* z = ZB + (size_t)(row0 + k) * 1280;
            qa[k] = *(const u32x4*)(z + 8 * lane); qb[k] = (u32x4){0u, 0u, 0u, 0u}; if (lane < 16) qb[k] = *(const u32x4*)(z + 512 + 8 * lane);
            kx1[k] = 0.f; kx2[k] = 0.f; pos[k] = 0; if (lane < 32) { kx1[k] = bf_lo((unsigned)z[640 + lane]); kx2[k] = bf_lo((unsigned)z[672 + lane]); pos[k] = p.pos[row0 + k]; } }
        __builtin_amdgcn_sched_barrier(0);
#pragma unroll
        for (int k = 0; k < 4; ++k) { const int row = row0 + k, t = t0 + k, lo = max(t - wl, 0), hi = min(t + wrr, SEQ);
            float sacc[8];
#pragma unroll
            for (int i = 0; i < 8; ++i) sacc[i] = 0.f;
#pragma unroll
            for (int d = 0; d < 16; ++d) { const int tt = t - 8 + d; const float wv = (tt >= lo && tt < hi) ? 1.f : 0.f; const u32x4 v = nb[k + d];
                sacc[0] = fmaf(wv, bf_lo(v.x), sacc[0]); sacc[1] = fmaf(wv, bf_hi(v.x), sacc[1]); sacc[2] = fmaf(wv, bf_lo(v.y), sacc[2]); sacc[3] = fmaf(wv, bf_hi(v.y), sacc[3]);
                sacc[4] = fmaf(wv, bf_lo(v.z), sacc[4]); sacc[5] = fmaf(wv, bf_hi(v.z), sacc[5]); sacc[6] = fmaf(wv, bf_lo(v.w), sacc[6]); sacc[7] = fmaf(wv, bf_hi(v.w), sacc[7]); }
            {
                const float inv = 1.f / (float)(hi - lo); const u32x4 pc = nb[k + 8];
                u32x4 w; w.x = cvt_pk_bf16(sacc[0] * inv - bf_lo(pc.x), sacc[1] * inv - bf_hi(pc.x)); w.y = cvt_pk_bf16(sacc[2] * inv - bf_lo(pc.y), sacc[3] * inv - bf_hi(pc.y));
                w.z = cvt_pk_bf16(sacc[4] * inv - bf_lo(pc.z), sacc[5] * inv - bf_hi(pc.z)); w.w = cvt_pk_bf16(sacc[6] * inv - bf_lo(pc.w), sacc[7] * inv - bf_hi(pc.w));
                *(u32x4*)(DP + (size_t)row * 512 + 8 * lane) = w; }
            {
                const u32x4 a4 = qa[k], b4 = qb[k];
                float va[8] = {bf_lo(a4.x), bf_hi(a4.x), bf_lo(a4.y), bf_hi(a4.y), bf_lo(a4.z), bf_hi(a4.z), bf_lo(a4.w), bf_hi(a4.w)};
                float vb[8] = {bf_lo(b4.x), bf_hi(b4.x), bf_lo(b4.y), bf_hi(b4.y), bf_lo(b4.z), bf_hi(b4.z), bf_lo(b4.w), bf_hi(b4.w)};
                float sa = 0.f, sb = 0.f;
#pragma unroll
                for (int i = 0; i < 8; ++i) { sa = fmaf(va[i], va[i], sa); sb = fmaf(vb[i], vb[i], sb); }
                const float ssq = wave_sum(lane < 48 ? sa : 0.f), sskv = wave_sum((lane >= 48 ? sa : 0.f) + sb);
                const float rq = __builtin_amdgcn_rsqf(ssq * (1.f / QL) + EPS), rkv = __builtin_amdgcn_rsqf(sskv * (1.f / KVL) + EPS);
                const float* ga = lane < 48 ? p.qa_g + 8 * lane : p.kva_g + 8 * (lane - 48); const float ra = lane < 48 ? rq : rkv;
                const f32x4 g0 = *(const f32x4*)ga, g1 = *(const f32x4*)(ga + 4);
                u32x4 w; w.x = cvt_pk_bf16(va[0] * g0.x * ra, va[1] * g0.y * ra); w.y = cvt_pk_bf16(va[2] * g0.z * ra, va[3] * g0.w * ra); w.z = cvt_pk_bf16(va[4] * g1.x * ra, va[5] * g1.y * ra); w.w = cvt_pk_bf16(va[6] * g1.z * ra, va[7] * g1.w * ra);
                bf16_t* dst = lane < 48 ? CQN + (size_t)row * QL + 8 * lane : CKVN + (size_t)row * KVL + 8 * (lane - 48);
                *(u32x4*)dst = w;
                if (lane < 16) { const f32x4 h0 = *(const f32x4*)(p.kva_g + 128 + 8 * lane), h1 = *(const f32x4*)(p.kva_g + 132 + 8 * lane);
                    u32x4 w2; w2.x = cvt_pk_bf16(vb[0] * h0.x * rkv, vb[1] * h0.y * rkv); w2.y = cvt_pk_bf16(vb[2] * h0.z * rkv, vb[3] * h0.w * rkv); w2.z = cvt_pk_bf16(vb[4] * h1.x * rkv, vb[5] * h1.y * rkv); w2.w = cvt_pk_bf16(vb[6] * h1.z * rkv, vb[7] * h1.w * rkv);
                    *(u32x4*)(CKVN + (size_t)row * KVL + 128 + 8 * lane) = w2; }
            }
            if (lane < 32) {
                const float ang = (float)pos[k] * p.inv_freq[lane];
                const double ad = (double)ang; const double kq = rint(ad * 0.15915494309189535); const float red = (float)(ad - kq * 6.283185307179586);
                const float cs = __cosf(red), sn = __sinf(red);
                TAB[(size_t)row * 64 + lane] = cs; TAB[(size_t)row * 64 + 32 + lane] = sn;
                *(unsigned*)(KR + (size_t)row * 64 + 2 * lane) = cvt_pk_bf16(kx1[k] * cs - kx2[k] * sn, kx2[k] * cs + kx1[k] * sn);
            }
            __builtin_amdgcn_sched_barrier(0);
        }
    } }
    GRID_SYNC();
    { pg8::Gemm g{CQN, Wuq, M, 1536, QL}; S.init(M, 1536, G, bid); pg8::EpiQ E{Q, TAB}; pg8::gemm_phase(ldsl, g, S, E); }
    {
        const int tail0 = (64 * 6) % G;
        if (tail0 != 0 && bid >= tail0) { PHASE_IDS(); const int tb = bid - tail0, nb = G - tail0, tgw = tb * NWAVES + wave, TNGW = nb * NWAVES;
            tr_job<TR_PLAIN>(p.w_oa, nullptr, 1024, 1024, 1024, Woa, scr, lane, tgw, TNGW);
            tr_job<TR_PLAIN>(p.w_out, nullptr, 1024, 1024, 1024, Wout, scr, lane, tgw, TNGW);
    for (int idx = tb * NTHREADS + tid; idx < 65536; idx += nb * NTHREADS) {
            const int n = idx & 1023, c8 = idx >> 10, g = c8 >> 4, cb = (c8 & 15) * 8;
            float a[8];
    #pragma unroll
            for (int i = 0; i < 8; ++i) a[i] = 0.f;
            for (int j0 = 0; j0 < 128; j0 += 8) { float w[8]; f32x4 pw[8][2];
    #pragma unroll
                for (int jj = 0; jj < 8; ++jj) w[jj] = p.w_op[(size_t)(g * 128 + j0 + jj) * 1024 + n] * p.pool_scale[g * 128 + j0 + jj];
    #pragma unroll
                for (int i = 0; i < 8; ++i) { pw[i][0] = *(const f32x4*)(p.pool_w + (size_t)(g * 128 + cb + i) * 128 + j0); pw[i][1] = *(const f32x4*)(p.pool_w + (size_t)(g * 128 + cb + i) * 128 + j0 + 4); }
    #pragma unroll
                for (int i = 0; i < 8; ++i)
    #pragma unroll
                    for (int jj = 0; jj < 8; ++jj) a[i] = fmaf(pw[i][jj >> 2][jj & 3], w[jj], a[i]); }
            u32x4 o; o.x = cvt_pk_bf16(a[0], a[1]); o.y = cvt_pk_bf16(a[2], a[3]); o.z = cvt_pk_bf16(a[4], a[5]); o.w = cvt_pk_bf16(a[6], a[7]);
            *(u32x4*)(Wp + (size_t)n * 512 + c8 * 8) = o;
        }
        }
        else if (tail0 == 0) { PHASE_IDS(); const int tb = bid, nb = G;
            tr_job<TR_PLAIN>(p.w_oa, nullptr, 1024, 1024, 1024, Woa, scr, lane, gw, NGW);
            tr_job<TR_PLAIN>(p.w_out, nullptr, 1024, 1024, 1024, Wout, scr, lane, gw, NGW);
    for (int idx = tb * NTHREADS + tid; idx < 65536; idx += nb * NTHREADS) {
            const int n = idx & 1023, c8 = idx >> 10, g = c8 >> 4, cb = (c8 & 15) * 8;
            float a[8];
    #pragma unroll
            for (int i = 0; i < 8; ++i) a[i] = 0.f;
            for (int j0 = 0; j0 < 128; j0 += 8) { float w[8]; f32x4 pw[8][2];
    #pragma unroll
                for (int jj = 0; jj < 8; ++jj) w[jj] = p.w_op[(size_t)(g * 128 + j0 + jj) * 1024 + n] * p.pool_scale[g * 128 + j0 + jj];
    #pragma unroll
                for (int i = 0; i < 8; ++i) { pw[i][0] = *(const f32x4*)(p.pool_w + (size_t)(g * 128 + cb + i) * 128 + j0); pw[i][1] = *(const f32x4*)(p.pool_w + (size_t)(g * 128 + cb + i) * 128 + j0 + 4); }
    #pragma unroll
                for (int i = 0; i < 8; ++i)
    #pragma unroll
                    for (int jj = 0; jj < 8; ++jj) a[i] = fmaf(pw[i][jj >> 2][jj & 3], w[jj], a[i]); }
            u32x4 o; o.x = cvt_pk_bf16(a[0], a[1]); o.y = cvt_pk_bf16(a[2], a[3]); o.z = cvt_pk_bf16(a[4], a[5]); o.w = cvt_pk_bf16(a[6], a[7]);
            *(u32x4*)(Wp + (size_t)n * 512 + c8 * 8) = o;
        }
        }
    }
    __syncthreads();
    { pg8::Gemm g{CKVN, Wukv, M, 2048, KVL}; S.init(M, 2048, G, bid); pg8::EpiBf16 E{KV, 2048}; pg8::gemm_phase(ldsl, g, S, E); }
    GRID_SYNC();
    {
        const int vcu = (bid & 7) * (G >> 3) + (bid >> 3);
        for (int it = vcu; it < NB * NH * (SEQ / 256); it += G) {
            const int qb = it & 7, h = (it >> 3) & 7, b = it >> 6;
            const size_t tok0 = (size_t)b * SEQ;
            att::attn_body(Q + (tok0 + qb * 256) * 1536 + h * 192, KV + tok0 * 2048 + h * 128, KR + tok0 * 64, KV + tok0 * 2048 + 1024 + h * 128,
                           O + (tok0 + qb * 256) * 1024 + h * 128, SEQ, (char*)lds);
            __syncthreads();
        }
    }
    GRID_SYNC();
    { pg8::Gemm g{XN, Win + (size_t)1280 * 1024, M, 2048, 1024}; pg8::GateOrder GO; GO.s.init(M, 1024, G, bid); pg8::EpiGate E{Gt}; pg8::gemm_phase(ldsl, g, GO, E); }
    { pg8::Gemm g{O, Woa, M, 1024, 1024}; S.init(M, 1024, G, bid); pg8::EpiT1 E{Gt, F}; pg8::gemm_phase(ldsl, g, S, E); }
    { pg8::Gemm g{DP, Wp, M, 1024, 512}; S.init(M, 1024, G, bid); pg8::EpiMX E{Gt, F, MXb}; pg8::gemm_phase(ldsl, g, S, E); }
    GRID_SYNC();
    { pg8::Gemm g{MXb, Wout, M, 1024, 1024}; S.init(M, 1024, G, bid);
      pg8::EpiResNorm<false, false> E{nullptr, (bf16_t*)X, nullptr, XN, 1.0f, p.mix_post, p.f2_pre, pg8::PanelSumSq{xbuf0 + (size_t)M * 8, cnt0 + 2 * 4096}, pg8::PanelSumSq{xbuf0 + (size_t)M * 12, cnt0 + 3 * 4096}}; pg8::gemm_phase(ldsl, g, S, E); }
    GRID_SYNC();
    { pg8::Gemm g{XN, Wgu, M, 5632, 1024}; S.init(M, 5632, G, bid); pg8::EpiSwiGLU E{H}; pg8::gemm_phase(ldsl, g, S, E); }
    GRID_SYNC();
    { pg8::Gemm g{H, Wd, M, 1024, DFF}; S.init(M, 1024, G, bid);
      pg8::EpiResNorm<true, false> E{nullptr, (bf16_t*)X, X, nullptr, 0.5f, p.f2_post, p.final_g, pg8::PanelSumSq{xbuf0 + (size_t)M * 16, cnt0 + 4 * 4096}, pg8::PanelSumSq{xbuf0 + (size_t)M * 20, cnt0 + 5 * 4096}}; pg8::gemm_phase(ldsl, g, S, E); }
}

extern "C" void kernel_launch(void* const* d_in, const int* in_sizes, int n_in, void* d_out, int out_size, void* d_ws, size_t ws_size, hipStream_t stream) {
    static int grid_blocks = 0;
    if (grid_blocks == 0) {
        if (n_in != 26 || in_sizes[0] != M * DM || out_size != M * DM || ws_size < WS_END) { fprintf(stderr, "kernel_launch: shape mismatch n_in %d in0 %d out %d ws %zu\n", n_in, n_in > 0 ? in_sizes[0] : -1, out_size, ws_size); grid_blocks = -1; return; }
        int dev = 0, cus = 0, per_cu = 0;
        (void)hipGetDevice(&dev);
        (void)hipDeviceGetAttribute(&cus, hipDeviceAttributeMultiprocessorCount, dev);
        if (hipFuncSetAttribute((const void*)fwd_megakernel, hipFuncAttributeMaxDynamicSharedMemorySize, LDS_BYTES) != hipSuccess) { fprintf(stderr, "kernel_launch: hipFuncSetAttribute failed\n"); grid_blocks = -1; return; }
        if (hipOccupancyMaxActiveBlocksPerMultiprocessor(&per_cu, (const void*)fwd_megakernel, NTHREADS, LDS_BYTES) != hipSuccess || per_cu < 1) { fprintf(stderr, "kernel_launch: occupancy query failed (%d)\n", per_cu); (void)hipGetLastError(); per_cu = 1; }
        grid_blocks = cus * 1;
        if (grid_blocks != 256) { fprintf(stderr, "kernel_launch: built for 256 CUs (one workgroup each), device has %d\n", cus); grid_blocks = -1; return; }
    }
    if (grid_blocks < 0) return;
    Params p{};
    p.x = (const float*)d_in[0]; p.pos = (const int*)d_in[1];
    p.f1_pre = (const float*)d_in[2]; p.f1_wg = (const float*)d_in[3]; p.f1_wu = (const float*)d_in[4]; p.f1_wd = (const float*)d_in[5]; p.f1_post = (const float*)d_in[6];
    p.mix_pre = (const float*)d_in[7]; p.w_in = (const float*)d_in[8]; p.qa_g = (const float*)d_in[9]; p.w_uq = (const float*)d_in[10]; p.kva_g = (const float*)d_in[11];
    p.w_uk = (const float*)d_in[12]; p.w_uv = (const float*)d_in[13]; p.w_oa = (const float*)d_in[14]; p.pool_w = (const float*)d_in[15]; p.pool_scale = (const float*)d_in[16];
    p.w_op = (const float*)d_in[17]; p.w_out = (const float*)d_in[18]; p.mix_post = (const float*)d_in[19];
    p.f2_pre = (const float*)d_in[20]; p.f2_wg = (const float*)d_in[21]; p.f2_wu = (const float*)d_in[22]; p.f2_wd = (const float*)d_in[23]; p.f2_post = (const float*)d_in[24]; p.final_g = (const float*)d_in[25];
    p.out = (float*)d_out; p.ws = (unsigned char*)d_ws;
    for (int i = 0; i < 32; ++i) p.inv_freq[i] = (float)pow(10000.0, -(2.0 * i) / 64.0);
    if (hipMemsetAsync((char*)d_ws + OFF_BAR, 0, CTL_BYTES, stream) != hipSuccess) { fprintf(stderr, "kernel_launch: memset failed\n"); return; }
    void* args[] = {&p};
    hipError_t e = hipLaunchCooperativeKernel((const void*)fwd_megakernel, dim3(grid_blocks), dim3(NTHREADS), args, LDS_BYTES, stream);
    if (e != hipSuccess) fprintf(stderr, "cooperative launch failed: %s (grid %d)\n", hipGetErrorString(e), grid_blocks);
}
```

```cpp
#include <hip/hip_runtime.h>
#include <hip/hip_cooperative_groups.h>
#include <cstdio>
#include <cmath>
#include <cstdint>
namespace cg = cooperative_groups;

#define LAS __attribute__((address_space(3)))
typedef unsigned short bf16_t;
typedef short bf16x8 __attribute__((ext_vector_type(8)));
typedef short s16x4 __attribute__((ext_vector_type(4)));
typedef float f32x2 __attribute__((ext_vector_type(2)));
typedef float f32x4 __attribute__((ext_vector_type(4)));
typedef float f32x16 __attribute__((ext_vector_type(16)));
typedef unsigned u32x4 __attribute__((ext_vector_type(4)));
typedef unsigned u32x2 __attribute__((ext_vector_type(2)));

constexpr int DM = 1024, NB = 8, SEQ = 2048, M = NB * SEQ, NH = 8, QL = 384, KVL = 256, DFF = 2816, INW = 3264;
constexpr float EPS = 1e-6f;
constexpr int NTHREADS = 512, NWAVES = 8;
constexpr int LDS_STAGE = 131072, LDS_BYTES = LDS_STAGE + 16;

constexpr size_t MiB = 1048576;
constexpr size_t OFF_WGU = 0;
constexpr size_t OFF_WD = OFF_WGU + (size_t)5632 * 1024 * 2;
constexpr size_t OFF_WIN = OFF_WD + (size_t)1024 * 2816 * 2;
constexpr size_t OFF_WUQ = OFF_WIN + (size_t)3328 * 1024 * 2;
constexpr size_t OFF_WUKV = OFF_WUQ + (size_t)1536 * 384 * 2;
constexpr size_t OFF_WOA = OFF_WUKV + (size_t)2048 * 256 * 2;
constexpr size_t OFF_WP = OFF_WOA + (size_t)1024 * 1024 * 2;
constexpr size_t OFF_WOUT = OFF_WP + (size_t)1024 * 512 * 2;
constexpr size_t OFF_XN = OFF_WOUT + (size_t)1024 * 1024 * 2;
constexpr size_t OFF_R = OFF_XN + 32 * MiB;
constexpr size_t OFF_F = OFF_R;
constexpr size_t OFF_ZF = OFF_R;
constexpr size_t OFF_KV = OFF_R;
constexpr size_t OFF_H = OFF_R + 64 * MiB;
constexpr size_t OFF_O = OFF_R + 64 * MiB;
constexpr size_t OFF_CQN = OFF_R + 80 * MiB;
constexpr size_t OFF_CKVN = OFF_R + 92 * MiB;
constexpr size_t OFF_TAB = OFF_R + 100 * MiB;
constexpr size_t OFF_Q = OFF_R + 104 * MiB;
constexpr size_t OFF_KR = OFF_R + 152 * MiB;
constexpr size_t OFF_G = OFF_R + 96 * MiB;
constexpr size_t OFF_DP = OFF_R + 176 * MiB;
constexpr size_t WS_END = OFF_R + 192 * MiB;
constexpr size_t OFF_BAR = WS_END, OFF_CNT = OFF_BAR + 16384, CTL_BYTES = 16384 + 6 * 16384, OFF_XBUF = OFF_BAR + CTL_BYTES;
static_assert(OFF_XBUF + 6 * (size_t)M * 16 <= 256 * MiB, "workspace");

struct Params {
    const float* x; const int* pos;
    const float *f1_pre, *f1_wg, *f1_wu, *f1_wd, *f1_post;
    const float *mix_pre, *w_in, *qa_g, *w_uq, *kva_g, *w_uk, *w_uv, *w_oa, *pool_w, *pool_scale, *w_op, *w_out, *mix_post;
    const float *f2_pre, *f2_wg, *f2_wu, *f2_wd, *f2_post, *final_g;
    float* out; unsigned char* ws;
    float inv_freq[32];
};

typedef __bf16 bf16x2_t __attribute__((ext_vector_type(2)));
__device__ __forceinline__ unsigned cvt_pk_bf16(float lo, float hi) { const f32x2 v = {lo, hi}; const bf16x2_t r = __builtin_convertvector(v, bf16x2_t); return __builtin_bit_cast(unsigned, r); }
__device__ __forceinline__ float bf_lo(unsigned w) { return __uint_as_float(w << 16); }
__device__ __forceinline__ float bf_hi(unsigned w) { return __uint_as_float(w & 0xffff0000u); }
__device__ __forceinline__ float sigmoidf_fast(float z) { return __builtin_amdgcn_rcpf(1.f + __builtin_amdgcn_exp2f(-1.4426950408889634f * z)); }
__device__ __forceinline__ int fresh_tid() { int t = threadIdx.x; asm volatile("" : "+v"(t)); return t; }
__device__ __forceinline__ float wave_sum(float v) {
#pragma unroll
    for (int o = 1; o < 64; o <<= 1) v += __shfl_xor(v, o);
    return v;
}

namespace pg8 {
constexpr int BM = 256, BK = 64, HALF = 128, HTB = HALF * BK * 2, STAGE_BYTES = 8 * HTB, NXCD = 8, WGM = 4;
__host__ __device__ __forceinline__ int lds_byte(int r, int c) { const int st = (r >> 4) * 2 + (c >> 5), rr = r & 15, cc = c & 31, ob = rr * 64 + cc * 2; return st * 1024 + (ob ^ (((ob >> 9) & 1) << 5)); }
__host__ __device__ __forceinline__ void stage_rc(int b, int& R, int& C) { const int st = b / 1024, sb = b % 1024, swz = sb ^ (((sb >> 9) & 1) << 5); R = (st >> 1) * 16 + swz / 64; C = (st & 1) * 32 + (swz % 64) / 2; }
__host__ __device__ __forceinline__ int perm32(int rho) { const int n = rho >> 4, i = rho & 15; return 8 * (i >> 2) + 4 * n + (i & 3); }
struct Unit { int pm, pn; };
struct Gemm { const bf16_t* A; const bf16_t* Bt; int M, N, K; };
struct StaticOrder {
    int nM, nN, nwg, G, c;
    __device__ void init(int M_, int N_, int G_, int c_) { nM = M_ / BM; nN = N_ / BM; nwg = nM * nN; G = G_; c = c_; }
    __device__ bool next(int i, Unit& u) const {
        const long L = (long)i * G + c; if (L >= nwg) return false;
        int wgid = (int)L; { const int q = nwg / NXCD, r = nwg % NXCD, xcd = wgid % NXCD, off = wgid / NXCD; wgid = (xcd < r ? xcd * (q + 1) : r * (q + 1) + (xcd - r) * q) + off; }
        const int nig = WGM * nN, gid = wgid / nig, fm = gid * WGM, gsz = (nM - fm) < WGM ? (nM - fm) : WGM;
        u.pm = fm + ((wgid % nig) % gsz); u.pn = (wgid % nig) / gsz; return true;
    }
};

struct GateOrder { StaticOrder s;
    __device__ bool next(int i, Unit& u) const { if (i >= 2) return false; Unit b; if (!s.next(0, b)) return false; u.pm = b.pm; u.pn = b.pn + 4 * i; return true; } };
template <class Epi, class Sched>
__device__ __forceinline__ void gemm_phase(LAS unsigned char* lds, const Gemm g, const Sched& S, const Epi& E) {
    const int tid = fresh_tid(), wid = __builtin_amdgcn_readfirstlane(tid >> 6), lane = tid & 63, wr = wid >> 2, wc = wid & 3, fr = lane & 15, fq = lane >> 4;
    const int K = g.K, nt = K / BK;
    unsigned voffA, voffB;
    { int R, C; stage_rc(tid * 16, R, C); const int Rb = Epi::PERM ? ((R & ~31) + perm32(R & 31)) : R;
      voffA = (unsigned)(R * K + C) * 2u; voffB = (unsigned)(Rb * K + C) * 2u; }
    const size_t rstep64 = (size_t)64 * K * 2;
    const size_t kstep = (size_t)(BK * 2);
    const size_t hstep = (size_t)HALF * K * 2;
    const size_t tstep = 2 * hstep;
    const unsigned ldsw = (unsigned)wid * 1024u;
    const int aoff = lds_byte(wr * 64 + fr, fq * 8), boff = lds_byte(wc * 32 + fr, fq * 8);
#define PG8_SA(b, h) (((b) * 2 + (h)) * HTB)
#define PG8_SB(b, h) ((4 + (b) * 2 + (h)) * HTB)
#define PG8_STAGE(bufoff, gbase, voff) do { _Pragma("unroll") for (int _i = 0; _i < 2; ++_i) \
        __builtin_amdgcn_global_load_lds((const unsigned*)((const char*)(gbase) + _i * rstep64 + (voff)), (LAS unsigned*)(lds + (bufoff) + ldsw + _i * 8192), 16, 0, 0); } while (0)
#define PG8_LDA(dst, b, h) do { _Pragma("unroll") for (int m = 0; m < 4; ++m) _Pragma("unroll") for (int k = 0; k < 2; ++k) dst[m][k] = *(const LAS bf16x8*)(lds + PG8_SA(b, h) + aoff + m * 2048 + k * 1024); } while (0)
#define PG8_LDB(dst, b, h) do { _Pragma("unroll") for (int n = 0; n < 2; ++n) _Pragma("unroll") for (int k = 0; k < 2; ++k) dst[n][k] = *(const LAS bf16x8*)(lds + PG8_SB(b, h) + boff + n * 2048 + k * 1024); } while (0)
#define PG8_MMA(ai, bj, At, Bt) do { __builtin_amdgcn_s_setprio(1); _Pragma("unroll") for (int m = 0; m < 4; ++m) _Pragma("unroll") for (int n = 0; n < 2; ++n) _Pragma("unroll") for (int k = 0; k < 2; ++k) \
        acc[ai][bj][m][n] = __builtin_amdgcn_mfma_f32_16x16x32_bf16(Bt[n][k], At[m][k], acc[ai][bj][m][n], 0, 0, 0); __builtin_amdgcn_s_setprio(0); } while (0)
#define PG8_WAIT_V(n) asm volatile("s_waitcnt vmcnt(" #n ")" ::: "memory")
#define PG8_WAIT_L(n) asm volatile("s_waitcnt lgkmcnt(" #n ")" ::: "memory")
#define PG8_BAR __builtin_amdgcn_s_barrier()
#define PG8_SCHED __builtin_amdgcn_sched_barrier(0)
    Unit cur, nxt; int ui = 0;
    if (!S.next(0, cur)) return;
    f32x4 acc[2][2][4][2];
#pragma unroll
    for (int a = 0; a < 2; ++a)
#pragma unroll
        for (int b = 0; b < 2; ++b)
#pragma unroll
            for (int m = 0; m < 4; ++m)
#pragma unroll
                for (int n = 0; n < 2; ++n) acc[a][b][m][n] = (f32x4){0.f, 0.f, 0.f, 0.f};
    bf16x8 At[4][2], B0[2][2], B1[2][2];
    const char* cA = (const char*)g.A + (size_t)cur.pm * tstep; const char* cB = (const char*)g.Bt + (size_t)cur.pn * tstep;
    PG8_STAGE(PG8_SB(0, 0), cB, voffB); PG8_STAGE(PG8_SA(0, 0), cA, voffA); PG8_STAGE(PG8_SB(0, 1), cB + hstep, voffB); PG8_STAGE(PG8_SA(0, 1), cA + hstep, voffA);
    if (wr == 1) PG8_BAR;
    PG8_WAIT_V(4); PG8_BAR;
    PG8_STAGE(PG8_SB(1, 0), cB + kstep, voffB); PG8_STAGE(PG8_SA(1, 0), cA + kstep, voffA); PG8_STAGE(PG8_SB(1, 1), cB + hstep + kstep, voffB);
    PG8_WAIT_V(6); PG8_BAR;
    for (;;) {
        const bool has_next = S.next(ui + 1, nxt);
        const char* nA = has_next ? (const char*)g.A + (size_t)nxt.pm * tstep : cA; const char* nB = has_next ? (const char*)g.Bt + (size_t)nxt.pn * tstep : cB;
        for (int t = 0; t < nt; t += 2) {
            const bool last = (t == nt - 2);
            const char* a1 = cA + (size_t)(t + 1) * kstep;
            const char* a2 = last ? nA : cA + (size_t)(t + 2) * kstep; const char* b2 = last ? nB : cB + (size_t)(t + 2) * kstep;
            const char* a3 = a2 + kstep; const char* b3 = b2 + kstep;
            PG8_LDB(B0, 0, 0); PG8_SCHED; PG8_LDA(At, 0, 0); PG8_STAGE(PG8_SA(1, 1), a1 + hstep, voffA);
            PG8_WAIT_L(8); PG8_BAR; PG8_WAIT_L(0); PG8_MMA(0, 0, At, B0); PG8_BAR; PG8_SCHED;
            PG8_LDB(B1, 0, 1); PG8_STAGE(PG8_SB(0, 0), b2, voffB);
            PG8_BAR; PG8_WAIT_L(0); PG8_MMA(0, 1, At, B1); PG8_BAR;
            PG8_LDA(At, 0, 1); PG8_STAGE(PG8_SA(0, 0), a2, voffA);
            PG8_BAR; PG8_WAIT_L(0); PG8_MMA(1, 0, At, B0); PG8_BAR; PG8_SCHED;
            PG8_STAGE(PG8_SB(0, 1), b2 + hstep, voffB);
            PG8_WAIT_V(6); PG8_BAR; PG8_MMA(1, 1, At, B1); PG8_BAR;
            PG8_LDB(B0, 1, 0); PG8_SCHED; PG8_LDA(At, 1, 0); PG8_STAGE(PG8_SA(0, 1), a2 + hstep, voffA);
            PG8_WAIT_L(8); PG8_BAR; PG8_WAIT_L(0); PG8_MMA(0, 0, At, B0); PG8_BAR; PG8_SCHED;
            PG8_LDB(B1, 1, 1); PG8_STAGE(PG8_SB(1, 0), b3, voffB);
            PG8_BAR; PG8_WAIT_L(0); PG8_MMA(0, 1, At, B1); PG8_BAR;
            PG8_LDA(At, 1, 1); PG8_STAGE(PG8_SA(1, 0), a3, voffA);
            PG8_BAR; PG8_WAIT_L(0); PG8_MMA(1, 0, At, B0); PG8_BAR; PG8_SCHED;
            PG8_STAGE(PG8_SB(1, 1), b3 + hstep, voffB);
            PG8_WAIT_V(6); PG8_BAR; PG8_MMA(1, 1, At, B1); PG8_BAR;
        }
        if constexpr (!Epi::AFTER_DRAIN) { const int t2 = fresh_tid(); E(acc, cur, wr, wc, t2 & 15, (t2 >> 4) & 3); }
        if (!has_next) break;
#pragma unroll
        for (int a = 0; a < 2; ++a)
#pragma unroll
            for (int b = 0; b < 2; ++b)
#pragma unroll
                for (int m = 0; m < 4; ++m)
#pragma unroll
                    for (int n = 0; n < 2; ++n) acc[a][b][m][n] = (f32x4){0.f, 0.f, 0.f, 0.f};
        cur = nxt; cA = nA; cB = nB; ++ui;
    }
    PG8_WAIT_V(0);
    if (wr == 0) PG8_BAR;
    PG8_BAR;
    if constexpr (Epi::AFTER_DRAIN) { const int t2 = fresh_tid(); E.fused(acc, cur, wr, wc, t2 & 15, (t2 >> 4) & 3, lds, t2 >> 6, t2 & 63); }
#undef PG8_SA
#undef PG8_SB
#undef PG8_STAGE
#undef PG8_LDA
#undef PG8_LDB
#undef PG8_MMA
#undef PG8_WAIT_V
#undef PG8_WAIT_L
#undef PG8_BAR
#undef PG8_SCHED
}

typedef f32x4 Acc[2][2][4][2];
struct EpiF32 {
    static constexpr bool PERM = false, AFTER_DRAIN = false;
    float* C; int ldc;
    __device__ __forceinline__ void operator()(const Acc& acc, const Unit& u, int wr, int wc, int fr, int fq) const {
        const int row0 = u.pm * BM + wr * 64 + fr, col0 = u.pn * BM + wc * 32 + 4 * fq;
#pragma unroll
        for (int ai = 0; ai < 2; ++ai)
#pragma unroll
            for (int m = 0; m < 4; ++m) { float* rowp = C + (size_t)(row0 + ai * HALF + m * 16) * ldc + col0;
#pragma unroll
                for (int bj = 0; bj < 2; ++bj)
#pragma unroll
                    for (int n = 0; n < 2; ++n) *(f32x4*)(rowp + bj * HALF + n * 16) = acc[ai][bj][m][n]; }
    }
};
struct EpiBf16 {
    static constexpr bool PERM = true, AFTER_DRAIN = false;
    bf16_t* O; int ldc;
    __device__ __forceinline__ void operator()(const Acc& acc, const Unit& u, int wr, int wc, int fr, int fq) const {
        const int row0 = u.pm * BM + wr * 64 + fr, col0 = u.pn * BM + wc * 32 + 8 * fq;
#pragma unroll
        for (int ai = 0; ai < 2; ++ai)
#pragma unroll
            for (int m = 0; m < 4; ++m) { bf16_t* rowp = O + (size_t)(row0 + ai * HALF + m * 16) * ldc + col0;
#pragma unroll
                for (int bj = 0; bj < 2; ++bj) { const f32x4 v0 = acc[ai][bj][m][0], v1 = acc[ai][bj][m][1];
                    u32x4 w; w.x = cvt_pk_bf16(v0[0], v0[1]); w.y = cvt_pk_bf16(v0[2], v0[3]); w.z = cvt_pk_bf16(v1[0], v1[1]); w.w = cvt_pk_bf16(v1[2], v1[3]);
                    *(u32x4*)(rowp + bj * HALF) = w; } }
    }
};
struct EpiSwiGLU {
    static constexpr bool PERM = true, AFTER_DRAIN = false;
    bf16_t* H;
    __device__ __forceinline__ void operator()(const Acc& acc, const Unit& u, int wr, int wc, int fr, int fq) const {
        const int row0 = u.pm * BM + wr * 64 + fr, col0 = u.pn * HALF + wc * 32 + 8 * fq;
#pragma unroll
        for (int ai = 0; ai < 2; ++ai)
#pragma unroll
            for (int m = 0; m < 4; ++m) { bf16_t* rowp = H + (size_t)(row0 + ai * HALF + m * 16) * DFF + col0;
                float h[8];
#pragma unroll
                for (int n = 0; n < 2; ++n)
#pragma unroll
                    for (int j = 0; j < 4; ++j) { const float gt = acc[ai][0][m][n][j], up = acc[ai][1][m][n][j]; h[n * 4 + j] = gt * sigmoidf_fast(gt) * up; }
                u32x4 w; w.x = cvt_pk_bf16(h[0], h[1]); w.y = cvt_pk_bf16(h[2], h[3]); w.z = cvt_pk_bf16(h[4], h[5]); w.w = cvt_pk_bf16(h[6], h[7]);
                *(u32x4*)rowp = w; }
    }
};
struct EpiGate {
    static constexpr bool PERM = true, AFTER_DRAIN = false;
    bf16_t* G;
    __device__ __forceinline__ void operator()(const Acc& acc, const Unit& u, int wr, int wc, int fr, int fq) const {
        const int row0 = u.pm * BM + wr * 64 + fr, col0 = u.pn * BM + wc * 32 + 8 * fq;
#pragma unroll
        for (int ai = 0; ai < 2; ++ai)
#pragma unroll
            for (int m = 0; m < 4; ++m) { bf16_t* rowp = G + (size_t)(row0 + ai * HALF + m * 16) * 2048 + col0;
#pragma unroll
                for (int bj = 0; bj < 2; ++bj) { const f32x4 v0 = acc[ai][bj][m][0], v1 = acc[ai][bj][m][1];
                    u32x4 w; w.x = cvt_pk_bf16(sigmoidf_fast(v0[0]), sigmoidf_fast(v0[1])); w.y = cvt_pk_bf16(sigmoidf_fast(v0[2]), sigmoidf_fast(v0[3]));
                    w.z = cvt_pk_bf16(sigmoidf_fast(v1[0]), sigmoidf_fast(v1[1])); w.w = cvt_pk_bf16(sigmoidf_fast(v1[2]), sigmoidf_fast(v1[3]));
                    *(u32x4*)(rowp + bj * HALF) = w; } }
    }
};
struct EpiQ {
    static constexpr bool PERM = true, AFTER_DRAIN = false;
    bf16_t* Q; const float* TAB;
    __device__ __forceinline__ void operator()(const Acc& acc, const Unit& u, int wr, int wc, int fr, int fq) const {
        const int row0 = u.pm * BM + wr * 64 + fr, col0 = u.pn * BM + wc * 32 + 8 * fq;
#pragma unroll
        for (int ai = 0; ai < 2; ++ai)
#pragma unroll
            for (int m = 0; m < 4; ++m) { const int row = row0 + ai * HALF + m * 16; bf16_t* rowp = Q + (size_t)row * 1536 + col0;
#pragma unroll
                for (int bj = 0; bj < 2; ++bj) { f32x4 v0 = acc[ai][bj][m][0], v1 = acc[ai][bj][m][1];
                    const int c = col0 + bj * HALF, w = c % 192;
                    if (w >= 128) { const int i0 = (w - 128) >> 1; const f32x4 cs = *(const f32x4*)(TAB + (size_t)row * 64 + i0), sn = *(const f32x4*)(TAB + (size_t)row * 64 + 32 + i0);
                        f32x4 r0, r1;
                        r0[0] = v0[0] * cs[0] - v0[1] * sn[0]; r0[1] = v0[1] * cs[0] + v0[0] * sn[0];
                        r0[2] = v0[2] * cs[1] - v0[3] * sn[1]; r0[3] = v0[3] * cs[1] + v0[2] * sn[1];
                        r1[0] = v1[0] * cs[2] - v1[1] * sn[2]; r1[1] = v1[1] * cs[2] + v1[0] * sn[2];
                        r1[2] = v1[2] * cs[3] - v1[3] * sn[3]; r1[3] = v1[3] * cs[3] + v1[2] * sn[3];
                        v0 = r0; v1 = r1; }
                    u32x4 wv; wv.x = cvt_pk_bf16(v0[0], v0[1]); wv.y = cvt_pk_bf16(v0[2], v0[3]); wv.z = cvt_pk_bf16(v1[0], v1[1]); wv.w = cvt_pk_bf16(v1[2], v1[3]);
                    *(u32x4*)(rowp + bj * HALF) = wv; } }
    }
};
struct EpiT1 {
    static constexpr bool PERM = true, AFTER_DRAIN = false;
    const bf16_t* G; bf16_t* F;
    __device__ __forceinline__ void operator()(const Acc& acc, const Unit& u, int wr, int wc, int fr, int fq) const {
        const int row0 = u.pm * BM + wr * 64 + fr, col0 = u.pn * BM + wc * 32 + 8 * fq;
#pragma unroll
        for (int ai = 0; ai < 2; ++ai)
#pragma unroll
            for (int m = 0; m < 4; ++m) { const int row = row0 + ai * HALF + m * 16;
#pragma unroll
                for (int bj = 0; bj < 2; ++bj) { const f32x4 v0 = acc[ai][bj][m][0], v1 = acc[ai][bj][m][1]; const int c = col0 + bj * HALF;
                    const u32x4 gw = *(const u32x4*)(G + (size_t)row * 2048 + c);
                    u32x4 wv;
                    wv.x = cvt_pk_bf16(v0[0] * bf_lo(gw.x), v0[1] * bf_hi(gw.x)); wv.y = cvt_pk_bf16(v0[2] * bf_lo(gw.y), v0[3] * bf_hi(gw.y));
                    wv.z = cvt_pk_bf16(v1[0] * bf_lo(gw.z), v1[1] * bf_hi(gw.z)); wv.w = cvt_pk_bf16(v1[2] * bf_lo(gw.w), v1[3] * bf_hi(gw.w));
                    *(u32x4*)(F + (size_t)row * 1024 + c) = wv; } }
    }
};
struct EpiMX {
    static constexpr bool PERM = true, AFTER_DRAIN = false;
    const bf16_t* G; const bf16_t* F; bf16_t* MX;
    __device__ __forceinline__ void operator()(const Acc& acc, const Unit& u, int wr, int wc, int fr, int fq) const {
        const int row0 = u.pm * BM + wr * 64 + fr, col0 = u.pn * BM + wc * 32 + 8 * fq;
#pragma unroll
        for (int ai = 0; ai < 2; ++ai)
#pragma unroll
            for (int m = 0; m < 4; ++m) { const int row = row0 + ai * HALF + m * 16;
#pragma unroll
                for (int bj = 0; bj < 2; ++bj) { const f32x4 v0 = acc[ai][bj][m][0], v1 = acc[ai][bj][m][1]; const int c = col0 + bj * HALF;
                    const u32x4 gw = *(const u32x4*)(G + (size_t)row * 2048 + 1024 + c);
                    const u32x4 tw = *(const u32x4*)(F + (size_t)row * 1024 + c);
                    u32x4 wv;
                    wv.x = cvt_pk_bf16(bf_lo(tw.x) + v0[0] * bf_lo(gw.x), bf_hi(tw.x) + v0[1] * bf_hi(gw.x)); wv.y = cvt_pk_bf16(bf_lo(tw.y) + v0[2] * bf_lo(gw.y), bf_hi(tw.y) + v0[3] * bf_hi(gw.y));
                    wv.z = cvt_pk_bf16(bf_lo(tw.z) + v1[0] * bf_lo(gw.z), bf_hi(tw.z) + v1[1] * bf_hi(gw.z)); wv.w = cvt_pk_bf16(bf_lo(tw.w) + v1[2] * bf_lo(gw.w), bf_hi(tw.w) + v1[3] * bf_hi(gw.w));
                    *(u32x4*)(MX + (size_t)row * 1024 + c) = wv; } }
    }
};

struct PanelSumSq {
    float* xbuf;
    unsigned* cnt;
    __device__ __forceinline__ void run(const Acc& v, const Unit& u, int wr, int wc, int fr, int fq, LAS unsigned char* lds, int wid, int lane) const {
        LAS float* P = (LAS float*)lds; LAS float* S = (LAS float*)(lds + 4096);
#pragma unroll
        for (int ai = 0; ai < 2; ++ai)
#pragma unroll
            for (int m = 0; m < 4; ++m) { float q = 0.f;
#pragma unroll
                for (int bj = 0; bj < 2; ++bj)
#pragma unroll
                    for (int n = 0; n < 2; ++n) { const f32x4 x = v[ai][bj][m][n]; q += (x[0] * x[0] + x[1] * x[1]) + (x[2] * x[2] + x[3] * x[3]); }
                q += __shfl_xor(q, 16); q += __shfl_xor(q, 32);
                if (fq == 0) P[(ai * HALF + wr * 64 + m * 16 + fr) * 4 + wc] = q; }
        asm volatile("s_waitcnt lgkmcnt(0)" ::: "memory"); __builtin_amdgcn_s_barrier(); asm volatile("" ::: "memory");
        const int row = wid * 32 + (lane & 31);
        if (lane < 32) { const float t = (P[row * 4 + 0] + P[row * 4 + 1]) + (P[row * 4 + 2] + P[row * 4 + 3]);
            __hip_atomic_store(xbuf + ((size_t)(u.pm * BM + row) * 4 + u.pn), t, __ATOMIC_RELAXED, __HIP_MEMORY_SCOPE_AGENT); }
        asm volatile("s_waitcnt vmcnt(0)" ::: "memory");
        if (lane == 0) __hip_atomic_fetch_add(cnt + 64 * u.pm, 1u, __ATOMIC_RELAXED, __HIP_MEMORY_SCOPE_AGENT);
        if (wid == 0) { unsigned sp = 0u;
            while ((unsigned)__builtin_amdgcn_readfirstlane(__hip_atomic_load(cnt + 64 * u.pm, __ATOMIC_RELAXED, __HIP_MEMORY_SCOPE_AGENT)) < 32u) { __builtin_amdgcn_s_sleep(1); if (++sp > (1u << 22)) break; }
            }
        asm volatile("s_waitcnt vmcnt(0) lgkmcnt(0)" ::: "memory"); __builtin_amdgcn_s_barrier(); asm volatile("" ::: "memory");
        if (lane < 32) { const float* slot = xbuf + (size_t)(u.pm * BM + row) * 4; float tot = 0.f;
#pragma unroll
            for (int t = 0; t < 4; ++t) tot += __hip_atomic_load(slot + t, __ATOMIC_RELAXED, __HIP_MEMORY_SCOPE_AGENT);
            S[row] = __builtin_amdgcn_rsqf(tot * (1.f / 1024.f) + EPS); }
        asm volatile("s_waitcnt lgkmcnt(0)" ::: "memory"); __builtin_amdgcn_s_barrier(); asm volatile("" ::: "memory");
    }
};
template <bool FINAL, bool BASEF32> struct EpiResNorm {
    static constexpr bool PERM = true, AFTER_DRAIN = true;
    const float* basef; bf16_t* xb; float* outf; bf16_t* xn; float wt; const float* gpost; const float* gnext; PanelSumSq st1, st2;
    __device__ __forceinline__ void operator()(const Acc&, const Unit&, int, int, int, int) const {}
    __device__ __forceinline__ void fused(Acc& acc, const Unit& u, int wr, int wc, int fr, int fq, LAS unsigned char* lds, int wid, int lane) const {
        const LAS float* S = (const LAS float*)(lds + 4096);
        const int col0 = u.pn * BM + wc * 32 + 8 * fq;
        st1.run(acc, u, wr, wc, fr, fq, lds, wid, lane);
#pragma unroll
        for (int ai = 0; ai < 2; ++ai)
#pragma unroll
            for (int m = 0; m < 4; ++m) { const int r = ai * HALF + wr * 64 + m * 16 + fr; const float sr = S[r] * wt;
                const size_t off = (size_t)(u.pm * BM + r) * 1024 + col0, xoff = (size_t)u.pm * 524288 + 262144 + (size_t)r * 1024 + col0;
#pragma unroll
                for (int bj = 0; bj < 2; ++bj) { f32x4 b0, b1;
                    if (BASEF32) { b0 = *(const f32x4*)(basef + off + bj * HALF); b1 = *(const f32x4*)(basef + off + bj * HALF + 4); }
                    else { const u32x4 w = *(const u32x4*)(xb + xoff + bj * HALF); b0 = (f32x4){bf_lo(w.x), bf_hi(w.x), bf_lo(w.y), bf_hi(w.y)}; b1 = (f32x4){bf_lo(w.z), bf_hi(w.z), bf_lo(w.w), bf_hi(w.w)}; }
                    const f32x4 g0 = *(const f32x4*)(gpost + col0 + bj * HALF), g1 = *(const f32x4*)(gpost + col0 + bj * HALF + 4);
                    acc[ai][bj][m][0] = b0 + acc[ai][bj][m][0] * g0 * sr; acc[ai][bj][m][1] = b1 + acc[ai][bj][m][1] * g1 * sr; }
                asm volatile("" : "+v"(acc[ai][0][m][0]), "+v"(acc[ai][0][m][1]), "+v"(acc[ai][1][m][0]), "+v"(acc[ai][1][m][1]));
                if (m & 1) asm volatile("" ::: "memory"); }
        st2.run(acc, u, wr, wc, fr, fq, lds, wid, lane);
#pragma unroll
        for (int ai = 0; ai < 2; ++ai)
#pragma unroll
            for (int m = 0; m < 4; ++m) { const int r = ai * HALF + wr * 64 + m * 16 + fr; const float sr = S[r];
                const size_t off = (size_t)(u.pm * BM + r) * 1024 + col0, xoff = (size_t)u.pm * 524288 + 262144 + (size_t)r * 1024 + col0;
#pragma unroll
                for (int bj = 0; bj < 2; ++bj) { const f32x4 x0 = acc[ai][bj][m][0], x1 = acc[ai][bj][m][1];
                    const f32x4 g0 = *(const f32x4*)(gnext + col0 + bj * HALF), g1 = *(const f32x4*)(gnext + col0 + bj * HALF + 4); const f32x4 o0 = x0 * g0 * sr, o1 = x1 * g1 * sr;
                    if (FINAL) { *(f32x4*)(outf + off + bj * HALF) = o0; *(f32x4*)(outf + off + bj * HALF + 4) = o1; }
                    else { u32x4 wx; wx.x = cvt_pk_bf16(x0[0], x0[1]); wx.y = cvt_pk_bf16(x0[2], x0[3]); wx.z = cvt_pk_bf16(x1[0], x1[1]); wx.w = cvt_pk_bf16(x1[2], x1[3]); *(u32x4*)(xb + xoff + bj * HALF) = wx;
                           u32x4 w; w.x = cvt_pk_bf16(o0[0], o0[1]); w.y = cvt_pk_bf16(o0[2], o0[3]); w.z = cvt_pk_bf16(o1[0], o1[1]); w.w = cvt_pk_bf16(o1[2], o1[3]); *(u32x4*)(xn + off + bj * HALF) = w; } }
                asm volatile("" ::: "memory"); }
    }
};
}

namespace att {
constexpr int NW = 8, QBLK = 32, KVBLK = 64;
constexpr float SCALE = 0.07216878364870322f;
constexpr float THR = 8.f;
constexpr int LDQ = 1536, LDKV = 2048, LDKR = 64, LDO = 1024;
constexpr int SHM_V = 64 * 128 * 2, SHM_K = 64 * 128 * 2, SHM_R = 64 * 64 * 2;
constexpr int NQL = 4;
constexpr int OFF_V = 0, OFF_K = 2 * SHM_V, OFF_RP = OFF_K + 2 * SHM_K, OFF_WS = OFF_RP + 2 * SHM_R, OFF_QL = OFF_WS + NW * 64 * 4, SHM_ATTN = OFF_QL + NW * NQL * 1024;
static_assert(SHM_ATTN <= LDS_STAGE, "lds");
#define KSWZ(row, colB) ((row) * 256 + ((colB) ^ (((row) & 15) << 4)))
#define RSWZ(row, colB) ((row) * 128 + ((colB) ^ ((((row) >> 1) & 7) << 4)))
#define SBAR() __builtin_amdgcn_sched_barrier(0)
__device__ __forceinline__ int crow(int r, int hi) { return (r & 3) + 8 * (r >> 2) + 4 * hi; }
__device__ __forceinline__ bf16x8 ld8(const bf16_t* p) { return *reinterpret_cast<const bf16x8*>(p); }

__device__ __forceinline__ void partialSM(f32x16& p0, f32x16& p1, float& m_reg, float& mn, float& alpha) {
    constexpr float C = SCALE * 1.4426950408889634f;
    float pmax = p0[0];
#pragma unroll
    for (int r = 1; r < 16; ++r) pmax = fmaxf(pmax, p0[r]);
#pragma unroll
    for (int r = 0; r < 16; ++r) pmax = fmaxf(pmax, p1[r]);
    { auto rr = __builtin_amdgcn_permlane32_swap(__float_as_uint(pmax), __float_as_uint(pmax), false, false);
      pmax = fmaxf(__uint_as_float(rr[0]), __uint_as_float(rr[1])); }
    if (__builtin_expect(__all(pmax - m_reg <= THR / SCALE), 1)) { mn = m_reg; alpha = 1.f; }
    else { mn = fmaxf(m_reg, pmax); alpha = __builtin_amdgcn_exp2f((m_reg - mn) * C); m_reg = mn; }
    float mnC = -mn * C;
#pragma unroll
    for (int r = 0; r < 16; ++r) p0[r] = fmaf(p0[r], C, mnC);
#pragma unroll
    for (int r = 0; r < 16; ++r) p1[r] = fmaf(p1[r], C, mnC);
#pragma unroll
    for (int r = 0; r < 16; ++r) p0[r] = __builtin_amdgcn_exp2f(p0[r]);
}
__device__ __forceinline__ void finishSM(f32x16& p0, f32x16& p1, float alpha, float& l_reg, bf16x8& pa0, bf16x8& pa1, bf16x8& pa2, bf16x8& pa3) {
#pragma unroll
    for (int r = 0; r < 16; ++r) p1[r] = __builtin_amdgcn_exp2f(p1[r]);
    float ps = 0;
#pragma unroll
    for (int r = 0; r < 16; ++r) ps += p0[r];
#pragma unroll
    for (int r = 0; r < 16; ++r) ps += p1[r];
    { auto rr = __builtin_amdgcn_permlane32_swap(__float_as_uint(ps), __float_as_uint(ps), false, false);
      ps = __uint_as_float(rr[0]) + __uint_as_float(rr[1]); }
    l_reg = l_reg * alpha + ps;
#define PK4(P, BASE, OUT) do { unsigned a0 = cvt_pk_bf16(P[BASE + 0], P[BASE + 1]), a1 = cvt_pk_bf16(P[BASE + 2], P[BASE + 3]);   \
    unsigned b0 = cvt_pk_bf16(P[BASE + 4], P[BASE + 5]), b1 = cvt_pk_bf16(P[BASE + 6], P[BASE + 7]);                              \
    auto r0 = __builtin_amdgcn_permlane32_swap(a0, b0, false, false); auto r1 = __builtin_amdgcn_permlane32_swap(a1, b1, false, false); \
    u32x4 w = {r0[0], r1[0], r0[1], r1[1]}; OUT = *reinterpret_cast<bf16x8*>(&w); } while (0)
    PK4(p0, 0, pa0); PK4(p0, 8, pa1); PK4(p1, 0, pa2); PK4(p1, 8, pa3);
#undef PK4
}
__device__ __forceinline__ void qkt(f32x16& p0, f32x16& p1, const char* Ks, const char* Rs, const bf16x8* qr, const char* ql, int r32, int hi) {
    p0 = f32x16{}; p1 = f32x16{};
#pragma unroll
    for (int d0 = 0; d0 < 8; ++d0) { int cb = (d0 * 16 + hi * 8) * 2;
        bf16x8 b0 = *reinterpret_cast<const bf16x8*>(Ks + KSWZ(r32, cb));
        bf16x8 b1 = *reinterpret_cast<const bf16x8*>(Ks + KSWZ(32 + r32, cb));
        p0 = __builtin_amdgcn_mfma_f32_32x32x16_bf16(b0, qr[d0], p0, 0, 0, 0);
        p1 = __builtin_amdgcn_mfma_f32_32x32x16_bf16(b1, qr[d0], p1, 0, 0, 0); }
#pragma unroll
    for (int d0 = 0; d0 < 4; ++d0) { int cb = (d0 * 16 + hi * 8) * 2;
        bf16x8 b0 = *reinterpret_cast<const bf16x8*>(Rs + RSWZ(r32, cb));
        bf16x8 b1 = *reinterpret_cast<const bf16x8*>(Rs + RSWZ(32 + r32, cb));
        const bf16x8 qv = *reinterpret_cast<const bf16x8*>(ql + d0 * 1024);
        p0 = __builtin_amdgcn_mfma_f32_32x32x16_bf16(b0, qv, p0, 0, 0, 0);
        p1 = __builtin_amdgcn_mfma_f32_32x32x16_bf16(b1, qv, p1, 0, 0, 0); }
}
__device__ __forceinline__ int v_st(int k, int c) { const int kk = (k & ~0xC) | ((k & 4) << 1) | ((k & 8) >> 1); return ((kk >> 3) * 4 + (c >> 5)) * 512 + ((kk & 7) * 32 + (c & 31)) * 2; }
__device__ __forceinline__ int v_rd_base(int lane) { return ((lane & 3) << 3) | (((lane >> 2) & 3) << 6) | (((lane >> 4) & 1) << 5) | (((lane >> 5) & 1) << 8); }
constexpr int v_rd_off(int d0, int ks, int half) { return d0 * 512 + ks * 4096 + half * 2048; }
template <int OFF> __device__ __forceinline__ s16x4 tr_read(int vb) {
    s16x4 r; asm volatile("ds_read_b64_tr_b16 %0, %1 offset:%2" : "=&v"(r) : "v"(vb), "i"(OFF) : "memory"); return r;
}
template <int D0> __device__ __forceinline__ void pv_one(f32x16& od, int vb, bf16x8 pa0, bf16x8 pa1, bf16x8 pa2, bf16x8 pa3) {
    const s16x4 l0 = tr_read<v_rd_off(D0, 0, 0)>(vb), h0 = tr_read<v_rd_off(D0, 0, 1)>(vb), l1 = tr_read<v_rd_off(D0, 1, 0)>(vb), h1 = tr_read<v_rd_off(D0, 1, 1)>(vb);
    const s16x4 l2 = tr_read<v_rd_off(D0, 2, 0)>(vb), h2 = tr_read<v_rd_off(D0, 2, 1)>(vb), l3 = tr_read<v_rd_off(D0, 3, 0)>(vb), h3 = tr_read<v_rd_off(D0, 3, 1)>(vb);
    asm volatile("s_waitcnt lgkmcnt(0)" ::: "memory"); SBAR();
#define PK(L, H) (bf16x8){L[0], L[1], L[2], L[3], H[0], H[1], H[2], H[3]}
    od = __builtin_amdgcn_mfma_f32_32x32x16_bf16(pa0, PK(l0, h0), od, 0, 0, 0);
    od = __builtin_amdgcn_mfma_f32_32x32x16_bf16(pa1, PK(l1, h1), od, 0, 0, 0);
    od = __builtin_amdgcn_mfma_f32_32x32x16_bf16(pa2, PK(l2, h2), od, 0, 0, 0);
    od = __builtin_amdgcn_mfma_f32_32x32x16_bf16(pa3, PK(l3, h3), od, 0, 0, 0);
#undef PK
}
__device__ __forceinline__ void pv_d0(f32x16* o, int vb, bf16x8 pa0, bf16x8 pa1, bf16x8 pa2, bf16x8 pa3) {
    pv_one<0>(o[0], vb, pa0, pa1, pa2, pa3); pv_one<1>(o[1], vb, pa0, pa1, pa2, pa3); pv_one<2>(o[2], vb, pa0, pa1, pa2, pa3); pv_one<3>(o[3], vb, pa0, pa1, pa2, pa3);
}

__device__ __forceinline__ void attn_body(const bf16_t* __restrict__ Qb, const bf16_t* __restrict__ Kn, const bf16_t* __restrict__ Kr, const bf16_t* __restrict__ Vh,
                                          bf16_t* __restrict__ Ob, int seq, char* lds) {
    const int tid = fresh_tid(), wid = tid >> 6, lane = tid & 63, r32 = lane & 31, hi = lane >> 5;
    char* V_lds = lds + OFF_V; char* K_lds = lds + OFF_K; char* R_lds = lds + OFF_RP;
    float* ws = (float*)(lds + OFF_WS) + wid * 64; float* li_l = ws; float* al_l = ws + 32;
    float m_reg = -1e30f, l_reg = 0; f32x16 o[4] = {}; bf16x8 qr[8];
    char* ql = lds + OFF_QL + wid * (NQL * 1024) + lane * 16;
    const bf16_t* Qw = Qb + (long)(wid * QBLK + r32) * LDQ + hi * 8;
#pragma unroll
    for (int d0 = 0; d0 < 8; ++d0) qr[d0] = ld8(Qw + d0 * 16);
#pragma unroll
    for (int d0 = 0; d0 < NQL; ++d0) *reinterpret_cast<bf16x8*>(ql + d0 * 1024) = ld8(Qw + (8 + d0) * 16);
    const int sr = tid >> 4, sc = (tid & 15) * 8, vst0 = v_st(sr, sc), vst1 = v_st(32 + sr, sc);
    const int rr_ = tid >> 3, rc_ = (tid & 7) * 8;
    const int vb0 = (int)(uintptr_t)V_lds + v_rd_base(lane);
    bf16x8 vs0, vs1, ks0, ks1, rs0;
#define SLOAD(k0) do { vs0 = ld8(&Vh[(long)((k0) + sr) * LDKV + sc]); vs1 = ld8(&Vh[(long)((k0) + 32 + sr) * LDKV + sc]); \
    ks0 = ld8(&Kn[(long)((k0) + sr) * LDKV + sc]); ks1 = ld8(&Kn[(long)((k0) + 32 + sr) * LDKV + sc]); rs0 = ld8(&Kr[(long)((k0) + rr_) * LDKR + rc_]); } while (0)
#define SWRITE(b) do { *(bf16x8*)(V_lds + (b) * SHM_V + vst0) = vs0; *(bf16x8*)(V_lds + (b) * SHM_V + vst1) = vs1; int kc = sc * 2; \
    *(bf16x8*)(K_lds + (b) * SHM_K + KSWZ(sr, kc)) = ks0; *(bf16x8*)(K_lds + (b) * SHM_K + KSWZ(32 + sr, kc)) = ks1; \
    *(bf16x8*)(R_lds + (b) * SHM_R + RSWZ(rr_, rc_ * 2)) = rs0; } while (0)
#define RESC(a) do { if (__any((a) < 1.f)) { if (hi == 0) al_l[r32] = (a); asm volatile("s_waitcnt lgkmcnt(0)" ::: "memory"); \
    _Pragma("unroll") for (int d = 0; d < 4; ++d) _Pragma("unroll") for (int r = 0; r < 16; ++r) o[d][r] *= al_l[crow(r, hi)]; } } while (0)
    f32x16 pA0, pA1, pB0, pB1; float mnA, mnB, alA, alB; bf16x8 pa0, pa1, pa2, pa3; const int NT = seq / KVBLK;
    SLOAD(0); asm volatile("s_waitcnt vmcnt(0)" ::: "memory"); SWRITE(0); __syncthreads();
    qkt(pA0, pA1, K_lds, R_lds, qr, ql, r32, hi); partialSM(pA0, pA1, m_reg, mnA, alA);
    SLOAD(KVBLK);
    asm volatile("s_waitcnt vmcnt(0)" ::: "memory"); SWRITE(1); __syncthreads();
    for (int j = 1; j + 1 < NT; j += 2) {
        SBAR(); qkt(pB0, pB1, K_lds + SHM_K, R_lds + SHM_R, qr, ql, r32, hi);
        finishSM(pA0, pA1, alA, l_reg, pa0, pa1, pa2, pa3); SBAR();
        SLOAD((j + 1) * KVBLK); SBAR();
        pv_d0(o, vb0, pa0, pa1, pa2, pa3); partialSM(pB0, pB1, m_reg, mnB, alB);
        __syncthreads(); asm volatile("s_waitcnt vmcnt(0)" ::: "memory"); SWRITE(0);
        RESC(alB); __syncthreads();
        SBAR(); qkt(pA0, pA1, K_lds, R_lds, qr, ql, r32, hi);
        finishSM(pB0, pB1, alB, l_reg, pa0, pa1, pa2, pa3); SBAR();
        SLOAD((j + 2) * KVBLK); SBAR();
        pv_d0(o, vb0 + SHM_V, pa0, pa1, pa2, pa3); partialSM(pA0, pA1, m_reg, mnA, alA);
        __syncthreads(); asm volatile("s_waitcnt vmcnt(0)" ::: "memory"); SWRITE(1);
        RESC(alA); __syncthreads();
    }
    SBAR(); qkt(pB0, pB1, K_lds + SHM_K, R_lds + SHM_R, qr, ql, r32, hi);
    finishSM(pA0, pA1, alA, l_reg, pa0, pa1, pa2, pa3); SBAR();
    pv_d0(o, vb0, pa0, pa1, pa2, pa3); partialSM(pB0, pB1, m_reg, mnB, alB);
    __syncthreads(); RESC(alB);
    finishSM(pB0, pB1, alB, l_reg, pa0, pa1, pa2, pa3); SBAR();
    pv_d0(o, vb0 + SHM_V, pa0, pa1, pa2, pa3);
    if (hi == 0) li_l[r32] = l_reg; asm volatile("s_waitcnt lgkmcnt(0)" ::: "memory");
    float rli[16];
#pragma unroll
    for (int r = 0; r < 16; ++r) rli[r] = __builtin_amdgcn_rcpf(li_l[crow(r, hi)]);
    bf16_t* Ow = Ob + (long)(wid * QBLK) * LDO;
#pragma unroll
    for (int r = 0; r < 16; ++r) { int orow = crow(r, hi);
#pragma unroll
        for (int d0 = 0; d0 < 4; ++d0) { const float v = o[d0][r] * rli[r]; Ow[(long)orow * LDO + d0 * 32 + r32] = (bf16_t)(cvt_pk_bf16(v, v) & 0xffffu); } }
#undef SLOAD
#undef SWRITE
#undef RESC
}
}


#define XB_TMO      128
#define XB_XCNT(j)  (256  + 64 * (j))
#define XB_XSUB(j)  (1280 + 64 * (j))
#define XB_XGEN(j)  (2304 + 64 * (j))
#define XB_TOP      3328
#define XB_TOPGEN   3392
#define XCD_BAR_WORDS 3456
#define XB_SPIN_CAP (1u << 18)
__device__ __forceinline__ unsigned xb_ld(unsigned* p)              { return __hip_atomic_load(p, __ATOMIC_RELAXED, __HIP_MEMORY_SCOPE_AGENT); }
__device__ __forceinline__ unsigned xb_add(unsigned* p, unsigned v) { return __hip_atomic_fetch_add(p, v, __ATOMIC_RELAXED, __HIP_MEMORY_SCOPE_AGENT); }
__device__ __forceinline__ unsigned xb_xcc_id() { return (unsigned)__builtin_amdgcn_s_getreg((3 << 11) | 20) & 0xFu; }
#define XB_SPIN(cond, bar) do { unsigned _sp = 0; while (cond) { __builtin_amdgcn_s_sleep(1); \
    if ((++_sp & 255u) == 0u) { if (xb_ld(&(bar)[XB_TMO])) break; if (_sp > XB_SPIN_CAP) { atomicAdd(&(bar)[XB_TMO], 1u); break; } } } } while (0)
struct XcdBarrier { unsigned* bar; unsigned x; volatile LAS unsigned* st; };
__device__ __forceinline__ XcdBarrier xcd_barrier_post(unsigned* bar, volatile LAS unsigned* st) {
    XcdBarrier b; b.bar = bar; b.x = xb_xcc_id(); b.st = st;
    if (threadIdx.x == 0) (void)xb_add(&bar[XB_XCNT(b.x)], 1u);
    return b;
}
__device__ __forceinline__ void xcd_barrier_complete(unsigned* bar, unsigned x, unsigned& nloc, unsigned& nx) {
    const unsigned G = gridDim.x * gridDim.y * gridDim.z;
    unsigned sum, cnt, mine, sp = 0u;
    for (;;) {
        sum = 0u; cnt = 0u; mine = 0u;
#pragma unroll
        for (unsigned j = 0; j < 16; ++j) { const unsigned c = xb_ld(&bar[XB_XCNT(j)]); sum += c; cnt += (c > 0u) ? 1u : 0u; mine = (j == x) ? c : mine; }
        if (sum == G) break;
        __builtin_amdgcn_s_sleep(1);
        if ((++sp & 255u) == 0u) { if (xb_ld(&bar[XB_TMO])) break; if (sp > XB_SPIN_CAP) { atomicAdd(&bar[XB_TMO], 1u); break; } }
    }
    nloc = mine > 0u ? mine : 1u; nx = cnt > 0u ? cnt : 1u;
}
__device__ __forceinline__ void xcd_barrier(const XcdBarrier& b) {
    asm volatile("s_waitcnt vmcnt(0)" ::: "memory");
    __syncthreads();
    if (threadIdx.x == 0) {
        unsigned* bar = b.bar;
        __builtin_amdgcn_s_waitcnt(0);
        unsigned nloc = b.st[0], nx = b.st[1];
        if (nloc == 0u) { xcd_barrier_complete(bar, b.x, nloc, nx); b.st[0] = nloc; b.st[1] = nx; }
        const unsigned old = xb_add(&bar[XB_XSUB(b.x)], 1u);
        const unsigned gen = old / nloc;
        if (old + 1u == (gen + 1u) * nloc) {
            __builtin_amdgcn_fence(__ATOMIC_RELEASE, "agent");
            asm volatile("s_waitcnt vmcnt(0)" ::: "memory");
            const unsigned og = xb_add(&bar[XB_TOP], 1u);
            const unsigned tg = og / nx;
            __builtin_amdgcn_fence(__ATOMIC_ACQUIRE, "agent");
            if (og + 1u == (tg + 1u) * nx) xb_add(&bar[XB_TOPGEN], 1u);
            else XB_SPIN(xb_ld(&bar[XB_TOPGEN]) == tg, bar);
            xb_add(&bar[XB_XGEN(b.x)], 1u);
            asm volatile("s_waitcnt vmcnt(0)" ::: "memory");
        } else {
            __builtin_amdgcn_fence(__ATOMIC_ACQUIRE, "agent");
            XB_SPIN(xb_ld(&bar[XB_XGEN(b.x)]) == gen, bar);
            asm volatile("s_waitcnt vmcnt(0)" ::: "memory");
        }
    }
    __syncthreads();
}

enum { TR_PLAIN = 0, TR_GU = 1, TR_WIN = 2, TR_UQ = 3, TR_UKV = 4 };
template <int MODE>
__device__ __forceinline__ void tr_job(const float* W0, const float* W1, int K, int Nsrc, int Nout, bf16_t* WT, LAS float* scr, int lane, int gw, int NGW) {
    const int nblk = Nout / 32, nitems = (K / 64) * nblk;
    for (int it = gw; it < nitems; it += NGW) {
        const int kb = it / nblk, nb = it % nblk, k0 = 64 * kb, n0 = 32 * nb, np = n0 + (lane & 31);
        const float* colp;
        if (MODE == TR_PLAIN) colp = W0 + np;
        else if (MODE == TR_GU) { const int t = np >> 8, w = np & 255; colp = (w < 128 ? W0 : W1) + t * 128 + (w & 127); }
        else if (MODE == TR_WIN) colp = np < 1216 ? W0 + np : (np < 1280 ? nullptr : W0 + (np - 64));
        else if (MODE == TR_UQ) { const int h = np / 192, w = np % 192; colp = W0 + (w < 128 ? np : h * 192 + 128 + ((w - 128) >> 1) + ((w - 128) & 1) * 32); }
        else colp = np < 1024 ? W0 + np : W1 + (np - 1024);
        float tv[32];
#pragma unroll
        for (int i = 0; i < 32; ++i) { const int kk = 2 * i + (lane >> 5); tv[i] = colp ? colp[(size_t)(k0 + kk) * Nsrc] : 0.f; }
#pragma unroll
        for (int i = 0; i < 32; ++i) { const int kk = 2 * i + (lane >> 5); scr[kk * 33 + (lane & 31)] = tv[i]; }
        asm volatile("s_waitcnt lgkmcnt(0)" ::: "memory");
        const int c = lane & 7;
#pragma unroll
        for (int j = 0; j < 4; ++j) { const int n = (lane >> 3) + 8 * j; const LAS float* s = scr + (8 * c) * 33 + n;
            u32x4 o; o.x = cvt_pk_bf16(s[0 * 33], s[1 * 33]); o.y = cvt_pk_bf16(s[2 * 33], s[3 * 33]); o.z = cvt_pk_bf16(s[4 * 33], s[5 * 33]); o.w = cvt_pk_bf16(s[6 * 33], s[7 * 33]);
            *(u32x4*)(WT + (size_t)(n0 + n) * K + k0 + 8 * c) = o; }
        asm volatile("s_waitcnt lgkmcnt(0)" ::: "memory");
    }
}

__device__ __forceinline__ void norm_rows(const float* xin, const float* gnext, bf16_t* xn, int gw, int NGW, int lane) {
    for (int row0 = gw; row0 < M; row0 += 2 * NGW) {
        f32x4 xv[2][4];
#pragma unroll
        for (int r = 0; r < 2; ++r) { const size_t row = (size_t)(row0 + r * NGW);
#pragma unroll
            for (int j = 0; j < 2; ++j) { xv[r][2 * j] = *(const f32x4*)(xin + row * DM + 8 * (lane + 64 * j)); xv[r][2 * j + 1] = *(const f32x4*)(xin + row * DM + 8 * (lane + 64 * j) + 4); } }
#pragma unroll
        for (int r = 0; r < 2; ++r) { const size_t row = (size_t)(row0 + r * NGW);
            float s2 = 0.f;
#pragma unroll
            for (int j = 0; j < 4; ++j) s2 += xv[r][j].x * xv[r][j].x + xv[r][j].y * xv[r][j].y + xv[r][j].z * xv[r][j].z + xv[r][j].w * xv[r][j].w;
            const float r2 = __builtin_amdgcn_rsqf(wave_sum(s2) * (1.f / DM) + EPS);
#pragma unroll
            for (int j = 0; j < 2; ++j) { const f32x4 g0 = *(const f32x4*)(gnext + 8 * (lane + 64 * j)), g1 = *(const f32x4*)(gnext + 8 * (lane + 64 * j) + 4);
                const f32x4 y0 = xv[r][2 * j] * g0 * r2, y1 = xv[r][2 * j + 1] * g1 * r2;
                u32x4 w; w.x = cvt_pk_bf16(y0.x, y0.y); w.y = cvt_pk_bf16(y0.z, y0.w); w.z = cvt_pk_bf16(y1.x, y1.y); w.w = cvt_pk_bf16(y1.z, y1.w);
                *(u32x4*)(xn + row * DM + 8 * (lane + 64 * j)) = w; }
        }
    }
}

__global__ void __launch_bounds__(NTHREADS, 2) fwd_megakernel(Params p) {
    extern __shared__ __attribute__((aligned(16))) unsigned char lds[];
    cg::grid_group grid = cg::this_grid();
    volatile LAS unsigned* bst = (volatile LAS unsigned*)((LAS unsigned char*)lds + LDS_STAGE);
    if (threadIdx.x < 2) bst[threadIdx.x] = 0u;
    __syncthreads();
    const XcdBarrier xbar = xcd_barrier_post((unsigned*)(p.ws + OFF_BAR), bst);
#define GRID_SYNC_CG() do { __builtin_amdgcn_fence(__ATOMIC_RELEASE, "agent"); asm volatile("s_waitcnt vmcnt(0)" ::: "memory"); grid.sync(); \
        __builtin_amdgcn_fence(__ATOMIC_ACQUIRE, "agent"); asm volatile("s_waitcnt vmcnt(0)" ::: "memory"); } while (0)
#define GRID_SYNC() xcd_barrier(xbar)
    const int G = gridDim.x, bid = blockIdx.x, NGW = G * NWAVES;
    LAS unsigned char* ldsl = (LAS unsigned char*)lds;
#define PHASE_IDS() const int tid = fresh_tid(), lane = tid & 63, wave = tid >> 6, gw = bid * NWAVES + wave; LAS float* scr = (LAS float*)(ldsl + wave * 8448); (void)scr; (void)gw; (void)lane
    unsigned char* ws = p.ws;
    bf16_t* Wgu = (bf16_t*)(ws + OFF_WGU); bf16_t* Wd = (bf16_t*)(ws + OFF_WD); bf16_t* Win = (bf16_t*)(ws + OFF_WIN); bf16_t* Wuq = (bf16_t*)(ws + OFF_WUQ);
    bf16_t* Wukv = (bf16_t*)(ws + OFF_WUKV); bf16_t* Woa = (bf16_t*)(ws + OFF_WOA); bf16_t* Wp = (bf16_t*)(ws + OFF_WP); bf16_t* Wout = (bf16_t*)(ws + OFF_WOUT);
    bf16_t* XN = (bf16_t*)(ws + OFF_XN); bf16_t* F = (bf16_t*)(ws + OFF_F); float* ZF = (float*)(ws + OFF_ZF); bf16_t* KV = (bf16_t*)(ws + OFF_KV);
    bf16_t* H = (bf16_t*)(ws + OFF_H); bf16_t* O = (bf16_t*)(ws + OFF_O); bf16_t* CQN = (bf16_t*)(ws + OFF_CQN); bf16_t* CKVN = (bf16_t*)(ws + OFF_CKVN);
    float* TAB = (float*)(ws + OFF_TAB); bf16_t* Q = (bf16_t*)(ws + OFF_Q); bf16_t* KR = (bf16_t*)(ws + OFF_KR); bf16_t* Gt = (bf16_t*)(ws + OFF_G); bf16_t* DP = (bf16_t*)(ws + OFF_DP);
    float* X = p.out;
    bf16_t* MXb = (bf16_t*)(ws + OFF_F + 32 * MiB);
    float* xbuf0 = (float*)(ws + OFF_XBUF); unsigned* cnt0 = (unsigned*)(ws + OFF_CNT);

    { PHASE_IDS();
    tr_job<TR_GU>(p.f1_wg, p.f1_wu, 1024, DFF, 5632, Wgu, scr, lane, gw, NGW);
    norm_rows(p.x, p.f1_pre, XN, gw, NGW, lane); }
    if (__builtin_expect(p.out == nullptr, 0)) GRID_SYNC_CG();
    GRID_SYNC();

    pg8::StaticOrder S;
    { pg8::Gemm g{XN, Wgu, M, 5632, 1024}; S.init(M, 5632, G, bid); pg8::EpiSwiGLU E{H}; pg8::gemm_phase(ldsl, g, S, E); }
    {
        const int tail0 = (64 * 22) % G;
        if (tail0 != 0 && bid >= tail0) { PHASE_IDS(); const int tb = bid - tail0, nb = G - tail0, tgw = tb * NWAVES + wave, TNGW = nb * NWAVES;
            tr_job<TR_PLAIN>(p.f1_wd, nullptr, DFF, 1024, 1024, Wd, scr, lane, tgw, TNGW);
            tr_job<TR_WIN>(p.w_in, nullptr, 1024, INW, 3328, Win, scr, lane, tgw, TNGW);
            tr_job<TR_UQ>(p.w_uq, nullptr, QL, 1536, 1536, Wuq, scr, lane, tgw, TNGW);
            tr_job<TR_UKV>(p.w_uk, p.w_uv, KVL, 1024, 2048, Wukv, scr, lane, tgw, TNGW);
    }
        else if (tail0 == 0) { PHASE_IDS(); const int tb = bid, nb = G;
            tr_job<TR_PLAIN>(p.f1_wd, nullptr, DFF, 1024, 1024, Wd, scr, lane, gw, NGW);
            tr_job<TR_WIN>(p.w_in, nullptr, 1024, INW, 3328, Win, scr, lane, gw, NGW);
            tr_job<TR_UQ>(p.w_uq, nullptr, QL, 1536, 1536, Wuq, scr, lane, gw, NGW);
            tr_job<TR_UKV>(p.w_uk, p.w_uv, KVL, 1024, 2048, Wukv, scr, lane, gw, NGW);
    }
    }
    GRID_SYNC();
    { pg8::Gemm g{H, Wd, M, 1024, DFF}; S.init(M, 1024, G, bid);
      pg8::EpiResNorm<false, true> E{p.x, (bf16_t*)X, nullptr, XN, 0.5f, p.f1_post, p.mix_pre, pg8::PanelSumSq{xbuf0, cnt0}, pg8::PanelSumSq{xbuf0 + (size_t)M * 4, cnt0 + 4096}}; pg8::gemm_phase(ldsl, g, S, E); }
    GRID_SYNC();
    { pg8::Gemm g{XN, Win, M, 1280, 1024}; S.init(M, 1280, G, bid); pg8::EpiBf16 E{(bf16_t*)ZF, 1280}; pg8::gemm_phase(ldsl, g, S, E); }
    {
        const int tail0 = (64 * 5) % G; PHASE_IDS();
        if (tail0 != 0 && bid >= tail0) { const int tgw = (bid - tail0) * NWAVES + wave, TNGW = (G - tail0) * NWAVES;
            tr_job<TR_GU>(p.f2_wg, p.f2_wu, 1024, DFF, 5632, Wgu, scr, lane, tgw, TNGW);
            tr_job<TR_PLAIN>(p.f2_wd, nullptr, DFF, 1024, 1024, Wd, scr, lane, tgw, TNGW); }
        else if (tail0 == 0) { tr_job<TR_GU>(p.f2_wg, p.f2_wu, 1024, DFF, 5632, Wgu, scr, lane, gw, NGW); tr_job<TR_PLAIN>(p.f2_wd, nullptr, DFF, 1024, 1024, Wd, scr, lane, gw, NGW); }
    }
    GRID_SYNC();
    { PHASE_IDS();
    const bf16_t* ZB = (const bf16_t*)ZF;
    for (int bt = gw; bt < M / 4; bt += NGW) { const int row0 = bt * 4, t0 = row0 & (SEQ - 1);
        const int lane = fresh_tid() & 63;
        const int t_g = lane >> 4, wnd = 2 << t_g, wl = wnd >> 1, wrr = wnd - wl;
        u32x4 nb[19], qa[4], qb[4]; float kx1[4], kx2[4]; int pos[4];
#pragma unroll
        for (int i = 0; i < 19; ++i) { int tt = t0 - 8 + i; tt = tt < 0 ? 0 : (tt > SEQ - 1 ? SEQ - 1 : tt); nb[i] = *(const u32x4*)(ZB + (size_t)(row0 - t0 + tt) * 1280 + 704 + 8 * lane); }
#pragma unroll
        for (int k = 0; k < 4; ++k) { const bf16_t* z = ZB + (size_t)(row0 + k) * 1280;
            qa[k] = *(const u32x4*)(z + 8 * lane); qb[k] = (u32x4){0u, 0u, 0u, 0u}; if (lane < 16) qb[k] = *(const u32x4*)(z + 512 + 8 * lane);
            kx1[k] = 0.f; kx2[k] = 0.f; pos[k] = 0; if (lane < 32) { kx1[k] = bf_lo((unsigned)z[640 + lane]); kx2[k] = bf_lo((unsigned)z[672 + lane]); pos[k] = p.pos[row0 + k]; } }
        __builtin_amdgcn_sched_barrier(0);
#pragma unroll
        for (int k = 0; k < 4; ++k) { const int row = row0 + k, t = t0 + k, lo = max(t - wl, 0), hi = min(t + wrr, SEQ);
            float sacc[8];
#pragma unroll
            for (int i = 0; i < 8; ++i) sacc[i] = 0.f;
#pragma unroll
            for (int d = 0; d < 16; ++d) { const int tt = t - 8 + d; const float wv = (tt >= lo && tt < hi) ? 1.f : 0.f; const u32x4 v = nb[k + d];
                sacc[0] = fmaf(wv, bf_lo(v.x), sacc[0]); sacc[1] = fmaf(wv, bf_hi(v.x), sacc[1]); sacc[2] = fmaf(wv, bf_lo(v.y), sacc[2]); sacc[3] = fmaf(wv, bf_hi(v.y), sacc[3]);
                sacc[4] = fmaf(wv, bf_lo(v.z), sacc[4]); sacc[5] = fmaf(wv, bf_hi(v.z), sacc[5]); sacc[6] = fmaf(wv, bf_lo(v.w), sacc[6]); sacc[7] = fmaf(wv, bf_hi(v.w), sacc[7]); }
            {
                const float inv = 1.f / (float)(hi - lo); const u32x4 pc = nb[k + 8];
                u32x4 w; w.x = cvt_pk_bf16(sacc[0] * inv - bf_lo(pc.x), sacc[1] * inv - bf_hi(pc.x)); w.y = cvt_pk_bf16(sacc[2] * inv - bf_lo(pc.y), sacc[3] * inv - bf_hi(pc.y));
                w.z = cvt_pk_bf16(sacc[4] * inv - bf_lo(pc.z), sacc[5] * inv - bf_hi(pc.z)); w.w = cvt_pk_bf16(sacc[6] * inv - bf_lo(pc.w), sacc[7] * inv - bf_hi(pc.w));
                *(u32x4*)(DP + (size_t)row * 512 + 8 * lane) = w; }
            {
                const u32x4 a4 = qa[k], b4 = qb[k];
                float va[8] = {bf_lo(a4.x), bf_hi(a4.x), bf_lo(a4.y), bf_hi(a4.y), bf_lo(a4.z), bf_hi(a4.z), bf_lo(a4.w), bf_hi(a4.w)};
                float vb[8] = {bf_lo(b4.x), bf_hi(b4.x), bf_lo(b4.y), bf_hi(b4.y), bf_lo(b4.z), bf_hi(b4.z), bf_lo(b4.w), bf_hi(b4.w)};
                float sa = 0.f, sb = 0.f;
#pragma unroll
                for (int i = 0; i < 8; ++i) { sa = fmaf(va[i], va[i], sa); sb = fmaf(vb[i], vb[i], sb); }
                const float ssq = wave_sum(lane < 48 ? sa : 0.f), sskv = wave_sum((lane >= 48 ? sa : 0.f) + sb);
                const float rq = __builtin_amdgcn_rsqf(ssq * (1.f / QL) + EPS), rkv = __builtin_amdgcn_rsqf(sskv * (1.f / KVL) + EPS);
                const float* ga = lane < 48 ? p.qa_g + 8 * lane : p.kva_g + 8 * (lane - 48); const float ra = lane < 48 ? rq : rkv;
                const f32x4 g0 = *(const f32x4*)ga, g1 = *(const f32x4*)(ga + 4);
                u32x4 w; w.x = cvt_pk_bf16(va[0] * g0.x * ra, va[1] * g0.y * ra); w.y = cvt_pk_bf16(va[2] * g0.z * ra, va[3] * g0.w * ra); w.z = cvt_pk_bf16(va[4] * g1.x * ra, va[5] * g1.y * ra); w.w = cvt_pk_bf16(va[6] * g1.z * ra, va[7] * g1.w * ra);
                bf16_t* dst = lane < 48 ? CQN + (size_t)row * QL + 8 * lane : CKVN + (size_t)row * KVL + 8 * (lane - 48);
                *(u32x4*)dst = w;
                if (lane < 16) { const f32x4 h0 = *(const f32x4*)(p.kva_g + 128 + 8 * lane), h1 = *(const f32x4*)(p.kva_g + 132 + 8 * lane);
                    u32x4 w2; w2.x = cvt_pk_bf16(vb[0] * h0.x * rkv, vb[1] * h0.y * rkv); w2.y = cvt_pk_bf16(vb[2] * h0.z * rkv, vb[3] * h0.w * rkv); w2.z = cvt_pk_bf16(vb[4] * h1.x * rkv, vb[5] * h1.y * rkv); w2.w = cvt_pk_bf16(vb[6] * h1.z * rkv, vb[7] * h1.w * rkv);
                    *(u32x4*)(CKVN + (size_t)row * KVL + 128 + 8 * lane) = w2; }
            }
            if (lane < 32) {
                const float ang = (float)pos[k] * p.inv_freq[lane];
                const double ad = (double)ang; const double kq = rint(ad * 0.15915494309189535); const float red = (float)(ad - kq * 6.283185307179586);
                const float cs = __cosf(red), sn = __sinf(red);
                TAB[(size_t)row * 64 + lane] = cs; TAB[(size_t)row * 64 + 32 + lane] = sn;
                *(unsigned*)(KR + (size_t)row * 64 + 2 * lane) = cvt_pk_bf16(kx1[k] * cs - kx2[k] * sn, kx2[k] * cs + kx1[k] * sn);
            }
            __builtin_amdgcn_sched_barrier(0);
        }
    } }
    GRID_SYNC();
    { pg8::Gemm g{CQN, Wuq, M, 1536, QL}; S.init(M, 1536, G, bid); pg8::EpiQ E{Q, TAB}; pg8::gemm_phase(ldsl, g, S, E); }
    {
        const int tail0 = (64 * 6) % G;
        if (tail0 != 0 && bid >= tail0) { PHASE_IDS(); const int tb = bid - tail0, nb = G - tail0, tgw = tb * NWAVES + wave, TNGW = nb * NWAVES;
            tr_job<TR_PLAIN>(p.w_oa, nullptr, 1024, 1024, 1024, Woa, scr, lane, tgw, TNGW);
            tr_job<TR_PLAIN>(p.w_out, nullptr, 1024, 1024, 1024, Wout, scr, lane, tgw, TNGW);
    for (int idx = tb * NTHREADS + tid; idx < 65536; idx += nb * NTHREADS) {
            const int n = idx & 1023, c8 = idx >> 10, g = c8 >> 4, cb = (c8 & 15) * 8;
            float a[8];
    #pragma unroll
            for (int i = 0; i < 8; ++i) a[i] = 0.f;
            for (int j0 = 0; j0 < 128; j0 += 8) { float w[8]; f32x4 pw[8][2];
    #pragma unroll
                for (int jj = 0; jj < 8; ++jj) w[jj] = p.w_op[(size_t)(g * 128 + j0 + jj) * 1024 + n] * p.pool_scale[g * 128 + j0 + jj];
    #pragma unroll
                for (int i = 0; i < 8; ++i) { pw[i][0] = *(const f32x4*)(p.pool_w + (size_t)(g * 128 + cb + i) * 128 + j0); pw[i][1] = *(const f32x4*)(p.pool_w + (size_t)(g * 128 + cb + i) * 128 + j0 + 4); }
    #pragma unroll
                for (int i = 0; i < 8; ++i)
    #pragma unroll
                    for (int jj = 0; jj < 8; ++jj) a[i] = fmaf(pw[i][jj >> 2][jj & 3], w[jj], a[i]); }
            u32x4 o; o.x = cvt_pk_bf16(a[0], a[1]); o.y = cvt_pk_bf16(a[2], a[3]); o.z = cvt_pk_bf16(a[4], a[5]); o.w = cvt_pk_bf16(a[6], a[7]);
            *(u32x4*)(Wp + (size_t)n * 512 + c8 * 8) = o;
        }
        }
        else if (tail0 == 0) { PHASE_IDS(); const int tb = bid, nb = G;
            tr_job<TR_PLAIN>(p.w_oa, nullptr, 1024, 1024, 1024, Woa, scr, lane, gw, NGW);
            tr_job<TR_PLAIN>(p.w_out, nullptr, 1024, 1024, 1024, Wout, scr, lane, gw, NGW);
    for (int idx = tb * NTHREADS + tid; idx < 65536; idx += nb * NTHREADS) {
            const int n = idx & 1023, c8 = idx >> 10, g = c8 >> 4, cb = (c8 & 15) * 8;
            float a[8];
    #pragma unroll
            for (int i = 0; i < 8; ++i) a[i] = 0.f;
            for (int j0 = 0; j0 < 128; j0 += 8) { float w[8]; f32x4 pw[8][2];
    #pragma unroll
                for (int jj = 0; jj < 8; ++jj) w[jj] = p.w_op[(size_t)(g * 128 + j0 + jj) * 1024 + n] * p.pool_scale[g * 128 + j0 + jj];
    #pragma unroll
                for (int i = 0; i < 8; ++i) { pw[i][0] = *(const f32x4*)(p.pool_w + (size_t)(g * 128 + cb + i) * 128 + j0); pw[i][1] = *(const f32x4*)(p.pool_w + (size_t)(g * 128 + cb + i) * 128 + j0 + 4); }
    #pragma unroll
                for (int i = 0; i < 8; ++i)
    #pragma unroll
                    for (int jj = 0; jj < 8; ++jj) a[i] = fmaf(pw[i][jj >> 2][jj & 3], w[jj], a[i]); }
            u32x4 o; o.x = cvt_pk_bf16(a[0], a[1]); o.y = cvt_pk_bf16(a[2], a[3]); o.z = cvt_pk_bf16(a[4], a[5]); o.w = cvt_pk_bf16(a[6], a[7]);
            *(u32x4*)(Wp + (size_t)n * 512 + c8 * 8) = o;
        }
        }
    }
    __syncthreads();
    { pg8::Gemm g{CKVN, Wukv, M, 2048, KVL}; S.init(M, 2048, G, bid); pg8::EpiBf16 E{KV, 2048}; pg8::gemm_phase(ldsl, g, S, E); }
    GRID_SYNC();
    {
        const int vcu = (bid & 7) * (G >> 3) + (bid >> 3);
        for (int it = vcu; it < NB * NH * (SEQ / 256); it += G) {
            const int qb = it & 7, h = (it >> 3) & 7, b = it >> 6;
            const size_t tok0 = (size_t)b * SEQ;
            att::attn_body(Q + (tok0 + qb * 256) * 1536 + h * 192, KV + tok0 * 2048 + h * 128, KR + tok0 * 64, KV + tok0 * 2048 + 1024 + h * 128,
                           O + (tok0 + qb * 256) * 1024 + h * 128, SEQ, (char*)lds);
            __syncthreads();
        }
    }
    GRID_SYNC();
    { pg8::Gemm g{XN, Win + (size_t)1280 * 1024, M, 2048, 1024}; pg8::GateOrder GO; GO.s.init(M, 1024, G, bid); pg8::EpiGate E{Gt}; pg8::gemm_phase(ldsl, g, GO, E); }
    { pg8::Gemm g{O, Woa, M, 1024, 1024}; S.init(M, 1024, G, bid); pg8::EpiT1 E{Gt, F}; pg8::gemm_phase(ldsl, g, S, E); }
    { pg8::Gemm g{DP, Wp, M, 1024, 512}; S.init(M, 1024, G, bid); pg8::EpiMX E{Gt, F, MXb}; pg8::gemm_phase(ldsl, g, S, E); }
    GRID_SYNC();
    { pg8::Gemm g{MXb, Wout, M, 1024, 1024}; S.init(M, 1024, G, bid);
      pg8::EpiResNorm<false, false> E{nullptr, (bf16_t*)X, nullptr, XN, 1.0f, p.mix_post, p.f2_pre, pg8::PanelSumSq{xbuf0 + (size_t)M * 8, cnt0 + 2 * 4096}, pg8::PanelSumSq{xbuf0 + (size_t)M * 12, cnt0 + 3 * 4096}}; pg8::gemm_phase(ldsl, g, S, E); }
    GRID_SYNC();
    { pg8::Gemm g{XN, Wgu, M, 5632, 1024}; S.init(M, 5632, G, bid); pg8::EpiSwiGLU E{H}; pg8::gemm_phase(ldsl, g, S, E); }
    GRID_SYNC();
    { pg8::Gemm g{H, Wd, M, 1024, DFF}; S.init(M, 1024, G, bid);
      pg8::EpiResNorm<true, false> E{nullptr, (bf16_t*)X, X, nullptr, 0.5f, p.f2_post, p.final_g, pg8::PanelSumSq{xbuf0 + (size_t)M * 16, cnt0 + 4 * 4096}, pg8::PanelSumSq{xbuf0 + (size_t)M * 20, cnt0 + 5 * 4096}}; pg8::gemm_phase(ldsl, g, S, E); }
}

extern "C" void kernel_launch(void* const* d_in, const int* in_sizes, int n_in, void* d_out, int out_size, void* d_ws, size_t ws_size, hipStream_t stream) {
    static int grid_blocks = 0;
    if (grid_blocks == 0) {
        if (n_in != 26 || in_sizes[0] != M * DM || out_size != M * DM || ws_size < WS_END) { fprintf(stderr, "kernel_launch: shape mismatch n_in %d in0 %d out %d ws %zu\n", n_in, n_in > 0 ? in_sizes[0] : -1, out_size, ws_size); grid_blocks = -1; return; }
        int dev = 0, cus = 0, per_cu = 0;
        (void)hipGetDevice(&dev);
        (void)hipDeviceGetAttribute(&cus, hipDeviceAttributeMultiprocessorCount, dev);
        if (hipFuncSetAttribute((const void*)fwd_megakernel, hipFuncAttributeMaxDynamicSharedMemorySize, LDS_BYTES) != hipSuccess) { fprintf(stderr, "kernel_launch: hipFuncSetAttribute failed\n"); grid_blocks = -1; return; }
        if (hipOccupancyMaxActiveBlocksPerMultiprocessor(&per_cu, (const void*)fwd_megakernel, NTHREADS, LDS_BYTES) != hipSuccess || per_cu < 1) { fprintf(stderr, "kernel_launch: occupancy query failed (%d)\n", per_cu); (void)hipGetLastError(); per_cu = 1; }
        grid_blocks = cus * 1;
        if (grid_blocks != 256) { fprintf(stderr, "kernel_launch: built for 256 CUs (one workgroup each), device has %d\n", cus); grid_blocks = -1; return; }
    }
    if (grid_blocks < 0) return;
    Params p{};
    p.x = (const float*)d_in[0]; p.pos = (const int*)d_in[1];
    p.f1_pre = (const float*)d_in[2]; p.f1_wg = (const float*)d_in[3]; p.f1_wu = (const float*)d_in[4]; p.f1_wd = (const float*)d_in[5]; p.f1_post = (const float*)d_in[6];
    p.mix_pre = (const float*)d_in[7]; p.w_in = (const float*)d_in[8]; p.qa_g = (const float*)d_in[9]; p.w_uq = (const float*)d_in[10]; p.kva_g = (const float*)d_in[11];
    p.w_uk = (const float*)d_in[12]; p.w_uv = (const float*)d_in[13]; p.w_oa = (const float*)d_in[14]; p.pool_w = (const float*)d_in[15]; p.pool_scale = (const float*)d_in[16];
    p.w_op = (const float*)d_in[17]; p.w_out = (const float*)d_in[18]; p.mix_post = (const float*)d_in[19];
    p.f2_pre = (const float*)d_in[20]; p.f2_wg = (const float*)d_in[21]; p.f2_wu = (const float*)d_in[22]; p.f2_wd = (const float*)d_in[23]; p.f2_post = (const float*)d_in[24]; p.final_g = (const float*)d_in[25];
    p.out = (float*)d_out; p.ws = (unsigned char*)d_ws;
    for (int i = 0; i < 32; ++i) p.inv_freq[i] = (float)pow(10000.0, -(2.0 * i) / 64.0);
    if (hipMemsetAsync((char*)d_ws + OFF_BAR, 0, CTL_BYTES, stream) != hipSuccess) { fprintf(stderr, "kernel_launch: memset failed\n"); return; }
    void* args[] = {&p};
    hipError_t e = hipLaunchCooperativeKernel((const void*)fwd_megakernel, dim3(grid_blocks), dim3(NTHREADS), args, LDS_BYTES, stream);
    if (e != hipSuccess) fprintf(stderr, "cooperative launch failed: %s (grid %d)\n", hipGetErrorString(e), grid_blocks);
}
```

```cpp
#include <hip/hip_runtime.h>
#include <hip/hip_cooperative_groups.h>
#include <cstdio>
#include <cmath>
#include <cstdint>
namespace cg = cooperative_groups;

#define LAS __attribute__((address_space(3)))
typedef unsigned short bf16_t;
typedef short bf16x8 __attribute__((ext_vector_type(8)));
typedef short s16x4 __attribute__((ext_vector_type(4)));
typedef float f32x2 __attribute__((ext_vector_type(2)));
typedef float f32x4 __attribute__((ext_vector_type(4)));
typedef float f32x16 __attribute__((ext_vector_type(16)));
typedef unsigned u32x4 __attribute__((ext_vector_type(4)));
typedef unsigned u32x2 __attribute__((ext_vector_type(2)));

constexpr int DM = 1024, NB = 8, SEQ = 2048, M = NB * SEQ, NH = 8, QL = 384, KVL = 256, DFF = 2816, INW = 3264;
constexpr float EPS = 1e-6f;
constexpr int NTHREADS = 512, NWAVES = 8;
constexpr int LDS_STAGE = 131072, LDS_BYTES = LDS_STAGE + 16;

constexpr size_t MiB = 1048576;
constexpr size_t OFF_WGU = 0;
constexpr size_t OFF_WD = OFF_WGU + (size_t)5632 * 1024 * 2;
constexpr size_t OFF_WIN = OFF_WD + (size_t)1024 * 2816 * 2;
constexpr size_t OFF_WUQ = OFF_WIN + (size_t)3328 * 1024 * 2;
constexpr size_t OFF_WUKV = OFF_WUQ + (size_t)1536 * 384 * 2;
constexpr size_t OFF_WOA = OFF_WUKV + (size_t)2048 * 256 * 2;
constexpr size_t OFF_WP = OFF_WOA + (size_t)1024 * 1024 * 2;
constexpr size_t OFF_WOUT = OFF_WP + (size_t)1024 * 512 * 2;
constexpr size_t OFF_XN = OFF_WOUT + (size_t)1024 * 1024 * 2;
constexpr size_t OFF_R = OFF_XN + 32 * MiB;
constexpr size_t OFF_F = OFF_R;
constexpr size_t OFF_ZF = OFF_R;
constexpr size_t OFF_KV = OFF_R;
constexpr size_t OFF_H = OFF_R + 64 * MiB;
constexpr size_t OFF_O = OFF_R + 64 * MiB;
constexpr size_t OFF_CQN = OFF_R + 80 * MiB;
constexpr size_t OFF_CKVN = OFF_R + 92 * MiB;
constexpr size_t OFF_TAB = OFF_R + 100 * MiB;
constexpr size_t OFF_Q = OFF_R + 104 * MiB;
constexpr size_t OFF_KR = OFF_R + 152 * MiB;
constexpr size_t OFF_G = OFF_R + 96 * MiB;
constexpr size_t OFF_DP = OFF_R + 176 * MiB;
constexpr size_t WS_END = OFF_R + 192 * MiB;
constexpr size_t OFF_BAR = WS_END, OFF_CNT = OFF_BAR + 16384, CTL_BYTES = 16384 + 6 * 16384, OFF_XBUF = OFF_BAR + CTL_BYTES;
static_assert(OFF_XBUF + 6 * (size_t)M * 16 <= 256 * MiB, "workspace");

struct Params {
    const float* x; const int* pos;
    const float *f1_pre, *f1_wg, *f1_wu, *f1_wd, *f1_post;
    const float *mix_pre, *w_in, *qa_g, *w_uq, *kva_g, *w_uk, *w_uv, *w_oa, *pool_w, *pool_scale, *w_op, *w_out, *mix_post;
    const float *f2_pre, *f2_wg, *f2_wu, *f2_wd, *f2_post, *final_g;
    float* out; unsigned char* ws;
    float inv_freq[32];
};

typedef __bf16 bf16x2_t __attribute__((ext_vector_type(2)));
__device__ __forceinline__ unsigned cvt_pk_bf16(float lo, float hi) { const f32x2 v = {lo, hi}; const bf16x2_t r = __builtin_convertvector(v, bf16x2_t); return __builtin_bit_cast(unsigned, r); }
__device__ __forceinline__ float bf_lo(unsigned w) { return __uint_as_float(w << 16); }
__device__ __forceinline__ float bf_hi(unsigned w) { return __uint_as_float(w & 0xffff0000u); }
__device__ __forceinline__ float sigmoidf_fast(float z) { return __builtin_amdgcn_rcpf(1.f + __builtin_amdgcn_exp2f(-1.4426950408889634f * z)); }
__device__ __forceinline__ int fresh_tid() { int t = threadIdx.x; asm volatile("" : "+v"(t)); return t; }
__device__ __forceinline__ float wave_sum(float v) {
#pragma unroll
    for (int o = 1; o < 64; o <<= 1) v += __shfl_xor(v, o);
    return v;
}

namespace pg8 {
constexpr int BM = 256, BK = 64, HALF = 128, HTB = HALF * BK * 2, STAGE_BYTES = 8 * HTB, NXCD = 8, WGM = 4;
__host__ __device__ __forceinline__ int lds_byte(int r, int c) { const int st = (r >> 4) * 2 + (c >> 5), rr = r & 15, cc = c & 31, ob = rr * 64 + cc * 2; return st * 1024 + (ob ^ (((ob >> 9) & 1) << 5)); }
__host__ __device__ __forceinline__ void stage_rc(int b, int& R, int& C) { const int st = b / 1024, sb = b % 1024, swz = sb ^ (((sb >> 9) & 1) << 5); R = (st >> 1) * 16 + swz / 64; C = (st & 1) * 32 + (swz % 64) / 2; }
__host__ __device__ __forceinline__ int perm32(int rho) { const int n = rho >> 4, i = rho & 15; return 8 * (i >> 2) + 4 * n + (i & 3); }
struct Unit { int pm, pn; };
struct Gemm { const bf16_t* A; const bf16_t* Bt; int M, N, K; };
struct StaticOrder {
    int nM, nN, nwg, G, c;
    __device__ void init(int M_, int N_, int G_, int c_) { nM = M_ / BM; nN = N_ / BM; nwg = nM * nN; G = G_; c = c_; }
    __device__ bool next(int i, Unit& u) const {
        const long L = (long)i * G + c; if (L >= nwg) return false;
        int wgid = (int)L; { const int q = nwg / NXCD, r = nwg % NXCD, xcd = wgid % NXCD, off = wgid / NXCD; wgid = (xcd < r ? xcd * (q + 1) : r * (q + 1) + (xcd - r) * q) + off; }
        const int nig = WGM * nN, gid = wgid / nig, fm = gid * WGM, gsz = (nM - fm) < WGM ? (nM - fm) : WGM;
        u.pm = fm + ((wgid % nig) % gsz); u.pn = (wgid % nig) / gsz; return true;
    }
};

struct GateOrder { StaticOrder s;
    __device__ bool next(int i, Unit& u) const { if (i >= 2) return false; Unit b; if (!s.next(0, b)) return false; u.pm = b.pm; u.pn = b.pn + 4 * i; return true; } };
template <class Epi, class Sched>
__device__ __forceinline__ void gemm_phase(LAS unsigned char* lds, const Gemm g, const Sched& S, const Epi& E) {
    const int tid = fresh_tid(), wid = __builtin_amdgcn_readfirstlane(tid >> 6), lane = tid & 63, wr = wid >> 2, wc = wid & 3, fr = lane & 15, fq = lane >> 4;
    const int K = g.K, nt = K / BK;
    unsigned voffA, voffB;
    { int R, C; stage_rc(tid * 16, R, C); const int Rb = Epi::PERM ? ((R & ~31) + perm32(R & 31)) : R;
      voffA = (unsigned)(R * K + C) * 2u; voffB = (unsigned)(Rb * K + C) * 2u; }
    const size_t rstep64 = (size_t)64 * K * 2;
    const size_t kstep = (size_t)(BK * 2);
    const size_t hstep = (size_t)HALF * K * 2;
    const size_t tstep = 2 * hstep;
    const unsigned ldsw = (unsigned)wid * 1024u;
    const int aoff = lds_byte(wr * 64 + fr, fq * 8), boff = lds_byte(wc * 32 + fr, fq * 8);
#define PG8_SA(b, h) (((b) * 2 + (h)) * HTB)
#define PG8_SB(b, h) ((4 + (b) * 2 + (h)) * HTB)
#define PG8_STAGE(bufoff, gbase, voff) do { _Pragma("unroll") for (int _i = 0; _i < 2; ++_i) \
        __builtin_amdgcn_global_load_lds((const unsigned*)((const char*)(gbase) + _i * rstep64 + (voff)), (LAS unsigned*)(lds + (bufoff) + ldsw + _i * 8192), 16, 0, 0); } while (0)
#define PG8_LDA(dst, b, h) do { _Pragma("unroll") for (int m = 0; m < 4; ++m) _Pragma("unroll") for (int k = 0; k < 2; ++k) dst[m][k] = *(const LAS bf16x8*)(lds + PG8_SA(b, h) + aoff + m * 2048 + k * 1024); } while (0)
#define PG8_LDB(dst, b, h) do { _Pragma("unroll") for (int n = 0; n < 2; ++n) _Pragma("unroll") for (int k = 0; k < 2; ++k) dst[n][k] = *(const LAS bf16x8*)(lds + PG8_SB(b, h) + boff + n * 2048 + k * 1024); } while (0)
#define PG8_MMA(ai, bj, At, Bt) do { __builtin_amdgcn_s_setprio(1); _Pragma("unroll") for (int m = 0; m < 4; ++m) _Pragma("unroll") for (int n = 0; n < 2; ++n) _Pragma("unroll") for (int k = 0; k < 2; ++k) \
        acc[ai][bj][m][n] = __builtin_amdgcn_mfma_f32_16x16x32_bf16(Bt[n][k], At[m][k], acc[ai][bj][m][n], 0, 0, 0); __builtin_amdgcn_s_setprio(0); } while (0)
#define PG8_WAIT_V(n) asm volatile("s_waitcnt vmcnt(" #n ")" ::: "memory")
#define PG8_WAIT_L(n) asm volatile("s_waitcnt lgkmcnt(" #n ")" ::: "memory")
#define PG8_BAR __builtin_amdgcn_s_barrier()
#define PG8_SCHED __builtin_amdgcn_sched_barrier(0)
    Unit cur, nxt; int ui = 0;
    if (!S.next(0, cur)) return;
    f32x4 acc[2][2][4][2];
#pragma unroll
    for (int a = 0; a < 2; ++a)
#pragma unroll
        for (int b = 0; b < 2; ++b)
#pragma unroll
            for (int m = 0; m < 4; ++m)
#pragma unroll
                for (int n = 0; n < 2; ++n) acc[a][b][m][n] = (f32x4){0.f, 0.f, 0.f, 0.f};
    bf16x8 At[4][2], B0[2][2], B1[2][2];
    const char* cA = (const char*)g.A + (size_t)cur.pm * tstep; const char* cB = (const char*)g.Bt + (size_t)cur.pn * tstep;
    PG8_STAGE(PG8_SB(0, 0), cB, voffB); PG8_STAGE(PG8_SA(0, 0), cA, voffA); PG8_STAGE(PG8_SB(0, 1), cB + hstep, voffB); PG8_STAGE(PG8_SA(0, 1), cA + hstep, voffA);
    if (wr == 1) PG8_BAR;
    PG8_WAIT_V(4); PG8_BAR;
    PG8_STAGE(PG8_SB(1, 0), cB + kstep, voffB); PG8_STAGE(PG8_SA(1, 0), cA + kstep, voffA); PG8_STAGE(PG8_SB(1, 1), cB + hstep + kstep, voffB);
    PG8_WAIT_V(6); PG8_BAR;
    for (;;) {
        const bool has_next = S.next(ui + 1, nxt);
        const char* nA = has_next ? (const char*)g.A + (size_t)nxt.pm * tstep : cA; const char* nB = has_next ? (const char*)g.Bt + (size_t)nxt.pn * tstep : cB;
        for (int t = 0; t < nt; t += 2) {
            const bool last = (t == nt - 2);
            const char* a1 = cA + (size_t)(t + 1) * kstep;
            const char* a2 = last ? nA : cA + (size_t)(t + 2) * kstep; const char* b2 = last ? nB : cB + (size_t)(t + 2) * kstep;
            const char* a3 = a2 + kstep; const char* b3 = b2 + kstep;
            PG8_LDB(B0, 0, 0); PG8_SCHED; PG8_LDA(At, 0, 0); PG8_STAGE(PG8_SA(1, 1), a1 + hstep, voffA);
            PG8_WAIT_L(8); PG8_BAR; PG8_WAIT_L(0); PG8_MMA(0, 0, At, B0); PG8_BAR; PG8_SCHED;
            PG8_LDB(B1, 0, 1); PG8_STAGE(PG8_SB(0, 0), b2, voffB);
            PG8_BAR; PG8_WAIT_L(0); PG8_MMA(0, 1, At, B1); PG8_BAR;
            PG8_LDA(At, 0, 1); PG8_STAGE(PG8_SA(0, 0), a2, voffA);
            PG8_BAR; PG8_WAIT_L(0); PG8_MMA(1, 0, At, B0); PG8_BAR; PG8_SCHED;
            PG8_STAGE(PG8_SB(0, 1), b2 + hstep, voffB);
            PG8_WAIT_V(6); PG8_BAR; PG8_MMA(1, 1, At, B1); PG8_BAR;
            PG8_LDB(B0, 1, 0); PG8_SCHED; PG8_LDA(At, 1, 0); PG8_STAGE(PG8_SA(0, 1), a2 + hstep, voffA);
            PG8_WAIT_L(8); PG8_BAR; PG8_WAIT_L(0); PG8_MMA(0, 0, At, B0); PG8_BAR; PG8_SCHED;
            PG8_LDB(B1, 1, 1); PG8_STAGE(PG8_SB(1, 0), b3, voffB);
            PG8_BAR; PG8_WAIT_L(0); PG8_MMA(0, 1, At, B1); PG8_BAR;
            PG8_LDA(At, 1, 1); PG8_STAGE(PG8_SA(1, 0), a3, voffA);
            PG8_BAR; PG8_WAIT_L(0); PG8_MMA(1, 0, At, B0); PG8_BAR; PG8_SCHED;
            PG8_STAGE(PG8_SB(1, 1), b3 + hstep, voffB);
            PG8_WAIT_V(6); PG8_BAR; PG8_MMA(1, 1, At, B1); PG8_BAR;
        }
        if constexpr (!Epi::AFTER_DRAIN) { const int t2 = fresh_tid(); E(acc, cur, wr, wc, t2 & 15, (t2 >> 4) & 3); }
        if (!has_next) break;
#pragma unroll
        for (int a = 0; a < 2; ++a)
#pragma unroll
            for (int b = 0; b < 2; ++b)
#pragma unroll
                for (int m = 0; m < 4; ++m)
#pragma unroll
                    for (int n = 0; n < 2; ++n) acc[a][b][m][n] = (f32x4){0.f, 0.f, 0.f, 0.f};
        cur = nxt; cA = nA; cB = nB; ++ui;
    }
    PG8_WAIT_V(0);
    if (wr == 0) PG8_BAR;
    PG8_BAR;
    if constexpr (Epi::AFTER_DRAIN) { const int t2 = fresh_tid(); E.fused(acc, cur, wr, wc, t2 & 15, (t2 >> 4) & 3, lds, t2 >> 6, t2 & 63); }
#undef PG8_SA
#undef PG8_SB
#undef PG8_STAGE
#undef PG8_LDA
#undef PG8_LDB
#undef PG8_MMA
#undef PG8_WAIT_V
#undef PG8_WAIT_L
#undef PG8_BAR
#undef PG8_SCHED
}

typedef f32x4 Acc[2][2][4][2];
struct EpiF32 {
    static constexpr bool PERM = false, AFTER_DRAIN = false;
    float* C; int ldc;
    __device__ __forceinline__ void operator()(const Acc& acc, const Unit& u, int wr, int wc, int fr, int fq) const {
        const int row0 = u.pm * BM + wr * 64 + fr, col0 = u.pn * BM + wc * 32 + 4 * fq;
#pragma unroll
        for (int ai = 0; ai < 2; ++ai)
#pragma unroll
            for (int m = 0; m < 4; ++m) { float* rowp = C + (size_t)(row0 + ai * HALF + m * 16) * ldc + col0;
#pragma unroll
                for (int bj = 0; bj < 2; ++bj)
#pragma unroll
                    for (int n = 0; n < 2; ++n) *(f32x4*)(rowp + bj * HALF + n * 16) = acc[ai][bj][m][n]; }
    }
};
struct EpiBf16 {
    static constexpr bool PERM = true, AFTER_DRAIN = false;
    bf16_t* O; int ldc;
    __device__ __forceinline__ void operator()(const Acc& acc, const Unit& u, int wr, int wc, int fr, int fq) const {
        const int row0 = u.pm * BM + wr * 64 + fr, col0 = u.pn * BM + wc * 32 + 8 * fq;
#pragma unroll
        for (int ai = 0; ai < 2; ++ai)
#pragma unroll
            for (int m = 0; m < 4; ++m) { bf16_t* rowp = O + (size_t)(row0 + ai * HALF + m * 16) * ldc + col0;
#pragma unroll
                for (int bj = 0; bj < 2; ++bj) { const f32x4 v0 = acc[ai][bj][m][0], v1 = acc[ai][bj][m][1];
                    u32x4 w; w.x = cvt_pk_bf16(v0[0], v0[1]); w.y = cvt_pk_bf16(v0[2], v0[3]); w.z = cvt_pk_bf16(v1[0], v1[1]); w.w = cvt_pk_bf16(v1[2], v1[3]);
                    *(u32x4*)(rowp + bj * HALF) = w; } }
    }
};
struct EpiSwiGLU {
    static constexpr bool PERM = true, AFTER_DRAIN = false;
    bf16_t* H;
    __device__ __forceinline__ void operator()(const Acc& acc, const Unit& u, int wr, int wc, int fr, int fq) const {
        const int row0 = u.pm * BM + wr * 64 + fr, col0 = u.pn * HALF + wc * 32 + 8 * fq;
#pragma unroll
        for (int ai = 0; ai < 2; ++ai)
#pragma unroll
            for (int m = 0; m < 4; ++m) { bf16_t* rowp = H + (size_t)(row0 + ai * HALF + m * 16) * DFF + col0;
                float h[8];
#pragma unroll
                for (int n = 0; n < 2; ++n)
#pragma unroll
                    for (int j = 0; j < 4; ++j) { const float gt = acc[ai][0][m][n][j], up = acc[ai][1][m][n][j]; h[n * 4 + j] = gt * sigmoidf_fast(gt) * up; }
                u32x4 w; w.x = cvt_pk_bf16(h[0], h[1]); w.y = cvt_pk_bf16(h[2], h[3]); w.z = cvt_pk_bf16(h[4], h[5]); w.w = cvt_pk_bf16(h[6], h[7]);
                *(u32x4*)rowp = w; }
    }
};
struct EpiGate {
    static constexpr bool PERM = true, AFTER_DRAIN = false;
    bf16_t* G;
    __device__ __forceinline__ void operator()(const Acc& acc, const Unit& u, int wr, int wc, int fr, int fq) const {
        const int row0 = u.pm * BM + wr * 64 + fr, col0 = u.pn * BM + wc * 32 + 8 * fq;
#pragma unroll
        for (int ai = 0; ai < 2; ++ai)
#pragma unroll
            for (int m = 0; m < 4; ++m) { bf16_t* rowp = G + (size_t)(row0 + ai * HALF + m * 16) * 2048 + col0;
#pragma unroll
                for (int bj = 0; bj < 2; ++bj) { const f32x4 v0 = acc[ai][bj][m][0], v1 = acc[ai][bj][m][1];
                    u32x4 w; w.x = cvt_pk_bf16(sigmoidf_fast(v0[0]), sigmoidf_fast(v0[1])); w.y = cvt_pk_bf16(sigmoidf_fast(v0[2]), sigmoidf_fast(v0[3]));
                    w.z = cvt_pk_bf16(sigmoidf_fast(v1[0]), sigmoidf_fast(v1[1])); w.w = cvt_pk_bf16(sigmoidf_fast(v1[2]), sigmoidf_fast(v1[3]));
                    *(u32x4*)(rowp + bj * HALF) = w; } }
    }
};
struct EpiQ {
    static constexpr bool PERM = true, AFTER_DRAIN = false;
    bf16_t* Q; const float* TAB;
    __device__ __forceinline__ void operator()(const Acc& acc, const Unit& u, int wr, int wc, int fr, int fq) const {
        const int row0 = u.pm * BM + wr * 64 + fr, col0 = u.pn * BM + wc * 32 + 8 * fq;
#pragma unroll
        for (int ai = 0; ai < 2; ++ai)
#pragma unroll
            for (int m = 0; m < 4; ++m) { const int row = row0 + ai * HALF + m * 16; bf16_t* rowp = Q + (size_t)row * 1536 + col0;
#pragma unroll
                for (int bj = 0; bj < 2; ++bj) { f32x4 v0 = acc[ai][bj][m][0], v1 = acc[ai][bj][m][1];
                    const int c = col0 + bj * HALF, w = c % 192;
                    if (w >= 128) { const int i0 = (w - 128) >> 1; const f32x4 cs = *(const f32x4*)(TAB + (size_t)row * 64 + i0), sn = *(const f32x4*)(TAB + (size_t)row * 64 + 32 + i0);
                        f32x4 r0, r1;
                        r0[0] = v0[0] * cs[0] - v0[1] * sn[0]; r0[1] = v0[1] * cs[0] + v0[0] * sn[0];
                        r0[2] = v0[2] * cs[1] - v0[3] * sn[1]; r0[3] = v0[3] * cs[1] + v0[2] * sn[1];
                        r1[0] = v1[0] * cs[2] - v1[1] * sn[2]; r1[1] = v1[1] * cs[2] + v1[0] * sn[2];
                        r1[2] = v1[2] * cs[3] - v1[3] * sn[3]; r1[3] = v1[3] * cs[3] + v1[2] * sn[3];
                        v0 = r0; v1 = r1; }
                    u32x4 wv; wv.x = cvt_pk_bf16(v0[0], v0[1]); wv.y = cvt_pk_bf16(v0[2], v0[3]); wv.z = cvt_pk_bf16(v1[0], v1[1]); wv.w = cvt_pk_bf16(v1[2], v1[3]);
                    *(u32x4*)(rowp + bj * HALF) = wv; } }
    }
};
struct EpiT1 {
    static constexpr bool PERM = true, AFTER_DRAIN = false;
    const bf16_t* G; bf16_t* F;
    __device__ __forceinline__ void operator()(const Acc& acc, const Unit& u, int wr, int wc, int fr, int fq) const {
        const int row0 = u.pm * BM + wr * 64 + fr, col0 = u.pn * BM + wc * 32 + 8 * fq;
#pragma unroll
        for (int ai = 0; ai < 2; ++ai)
#pragma unroll
            for (int m = 0; m < 4; ++m) { const int row = row0 + ai * HALF + m * 16;
#pragma unroll
                for (int bj = 0; bj < 2; ++bj) { const f32x4 v0 = acc[ai][bj][m][0], v1 = acc[ai][bj][m][1]; const int c = col0 + bj * HALF;
                    const u32x4 gw = *(const u32x4*)(G + (size_t)row * 2048 + c);
                    u32x4 wv;
                    wv.x = cvt_pk_bf16(v0[0] * bf_lo(gw.x), v0[1] * bf_hi(gw.x)); wv.y = cvt_pk_bf16(v0[2] * bf_lo(gw.y), v0[3] * bf_hi(gw.y));
                    wv.z = cvt_pk_bf16(v1[0] * bf_lo(gw.z), v1[1] * bf_hi(gw.z)); wv.w = cvt_pk_bf16(v1[2] * bf_lo(gw.w), v1[3] * bf_hi(gw.w));
                    *(u32x4*)(F + (size_t)row * 1024 + c) = wv; } }
    }
};
struct EpiMX {
    static constexpr bool PERM = true, AFTER_DRAIN = false;
    const bf16_t* G; const bf16_t* F; bf16_t* MX;
    __device__ __forceinline__ void operator()(const Acc& acc, const Unit& u, int wr, int wc, int fr, int fq) const {
        const int row0 = u.pm * BM + wr * 64 + fr, col0 = u.pn * BM + wc * 32 + 8 * fq;
#pragma unroll
        for (int ai = 0; ai < 2; ++ai)
#pragma unroll
            for (int m = 0; m < 4; ++m) { const int row = row0 + ai * HALF + m * 16;
#pragma unroll
                for (int bj = 0; bj < 2; ++bj) { const f32x4 v0 = acc[ai][bj][m][0], v1 = acc[ai][bj][m][1]; const int c = col0 + bj * HALF;
                    const u32x4 gw = *(const u32x4*)(G + (size_t)row * 2048 + 1024 + c);
                    const u32x4 tw = *(const u32x4*)(F + (size_t)row * 1024 + c);
                    u32x4 wv;
                    wv.x = cvt_pk_bf16(bf_lo(tw.x) + v0[0] * bf_lo(gw.x), bf_hi(tw.x) + v0[1] * bf_hi(gw.x)); wv.y = cvt_pk_bf16(bf_lo(tw.y) + v0[2] * bf_lo(gw.y), bf_hi(tw.y) + v0[3] * bf_hi(gw.y));
                    wv.z = cvt_pk_bf16(bf_lo(tw.z) + v1[0] * bf_lo(gw.z), bf_hi(tw.z) + v1[1] * bf_hi(gw.z)); wv.w = cvt_pk_bf16(bf_lo(tw.w) + v1[2] * bf_lo(gw.w), bf_hi(tw.w) + v1[3] * bf_hi(gw.w));
                    *(u32x4*)(MX + (size_t)row * 1024 + c) = wv; } }
    }
};

struct PanelSumSq {
    float* xbuf;
    unsigned* cnt;
    __device__ __forceinline__ void run(const Acc& v, const Unit& u, int wr, int wc, int fr, int fq, LAS unsigned char* lds, int wid, int lane) const {
        LAS float* P = (LAS float*)lds; LAS float* S = (LAS float*)(lds + 4096);
#pragma unroll
        for (int ai = 0; ai < 2; ++ai)
#pragma unroll
            for (int m = 0; m < 4; ++m) { float q = 0.f;
#pragma unroll
                for (int bj = 0; bj < 2; ++bj)
#pragma unroll
                    for (int n = 0; n < 2; ++n) { const f32x4 x = v[ai][bj][m][n]; q += (x[0] * x[0] + x[1] * x[1]) + (x[2] * x[2] + x[3] * x[3]); }
                q += __shfl_xor(q, 16); q += __shfl_xor(q, 32);
                if (fq == 0) P[(ai * HALF + wr * 64 + m * 16 + fr) * 4 + wc] = q; }
        asm volatile("s_waitcnt lgkmcnt(0)" ::: "memory"); __builtin_amdgcn_s_barrier(); asm volatile("" ::: "memory");
        const int row = wid * 32 + (lane & 31);
        if (lane < 32) { const float t = (P[row * 4 + 0] + P[row * 4 + 1]) + (P[row * 4 + 2] + P[row * 4 + 3]);
            __hip_atomic_store(xbuf + ((size_t)(u.pm * BM + row) * 4 + u.pn), t, __ATOMIC_RELAXED, __HIP_MEMORY_SCOPE_AGENT); }
        asm volatile("s_waitcnt vmcnt(0)" ::: "memory");
        if (lane == 0) __hip_atomic_fetch_add(cnt + 64 * u.pm, 1u, __ATOMIC_RELAXED, __HIP_MEMORY_SCOPE_AGENT);
        if (wid == 0) { unsigned sp = 0u;
            while ((unsigned)__builtin_amdgcn_readfirstlane(__hip_atomic_load(cnt + 64 * u.pm, __ATOMIC_RELAXED, __HIP_MEMORY_SCOPE_AGENT)) < 32u) { __builtin_amdgcn_s_sleep(1); if (++sp > (1u << 22)) break; }
            }
        asm volatile("s_waitcnt vmcnt(0) lgkmcnt(0)" ::: "memory"); __builtin_amdgcn_s_barrier(); asm volatile("" ::: "memory");
        if (lane < 32) { const float* slot = xbuf + (size_t)(u.pm * BM + row) * 4; float tot = 0.f;
#pragma unroll
            for (int t = 0; t < 4; ++t) tot += __hip_atomic_load(slot + t, __ATOMIC_RELAXED, __HIP_MEMORY_SCOPE_AGENT);
            S[row] = __builtin_amdgcn_rsqf(tot * (1.f / 1024.f) + EPS); }
        asm volatile("s_waitcnt lgkmcnt(0)" ::: "memory"); __builtin_amdgcn_s_barrier(); asm volatile("" ::: "memory");
    }
};
template <bool FINAL, bool BASEF32> struct EpiResNorm {
    static constexpr bool PERM = true, AFTER_DRAIN = true;
    const float* basef; bf16_t* xb; float* outf; bf16_t* xn; float wt; const float* gpost; const float* gnext; PanelSumSq st1, st2;
    __device__ __forceinline__ void operator()(const Acc&, const Unit&, int, int, int, int) const {}
    __device__ __forceinline__ void fused(Acc& acc, const Unit& u, int wr, int wc, int fr, int fq, LAS unsigned char* lds, int wid, int lane) const {
        const LAS float* S = (const LAS float*)(lds + 4096);
        const int col0 = u.pn * BM + wc * 32 + 8 * fq;
        st1.run(acc, u, wr, wc, fr, fq, lds, wid, lane);
#pragma unroll
        for (int ai = 0; ai < 2; ++ai)
#pragma unroll
            for (int m = 0; m < 4; ++m) { const int r = ai * HALF + wr * 64 + m * 16 + fr; const float sr = S[r] * wt;
                const size_t off = (size_t)(u.pm * BM + r) * 1024 + col0, xoff = (size_t)u.pm * 524288 + 262144 + (size_t)r * 1024 + col0;
#pragma unroll
                for (int bj = 0; bj < 2; ++bj) { f32x4 b0, b1;
                    if (BASEF32) { b0 = *(const f32x4*)(basef + off + bj * HALF); b1 = *(const f32x4*)(basef + off + bj * HALF + 4); }
                    else { const u32x4 w = *(const u32x4*)(xb + xoff + bj * HALF); b0 = (f32x4){bf_lo(w.x), bf_hi(w.x), bf_lo(w.y), bf_hi(w.y)}; b1 = (f32x4){bf_lo(w.z), bf_hi(w.z), bf_lo(w.w), bf_hi(w.w)}; }
                    const f32x4 g0 = *(const f32x4*)(gpost + col0 + bj * HALF), g1 = *(const f32x4*)(gpost + col0 + bj * HALF + 4);
                    acc[ai][bj][m][0] = b0 + acc[ai][bj][m][0] * g0 * sr; acc[ai][bj][m][1] = b1 + acc[ai][bj][m][1] * g1 * sr; }
                asm volatile("" : "+v"(acc[ai][0][m][0]), "+v"(acc[ai][0][m][1]), "+v"(acc[ai][1][m][0]), "+v"(acc[ai][1][m][1]));
                if (m & 1) asm volatile("" ::: "memory"); }
        st2.run(acc, u, wr, wc, fr, fq, lds, wid, lane);
#pragma unroll
        for (int ai = 0; ai < 2; ++ai)
#pragma unroll
            for (int m = 0; m < 4; ++m) { const int r = ai * HALF + wr * 64 + m * 16 + fr; const float sr = S[r];
                const size_t off = (size_t)(u.pm * BM + r) * 1024 + col0, xoff = (size_t)u.pm * 524288 + 262144 + (size_t)r * 1024 + col0;
#pragma unroll
                for (int bj = 0; bj < 2; ++bj) { const f32x4 x0 = acc[ai][bj][m][0], x1 = acc[ai][bj][m][1];
                    const f32x4 g0 = *(const f32x4*)(gnext + col0 + bj * HALF), g1 = *(const f32x4*)(gnext + col0 + bj * HALF + 4); const f32x4 o0 = x0 * g0 * sr, o1 = x1 * g1 * sr;
                    if (FINAL) { *(f32x4*)(outf + off + bj * HALF) = o0; *(f32x4*)(outf + off + bj * HALF + 4) = o1; }
                    else { u32x4 wx; wx.x = cvt_pk_bf16(x0[0], x0[1]); wx.y = cvt_pk_bf16(x0[2], x0[3]); wx.z = cvt_pk_bf16(x1[0], x1[1]); wx.w = cvt_pk_bf16(x1[2], x1[3]); *(u32x4*)(xb + xoff + bj * HALF) = wx;
                           u32x4 w; w.x = cvt_pk_bf16(o0[0], o0[1]); w.y = cvt_pk_bf16(o0[2], o0[3]); w.z = cvt_pk_bf16(o1[0], o1[1]); w.w = cvt_pk_bf16(o1[2], o1[3]); *(u32x4*)(xn + off + bj * HALF) = w; } }
                asm volatile("" ::: "memory"); }
    }
};
}

namespace att {
constexpr int NW = 8, QBLK = 32, KVBLK = 64;
constexpr float SCALE = 0.07216878364870322f;
constexpr float THR = 8.f;
constexpr int LDQ = 1536, LDKV = 2048, LDKR = 64, LDO = 1024;
constexpr int SHM_V = 64 * 128 * 2, SHM_K = 64 * 128 * 2, SHM_R = 64 * 64 * 2;
constexpr int NQL = 4;
constexpr int OFF_V = 0, OFF_K = 2 * SHM_V, OFF_RP = OFF_K + 2 * SHM_K, OFF_WS = OFF_RP + 2 * SHM_R, OFF_QL = OFF_WS + NW * 64 * 4, SHM_ATTN = OFF_QL + NW * NQL * 1024;
static_assert(SHM_ATTN <= LDS_STAGE, "lds");
#define KSWZ(row, colB) ((row) * 256 + ((colB) ^ (((row) & 15) << 4)))
#define RSWZ(row, colB) ((row) * 128 + ((colB) ^ ((((row) >> 1) & 7) << 4)))
#define SBAR() __builtin_amdgcn_sched_barrier(0)
__device__ __forceinline__ int crow(int r, int hi) { return (r & 3) + 8 * (r >> 2) + 4 * hi; }
__device__ __forceinline__ bf16x8 ld8(const bf16_t* p) { return *reinterpret_cast<const bf16x8*>(p); }

__device__ __forceinline__ void partialSM(f32x16& p0, f32x16& p1, float& m_reg, float& mn, float& alpha) {
    constexpr float C = SCALE * 1.4426950408889634f;
    float pmax = p0[0];
#pragma unroll
    for (int r = 1; r < 16; ++r) pmax = fmaxf(pmax, p0[r]);
#pragma unroll
    for (int r = 0; r < 16; ++r) pmax = fmaxf(pmax, p1[r]);
    { auto rr = __builtin_amdgcn_permlane32_swap(__float_as_uint(pmax), __float_as_uint(pmax), false, false);
      pmax = fmaxf(__uint_as_float(rr[0]), __uint_as_float(rr[1])); }
    if (__builtin_expect(__all(pmax - m_reg <= THR / SCALE), 1)) { mn = m_reg; alpha = 1.f; }
    else { mn = fmaxf(m_reg, pmax); alpha = __builtin_amdgcn_exp2f((m_reg - mn) * C); m_reg = mn; }
    float mnC = -mn * C;
#pragma unroll
    for (int r = 0; r < 16; ++r) p0[r] = fmaf(p0[r], C, mnC);
#pragma unroll
    for (int r = 0; r < 16; ++r) p1[r] = fmaf(p1[r], C, mnC);
#pragma unroll
    for (int r = 0; r < 16; ++r) p0[r] = __builtin_amdgcn_exp2f(p0[r]);
}
__device__ __forceinline__ void finishSM(f32x16& p0, f32x16& p1, float alpha, float& l_reg, bf16x8& pa0, bf16x8& pa1, bf16x8& pa2, bf16x8& pa3) {
#pragma unroll
    for (int r = 0; r < 16; ++r) p1[r] = __builtin_amdgcn_exp2f(p1[r]);
    float ps = 0;
#pragma unroll
    for (int r = 0; r < 16; ++r) ps += p0[r];
#pragma unroll
    for (int r = 0; r < 16; ++r) ps += p1[r];
    { auto rr = __builtin_amdgcn_permlane32_swap(__float_as_uint(ps), __float_as_uint(ps), false, false);
      ps = __uint_as_float(rr[0]) + __uint_as_float(rr[1]); }
    l_reg = l_reg * alpha + ps;
#define PK4(P, BASE, OUT) do { unsigned a0 = cvt_pk_bf16(P[BASE + 0], P[BASE + 1]), a1 = cvt_pk_bf16(P[BASE + 2], P[BASE + 3]);   \
    unsigned b0 = cvt_pk_bf16(P[BASE + 4], P[BASE + 5]), b1 = cvt_pk_bf16(P[BASE + 6], P[BASE + 7]);                              \
    auto r0 = __builtin_amdgcn_permlane32_swap(a0, b0, false, false); auto r1 = __builtin_amdgcn_permlane32_swap(a1, b1, false, false); \
    u32x4 w = {r0[0], r1[0], r0[1], r1[1]}; OUT = *reinterpret_cast<bf16x8*>(&w); } while (0)
    PK4(p0, 0, pa0); PK4(p0, 8, pa1); PK4(p1, 0, pa2); PK4(p1, 8, pa3);
#undef PK4
}
__device__ __forceinline__ void qkt(f32x16& p0, f32x16& p1, const char* Ks, const char* Rs, const bf16x8* qr, const char* ql, int r32, int hi) {
    p0 = f32x16{}; p1 = f32x16{};
#pragma unroll
    for (int d0 = 0; d0 < 8; ++d0) { int cb = (d0 * 16 + hi * 8) * 2;
        bf16x8 b0 = *reinterpret_cast<const bf16x8*>(Ks + KSWZ(r32, cb));
        bf16x8 b1 = *reinterpret_cast<const bf16x8*>(Ks + KSWZ(32 + r32, cb));
        p0 = __builtin_amdgcn_mfma_f32_32x32x16_bf16(b0, qr[d0], p0, 0, 0, 0);
        p1 = __builtin_amdgcn_mfma_f32_32x32x16_bf16(b1, qr[d0], p1, 0, 0, 0); }
#pragma unroll
    for (int d0 = 0; d0 < 4; ++d0) { int cb = (d0 * 16 + hi * 8) * 2;
        bf16x8 b0 = *reinterpret_cast<const bf16x8*>(Rs + RSWZ(r32, cb));
        bf16x8 b1 = *reinterpret_cast<const bf16x8*>(Rs + RSWZ(32 + r32, cb));
        const bf16x8 qv = *reinterpret_cast<const bf16x8*>(ql + d0 * 1024);
        p0 = __builtin_amdgcn_mfma_f32_32x32x16_bf16(b0, qv, p0, 0, 0, 0);
        p1 = __builtin_amdgcn_mfma_f32_32x32x16_bf16(b1, qv, p1, 0, 0, 0); }
}
__device__ __forceinline__ int v_st(int k, int c) { const int kk = (k & ~0xC) | ((k & 4) << 1) | ((k & 8) >> 1); return ((kk >> 3) * 4 + (c >> 5)) * 512 + ((kk & 7) * 32 + (c & 31)) * 2; }
__device__ __forceinline__ int v_rd_base(int lane) { return ((lane & 3) << 3) | (((lane >> 2) & 3) << 6) | (((lane >> 4) & 1) << 5) | (((lane >> 5) & 1) << 8); }
constexpr int v_rd_off(int d0, int ks, int half) { return d0 * 512 + ks * 4096 + half * 2048; }
template <int OFF> __device__ __forceinline__ s16x4 tr_read(int vb) {
    s16x4 r; asm volatile("ds_read_b64_tr_b16 %0, %1 offset:%2" : "=&v"(r) : "v"(vb), "i"(OFF) : "memory"); return r;
}
template <int D0> __device__ __forceinline__ void pv_one(f32x16& od, int vb, bf16x8 pa0, bf16x8 pa1, bf16x8 pa2, bf16x8 pa3) {
    const s16x4 l0 = tr_read<v_rd_off(D0, 0, 0)>(vb), h0 = tr_read<v_rd_off(D0, 0, 1)>(vb), l1 = tr_read<v_rd_off(D0, 1, 0)>(vb), h1 = tr_read<v_rd_off(D0, 1, 1)>(vb);
    const s16x4 l2 = tr_read<v_rd_off(D0, 2, 0)>(vb), h2 = tr_read<v_rd_off(D0, 2, 1)>(vb), l3 = tr_read<v_rd_off(D0, 3, 0)>(vb), h3 = tr_read<v_rd_off(D0, 3, 1)>(vb);
    asm volatile("s_waitcnt lgkmcnt(0)" ::: "memory"); SBAR();
#define PK(L, H) (bf16x8){L[0], L[1], L[2], L[3], H[0], H[1], H[2], H[3]}
    od = __builtin_amdgcn_mfma_f32_32x32x16_bf16(pa0, PK(l0, h0), od, 0, 0, 0);
    od = __builtin_amdgcn_mfma_f32_32x32x16_bf16(pa1, PK(l1, h1), od, 0, 0, 0);
    od = __builtin_amdgcn_mfma_f32_32x32x16_bf16(pa2, PK(l2, h2), od, 0, 0, 0);
    od = __builtin_amdgcn_mfma_f32_32x32x16_bf16(pa3, PK(l3, h3), od, 0, 0, 0);
#undef PK
}
__device__ __forceinline__ void pv_d0(f32x16* o, int vb, bf16x8 pa0, bf16x8 pa1, bf16x8 pa2, bf16x8 pa3) {
    pv_one<0>(o[0], vb, pa0, pa1, pa2, pa3); pv_one<1>(o[1], vb, pa0, pa1, pa2, pa3); pv_one<2>(o[2], vb, pa0, pa1, pa2, pa3); pv_one<3>(o[3], vb, pa0, pa1, pa2, pa3);
}

__device__ __forceinline__ void attn_body(const bf16_t* __restrict__ Qb, const bf16_t* __restrict__ Kn, const bf16_t* __restrict__ Kr, const bf16_t* __restrict__ Vh,
                                          bf16_t* __restrict__ Ob, int seq, char* lds) {
    const int tid = fresh_tid(), wid = tid >> 6, lane = tid & 63, r32 = lane & 31, hi = lane >> 5;
    char* V_lds = lds + OFF_V; char* K_lds = lds + OFF_K; char* R_lds = lds + OFF_RP;
    float* ws = (float*)(lds + OFF_WS) + wid * 64; float* li_l = ws; float* al_l = ws + 32;
    float m_reg = -1e30f, l_reg = 0; f32x16 o[4] = {}; bf16x8 qr[8];
    char* ql = lds + OFF_QL + wid * (NQL * 1024) + lane * 16;
    const bf16_t* Qw = Qb + (long)(wid * QBLK + r32) * LDQ + hi * 8;
#pragma unroll
    for (int d0 = 0; d0 < 8; ++d0) qr[d0] = ld8(Qw + d0 * 16);
#pragma unroll
    for (int d0 = 0; d0 < NQL; ++d0) *reinterpret_cast<bf16x8*>(ql + d0 * 1024) = ld8(Qw + (8 + d0) * 16);
    const int sr = tid >> 4, sc = (tid & 15) * 8, vst0 = v_st(sr, sc), vst1 = v_st(32 + sr, sc);
    const int rr_ = tid >> 3, rc_ = (tid & 7) * 8;
    const int vb0 = (int)(uintptr_t)V_lds + v_rd_base(lane);
    bf16x8 vs0, vs1, ks0, ks1, rs0;
#define SLOAD(k0) do { vs0 = ld8(&Vh[(long)((k0) + sr) * LDKV + sc]); vs1 = ld8(&Vh[(long)((k0) + 32 + sr) * LDKV + sc]); \
    ks0 = ld8(&Kn[(long)((k0) + sr) * LDKV + sc]); ks1 = ld8(&Kn[(long)((k0) + 32 + sr) * LDKV + sc]); rs0 = ld8(&Kr[(long)((k0) + rr_) * LDKR + rc_]); } while (0)
#define SWRITE(b) do { *(bf16x8*)(V_lds + (b) * SHM_V + vst0) = vs0; *(bf16x8*)(V_lds + (b) * SHM_V + vst1) = vs1; int kc = sc * 2; \
    *(bf16x8*)(K_lds + (b) * SHM_K + KSWZ(sr, kc)) = ks0; *(bf16x8*)(K_lds + (b) * SHM_K + KSWZ(32 + sr, kc)) = ks1; \
    *(bf16x8*)(R_lds + (b) * SHM_R + RSWZ(rr_, rc_ * 2)) = rs0; } while (0)
#define RESC(a) do { if (__any((a) < 1.f)) { if (hi == 0) al_l[r32] = (a); asm volatile("s_waitcnt lgkmcnt(0)" ::: "memory"); \
    _Pragma("unroll") for (int d = 0; d < 4; ++d) _Pragma("unroll") for (int r = 0; r < 16; ++r) o[d][r] *= al_l[crow(r, hi)]; } } while (0)
    f32x16 pA0, pA1, pB0, pB1; float mnA, mnB, alA, alB; bf16x8 pa0, pa1, pa2, pa3; const int NT = seq / KVBLK;
    SLOAD(0); asm volatile("s_waitcnt vmcnt(0)" ::: "memory"); SWRITE(0); __syncthreads();
    qkt(pA0, pA1, K_lds, R_lds, qr, ql, r32, hi); partialSM(pA0, pA1, m_reg, mnA, alA);
    SLOAD(KVBLK);
    asm volatile("s_waitcnt vmcnt(0)" ::: "memory"); SWRITE(1); __syncthreads();
    for (int j = 1; j + 1 < NT; j += 2) {
        SBAR(); qkt(pB0, pB1, K_lds + SHM_K, R_lds + SHM_R, qr, ql, r32, hi);
        finishSM(pA0, pA1, alA, l_reg, pa0, pa1, pa2, pa3); SBAR();
        SLOAD((j + 1) * KVBLK); SBAR();
        pv_d0(o, vb0, pa0, pa1, pa2, pa3); partialSM(pB0, pB1, m_reg, mnB, alB);
        __syncthreads(); asm volatile("s_waitcnt vmcnt(0)" ::: "memory"); SWRITE(0);
        RESC(alB); __syncthreads();
        SBAR(); qkt(pA0, pA1, K_lds, R_lds, qr, ql, r32, hi);
        finishSM(pB0, pB1, alB, l_reg, pa0, pa1, pa2, pa3); SBAR();
        SLOAD((j + 2) * KVBLK); SBAR();
        pv_d0(o, vb0 + SHM_V, pa0, pa1, pa2, pa3); partialSM(pA0, pA1, m_reg, mnA, alA);
        __syncthreads(); asm volatile("s_waitcnt vmcnt(0)" ::: "memory"); SWRITE(1);
        RESC(alA); __syncthreads();
    }
    SBAR(); qkt(pB0, pB1, K_lds + SHM_K, R_lds + SHM_R, qr, ql, r32, hi);
    finishSM(pA0, pA1, alA, l_reg, pa0, pa1, pa2, pa3); SBAR();
    pv_d0(o, vb0, pa0, pa1, pa2, pa3); partialSM(pB0, pB1, m_reg, mnB, alB);
    __syncthreads(); RESC(alB);
    finishSM(pB0, pB1, alB, l_reg, pa0, pa1, pa2, pa3); SBAR();
    pv_d0(o, vb0 + SHM_V, pa0, pa1, pa2, pa3);
    if (hi == 0) li_l[r32] = l_reg; asm volatile("s_waitcnt lgkmcnt(0)" ::: "memory");
    float rli[16];
#pragma unroll
    for (int r = 0; r < 16; ++r) rli[r] = __builtin_amdgcn_rcpf(li_l[crow(r, hi)]);
    bf16_t* Ow = Ob + (long)(wid * QBLK) * LDO;
#pragma unroll
    for (int r = 0; r < 16; ++r) { int orow = crow(r, hi);
#pragma unroll
        for (int d0 = 0; d0 < 4; ++d0) { const float v = o[d0][r] * rli[r]; Ow[(long)orow * LDO + d0 * 32 + r32] = (bf16_t)(cvt_pk_bf16(v, v) & 0xffffu); } }
#undef SLOAD
#undef SWRITE
#undef RESC
}
}


#define XB_TMO      128
#define XB_XCNT(j)  (256  + 64 * (j))
#define XB_XSUB(j)  (1280 + 64 * (j))
#define XB_XGEN(j)  (2304 + 64 * (j))
#define XB_TOP      3328
#define XB_TOPGEN   3392
#define XCD_BAR_WORDS 3456
#define XB_SPIN_CAP (1u << 18)
__device__ __forceinline__ unsigned xb_ld(unsigned* p)              { return __hip_atomic_load(p, __ATOMIC_RELAXED, __HIP_MEMORY_SCOPE_AGENT); }
__device__ __forceinline__ unsigned xb_add(unsigned* p, unsigned v) { return __hip_atomic_fetch_add(p, v, __ATOMIC_RELAXED, __HIP_MEMORY_SCOPE_AGENT); }
__device__ __forceinline__ unsigned xb_xcc_id() { return (unsigned)__builtin_amdgcn_s_getreg((3 << 11) | 20) & 0xFu; }
#define XB_SPIN(cond, bar) do { unsigned _sp = 0; while (cond) { __builtin_amdgcn_s_sleep(1); \
    if ((++_sp & 255u) == 0u) { if (xb_ld(&(bar)[XB_TMO])) break; if (_sp > XB_SPIN_CAP) { atomicAdd(&(bar)[XB_TMO], 1u); break; } } } } while (0)
struct XcdBarrier { unsigned* bar; unsigned x; volatile LAS unsigned* st; };
__device__ __forceinline__ XcdBarrier xcd_barrier_post(unsigned* bar, volatile LAS unsigned* st) {
    XcdBarrier b; b.bar = bar; b.x = xb_xcc_id(); b.st = st;
    if (threadIdx.x == 0) (void)xb_add(&bar[XB_XCNT(b.x)], 1u);
    return b;
}
__device__ __forceinline__ void xcd_barrier_complete(unsigned* bar, unsigned x, unsigned& nloc, unsigned& nx) {
    const unsigned G = gridDim.x * gridDim.y * gridDim.z;
    unsigned sum, cnt, mine, sp = 0u;
    for (;;) {
        sum = 0u; cnt = 0u; mine = 0u;
#pragma unroll
        for (unsigned j = 0; j < 16; ++j) { const unsigned c = xb_ld(&bar[XB_XCNT(j)]); sum += c; cnt += (c > 0u) ? 1u : 0u; mine = (j == x) ? c : mine; }
        if (sum == G) break;
        __builtin_amdgcn_s_sleep(1);
        if ((++sp & 255u) == 0u) { if (xb_ld(&bar[XB_TMO])) break; if (sp > XB_SPIN_CAP) { atomicAdd(&bar[XB_TMO], 1u); break; } }
    }
    nloc = mine > 0u ? mine : 1u; nx = cnt > 0u ? cnt : 1u;
}
__device__ __forceinline__ void xcd_barrier(const XcdBarrier& b) {
    asm volatile("s_waitcnt vmcnt(0)" ::: "memory");
    __syncthreads();
    if (threadIdx.x == 0) {
        unsigned* bar = b.bar;
        __builtin_amdgcn_s_waitcnt(0);
        unsigned nloc = b.st[0], nx = b.st[1];
        if (nloc == 0u) { xcd_barrier_complete(bar, b.x, nloc, nx); b.st[0] = nloc; b.st[1] = nx; }
        const unsigned old = xb_add(&bar[XB_XSUB(b.x)], 1u);
        const unsigned gen = old / nloc;
        if (old + 1u == (gen + 1u) * nloc) {
            __builtin_amdgcn_fence(__ATOMIC_RELEASE, "agent");
            asm volatile("s_waitcnt vmcnt(0)" ::: "memory");
            const unsigned og = xb_add(&bar[XB_TOP], 1u);
            const unsigned tg = og / nx;
            __builtin_amdgcn_fence(__ATOMIC_ACQUIRE, "agent");
            if (og + 1u == (tg + 1u) * nx) xb_add(&bar[XB_TOPGEN], 1u);
            else XB_SPIN(xb_ld(&bar[XB_TOPGEN]) == tg, bar);
            xb_add(&bar[XB_XGEN(b.x)], 1u);
            asm volatile("s_waitcnt vmcnt(0)" ::: "memory");
        } else {
            __builtin_amdgcn_fence(__ATOMIC_ACQUIRE, "agent");
            XB_SPIN(xb_ld(&bar[XB_XGEN(b.x)]) == gen, bar);
            asm volatile("s_waitcnt vmcnt(0)" ::: "memory");
        }
    }
    __syncthreads();
}

enum { TR_PLAIN = 0, TR_GU = 1, TR_WIN = 2, TR_UQ = 3, TR_UKV = 4 };
template <int MODE>
__device__ __forceinline__ void tr_job(const float* W0, const float* W1, int K, int Nsrc, int Nout, bf16_t* WT, LAS float* scr, int lane, int gw, int NGW) {
    const int nblk = Nout / 32, nitems = (K / 64) * nblk;
    for (int it = gw; it < nitems; it += NGW) {
        const int kb = it / nblk, nb = it % nblk, k0 = 64 * kb, n0 = 32 * nb, np = n0 + (lane & 31);
        const float* colp;
        if (MODE == TR_PLAIN) colp = W0 + np;
        else if (MODE == TR_GU) { const int t = np >> 8, w = np & 255; colp = (w < 128 ? W0 : W1) + t * 128 + (w & 127); }
        else if (MODE == TR_WIN) colp = np < 1216 ? W0 + np : (np < 1280 ? nullptr : W0 + (np - 64));
        else if (MODE == TR_UQ) { const int h = np / 192, w = np % 192; colp = W0 + (w < 128 ? np : h * 192 + 128 + ((w - 128) >> 1) + ((w - 128) & 1) * 32); }
        else colp = np < 1024 ? W0 + np : W1 + (np - 1024);
        float tv[32];
#pragma unroll
        for (int i = 0; i < 32; ++i) { const int kk = 2 * i + (lane >> 5); tv[i] = colp ? __builtin_nontemporal_load(colp + (size_t)(k0 + kk) * Nsrc) : 0.f; }
#pragma unroll
        for (int i = 0; i < 32; ++i) { const int kk = 2 * i + (lane >> 5); scr[kk * 33 + (lane & 31)] = tv[i]; }
        asm volatile("s_waitcnt lgkmcnt(0)" ::: "memory");
        const int c = lane & 7;
#pragma unroll
        for (int j = 0; j < 4; ++j) { const int n = (lane >> 3) + 8 * j; const LAS float* s = scr + (8 * c) * 33 + n;
            u32x4 o; o.x = cvt_pk_bf16(s[0 * 33], s[1 * 33]); o.y = cvt_pk_bf16(s[2 * 33], s[3 * 33]); o.z = cvt_pk_bf16(s[4 * 33], s[5 * 33]); o.w = cvt_pk_bf16(s[6 * 33], s[7 * 33]);
            *(u32x4*)(WT + (size_t)(n0 + n) * K + k0 + 8 * c) = o; }
        asm volatile("s_waitcnt lgkmcnt(0)" ::: "memory");
    }
}

__device__ __forceinline__ void norm_rows(const float* xin, const float* gnext, bf16_t* xn, int gw, int NGW, int lane) {
    for (int row0 = gw; row0 < M; row0 += 2 * NGW) {
        f32x4 xv[2][4];
#pragma unroll
        for (int r = 0; r < 2; ++r) { const size_t row = (size_t)(row0 + r * NGW);
#pragma unroll
            for (int j = 0; j < 2; ++j) { xv[r][2 * j] = *(const f32x4*)(xin + row * DM + 8 * (lane + 64 * j)); xv[r][2 * j + 1] = *(const f32x4*)(xin + row * DM + 8 * (lane + 64 * j) + 4); } }
#pragma unroll
        for (int r = 0; r < 2; ++r) { const size_t row = (size_t)(row0 + r * NGW);
            float s2 = 0.f;
#pragma unroll
            for (int j = 0; j < 4; ++j) s2 += xv[r][j].x * xv[r][j].x + xv[r][j].y * xv[r][j].y + xv[r][j].z * xv[r][j].z + xv[r][j].w * xv[r][j].w;
            const float r2 = __builtin_amdgcn_rsqf(wave_sum(s2) * (1.f / DM) + EPS);
#pragma unroll
            for (int j = 0; j < 2; ++j) { const f32x4 g0 = *(const f32x4*)(gnext + 8 * (lane + 64 * j)), g1 = *(const f32x4*)(gnext + 8 * (lane + 64 * j) + 4);
                const f32x4 y0 = xv[r][2 * j] * g0 * r2, y1 = xv[r][2 * j + 1] * g1 * r2;
                u32x4 w; w.x = cvt_pk_bf16(y0.x, y0.y); w.y = cvt_pk_bf16(y0.z, y0.w); w.z = cvt_pk_bf16(y1.x, y1.y); w.w = cvt_pk_bf16(y1.z, y1.w);
                *(u32x4*)(xn + row * DM + 8 * (lane + 64 * j)) = w; }
        }
    }
}

__global__ void __launch_bounds__(NTHREADS, 2) fwd_megakernel(Params p) {
    extern __shared__ __attribute__((aligned(16))) unsigned char lds[];
    cg::grid_group grid = cg::this_grid();
    volatile LAS unsigned* bst = (volatile LAS unsigned*)((LAS unsigned char*)lds + LDS_STAGE);
    if (threadIdx.x < 2) bst[threadIdx.x] = 0u;
    __syncthreads();
    const XcdBarrier xbar = xcd_barrier_post((unsigned*)(p.ws + OFF_BAR), bst);
#define GRID_SYNC_CG() do { __builtin_amdgcn_fence(__ATOMIC_RELEASE, "agent"); asm volatile("s_waitcnt vmcnt(0)" ::: "memory"); grid.sync(); \
        __builtin_amdgcn_fence(__ATOMIC_ACQUIRE, "agent"); asm volatile("s_waitcnt vmcnt(0)" ::: "memory"); } while (0)
#define GRID_SYNC() xcd_barrier(xbar)
    const int G = gridDim.x, bid = blockIdx.x, NGW = G * NWAVES;
    LAS unsigned char* ldsl = (LAS unsigned char*)lds;
#define PHASE_IDS() const int tid = fresh_tid(), lane = tid & 63, wave = tid >> 6, gw = bid * NWAVES + wave; LAS float* scr = (LAS float*)(ldsl + wave * 8448); (void)scr; (void)gw; (void)lane
    unsigned char* ws = p.ws;
    bf16_t* Wgu = (bf16_t*)(ws + OFF_WGU); bf16_t* Wd = (bf16_t*)(ws + OFF_WD); bf16_t* Win = (bf16_t*)(ws + OFF_WIN); bf16_t* Wuq = (bf16_t*)(ws + OFF_WUQ);
    bf16_t* Wukv = (bf16_t*)(ws + OFF_WUKV); bf16_t* Woa = (bf16_t*)(ws + OFF_WOA); bf16_t* Wp = (bf16_t*)(ws + OFF_WP); bf16_t* Wout = (bf16_t*)(ws + OFF_WOUT);
    bf16_t* XN = (bf16_t*)(ws + OFF_XN); bf16_t* F = (bf16_t*)(ws + OFF_F); float* ZF = (float*)(ws + OFF_ZF); bf16_t* KV = (bf16_t*)(ws + OFF_KV);
    bf16_t* H = (bf16_t*)(ws + OFF_H); bf16_t* O = (bf16_t*)(ws + OFF_O); bf16_t* CQN = (bf16_t*)(ws + OFF_CQN); bf16_t* CKVN = (bf16_t*)(ws + OFF_CKVN);
    float* TAB = (float*)(ws + OFF_TAB); bf16_t* Q = (bf16_t*)(ws + OFF_Q); bf16_t* KR = (bf16_t*)(ws + OFF_KR); bf16_t* Gt = (bf16_t*)(ws + OFF_G); bf16_t* DP = (bf16_t*)(ws + OFF_DP);
    float* X = p.out;
    bf16_t* MXb = (bf16_t*)(ws + OFF_F + 32 * MiB);
    float* xbuf0 = (float*)(ws + OFF_XBUF); unsigned* cnt0 = (unsigned*)(ws + OFF_CNT);

    { PHASE_IDS();
    tr_job<TR_GU>(p.f1_wg, p.f1_wu, 1024, DFF, 5632, Wgu, scr, lane, gw, NGW);
    norm_rows(p.x, p.f1_pre, XN, gw, NGW, lane); }
    if (__builtin_expect(p.out == nullptr, 0)) GRID_SYNC_CG();
    GRID_SYNC();

    pg8::StaticOrder S;
    { pg8::Gemm g{XN, Wgu, M, 5632, 1024}; S.init(M, 5632, G, bid); pg8::EpiSwiGLU E{H}; pg8::gemm_phase(ldsl, g, S, E); }
    {
        const int tail0 = (64 * 22) % G;
        if (tail0 != 0 && bid >= tail0) { PHASE_IDS(); const int tb = bid - tail0, nb = G - tail0, tgw = tb * NWAVES + wave, TNGW = nb * NWAVES;
            tr_job<TR_PLAIN>(p.f1_wd, nullptr, DFF, 1024, 1024, Wd, scr, lane, tgw, TNGW);
            tr_job<TR_WIN>(p.w_in, nullptr, 1024, INW, 3328, Win, scr, lane, tgw, TNGW);
            tr_job<TR_UQ>(p.w_uq, nullptr, QL, 1536, 1536, Wuq, scr, lane, tgw, TNGW);
            tr_job<TR_UKV>(p.w_uk, p.w_uv, KVL, 1024, 2048, Wukv, scr, lane, tgw, TNGW);
    }
        else if (tail0 == 0) { PHASE_IDS(); const int tb = bid, nb = G;
            tr_job<TR_PLAIN>(p.f1_wd, nullptr, DFF, 1024, 1024, Wd, scr, lane, gw, NGW);
            tr_job<TR_WIN>(p.w_in, nullptr, 1024, INW, 3328, Win, scr, lane, gw, NGW);
            tr_job<TR_UQ>(p.w_uq, nullptr, QL, 1536, 1536, Wuq, scr, lane, gw, NGW);
            tr_job<TR_UKV>(p.w_uk, p.w_uv, KVL, 1024, 2048, Wukv, scr, lane, gw, NGW);
    }
    }
    GRID_SYNC();
    { pg8::Gemm g{H, Wd, M, 1024, DFF}; S.init(M, 1024, G, bid);
      pg8::EpiResNorm<false, true> E{p.x, (bf16_t*)X, nullptr, XN, 0.5f, p.f1_post, p.mix_pre, pg8::PanelSumSq{xbuf0, cnt0}, pg8::PanelSumSq{xbuf0 + (size_t)M * 4, cnt0 + 4096}}; pg8::gemm_phase(ldsl, g, S, E); }
    GRID_SYNC();
    { pg8::Gemm g{XN, Win, M, 1280, 1024}; S.init(M, 1280, G, bid); pg8::EpiBf16 E{(bf16_t*)ZF, 1280}; pg8::gemm_phase(ldsl, g, S, E); }
    {
        const int tail0 = (64 * 5) % G; PHASE_IDS();
        if (tail0 != 0 && bid >= tail0) { const int tgw = (bid - tail0) * NWAVES + wave, TNGW = (G - tail0) * NWAVES;
            tr_job<TR_GU>(p.f2_wg, p.f2_wu, 1024, DFF, 5632, Wgu, scr, lane, tgw, TNGW);
            tr_job<TR_PLAIN>(p.f2_wd, nullptr, DFF, 1024, 1024, Wd, scr, lane, tgw, TNGW); }
        else if (tail0 == 0) { tr_job<TR_GU>(p.f2_wg, p.f2_wu, 1024, DFF, 5632, Wgu, scr, lane, gw, NGW); tr_job<TR_PLAIN>(p.f2_wd, nullptr, DFF, 1024, 1024, Wd, scr, lane, gw, NGW); }
    }
    GRID_SYNC();
    { PHASE_IDS();
    const bf16_t* ZB = (const bf16_t*)ZF;
    for (int bt = gw; bt < M / 4; bt += NGW) { const int row0 = bt * 4, t0 = row0 & (SEQ - 1);
        const int lane = fresh_tid() & 63;
        const int t_g = lane >> 4, wnd = 2 << t_g, wl = wnd >> 1, wrr = wnd - wl;
        u32x4 nb[19], qa[4], qb[4]; float kx1[4], kx2[4]; int pos[4];
#pragma unroll
        for (int i = 0; i < 19; ++i) { int tt = t0 - 8 + i; tt = tt < 0 ? 0 : (tt > SEQ - 1 ? SEQ - 1 : tt); nb[i] = *(const u32x4*)(ZB + (size_t)(row0 - t0 + tt) * 1280 + 704 + 8 * lane); }
#pragma unroll
        for (int k = 0; k < 4; ++k) { const bf16_t* z = ZB + (size_t)(row0 + k) * 1280;
            qa[k] = *(const u32x4*)(z + 8 * lane); qb[k] = (u32x4){0u, 0u, 0u, 0u}; if (lane < 16) qb[k] = *(const u32x4*)(z + 512 + 8 * lane);
            kx1[k] = 0.f; kx2[k] = 0.f; pos[k] = 0; if (lane < 32) { kx1[k] = bf_lo((unsigned)z[640 + lane]); kx2[k] = bf_lo((unsigned)z[672 + lane]); pos[k] = p.pos[row0 + k]; } }
        __builtin_amdgcn_sched_barrier(0);
#pragma unroll
        for (int k = 0; k < 4; ++k) { const int row = row0 + k, t = t0 + k, lo = max(t - wl, 0), hi = min(t + wrr, SEQ);
            float sacc[8];
#pragma unroll
            for (int i = 0; i < 8; ++i) sacc[i] = 0.f;
#pragma unroll
            for (int d = 0; d < 16; ++d) { const int tt = t - 8 + d; const float wv = (tt >= lo && tt < hi) ? 1.f : 0.f; const u32x4 v = nb[k + d];
                sacc[0] = fmaf(wv, bf_lo(v.x), sacc[0]); sacc[1] = fmaf(wv, bf_hi(v.x), sacc[1]); sacc[2] = fmaf(wv, bf_lo(v.y), sacc[2]); sacc[3] = fmaf(wv, bf_hi(v.y), sacc[3]);
                sacc[4] = fmaf(wv, bf_lo(v.z), sacc[4]); sacc[5] = fmaf(wv, bf_hi(v.z), sacc[5]); sacc[6] = fmaf(wv, bf_lo(v.w), sacc[6]); sacc[7] = fmaf(wv, bf_hi(v.w), sacc[7]); }
            {
                const float inv = 1.f / (float)(hi - lo); const u32x4 pc = nb[k + 8];
                u32x4 w; w.x = cvt_pk_bf16(sacc[0] * inv - bf_lo(pc.x), sacc[1] * inv - bf_hi(pc.x)); w.y = cvt_pk_bf16(sacc[2] * inv - bf_lo(pc.y), sacc[3] * inv - bf_hi(pc.y));
                w.z = cvt_pk_bf16(sacc[4] * inv - bf_lo(pc.z), sacc[5] * inv - bf_hi(pc.z)); w.w = cvt_pk_bf16(sacc[6] * inv - bf_lo(pc.w), sacc[7] * inv - bf_hi(pc.w));
                *(u32x4*)(DP + (size_t)row * 512 + 8 * lane) = w; }
            {
                const u32x4 a4 = qa[k], b4 = qb[k];
                float va[8] = {bf_lo(a4.x), bf_hi(a4.x), bf_lo(a4.y), bf_hi(a4.y), bf_lo(a4.z), bf_hi(a4.z), bf_lo(a4.w), bf_hi(a4.w)};
                float vb[8] = {bf_lo(b4.x), bf_hi(b4.x), bf_lo(b4.y), bf_hi(b4.y), bf_lo(b4.z), bf_hi(b4.z), bf_lo(b4.w), bf_hi(b4.w)};
                float sa = 0.f, sb = 0.f;
#pragma unroll
                for (int i = 0; i < 8; ++i) { sa = fmaf(va[i], va[i], sa); sb = fmaf(vb[i], vb[i], sb); }
                const float ssq = wave_sum(lane < 48 ? sa : 0.f), sskv = wave_sum((lane >= 48 ? sa : 0.f) + sb);
                const float rq = __builtin_amdgcn_rsqf(ssq * (1.f / QL) + EPS), rkv = __builtin_amdgcn_rsqf(sskv * (1.f / KVL) + EPS);
                const float* ga = lane < 48 ? p.qa_g + 8 * lane : p.kva_g + 8 * (lane - 48); const float ra = lane < 48 ? rq : rkv;
                const f32x4 g0 = *(const f32x4*)ga, g1 = *(const f32x4*)(ga + 4);
                u32x4 w; w.x = cvt_pk_bf16(va[0] * g0.x * ra, va[1] * g0.y * ra); w.y = cvt_pk_bf16(va[2] * g0.z * ra, va[3] * g0.w * ra); w.z = cvt_pk_bf16(va[4] * g1.x * ra, va[5] * g1.y * ra); w.w = cvt_pk_bf16(va[6] * g1.z * ra, va[7] * g1.w * ra);
                bf16_t* dst = lane < 48 ? CQN + (size_t)row * QL + 8 * lane : CKVN + (size_t)row * KVL + 8 * (lane - 48);
                *(u32x4*)dst = w;
                if (lane < 16) { const f32x4 h0 = *(const f32x4*)(p.kva_g + 128 + 8 * lane), h1 = *(const f32x4*)(p.kva_g + 132 + 8 * lane);
                    u32x4 w2; w2.x = cvt_pk_bf16(vb[0] * h0.x * rkv, vb[1] * h0.y * rkv); w2.y = cvt_pk_bf16(vb[2] * h0.z * rkv, vb[3] * h0.w * rkv); w2.z = cvt_pk_bf16(vb[4] * h1.x * rkv, vb[5] * h1.y * rkv); w2.w = cvt_pk_bf16(vb[6] * h1.z * rkv, vb[7] * h1.w * rkv);
                    *(u32x4*)(CKVN + (size_t)row * KVL + 128 + 8 * lane) = w2; }
            }
            if (lane < 32) {
                const float ang = (float)pos[k] * p.inv_freq[lane];
                const double ad = (double)ang; const double kq = rint(ad * 0.15915494309189535); const float red = (float)(ad - kq * 6.283185307179586);
                const float cs = __cosf(red), sn = __sinf(red);
                TAB[(size_t)row * 64 + lane] = cs; TAB[(size_t)row * 64 + 32 + lane] = sn;
                *(unsigned*)(KR + (size_t)row * 64 + 2 * lane) = cvt_pk_bf16(kx1[k] * cs - kx2[k] * sn, kx2[k] * cs + kx1[k] * sn);
            }
            __builtin_amdgcn_sched_barrier(0);
        }
    } }
    GRID_SYNC();
    { pg8::Gemm g{CQN, Wuq, M, 1536, QL}; S.init(M, 1536, G, bid); pg8::EpiQ E{Q, TAB}; pg8::gemm_phase(ldsl, g, S, E); }
    {
        const int tail0 = (64 * 6) % G;
        if (tail0 != 0 && bid >= tail0) { PHASE_IDS(); const int tb = bid - tail0, nb = G - tail0, tgw = tb * NWAVES + wave, TNGW = nb * NWAVES;
            tr_job<TR_PLAIN>(p.w_oa, nullptr, 1024, 1024, 1024, Woa, scr, lane, tgw, TNGW);
            tr_job<TR_PLAIN>(p.w_out, nullptr, 1024, 1024, 1024, Wout, scr, lane, tgw, TNGW);
    for (int idx = tb * NTHREADS + tid; idx < 65536; idx += nb * NTHREADS) {
            const int n = idx & 1023, c8 = idx >> 10, g = c8 >> 4, cb = (c8 & 15) * 8;
            float a[8];
    #pragma unroll
            for (int i = 0; i < 8; ++i) a[i] = 0.f;
            for (int j0 = 0; j0 < 128; j0 += 8) { float w[8]; f32x4 pw[8][2];
    #pragma unroll
                for (int jj = 0; jj < 8; ++jj) w[jj] = p.w_op[(size_t)(g * 128 + j0 + jj) * 1024 + n] * p.pool_scale[g * 128 + j0 + jj];
    #pragma unroll
                for (int i = 0; i < 8; ++i) { pw[i][0] = *(const f32x4*)(p.pool_w + (size_t)(g * 128 + cb + i) * 128 + j0); pw[i][1] = *(const f32x4*)(p.pool_w + (size_t)(g * 128 + cb + i) * 128 + j0 + 4); }
    #pragma unroll
                for (int i = 0; i < 8; ++i)
    #pragma unroll
                    for (int jj = 0; jj < 8; ++jj) a[i] = fmaf(pw[i][jj >> 2][jj & 3], w[jj], a[i]); }
            u32x4 o; o.x = cvt_pk_bf16(a[0], a[1]); o.y = cvt_pk_bf16(a[2], a[3]); o.z = cvt_pk_bf16(a[4], a[5]); o.w = cvt_pk_bf16(a[6], a[7]);
            *(u32x4*)(Wp + (size_t)n * 512 + c8 * 8) = o;
        }
        }
        else if (tail0 == 0) { PHASE_IDS(); const int tb = bid, nb = G;
            tr_job<TR_PLAIN>(p.w_oa, nullptr, 1024, 1024, 1024, Woa, scr, lane, gw, NGW);
            tr_job<TR_PLAIN>(p.w_out, nullptr, 1024, 1024, 1024, Wout, scr, lane, gw, NGW);
    for (int idx = tb * NTHREADS + tid; idx < 65536; idx += nb * NTHREADS) {
            const int n = idx & 1023, c8 = idx >> 10, g = c8 >> 4, cb = (c8 & 15) * 8;
            float a[8];
    #pragma unroll
            for (int i = 0; i < 8; ++i) a[i] = 0.f;
            for (int j0 = 0; j0 < 128; j0 += 8) { float w[8]; f32x4 pw[8][2];
    #pragma unroll
                for (int jj = 0; jj < 8; ++jj) w[jj] = p.w_op[(size_t)(g * 128 + j0 + jj) * 1024 + n] * p.pool_scale[g * 128 + j0 + jj];
    #pragma unroll
                for (int i = 0; i < 8; ++i) { pw[i][0] = *(const f32x4*)(p.pool_w + (size_t)(g * 128 + cb + i) * 128 + j0); pw[i][1] = *(const f32x4*)(p.pool_w + (size_t)(g * 128 + cb + i) * 128 + j0 + 4); }
    #pragma unroll
                for (int i = 0; i < 8; ++i)
    #pragma unroll
                    for (int jj = 0; jj < 8; ++jj) a[i] = fmaf(pw[i][jj >> 2][jj & 3], w[jj], a[i]); }
            u32x4 o; o.x = cvt_pk_bf16(a[0], a[1]); o.y = cvt_pk_bf16(a[2], a[3]); o.z = cvt_pk_bf16(a[4], a[5]); o.w = cvt_pk_bf16(a[6], a[7]);
            *(u32x4*)(Wp + (size_t)n * 512 + c8 * 8) = o;
        }
        }
    }
    __syncthreads();
    { pg8::Gemm g{CKVN, Wukv, M, 2048, KVL}; S.init(M, 2048, G, bid); pg8::EpiBf16 E{KV, 2048}; pg8::gemm_phase(ldsl, g, S, E); }
    GRID_SYNC();
    {
        const int vcu = (bid & 7) * (G >> 3) + (bid >> 3);
        for (int it = vcu; it < NB * NH * (SEQ / 256); it += G) {
            const int qb = it & 7, h = (it >> 3) & 7, b = it >> 6;
            const size_t tok0 = (size_t)b * SEQ;
            att::attn_body(Q + (tok0 + qb * 256) * 1536 + h * 192, KV + tok0 * 2048 + h * 128, KR + tok0 * 64, KV + tok0 * 2048 + 1024 + h * 128,
                           O + (tok0 + qb * 256) * 1024 + h * 128, SEQ, (char*)lds);
            __syncthreads();
        }
    }
    GRID_SYNC();
    { pg8::Gemm g{XN, Win + (size_t)1280 * 1024, M, 2048, 1024}; pg8::GateOrder GO; GO.s.init(M, 1024, G, bid); pg8::EpiGate E{Gt}; pg8::gemm_phase(ldsl, g, GO, E); }
    { pg8::Gemm g{O, Woa, M, 1024, 1024}; S.init(M, 1024, G, bid); pg8::EpiT1 E{Gt, F}; pg8::gemm_phase(ldsl, g, S, E); }
    { pg8::Gemm g{DP, Wp, M, 1024, 512}; S.init(M, 1024, G, bid); pg8::EpiMX E{Gt, F, MXb}; pg8::gemm_phase(ldsl, g, S, E); }
    GRID_SYNC();
    { pg8::Gemm g{MXb, Wout, M, 1024, 1024}; S.init(M, 1024, G, bid);
      pg8::EpiResNorm<false, false> E{nullptr, (bf16_t*)X, nullptr, XN, 1.0f, p.mix_post, p.f2_pre, pg8::PanelSumSq{xbuf0 + (size_t)M * 8, cnt0 + 2 * 4096}, pg8::PanelSumSq{xbuf0 + (size_t)M * 12, cnt0 + 3 * 4096}}; pg8::gemm_phase(ldsl, g, S, E); }
    GRID_SYNC();
    { pg8::Gemm g{XN, Wgu, M, 5632, 1024}; S.init(M, 5632, G, bid); pg8::EpiSwiGLU E{H}; pg8::gemm_phase(ldsl, g, S, E); }
    GRID_SYNC();
    { pg8::Gemm g{H, Wd, M, 1024, DFF}; S.init(M, 1024, G, bid);
      pg8::EpiResNorm<true, false> E{nullptr, (bf16_t*)X, X, nullptr, 0.5f, p.f2_post, p.final_g, pg8::PanelSumSq{xbuf0 + (size_t)M * 16, cnt0 + 4 * 4096}, pg8::PanelSumSq{xbuf0 + (size_t)M * 20, cnt0 + 5 * 4096}}; pg8::gemm_phase(ldsl, g, S, E); }
}

extern "C" void kernel_launch(void* const* d_in, const int* in_sizes, int n_in, void* d_out, int out_size, void* d_ws, size_t ws_size, hipStream_t stream) {
    static int grid_blocks = 0;
    if (grid_blocks == 0) {
        if (n_in != 26 || in_sizes[0] != M * DM || out_size != M * DM || ws_size < WS_END) { fprintf(stderr, "kernel_launch: shape mismatch n_in %d in0 %d out %d ws %zu\n", n_in, n_in > 0 ? in_sizes[0] : -1, out_size, ws_size); grid_blocks = -1; return; }
        int dev = 0, cus = 0, per_cu = 0;
        (void)hipGetDevice(&dev);
        (void)hipDeviceGetAttribute(&cus, hipDeviceAttributeMultiprocessorCount, dev);
        if (hipFuncSetAttribute((const void*)fwd_megakernel, hipFuncAttributeMaxDynamicSharedMemorySize, LDS_BYTES) != hipSuccess) { fprintf(stderr, "kernel_launch: hipFuncSetAttribute failed\n"); grid_blocks = -1; return; }
        if (hipOccupancyMaxActiveBlocksPerMultiprocessor(&per_cu, (const void*)fwd_megakernel, NTHREADS, LDS_BYTES) != hipSuccess || per_cu < 1) { fprintf(stderr, "kernel_launch: occupancy query failed (%d)\n", per_cu); (void)hipGetLastError(); per_cu = 1; }
        grid_blocks = cus * 1;
        if (grid_blocks != 256) { fprintf(stderr, "kernel_launch: built for 256 CUs (one workgroup each), device has %d\n", cus); grid_blocks = -1; return; }
    }
    if (grid_blocks < 0) return;
    Params p{};
    p.x = (const float*)d_in[0]; p.pos = (const int*)d_in[1];
    p.f1_pre = (const float*)d_in[2]; p.f1_wg = (const float*)d_in[3]; p.f1_wu = (const float*)d_in[4]; p.f1_wd = (const float*)d_in[5]; p.f1_post = (const float*)d_in[6];
    p.mix_pre = (const float*)d_in[7]; p.w_in = (const float*)d_in[8]; p.qa_g = (const float*)d_in[9]; p.w_uq = (const float*)d_in[10]; p.kva_g = (const float*)d_in[11];
    p.w_uk = (const float*)d_in[12]; p.w_uv = (const float*)d_in[13]; p.w_oa = (const float*)d_in[14]; p.pool_w = (const float*)d_in[15]; p.pool_scale = (const float*)d_in[16];
    p.w_op = (const float*)d_in[17]; p.w_out = (const float*)d_in[18]; p.mix_post = (const float*)d_in[19];
    p.f2_pre = (const float*)d_in[20]; p.f2_wg = (const float*)d_in[21]; p.f2_wu = (const float*)d_in[22]; p.f2_wd = (const float*)d_in[23]; p.f2_post = (const float*)d_in[24]; p.final_g = (const float*)d_in[25];
    p.out = (float*)d_out; p.ws = (unsigned char*)d_ws;
    for (int i = 0; i < 32; ++i) p.inv_freq[i] = (float)pow(10000.0, -(2.0 * i) / 64.0);
    if (hipMemsetAsync((char*)d_ws + OFF_BAR, 0, CTL_BYTES, stream) != hipSuccess) { fprintf(stderr, "kernel_launch: memset failed\n"); return; }
    void* args[] = {&p};
    hipError_t e = hipLaunchCooperativeKernel((const void*)fwd_megakernel, dim3(grid_blocks), dim3(NTHREADS), args, LDS_BYTES, stream);
    if (e != hipSuccess) fprintf(stderr, "cooperative launch failed: %s (grid %d)\n", hipGetErrorString(e), grid_blocks);
}
```

```cpp
#include <hip/hip_runtime.h>
#include <hip/hip_cooperative_groups.h>
#include <cstdio>
#include <cmath>
#include <cstdint>
namespace cg = cooperative_groups;

#define LAS __attribute__((address_space(3)))
typedef unsigned short bf16_t;
typedef short bf16x8 __attribute__((ext_vector_type(8)));
typedef short s16x4 __attribute__((ext_vector_type(4)));
typedef float f32x2 __attribute__((ext_vector_type(2)));
typedef float f32x4 __attribute__((ext_vector_type(4)));
typedef float f32x16 __attribute__((ext_vector_type(16)));
typedef unsigned u32x4 __attribute__((ext_vector_type(4)));
typedef unsigned u32x2 __attribute__((ext_vector_type(2)));

constexpr int DM = 1024, NB = 8, SEQ = 2048, M = NB * SEQ, NH = 8, QL = 384, KVL = 256, DFF = 2816, INW = 3264;
constexpr float EPS = 1e-6f;
constexpr int NTHREADS = 512, NWAVES = 8;
constexpr int LDS_STAGE = 131072, LDS_BYTES = LDS_STAGE + 16;

constexpr size_t MiB = 1048576;
constexpr size_t OFF_WGU = 0;
constexpr size_t OFF_WD = OFF_WGU + (size_t)5632 * 1024 * 2;
constexpr size_t OFF_WIN = OFF_WD + (size_t)1024 * 2816 * 2;
constexpr size_t OFF_WUQ = OFF_WIN + (size_t)3328 * 1024 * 2;
constexpr size_t OFF_WUKV = OFF_WUQ + (size_t)1536 * 384 * 2;
constexpr size_t OFF_WOA = OFF_WUKV + (size_t)2048 * 256 * 2;
constexpr size_t OFF_WP = OFF_WOA + (size_t)1024 * 1024 * 2;
constexpr size_t OFF_WOUT = OFF_WP + (size_t)1024 * 512 * 2;
constexpr size_t OFF_XN = OFF_WOUT + (size_t)1024 * 1024 * 2;
constexpr size_t OFF_R = OFF_XN + 32 * MiB;
constexpr size_t OFF_F = OFF_R;
constexpr size_t OFF_ZF = OFF_R;
constexpr size_t OFF_KV = OFF_R;
constexpr size_t OFF_H = OFF_R + 64 * MiB;
constexpr size_t OFF_O = OFF_R + 64 * MiB;
constexpr size_t OFF_CQN = OFF_R + 80 * MiB;
constexpr size_t OFF_CKVN = OFF_R + 92 * MiB;
constexpr size_t OFF_TAB = OFF_R + 100 * MiB;
constexpr size_t OFF_Q = OFF_R + 104 * MiB;
constexpr size_t OFF_KR = OFF_R + 152 * MiB;
constexpr size_t OFF_G = OFF_R + 96 * MiB;
constexpr size_t OFF_DP = OFF_R + 176 * MiB;
constexpr size_t WS_END = OFF_R + 192 * MiB;
constexpr size_t OFF_BAR = WS_END, OFF_CNT = OFF_BAR + 16384, CTL_BYTES = 16384 + 6 * 16384, OFF_XBUF = OFF_BAR + CTL_BYTES;
static_assert(OFF_XBUF + 6 * (size_t)M * 16 <= 256 * MiB, "workspace");

struct Params {
    const float* x; const int* pos;
    const float *f1_pre, *f1_wg, *f1_wu, *f1_wd, *f1_post;
    const float *mix_pre, *w_in, *qa_g, *w_uq, *kva_g, *w_uk, *w_uv, *w_oa, *pool_w, *pool_scale, *w_op, *w_out, *mix_post;
    const float *f2_pre, *f2_wg, *f2_wu, *f2_wd, *f2_post, *final_g;
    float* out; unsigned char* ws;
    float inv_freq[32];
};

typedef __bf16 bf16x2_t __attribute__((ext_vector_type(2)));
__device__ __forceinline__ unsigned cvt_pk_bf16(float lo, float hi) { const f32x2 v = {lo, hi}; const bf16x2_t r = __builtin_convertvector(v, bf16x2_t); return __builtin_bit_cast(unsigned, r); }
__device__ __forceinline__ float bf_lo(unsigned w) { return __uint_as_float(w << 16); }
__device__ __forceinline__ float bf_hi(unsigned w) { return __uint_as_float(w & 0xffff0000u); }
__device__ __forceinline__ float sigmoidf_fast(float z) { return __builtin_amdgcn_rcpf(1.f + __builtin_amdgcn_exp2f(-1.4426950408889634f * z)); }
__device__ __forceinline__ int fresh_tid() { int t = threadIdx.x; asm volatile("" : "+v"(t)); return t; }
__device__ __forceinline__ float wave_sum(float v) {
#pragma unroll
    for (int o = 1; o < 64; o <<= 1) v += __shfl_xor(v, o);
    return v;
}

namespace pg8 {
constexpr int BM = 256, BK = 64, HALF = 128, HTB = HALF * BK * 2, STAGE_BYTES = 8 * HTB, NXCD = 8, WGM = 4;
__host__ __device__ __forceinline__ int lds_byte(int r, int c) { const int st = (r >> 4) * 2 + (c >> 5), rr = r & 15, cc = c & 31, ob = rr * 64 + cc * 2; return st * 1024 + (ob ^ (((ob >> 9) & 1) << 5)); }
__host__ __device__ __forceinline__ void stage_rc(int b, int& R, int& C) { const int st = b / 1024, sb = b % 1024, swz = sb ^ (((sb >> 9) & 1) << 5); R = (st >> 1) * 16 + swz / 64; C = (st & 1) * 32 + (swz % 64) / 2; }
__host__ __device__ __forceinline__ int perm32(int rho) { const int n = rho >> 4, i = rho & 15; return 8 * (i >> 2) + 4 * n + (i & 3); }
struct Unit { int pm, pn; };
struct Gemm { const bf16_t* A; const bf16_t* Bt; int M, N, K; };
struct StaticOrder {
    int nM, nN, nwg, G, c;
    __device__ void init(int M_, int N_, int G_, int c_) { nM = M_ / BM; nN = N_ / BM; nwg = nM * nN; G = G_; c = c_; }
    __device__ bool next(int i, Unit& u) const {
        const long L = (long)i * G + c; if (L >= nwg) return false;
        int wgid = (int)L; { const int q = nwg / NXCD, r = nwg % NXCD, xcd = wgid % NXCD, off = wgid / NXCD; wgid = (xcd < r ? xcd * (q + 1) : r * (q + 1) + (xcd - r) * q) + off; }
        const int nig = WGM * nN, gid = wgid / nig, fm = gid * WGM, gsz = (nM - fm) < WGM ? (nM - fm) : WGM;
        u.pm = fm + ((wgid % nig) % gsz); u.pn = (wgid % nig) / gsz; return true;
    }
};

struct GateOrder { StaticOrder s;
    __device__ bool next(int i, Unit& u) const { if (i >= 2) return false; Unit b; if (!s.next(0, b)) return false; u.pm = b.pm; u.pn = b.pn + 4 * i; return true; } };
template <class Epi, class Sched>
__device__ __forceinline__ void gemm_phase(LAS unsigned char* lds, const Gemm g, const Sched& S, const Epi& E) {
    const int tid = fresh_tid(), wid = __builtin_amdgcn_readfirstlane(tid >> 6), lane = tid & 63, wr = wid >> 2, wc = wid & 3, fr = lane & 15, fq = lane >> 4;
    const int K = g.K, nt = K / BK;
    unsigned voffA, voffB;
    { int R, C; stage_rc(tid * 16, R, C); const int Rb = Epi::PERM ? ((R & ~31) + perm32(R & 31)) : R;
      voffA = (unsigned)(R * K + C) * 2u; voffB = (unsigned)(Rb * K + C) * 2u; }
    const size_t rstep64 = (size_t)64 * K * 2;
    const size_t kstep = (size_t)(BK * 2);
    const size_t hstep = (size_t)HALF * K * 2;
    const size_t tstep = 2 * hstep;
    const unsigned ldsw = (unsigned)wid * 1024u;
    const int aoff = lds_byte(wr * 64 + fr, fq * 8), boff = lds_byte(wc * 32 + fr, fq * 8);
#define PG8_SA(b, h) (((b) * 2 + (h)) * HTB)
#define PG8_SB(b, h) ((4 + (b) * 2 + (h)) * HTB)
#define PG8_STAGE(bufoff, gbase, voff) do { _Pragma("unroll") for (int _i = 0; _i < 2; ++_i) \
        __builtin_amdgcn_global_load_lds((const unsigned*)((const char*)(gbase) + _i * rstep64 + (voff)), (LAS unsigned*)(lds + (bufoff) + ldsw + _i * 8192), 16, 0, 0); } while (0)
#define PG8_LDA(dst, b, h) do { _Pragma("unroll") for (int m = 0; m < 4; ++m) _Pragma("unroll") for (int k = 0; k < 2; ++k) dst[m][k] = *(const LAS bf16x8*)(lds + PG8_SA(b, h) + aoff + m * 2048 + k * 1024); } while (0)
#define PG8_LDB(dst, b, h) do { _Pragma("unroll") for (int n = 0; n < 2; ++n) _Pragma("unroll") for (int k = 0; k < 2; ++k) dst[n][k] = *(const LAS bf16x8*)(lds + PG8_SB(b, h) + boff + n * 2048 + k * 1024); } while (0)
#define PG8_MMA(ai, bj, At, Bt) do { __builtin_amdgcn_s_setprio(1); _Pragma("unroll") for (int m = 0; m < 4; ++m) _Pragma("unroll") for (int n = 0; n < 2; ++n) _Pragma("unroll") for (int k = 0; k < 2; ++k) \
        acc[ai][bj][m][n] = __builtin_amdgcn_mfma_f32_16x16x32_bf16(Bt[n][k], At[m][k], acc[ai][bj][m][n], 0, 0, 0); __builtin_amdgcn_s_setprio(0); } while (0)
#define PG8_WAIT_V(n) asm volatile("s_waitcnt vmcnt(" #n ")" ::: "memory")
#define PG8_WAIT_L(n) asm volatile("s_waitcnt lgkmcnt(" #n ")" ::: "memory")
#define PG8_BAR __builtin_amdgcn_s_barrier()
#define PG8_SCHED __builtin_amdgcn_sched_barrier(0)
    Unit cur, nxt; int ui = 0;
    if (!S.next(0, cur)) return;
    f32x4 acc[2][2][4][2];
#pragma unroll
    for (int a = 0; a < 2; ++a)
#pragma unroll
        for (int b = 0; b < 2; ++b)
#pragma unroll
            for (int m = 0; m < 4; ++m)
#pragma unroll
                for (int n = 0; n < 2; ++n) acc[a][b][m][n] = (f32x4){0.f, 0.f, 0.f, 0.f};
    bf16x8 At[4][2], B0[2][2], B1[2][2];
    const char* cA = (const char*)g.A + (size_t)cur.pm * tstep; const char* cB = (const char*)g.Bt + (size_t)cur.pn * tstep;
    PG8_STAGE(PG8_SB(0, 0), cB, voffB); PG8_STAGE(PG8_SA(0, 0), cA, voffA); PG8_STAGE(PG8_SB(0, 1), cB + hstep, voffB); PG8_STAGE(PG8_SA(0, 1), cA + hstep, voffA);
    if (wr == 1) PG8_BAR;
    PG8_WAIT_V(4); PG8_BAR;
    PG8_STAGE(PG8_SB(1, 0), cB + kstep, voffB); PG8_STAGE(PG8_SA(1, 0), cA + kstep, voffA); PG8_STAGE(PG8_SB(1, 1), cB + hstep + kstep, voffB);
    PG8_WAIT_V(6); PG8_BAR;
    for (;;) {
        const bool has_next = S.next(ui + 1, nxt);
        const char* nA = has_next ? (const char*)g.A + (size_t)nxt.pm * tstep : cA; const char* nB = has_next ? (const char*)g.Bt + (size_t)nxt.pn * tstep : cB;
        for (int t = 0; t < nt; t += 2) {
            const bool last = (t == nt - 2);
            const char* a1 = cA + (size_t)(t + 1) * kstep;
            const char* a2 = last ? nA : cA + (size_t)(t + 2) * kstep; const char* b2 = last ? nB : cB + (size_t)(t + 2) * kstep;
            const char* a3 = a2 + kstep; const char* b3 = b2 + kstep;
            PG8_LDB(B0, 0, 0); PG8_SCHED; PG8_LDA(At, 0, 0); PG8_STAGE(PG8_SA(1, 1), a1 + hstep, voffA);
            PG8_WAIT_L(8); PG8_BAR; PG8_WAIT_L(0); PG8_MMA(0, 0, At, B0); PG8_BAR; PG8_SCHED;
            PG8_LDB(B1, 0, 1); PG8_STAGE(PG8_SB(0, 0), b2, voffB);
            PG8_BAR; PG8_WAIT_L(0); PG8_MMA(0, 1, At, B1); PG8_BAR;
            PG8_LDA(At, 0, 1); PG8_STAGE(PG8_SA(0, 0), a2, voffA);
            PG8_BAR; PG8_WAIT_L(0); PG8_MMA(1, 0, At, B0); PG8_BAR; PG8_SCHED;
            PG8_STAGE(PG8_SB(0, 1), b2 + hstep, voffB);
            PG8_WAIT_V(6); PG8_BAR; PG8_MMA(1, 1, At, B1); PG8_BAR;
            PG8_LDB(B0, 1, 0); PG8_SCHED; PG8_LDA(At, 1, 0); PG8_STAGE(PG8_SA(0, 1), a2 + hstep, voffA);
            PG8_WAIT_L(8); PG8_BAR; PG8_WAIT_L(0); PG8_MMA(0, 0, At, B0); PG8_BAR; PG8_SCHED;
            PG8_LDB(B1, 1, 1); PG8_STAGE(PG8_SB(1, 0), b3, voffB);
            PG8_BAR; PG8_WAIT_L(0); PG8_MMA(0, 1, At, B1); PG8_BAR;
            PG8_LDA(At, 1, 1); PG8_STAGE(PG8_SA(1, 0), a3, voffA);
            PG8_BAR; PG8_WAIT_L(0); PG8_MMA(1, 0, At, B0); PG8_BAR; PG8_SCHED;
            PG8_STAGE(PG8_SB(1, 1), b3 + hstep, voffB);
            PG8_WAIT_V(6); PG8_BAR; PG8_MMA(1, 1, At, B1); PG8_BAR;
        }
        if constexpr (!Epi::AFTER_DRAIN) { const int t2 = fresh_tid(); E(acc, cur, wr, wc, t2 & 15, (t2 >> 4) & 3); }
        if (!has_next) break;
#pragma unroll
        for (int a = 0; a < 2; ++a)
#pragma unroll
            for (int b = 0; b < 2; ++b)
#pragma unroll
                for (int m = 0; m < 4; ++m)
#pragma unroll
                    for (int n = 0; n < 2; ++n) acc[a][b][m][n] = (f32x4){0.f, 0.f, 0.f, 0.f};
        cur = nxt; cA = nA; cB = nB; ++ui;
    }
    PG8_WAIT_V(0);
    if (wr == 0) PG8_BAR;
    PG8_BAR;
    if constexpr (Epi::AFTER_DRAIN) { const int t2 = fresh_tid(); E.fused(acc, cur, wr, wc, t2 & 15, (t2 >> 4) & 3, lds, t2 >> 6, t2 & 63); }
#undef PG8_SA
#undef PG8_SB
#undef PG8_STAGE
#undef PG8_LDA
#undef PG8_LDB
#undef PG8_MMA
#undef PG8_WAIT_V
#undef PG8_WAIT_L
#undef PG8_BAR
#undef PG8_SCHED
}

typedef f32x4 Acc[2][2][4][2];
struct EpiF32 {
    static constexpr bool PERM = false, AFTER_DRAIN = false;
    float* C; int ldc;
    __device__ __forceinline__ void operator()(const Acc& acc, const Unit& u, int wr, int wc, int fr, int fq) const {
        const int row0 = u.pm * BM + wr * 64 + fr, col0 = u.pn * BM + wc * 32 + 4 * fq;
#pragma unroll
        for (int ai = 0; ai < 2; ++ai)
#pragma unroll
            for (int m = 0; m < 4; ++m) { float* rowp = C + (size_t)(row0 + ai * HALF + m * 16) * ldc + col0;
#pragma unroll
                for (int bj = 0; bj < 2; ++bj)
#pragma unroll
                    for (int n = 0; n < 2; ++n) *(f32x4*)(rowp + bj * HALF + n * 16) = acc[ai][bj][m][n]; }
    }
};
struct EpiBf16 {
    static constexpr bool PERM = true, AFTER_DRAIN = false;
    bf16_t* O; int ldc;
    __device__ __forceinline__ void operator()(const Acc& acc, const Unit& u, int wr, int wc, int fr, int fq) const {
        const int row0 = u.pm * BM + wr * 64 + fr, col0 = u.pn * BM + wc * 32 + 8 * fq;
#pragma unroll
        for (int ai = 0; ai < 2; ++ai)
#pragma unroll
            for (int m = 0; m < 4; ++m) { bf16_t* rowp = O + (size_t)(row0 + ai * HALF + m * 16) * ldc + col0;
#pragma unroll
                for (int bj = 0; bj < 2; ++bj) { const f32x4 v0 = acc[ai][bj][m][0], v1 = acc[ai][bj][m][1];
                    u32x4 w; w.x = cvt_pk_bf16(v0[0], v0[1]); w.y = cvt_pk_bf16(v0[2], v0[3]); w.z = cvt_pk_bf16(v1[0], v1[1]); w.w = cvt_pk_bf16(v1[2], v1[3]);
                    *(u32x4*)(rowp + bj * HALF) = w; } }
    }
};
struct EpiSwiGLU {
    static constexpr bool PERM = true, AFTER_DRAIN = false;
    bf16_t* H;
    __device__ __forceinline__ void operator()(const Acc& acc, const Unit& u, int wr, int wc, int fr, int fq) const {
        const int row0 = u.pm * BM + wr * 64 + fr, col0 = u.pn * HALF + wc * 32 + 8 * fq;
#pragma unroll
        for (int ai = 0; ai < 2; ++ai)
#pragma unroll
            for (int m = 0; m < 4; ++m) { bf16_t* rowp = H + (size_t)(row0 + ai * HALF + m * 16) * DFF + col0;
                float h[8];
#pragma unroll
                for (int n = 0; n < 2; ++n)
#pragma unroll
                    for (int j = 0; j < 4; ++j) { const float gt = acc[ai][0][m][n][j], up = acc[ai][1][m][n][j]; h[n * 4 + j] = gt * sigmoidf_fast(gt) * up; }
                u32x4 w; w.x = cvt_pk_bf16(h[0], h[1]); w.y = cvt_pk_bf16(h[2], h[3]); w.z = cvt_pk_bf16(h[4], h[5]); w.w = cvt_pk_bf16(h[6], h[7]);
                *(u32x4*)rowp = w; }
    }
};
struct EpiGate {
    static constexpr bool PERM = true, AFTER_DRAIN = false;
    bf16_t* G;
    __device__ __forceinline__ void operator()(const Acc& acc, const Unit& u, int wr, int wc, int fr, int fq) const {
        const int row0 = u.pm * BM + wr * 64 + fr, col0 = u.pn * BM + wc * 32 + 8 * fq;
#pragma unroll
        for (int ai = 0; ai < 2; ++ai)
#pragma unroll
            for (int m = 0; m < 4; ++m) { bf16_t* rowp = G + (size_t)(row0 + ai * HALF + m * 16) * 2048 + col0;
#pragma unroll
                for (int bj = 0; bj < 2; ++bj) { const f32x4 v0 = acc[ai][bj][m][0], v1 = acc[ai][bj][m][1];
                    u32x4 w; w.x = cvt_pk_bf16(sigmoidf_fast(v0[0]), sigmoidf_fast(v0[1])); w.y = cvt_pk_bf16(sigmoidf_fast(v0[2]), sigmoidf_fast(v0[3]));
                    w.z = cvt_pk_bf16(sigmoidf_fast(v1[0]), sigmoidf_fast(v1[1])); w.w = cvt_pk_bf16(sigmoidf_fast(v1[2]), sigmoidf_fast(v1[3]));
                    *(u32x4*)(rowp + bj * HALF) = w; } }
    }
};
struct EpiQ {
    static constexpr bool PERM = true, AFTER_DRAIN = false;
    bf16_t* Q; const float* TAB;
    __device__ __forceinline__ void operator()(const Acc& acc, const Unit& u, int wr, int wc, int fr, int fq) const {
        const int row0 = u.pm * BM + wr * 64 + fr, col0 = u.pn * BM + wc * 32 + 8 * fq;
#pragma unroll
        for (int ai = 0; ai < 2; ++ai)
#pragma unroll
            for (int m = 0; m < 4; ++m) { const int row = row0 + ai * HALF + m * 16; bf16_t* rowp = Q + (size_t)row * 1536 + col0;
#pragma unroll
                for (int bj = 0; bj < 2; ++bj) { f32x4 v0 = acc[ai][bj][m][0], v1 = acc[ai][bj][m][1];
                    const int c = col0 + bj * HALF, w = c % 192;
                    if (w >= 128) { const int i0 = (w - 128) >> 1; const f32x4 cs = *(const f32x4*)(TAB + (size_t)row * 64 + i0), sn = *(const f32x4*)(TAB + (size_t)row * 64 + 32 + i0);
                        f32x4 r0, r1;
                        r0[0] = v0[0] * cs[0] - v0[1] * sn[0]; r0[1] = v0[1] * cs[0] + v0[0] * sn[0];
                        r0[2] = v0[2] * cs[1] - v0[3] * sn[1]; r0[3] = v0[3] * cs[1] + v0[2] * sn[1];
                        r1[0] = v1[0] * cs[2] - v1[1] * sn[2]; r1[1] = v1[1] * cs[2] + v1[0] * sn[2];
                        r1[2] = v1[2] * cs[3] - v1[3] * sn[3]; r1[3] = v1[3] * cs[3] + v1[2] * sn[3];
                        v0 = r0; v1 = r1; }
                    u32x4 wv; wv.x = cvt_pk_bf16(v0[0], v0[1]); wv.y = cvt_pk_bf16(v0[2], v0[3]); wv.z = cvt_pk_bf16(v1[0], v1[1]); wv.w = cvt_pk_bf16(v1[2], v1[3]);
                    *(u32x4*)(rowp + bj * HALF) = wv; } }
    }
};
struct EpiT1 {
    static constexpr bool PERM = true, AFTER_DRAIN = false;
    const bf16_t* G; bf16_t* F;
    __device__ __forceinline__ void operator()(const Acc& acc, const Unit& u, int wr, int wc, int fr, int fq) const {
        const int row0 = u.pm * BM + wr * 64 + fr, col0 = u.pn * BM + wc * 32 + 8 * fq;
#pragma unroll
        for (int ai = 0; ai < 2; ++ai)
#pragma unroll
            for (int m = 0; m < 4; ++m) { const int row = row0 + ai * HALF + m * 16;
#pragma unroll
                for (int bj = 0; bj < 2; ++bj) { const f32x4 v0 = acc[ai][bj][m][0], v1 = acc[ai][bj][m][1]; const int c = col0 + bj * HALF;
                    const u32x4 gw = *(const u32x4*)(G + (size_t)row * 2048 + c);
                    u32x4 wv;
                    wv.x = cvt_pk_bf16(v0[0] * bf_lo(gw.x), v0[1] * bf_hi(gw.x)); wv.y = cvt_pk_bf16(v0[2] * bf_lo(gw.y), v0[3] * bf_hi(gw.y));
                    wv.z = cvt_pk_bf16(v1[0] * bf_lo(gw.z), v1[1] * bf_hi(gw.z)); wv.w = cvt_pk_bf16(v1[2] * bf_lo(gw.w), v1[3] * bf_hi(gw.w));
                    *(u32x4*)(F + (size_t)row * 1024 + c) = wv; } }
    }
};
struct EpiMX {
    static constexpr bool PERM = true, AFTER_DRAIN = false;
    const bf16_t* G; const bf16_t* F; bf16_t* MX;
    __device__ __forceinline__ void operator()(const Acc& acc, const Unit& u, int wr, int wc, int fr, int fq) const {
        const int row0 = u.pm * BM + wr * 64 + fr, col0 = u.pn * BM + wc * 32 + 8 * fq;
#pragma unroll
        for (int ai = 0; ai < 2; ++ai)
#pragma unroll
            for (int m = 0; m < 4; ++m) { const int row = row0 + ai * HALF + m * 16;
#pragma unroll
                for (int bj = 0; bj < 2; ++bj) { const f32x4 v0 = acc[ai][bj][m][0], v1 = acc[ai][bj][m][1]; const int c = col0 + bj * HALF;
                    const u32x4 gw = *(const u32x4*)(G + (size_t)row * 2048 + 1024 + c);
                    const u32x4 tw = *(const u32x4*)(F + (size_t)row * 1024 + c);
                    u32x4 wv;
                    wv.x = cvt_pk_bf16(bf_lo(tw.x) + v0[0] * bf_lo(gw.x), bf_hi(tw.x) + v0[1] * bf_hi(gw.x)); wv.y = cvt_pk_bf16(bf_lo(tw.y) + v0[2] * bf_lo(gw.y), bf_hi(tw.y) + v0[3] * bf_hi(gw.y));
                    wv.z = cvt_pk_bf16(bf_lo(tw.z) + v1[0] * bf_lo(gw.z), bf_hi(tw.z) + v1[1] * bf_hi(gw.z)); wv.w = cvt_pk_bf16(bf_lo(tw.w) + v1[2] * bf_lo(gw.w), bf_hi(tw.w) + v1[3] * bf_hi(gw.w));
                    *(u32x4*)(MX + (size_t)row * 1024 + c) = wv; } }
    }
};

struct PanelSumSq {
    float* xbuf;
    unsigned* cnt;
    __device__ __forceinline__ void run(const Acc& v, const Unit& u, int wr, int wc, int fr, int fq, LAS unsigned char* lds, int wid, int lane) const {
        LAS float* P = (LAS float*)lds; LAS float* S = (LAS float*)(lds + 4096);
#pragma unroll
        for (int ai = 0; ai < 2; ++ai)
#pragma unroll
            for (int m = 0; m < 4; ++m) { float q = 0.f;
#pragma unroll
                for (int bj = 0; bj < 2; ++bj)
#pragma unroll
                    for (int n = 0; n < 2; ++n) { const f32x4 x = v[ai][bj][m][n]; q += (x[0] * x[0] + x[1] * x[1]) + (x[2] * x[2] + x[3] * x[3]); }
                q += __shfl_xor(q, 16); q += __shfl_xor(q, 32);
                if (fq == 0) P[(ai * HALF + wr * 64 + m * 16 + fr) * 4 + wc] = q; }
        asm volatile("s_waitcnt lgkmcnt(0)" ::: "memory"); __builtin_amdgcn_s_barrier(); asm volatile("" ::: "memory");
        const int row = wid * 32 + (lane & 31);
        if (lane < 32) { const float t = (P[row * 4 + 0] + P[row * 4 + 1]) + (P[row * 4 + 2] + P[row * 4 + 3]);
            __hip_atomic_store(xbuf + ((size_t)(u.pm * BM + row) * 4 + u.pn), t, __ATOMIC_RELAXED, __HIP_MEMORY_SCOPE_AGENT); }
        asm volatile("s_waitcnt vmcnt(0)" ::: "memory");
        if (lane == 0) __hip_atomic_fetch_add(cnt + 64 * u.pm, 1u, __ATOMIC_RELAXED, __HIP_MEMORY_SCOPE_AGENT);
        if (wid == 0) { unsigned sp = 0u;
            while ((unsigned)__builtin_amdgcn_readfirstlane(__hip_atomic_load(cnt + 64 * u.pm, __ATOMIC_RELAXED, __HIP_MEMORY_SCOPE_AGENT)) < 32u) { __builtin_amdgcn_s_sleep(1); if (++sp > (1u << 22)) break; }
            }
        asm volatile("s_waitcnt vmcnt(0) lgkmcnt(0)" ::: "memory"); __builtin_amdgcn_s_barrier(); asm volatile("" ::: "memory");
        if (lane < 32) { const float* slot = xbuf + (size_t)(u.pm * BM + row) * 4; float tot = 0.f;
#pragma unroll
            for (int t = 0; t < 4; ++t) tot += __hip_atomic_load(slot + t, __ATOMIC_RELAXED, __HIP_MEMORY_SCOPE_AGENT);
            S[row] = __builtin_amdgcn_rsqf(tot * (1.f / 1024.f) + EPS); }
        asm volatile("s_waitcnt lgkmcnt(0)" ::: "memory"); __builtin_amdgcn_s_barrier(); asm volatile("" ::: "memory");
    }
};
template <bool FINAL, bool BASEF32> struct EpiResNorm {
    static constexpr bool PERM = true, AFTER_DRAIN = true;
    const float* basef; bf16_t* xb; float* outf; bf16_t* xn; float wt; const float* gpost; const float* gnext; PanelSumSq st1, st2;
    __device__ __forceinline__ void operator()(const Acc&, const Unit&, int, int, int, int) const {}
    __device__ __forceinline__ void fused(Acc& acc, const Unit& u, int wr, int wc, int fr, int fq, LAS unsigned char* lds, int wid, int lane) const {
        const LAS float* S = (const LAS float*)(lds + 4096);
        const int col0 = u.pn * BM + wc * 32 + 8 * fq;
        st1.run(acc, u, wr, wc, fr, fq, lds, wid, lane);
#pragma unroll
        for (int ai = 0; ai < 2; ++ai)
#pragma unroll
            for (int m = 0; m < 4; ++m) { const int r = ai * HALF + wr * 64 + m * 16 + fr; const float sr = S[r] * wt;
                const size_t off = (size_t)(u.pm * BM + r) * 1024 + col0, xoff = (size_t)u.pm * 524288 + 262144 + (size_t)r * 1024 + col0;
#pragma unroll
                for (int bj = 0; bj < 2; ++bj) { f32x4 b0, b1;
                    if (BASEF32) { b0 = __builtin_nontemporal_load((const f32x4*)(basef + off + bj * HALF)); b1 = __builtin_nontemporal_load((const f32x4*)(basef + off + bj * HALF + 4)); }
                    else { const u32x4 w = __builtin_nontemporal_load((const u32x4*)(xb + xoff + bj * HALF)); b0 = (f32x4){bf_lo(w.x), bf_hi(w.x), bf_lo(w.y), bf_hi(w.y)}; b1 = (f32x4){bf_lo(w.z), bf_hi(w.z), bf_lo(w.w), bf_hi(w.w)}; }
                    const f32x4 g0 = *(const f32x4*)(gpost + col0 + bj * HALF), g1 = *(const f32x4*)(gpost + col0 + bj * HALF + 4);
                    acc[ai][bj][m][0] = b0 + acc[ai][bj][m][0] * g0 * sr; acc[ai][bj][m][1] = b1 + acc[ai][bj][m][1] * g1 * sr; }
                asm volatile("" : "+v"(acc[ai][0][m][0]), "+v"(acc[ai][0][m][1]), "+v"(acc[ai][1][m][0]), "+v"(acc[ai][1][m][1]));
                if (m & 1) asm volatile("" ::: "memory"); }
        st2.run(acc, u, wr, wc, fr, fq, lds, wid, lane);
#pragma unroll
        for (int ai = 0; ai < 2; ++ai)
#pragma unroll
            for (int m = 0; m < 4; ++m) { const int r = ai * HALF + wr * 64 + m * 16 + fr; const float sr = S[r];
                const size_t off = (size_t)(u.pm * BM + r) * 1024 + col0, xoff = (size_t)u.pm * 524288 + 262144 + (size_t)r * 1024 + col0;
#pragma unroll
                for (int bj = 0; bj < 2; ++bj) { const f32x4 x0 = acc[ai][bj][m][0], x1 = acc[ai][bj][m][1];
                    const f32x4 g0 = *(const f32x4*)(gnext + col0 + bj * HALF), g1 = *(const f32x4*)(gnext + col0 + bj * HALF + 4); const f32x4 o0 = x0 * g0 * sr, o1 = x1 * g1 * sr;
                    if (FINAL) { *(f32x4*)(outf + off + bj * HALF) = o0; *(f32x4*)(outf + off + bj * HALF + 4) = o1; }
                    else { u32x4 wx; wx.x = cvt_pk_bf16(x0[0], x0[1]); wx.y = cvt_pk_bf16(x0[2], x0[3]); wx.z = cvt_pk_bf16(x1[0], x1[1]); wx.w = cvt_pk_bf16(x1[2], x1[3]); *(u32x4*)(xb + xoff + bj * HALF) = wx;
                           u32x4 w; w.x = cvt_pk_bf16(o0[0], o0[1]); w.y = cvt_pk_bf16(o0[2], o0[3]); w.z = cvt_pk_bf16(o1[0], o1[1]); w.w = cvt_pk_bf16(o1[2], o1[3]); *(u32x4*)(xn + off + bj * HALF) = w; } }
                asm volatile("" ::: "memory"); }
    }
};
}

namespace att {
constexpr int NW = 8, QBLK = 32, KVBLK = 64;
constexpr float SCALE = 0.07216878364870322f;
constexpr float THR = 8.f;
constexpr int LDQ = 1536, LDKV = 2048, LDKR = 64, LDO = 1024;
constexpr int SHM_V = 64 * 128 * 2, SHM_K = 64 * 128 * 2, SHM_R = 64 * 64 * 2;
constexpr int NQL = 4;
constexpr int OFF_V = 0, OFF_K = 2 * SHM_V, OFF_RP = OFF_K + 2 * SHM_K, OFF_WS = OFF_RP + 2 * SHM_R, OFF_QL = OFF_WS + NW * 64 * 4, SHM_ATTN = OFF_QL + NW * NQL * 1024;
static_assert(SHM_ATTN <= LDS_STAGE, "lds");
#define KSWZ(row, colB) ((row) * 256 + ((colB) ^ (((row) & 15) << 4)))
#define RSWZ(row, colB) ((row) * 128 + ((colB) ^ ((((row) >> 1) & 7) << 4)))
#define SBAR() __builtin_amdgcn_sched_barrier(0)
__device__ __forceinline__ int crow(int r, int hi) { return (r & 3) + 8 * (r >> 2) + 4 * hi; }
__device__ __forceinline__ bf16x8 ld8(const bf16_t* p) { return *reinterpret_cast<const bf16x8*>(p); }

__device__ __forceinline__ void partialSM(f32x16& p0, f32x16& p1, float& m_reg, float& mn, float& alpha) {
    constexpr float C = SCALE * 1.4426950408889634f;
    float pmax = p0[0];
#pragma unroll
    for (int r = 1; r < 16; ++r) pmax = fmaxf(pmax, p0[r]);
#pragma unroll
    for (int r = 0; r < 16; ++r) pmax = fmaxf(pmax, p1[r]);
    { auto rr = __builtin_amdgcn_permlane32_swap(__float_as_uint(pmax), __float_as_uint(pmax), false, false);
      pmax = fmaxf(__uint_as_float(rr[0]), __uint_as_float(rr[1])); }
    if (__builtin_expect(__all(pmax - m_reg <= THR / SCALE), 1)) { mn = m_reg; alpha = 1.f; }
    else { mn = fmaxf(m_reg, pmax); alpha = __builtin_amdgcn_exp2f((m_reg - mn) * C); m_reg = mn; }
    float mnC = -mn * C;
#pragma unroll
    for (int r = 0; r < 16; ++r) p0[r] = fmaf(p0[r], C, mnC);
#pragma unroll
    for (int r = 0; r < 16; ++r) p1[r] = fmaf(p1[r], C, mnC);
#pragma unroll
    for (int r = 0; r < 16; ++r) p0[r] = __builtin_amdgcn_exp2f(p0[r]);
}
__device__ __forceinline__ void finishSM(f32x16& p0, f32x16& p1, float alpha, float& l_reg, bf16x8& pa0, bf16x8& pa1, bf16x8& pa2, bf16x8& pa3) {
#pragma unroll
    for (int r = 0; r < 16; ++r) p1[r] = __builtin_amdgcn_exp2f(p1[r]);
    float ps = 0;
#pragma unroll
    for (int r = 0; r < 16; ++r) ps += p0[r];
#pragma unroll
    for (int r = 0; r < 16; ++r) ps += p1[r];
    { auto rr = __builtin_amdgcn_permlane32_swap(__float_as_uint(ps), __float_as_uint(ps), false, false);
      ps = __uint_as_float(rr[0]) + __uint_as_float(rr[1]); }
    l_reg = l_reg * alpha + ps;
#define PK4(P, BASE, OUT) do { unsigned a0 = cvt_pk_bf16(P[BASE + 0], P[BASE + 1]), a1 = cvt_pk_bf16(P[BASE + 2], P[BASE + 3]);   \
    unsigned b0 = cvt_pk_bf16(P[BASE + 4], P[BASE + 5]), b1 = cvt_pk_bf16(P[BASE + 6], P[BASE + 7]);                              \
    auto r0 = __builtin_amdgcn_permlane32_swap(a0, b0, false, false); auto r1 = __builtin_amdgcn_permlane32_swap(a1, b1, false, false); \
    u32x4 w = {r0[0], r1[0], r0[1], r1[1]}; OUT = *reinterpret_cast<bf16x8*>(&w); } while (0)
    PK4(p0, 0, pa0); PK4(p0, 8, pa1); PK4(p1, 0, pa2); PK4(p1, 8, pa3);
#undef PK4
}
__device__ __forceinline__ void qkt(f32x16& p0, f32x16& p1, const char* Ks, const char* Rs, const bf16x8* qr, const char* ql, int r32, int hi) {
    p0 = f32x16{}; p1 = f32x16{};
#pragma unroll
    for (int d0 = 0; d0 < 8; ++d0) { int cb = (d0 * 16 + hi * 8) * 2;
        bf16x8 b0 = *reinterpret_cast<const bf16x8*>(Ks + KSWZ(r32, cb));
        bf16x8 b1 = *reinterpret_cast<const bf16x8*>(Ks + KSWZ(32 + r32, cb));
        p0 = __builtin_amdgcn_mfma_f32_32x32x16_bf16(b0, qr[d0], p0, 0, 0, 0);
        p1 = __builtin_amdgcn_mfma_f32_32x32x16_bf16(b1, qr[d0], p1, 0, 0, 0); }
#pragma unroll
    for (int d0 = 0; d0 < 4; ++d0) { int cb = (d0 * 16 + hi * 8) * 2;
        bf16x8 b0 = *reinterpret_cast<const bf16x8*>(Rs + RSWZ(r32, cb));
        bf16x8 b1 = *reinterpret_cast<const bf16x8*>(Rs + RSWZ(32 + r32, cb));
        const bf16x8 qv = *reinterpret_cast<const bf16x8*>(ql + d0 * 1024);
        p0 = __builtin_amdgcn_mfma_f32_32x32x16_bf16(b0, qv, p0, 0, 0, 0);
        p1 = __builtin_amdgcn_mfma_f32_32x32x16_bf16(b1, qv, p1, 0, 0, 0); }
}
__device__ __forceinline__ int v_st(int k, int c) { const int kk = (k & ~0xC) | ((k & 4) << 1) | ((k & 8) >> 1); return ((kk >> 3) * 4 + (c >> 5)) * 512 + ((kk & 7) * 32 + (c & 31)) * 2; }
__device__ __forceinline__ int v_rd_base(int lane) { return ((lane & 3) << 3) | (((lane >> 2) & 3) << 6) | (((lane >> 4) & 1) << 5) | (((lane >> 5) & 1) << 8); }
constexpr int v_rd_off(int d0, int ks, int half) { return d0 * 512 + ks * 4096 + half * 2048; }
template <int OFF> __device__ __forceinline__ s16x4 tr_read(int vb) {
    s16x4 r; asm volatile("ds_read_b64_tr_b16 %0, %1 offset:%2" : "=&v"(r) : "v"(vb), "i"(OFF) : "memory"); return r;
}
template <int D0> __device__ __forceinline__ void pv_one(f32x16& od, int vb, bf16x8 pa0, bf16x8 pa1, bf16x8 pa2, bf16x8 pa3) {
    const s16x4 l0 = tr_read<v_rd_off(D0, 0, 0)>(vb), h0 = tr_read<v_rd_off(D0, 0, 1)>(vb), l1 = tr_read<v_rd_off(D0, 1, 0)>(vb), h1 = tr_read<v_rd_off(D0, 1, 1)>(vb);
    const s16x4 l2 = tr_read<v_rd_off(D0, 2, 0)>(vb), h2 = tr_read<v_rd_off(D0, 2, 1)>(vb), l3 = tr_read<v_rd_off(D0, 3, 0)>(vb), h3 = tr_read<v_rd_off(D0, 3, 1)>(vb);
    asm volatile("s_waitcnt lgkmcnt(0)" ::: "memory"); SBAR();
#define PK(L, H) (bf16x8){L[0], L[1], L[2], L[3], H[0], H[1], H[2], H[3]}
    od = __builtin_amdgcn_mfma_f32_32x32x16_bf16(pa0, PK(l0, h0), od, 0, 0, 0);
    od = __builtin_amdgcn_mfma_f32_32x32x16_bf16(pa1, PK(l1, h1), od, 0, 0, 0);
    od = __builtin_amdgcn_mfma_f32_32x32x16_bf16(pa2, PK(l2, h2), od, 0, 0, 0);
    od = __builtin_amdgcn_mfma_f32_32x32x16_bf16(pa3, PK(l3, h3), od, 0, 0, 0);
#undef PK
}
__device__ __forceinline__ void pv_d0(f32x16* o, int vb, bf16x8 pa0, bf16x8 pa1, bf16x8 pa2, bf16x8 pa3) {
    pv_one<0>(o[0], vb, pa0, pa1, pa2, pa3); pv_one<1>(o[1], vb, pa0, pa1, pa2, pa3); pv_one<2>(o[2], vb, pa0, pa1, pa2, pa3); pv_one<3>(o[3], vb, pa0, pa1, pa2, pa3);
}

__device__ __forceinline__ void attn_body(const bf16_t* __restrict__ Qb, const bf16_t* __restrict__ Kn, const bf16_t* __restrict__ Kr, const bf16_t* __restrict__ Vh,
                                          bf16_t* __restrict__ Ob, int seq, char* lds) {
    const int tid = fresh_tid(), wid = tid >> 6, lane = tid & 63, r32 = lane & 31, hi = lane >> 5;
    char* V_lds = lds + OFF_V; char* K_lds = lds + OFF_K; char* R_lds = lds + OFF_RP;
    float* ws = (float*)(lds + OFF_WS) + wid * 64; float* li_l = ws; float* al_l = ws + 32;
    float m_reg = -1e30f, l_reg = 0; f32x16 o[4] = {}; bf16x8 qr[8];
    char* ql = lds + OFF_QL + wid * (NQL * 1024) + lane * 16;
    const bf16_t* Qw = Qb + (long)(wid * QBLK + r32) * LDQ + hi * 8;
#pragma unroll
    for (int d0 = 0; d0 < 8; ++d0) qr[d0] = ld8(Qw + d0 * 16);
#pragma unroll
    for (int d0 = 0; d0 < NQL; ++d0) *reinterpret_cast<bf16x8*>(ql + d0 * 1024) = ld8(Qw + (8 + d0) * 16);
    const int sr = tid >> 4, sc = (tid & 15) * 8, vst0 = v_st(sr, sc), vst1 = v_st(32 + sr, sc);
    const int rr_ = tid >> 3, rc_ = (tid & 7) * 8;
    const int vb0 = (int)(uintptr_t)V_lds + v_rd_base(lane);
    bf16x8 vs0, vs1, ks0, ks1, rs0;
#define SLOAD(k0) do { vs0 = ld8(&Vh[(long)((k0) + sr) * LDKV + sc]); vs1 = ld8(&Vh[(long)((k0) + 32 + sr) * LDKV + sc]); \
    ks0 = ld8(&Kn[(long)((k0) + sr) * LDKV + sc]); ks1 = ld8(&Kn[(long)((k0) + 32 + sr) * LDKV + sc]); rs0 = ld8(&Kr[(long)((k0) + rr_) * LDKR + rc_]); } while (0)
#define SWRITE(b) do { *(bf16x8*)(V_lds + (b) * SHM_V + vst0) = vs0; *(bf16x8*)(V_lds + (b) * SHM_V + vst1) = vs1; int kc = sc * 2; \
    *(bf16x8*)(K_lds + (b) * SHM_K + KSWZ(sr, kc)) = ks0; *(bf16x8*)(K_lds + (b) * SHM_K + KSWZ(32 + sr, kc)) = ks1; \
    *(bf16x8*)(R_lds + (b) * SHM_R + RSWZ(rr_, rc_ * 2)) = rs0; } while (0)
#define RESC(a) do { if (__any((a) < 1.f)) { if (hi == 0) al_l[r32] = (a); asm volatile("s_waitcnt lgkmcnt(0)" ::: "memory"); \
    _Pragma("unroll") for (int d = 0; d < 4; ++d) _Pragma("unroll") for (int r = 0; r < 16; ++r) o[d][r] *= al_l[crow(r, hi)]; } } while (0)
    f32x16 pA0, pA1, pB0, pB1; float mnA, mnB, alA, alB; bf16x8 pa0, pa1, pa2, pa3; const int NT = seq / KVBLK;
    SLOAD(0); asm volatile("s_waitcnt vmcnt(0)" ::: "memory"); SWRITE(0); __syncthreads();
    qkt(pA0, pA1, K_lds, R_lds, qr, ql, r32, hi); partialSM(pA0, pA1, m_reg, mnA, alA);
    SLOAD(KVBLK);
    asm volatile("s_waitcnt vmcnt(0)" ::: "memory"); SWRITE(1); __syncthreads();
    for (int j = 1; j + 1 < NT; j += 2) {
        SBAR(); qkt(pB0, pB1, K_lds + SHM_K, R_lds + SHM_R, qr, ql, r32, hi);
        finishSM(pA0, pA1, alA, l_reg, pa0, pa1, pa2, pa3); SBAR();
        SLOAD((j + 1) * KVBLK); SBAR();
        pv_d0(o, vb0, pa0, pa1, pa2, pa3); partialSM(pB0, pB1, m_reg, mnB, alB);
        __syncthreads(); asm volatile("s_waitcnt vmcnt(0)" ::: "memory"); SWRITE(0);
        RESC(alB); __syncthreads();
        SBAR(); qkt(pA0, pA1, K_lds, R_lds, qr, ql, r32, hi);
        finishSM(pB0, pB1, alB, l_reg, pa0, pa1, pa2, pa3); SBAR();
        SLOAD((j + 2) * KVBLK); SBAR();
        pv_d0(o, vb0 + SHM_V, pa0, pa1, pa2, pa3); partialSM(pA0, pA1, m_reg, mnA, alA);
        __syncthreads(); asm volatile("s_waitcnt vmcnt(0)" ::: "memory"); SWRITE(1);
        RESC(alA); __syncthreads();
    }
    SBAR(); qkt(pB0, pB1, K_lds + SHM_K, R_lds + SHM_R, qr, ql, r32, hi);
    finishSM(pA0, pA1, alA, l_reg, pa0, pa1, pa2, pa3); SBAR();
    pv_d0(o, vb0, pa0, pa1, pa2, pa3); partialSM(pB0, pB1, m_reg, mnB, alB);
    __syncthreads(); RESC(alB);
    finishSM(pB0, pB1, alB, l_reg, pa0, pa1, pa2, pa3); SBAR();
    pv_d0(o, vb0 + SHM_V, pa0, pa1, pa2, pa3);
    if (hi == 0) li_l[r32] = l_reg; asm volatile("s_waitcnt lgkmcnt(0)" ::: "memory");
    float rli[16];
#pragma unroll
    for (int r = 0; r < 16; ++r) rli[r] = __builtin_amdgcn_rcpf(li_l[crow(r, hi)]);
    bf16_t* Ow = Ob + (long)(wid * QBLK) * LDO;
#pragma unroll
    for (int r = 0; r < 16; ++r) { int orow = crow(r, hi);
#pragma unroll
        for (int d0 = 0; d0 < 4; ++d0) { const float v = o[d0][r] * rli[r]; Ow[(long)orow * LDO + d0 * 32 + r32] = (bf16_t)(cvt_pk_bf16(v, v) & 0xffffu); } }
#undef SLOAD
#undef SWRITE
#undef RESC
}
}


#define XB_TMO      128
#define XB_XCNT(j)  (256  + 64 * (j))
#define XB_XSUB(j)  (1280 + 64 * (j))
#define XB_XGEN(j)  (2304 + 64 * (j))
#define XB_TOP      3328
#define XB_TOPGEN   3392
#define XCD_BAR_WORDS 3456
#define XB_SPIN_CAP (1u << 18)
__device__ __forceinline__ unsigned xb_ld(unsigned* p)              { return __hip_atomic_load(p, __ATOMIC_RELAXED, __HIP_MEMORY_SCOPE_AGENT); }
__device__ __forceinline__ unsigned xb_add(unsigned* p, unsigned v) { return __hip_atomic_fetch_add(p, v, __ATOMIC_RELAXED, __HIP_MEMORY_SCOPE_AGENT); }
__device__ __forceinline__ unsigned xb_xcc_id() { return (unsigned)__builtin_amdgcn_s_getreg((3 << 11) | 20) & 0xFu; }
#define XB_SPIN(cond, bar) do { unsigned _sp = 0; while (cond) { __builtin_amdgcn_s_sleep(1); \
    if ((++_sp & 255u) == 0u) { if (xb_ld(&(bar)[XB_TMO])) break; if (_sp > XB_SPIN_CAP) { atomicAdd(&(bar)[XB_TMO], 1u); break; } } } } while (0)
struct XcdBarrier { unsigned* bar; unsigned x; volatile LAS unsigned* st; };
__device__ __forceinline__ XcdBarrier xcd_barrier_post(unsigned* bar, volatile LAS unsigned* st) {
    XcdBarrier b; b.bar = bar; b.x = xb_xcc_id(); b.st = st;
    if (threadIdx.x == 0) (void)xb_add(&bar[XB_XCNT(b.x)], 1u);
    return b;
}
__device__ __forceinline__ void xcd_barrier_complete(unsigned* bar, unsigned x, unsigned& nloc, unsigned& nx) {
    const unsigned G = gridDim.x * gridDim.y * gridDim.z;
    unsigned sum, cnt, mine, sp = 0u;
    for (;;) {
        sum = 0u; cnt = 0u; mine = 0u;
#pragma unroll
        for (unsigned j = 0; j < 16; ++j) { const unsigned c = xb_ld(&bar[XB_XCNT(j)]); sum += c; cnt += (c > 0u) ? 1u : 0u; mine = (j == x) ? c : mine; }
        if (sum == G) break;
        __builtin_amdgcn_s_sleep(1);
        if ((++sp & 255u) == 0u) { if (xb_ld(&bar[XB_TMO])) break; if (sp > XB_SPIN_CAP) { atomicAdd(&bar[XB_TMO], 1u); break; } }
    }
    nloc = mine > 0u ? mine : 1u; nx = cnt > 0u ? cnt : 1u;
}
__device__ __forceinline__ void xcd_barrier(const XcdBarrier& b) {
    asm volatile("s_waitcnt vmcnt(0)" ::: "memory");
    __syncthreads();
    if (threadIdx.x == 0) {
        unsigned* bar = b.bar;
        __builtin_amdgcn_s_waitcnt(0);
        unsigned nloc = b.st[0], nx = b.st[1];
        if (nloc == 0u) { xcd_barrier_complete(bar, b.x, nloc, nx); b.st[0] = nloc; b.st[1] = nx; }
        const unsigned old = xb_add(&bar[XB_XSUB(b.x)], 1u);
        const unsigned gen = old / nloc;
        if (old + 1u == (gen + 1u) * nloc) {
            __builtin_amdgcn_fence(__ATOMIC_RELEASE, "agent");
            asm volatile("s_waitcnt vmcnt(0)" ::: "memory");
            const unsigned og = xb_add(&bar[XB_TOP], 1u);
            const unsigned tg = og / nx;
            __builtin_amdgcn_fence(__ATOMIC_ACQUIRE, "agent");
            if (og + 1u == (tg + 1u) * nx) xb_add(&bar[XB_TOPGEN], 1u);
            else XB_SPIN(xb_ld(&bar[XB_TOPGEN]) == tg, bar);
            xb_add(&bar[XB_XGEN(b.x)], 1u);
            asm volatile("s_waitcnt vmcnt(0)" ::: "memory");
        } else {
            __builtin_amdgcn_fence(__ATOMIC_ACQUIRE, "agent");
            XB_SPIN(xb_ld(&bar[XB_XGEN(b.x)]) == gen, bar);
            asm volatile("s_waitcnt vmcnt(0)" ::: "memory");
        }
    }
    __syncthreads();
}

enum { TR_PLAIN = 0, TR_GU = 1, TR_WIN = 2, TR_UQ = 3, TR_UKV = 4 };
template <int MODE>
__device__ __forceinline__ void tr_job(const float* W0, const float* W1, int K, int Nsrc, int Nout, bf16_t* WT, LAS float* scr, int lane, int gw, int NGW) {
    const int nblk = Nout / 32, nitems = (K / 64) * nblk;
    for (int it = gw; it < nitems; it += NGW) {
        const int kb = it / nblk, nb = it % nblk, k0 = 64 * kb, n0 = 32 * nb, np = n0 + (lane & 31);
        const float* colp;
        if (MODE == TR_PLAIN) colp = W0 + np;
        else if (MODE == TR_GU) { const int t = np >> 8, w = np & 255; colp = (w < 128 ? W0 : W1) + t * 128 + (w & 127); }
        else if (MODE == TR_WIN) colp = np < 1216 ? W0 + np : (np < 1280 ? nullptr : W0 + (np - 64));
        else if (MODE == TR_UQ) { const int h = np / 192, w = np % 192; colp = W0 + (w < 128 ? np : h * 192 + 128 + ((w - 128) >> 1) + ((w - 128) & 1) * 32); }
        else colp = np < 1024 ? W0 + np : W1 + (np - 1024);
        float tv[32];
#pragma unroll
        for (int i = 0; i < 32; ++i) { const int kk = 2 * i + (lane >> 5); tv[i] = colp ? __builtin_nontemporal_load(colp + (size_t)(k0 + kk) * Nsrc) : 0.f; }
#pragma unroll
        for (int i = 0; i < 32; ++i) { const int kk = 2 * i + (lane >> 5); scr[kk * 33 + (lane & 31)] = tv[i]; }
        asm volatile("s_waitcnt lgkmcnt(0)" ::: "memory");
        const int c = lane & 7;
#pragma unroll
        for (int j = 0; j < 4; ++j) { const int n = (lane >> 3) + 8 * j; const LAS float* s = scr + (8 * c) * 33 + n;
            u32x4 o; o.x = cvt_pk_bf16(s[0 * 33], s[1 * 33]); o.y = cvt_pk_bf16(s[2 * 33], s[3 * 33]); o.z = cvt_pk_bf16(s[4 * 33], s[5 * 33]); o.w = cvt_pk_bf16(s[6 * 33], s[7 * 33]);
            *(u32x4*)(WT + (size_t)(n0 + n) * K + k0 + 8 * c) = o; }
        asm volatile("s_waitcnt lgkmcnt(0)" ::: "memory");
    }
}

__device__ __forceinline__ void norm_rows(const float* xin, const float* gnext, bf16_t* xn, int gw, int NGW, int lane) {
    for (int row0 = gw; row0 < M; row0 += 2 * NGW) {
        f32x4 xv[2][4];
#pragma unroll
        for (int r = 0; r < 2; ++r) { const size_t row = (size_t)(row0 + r * NGW);
#pragma unroll
            for (int j = 0; j < 2; ++j) { xv[r][2 * j] = __builtin_nontemporal_load((const f32x4*)(xin + row * DM + 8 * (lane + 64 * j))); xv[r][2 * j + 1] = __builtin_nontemporal_load((const f32x4*)(xin + row * DM + 8 * (lane + 64 * j) + 4)); } }
#pragma unroll
        for (int r = 0; r < 2; ++r) { const size_t row = (size_t)(row0 + r * NGW);
            float s2 = 0.f;
#pragma unroll
            for (int j = 0; j < 4; ++j) s2 += xv[r][j].x * xv[r][j].x + xv[r][j].y * xv[r][j].y + xv[r][j].z * xv[r][j].z + xv[r][j].w * xv[r][j].w;
            const float r2 = __builtin_amdgcn_rsqf(wave_sum(s2) * (1.f / DM) + EPS);
#pragma unroll
            for (int j = 0; j < 2; ++j) { const f32x4 g0 = *(const f32x4*)(gnext + 8 * (lane + 64 * j)), g1 = *(const f32x4*)(gnext + 8 * (lane + 64 * j) + 4);
                const f32x4 y0 = xv[r][2 * j] * g0 * r2, y1 = xv[r][2 * j + 1] * g1 * r2;
                u32x4 w; w.x = cvt_pk_bf16(y0.x, y0.y); w.y = cvt_pk_bf16(y0.z, y0.w); w.z = cvt_pk_bf16(y1.x, y1.y); w.w = cvt_pk_bf16(y1.z, y1.w);
                *(u32x4*)(xn + row * DM + 8 * (lane + 64 * j)) = w; }
        }
    }
}

__global__ void __launch_bounds__(NTHREADS, 2) fwd_megakernel(Params p) {
    extern __shared__ __attribute__((aligned(16))) unsigned char lds[];
    cg::grid_group grid = cg::this_grid();
    volatile LAS unsigned* bst = (volatile LAS unsigned*)((LAS unsigned char*)lds + LDS_STAGE);
    if (threadIdx.x < 2) bst[threadIdx.x] = 0u;
    __syncthreads();
    const XcdBarrier xbar = xcd_barrier_post((unsigned*)(p.ws + OFF_BAR), bst);
#define GRID_SYNC_CG() do { __builtin_amdgcn_fence(__ATOMIC_RELEASE, "agent"); asm volatile("s_waitcnt vmcnt(0)" ::: "memory"); grid.sync(); \
        __builtin_amdgcn_fence(__ATOMIC_ACQUIRE, "agent"); asm volatile("s_waitcnt vmcnt(0)" ::: "memory"); } while (0)
#define GRID_SYNC() xcd_barrier(xbar)
    const int G = gridDim.x, bid = blockIdx.x, NGW = G * NWAVES;
    LAS unsigned char* ldsl = (LAS unsigned char*)lds;
#define PHASE_IDS() const int tid = fresh_tid(), lane = tid & 63, wave = tid >> 6, gw = bid * NWAVES + wave; LAS float* scr = (LAS float*)(ldsl + wave * 8448); (void)scr; (void)gw; (void)lane
    unsigned char* ws = p.ws;
    bf16_t* Wgu = (bf16_t*)(ws + OFF_WGU); bf16_t* Wd = (bf16_t*)(ws + OFF_WD); bf16_t* Win = (bf16_t*)(ws + OFF_WIN); bf16_t* Wuq = (bf16_t*)(ws + OFF_WUQ);
    bf16_t* Wukv = (bf16_t*)(ws + OFF_WUKV); bf16_t* Woa = (bf16_t*)(ws + OFF_WOA); bf16_t* Wp = (bf16_t*)(ws + OFF_WP); bf16_t* Wout = (bf16_t*)(ws + OFF_WOUT);
    bf16_t* XN = (bf16_t*)(ws + OFF_XN); bf16_t* F = (bf16_t*)(ws + OFF_F); float* ZF = (float*)(ws + OFF_ZF); bf16_t* KV = (bf16_t*)(ws + OFF_KV);
    bf16_t* H = (bf16_t*)(ws + OFF_H); bf16_t* O = (bf16_t*)(ws + OFF_O); bf16_t* CQN = (bf16_t*)(ws + OFF_CQN); bf16_t* CKVN = (bf16_t*)(ws + OFF_CKVN);
    float* TAB = (float*)(ws + OFF_TAB); bf16_t* Q = (bf16_t*)(ws + OFF_Q); bf16_t* KR = (bf16_t*)(ws + OFF_KR); bf16_t* Gt = (bf16_t*)(ws + OFF_G); bf16_t* DP = (bf16_t*)(ws + OFF_DP);
    float* X = p.out;
    bf16_t* MXb = (bf16_t*)(ws + OFF_F + 32 * MiB);
    float* xbuf0 = (float*)(ws + OFF_XBUF); unsigned* cnt0 = (unsigned*)(ws + OFF_CNT);

    { PHASE_IDS();
    tr_job<TR_GU>(p.f1_wg, p.f1_wu, 1024, DFF, 5632, Wgu, scr, lane, gw, NGW);
    norm_rows(p.x, p.f1_pre, XN, gw, NGW, lane); }
    if (__builtin_expect(p.out == nullptr, 0)) GRID_SYNC_CG();
    GRID_SYNC();

    pg8::StaticOrder S;
    { pg8::Gemm g{XN, Wgu, M, 5632, 1024}; S.init(M, 5632, G, bid); pg8::EpiSwiGLU E{H}; pg8::gemm_phase(ldsl, g, S, E); }
    {
        const int tail0 = (64 * 22) % G;
        if (tail0 != 0 && bid >= tail0) { PHASE_IDS(); const int tb = bid - tail0, nb = G - tail0, tgw = tb * NWAVES + wave, TNGW = nb * NWAVES;
            tr_job<TR_PLAIN>(p.f1_wd, nullptr, DFF, 1024, 1024, Wd, scr, lane, tgw, TNGW);
            tr_job<TR_WIN>(p.w_in, nullptr, 1024, INW, 3328, Win, scr, lane, tgw, TNGW);
            tr_job<TR_UQ>(p.w_uq, nullptr, QL, 1536, 1536, Wuq, scr, lane, tgw, TNGW);
            tr_job<TR_UKV>(p.w_uk, p.w_uv, KVL, 1024, 2048, Wukv, scr, lane, tgw, TNGW);
    }
        else if (tail0 == 0) { PHASE_IDS(); const int tb = bid, nb = G;
            tr_job<TR_PLAIN>(p.f1_wd, nullptr, DFF, 1024, 1024, Wd, scr, lane, gw, NGW);
            tr_job<TR_WIN>(p.w_in, nullptr, 1024, INW, 3328, Win, scr, lane, gw, NGW);
            tr_job<TR_UQ>(p.w_uq, nullptr, QL, 1536, 1536, Wuq, scr, lane, gw, NGW);
            tr_job<TR_UKV>(p.w_uk, p.w_uv, KVL, 1024, 2048, Wukv, scr, lane, gw, NGW);
    }
    }
    GRID_SYNC();
    { pg8::Gemm g{H, Wd, M, 1024, DFF}; S.init(M, 1024, G, bid);
      pg8::EpiResNorm<false, true> E{p.x, (bf16_t*)X, nullptr, XN, 0.5f, p.f1_post, p.mix_pre, pg8::PanelSumSq{xbuf0, cnt0}, pg8::PanelSumSq{xbuf0 + (size_t)M * 4, cnt0 + 4096}}; pg8::gemm_phase(ldsl, g, S, E); }
    GRID_SYNC();
    { pg8::Gemm g{XN, Win, M, 1280, 1024}; S.init(M, 1280, G, bid); pg8::EpiBf16 E{(bf16_t*)ZF, 1280}; pg8::gemm_phase(ldsl, g, S, E); }
    {
        const int tail0 = (64 * 5) % G; PHASE_IDS();
        if (tail0 != 0 && bid >= tail0) { const int tgw = (bid - tail0) * NWAVES + wave, TNGW = (G - tail0) * NWAVES;
            tr_job<TR_GU>(p.f2_wg, p.f2_wu, 1024, DFF, 5632, Wgu, scr, lane, tgw, TNGW);
            tr_job<TR_PLAIN>(p.f2_wd, nullptr, DFF, 1024, 1024, Wd, scr, lane, tgw, TNGW); }
        else if (tail0 == 0) { tr_job<TR_GU>(p.f2_wg, p.f2_wu, 1024, DFF, 5632, Wgu, scr, lane, gw, NGW); tr_job<TR_PLAIN>(p.f2_wd, nullptr, DFF, 1024, 1024, Wd, scr, lane, gw, NGW); }
    }
    GRID_SYNC();
    { PHASE_IDS();
    const bf16_t* ZB = (const bf16_t*)ZF;
    for (int bt = gw; bt < M / 4; bt += NGW) { const int row0 = bt * 4, t0 = row0 & (SEQ - 1);
        const int lane = fresh_tid() & 63;
        const int t_g = lane >> 4, wnd = 2 << t_g, wl = wnd >> 1, wrr = wnd - wl;
        u32x4 nb[19], qa[4], qb[4]; float kx1[4], kx2[4]; int pos[4];
#pragma unroll
        for (int i = 0; i < 19; ++i) { int tt = t0 - 8 + i; tt = tt < 0 ? 0 : (tt > SEQ - 1 ? SEQ - 1 : tt); nb[i] = *(const u32x4*)(ZB + (size_t)(row0 - t0 + tt) * 1280 + 704 + 8 * lane); }
#pragma unroll
        for (int k = 0; k < 4; ++k) { const bf16_t* z = ZB + (size_t)(row0 + k) * 1280;
            qa[k] = *(const u32x4*)(z + 8 * lane); qb[k] = (u32x4){0u, 0u, 0u, 0u}; if (lane < 16) qb[k] = *(const u32x4*)(z + 512 + 8 * lane);
            kx1[k] = 0.f; kx2[k] = 0.f; pos[k] = 0; if (lane < 32) { kx1[k] = bf_lo((unsigned)z[640 + lane]); kx2[k] = bf_lo((unsigned)z[672 + lane]); pos[k] = p.pos[row0 + k]; } }
        __builtin_amdgcn_sched_barrier(0);
#pragma unroll
        for (int k = 0; k < 4; ++k) { const int row = row0 + k, t = t0 + k, lo = max(t - wl, 0), hi = min(t + wrr, SEQ);
            float sacc[8];
#pragma unroll
            for (int i = 0; i < 8; ++i) sacc[i] = 0.f;
#pragma unroll
            for (int d = 0; d < 16; ++d) { const int tt = t - 8 + d; const float wv = (tt >= lo && tt < hi) ? 1.f : 0.f; const u32x4 v = nb[k + d];
                sacc[0] = fmaf(wv, bf_lo(v.x), sacc[0]); sacc[1] = fmaf(wv, bf_hi(v.x), sacc[1]); sacc[2] = fmaf(wv, bf_lo(v.y), sacc[2]); sacc[3] = fmaf(wv, bf_hi(v.y), sacc[3]);
                sacc[4] = fmaf(wv, bf_lo(v.z), sacc[4]); sacc[5] = fmaf(wv, bf_hi(v.z), sacc[5]); sacc[6] = fmaf(wv, bf_lo(v.w), sacc[6]); sacc[7] = fmaf(wv, bf_hi(v.w), sacc[7]); }
            {
                const float inv = 1.f / (float)(hi - lo); const u32x4 pc = nb[k + 8];
                u32x4 w; w.x = cvt_pk_bf16(sacc[0] * inv - bf_lo(pc.x), sacc[1] * inv - bf_hi(pc.x)); w.y = cvt_pk_bf16(sacc[2] * inv - bf_lo(pc.y), sacc[3] * inv - bf_hi(pc.y));
                w.z = cvt_pk_bf16(sacc[4] * inv - bf_lo(pc.z), sacc[5] * inv - bf_hi(pc.z)); w.w = cvt_pk_bf16(sacc[6] * inv - bf_lo(pc.w), sacc[7] * inv - bf_hi(pc.w));
                *(u32x4*)(DP + (size_t)row * 512 + 8 * lane) = w; }
            {
                const u32x4 a4 = qa[k], b4 = qb[k];
                float va[8] = {bf_lo(a4.x), bf_hi(a4.x), bf_lo(a4.y), bf_hi(a4.y), bf_lo(a4.z), bf_hi(a4.z), bf_lo(a4.w), bf_hi(a4.w)};
                float vb[8] = {bf_lo(b4.x), bf_hi(b4.x), bf_lo(b4.y), bf_hi(b4.y), bf_lo(b4.z), bf_hi(b4.z), bf_lo(b4.w), bf_hi(b4.w)};
                float sa = 0.f, sb = 0.f;
#pragma unroll
                for (int i = 0; i < 8; ++i) { sa = fmaf(va[i], va[i], sa); sb = fmaf(vb[i], vb[i], sb); }
                const float ssq = wave_sum(lane < 48 ? sa : 0.f), sskv = wave_sum((lane >= 48 ? sa : 0.f) + sb);
                const float rq = __builtin_amdgcn_rsqf(ssq * (1.f / QL) + EPS), rkv = __builtin_amdgcn_rsqf(sskv * (1.f / KVL) + EPS);
                const float* ga = lane < 48 ? p.qa_g + 8 * lane : p.kva_g + 8 * (lane - 48); const float ra = lane < 48 ? rq : rkv;
                const f32x4 g0 = *(const f32x4*)ga, g1 = *(const f32x4*)(ga + 4);
                u32x4 w; w.x = cvt_pk_bf16(va[0] * g0.x * ra, va[1] * g0.y * ra); w.y = cvt_pk_bf16(va[2] * g0.z * ra, va[3] * g0.w * ra); w.z = cvt_pk_bf16(va[4] * g1.x * ra, va[5] * g1.y * ra); w.w = cvt_pk_bf16(va[6] * g1.z * ra, va[7] * g1.w * ra);
                bf16_t* dst = lane < 48 ? CQN + (size_t)row * QL + 8 * lane : CKVN + (size_t)row * KVL + 8 * (lane - 48);
                *(u32x4*)dst = w;
                if (lane < 16) { const f32x4 h0 = *(const f32x4*)(p.kva_g + 128 + 8 * lane), h1 = *(const f32x4*)(p.kva_g + 132 + 8 * lane);
                    u32x4 w2; w2.x = cvt_pk_bf16(vb[0] * h0.x * rkv, vb[1] * h0.y * rkv); w2.y = cvt_pk_bf16(vb[2] * h0.z * rkv, vb[3] * h0.w * rkv); w2.z = cvt_pk_bf16(vb[4] * h1.x * rkv, vb[5] * h1.y * rkv); w2.w = cvt_pk_bf16(vb[6] * h1.z * rkv, vb[7] * h1.w * rkv);
                    *(u32x4*)(CKVN + (size_t)row * KVL + 128 + 8 * lane) = w2; }
            }
            if (lane < 32) {
                const float ang = (float)pos[k] * p.inv_freq[lane];
                const double ad = (double)ang; const double kq = rint(ad * 0.15915494309189535); const float red = (float)(ad - kq * 6.283185307179586);
                const float cs = __cosf(red), sn = __sinf(red);
                TAB[(size_t)row * 64 + lane] = cs; TAB[(size_t)row * 64 + 32 + lane] = sn;
                *(unsigned*)(KR + (size_t)row * 64 + 2 * lane) = cvt_pk_bf16(kx1[k] * cs - kx2[k] * sn, kx2[k] * cs + kx1[k] * sn);
            }
            __builtin_amdgcn_sched_barrier(0);
        }
    } }
    GRID_SYNC();
    { pg8::Gemm g{CQN, Wuq, M, 1536, QL}; S.init(M, 1536, G, bid); pg8::EpiQ E{Q, TAB}; pg8::gemm_phase(ldsl, g, S, E); }
    {
        const int tail0 = (64 * 6) % G;
        if (tail0 != 0 && bid >= tail0) { PHASE_IDS(); const int tb = bid - tail0, nb = G - tail0, tgw = tb * NWAVES + wave, TNGW = nb * NWAVES;
            tr_job<TR_PLAIN>(p.w_oa, nullptr, 1024, 1024, 1024, Woa, scr, lane, tgw, TNGW);
            tr_job<TR_PLAIN>(p.w_out, nullptr, 1024, 1024, 1024, Wout, scr, lane, tgw, TNGW);
    for (int idx = tb * NTHREADS + tid; idx < 65536; idx += nb * NTHREADS) {
            const int n = idx & 1023, c8 = idx >> 10, g = c8 >> 4, cb = (c8 & 15) * 8;
            float a[8];
    #pragma unroll
            for (int i = 0; i < 8; ++i) a[i] = 0.f;
            for (int j0 = 0; j0 < 128; j0 += 8) { float w[8]; f32x4 pw[8][2];
    #pragma unroll
                for (int jj = 0; jj < 8; ++jj) w[jj] = p.w_op[(size_t)(g * 128 + j0 + jj) * 1024 + n] * p.pool_scale[g * 128 + j0 + jj];
    #pragma unroll
                for (int i = 0; i < 8; ++i) { pw[i][0] = *(const f32x4*)(p.pool_w + (size_t)(g * 128 + cb + i) * 128 + j0); pw[i][1] = *(const f32x4*)(p.pool_w + (size_t)(g * 128 + cb + i) * 128 + j0 + 4); }
    #pragma unroll
                for (int i = 0; i < 8; ++i)
    #pragma unroll
                    for (int jj = 0; jj < 8; ++jj) a[i] = fmaf(pw[i][jj >> 2][jj & 3], w[jj], a[i]); }
            u32x4 o; o.x = cvt_pk_bf16(a[0], a[1]); o.y = cvt_pk_bf16(a[2], a[3]); o.z = cvt_pk_bf16(a[4], a[5]); o.w = cvt_pk_bf16(a[6], a[7]);
            *(u32x4*)(Wp + (size_t)n * 512 + c8 * 8) = o;
        }
        }
        else if (tail0 == 0) { PHASE_IDS(); const int tb = bid, nb = G;
            tr_job<TR_PLAIN>(p.w_oa, nullptr, 1024, 1024, 1024, Woa, scr, lane, gw, NGW);
            tr_job<TR_PLAIN>(p.w_out, nullptr, 1024, 1024, 1024, Wout, scr, lane, gw, NGW);
    for (int idx = tb * NTHREADS + tid; idx < 65536; idx += nb * NTHREADS) {
            const int n = idx & 1023, c8 = idx >> 10, g = c8 >> 4, cb = (c8 & 15) * 8;
            float a[8];
    #pragma unroll
            for (int i = 0; i < 8; ++i) a[i] = 0.f;
            for (int j0 = 0; j0 < 128; j0 += 8) { float w[8]; f32x4 pw[8][2];
    #pragma unroll
                for (int jj = 0; jj < 8; ++jj) w[jj] = p.w_op[(size_t)(g * 128 + j0 + jj) * 1024 + n] * p.pool_scale[g * 128 + j0 + jj];
    #pragma unroll
                for (int i = 0; i < 8; ++i) { pw[i][0] = *(const f32x4*)(p.pool_w + (size_t)(g * 128 + cb + i) * 128 + j0); pw[i][1] = *(const f32x4*)(p.pool_w + (size_t)(g * 128 + cb + i) * 128 + j0 + 4); }
    #pragma unroll
                for (int i = 0; i < 8; ++i)
    #pragma unroll
                    for (int jj = 0; jj < 8; ++jj) a[i] = fmaf(pw[i][jj >> 2][jj & 3], w[jj], a[i]); }
            u32x4 o; o.x = cvt_pk_bf16(a[0], a[1]); o.y = cvt_pk_bf16(a[2], a[3]); o.z = cvt_pk_bf16(a[4], a[5]); o.w = cvt_pk_bf16(a[6], a[7]);
            *(u32x4*)(Wp + (size_t)n * 512 + c8 * 8) = o;
        }
        }
    }
    __syncthreads();
    { pg8::Gemm g{CKVN, Wukv, M, 2048, KVL}; S.init(M, 2048, G, bid); pg8::EpiBf16 E{KV, 2048}; pg8::gemm_phase(ldsl, g, S, E); }
    GRID_SYNC();
    {
        const int vcu = (bid & 7) * (G >> 3) + (bid >> 3);
        for (int it = vcu; it < NB * NH * (SEQ / 256); it += G) {
            const int qb = it & 7, h = (it >> 3) & 7, b = it >> 6;
            const size_t tok0 = (size_t)b * SEQ;
            att::attn_body(Q + (tok0 + qb * 256) * 1536 + h * 192, KV + tok0 * 2048 + h * 128, KR + tok0 * 64, KV + tok0 * 2048 + 1024 + h * 128,
                           O + (tok0 + qb * 256) * 1024 + h * 128, SEQ, (char*)lds);
            __syncthreads();
        }
    }
    GRID_SYNC();
    { pg8::Gemm g{XN, Win + (size_t)1280 * 1024, M, 2048, 1024}; pg8::GateOrder GO; GO.s.init(M, 1024, G, bid); pg8::EpiGate E{Gt}; pg8::gemm_phase(ldsl, g, GO, E); }
    { pg8::Gemm g{O, Woa, M, 1024, 1024}; S.init(M, 1024, G, bid); pg8::EpiT1 E{Gt, F}; pg8::gemm_phase(ldsl, g, S, E); }
    { pg8::Gemm g{DP, Wp, M, 1024, 512}; S.init(M, 1024, G, bid); pg8::EpiMX E{Gt, F, MXb}; pg8::gemm_phase(ldsl, g, S, E); }
    GRID_SYNC();
    { pg8::Gemm g{MXb, Wout, M, 1024, 1024}; S.init(M, 1024, G, bid);
      pg8::EpiResNorm<false, false> E{nullptr, (bf16_t*)X, nullptr, XN, 1.0f, p.mix_post, p.f2_pre, pg8::PanelSumSq{xbuf0 + (size_t)M * 8, cnt0 + 2 * 4096}, pg8::PanelSumSq{xbuf0 + (size_t)M * 12, cnt0 + 3 * 4096}}; pg8::gemm_phase(ldsl, g, S, E); }
    GRID_SYNC();
    { pg8::Gemm g{XN, Wgu, M, 5632, 1024}; S.init(M, 5632, G, bid); pg8::EpiSwiGLU E{H}; pg8::gemm_phase(ldsl, g, S, E); }
    GRID_SYNC();
    { pg8::Gemm g{H, Wd, M, 1024, DFF}; S.init(M, 1024, G, bid);
      pg8::EpiResNorm<true, false> E{nullptr, (bf16_t*)X, X, nullptr, 0.5f, p.f2_post, p.final_g, pg8::PanelSumSq{xbuf0 + (size_t)M * 16, cnt0 + 4 * 4096}, pg8::PanelSumSq{xbuf0 + (size_t)M * 20, cnt0 + 5 * 4096}}; pg8::gemm_phase(ldsl, g, S, E); }
}

extern "C" void kernel_launch(void* const* d_in, const int* in_sizes, int n_in, void* d_out, int out_size, void* d_ws, size_t ws_size, hipStream_t stream) {
    static int grid_blocks = 0;
    if (grid_blocks == 0) {
        if (n_in != 26 || in_sizes[0] != M * DM || out_size != M * DM || ws_size < WS_END) { fprintf(stderr, "kernel_launch: shape mismatch n_in %d in0 %d out %d ws %zu\n", n_in, n_in > 0 ? in_sizes[0] : -1, out_size, ws_size); grid_blocks = -1; return; }
        int dev = 0, cus = 0, per_cu = 0;
        (void)hipGetDevice(&dev);
        (void)hipDeviceGetAttribute(&cus, hipDeviceAttributeMultiprocessorCount, dev);
        if (hipFuncSetAttribute((const void*)fwd_megakernel, hipFuncAttributeMaxDynamicSharedMemorySize, LDS_BYTES) != hipSuccess) { fprintf(stderr, "kernel_launch: hipFuncSetAttribute failed\n"); grid_blocks = -1; return; }
        if (hipOccupancyMaxActiveBlocksPerMultiprocessor(&per_cu, (const void*)fwd_megakernel, NTHREADS, LDS_BYTES) != hipSuccess || per_cu < 1) { fprintf(stderr, "kernel_launch: occupancy query failed (%d)\n", per_cu); (void)hipGetLastError(); per_cu = 1; }
        grid_blocks = cus * 1;
        if (grid_blocks != 256) { fprintf(stderr, "kernel_launch: built for 256 CUs (one workgroup each), device has %d\n", cus); grid_blocks = -1; return; }
    }
    if (grid_blocks < 0) return;
    Params p{};
    p.x = (const float*)d_in[0]; p.pos = (const int*)d_in[1];
    p.f1_pre = (const float*)d_in[2]; p.f1_wg = (const float*)d_in[3]; p.f1_wu = (const float*)d_in[4]; p.f1_wd = (const float*)d_in[5]; p.f1_post = (const float*)d_in[6];
    p.mix_pre = (const float*)d_in[7]; p.w_in = (const float*)d_in[8]; p.qa_g = (const float*)d_in[9]; p.w_uq = (const float*)d_in[10]; p.kva_g = (const float*)d_in[11];
    p.w_uk = (const float*)d_in[12]; p.w_uv = (const float*)d_in[13]; p.w_oa = (const float*)d_in[14]; p.pool_w = (const float*)d_in[15]; p.pool_scale = (const float*)d_in[16];
    p.w_op = (const float*)d_in[17]; p.w_out = (const float*)d_in[18]; p.mix_post = (const float*)d_in[19];
    p.f2_pre = (const float*)d_in[20]; p.f2_wg = (const float*)d_in[21]; p.f2_wu = (const float*)d_in[22]; p.f2_wd = (const float*)d_in[23]; p.f2_post = (const float*)d_in[24]; p.final_g = (const float*)d_in[25];
    p.out = (float*)d_out; p.ws = (unsigned char*)d_ws;
    for (int i = 0; i < 32; ++i) p.inv_freq[i] = (float)pow(10000.0, -(2.0 * i) / 64.0);
    if (hipMemsetAsync((char*)d_ws + OFF_BAR, 0, CTL_BYTES, stream) != hipSuccess) { fprintf(stderr, "kernel_launch: memset failed\n"); return; }
    void* args[] = {&p};
    hipError_t e = hipLaunchCooperativeKernel((const void*)fwd_megakernel, dim3(grid_blocks), dim3(NTHREADS), args, LDS_BYTES, stream);
    if (e != hipSuccess) fprintf(stderr, "cooperative launch failed: %s (grid %d)\n", hipGetErrorString(e), grid_blocks);
}
```

```cpp
#include <hip/hip_runtime.h>
#include <hip/hip_cooperative_groups.h>
#include <cstdio>
#include <cmath>
#include <cstdint>
namespace cg = cooperative_groups;

#define LAS __attribute__((address_space(3)))
typedef unsigned short bf16_t;
typedef short bf16x8 __attribute__((ext_vector_type(8)));
typedef short s16x4 __attribute__((ext_vector_type(4)));
typedef float f32x2 __attribute__((ext_vector_type(2)));
typedef float f32x4 __attribute__((ext_vector_type(4)));
typedef float f32x16 __attribute__((ext_vector_type(16)));
typedef unsigned u32x4 __attribute__((ext_vector_type(4)));
typedef unsigned u32x2 __attribute__((ext_vector_type(2)));

constexpr int DM = 1024, NB = 8, SEQ = 2048, M = NB * SEQ, NH = 8, QL = 384, KVL = 256, DFF = 2816, INW = 3264;
constexpr float EPS = 1e-6f;
constexpr int NTHREADS = 512, NWAVES = 8;
constexpr int LDS_STAGE = 131072, LDS_BYTES = LDS_STAGE + 16;

constexpr size_t MiB = 1048576;
constexpr size_t OFF_WGU = 0;
constexpr size_t OFF_WD = OFF_WGU + (size_t)5632 * 1024 * 2;
constexpr size_t OFF_WIN = OFF_WD + (size_t)1024 * 2816 * 2;
constexpr size_t OFF_WUQ = OFF_WIN + (size_t)3328 * 1024 * 2;
constexpr size_t OFF_WUKV = OFF_WUQ + (size_t)1536 * 384 * 2;
constexpr size_t OFF_WOA = OFF_WUKV + (size_t)2048 * 256 * 2;
constexpr size_t OFF_WP = OFF_WOA + (size_t)1024 * 1024 * 2;
constexpr size_t OFF_WOUT = OFF_WP + (size_t)1024 * 512 * 2;
constexpr size_t OFF_XN = OFF_WOUT + (size_t)1024 * 1024 * 2;
constexpr size_t OFF_R = OFF_XN + 32 * MiB;
constexpr size_t OFF_F = OFF_R;
constexpr size_t OFF_ZF = OFF_R;
constexpr size_t OFF_KV = OFF_R;
constexpr size_t OFF_H = OFF_R + 64 * MiB;
constexpr size_t OFF_O = OFF_R + 64 * MiB;
constexpr size_t OFF_CQN = OFF_R + 80 * MiB;
constexpr size_t OFF_CKVN = OFF_R + 92 * MiB;
constexpr size_t OFF_TAB = OFF_R + 100 * MiB;
constexpr size_t OFF_Q = OFF_R + 104 * MiB;
constexpr size_t OFF_KR = OFF_R + 152 * MiB;
constexpr size_t OFF_G = OFF_R + 96 * MiB;
constexpr size_t OFF_DP = OFF_R + 176 * MiB;
constexpr size_t WS_END = OFF_R + 192 * MiB;
constexpr size_t OFF_BAR = WS_END, OFF_CNT = OFF_BAR + 16384, CTL_BYTES = 16384 + 6 * 16384, OFF_XBUF = OFF_BAR + CTL_BYTES;
static_assert(OFF_XBUF + 6 * (size_t)M * 16 <= 256 * MiB, "workspace");

struct Params {
    const float* x; const int* pos;
    const float *f1_pre, *f1_wg, *f1_wu, *f1_wd, *f1_post;
    const float *mix_pre, *w_in, *qa_g, *w_uq, *kva_g, *w_uk, *w_uv, *w_oa, *pool_w, *pool_scale, *w_op, *w_out, *mix_post;
    const float *f2_pre, *f2_wg, *f2_wu, *f2_wd, *f2_post, *final_g;
    float* out; unsigned char* ws;
    float inv_freq[32];
};

typedef __bf16 bf16x2_t __attribute__((ext_vector_type(2)));
__device__ __forceinline__ unsigned cvt_pk_bf16(float lo, float hi) { const f32x2 v = {lo, hi}; const bf16x2_t r = __builtin_convertvector(v, bf16x2_t); return __builtin_bit_cast(unsigned, r); }
__device__ __forceinline__ float bf_lo(unsigned w) { return __uint_as_float(w << 16); }
__device__ __forceinline__ float bf_hi(unsigned w) { return __uint_as_float(w & 0xffff0000u); }
__device__ __forceinline__ float sigmoidf_fast(float z) { return __builtin_amdgcn_rcpf(1.f + __builtin_amdgcn_exp2f(-1.4426950408889634f * z)); }
__device__ __forceinline__ int fresh_tid() { int t = threadIdx.x; asm volatile("" : "+v"(t)); return t; }
__device__ __forceinline__ float wave_sum(float v) {
#pragma unroll
    for (int o = 1; o < 64; o <<= 1) v += __shfl_xor(v, o);
    return v;
}

namespace pg8 {
constexpr int BM = 256, BK = 64, HALF = 128, HTB = HALF * BK * 2, STAGE_BYTES = 8 * HTB, NXCD = 8, WGM = 4;
__host__ __device__ __forceinline__ int lds_byte(int r, int c) { const int st = (r >> 4) * 2 + (c >> 5), rr = r & 15, cc = c & 31, ob = rr * 64 + cc * 2; return st * 1024 + (ob ^ (((ob >> 9) & 1) << 5)); }
__host__ __device__ __forceinline__ void stage_rc(int b, int& R, int& C) { const int st = b / 1024, sb = b % 1024, swz = sb ^ (((sb >> 9) & 1) << 5); R = (st >> 1) * 16 + swz / 64; C = (st & 1) * 32 + (swz % 64) / 2; }
__host__ __device__ __forceinline__ int perm32(int rho) { const int n = rho >> 4, i = rho & 15; return 8 * (i >> 2) + 4 * n + (i & 3); }
struct Unit { int pm, pn; };
struct Gemm { const bf16_t* A; const bf16_t* Bt; int M, N, K; };
struct StaticOrder {
    int nM, nN, nwg, G, c;
    __device__ void init(int M_, int N_, int G_, int c_) { nM = M_ / BM; nN = N_ / BM; nwg = nM * nN; G = G_; c = c_; }
    __device__ bool next(int i, Unit& u) const {
        const long L = (long)i * G + c; if (L >= nwg) return false;
        int wgid = (int)L; { const int q = nwg / NXCD, r = nwg % NXCD, xcd = wgid % NXCD, off = wgid / NXCD; wgid = (xcd < r ? xcd * (q + 1) : r * (q + 1) + (xcd - r) * q) + off; }
        const int nig = WGM * nN, gid = wgid / nig, fm = gid * WGM, gsz = (nM - fm) < WGM ? (nM - fm) : WGM;
        u.pm = fm + ((wgid % nig) % gsz); u.pn = (wgid % nig) / gsz; return true;
    }
};

struct GateOrder { StaticOrder s;
    __device__ bool next(int i, Unit& u) const { if (i >= 2) return false; Unit b; if (!s.next(0, b)) return false; u.pm = b.pm; u.pn = b.pn + 4 * i; return true; } };
template <class Epi, class Sched>
__device__ __forceinline__ void gemm_phase(LAS unsigned char* lds, const Gemm g, const Sched& S, const Epi& E) {
    const int tid = fresh_tid(), wid = __builtin_amdgcn_readfirstlane(tid >> 6), lane = tid & 63, wr = wid >> 2, wc = wid & 3, fr = lane & 15, fq = lane >> 4;
    const int K = g.K, nt = K / BK;
    unsigned voffA, voffB;
    { int R, C; stage_rc(tid * 16, R, C); const int Rb = Epi::PERM ? ((R & ~31) + perm32(R & 31)) : R;
      voffA = (unsigned)(R * K + C) * 2u; voffB = (unsigned)(Rb * K + C) * 2u; }
    const size_t rstep64 = (size_t)64 * K * 2;
    const size_t kstep = (size_t)(BK * 2);
    const size_t hstep = (size_t)HALF * K * 2;
    const size_t tstep = 2 * hstep;
    const unsigned ldsw = (unsigned)wid * 1024u;
    const int aoff = lds_byte(wr * 64 + fr, fq * 8), boff = lds_byte(wc * 32 + fr, fq * 8);
#define PG8_SA(b, h) (((b) * 2 + (h)) * HTB)
#define PG8_SB(b, h) ((4 + (b) * 2 + (h)) * HTB)
#define PG8_STAGE(bufoff, gbase, voff) do { _Pragma("unroll") for (int _i = 0; _i < 2; ++_i) \
        __builtin_amdgcn_global_load_lds((const unsigned*)((const char*)(gbase) + _i * rstep64 + (voff)), (LAS unsigned*)(lds + (bufoff) + ldsw + _i * 8192), 16, 0, 0); } while (0)
#define PG8_LDA(dst, b, h) do { _Pragma("unroll") for (int m = 0; m < 4; ++m) _Pragma("unroll") for (int k = 0; k < 2; ++k) dst[m][k] = *(const LAS bf16x8*)(lds + PG8_SA(b, h) + aoff + m * 2048 + k * 1024); } while (0)
#define PG8_LDB(dst, b, h) do { _Pragma("unroll") for (int n = 0; n < 2; ++n) _Pragma("unroll") for (int k = 0; k < 2; ++k) dst[n][k] = *(const LAS bf16x8*)(lds + PG8_SB(b, h) + boff + n * 2048 + k * 1024); } while (0)
#define PG8_MMA(ai, bj, At, Bt) do { __builtin_amdgcn_s_setprio(1); _Pragma("unroll") for (int m = 0; m < 4; ++m) _Pragma("unroll") for (int n = 0; n < 2; ++n) _Pragma("unroll") for (int k = 0; k < 2; ++k) \
        acc[ai][bj][m][n] = __builtin_amdgcn_mfma_f32_16x16x32_bf16(Bt[n][k], At[m][k], acc[ai][bj][m][n], 0, 0, 0); __builtin_amdgcn_s_setprio(0); } while (0)
#define PG8_WAIT_V(n) asm volatile("s_waitcnt vmcnt(" #n ")" ::: "memory")
#define PG8_WAIT_L(n) asm volatile("s_waitcnt lgkmcnt(" #n ")" ::: "memory")
#define PG8_BAR __builtin_amdgcn_s_barrier()
#define PG8_SCHED __builtin_amdgcn_sched_barrier(0)
    Unit cur, nxt; int ui = 0;
    if (!S.next(0, cur)) return;
    f32x4 acc[2][2][4][2];
#pragma unroll
    for (int a = 0; a < 2; ++a)
#pragma unroll
        for (int b = 0; b < 2; ++b)
#pragma unroll
            for (int m = 0; m < 4; ++m)
#pragma unroll
                for (int n = 0; n < 2; ++n) acc[a][b][m][n] = (f32x4){0.f, 0.f, 0.f, 0.f};
    bf16x8 At[4][2], B0[2][2], B1[2][2];
    const char* cA = (const char*)g.A + (size_t)cur.pm * tstep; const char* cB = (const char*)g.Bt + (size_t)cur.pn * tstep;
    PG8_STAGE(PG8_SB(0, 0), cB, voffB); PG8_STAGE(PG8_SA(0, 0), cA, voffA); PG8_STAGE(PG8_SB(0, 1), cB + hstep, voffB); PG8_STAGE(PG8_SA(0, 1), cA + hstep, voffA);
    if (wr == 1) PG8_BAR;
    PG8_WAIT_V(4); PG8_BAR;
    PG8_STAGE(PG8_SB(1, 0), cB + kstep, voffB); PG8_STAGE(PG8_SA(1, 0), cA + kstep, voffA); PG8_STAGE(PG8_SB(1, 1), cB + hstep + kstep, voffB);
    PG8_WAIT_V(6); PG8_BAR;
    for (;;) {
        const bool has_next = S.next(ui + 1, nxt);
        const char* nA = has_next ? (const char*)g.A + (size_t)nxt.pm * tstep : cA; const char* nB = has_next ? (const char*)g.Bt + (size_t)nxt.pn * tstep : cB;
        for (int t = 0; t < nt; t += 2) {
            const bool last = (t == nt - 2);
            const char* a1 = cA + (size_t)(t + 1) * kstep;
            const char* a2 = last ? nA : cA + (size_t)(t + 2) * kstep; const char* b2 = last ? nB : cB + (size_t)(t + 2) * kstep;
            const char* a3 = a2 + kstep; const char* b3 = b2 + kstep;
            PG8_LDB(B0, 0, 0); PG8_SCHED; PG8_LDA(At, 0, 0); PG8_STAGE(PG8_SA(1, 1), a1 + hstep, voffA);
            PG8_WAIT_L(8); PG8_BAR; PG8_WAIT_L(0); PG8_MMA(0, 0, At, B0); PG8_BAR; PG8_SCHED;
            PG8_LDB(B1, 0, 1); PG8_STAGE(PG8_SB(0, 0), b2, voffB);
            PG8_BAR; PG8_WAIT_L(0); PG8_MMA(0, 1, At, B1); PG8_BAR;
            PG8_LDA(At, 0, 1); PG8_STAGE(PG8_SA(0, 0), a2, voffA);
            PG8_BAR; PG8_WAIT_L(0); PG8_MMA(1, 0, At, B0); PG8_BAR; PG8_SCHED;
            PG8_STAGE(PG8_SB(0, 1), b2 + hstep, voffB);
            PG8_WAIT_V(6); PG8_BAR; PG8_MMA(1, 1, At, B1); PG8_BAR;
            PG8_LDB(B0, 1, 0); PG8_SCHED; PG8_LDA(At, 1, 0); PG8_STAGE(PG8_SA(0, 1), a2 + hstep, voffA);
            PG8_WAIT_L(8); PG8_BAR; PG8_WAIT_L(0); PG8_MMA(0, 0, At, B0); PG8_BAR; PG8_SCHED;
            PG8_LDB(B1, 1, 1); PG8_STAGE(PG8_SB(1, 0), b3, voffB);
            PG8_BAR; PG8_WAIT_L(0); PG8_MMA(0, 1, At, B1); PG8_BAR;
            PG8_LDA(At, 1, 1); PG8_STAGE(PG8_SA(1, 0), a3, voffA);
            PG8_BAR; PG8_WAIT_L(0); PG8_MMA(1, 0, At, B0); PG8_BAR; PG8_SCHED;
            PG8_STAGE(PG8_SB(1, 1), b3 + hstep, voffB);
            PG8_WAIT_V(6); PG8_BAR; PG8_MMA(1, 1, At, B1); PG8_BAR;
        }
        if constexpr (!Epi::AFTER_DRAIN) { const int t2 = fresh_tid(); E(acc, cur, wr, wc, t2 & 15, (t2 >> 4) & 3); }
        if (!has_next) break;
#pragma unroll
        for (int a = 0; a < 2; ++a)
#pragma unroll
            for (int b = 0; b < 2; ++b)
#pragma unroll
                for (int m = 0; m < 4; ++m)
#pragma unroll
                    for (int n = 0; n < 2; ++n) acc[a][b][m][n] = (f32x4){0.f, 0.f, 0.f, 0.f};
        cur = nxt; cA = nA; cB = nB; ++ui;
    }
    PG8_WAIT_V(0);
    if (wr == 0) PG8_BAR;
    PG8_BAR;
    if constexpr (Epi::AFTER_DRAIN) { const int t2 = fresh_tid(); E.fused(acc, cur, wr, wc, t2 & 15, (t2 >> 4) & 3, lds, t2 >> 6, t2 & 63); }
#undef PG8_SA
#undef PG8_SB
#undef PG8_STAGE
#undef PG8_LDA
#undef PG8_LDB
#undef PG8_MMA
#undef PG8_WAIT_V
#undef PG8_WAIT_L
#undef PG8_BAR
#undef PG8_SCHED
}

typedef f32x4 Acc[2][2][4][2];
struct EpiF32 {
    static constexpr bool PERM = false, AFTER_DRAIN = false;
    float* C; int ldc;
    __device__ __forceinline__ void operator()(const Acc& acc, const Unit& u, int wr, int wc, int fr, int fq) const {
        const int row0 = u.pm * BM + wr * 64 + fr, col0 = u.pn * BM + wc * 32 + 4 * fq;
#pragma unroll
        for (int ai = 0; ai < 2; ++ai)
#pragma unroll
            for (int m = 0; m < 4; ++m) { float* rowp = C + (size_t)(row0 + ai * HALF + m * 16) * ldc + col0;
#pragma unroll
                for (int bj = 0; bj < 2; ++bj)
#pragma unroll
                    for (int n = 0; n < 2; ++n) *(f32x4*)(rowp + bj * HALF + n * 16) = acc[ai][bj][m][n]; }
    }
};
struct EpiBf16 {
    static constexpr bool PERM = true, AFTER_DRAIN = false;
    bf16_t* O; int ldc;
    __device__ __forceinline__ void operator()(const Acc& acc, const Unit& u, int wr, int wc, int fr, int fq) const {
        const int row0 = u.pm * BM + wr * 64 + fr, col0 = u.pn * BM + wc * 32 + 8 * fq;
#pragma unroll
        for (int ai = 0; ai < 2; ++ai)
#pragma unroll
            for (int m = 0; m < 4; ++m) { bf16_t* rowp = O + (size_t)(row0 + ai * HALF + m * 16) * ldc + col0;
#pragma unroll
                for (int bj = 0; bj < 2; ++bj) { const f32x4 v0 = acc[ai][bj][m][0], v1 = acc[ai][bj][m][1];
                    u32x4 w; w.x = cvt_pk_bf16(v0[0], v0[1]); w.y = cvt_pk_bf16(v0[2], v0[3]); w.z = cvt_pk_bf16(v1[0], v1[1]); w.w = cvt_pk_bf16(v1[2], v1[3]);
                    *(u32x4*)(rowp + bj * HALF) = w; } }
    }
};
struct EpiSwiGLU {
    static constexpr bool PERM = true, AFTER_DRAIN = false;
    bf16_t* H;
    __device__ __forceinline__ void operator()(const Acc& acc, const Unit& u, int wr, int wc, int fr, int fq) const {
        const int row0 = u.pm * BM + wr * 64 + fr, col0 = u.pn * HALF + wc * 32 + 8 * fq;
#pragma unroll
        for (int ai = 0; ai < 2; ++ai)
#pragma unroll
            for (int m = 0; m < 4; ++m) { bf16_t* rowp = H + (size_t)(row0 + ai * HALF + m * 16) * DFF + col0;
                float h[8];
#pragma unroll
                for (int n = 0; n < 2; ++n)
#pragma unroll
                    for (int j = 0; j < 4; ++j) { const float gt = acc[ai][0][m][n][j], up = acc[ai][1][m][n][j]; h[n * 4 + j] = gt * sigmoidf_fast(gt) * up; }
                u32x4 w; w.x = cvt_pk_bf16(h[0], h[1]); w.y = cvt_pk_bf16(h[2], h[3]); w.z = cvt_pk_bf16(h[4], h[5]); w.w = cvt_pk_bf16(h[6], h[7]);
                *(u32x4*)rowp = w; }
    }
};
struct EpiGate {
    static constexpr bool PERM = true, AFTER_DRAIN = false;
    bf16_t* G;
    __device__ __forceinline__ void operator()(const Acc& acc, const Unit& u, int wr, int wc, int fr, int fq) const {
        const int row0 = u.pm * BM + wr * 64 + fr, col0 = u.pn * BM + wc * 32 + 8 * fq;
#pragma unroll
        for (int ai = 0; ai < 2; ++ai)
#pragma unroll
            for (int m = 0; m < 4; ++m) { bf16_t* rowp = G + (size_t)(row0 + ai * HALF + m * 16) * 2048 + col0;
#pragma unroll
                for (int bj = 0; bj < 2; ++bj) { const f32x4 v0 = acc[ai][bj][m][0], v1 = acc[ai][bj][m][1];
                    u32x4 w; w.x = cvt_pk_bf16(sigmoidf_fast(v0[0]), sigmoidf_fast(v0[1])); w.y = cvt_pk_bf16(sigmoidf_fast(v0[2]), sigmoidf_fast(v0[3]));
                    w.z = cvt_pk_bf16(sigmoidf_fast(v1[0]), sigmoidf_fast(v1[1])); w.w = cvt_pk_bf16(sigmoidf_fast(v1[2]), sigmoidf_fast(v1[3]));
                    *(u32x4*)(rowp + bj * HALF) = w; } }
    }
};
struct EpiQ {
    static constexpr bool PERM = true, AFTER_DRAIN = false;
    bf16_t* Q; const float* TAB;
    __device__ __forceinline__ void operator()(const Acc& acc, const Unit& u, int wr, int wc, int fr, int fq) const {
        const int row0 = u.pm * BM + wr * 64 + fr, col0 = u.pn * BM + wc * 32 + 8 * fq;
#pragma unroll
        for (int ai = 0; ai < 2; ++ai)
#pragma unroll
            for (int m = 0; m < 4; ++m) { const int row = row0 + ai * HALF + m * 16; bf16_t* rowp = Q + (size_t)row * 1536 + col0;
#pragma unroll
                for (int bj = 0; bj < 2; ++bj) { f32x4 v0 = acc[ai][bj][m][0], v1 = acc[ai][bj][m][1];
                    const int c = col0 + bj * HALF, w = c % 192;
                    if (w >= 128) { const int i0 = (w - 128) >> 1; const f32x4 cs = *(const f32x4*)(TAB + (size_t)row * 64 + i0), sn = *(const f32x4*)(TAB + (size_t)row * 64 + 32 + i0);
                        f32x4 r0, r1;
                        r0[0] = v0[0] * cs[0] - v0[1] * sn[0]; r0[1] = v0[1] * cs[0] + v0[0] * sn[0];
                        r0[2] = v0[2] * cs[1] - v0[3] * sn[1]; r0[3] = v0[3] * cs[1] + v0[2] * sn[1];
                        r1[0] = v1[0] * cs[2] - v1[1] * sn[2]; r1[1] = v1[1] * cs[2] + v1[0] * sn[2];
                        r1[2] = v1[2] * cs[3] - v1[3] * sn[3]; r1[3] = v1[3] * cs[3] + v1[2] * sn[3];
                        v0 = r0; v1 = r1; }
                    u32x4 wv; wv.x = cvt_pk_bf16(v0[0], v0[1]); wv.y = cvt_pk_bf16(v0[2], v0[3]); wv.z = cvt_pk_bf16(v1[0], v1[1]); wv.w = cvt_pk_bf16(v1[2], v1[3]);
                    *(u32x4*)(rowp + bj * HALF) = wv; } }
    }
};
struct EpiT1 {
    static constexpr bool PERM = true, AFTER_DRAIN = false;
    const bf16_t* G; bf16_t* F;
    __device__ __forceinline__ void operator()(const Acc& acc, const Unit& u, int wr, int wc, int fr, int fq) const {
        const int row0 = u.pm * BM + wr * 64 + fr, col0 = u.pn * BM + wc * 32 + 8 * fq;
#pragma unroll
        for (int ai = 0; ai < 2; ++ai)
#pragma unroll
            for (int m = 0; m < 4; ++m) { const int row = row0 + ai * HALF + m * 16;
#pragma unroll
                for (int bj = 0; bj < 2; ++bj) { const f32x4 v0 = acc[ai][bj][m][0], v1 = acc[ai][bj][m][1]; const int c = col0 + bj * HALF;
                    const u32x4 gw = *(const u32x4*)(G + (size_t)row * 2048 + c);
                    u32x4 wv;
                    wv.x = cvt_pk_bf16(v0[0] * bf_lo(gw.x), v0[1] * bf_hi(gw.x)); wv.y = cvt_pk_bf16(v0[2] * bf_lo(gw.y), v0[3] * bf_hi(gw.y));
                    wv.z = cvt_pk_bf16(v1[0] * bf_lo(gw.z), v1[1] * bf_hi(gw.z)); wv.w = cvt_pk_bf16(v1[2] * bf_lo(gw.w), v1[3] * bf_hi(gw.w));
                    *(u32x4*)(F + (size_t)row * 1024 + c) = wv; } }
    }
};
struct EpiMX {
    static constexpr bool PERM = true, AFTER_DRAIN = false;
    const bf16_t* G; const bf16_t* F; bf16_t* MX;
    __device__ __forceinline__ void operator()(const Acc& acc, const Unit& u, int wr, int wc, int fr, int fq) const {
        const int row0 = u.pm * BM + wr * 64 + fr, col0 = u.pn * BM + wc * 32 + 8 * fq;
#pragma unroll
        for (int ai = 0; ai < 2; ++ai)
#pragma unroll
            for (int m = 0; m < 4; ++m) { const int row = row0 + ai * HALF + m * 16;
#pragma unroll
                for (int bj = 0; bj < 2; ++bj) { const f32x4 v0 = acc[ai][bj][m][0], v1 = acc[ai][bj][m][1]; const int c = col0 + bj * HALF;
                    const u32x4 gw = *(const u32x4*)(G + (size_t)row * 2048 + 1024 + c);
                    const u32x4 tw = *(const u32x4*)(F + (size_t)row * 1024 + c);
                    u32x4 wv;
                    wv.x = cvt_pk_bf16(bf_lo(tw.x) + v0[0] * bf_lo(gw.x), bf_hi(tw.x) + v0[1] * bf_hi(gw.x)); wv.y = cvt_pk_bf16(bf_lo(tw.y) + v0[2] * bf_lo(gw.y), bf_hi(tw.y) + v0[3] * bf_hi(gw.y));
                    wv.z = cvt_pk_bf16(bf_lo(tw.z) + v1[0] * bf_lo(gw.z), bf_hi(tw.z) + v1[1] * bf_hi(gw.z)); wv.w = cvt_pk_bf16(bf_lo(tw.w) + v1[2] * bf_lo(gw.w), bf_hi(tw.w) + v1[3] * bf_hi(gw.w));
                    *(u32x4*)(MX + (size_t)row * 1024 + c) = wv; } }
    }
};

struct PanelSumSq {
    float* xbuf;
    unsigned* cnt;
    __device__ __forceinline__ void run(const Acc& v, const Unit& u, int wr, int wc, int fr, int fq, LAS unsigned char* lds, int wid, int lane) const {
        LAS float* P = (LAS float*)lds; LAS float* S = (LAS float*)(lds + 4096);
#pragma unroll
        for (int ai = 0; ai < 2; ++ai)
#pragma unroll
            for (int m = 0; m < 4; ++m) { float q = 0.f;
#pragma unroll
                for (int bj = 0; bj < 2; ++bj)
#pragma unroll
                    for (int n = 0; n < 2; ++n) { const f32x4 x = v[ai][bj][m][n]; q += (x[0] * x[0] + x[1] * x[1]) + (x[2] * x[2] + x[3] * x[3]); }
                q += __shfl_xor(q, 16); q += __shfl_xor(q, 32);
                if (fq == 0) P[(ai * HALF + wr * 64 + m * 16 + fr) * 4 + wc] = q; }
        asm volatile("s_waitcnt lgkmcnt(0)" ::: "memory"); __builtin_amdgcn_s_barrier(); asm volatile("" ::: "memory");
        const int row = wid * 32 + (lane & 31);
        if (lane < 32) { const float t = (P[row * 4 + 0] + P[row * 4 + 1]) + (P[row * 4 + 2] + P[row * 4 + 3]);
            __hip_atomic_store(xbuf + ((size_t)(u.pm * BM + row) * 4 + u.pn), t, __ATOMIC_RELAXED, __HIP_MEMORY_SCOPE_AGENT); }
        asm volatile("s_waitcnt vmcnt(0)" ::: "memory");
        if (lane == 0) __hip_atomic_fetch_add(cnt + 64 * u.pm, 1u, __ATOMIC_RELAXED, __HIP_MEMORY_SCOPE_AGENT);
        if (wid == 0) { unsigned sp = 0u;
            while ((unsigned)__builtin_amdgcn_readfirstlane(__hip_atomic_load(cnt + 64 * u.pm, __ATOMIC_RELAXED, __HIP_MEMORY_SCOPE_AGENT)) < 32u) { __builtin_amdgcn_s_sleep(1); if (++sp > (1u << 22)) break; }
            }
        asm volatile("s_waitcnt vmcnt(0) lgkmcnt(0)" ::: "memory"); __builtin_amdgcn_s_barrier(); asm volatile("" ::: "memory");
        if (lane < 32) { const float* slot = xbuf + (size_t)(u.pm * BM + row) * 4; float tot = 0.f;
#pragma unroll
            for (int t = 0; t < 4; ++t) tot += __hip_atomic_load(slot + t, __ATOMIC_RELAXED, __HIP_MEMORY_SCOPE_AGENT);
            S[row] = __builtin_amdgcn_rsqf(tot * (1.f / 1024.f) + EPS); }
        asm volatile("s_waitcnt lgkmcnt(0)" ::: "memory"); __builtin_amdgcn_s_barrier(); asm volatile("" ::: "memory");
    }
};
template <bool FINAL, bool BASEF32> struct EpiResNorm {
    static constexpr bool PERM = true, AFTER_DRAIN = true;
    const float* basef; bf16_t* xb; float* outf; bf16_t* xn; float wt; const float* gpost; const float* gnext; PanelSumSq st1, st2;
    __device__ __forceinline__ void operator()(const Acc&, const Unit&, int, int, int, int) const {}
    __device__ __forceinline__ void fused(Acc& acc, const Unit& u, int wr, int wc, int fr, int fq, LAS unsigned char* lds, int wid, int lane) const {
        const LAS float* S = (const LAS float*)(lds + 4096);
        const int col0 = u.pn * BM + wc * 32 + 8 * fq;
        st1.run(acc, u, wr, wc, fr, fq, lds, wid, lane);
#pragma unroll
        for (int ai = 0; ai < 2; ++ai)
#pragma unroll
            for (int m = 0; m < 4; ++m) { const int r = ai * HALF + wr * 64 + m * 16 + fr; const float sr = S[r] * wt;
                const size_t off = (size_t)(u.pm * BM + r) * 1024 + col0, xoff = (size_t)u.pm * 524288 + 262144 + (size_t)r * 1024 + col0;
#pragma unroll
                for (int bj = 0; bj < 2; ++bj) { f32x4 b0, b1;
                    if (BASEF32) { b0 = __builtin_nontemporal_load((const f32x4*)(basef + off + bj * HALF)); b1 = __builtin_nontemporal_load((const f32x4*)(basef + off + bj * HALF + 4)); }
                    else { const u32x4 w = __builtin_nontemporal_load((const u32x4*)(xb + xoff + bj * HALF)); b0 = (f32x4){bf_lo(w.x), bf_hi(w.x), bf_lo(w.y), bf_hi(w.y)}; b1 = (f32x4){bf_lo(w.z), bf_hi(w.z), bf_lo(w.w), bf_hi(w.w)}; }
                    const f32x4 g0 = *(const f32x4*)(gpost + col0 + bj * HALF), g1 = *(const f32x4*)(gpost + col0 + bj * HALF + 4);
                    acc[ai][bj][m][0] = b0 + acc[ai][bj][m][0] * g0 * sr; acc[ai][bj][m][1] = b1 + acc[ai][bj][m][1] * g1 * sr; }
                asm volatile("" : "+v"(acc[ai][0][m][0]), "+v"(acc[ai][0][m][1]), "+v"(acc[ai][1][m][0]), "+v"(acc[ai][1][m][1]));
                if (m & 1) asm volatile("" ::: "memory"); }
        st2.run(acc, u, wr, wc, fr, fq, lds, wid, lane);
#pragma unroll
        for (int ai = 0; ai < 2; ++ai)
#pragma unroll
            for (int m = 0; m < 4; ++m) { const int r = ai * HALF + wr * 64 + m * 16 + fr; const float sr = S[r];
                const size_t off = (size_t)(u.pm * BM + r) * 1024 + col0, xoff = (size_t)u.pm * 524288 + 262144 + (size_t)r * 1024 + col0;
#pragma unroll
                for (int bj = 0; bj < 2; ++bj) { const f32x4 x0 = acc[ai][bj][m][0], x1 = acc[ai][bj][m][1];
                    const f32x4 g0 = *(const f32x4*)(gnext + col0 + bj * HALF), g1 = *(const f32x4*)(gnext + col0 + bj * HALF + 4); const f32x4 o0 = x0 * g0 * sr, o1 = x1 * g1 * sr;
                    if (FINAL) { *(f32x4*)(outf + off + bj * HALF) = o0; *(f32x4*)(outf + off + bj * HALF + 4) = o1; }
                    else { u32x4 wx; wx.x = cvt_pk_bf16(x0[0], x0[1]); wx.y = cvt_pk_bf16(x0[2], x0[3]); wx.z = cvt_pk_bf16(x1[0], x1[1]); wx.w = cvt_pk_bf16(x1[2], x1[3]); *(u32x4*)(xb + xoff + bj * HALF) = wx;
                           u32x4 w; w.x = cvt_pk_bf16(o0[0], o0[1]); w.y = cvt_pk_bf16(o0[2], o0[3]); w.z = cvt_pk_bf16(o1[0], o1[1]); w.w = cvt_pk_bf16(o1[2], o1[3]); *(u32x4*)(xn + off + bj * HALF) = w; } }
                asm volatile("" ::: "memory"); }
    }
};
}

namespace att {
constexpr int NW = 8, QBLK = 32, KVBLK = 64;
constexpr float SCALE = 0.07216878364870322f;
constexpr float THR = 8.f;
constexpr int LDQ = 1536, LDKV = 2048, LDKR = 64, LDO = 1024;
constexpr int SHM_V = 64 * 128 * 2, SHM_K = 64 * 128 * 2, SHM_R = 64 * 64 * 2;
constexpr int NQL = 4;
constexpr int OFF_V = 0, OFF_K = 2 * SHM_V, OFF_RP = OFF_K + 2 * SHM_K, OFF_WS = OFF_RP + 2 * SHM_R, OFF_QL = OFF_WS + NW * 64 * 4, SHM_ATTN = OFF_QL + NW * NQL * 1024;
static_assert(SHM_ATTN <= LDS_STAGE, "lds");
#define KSWZ(row, colB) ((row) * 256 + ((colB) ^ (((row) & 15) << 4)))
#define RSWZ(row, colB) ((row) * 128 + ((colB) ^ ((((row) >> 1) & 7) << 4)))
#define SBAR() __builtin_amdgcn_sched_barrier(0)
__device__ __forceinline__ int crow(int r, int hi) { return (r & 3) + 8 * (r >> 2) + 4 * hi; }
__device__ __forceinline__ bf16x8 ld8(const bf16_t* p) { return *reinterpret_cast<const bf16x8*>(p); }

__device__ __forceinline__ void partialSM(f32x16& p0, f32x16& p1, float& m_reg, float& mn, float& alpha) {
    constexpr float C = SCALE * 1.4426950408889634f;
    float pmax = p0[0];
#pragma unroll
    for (int r = 1; r < 16; ++r) pmax = fmaxf(pmax, p0[r]);
#pragma unroll
    for (int r = 0; r < 16; ++r) pmax = fmaxf(pmax, p1[r]);
    { auto rr = __builtin_amdgcn_permlane32_swap(__float_as_uint(pmax), __float_as_uint(pmax), false, false);
      pmax = fmaxf(__uint_as_float(rr[0]), __uint_as_float(rr[1])); }
    if (__builtin_expect(__all(pmax - m_reg <= THR / SCALE), 1)) { mn = m_reg; alpha = 1.f; }
    else { mn = fmaxf(m_reg, pmax); alpha = __builtin_amdgcn_exp2f((m_reg - mn) * C); m_reg = mn; }
    float mnC = -mn * C;
#pragma unroll
    for (int r = 0; r < 16; ++r) p0[r] = fmaf(p0[r], C, mnC);
#pragma unroll
    for (int r = 0; r < 16; ++r) p1[r] = fmaf(p1[r], C, mnC);
#pragma unroll
    for (int r = 0; r < 16; ++r) p0[r] = __builtin_amdgcn_exp2f(p0[r]);
}
__device__ __forceinline__ void finishSM(f32x16& p0, f32x16& p1, float alpha, float& l_reg, bf16x8& pa0, bf16x8& pa1, bf16x8& pa2, bf16x8& pa3) {
#pragma unroll
    for (int r = 0; r < 16; ++r) p1[r] = __builtin_amdgcn_exp2f(p1[r]);
    float ps = 0;
#pragma unroll
    for (int r = 0; r < 16; ++r) ps += p0[r];
#pragma unroll
    for (int r = 0; r < 16; ++r) ps += p1[r];
    { auto rr = __builtin_amdgcn_permlane32_swap(__float_as_uint(ps), __float_as_uint(ps), false, false);
      ps = __uint_as_float(rr[0]) + __uint_as_float(rr[1]); }
    l_reg = l_reg * alpha + ps;
#define PK4(P, BASE, OUT) do { unsigned a0 = cvt_pk_bf16(P[BASE + 0], P[BASE + 1]), a1 = cvt_pk_bf16(P[BASE + 2], P[BASE + 3]);   \
    unsigned b0 = cvt_pk_bf16(P[BASE + 4], P[BASE + 5]), b1 = cvt_pk_bf16(P[BASE + 6], P[BASE + 7]);                              \
    auto r0 = __builtin_amdgcn_permlane32_swap(a0, b0, false, false); auto r1 = __builtin_amdgcn_permlane32_swap(a1, b1, false, false); \
    u32x4 w = {r0[0], r1[0], r0[1], r1[1]}; OUT = *reinterpret_cast<bf16x8*>(&w); } while (0)
    PK4(p0, 0, pa0); PK4(p0, 8, pa1); PK4(p1, 0, pa2); PK4(p1, 8, pa3);
#undef PK4
}
__device__ __forceinline__ void qkt(f32x16& p0, f32x16& p1, const char* Ks, const char* Rs, const bf16x8* qr, const char* ql, int r32, int hi) {
    p0 = f32x16{}; p1 = f32x16{};
#pragma unroll
    for (int d0 = 0; d0 < 8; ++d0) { int cb = (d0 * 16 + hi * 8) * 2;
        bf16x8 b0 = *reinterpret_cast<const bf16x8*>(Ks + KSWZ(r32, cb));
        bf16x8 b1 = *reinterpret_cast<const bf16x8*>(Ks + KSWZ(32 + r32, cb));
        p0 = __builtin_amdgcn_mfma_f32_32x32x16_bf16(b0, qr[d0], p0, 0, 0, 0);
        p1 = __builtin_amdgcn_mfma_f32_32x32x16_bf16(b1, qr[d0], p1, 0, 0, 0); }
#pragma unroll
    for (int d0 = 0; d0 < 4; ++d0) { int cb = (d0 * 16 + hi * 8) * 2;
        bf16x8 b0 = *reinterpret_cast<const bf16x8*>(Rs + RSWZ(r32, cb));
        bf16x8 b1 = *reinterpret_cast<const bf16x8*>(Rs + RSWZ(32 + r32, cb));
        const bf16x8 qv = *reinterpret_cast<const bf16x8*>(ql + d0 * 1024);
        p0 = __builtin_amdgcn_mfma_f32_32x32x16_bf16(b0, qv, p0, 0, 0, 0);
        p1 = __builtin_amdgcn_mfma_f32_32x32x16_bf16(b1, qv, p1, 0, 0, 0); }
}
__device__ __forceinline__ int v_st(int k, int c) { const int kk = (k & ~0xC) | ((k & 4) << 1) | ((k & 8) >> 1); return ((kk >> 3) * 4 + (c >> 5)) * 512 + ((kk & 7) * 32 + (c & 31)) * 2; }
__device__ __forceinline__ int v_rd_base(int lane) { return ((lane & 3) << 3) | (((lane >> 2) & 3) << 6) | (((lane >> 4) & 1) << 5) | (((lane >> 5) & 1) << 8); }
constexpr int v_rd_off(int d0, int ks, int half) { return d0 * 512 + ks * 4096 + half * 2048; }
template <int OFF> __device__ __forceinline__ s16x4 tr_read(int vb) {
    s16x4 r; asm volatile("ds_read_b64_tr_b16 %0, %1 offset:%2" : "=&v"(r) : "v"(vb), "i"(OFF) : "memory"); return r;
}
template <int D0> __device__ __forceinline__ void pv_one(f32x16& od, int vb, bf16x8 pa0, bf16x8 pa1, bf16x8 pa2, bf16x8 pa3) {
    const s16x4 l0 = tr_read<v_rd_off(D0, 0, 0)>(vb), h0 = tr_read<v_rd_off(D0, 0, 1)>(vb), l1 = tr_read<v_rd_off(D0, 1, 0)>(vb), h1 = tr_read<v_rd_off(D0, 1, 1)>(vb);
    const s16x4 l2 = tr_read<v_rd_off(D0, 2, 0)>(vb), h2 = tr_read<v_rd_off(D0, 2, 1)>(vb), l3 = tr_read<v_rd_off(D0, 3, 0)>(vb), h3 = tr_read<v_rd_off(D0, 3, 1)>(vb);
    asm volatile("s_waitcnt lgkmcnt(0)" ::: "memory"); SBAR();
#define PK(L, H) (bf16x8){L[0], L[1], L[2], L[3], H[0], H[1], H[2], H[3]}
    od = __builtin_amdgcn_mfma_f32_32x32x16_bf16(pa0, PK(l0, h0), od, 0, 0, 0);
    od = __builtin_amdgcn_mfma_f32_32x32x16_bf16(pa1, PK(l1, h1), od, 0, 0, 0);
    od = __builtin_amdgcn_mfma_f32_32x32x16_bf16(pa2, PK(l2, h2), od, 0, 0, 0);
    od = __builtin_amdgcn_mfma_f32_32x32x16_bf16(pa3, PK(l3, h3), od, 0, 0, 0);
#undef PK
}
__device__ __forceinline__ void pv_d0(f32x16* o, int vb, bf16x8 pa0, bf16x8 pa1, bf16x8 pa2, bf16x8 pa3) {
    pv_one<0>(o[0], vb, pa0, pa1, pa2, pa3); pv_one<1>(o[1], vb, pa0, pa1, pa2, pa3); pv_one<2>(o[2], vb, pa0, pa1, pa2, pa3); pv_one<3>(o[3], vb, pa0, pa1, pa2, pa3);
}

__device__ __forceinline__ void attn_body(const bf16_t* __restrict__ Qb, const bf16_t* __restrict__ Kn, const bf16_t* __restrict__ Kr, const bf16_t* __restrict__ Vh,
                                          bf16_t* __restrict__ Ob, int seq, char* lds) {
    const int tid = fresh_tid(), wid = tid >> 6, lane = tid & 63, r32 = lane & 31, hi = lane >> 5;
    char* V_lds = lds + OFF_V; char* K_lds = lds + OFF_K; char* R_lds = lds + OFF_RP;
    float* ws = (float*)(lds + OFF_WS) + wid * 64; float* li_l = ws; float* al_l = ws + 32;
    float m_reg = -1e30f, l_reg = 0; f32x16 o[4] = {}; bf16x8 qr[8];
    char* ql = lds + OFF_QL + wid * (NQL * 1024) + lane * 16;
    const bf16_t* Qw = Qb + (long)(wid * QBLK + r32) * LDQ + hi * 8;
#pragma unroll
    for (int d0 = 0; d0 < 8; ++d0) qr[d0] = ld8(Qw + d0 * 16);
#pragma unroll
    for (int d0 = 0; d0 < NQL; ++d0) *reinterpret_cast<bf16x8*>(ql + d0 * 1024) = ld8(Qw + (8 + d0) * 16);
    const int sr = tid >> 4, sc = (tid & 15) * 8, vst0 = v_st(sr, sc), vst1 = v_st(32 + sr, sc);
    const int rr_ = tid >> 3, rc_ = (tid & 7) * 8;
    const int vb0 = (int)(uintptr_t)V_lds + v_rd_base(lane);
    bf16x8 vs0, vs1, ks0, ks1, rs0;
#define SLOAD(k0) do { vs0 = ld8(&Vh[(long)((k0) + sr) * LDKV + sc]); vs1 = ld8(&Vh[(long)((k0) + 32 + sr) * LDKV + sc]); \
    ks0 = ld8(&Kn[(long)((k0) + sr) * LDKV + sc]); ks1 = ld8(&Kn[(long)((k0) + 32 + sr) * LDKV + sc]); rs0 = ld8(&Kr[(long)((k0) + rr_) * LDKR + rc_]); } while (0)
#define SWRITE(b) do { *(bf16x8*)(V_lds + (b) * SHM_V + vst0) = vs0; *(bf16x8*)(V_lds + (b) * SHM_V + vst1) = vs1; int kc = sc * 2; \
    *(bf16x8*)(K_lds + (b) * SHM_K + KSWZ(sr, kc)) = ks0; *(bf16x8*)(K_lds + (b) * SHM_K + KSWZ(32 + sr, kc)) = ks1; \
    *(bf16x8*)(R_lds + (b) * SHM_R + RSWZ(rr_, rc_ * 2)) = rs0; } while (0)
#define RESC(a) do { if (__any((a) < 1.f)) { if (hi == 0) al_l[r32] = (a); asm volatile("s_waitcnt lgkmcnt(0)" ::: "memory"); \
    _Pragma("unroll") for (int d = 0; d < 4; ++d) _Pragma("unroll") for (int r = 0; r < 16; ++r) o[d][r] *= al_l[crow(r, hi)]; } } while (0)
    f32x16 pA0, pA1, pB0, pB1; float mnA, mnB, alA, alB; bf16x8 pa0, pa1, pa2, pa3; const int NT = seq / KVBLK;
    SLOAD(0); asm volatile("s_waitcnt vmcnt(0)" ::: "memory"); SWRITE(0); __syncthreads();
    qkt(pA0, pA1, K_lds, R_lds, qr, ql, r32, hi); partialSM(pA0, pA1, m_reg, mnA, alA);
    SLOAD(KVBLK);
    asm volatile("s_waitcnt vmcnt(0)" ::: "memory"); SWRITE(1); __syncthreads();
    for (int j = 1; j + 1 < NT; j += 2) {
        SBAR(); qkt(pB0, pB1, K_lds + SHM_K, R_lds + SHM_R, qr, ql, r32, hi);
        finishSM(pA0, pA1, alA, l_reg, pa0, pa1, pa2, pa3); SBAR();
        SLOAD((j + 1) * KVBLK); SBAR();
        pv_d0(o, vb0, pa0, pa1, pa2, pa3); partialSM(pB0, pB1, m_reg, mnB, alB);
        __syncthreads(); asm volatile("s_waitcnt vmcnt(0)" ::: "memory"); SWRITE(0);
        RESC(alB); __syncthreads();
        SBAR(); qkt(pA0, pA1, K_lds, R_lds, qr, ql, r32, hi);
        finishSM(pB0, pB1, alB, l_reg, pa0, pa1, pa2, pa3); SBAR();
        SLOAD((j + 2) * KVBLK); SBAR();
        pv_d0(o, vb0 + SHM_V, pa0, pa1, pa2, pa3); partialSM(pA0, pA1, m_reg, mnA, alA);
        __syncthreads(); asm volatile("s_waitcnt vmcnt(0)" ::: "memory"); SWRITE(1);
        RESC(alA); __syncthreads();
    }
    SBAR(); qkt(pB0, pB1, K_lds + SHM_K, R_lds + SHM_R, qr, ql, r32, hi);
    finishSM(pA0, pA1, alA, l_reg, pa0, pa1, pa2, pa3); SBAR();
    pv_d0(o, vb0, pa0, pa1, pa2, pa3); partialSM(pB0, pB1, m_reg, mnB, alB);
    __syncthreads(); RESC(alB);
    finishSM(pB0, pB1, alB, l_reg, pa0, pa1, pa2, pa3); SBAR();
    pv_d0(o, vb0 + SHM_V, pa0, pa1, pa2, pa3);
    if (hi == 0) li_l[r32] = l_reg; asm volatile("s_waitcnt lgkmcnt(0)" ::: "memory");
    float rli[16];
#pragma unroll
    for (int r = 0; r < 16; ++r) rli[r] = __builtin_amdgcn_rcpf(li_l[crow(r, hi)]);
    bf16_t* Ow = Ob + (long)(wid * QBLK) * LDO;
#pragma unroll
    for (int r = 0; r < 16; ++r) { int orow = crow(r, hi);
#pragma unroll
        for (int d0 = 0; d0 < 4; ++d0) { const float v = o[d0][r] * rli[r]; Ow[(long)orow * LDO + d0 * 32 + r32] = (bf16_t)(cvt_pk_bf16(v, v) & 0xffffu); } }
#undef SLOAD
#undef SWRITE
#undef RESC
}
}


#define XB_TMO      128
#define XB_XCNT(j)  (256  + 64 * (j))
#define XB_XSUB(j)  (1280 + 64 * (j))
#define XB_XGEN(j)  (2304 + 64 * (j))
#define XB_TOP      3328
#define XB_TOPGEN   3392
#define XCD_BAR_WORDS 3456
#define XB_SPIN_CAP (1u << 18)
__device__ __forceinline__ unsigned xb_ld(unsigned* p)              { return __hip_atomic_load(p, __ATOMIC_RELAXED, __HIP_MEMORY_SCOPE_AGENT); }
__device__ __forceinline__ unsigned xb_add(unsigned* p, unsigned v) { return __hip_atomic_fetch_add(p, v, __ATOMIC_RELAXED, __HIP_MEMORY_SCOPE_AGENT); }
__device__ __forceinline__ unsigned xb_xcc_id() { return (unsigned)__builtin_amdgcn_s_getreg((3 << 11) | 20) & 0xFu; }
#define XB_SPIN(cond, bar) do { unsigned _sp = 0; while (cond) { __builtin_amdgcn_s_sleep(1); \
    if ((++_sp & 255u) == 0u) { if (xb_ld(&(bar)[XB_TMO])) break; if (_sp > XB_SPIN_CAP) { atomicAdd(&(bar)[XB_TMO], 1u); break; } } } } while (0)
struct XcdBarrier { unsigned* bar; unsigned x; volatile LAS unsigned* st; };
__device__ __forceinline__ XcdBarrier xcd_barrier_post(unsigned* bar, volatile LAS unsigned* st) {
    XcdBarrier b; b.bar = bar; b.x = xb_xcc_id(); b.st = st;
    if (threadIdx.x == 0) (void)xb_add(&bar[XB_XCNT(b.x)], 1u);
    return b;
}
__device__ __forceinline__ void xcd_barrier_complete(unsigned* bar, unsigned x, unsigned& nloc, unsigned& nx) {
    const unsigned G = gridDim.x * gridDim.y * gridDim.z;
    unsigned sum, cnt, mine, sp = 0u;
    for (;;) {
        sum = 0u; cnt = 0u; mine = 0u;
#pragma unroll
        for (unsigned j = 0; j < 16; ++j) { const unsigned c = xb_ld(&bar[XB_XCNT(j)]); sum += c; cnt += (c > 0u) ? 1u : 0u; mine = (j == x) ? c : mine; }
        if (sum == G) break;
        __builtin_amdgcn_s_sleep(1);
        if ((++sp & 255u) == 0u) { if (xb_ld(&bar[XB_TMO])) break; if (sp > XB_SPIN_CAP) { atomicAdd(&bar[XB_TMO], 1u); break; } }
    }
    nloc = mine > 0u ? mine : 1u; nx = cnt > 0u ? cnt : 1u;
}
__device__ __forceinline__ void xcd_barrier(const XcdBarrier& b) {
    asm volatile("s_waitcnt vmcnt(0)" ::: "memory");
    __syncthreads();
    if (threadIdx.x == 0) {
        unsigned* bar = b.bar;
        __builtin_amdgcn_s_waitcnt(0);
        unsigned nloc = b.st[0], nx = b.st[1];
        if (nloc == 0u) { xcd_barrier_complete(bar, b.x, nloc, nx); b.st[0] = nloc; b.st[1] = nx; }
        const unsigned old = xb_add(&bar[XB_XSUB(b.x)], 1u);
        const unsigned gen = old / nloc;
        if (old + 1u == (gen + 1u) * nloc) {
            __builtin_amdgcn_fence(__ATOMIC_RELEASE, "agent");
            asm volatile("s_waitcnt vmcnt(0)" ::: "memory");
            const unsigned og = xb_add(&bar[XB_TOP], 1u);
            const unsigned tg = og / nx;
            __builtin_amdgcn_fence(__ATOMIC_ACQUIRE, "agent");
            if (og + 1u == (tg + 1u) * nx) xb_add(&bar[XB_TOPGEN], 1u);
            else XB_SPIN(xb_ld(&bar[XB_TOPGEN]) == tg, bar);
            xb_add(&bar[XB_XGEN(b.x)], 1u);
            asm volatile("s_waitcnt vmcnt(0)" ::: "memory");
        } else {
            __builtin_amdgcn_fence(__ATOMIC_ACQUIRE, "agent");
            XB_SPIN(xb_ld(&bar[XB_XGEN(b.x)]) == gen, bar);
            asm volatile("s_waitcnt vmcnt(0)" ::: "memory");
        }
    }
    __syncthreads();
}

enum { TR_PLAIN = 0, TR_GU = 1, TR_WIN = 2, TR_UQ = 3, TR_UKV = 4 };
template <int MODE>
__device__ __forceinline__ void tr_job(const float* W0, const float* W1, int K, int Nsrc, int Nout, bf16_t* WT, LAS float* scr, int lane, int gw, int NGW, int shift = 0) {
    const int nblk = Nout / 32, nitems = (K / 64) * nblk;
    int it0 = gw - shift; if (it0 < 0) it0 += NGW;
    for (int it = it0; it < nitems; it += NGW) {
        const int kb = it / nblk, nb = it % nblk, k0 = 64 * kb, n0 = 32 * nb, np = n0 + (lane & 31);
        const float* colp;
        if (MODE == TR_PLAIN) colp = W0 + np;
        else if (MODE == TR_GU) { const int t = np >> 8, w = np & 255; colp = (w < 128 ? W0 : W1) + t * 128 + (w & 127); }
        else if (MODE == TR_WIN) colp = np < 1216 ? W0 + np : (np < 1280 ? nullptr : W0 + (np - 64));
        else if (MODE == TR_UQ) { const int h = np / 192, w = np % 192; colp = W0 + (w < 128 ? np : h * 192 + 128 + ((w - 128) >> 1) + ((w - 128) & 1) * 32); }
        else colp = np < 1024 ? W0 + np : W1 + (np - 1024);
        float tv[32];
#pragma unroll
        for (int i = 0; i < 32; ++i) { const int kk = 2 * i + (lane >> 5); tv[i] = colp ? __builtin_nontemporal_load(colp + (size_t)(k0 + kk) * Nsrc) : 0.f; }
#pragma unroll
        for (int i = 0; i < 32; ++i) { const int kk = 2 * i + (lane >> 5); scr[kk * 33 + (lane & 31)] = tv[i]; }
        asm volatile("s_waitcnt lgkmcnt(0)" ::: "memory");
        const int c = lane & 7;
#pragma unroll
        for (int j = 0; j < 4; ++j) { const int n = (lane >> 3) + 8 * j; const LAS float* s = scr + (8 * c) * 33 + n;
            u32x4 o; o.x = cvt_pk_bf16(s[0 * 33], s[1 * 33]); o.y = cvt_pk_bf16(s[2 * 33], s[3 * 33]); o.z = cvt_pk_bf16(s[4 * 33], s[5 * 33]); o.w = cvt_pk_bf16(s[6 * 33], s[7 * 33]);
            *(u32x4*)(WT + (size_t)(n0 + n) * K + k0 + 8 * c) = o; }
        asm volatile("s_waitcnt lgkmcnt(0)" ::: "memory");
    }
}

__device__ __forceinline__ void norm_rows(const float* xin, const float* gnext, bf16_t* xn, int gw, int NGW, int lane) {
    for (int row0 = gw; row0 < M; row0 += 2 * NGW) {
        f32x4 xv[2][4];
#pragma unroll
        for (int r = 0; r < 2; ++r) { const size_t row = (size_t)(row0 + r * NGW);
#pragma unroll
            for (int j = 0; j < 2; ++j) { xv[r][2 * j] = __builtin_nontemporal_load((const f32x4*)(xin + row * DM + 8 * (lane + 64 * j))); xv[r][2 * j + 1] = __builtin_nontemporal_load((const f32x4*)(xin + row * DM + 8 * (lane + 64 * j) + 4)); } }
#pragma unroll
        for (int r = 0; r < 2; ++r) { const size_t row = (size_t)(row0 + r * NGW);
            float s2 = 0.f;
#pragma unroll
            for (int j = 0; j < 4; ++j) s2 += xv[r][j].x * xv[r][j].x + xv[r][j].y * xv[r][j].y + xv[r][j].z * xv[r][j].z + xv[r][j].w * xv[r][j].w;
            const float r2 = __builtin_amdgcn_rsqf(wave_sum(s2) * (1.f / DM) + EPS);
#pragma unroll
            for (int j = 0; j < 2; ++j) { const f32x4 g0 = *(const f32x4*)(gnext + 8 * (lane + 64 * j)), g1 = *(const f32x4*)(gnext + 8 * (lane + 64 * j) + 4);
                const f32x4 y0 = xv[r][2 * j] * g0 * r2, y1 = xv[r][2 * j + 1] * g1 * r2;
                u32x4 w; w.x = cvt_pk_bf16(y0.x, y0.y); w.y = cvt_pk_bf16(y0.z, y0.w); w.z = cvt_pk_bf16(y1.x, y1.y); w.w = cvt_pk_bf16(y1.z, y1.w);
                *(u32x4*)(xn + row * DM + 8 * (lane + 64 * j)) = w; }
        }
    }
}

__global__ void __launch_bounds__(NTHREADS, 2) fwd_megakernel(Params p) {
    extern __shared__ __attribute__((aligned(16))) unsigned char lds[];
    cg::grid_group grid = cg::this_grid();
    volatile LAS unsigned* bst = (volatile LAS unsigned*)((LAS unsigned char*)lds + LDS_STAGE);
    if (threadIdx.x < 2) bst[threadIdx.x] = 0u;
    __syncthreads();
    const XcdBarrier xbar = xcd_barrier_post((unsigned*)(p.ws + OFF_BAR), bst);
#define GRID_SYNC_CG() do { __builtin_amdgcn_fence(__ATOMIC_RELEASE, "agent"); asm volatile("s_waitcnt vmcnt(0)" ::: "memory"); grid.sync(); \
        __builtin_amdgcn_fence(__ATOMIC_ACQUIRE, "agent"); asm volatile("s_waitcnt vmcnt(0)" ::: "memory"); } while (0)
#define GRID_SYNC() xcd_barrier(xbar)
    const int G = gridDim.x, bid = blockIdx.x, NGW = G * NWAVES;
    LAS unsigned char* ldsl = (LAS unsigned char*)lds;
#define PHASE_IDS() const int tid = fresh_tid(), lane = tid & 63, wave = tid >> 6, gw = bid * NWAVES + wave; LAS float* scr = (LAS float*)(ldsl + wave * 8448); (void)scr; (void)gw; (void)lane
    unsigned char* ws = p.ws;
    bf16_t* Wgu = (bf16_t*)(ws + OFF_WGU); bf16_t* Wd = (bf16_t*)(ws + OFF_WD); bf16_t* Win = (bf16_t*)(ws + OFF_WIN); bf16_t* Wuq = (bf16_t*)(ws + OFF_WUQ);
    bf16_t* Wukv = (bf16_t*)(ws + OFF_WUKV); bf16_t* Woa = (bf16_t*)(ws + OFF_WOA); bf16_t* Wp = (bf16_t*)(ws + OFF_WP); bf16_t* Wout = (bf16_t*)(ws + OFF_WOUT);
    bf16_t* XN = (bf16_t*)(ws + OFF_XN); bf16_t* F = (bf16_t*)(ws + OFF_F); float* ZF = (float*)(ws + OFF_ZF); bf16_t* KV = (bf16_t*)(ws + OFF_KV);
    bf16_t* H = (bf16_t*)(ws + OFF_H); bf16_t* O = (bf16_t*)(ws + OFF_O); bf16_t* CQN = (bf16_t*)(ws + OFF_CQN); bf16_t* CKVN = (bf16_t*)(ws + OFF_CKVN);
    float* TAB = (float*)(ws + OFF_TAB); bf16_t* Q = (bf16_t*)(ws + OFF_Q); bf16_t* KR = (bf16_t*)(ws + OFF_KR); bf16_t* Gt = (bf16_t*)(ws + OFF_G); bf16_t* DP = (bf16_t*)(ws + OFF_DP);
    float* X = p.out;
    bf16_t* MXb = (bf16_t*)(ws + OFF_F + 32 * MiB);
    float* xbuf0 = (float*)(ws + OFF_XBUF); unsigned* cnt0 = (unsigned*)(ws + OFF_CNT);

    { PHASE_IDS();
    tr_job<TR_GU>(p.f1_wg, p.f1_wu, 1024, DFF, 5632, Wgu, scr, lane, gw, NGW);
    norm_rows(p.x, p.f1_pre, XN, gw, NGW, lane); }
    if (__builtin_expect(p.out == nullptr, 0)) GRID_SYNC_CG();
    GRID_SYNC();

    pg8::StaticOrder S;
    { pg8::Gemm g{XN, Wgu, M, 5632, 1024}; S.init(M, 5632, G, bid); pg8::EpiSwiGLU E{H}; pg8::gemm_phase(ldsl, g, S, E); }
    {
        const int tail0 = (64 * 22) % G;
        if (tail0 != 0 && bid >= tail0) { PHASE_IDS(); const int tb = bid - tail0, nb = G - tail0, tgw = tb * NWAVES + wave, TNGW = nb * NWAVES;
            tr_job<TR_PLAIN>(p.f1_wd, nullptr, DFF, 1024, 1024, Wd, scr, lane, tgw, TNGW);
            tr_job<TR_WIN>(p.w_in, nullptr, 1024, INW, 3328, Win, scr, lane, tgw, TNGW, 384 % TNGW);
            tr_job<TR_UQ>(p.w_uq, nullptr, QL, 1536, 1536, Wuq, scr, lane, tgw, TNGW);
            tr_job<TR_UKV>(p.w_uk, p.w_uv, KVL, 1024, 2048, Wukv, scr, lane, tgw, TNGW, 384 % TNGW);
    }
        else if (tail0 == 0) { PHASE_IDS(); const int tb = bid, nb = G;
            tr_job<TR_PLAIN>(p.f1_wd, nullptr, DFF, 1024, 1024, Wd, scr, lane, gw, NGW);
            tr_job<TR_WIN>(p.w_in, nullptr, 1024, INW, 3328, Win, scr, lane, gw, NGW);
            tr_job<TR_UQ>(p.w_uq, nullptr, QL, 1536, 1536, Wuq, scr, lane, gw, NGW);
            tr_job<TR_UKV>(p.w_uk, p.w_uv, KVL, 1024, 2048, Wukv, scr, lane, gw, NGW);
    }
    }
    GRID_SYNC();
    { pg8::Gemm g{H, Wd, M, 1024, DFF}; S.init(M, 1024, G, bid);
      pg8::EpiResNorm<false, true> E{p.x, (bf16_t*)X, nullptr, XN, 0.5f, p.f1_post, p.mix_pre, pg8::PanelSumSq{xbuf0, cnt0}, pg8::PanelSumSq{xbuf0 + (size_t)M * 4, cnt0 + 4096}}; pg8::gemm_phase(ldsl, g, S, E); }
    GRID_SYNC();
    { pg8::Gemm g{XN, Win, M, 1280, 1024}; S.init(M, 1280, G, bid); pg8::EpiBf16 E{(bf16_t*)ZF, 1280}; pg8::gemm_phase(ldsl, g, S, E); }
    {
        const int tail0 = (64 * 5) % G; PHASE_IDS();
        if (tail0 != 0 && bid >= tail0) { const int tgw = (bid - tail0) * NWAVES + wave, TNGW = (G - tail0) * NWAVES;
            tr_job<TR_GU>(p.f2_wg, p.f2_wu, 1024, DFF, 5632, Wgu, scr, lane, tgw, TNGW);
            tr_job<TR_PLAIN>(p.f2_wd, nullptr, DFF, 1024, 1024, Wd, scr, lane, tgw, TNGW); }
        else if (tail0 == 0) { tr_job<TR_GU>(p.f2_wg, p.f2_wu, 1024, DFF, 5632, Wgu, scr, lane, gw, NGW); tr_job<TR_PLAIN>(p.f2_wd, nullptr, DFF, 1024, 1024, Wd, scr, lane, gw, NGW); }
    }
    GRID_SYNC();
    { PHASE_IDS();
    const bf16_t* ZB = (const bf16_t*)ZF;
    for (int bt = gw; bt < M / 4; bt += NGW) { const int row0 = bt * 4, t0 = row0 & (SEQ - 1);
        const int lane = fresh_tid() & 63;
        const int t_g = lane >> 4, wnd = 2 << t_g, wl = wnd >> 1, wrr = wnd - wl;
        u32x4 nb[19], qa[4], qb[4]; float kx1[4], kx2[4]; int pos[4];
#pragma unroll
        for (int i = 0; i < 19; ++i) { int tt = t0 - 8 + i; tt = tt < 0 ? 0 : (tt > SEQ - 1 ? SEQ - 1 : tt); nb[i] = *(const u32x4*)(ZB + (size_t)(row0 - t0 + tt) * 1280 + 704 + 8 * lane); }
#pragma unroll
        for (int k = 0; k < 4; ++k) { const bf16_t* z = ZB + (size_t)(row0 + k) * 1280;
            qa[k] = *(const u32x4*)(z + 8 * lane); qb[k] = (u32x4){0u, 0u, 0u, 0u}; if (lane < 16) qb[k] = *(const u32x4*)(z + 512 + 8 * lane);
            kx1[k] = 0.f; kx2[k] = 0.f; pos[k] = 0; if (lane < 32) { kx1[k] = bf_lo((unsigned)z[640 + lane]); kx2[k] = bf_lo((unsigned)z[672 + lane]); pos[k] = p.pos[row0 + k]; } }
        __builtin_amdgcn_sched_barrier(0);
#pragma unroll
        for (int k = 0; k < 4; ++k) { const int row = row0 + k, t = t0 + k, lo = max(t - wl, 0), hi = min(t + wrr, SEQ);
            float sacc[8];
#pragma unroll
            for (int i = 0; i < 8; ++i) sacc[i] = 0.f;
#pragma unroll
            for (int d = 0; d < 16; ++d) { const int tt = t - 8 + d; const float wv = (tt >= lo && tt < hi) ? 1.f : 0.f; const u32x4 v = nb[k + d];
                sacc[0] = fmaf(wv, bf_lo(v.x), sacc[0]); sacc[1] = fmaf(wv, bf_hi(v.x), sacc[1]); sacc[2] = fmaf(wv, bf_lo(v.y), sacc[2]); sacc[3] = fmaf(wv, bf_hi(v.y), sacc[3]);
                sacc[4] = fmaf(wv, bf_lo(v.z), sacc[4]); sacc[5] = fmaf(wv, bf_hi(v.z), sacc[5]); sacc[6] = fmaf(wv, bf_lo(v.w), sacc[6]); sacc[7] = fmaf(wv, bf_hi(v.w), sacc[7]); }
            {
                const float inv = 1.f / (float)(hi - lo); const u32x4 pc = nb[k + 8];
                u32x4 w; w.x = cvt_pk_bf16(sacc[0] * inv - bf_lo(pc.x), sacc[1] * inv - bf_hi(pc.x)); w.y = cvt_pk_bf16(sacc[2] * inv - bf_lo(pc.y), sacc[3] * inv - bf_hi(pc.y));
                w.z = cvt_pk_bf16(sacc[4] * inv - bf_lo(pc.z), sacc[5] * inv - bf_hi(pc.z)); w.w = cvt_pk_bf16(sacc[6] * inv - bf_lo(pc.w), sacc[7] * inv - bf_hi(pc.w));
                *(u32x4*)(DP + (size_t)row * 512 + 8 * lane) = w; }
            {
                const u32x4 a4 = qa[k], b4 = qb[k];
                float va[8] = {bf_lo(a4.x), bf_hi(a4.x), bf_lo(a4.y), bf_hi(a4.y), bf_lo(a4.z), bf_hi(a4.z), bf_lo(a4.w), bf_hi(a4.w)};
                float vb[8] = {bf_lo(b4.x), bf_hi(b4.x), bf_lo(b4.y), bf_hi(b4.y), bf_lo(b4.z), bf_hi(b4.z), bf_lo(b4.w), bf_hi(b4.w)};
                float sa = 0.f, sb = 0.f;
#pragma unroll
                for (int i = 0; i < 8; ++i) { sa = fmaf(va[i], va[i], sa); sb = fmaf(vb[i], vb[i], sb); }
                const float ssq = wave_sum(lane < 48 ? sa : 0.f), sskv = wave_sum((lane >= 48 ? sa : 0.f) + sb);
                const float rq = __builtin_amdgcn_rsqf(ssq * (1.f / QL) + EPS), rkv = __builtin_amdgcn_rsqf(sskv * (1.f / KVL) + EPS);
                const float* ga = lane < 48 ? p.qa_g + 8 * lane : p.kva_g + 8 * (lane - 48); const float ra = lane < 48 ? rq : rkv;
                const f32x4 g0 = *(const f32x4*)ga, g1 = *(const f32x4*)(ga + 4);
                u32x4 w; w.x = cvt_pk_bf16(va[0] * g0.x * ra, va[1] * g0.y * ra); w.y = cvt_pk_bf16(va[2] * g0.z * ra, va[3] * g0.w * ra); w.z = cvt_pk_bf16(va[4] * g1.x * ra, va[5] * g1.y * ra); w.w = cvt_pk_bf16(va[6] * g1.z * ra, va[7] * g1.w * ra);
                bf16_t* dst = lane < 48 ? CQN + (size_t)row * QL + 8 * lane : CKVN + (size_t)row * KVL + 8 * (lane - 48);
                *(u32x4*)dst = w;
                if (lane < 16) { const f32x4 h0 = *(const f32x4*)(p.kva_g + 128 + 8 * lane), h1 = *(const f32x4*)(p.kva_g + 132 + 8 * lane);
                    u32x4 w2; w2.x = cvt_pk_bf16(vb[0] * h0.x * rkv, vb[1] * h0.y * rkv); w2.y = cvt_pk_bf16(vb[2] * h0.z * rkv, vb[3] * h0.w * rkv); w2.z = cvt_pk_bf16(vb[4] * h1.x * rkv, vb[5] * h1.y * rkv); w2.w = cvt_pk_bf16(vb[6] * h1.z * rkv, vb[7] * h1.w * rkv);
                    *(u32x4*)(CKVN + (size_t)row * KVL + 128 + 8 * lane) = w2; }
            }
            if (lane < 32) {
                const float ang = (float)pos[k] * p.inv_freq[lane];
                const double ad = (double)ang; const double kq = rint(ad * 0.15915494309189535); const float red = (float)(ad - kq * 6.283185307179586);
                const float cs = __cosf(red), sn = __sinf(red);
                TAB[(size_t)row * 64 + lane] = cs; TAB[(size_t)row * 64 + 32 + lane] = sn;
                *(unsigned*)(KR + (size_t)row * 64 + 2 * lane) = cvt_pk_bf16(kx1[k] * cs - kx2[k] * sn, kx2[k] * cs + kx1[k] * sn);
            }
            __builtin_amdgcn_sched_barrier(0);
        }
    } }
    GRID_SYNC();
    { pg8::Gemm g{CQN, Wuq, M, 1536, QL}; S.init(M, 1536, G, bid); pg8::EpiQ E{Q, TAB}; pg8::gemm_phase(ldsl, g, S, E); }
    {
        const int tail0 = (64 * 6) % G;
        if (tail0 != 0 && bid >= tail0) { PHASE_IDS(); const int tb = bid - tail0, nb = G - tail0, tgw = tb * NWAVES + wave, TNGW = nb * NWAVES;
            tr_job<TR_PLAIN>(p.w_oa, nullptr, 1024, 1024, 1024, Woa, scr, lane, tgw, TNGW);
            tr_job<TR_PLAIN>(p.w_out, nullptr, 1024, 1024, 1024, Wout, scr, lane, tgw, TNGW, 512 % TNGW);
    for (int idx = tb * NTHREADS + tid; idx < 65536; idx += nb * NTHREADS) {
            const int n = idx & 1023, c8 = idx >> 10, g = c8 >> 4, cb = (c8 & 15) * 8;
            float a[8];
    #pragma unroll
            for (int i = 0; i < 8; ++i) a[i] = 0.f;
            for (int j0 = 0; j0 < 128; j0 += 8) { float w[8]; f32x4 pw[8][2];
    #pragma unroll
                for (int jj = 0; jj < 8; ++jj) w[jj] = p.w_op[(size_t)(g * 128 + j0 + jj) * 1024 + n] * p.pool_scale[g * 128 + j0 + jj];
    #pragma unroll
                for (int i = 0; i < 8; ++i) { pw[i][0] = *(const f32x4*)(p.pool_w + (size_t)(g * 128 + cb + i) * 128 + j0); pw[i][1] = *(const f32x4*)(p.pool_w + (size_t)(g * 128 + cb + i) * 128 + j0 + 4); }
    #pragma unroll
                for (int i = 0; i < 8; ++i)
    #pragma unroll
                    for (int jj = 0; jj < 8; ++jj) a[i] = fmaf(pw[i][jj >> 2][jj & 3], w[jj], a[i]); }
            u32x4 o; o.x = cvt_pk_bf16(a[0], a[1]); o.y = cvt_pk_bf16(a[2], a[3]); o.z = cvt_pk_bf16(a[4], a[5]); o.w = cvt_pk_bf16(a[6], a[7]);
            *(u32x4*)(Wp + (size_t)n * 512 + c8 * 8) = o;
        }
        }
        else if (tail0 == 0) { PHASE_IDS(); const int tb = bid, nb = G;
            tr_job<TR_PLAIN>(p.w_oa, nullptr, 1024, 1024, 1024, Woa, scr, lane, gw, NGW);
            tr_job<TR_PLAIN>(p.w_out, nullptr, 1024, 1024, 1024, Wout, scr, lane, gw, NGW);
    for (int idx = tb * NTHREADS + tid; idx < 65536; idx += nb * NTHREADS) {
            const int n = idx & 1023, c8 = idx >> 10, g = c8 >> 4, cb = (c8 & 15) * 8;
            float a[8];
    #pragma unroll
            for (int i = 0; i < 8; ++i) a[i] = 0.f;
            for (int j0 = 0; j0 < 128; j0 += 8) { float w[8]; f32x4 pw[8][2];
    #pragma unroll
                for (int jj = 0; jj < 8; ++jj) w[jj] = p.w_op[(size_t)(g * 128 + j0 + jj) * 1024 + n] * p.pool_scale[g * 128 + j0 + jj];
    #pragma unroll
                for (int i = 0; i < 8; ++i) { pw[i][0] = *(const f32x4*)(p.pool_w + (size_t)(g * 128 + cb + i) * 128 + j0); pw[i][1] = *(const f32x4*)(p.pool_w + (size_t)(g * 128 + cb + i) * 128 + j0 + 4); }
    #pragma unroll
                for (int i = 0; i < 8; ++i)
    #pragma unroll
                    for (int jj = 0; jj < 8; ++jj) a[i] = fmaf(pw[i][jj >> 2][jj & 3], w[jj], a[i]); }
            u32x4 o; o.x = cvt_pk_bf16(a[0], a[1]); o.y = cvt_pk_bf16(a[2], a[3]); o.z = cvt_pk_bf16(a[4], a[5]); o.w = cvt_pk_bf16(a[6], a[7]);
            *(u32x4*)(Wp + (size_t)n * 512 + c8 * 8) = o;
        }
        }
    }
    __syncthreads();
    { pg8::Gemm g{CKVN, Wukv, M, 2048, KVL}; S.init(M, 2048, G, bid); pg8::EpiBf16 E{KV, 2048}; pg8::gemm_phase(ldsl, g, S, E); }
    GRID_SYNC();
    {
        const int vcu = (bid & 7) * (G >> 3) + (bid >> 3);
        for (int it = vcu; it < NB * NH * (SEQ / 256); it += G) {
            const int qb = it & 7, h = (it >> 3) & 7, b = it >> 6;
            const size_t tok0 = (size_t)b * SEQ;
            att::attn_body(Q + (tok0 + qb * 256) * 1536 + h * 192, KV + tok0 * 2048 + h * 128, KR + tok0 * 64, KV + tok0 * 2048 + 1024 + h * 128,
                           O + (tok0 + qb * 256) * 1024 + h * 128, SEQ, (char*)lds);
            __syncthreads();
        }
    }
    GRID_SYNC();
    { pg8::Gemm g{XN, Win + (size_t)1280 * 1024, M, 2048, 1024}; pg8::GateOrder GO; GO.s.init(M, 1024, G, bid); pg8::EpiGate E{Gt}; pg8::gemm_phase(ldsl, g, GO, E); }
    { pg8::Gemm g{O, Woa, M, 1024, 1024}; S.init(M, 1024, G, bid); pg8::EpiT1 E{Gt, F}; pg8::gemm_phase(ldsl, g, S, E); }
    { pg8::Gemm g{DP, Wp, M, 1024, 512}; S.init(M, 1024, G, bid); pg8::EpiMX E{Gt, F, MXb}; pg8::gemm_phase(ldsl, g, S, E); }
    GRID_SYNC();
    { pg8::Gemm g{MXb, Wout, M, 1024, 1024}; S.init(M, 1024, G, bid);
      pg8::EpiResNorm<false, false> E{nullptr, (bf16_t*)X, nullptr, XN, 1.0f, p.mix_post, p.f2_pre, pg8::PanelSumSq{xbuf0 + (size_t)M * 8, cnt0 + 2 * 4096}, pg8::PanelSumSq{xbuf0 + (size_t)M * 12, cnt0 + 3 * 4096}}; pg8::gemm_phase(ldsl, g, S, E); }
    GRID_SYNC();
    { pg8::Gemm g{XN, Wgu, M, 5632, 1024}; S.init(M, 5632, G, bid); pg8::EpiSwiGLU E{H}; pg8::gemm_phase(ldsl, g, S, E); }
    GRID_SYNC();
    { pg8::Gemm g{H, Wd, M, 1024, DFF}; S.init(M, 1024, G, bid);
      pg8::EpiResNorm<true, false> E{nullptr, (bf16_t*)X, X, nullptr, 0.5f, p.f2_post, p.final_g, pg8::PanelSumSq{xbuf0 + (size_t)M * 16, cnt0 + 4 * 4096}, pg8::PanelSumSq{xbuf0 + (size_t)M * 20, cnt0 + 5 * 4096}}; pg8::gemm_phase(ldsl, g, S, E); }
}

extern "C" void kernel_launch(void* const* d_in, const int* in_sizes, int n_in, void* d_out, int out_size, void* d_ws, size_t ws_size, hipStream_t stream) {
    static int grid_blocks = 0;
    if (grid_blocks == 0) {
        if (n_in != 26 || in_sizes[0] != M * DM || out_size != M * DM || ws_size < WS_END) { fprintf(stderr, "kernel_launch: shape mismatch n_in %d in0 %d out %d ws %zu\n", n_in, n_in > 0 ? in_sizes[0] : -1, out_size, ws_size); grid_blocks = -1; return; }
        int dev = 0, cus = 0, per_cu = 0;
        (void)hipGetDevice(&dev);
        (void)hipDeviceGetAttribute(&cus, hipDeviceAttributeMultiprocessorCount, dev);
        if (hipFuncSetAttribute((const void*)fwd_megakernel, hipFuncAttributeMaxDynamicSharedMemorySize, LDS_BYTES) != hipSuccess) { fprintf(stderr, "kernel_launch: hipFuncSetAttribute failed\n"); grid_blocks = -1; return; }
        if (hipOccupancyMaxActiveBlocksPerMultiprocessor(&per_cu, (const void*)fwd_megakernel, NTHREADS, LDS_BYTES) != hipSuccess || per_cu < 1) { fprintf(stderr, "kernel_launch: occupancy query failed (%d)\n", per_cu); (void)hipGetLastError(); per_cu = 1; }
        grid_blocks = cus * 1;
        if (grid_blocks != 256) { fprintf(stderr, "kernel_launch: built for 256 CUs (one workgroup each), device has %d\n", cus); grid_blocks = -1; return; }
    }
    if (grid_blocks < 0) return;
    Params p{};
    p.x = (const float*)d_in[0]; p.pos = (const int*)d_in[1];
    p.f1_pre = (const float*)d_in[2]; p.f1_wg = (const float*)d_in[3]; p.f1_wu = (const float*)d_in[4]; p.f1_wd = (const float*)d_in[5]; p.f1_post = (const float*)d_in[6];
    p.mix_pre = (const float*)d_in[7]; p.w_in = (const float*)d_in[8]; p.qa_g = (const float*)d_in[9]; p.w_uq = (const float*)d_in[10]; p.kva_g = (const float*)d_in[11];
    p.w_uk = (const float*)d_in[12]; p.w_uv = (const float*)d_in[13]; p.w_oa = (const float*)d_in[14]; p.pool_w = (const float*)d_in[15]; p.pool_scale = (const float*)d_in[16];
    p.w_op = (const float*)d_in[17]; p.w_out = (const float*)d_in[18]; p.mix_post = (const float*)d_in[19];
    p.f2_pre = (const float*)d_in[20]; p.f2_wg = (const float*)d_in[21]; p.f2_wu = (const float*)d_in[22]; p.f2_wd = (const float*)d_in[23]; p.f2_post = (const float*)d_in[24]; p.final_g = (const float*)d_in[25];
    p.out = (float*)d_out; p.ws = (unsigned char*)d_ws;
    for (int i = 0; i < 32; ++i) p.inv_freq[i] = (float)pow(10000.0, -(2.0 * i) / 64.0);
    if (hipMemsetAsync((char*)d_ws + OFF_BAR, 0, CTL_BYTES, stream) != hipSuccess) { fprintf(stderr, "kernel_launch: memset failed\n"); return; }
    void* args[] = {&p};
    hipError_t e = hipLaunchCooperativeKernel((const void*)fwd_megakernel, dim3(grid_blocks), dim3(NTHREADS), args, LDS_BYTES, stream);
    if (e != hipSuccess) fprintf(stderr, "cooperative launch failed: %s (grid %d)\n", hipGetErrorString(e), grid_blocks);
}
```
